# Optimizing an MI355X kernel written in HIP

```python
import jax, jax.numpy as jnp
from jax import lax
import numpy as np

D_MODEL = 2048
BATCH = 1
SEQ = 8192
DEPTH = 1

D_MIX = D_MODEL
HEAD_DIM = 64
RWKV_WIDTH = D_MIX // 2
RWKV_HEADS = RWKV_WIDTH // HEAD_DIM
DECAY_LORA = 64
ICLR_LORA = 64
ATTN_WIDTH = D_MIX - RWKV_WIDTH
ATTN_Q_HEADS = ATTN_WIDTH // HEAD_DIM
GQA_GROUP = 8
ATTN_KV_HEADS = ATTN_Q_HEADS // GQA_GROUP
KV_WIDTH = ATTN_KV_HEADS * HEAD_DIM
WINDOW = 128
BLOCK = 128
RMS_EPS = 1e-5
LNX_EPS = 64e-5
NEG_INF = -1e30

RWKV_COLS = 4 * RWKV_WIDTH + DECAY_LORA + ICLR_LORA
ATTN_COLS = 2 * ATTN_WIDTH + 2 * KV_WIDTH
IN_COLS = RWKV_COLS + ATTN_COLS

kernel_name = "hymba_rwkv7_swa_sink_alibi_block"


def rmsnorm(x, gain):
    xf = x.astype(jnp.float32)
    y = xf * lax.rsqrt(jnp.mean(xf * xf, axis=-1, keepdims=True) + RMS_EPS)
    return (y * gain.astype(jnp.float32)).astype(x.dtype)


def token_shift_lerp(p, mu):
    prev = jnp.pad(p[:, :-1], ((0, 0), (1, 0), (0, 0)))
    return p + (prev - p) * mu


def rwkv7_scan(r, decay, k, v, kk, a):
    B, T, H, N = r.shape
    b = kk * a
    xs = tuple(jnp.swapaxes(t, 0, 1) for t in (r, decay, k, v, kk, b))

    def step(S, inp):
        r_t, w_t, k_t, v_t, kk_t, b_t = inp
        sa = -jnp.einsum('bhvk,bhk->bhv', S, kk_t)
        S = S * w_t[:, :, None, :] + sa[..., None] * b_t[:, :, None, :] + v_t[..., None] * k_t[:, :, None, :]
        y = jnp.einsum('bhvk,bhk->bhv', S, r_t)
        return S, y

    S0 = jnp.zeros((B, H, N, N), jnp.float32)
    _, ys = lax.scan(step, S0, xs)
    return jnp.swapaxes(ys, 0, 1)


def rwkv7_group(p, mu, w0, w_up, a0, a_up, k_k, k_a, r_k, lnx_gain, lnx_bias):
    B, T, _ = p.shape
    H, N = RWKV_HEADS, HEAD_DIM
    p = token_shift_lerp(p, mu)
    cuts = [RWKV_WIDTH, 2 * RWKV_WIDTH, 3 * RWKV_WIDTH, 3 * RWKV_WIDTH + DECAY_LORA,
            3 * RWKV_WIDTH + DECAY_LORA + ICLR_LORA]
    r, k, v, wd, ad, g = jnp.split(p, cuts, axis=-1)
    w_log = -jax.nn.softplus(-(w0 + jnp.tanh(wd) @ w_up)) - 0.5
    decay = jnp.exp(-jnp.exp(w_log))
    a = jax.nn.sigmoid(a0 + ad @ a_up)
    kk = (k * k_k).reshape(B, T, H, N)
    kk = kk / jnp.maximum(jnp.linalg.norm(kk, axis=-1, keepdims=True), 1e-12)
    k = k * (1.0 + (a - 1.0) * k_a)
    rh, kh, vh = (t.reshape(B, T, H, N) for t in (r, k, v))
    y = rwkv7_scan(rh, decay.reshape(B, T, H, N), kh, vh, kk, a.reshape(B, T, H, N))
    mean = jnp.mean(y, axis=-1, keepdims=True)
    var = jnp.mean(jnp.square(y - mean), axis=-1, keepdims=True)
    y = ((y - mean) * lax.rsqrt(var + LNX_EPS)).reshape(B, T, RWKV_WIDTH) * lnx_gain + lnx_bias
    bonus = jnp.sum(rh * kh * r_k, axis=-1, keepdims=True) * vh
    y = y + bonus.reshape(B, T, RWKV_WIDTH)
    return y * jax.nn.silu(g)


def alibi_slopes(n_heads):
    h = jnp.arange(1, n_heads + 1, dtype=jnp.float32)
    return jnp.exp2(-8.0 * h / n_heads)


def swa_sink_alibi_group(p, sinks):
    B, T, _ = p.shape
    nb = T // BLOCK
    cuts = [ATTN_WIDTH, ATTN_WIDTH + KV_WIDTH, ATTN_WIDTH + 2 * KV_WIDTH]
    q, k, v, g = jnp.split(p, cuts, axis=-1)
    qb = q.reshape(B, nb, BLOCK, ATTN_KV_HEADS, GQA_GROUP, HEAD_DIM)

    def band(t):
        tb = t.reshape(B, nb, BLOCK, ATTN_KV_HEADS, HEAD_DIM)
        prev = jnp.concatenate([jnp.zeros_like(tb[:, :1]), tb[:, :-1]], axis=1)
        return jnp.concatenate([prev, tb], axis=2)

    kw, vw = band(k), band(v)
    s = jnp.einsum('bnqhgd,bnkhd->bnhgqk', qb, kw) * (HEAD_DIM ** -0.5)
    qi = jnp.arange(BLOCK)[:, None]
    kj = jnp.arange(2 * BLOCK)[None, :]
    dist = BLOCK + qi - kj
    blk = jnp.arange(nb)[:, None, None]
    valid = (dist >= 0) & (dist < WINDOW) & ((blk - 1) * BLOCK + kj[None] >= 0)
    slopes = alibi_slopes(ATTN_Q_HEADS).reshape(ATTN_KV_HEADS, GQA_GROUP)
    s = s - slopes[:, :, None, None] * dist.astype(jnp.float32)
    s = jnp.where(valid[None, :, None, None], s, NEG_INF)
    sink = jnp.broadcast_to(sinks.reshape(ATTN_KV_HEADS, GQA_GROUP)[None, None, :, :, None, None],
                            s.shape[:-1] + (1,))
    prob = jax.nn.softmax(jnp.concatenate([s, sink], axis=-1), axis=-1)[..., :-1]
    o = jnp.einsum('bnhgqk,bnkhd->bnqhgd', prob, vw).reshape(B, T, ATTN_WIDTH)
    return o * jax.nn.silu(g)


def setup_inputs(seed: int = 0) -> dict:
    key = jax.random.key(seed)
    ks = jax.random.split(key, 20)
    f32 = jnp.float32
    L = DEPTH
    x = jax.random.normal(ks[0], (BATCH, SEQ, D_MODEL), f32)
    norm_gain = 1.0 + 0.05 * jax.random.normal(ks[1], (L, D_MODEL), f32)
    w_in = jax.random.normal(ks[2], (L, D_MODEL, IN_COLS), f32) * D_MODEL ** -0.5
    mu_rwkv = jax.random.uniform(ks[3], (L, RWKV_COLS), f32)
    w0 = jax.random.uniform(ks[4], (L, RWKV_WIDTH), f32, minval=-4.0, maxval=1.0)
    w_up = jax.random.normal(ks[5], (L, DECAY_LORA, RWKV_WIDTH), f32) * 0.5 * DECAY_LORA ** -0.5
    a0 = 0.5 * jax.random.normal(ks[6], (L, RWKV_WIDTH), f32)
    a_up = jax.random.normal(ks[7], (L, ICLR_LORA, RWKV_WIDTH), f32) * 0.5 * ICLR_LORA ** -0.5
    k_k = 0.85 + 0.05 * jax.random.normal(ks[8], (L, RWKV_WIDTH), f32)
    k_a = 1.0 + 0.05 * jax.random.normal(ks[9], (L, RWKV_WIDTH), f32)
    r_k = -0.04 + 0.02 * jax.random.normal(ks[10], (L, RWKV_HEADS, HEAD_DIM), f32)
    lnx_gain = 1.0 + 0.05 * jax.random.normal(ks[11], (L, RWKV_WIDTH), f32)
    lnx_bias = 0.01 * jax.random.normal(ks[12], (L, RWKV_WIDTH), f32)
    attn_sinks = 0.5 * jax.random.normal(ks[13], (L, ATTN_Q_HEADS), f32)
    w_out = jax.random.normal(ks[14], (L, D_MIX, D_MODEL), f32) * D_MIX ** -0.5
    final_gain = 1.0 + 0.05 * jax.random.normal(ks[15], (D_MODEL,), f32)
    return {"x": x, "norm_gain": norm_gain, "w_in": w_in, "mu_rwkv": mu_rwkv, "w0": w0,
            "w_up": w_up, "a0": a0, "a_up": a_up, "k_k": k_k, "k_a": k_a, "r_k": r_k,
            "lnx_gain": lnx_gain, "lnx_bias": lnx_bias, "attn_sinks": attn_sinks,
            "w_out": w_out, "final_gain": final_gain}


def reference(x, norm_gain, w_in, mu_rwkv, w0, w_up, a0, a_up, k_k, k_a, r_k,
              lnx_gain, lnx_bias, attn_sinks, w_out, final_gain):
    f32 = jnp.float32
    for l in range(DEPTH):
        h = rmsnorm(x, norm_gain[l])
        proj = (h @ w_in[l]).astype(f32)
        p_rwkv, p_attn = proj[..., :RWKV_COLS], proj[..., RWKV_COLS:]
        y_rwkv = rwkv7_group(p_rwkv, mu_rwkv[l].astype(f32), w0[l].astype(f32),
                             w_up[l].astype(f32), a0[l].astype(f32), a_up[l].astype(f32),
                             k_k[l].astype(f32), k_a[l].astype(f32), r_k[l].astype(f32),
                             lnx_gain[l].astype(f32), lnx_bias[l].astype(f32))
        y_attn = swa_sink_alibi_group(p_attn, attn_sinks[l].astype(f32))
        mix = jnp.concatenate([y_rwkv, y_attn], axis=-1).astype(x.dtype)
        x = x + mix @ w_out[l]
    return rmsnorm(x, final_gain)
```

```cpp
#include <hip/hip_runtime.h>
#include <hip/hip_cooperative_groups.h>
#include <cstdio>
#include <cstdint>
namespace cg = cooperative_groups;
namespace pg8 {
#define PG8_LAS __attribute__((address_space(3)))
typedef unsigned short bf16_t;
typedef short bf16x8 __attribute__((ext_vector_type(8)));
typedef float f32x4 __attribute__((ext_vector_type(4)));
typedef unsigned u32x4 __attribute__((ext_vector_type(4)));
constexpr int BM = 256, BK = 64, HALF = 128, HTB = HALF * BK * 2  , STAGE_BYTES = 8 * HTB, NXCD = 8, WGM = 8;

__host__ __device__ __forceinline__ int lds_byte(int r, int c) { const int st = (r >> 4) * 2 + (c >> 5), rr = r & 15, cc = c & 31, ob = rr * 64 + cc * 2; return st * 1024 + (ob ^ (((ob >> 9) & 1) << 5)); }
__host__ __device__ __forceinline__ void stage_rc(int b, int& R, int& C) { const int st = b / 1024, sb = b % 1024, swz = sb ^ (((sb >> 9) & 1) << 5); R = (st >> 1) * 16 + swz / 64; C = (st & 1) * 32 + (swz % 64) / 2; }
__host__ __device__ __forceinline__ int perm32(int rho) { const int n = rho >> 4, i = rho & 15; return 8 * (i >> 2) + 4 * n + (i & 3); }

struct Unit { int pm, pn; };
struct Gemm { const bf16_t* A; const bf16_t* Bt; int M, N, K; };

struct StaticOrder {
    int nM, nN, nwg, G, c;
    __host__ __device__ void init(int M, int N, int G_, int c_) { nM = M / BM; nN = N / BM; nwg = nM * nN; G = G_; c = c_; }
    __host__ __device__ bool next(int i, Unit& u) const {
        const long L = (long)i * G + c; if (L >= nwg) return false;
        int wgid = (int)L; { const int q = nwg / NXCD, r = nwg % NXCD, xcd = wgid % NXCD, off = wgid / NXCD; wgid = (xcd < r ? xcd * (q + 1) : r * (q + 1) + (xcd - r) * q) + off; }
        const int nig = WGM * nN, gid = wgid / nig, fm = gid * WGM, gsz = (nM - fm) < WGM ? (nM - fm) : WGM;
        u.pm = fm + ((wgid % nig) % gsz); u.pn = (wgid % nig) / gsz; return true;
    }
    __device__ __forceinline__ void a_ready(const Unit&) const {}
    __device__ __forceinline__ void done(const Unit&) const {}
};

__device__ __forceinline__ unsigned cvt_pk_bf16(float lo, float hi) { unsigned r; asm volatile("v_cvt_pk_bf16_f32 %0, %1, %2" : "=v"(r) : "v"(lo), "v"(hi)); return r; }
typedef float f32x2 __attribute__((ext_vector_type(2)));
__device__ __forceinline__ f32x2 gelu_pk(f32x2 v) {
    const f32x2 av = __builtin_elementwise_abs(v), d = av * 0.2316418882f + 1.0f;
    f32x2 t; t.x = __builtin_amdgcn_rcpf(d.x); t.y = __builtin_amdgcn_rcpf(d.y);
    f32x2 q = t * 0.5307027145f + (-0.7265760135f); q = q * t + 0.7107068705f; q = q * t + (-0.142248368f); q = q * t + 0.127414796f; q = q * t;
    const f32x2 s = (v * v) * (-0.72134752044f);
    f32x2 e; e.x = __builtin_amdgcn_exp2f(s.x); e.y = __builtin_amdgcn_exp2f(s.y);
    const f32x2 m = v * (q * e), r = v - m;
    f32x2 o; o.x = v.x < 0.f ? m.x : r.x; o.y = v.y < 0.f ? m.y : r.y; return o;
}

template <int ACT  > struct EpiBf16 {
    static constexpr bool PERM = true, AFTER_DRAIN = false; static_assert(ACT == 0 || ACT == 1, "EpiBf16: ACT is 0 (none) or 1 (gelu_pk)");
    bf16_t* O; int ldc; const float* bias; int split_cols; size_t split_stride; float scale0;
    __device__ __forceinline__ void operator()(const f32x4 (&acc)[2][2][4][2], const Unit& u, int wr, int wc, int fr, int fq) const {
        const int row0 = u.pm * BM + wr * 64 + fr; int colt = u.pn * BM; bf16_t* base = O;
        float sc = 1.f; if (split_cols) { const int t = colt / split_cols; base += (size_t)t * split_stride; colt -= t * split_cols; if (t == 0) sc = scale0; }
        const int col0 = colt + wc * 32 + 8 * fq, bcol0 = u.pn * BM + wc * 32 + 8 * fq;
        f32x4 bv[2][2];
#pragma unroll
        for (int bj = 0; bj < 2; ++bj)
#pragma unroll
            for (int n = 0; n < 2; ++n) bv[bj][n] = bias ? *(const f32x4*)(bias + bcol0 + bj * HALF + 4 * n) : (f32x4){0.f, 0.f, 0.f, 0.f};
#pragma unroll
        for (int ai = 0; ai < 2; ++ai)
#pragma unroll
            for (int m = 0; m < 4; ++m) { bf16_t* rowp = base + (size_t)(row0 + ai * HALF + m * 16) * ldc + col0;
#pragma unroll
                for (int bj = 0; bj < 2; ++bj) { f32x4 v0 = acc[ai][bj][m][0] + bv[bj][0], v1 = acc[ai][bj][m][1] + bv[bj][1];
                    if (ACT == 1) { f32x2 a = gelu_pk((f32x2){v0[0], v0[1]}), b = gelu_pk((f32x2){v0[2], v0[3]}), c = gelu_pk((f32x2){v1[0], v1[1]}), d = gelu_pk((f32x2){v1[2], v1[3]});
                        v0 = (f32x4){a.x, a.y, b.x, b.y}; v1 = (f32x4){c.x, c.y, d.x, d.y}; }
                    v0 = v0 * sc; v1 = v1 * sc; u32x4 w; w.x = cvt_pk_bf16(v0[0], v0[1]); w.y = cvt_pk_bf16(v0[2], v0[3]); w.z = cvt_pk_bf16(v1[0], v1[1]); w.w = cvt_pk_bf16(v1[2], v1[3]);
                    *(u32x4*)(rowp + bj * HALF) = w; } }
    }
};
struct EpiResid {
    static constexpr bool PERM = false, AFTER_DRAIN = false;
    const float* x; float* out; float* sspart; int ldc;
    __device__ __forceinline__ void operator()(const f32x4 (&acc)[2][2][4][2], const Unit& u, int wr, int wc, int fr, int fq) const {
        const int row0 = u.pm * BM + wr * 64 + fr, col0 = u.pn * BM + wc * 32 + 4 * fq;
#pragma unroll
        for (int ai = 0; ai < 2; ++ai)
#pragma unroll
            for (int m = 0; m < 4; ++m) {
                const int row = row0 + ai * HALF + m * 16; float ss = 0.f;
#pragma unroll
                for (int bj = 0; bj < 2; ++bj)
#pragma unroll
                    for (int n = 0; n < 2; ++n) {
                        const size_t off = (size_t)row * ldc + col0 + bj * HALF + n * 16;
                        const f32x4 xv = *(const f32x4*)(x + off); const f32x4 v = acc[ai][bj][m][n] + xv;
                        *(f32x4*)(out + off) = v; ss += (v[0] * v[0] + v[1] * v[1]) + (v[2] * v[2] + v[3] * v[3]);
                    }
                ss += __shfl_xor(ss, 16); ss += __shfl_xor(ss, 32);
                if (fq == 0) sspart[(size_t)row * 32 + u.pn * 4 + wc] = ss;
            }
    }
};

template <class Epi, class Sched, bool ALIGN_EPI = false, bool SP2 = false>
__device__ __forceinline__ void gemm_phase(PG8_LAS unsigned char* lds, const Gemm g, const Sched& S, const Epi& E) {
    const int tid = threadIdx.x, wid = __builtin_amdgcn_readfirstlane(tid >> 6), lane = tid & 63, wr = wid >> 2, wc = wid & 3, fr = lane & 15, fq = lane >> 4;
    const int K = g.K, nt = K / BK;
    unsigned voffA[2], voffB[2];
#pragma unroll
    for (int i = 0; i < 2; ++i) { int R, C; stage_rc(tid * 16 + i * 8192, R, C); const int Rb = Epi::PERM ? ((R & ~31) + perm32(R & 31)) : R;
        voffA[i] = (unsigned)(R * K + C) * 2u; voffB[i] = (unsigned)(Rb * K + C) * 2u; }
    const size_t kstep = (size_t)(BK * 2);
    const size_t hstep = (size_t)HALF * K * 2;
    const size_t tstep = 2 * hstep;
    const unsigned ldsw = (unsigned)wid * 1024u;
    const int aoff = lds_byte(wr * 64 + fr, fq * 8), boff = lds_byte(wc * 32 + fr, fq * 8);
#define PG8_SA(b, h) (((b) * 2 + (h)) * HTB)
#define PG8_SB(b, h) ((4 + (b) * 2 + (h)) * HTB)
#define PG8_STAGE(bufoff, gbase, voff) do { _Pragma("unroll") for (int _i = 0; _i < 2; ++_i) \
        __builtin_amdgcn_global_load_lds((const unsigned*)((const char*)(gbase) + (voff)[_i]), (PG8_LAS unsigned*)(lds + (bufoff) + ldsw + _i * 8192), 16, 0, 0); } while (0)
#define PG8_LDA(dst, b, h) do { _Pragma("unroll") for (int m = 0; m < 4; ++m) _Pragma("unroll") for (int k = 0; k < 2; ++k) dst[m][k] = *(const PG8_LAS bf16x8*)(lds + PG8_SA(b, h) + aoff + m * 2048 + k * 1024); } while (0)
#define PG8_LDB(dst, b, h) do { _Pragma("unroll") for (int n = 0; n < 2; ++n) _Pragma("unroll") for (int k = 0; k < 2; ++k) dst[n][k] = *(const PG8_LAS bf16x8*)(lds + PG8_SB(b, h) + boff + n * 2048 + k * 1024); } while (0)
#define PG8_MMA(ai, bj, At, Bt) do { __builtin_amdgcn_s_setprio(1); _Pragma("unroll") for (int m = 0; m < 4; ++m) _Pragma("unroll") for (int n = 0; n < 2; ++n) _Pragma("unroll") for (int k = 0; k < 2; ++k) \
        acc[ai][bj][m][n] = __builtin_amdgcn_mfma_f32_16x16x32_bf16(Bt[n][k], At[m][k], acc[ai][bj][m][n], 0, 0, 0); __builtin_amdgcn_s_setprio(0); } while (0)
#define PG8_WAIT_V(n) asm volatile("s_waitcnt vmcnt(" #n ")" ::: "memory")
#define PG8_WAIT_L(n) asm volatile("s_waitcnt lgkmcnt(" #n ")" ::: "memory")
#define PG8_BAR __builtin_amdgcn_s_barrier()
#define PG8_SCHED __builtin_amdgcn_sched_barrier(0)
    Unit cur, nxt; int ui = 0;
    if (!S.next(0, cur)) return;
    f32x4 acc[2][2][4][2];
#pragma unroll
    for (int a = 0; a < 2; ++a)
#pragma unroll
        for (int b = 0; b < 2; ++b)
#pragma unroll
            for (int m = 0; m < 4; ++m)
#pragma unroll
                for (int n = 0; n < 2; ++n) acc[a][b][m][n] = (f32x4){0.f, 0.f, 0.f, 0.f};
    bf16x8 At[4][2], B0[2][2], B1[2][2];
    const char* cA = (const char*)g.A + (size_t)cur.pm * tstep; const char* cB = (const char*)g.Bt + (size_t)cur.pn * tstep;
    S.a_ready(cur);
    if constexpr (SP2) {
        PG8_STAGE(PG8_SB(0, 0), cB, voffB); PG8_STAGE(PG8_SB(0, 1), cB + hstep, voffB); PG8_STAGE(PG8_SA(0, 0), cA, voffA); PG8_STAGE(PG8_SA(0, 1), cA + hstep, voffA);
        if (wr == 1) PG8_BAR;
        PG8_WAIT_V(2); PG8_BAR;
        PG8_STAGE(PG8_SB(1, 0), cB + kstep, voffB); PG8_STAGE(PG8_SA(1, 0), cA + kstep, voffA); PG8_STAGE(PG8_SB(1, 1), cB + hstep + kstep, voffB);
        PG8_WAIT_V(6); PG8_BAR;
    } else {
        PG8_STAGE(PG8_SB(0, 0), cB, voffB); PG8_STAGE(PG8_SA(0, 0), cA, voffA); PG8_STAGE(PG8_SB(0, 1), cB + hstep, voffB); PG8_STAGE(PG8_SA(0, 1), cA + hstep, voffA);
        if (wr == 1) PG8_BAR;
        PG8_WAIT_V(4); PG8_BAR;
        PG8_STAGE(PG8_SB(1, 0), cB + kstep, voffB); PG8_STAGE(PG8_SA(1, 0), cA + kstep, voffA); PG8_STAGE(PG8_SB(1, 1), cB + hstep + kstep, voffB);
        PG8_WAIT_V(6); PG8_BAR;
    }
    for (;;) {
        const bool has_next = S.next(ui + 1, nxt);
        const char* nA = has_next ? (const char*)g.A + (size_t)nxt.pm * tstep : cA; const char* nB = has_next ? (const char*)g.Bt + (size_t)nxt.pn * tstep : cB;
        for (int t = 0; t < nt; t += 2) {
            const bool last = (t == nt - 2);
            const char* a1 = cA + (size_t)(t + 1) * kstep;
            const char* a2 = last ? nA : cA + (size_t)(t + 2) * kstep; const char* b2 = last ? nB : cB + (size_t)(t + 2) * kstep;
            const char* a3 = a2 + kstep; const char* b3 = b2 + kstep;
            if (last && has_next) S.a_ready(nxt);
            if constexpr (SP2) {
            PG8_LDB(B0, 0, 0); PG8_LDB(B1, 0, 1); PG8_SCHED; PG8_LDA(At, 0, 0); PG8_STAGE(PG8_SA(1, 1), a1 + hstep, voffA);
            PG8_WAIT_V(8); PG8_WAIT_L(0); PG8_BAR; PG8_MMA(0, 0, At, B0); PG8_MMA(0, 1, At, B1); PG8_BAR; PG8_SCHED;
            PG8_LDA(At, 0, 1); PG8_STAGE(PG8_SB(0, 0), b2, voffB); PG8_STAGE(PG8_SB(0, 1), b2 + hstep, voffB); PG8_STAGE(PG8_SA(0, 0), a2, voffA);
            PG8_WAIT_V(8); PG8_WAIT_L(0); PG8_BAR; PG8_MMA(1, 0, At, B0); PG8_MMA(1, 1, At, B1); PG8_BAR; PG8_SCHED;
            PG8_LDB(B0, 1, 0); PG8_LDB(B1, 1, 1); PG8_SCHED; PG8_LDA(At, 1, 0); PG8_STAGE(PG8_SA(0, 1), a2 + hstep, voffA);
            PG8_WAIT_V(8); PG8_WAIT_L(0); PG8_BAR; PG8_MMA(0, 0, At, B0); PG8_MMA(0, 1, At, B1); PG8_BAR; PG8_SCHED;
            PG8_LDA(At, 1, 1); PG8_STAGE(PG8_SB(1, 0), b3, voffB); PG8_STAGE(PG8_SB(1, 1), b3 + hstep, voffB); PG8_STAGE(PG8_SA(1, 0), a3, voffA);
            PG8_WAIT_V(8); PG8_WAIT_L(0); PG8_BAR; PG8_MMA(1, 0, At, B0); PG8_MMA(1, 1, At, B1); PG8_BAR; PG8_SCHED;
            } else {
            PG8_LDB(B0, 0, 0); PG8_SCHED; PG8_LDA(At, 0, 0); PG8_STAGE(PG8_SA(1, 1), a1 + hstep, voffA);
            PG8_WAIT_L(8); PG8_BAR; PG8_WAIT_L(0); PG8_MMA(0, 0, At, B0); PG8_BAR; PG8_SCHED;
            PG8_LDB(B1, 0, 1); PG8_STAGE(PG8_SB(0, 0), b2, voffB);
            PG8_BAR; PG8_WAIT_L(0); PG8_MMA(0, 1, At, B1); PG8_BAR;
            PG8_LDA(At, 0, 1); PG8_STAGE(PG8_SA(0, 0), a2, voffA);
            PG8_BAR; PG8_WAIT_L(0); PG8_MMA(1, 0, At, B0); PG8_BAR; PG8_SCHED;
            PG8_STAGE(PG8_SB(0, 1), b2 + hstep, voffB);
            PG8_WAIT_V(6); PG8_BAR; PG8_MMA(1, 1, At, B1); PG8_BAR;
            PG8_LDB(B0, 1, 0); PG8_SCHED; PG8_LDA(At, 1, 0); PG8_STAGE(PG8_SA(0, 1), a2 + hstep, voffA);
            PG8_WAIT_L(8); PG8_BAR; PG8_WAIT_L(0); PG8_MMA(0, 0, At, B0); PG8_BAR; PG8_SCHED;
            PG8_LDB(B1, 1, 1); PG8_STAGE(PG8_SB(1, 0), b3, voffB);
            PG8_BAR; PG8_WAIT_L(0); PG8_MMA(0, 1, At, B1); PG8_BAR;
            PG8_LDA(At, 1, 1); PG8_STAGE(PG8_SA(1, 0), a3, voffA);
            PG8_BAR; PG8_WAIT_L(0); PG8_MMA(1, 0, At, B0); PG8_BAR; PG8_SCHED;
            PG8_STAGE(PG8_SB(1, 1), b3 + hstep, voffB);
            PG8_WAIT_V(6); PG8_BAR; PG8_MMA(1, 1, At, B1); PG8_BAR;
            }
        }
        if constexpr (ALIGN_EPI) { if (wr == 0) PG8_BAR; }
        if constexpr (!Epi::AFTER_DRAIN) { E(acc, cur, wr, wc, fr, fq); S.done(cur); }
        if (!has_next) break;
#pragma unroll
        for (int a = 0; a < 2; ++a)
#pragma unroll
            for (int b = 0; b < 2; ++b)
#pragma unroll
                for (int m = 0; m < 4; ++m)
#pragma unroll
                    for (int n = 0; n < 2; ++n) acc[a][b][m][n] = (f32x4){0.f, 0.f, 0.f, 0.f};
        cur = nxt; cA = nA; cB = nB; ++ui;
        if constexpr (ALIGN_EPI) { if (wr == 1) PG8_BAR; }
    }
    PG8_WAIT_V(0);
    if constexpr (!ALIGN_EPI) { if (wr == 0) PG8_BAR; }
    PG8_BAR;
    if constexpr (Epi::AFTER_DRAIN) { E.fused(acc, cur, wr, wc, fr, fq, lds, wid, lane); S.done(cur); }
#undef PG8_SA
#undef PG8_SB
#undef PG8_STAGE
#undef PG8_LDA
#undef PG8_LDB
#undef PG8_MMA
#undef PG8_WAIT_V
#undef PG8_WAIT_L
#undef PG8_BAR
#undef PG8_SCHED
}
}
constexpr int T = 8192, D = 2048, NIN = 6528, NINP = 6656, RW = 1024, NH = 16, HD = 64, CH = 64, NCH = T / CH;
constexpr int C_R = 0, C_K = 1024, C_V = 2048, C_WD = 3072, C_AD = 3136, C_G = 3200, C_AQ = 4224, C_AK = 5248, C_AV = 5376, C_AG = 5504;
constexpr float RMS_EPS = 1e-5f, LNX_EPS = 64e-5f;
constexpr int NWAVES = 8, NTHR = 512;
constexpr size_t MiB = 1u << 20;
constexpr size_t WS_WTIN = 1 * MiB;
constexpr size_t WS_XN = 27 * MiB;
constexpr size_t WS_WTOUT = 59 * MiB;
constexpr size_t WS_UPT = 67 * MiB;
constexpr size_t WS_SSP = 68 * MiB;
constexpr size_t WS_PROJ = 70 * MiB;
constexpr size_t WS_SCR = 174 * MiB;
constexpr size_t WS_MIX = 1 * MiB;
constexpr int LDS_BYTES = 147456;

#define GAS __attribute__((address_space(1)))
#define LAS __attribute__((address_space(3)))
typedef unsigned short bf16;
typedef unsigned v4u __attribute__((ext_vector_type(4)));
typedef unsigned v2u __attribute__((ext_vector_type(2)));
typedef float f32x4 __attribute__((ext_vector_type(4)));
typedef float f32x16 __attribute__((ext_vector_type(16)));
typedef short bf16x8 __attribute__((ext_vector_type(8)));
typedef __bf16 bf16x2_t __attribute__((ext_vector_type(2)));
__device__ __forceinline__ unsigned pk2(float a, float b) { bf16x2_t v; v[0] = (__bf16)a; v[1] = (__bf16)b; return __builtin_bit_cast(unsigned, v); }
__device__ __forceinline__ float bflo(unsigned u) { return __uint_as_float(u << 16); }
__device__ __forceinline__ float bfhi(unsigned u) { return __uint_as_float(u & 0xffff0000u); }
__device__ __forceinline__ void unpack8(const v4u& p, float (&f)[8]) { f[0] = bflo(p.x); f[1] = bfhi(p.x); f[2] = bflo(p.y); f[3] = bfhi(p.y); f[4] = bflo(p.z); f[5] = bfhi(p.z); f[6] = bflo(p.w); f[7] = bfhi(p.w); }
__device__ __forceinline__ v4u pack8(const float (&f)[8]) { v4u o; o.x = pk2(f[0], f[1]); o.y = pk2(f[2], f[3]); o.z = pk2(f[4], f[5]); o.w = pk2(f[6], f[7]); return o; }
__device__ __forceinline__ float wave_sum(float v) {
#pragma unroll
    for (int o = 1; o < 64; o <<= 1) v += __shfl_xor(v, o);
    return v;
}
__device__ __forceinline__ float sum8(float v) { v += __shfl_xor(v, 1); v += __shfl_xor(v, 2); v += __shfl_xor(v, 4); return v; }
__device__ __forceinline__ float sigmoidf_(float x) { return 1.f / (1.f + __expf(-x)); }
__device__ __forceinline__ float siluf_(float x) { return x / (1.f + __expf(-x)); }

struct Args { const float* in[16]; float* out; unsigned char* ws; int ph_lo, ph_hi; };

__device__ __forceinline__ void p0_transpose_item(const float* W, int K, int N, bf16* WT, LAS float* scr, int item, int lane) {
    const int nblk = N / 32, kb = item / nblk, nb = item % nblk, k0 = 64 * kb, n0 = 32 * nb;
#pragma unroll 8
    for (int i = 0; i < 32; ++i) { const int kk = 2 * i + (lane >> 5); scr[kk * 33 + (lane & 31)] = W[(size_t)(k0 + kk) * N + n0 + (lane & 31)]; }
    asm volatile("s_waitcnt lgkmcnt(0)" ::: "memory");
    const int c = lane & 7;
#pragma unroll
    for (int j = 0; j < 4; ++j) { const int n = (lane >> 3) + 8 * j; const LAS float* s = scr + (8 * c) * 33 + n;
        v4u o; o.x = pk2(s[0 * 33], s[1 * 33]); o.y = pk2(s[2 * 33], s[3 * 33]); o.z = pk2(s[4 * 33], s[5 * 33]); o.w = pk2(s[6 * 33], s[7 * 33]);
        *(v4u*)(WT + (size_t)(n0 + n) * K + k0 + 8 * c) = o; }
    asm volatile("s_waitcnt lgkmcnt(0)" ::: "memory");
}
__device__ __forceinline__ void p0_prologue(const Args& a, LAS unsigned char* lds, int vcu, int G, int wave, int lane) {
    LAS float* scr = (LAS float*)(lds + wave * 16384);
    const int gw = vcu * NWAVES + wave, NGW = G * NWAVES;
    bf16* wtin = (bf16*)(a.ws + WS_WTIN); bf16* wtout = (bf16*)(a.ws + WS_WTOUT); bf16* upt = (bf16*)(a.ws + WS_UPT); bf16* aupt = upt + 65536;
    constexpr int I_IN = (D / 64) * (NIN / 32), I_OUT = (D / 64) * (D / 32), I_UP = RW / 32;
    constexpr int NITEMS = I_IN + I_OUT + 2 * I_UP;
    for (int it = gw; it < NITEMS; it += NGW) {
        int r = it;
        if (r < I_IN) { p0_transpose_item(a.in[2], D, NIN, wtin, scr, r, lane); continue; } r -= I_IN;
        if (r < I_OUT) { p0_transpose_item(a.in[14], D, D, wtout, scr, r, lane); continue; } r -= I_OUT;
        if (r < I_UP) { p0_transpose_item(a.in[5], 64, RW, upt, scr, r, lane); continue; } r -= I_UP;
        p0_transpose_item(a.in[7], 64, RW, aupt, scr, r, lane);
    }
    { v4u z = {0u, 0u, 0u, 0u}; v4u* p = (v4u*)(wtin + (size_t)NIN * D); const int n16 = (NINP - NIN) * D * 2 / 16;
      for (int i = gw * 64 + lane; i < n16; i += NGW * 64) p[i] = z; }
    const float* gain = a.in[1];
    for (int m = gw; m < T; m += NGW) {
        const f32x4* xr = (const f32x4*)(a.in[0] + (size_t)m * D) + lane; f32x4 v[8]; float s = 0.f;
#pragma unroll
        for (int j = 0; j < 8; ++j) { v[j] = xr[64 * j]; s += (v[j].x * v[j].x + v[j].y * v[j].y) + (v[j].z * v[j].z + v[j].w * v[j].w); }
        const float rstd = 1.f / sqrtf(wave_sum(s) * (1.f / D) + RMS_EPS);
        v2u* o8 = (v2u*)((bf16*)(a.ws + WS_XN) + (size_t)m * D) + lane;
#pragma unroll
        for (int j = 0; j < 8; ++j) { const f32x4 g = *((const f32x4*)gain + lane + 64 * j); v2u o; o.x = pk2(v[j].x * rstd * g.x, v[j].y * rstd * g.y); o.y = pk2(v[j].z * rstd * g.z, v[j].w * rstd * g.w); o8[64 * j] = o; }
    }
}
__device__ __forceinline__ void final_norm(const Args& a, int vcu, int G, int wave, int lane) {
    const int gw = vcu * NWAVES + wave, NGW = G * NWAVES; const float* ssp = (const float*)(a.ws + WS_SSP); const float* gain = a.in[15];
    for (int m = gw; m < T; m += NGW) {
        float s = (lane < 32) ? ssp[(size_t)m * 32 + lane] : 0.f; s = wave_sum(s);
        const float rstd = 1.f / sqrtf(s * (1.f / D) + RMS_EPS);
        f32x4* xr = (f32x4*)(a.out + (size_t)m * D) + lane;
#pragma unroll
        for (int j = 0; j < 8; ++j) { f32x4 v = xr[64 * j]; const f32x4 g = *((const f32x4*)gain + lane + 64 * j); v.x *= rstd * g.x; v.y *= rstd * g.y; v.z *= rstd * g.z; v.w *= rstd * g.w; xr[64 * j] = v; }
    }
}
#define MFMA32(a_, b_, c_) __builtin_amdgcn_mfma_f32_32x32x16_bf16((a_), (b_), (c_), 0, 0, 0)
#define MFMA16(a_, b_, c_) __builtin_amdgcn_mfma_f32_16x16x32_bf16((a_), (b_), (c_), 0, 0, 0)
__device__ __forceinline__ v4u ldg16(const bf16* p) { return *(const v4u*)p; }
__device__ __forceinline__ void load_shift8(const bf16* proj, int row, int col, const float* mu, float (&o)[8]) {
    const v4u p = ldg16(proj + (size_t)row * NINP + col); v4u q = {0u, 0u, 0u, 0u};
    if (row > 0) q = ldg16(proj + (size_t)(row - 1) * NINP + col);
    float pf[8], qf[8]; unpack8(p, pf); unpack8(q, qf);
    const f32x4 m0 = *(const f32x4*)(mu + col), m1 = *(const f32x4*)(mu + col + 4);
    const float mf[8] = {m0.x, m0.y, m0.z, m0.w, m1.x, m1.y, m1.z, m1.w};
#pragma unroll
    for (int j = 0; j < 8; ++j) o[j] = pf[j] + (qf[j] - pf[j]) * mf[j];
}
__device__ __forceinline__ void ld8f(const float* p, float (&o)[8]) { const f32x4 a = *(const f32x4*)p, b = *(const f32x4*)(p + 4); o[0] = a.x; o[1] = a.y; o[2] = a.z; o[3] = a.w; o[4] = b.x; o[5] = b.y; o[6] = b.z; o[7] = b.w; }

constexpr int VP = 168;
__device__ __forceinline__ void attn_unit(const Args& a, LAS unsigned char* lds, int unit, int tid, int wave, int lane) {
    const bf16* proj = (const bf16*)(a.ws + WS_PROJ); bf16* mix = (bf16*)(a.ws + WS_MIX);
    const int qb = unit >> 1, kvh = unit & 1, q0 = qb * 32, kbase = q0 - 128, hq = kvh * 8 + wave;
    LAS bf16* VT = (LAS bf16*)lds;
    __syncthreads();
    for (int idx = tid; idx < 160 * 8; idx += NTHR) {
        const int key = idx >> 3, d8 = (idx & 7) * 8, tk = kbase + key;
        v4u p = {0u, 0u, 0u, 0u};
        if (tk >= 0) p = ldg16(proj + (size_t)tk * NINP + C_AV + kvh * 64 + d8);
        const unsigned w[4] = {p.x, p.y, p.z, p.w};
#pragma unroll
        for (int j = 0; j < 4; ++j) { VT[(d8 + 2 * j) * VP + key] = (bf16)(w[j] & 0xffffu); VT[(d8 + 2 * j + 1) * VP + key] = (bf16)(w[j] >> 16); }
    }
    __syncthreads();
    const int r = lane & 31, h = lane >> 5;
    bf16x8 bq[4];
    { const bf16* qrow = proj + (size_t)(q0 + r) * NINP + C_AQ + hq * 64 + 8 * h;
#pragma unroll
      for (int s = 0; s < 4; ++s) bq[s] = *(const bf16x8*)(qrow + 16 * s); }
    const float slope = exp2f(-0.5f * (float)(hq + 1)), sink = a.in[13][hq];
    f32x16 sc[5]; float mx = sink;
#pragma unroll
    for (int kt = 0; kt < 5; ++kt) {
        const int tkb = kbase + 32 * kt;
        f32x16 acc; for (int i = 0; i < 16; ++i) acc[i] = 0.f;
        if (tkb >= 0) {
            const bf16* krow = proj + (size_t)(tkb + r) * NINP + C_AK + kvh * 64 + 8 * h;
#pragma unroll
            for (int s = 0; s < 4; ++s) acc = MFMA32(*(const bf16x8*)(krow + 16 * s), bq[s], acc);
        }
#pragma unroll
        for (int i = 0; i < 16; ++i) {
            const int key = tkb + (i & 3) + 8 * (i >> 2) + 4 * h, dist = (q0 + r) - key;
            const bool valid = (tkb >= 0) && (dist >= 0) && (dist < 128);
            const float v = valid ? acc[i] * 0.125f - slope * (float)dist : -1e30f;
            sc[kt][i] = v; mx = fmaxf(mx, v);
        }
        __builtin_amdgcn_sched_barrier(0);
    }
    mx = fmaxf(mx, __shfl_xor(mx, 32));
    float sum = 0.f;
#pragma unroll
    for (int kt = 0; kt < 5; ++kt)
#pragma unroll
        for (int i = 0; i < 16; ++i) { const float p = __expf(sc[kt][i] - mx); sc[kt][i] = p; sum += p; }
    sum += __shfl_xor(sum, 32); sum += __expf(sink - mx);
    f32x16 o[2]; for (int i = 0; i < 16; ++i) { o[0][i] = 0.f; o[1][i] = 0.f; }
#pragma unroll
    for (int kt = 0; kt < 5; ++kt) {
        if (kbase + 32 * kt >= 0) {
#pragma unroll
            for (int s = 0; s < 2; ++s) {
                v4u pw; pw.x = pk2(sc[kt][8 * s + 0], sc[kt][8 * s + 1]); pw.y = pk2(sc[kt][8 * s + 2], sc[kt][8 * s + 3]); pw.z = pk2(sc[kt][8 * s + 4], sc[kt][8 * s + 5]); pw.w = pk2(sc[kt][8 * s + 6], sc[kt][8 * s + 7]);
                const bf16x8 pb = __builtin_bit_cast(bf16x8, pw);
#pragma unroll
                for (int dt = 0; dt < 2; ++dt) {
                    const LAS bf16* vp = VT + (32 * dt + r) * VP + 32 * kt + 16 * s + 4 * h;
                    const v2u lo = *(const LAS v2u*)vp, hi = *(const LAS v2u*)(vp + 8);
                    v4u vw; vw.x = lo.x; vw.y = lo.y; vw.z = hi.x; vw.w = hi.y;
                    o[dt] = MFMA32(__builtin_bit_cast(bf16x8, vw), pb, o[dt]);
                }
            }
        }
    }
    const float inv = 1.f / sum;
#pragma unroll
    for (int dt = 0; dt < 2; ++dt)
#pragma unroll
        for (int g4 = 0; g4 < 4; ++g4) {
            const int d0 = 32 * dt + 8 * g4 + 4 * h;
            const v2u gp = *(const v2u*)(proj + (size_t)(q0 + r) * NINP + C_AG + hq * 64 + d0);
            v2u w; w.x = pk2(o[dt][4 * g4 + 0] * inv * siluf_(bflo(gp.x)), o[dt][4 * g4 + 1] * inv * siluf_(bfhi(gp.x)));
            w.y = pk2(o[dt][4 * g4 + 2] * inv * siluf_(bflo(gp.y)), o[dt][4 * g4 + 3] * inv * siluf_(bfhi(gp.y)));
            *(v2u*)(mix + (size_t)(q0 + r) * D + RW + hq * 64 + d0) = w;
        }
}

struct Prep { float r[8], kp[8], v[8], g[8], w[8], lw[8], kk[8], b[8], bonus; };
__device__ __forceinline__ void rwkv_prep(const Args& a, LAS unsigned char* lds, int h, int t0, int tid, int wave, int lane, Prep& P) {
    const bf16* proj = (const bf16*)(a.ws + WS_PROJ); const bf16* upt = (const bf16*)(a.ws + WS_UPT); const bf16* aupt = upt + 65536;
    LAS bf16* TW = (LAS bf16*)lds; LAS bf16* ADm = TW + 64 * 72; LAS float* Z = (LAS float*)(lds + 18432); LAS float* AP = Z + 64 * 68;
    const int t = tid >> 3, c8 = (tid & 7) * 8, ch = h * 64 + c8, row = t0 + t;
    const float* mu = a.in[3];
    { float x[8]; load_shift8(proj, row, C_WD + c8, mu, x);
#pragma unroll
      for (int j = 0; j < 8; ++j) x[j] = tanhf(x[j]);
      *(LAS v4u*)(TW + t * 72 + c8) = pack8(x);
      load_shift8(proj, row, C_AD + c8, mu, x); *(LAS v4u*)(ADm + t * 72 + c8) = pack8(x); }
    __syncthreads();
    { const int rt = wave & 3, cp = (wave >> 2) * 2, fr = lane & 15, fq = lane >> 4;
      bf16x8 aT[2], aA[2];
#pragma unroll
      for (int s = 0; s < 2; ++s) { aT[s] = *(const LAS bf16x8*)(TW + (16 * rt + fr) * 72 + 32 * s + 8 * fq); aA[s] = *(const LAS bf16x8*)(ADm + (16 * rt + fr) * 72 + 32 * s + 8 * fq); }
#pragma unroll
      for (int ci = 0; ci < 2; ++ci) { const int ct = cp + ci; f32x4 z = {0.f, 0.f, 0.f, 0.f}, ap = {0.f, 0.f, 0.f, 0.f};
#pragma unroll
          for (int s = 0; s < 2; ++s) { const size_t bo = (size_t)(h * 64 + 16 * ct + fr) * 64 + 32 * s + 8 * fq;
              z = MFMA16(aT[s], *(const bf16x8*)(upt + bo), z); ap = MFMA16(aA[s], *(const bf16x8*)(aupt + bo), ap); }
#pragma unroll
          for (int j = 0; j < 4; ++j) { Z[(16 * rt + 4 * fq + j) * 68 + 16 * ct + fr] = z[j]; AP[(16 * rt + 4 * fq + j) * 68 + 16 * ct + fr] = ap[j]; } } }
    __syncthreads();
    float zz[8], aa[8], kr[8], c0[8], c1[8];
#pragma unroll
    for (int j = 0; j < 8; ++j) { zz[j] = Z[t * 68 + c8 + j]; aa[j] = AP[t * 68 + c8 + j]; }
    load_shift8(proj, row, C_R + ch, mu, P.r); load_shift8(proj, row, C_K + ch, mu, kr); load_shift8(proj, row, C_V + ch, mu, P.v); load_shift8(proj, row, C_G + ch, mu, P.g);
    ld8f(a.in[4] + ch, c0); ld8f(a.in[6] + ch, c1);
#pragma unroll
    for (int j = 0; j < 8; ++j) { const float z = c0[j] + zz[j]; const float sp = fmaxf(-z, 0.f) + log1pf(__expf(-fabsf(z))); const float wl = -sp - 0.5f; P.lw[j] = -__expf(wl); P.w[j] = __expf(P.lw[j]); aa[j] = sigmoidf_(c1[j] + aa[j]); }
    ld8f(a.in[8] + ch, c0); ld8f(a.in[9] + ch, c1);
    float ss = 0.f;
#pragma unroll
    for (int j = 0; j < 8; ++j) { P.kk[j] = kr[j] * c0[j]; ss += P.kk[j] * P.kk[j]; P.kp[j] = kr[j] * (1.f + (aa[j] - 1.f) * c1[j]); }
    ss = sum8(ss); const float rn = 1.f / fmaxf(sqrtf(ss), 1e-12f);
    ld8f(a.in[10] + ch, c0);
    float bs = 0.f;
#pragma unroll
    for (int j = 0; j < 8; ++j) { P.kk[j] *= rn; P.b[j] = P.kk[j] * aa[j]; bs += P.r[j] * P.kp[j] * c0[j]; }
    P.bonus = sum8(bs);
}
__device__ __forceinline__ void rwkv_out8(const Args& a, const float (&y)[8], const float (&v)[8], const float (&g)[8], float bonus, int row, int ch) {
    bf16* mix = (bf16*)(a.ws + WS_MIX);
    float s = 0.f;
#pragma unroll
    for (int j = 0; j < 8; ++j) s += y[j];
    const float mean = sum8(s) * (1.f / 64.f); float q = 0.f;
#pragma unroll
    for (int j = 0; j < 8; ++j) { const float d = y[j] - mean; q += d * d; }
    const float rstd = 1.f / sqrtf(sum8(q) * (1.f / 64.f) + LNX_EPS);
    float lg[8], lb[8], o[8]; ld8f(a.in[11] + ch, lg); ld8f(a.in[12] + ch, lb);
#pragma unroll
    for (int j = 0; j < 8; ++j) { const float yn = (y[j] - mean) * rstd * lg[j] + lb[j] + bonus * v[j]; o[j] = yn * siluf_(g[j]); }
    *(v4u*)(mix + (size_t)row * D + ch) = pack8(o);
}
__device__ __forceinline__ void rwkv_seq_head(const Args& a, LAS unsigned char* lds, int h, int tid, int wave, int lane) {
    LAS float* SR = (LAS float*)lds; LAS float* SW = SR + 4096; LAS float* SK = SW + 4096; LAS float* SKK = SK + 4096; LAS float* SB = SKK + 4096; LAS float* SV = SB + 4096; LAS float* SY = SV + 4096;
    const int t = tid >> 3, c8 = (tid & 7) * 8, ch = h * 64 + c8;
    float S[64];
#pragma unroll
    for (int k = 0; k < 64; ++k) S[k] = 0.f;
    for (int c = 0; c < NCH; ++c) {
        const int t0 = c * CH; Prep P;
        rwkv_prep(a, lds, h, t0, tid, wave, lane, P);
        __syncthreads();
#pragma unroll
        for (int j = 0; j < 8; ++j) { const int o = t * 64 + c8 + j; SR[o] = P.r[j]; SW[o] = P.w[j]; SK[o] = P.kp[j]; SKK[o] = P.kk[j]; SB[o] = P.b[j]; SV[o] = P.v[j]; }
        __syncthreads();
        if (wave == 0) {
            for (int tt = 0; tt < CH; ++tt) {
                float s0 = 0.f, s1 = 0.f, s2 = 0.f, s3 = 0.f;
#pragma unroll
                for (int k4 = 0; k4 < 16; ++k4) { const f32x4 q = *(const LAS f32x4*)(SKK + tt * 64 + 4 * k4); s0 += S[4 * k4] * q.x; s1 += S[4 * k4 + 1] * q.y; s2 += S[4 * k4 + 2] * q.z; s3 += S[4 * k4 + 3] * q.w; }
                const float sa = -((s0 + s1) + (s2 + s3)); const float vv = SV[tt * 64 + lane];
                float y0 = 0.f, y1 = 0.f, y2 = 0.f, y3 = 0.f;
#pragma unroll
                for (int k4 = 0; k4 < 16; ++k4) {
                    const f32x4 w = *(const LAS f32x4*)(SW + tt * 64 + 4 * k4), b = *(const LAS f32x4*)(SB + tt * 64 + 4 * k4), kq = *(const LAS f32x4*)(SK + tt * 64 + 4 * k4), rr = *(const LAS f32x4*)(SR + tt * 64 + 4 * k4);
                    S[4 * k4] = S[4 * k4] * w.x + sa * b.x + vv * kq.x; y0 += S[4 * k4] * rr.x;
                    S[4 * k4 + 1] = S[4 * k4 + 1] * w.y + sa * b.y + vv * kq.y; y1 += S[4 * k4 + 1] * rr.y;
                    S[4 * k4 + 2] = S[4 * k4 + 2] * w.z + sa * b.z + vv * kq.z; y2 += S[4 * k4 + 2] * rr.z;
                    S[4 * k4 + 3] = S[4 * k4 + 3] * w.w + sa * b.w + vv * kq.w; y3 += S[4 * k4 + 3] * rr.w;
                }
                SY[tt * 64 + lane] = (y0 + y1) + (y2 + y3);
            }
        }
        __syncthreads();
        float y[8];
#pragma unroll
        for (int j = 0; j < 8; ++j) y[j] = SY[t * 64 + c8 + j];
        rwkv_out8(a, y, P.v, P.g, P.bonus, t0 + t, ch);
    }
}
#ifndef ONE_LAUNCH
#define ONE_LAUNCH 0
#endif
constexpr int NPHASE = 5;
__global__ void __launch_bounds__(NTHR, 2) mega(Args a) {
    extern __shared__ __attribute__((aligned(16))) unsigned char lds_[];
    LAS unsigned char* lds = (LAS unsigned char*)lds_;
    const int tid = threadIdx.x, lane = tid & 63, wave = __builtin_amdgcn_readfirstlane(tid >> 6);
    const int G = gridDim.x, bx = blockIdx.x, vcu = (G % 8 == 0) ? (bx % 8) * (G / 8) + bx / 8 : bx;
    cg::grid_group grid = cg::this_grid();
#define IN(k) (a.ph_lo <= (k) && (k) < a.ph_hi)
#define SEAM(k) do { if (IN(k) && IN((k) + 1)) grid.sync(); } while (0)
    if (IN(0)) { p0_prologue(a, lds, vcu, G, wave, lane); }
    SEAM(0);
    if (IN(1)) {
        pg8::Gemm g{(const pg8::bf16_t*)(a.ws + WS_XN), (const pg8::bf16_t*)(a.ws + WS_WTIN), T, NINP, D}; pg8::StaticOrder S; S.init(T, NINP, G, bx);
        pg8::EpiBf16<0> E{(pg8::bf16_t*)(a.ws + WS_PROJ), NINP, nullptr, 0, 0, 1.f};
        pg8::gemm_phase<pg8::EpiBf16<0>, pg8::StaticOrder, true, true>(lds, g, S, E);
    }
    SEAM(1);
    if (IN(2)) {
        if (bx < NH) rwkv_seq_head(a, lds, bx, tid, wave, lane);
        else for (int u = bx - NH; u < 512; u += G - NH) attn_unit(a, lds, u, tid, wave, lane);
    }
    SEAM(2);
    if (IN(3)) {
        pg8::Gemm g{(const pg8::bf16_t*)(a.ws + WS_MIX), (const pg8::bf16_t*)(a.ws + WS_WTOUT), T, D, D}; pg8::StaticOrder S; S.init(T, D, G, bx);
        pg8::EpiResid E{a.in[0], a.out, (float*)(a.ws + WS_SSP), D};
        pg8::gemm_phase<pg8::EpiResid, pg8::StaticOrder, true, true>(lds, g, S, E);
    }
    SEAM(3);
    if (IN(4)) final_norm(a, vcu, G, wave, lane);
#undef IN
#undef SEAM
}

extern "C" void kernel_launch(void* const* d_in, const int* in_sizes, int n_in, void* d_out, int out_size, void* d_ws, size_t ws_size, hipStream_t stream) {
    static int grid = 0;
    if (grid == 0) {
        int dev = 0, cus = 0;
        if (hipGetDevice(&dev) != hipSuccess || hipDeviceGetAttribute(&cus, hipDeviceAttributeMultiprocessorCount, dev) != hipSuccess) { fprintf(stderr, "kernel_launch: device query failed\n"); grid = -1; return; }
        if (hipFuncSetAttribute((const void*)mega, hipFuncAttributeMaxDynamicSharedMemorySize, LDS_BYTES) != hipSuccess) { fprintf(stderr, "kernel_launch: hipFuncSetAttribute failed\n"); grid = -1; return; }
        (void)hipGetLastError();
        grid = cus;
    }
    if (grid < 0) return;
    Args a{};
    for (int i = 0; i < 16; ++i) a.in[i] = (const float*)d_in[i];
    a.out = (float*)d_out; a.ws = (unsigned char*)d_ws;
#if ONE_LAUNCH
    a.ph_lo = 0; a.ph_hi = NPHASE;
    void* args[] = {&a};
    hipError_t e = hipLaunchCooperativeKernel((const void*)mega, dim3(grid), dim3(NTHR), args, LDS_BYTES, stream);
    if (e != hipSuccess) fprintf(stderr, "cooperative launch failed: %s (grid %d)\n", hipGetErrorString(e), grid);
#else
    for (int p = 0; p < NPHASE; ++p) { a.ph_lo = p; a.ph_hi = p + 1; hipLaunchKernelGGL(mega, dim3(grid), dim3(NTHR), LDS_BYTES, stream, a); }
#endif
}
```

```cpp
#include <hip/hip_runtime.h>
#include <hip/hip_cooperative_groups.h>
#include <cstdio>
#include <cstdint>
namespace cg = cooperative_groups;
namespace pg8 {
#define PG8_LAS __attribute__((address_space(3)))
typedef unsigned short bf16_t;
typedef short bf16x8 __attribute__((ext_vector_type(8)));
typedef float f32x4 __attribute__((ext_vector_type(4)));
typedef unsigned u32x4 __attribute__((ext_vector_type(4)));
constexpr int BM = 256, BK = 64, HALF = 128, HTB = HALF * BK * 2  , STAGE_BYTES = 8 * HTB, NXCD = 8, WGM = 8;

__host__ __device__ __forceinline__ int lds_byte(int r, int c) { const int st = (r >> 4) * 2 + (c >> 5), rr = r & 15, cc = c & 31, ob = rr * 64 + cc * 2; return st * 1024 + (ob ^ (((ob >> 9) & 1) << 5)); }
__host__ __device__ __forceinline__ void stage_rc(int b, int& R, int& C) { const int st = b / 1024, sb = b % 1024, swz = sb ^ (((sb >> 9) & 1) << 5); R = (st >> 1) * 16 + swz / 64; C = (st & 1) * 32 + (swz % 64) / 2; }
__host__ __device__ __forceinline__ int perm32(int rho) { const int n = rho >> 4, i = rho & 15; return 8 * (i >> 2) + 4 * n + (i & 3); }

struct Unit { int pm, pn; };
struct Gemm { const bf16_t* A; const bf16_t* Bt; int M, N, K; };

struct StaticOrder {
    int nM, nN, nwg, G, c;
    __host__ __device__ void init(int M, int N, int G_, int c_) { nM = M / BM; nN = N / BM; nwg = nM * nN; G = G_; c = c_; }
    __host__ __device__ bool next(int i, Unit& u) const {
        const long L = (long)i * G + c; if (L >= nwg) return false;
        int wgid = (int)L; { const int q = nwg / NXCD, r = nwg % NXCD, xcd = wgid % NXCD, off = wgid / NXCD; wgid = (xcd < r ? xcd * (q + 1) : r * (q + 1) + (xcd - r) * q) + off; }
        const int nig = WGM * nN, gid = wgid / nig, fm = gid * WGM, gsz = (nM - fm) < WGM ? (nM - fm) : WGM;
        u.pm = fm + ((wgid % nig) % gsz); u.pn = (wgid % nig) / gsz; return true;
    }
    __device__ __forceinline__ void a_ready(const Unit&) const {}
    __device__ __forceinline__ void done(const Unit&) const {}
};

__device__ __forceinline__ unsigned cvt_pk_bf16(float lo, float hi) { unsigned r; asm volatile("v_cvt_pk_bf16_f32 %0, %1, %2" : "=v"(r) : "v"(lo), "v"(hi)); return r; }
typedef float f32x2 __attribute__((ext_vector_type(2)));
__device__ __forceinline__ f32x2 gelu_pk(f32x2 v) {
    const f32x2 av = __builtin_elementwise_abs(v), d = av * 0.2316418882f + 1.0f;
    f32x2 t; t.x = __builtin_amdgcn_rcpf(d.x); t.y = __builtin_amdgcn_rcpf(d.y);
    f32x2 q = t * 0.5307027145f + (-0.7265760135f); q = q * t + 0.7107068705f; q = q * t + (-0.142248368f); q = q * t + 0.127414796f; q = q * t;
    const f32x2 s = (v * v) * (-0.72134752044f);
    f32x2 e; e.x = __builtin_amdgcn_exp2f(s.x); e.y = __builtin_amdgcn_exp2f(s.y);
    const f32x2 m = v * (q * e), r = v - m;
    f32x2 o; o.x = v.x < 0.f ? m.x : r.x; o.y = v.y < 0.f ? m.y : r.y; return o;
}

template <int ACT  > struct EpiBf16 {
    static constexpr bool PERM = true, AFTER_DRAIN = false; static_assert(ACT == 0 || ACT == 1, "EpiBf16: ACT is 0 (none) or 1 (gelu_pk)");
    bf16_t* O; int ldc; const float* bias; int split_cols; size_t split_stride; float scale0;
    __device__ __forceinline__ void operator()(const f32x4 (&acc)[2][2][4][2], const Unit& u, int wr, int wc, int fr, int fq) const {
        const int row0 = u.pm * BM + wr * 64 + fr; int colt = u.pn * BM; bf16_t* base = O;
        float sc = 1.f; if (split_cols) { const int t = colt / split_cols; base += (size_t)t * split_stride; colt -= t * split_cols; if (t == 0) sc = scale0; }
        const int col0 = colt + wc * 32 + 8 * fq, bcol0 = u.pn * BM + wc * 32 + 8 * fq;
        f32x4 bv[2][2];
#pragma unroll
        for (int bj = 0; bj < 2; ++bj)
#pragma unroll
            for (int n = 0; n < 2; ++n) bv[bj][n] = bias ? *(const f32x4*)(bias + bcol0 + bj * HALF + 4 * n) : (f32x4){0.f, 0.f, 0.f, 0.f};
#pragma unroll
        for (int ai = 0; ai < 2; ++ai)
#pragma unroll
            for (int m = 0; m < 4; ++m) { bf16_t* rowp = base + (size_t)(row0 + ai * HALF + m * 16) * ldc + col0;
#pragma unroll
                for (int bj = 0; bj < 2; ++bj) { f32x4 v0 = acc[ai][bj][m][0] + bv[bj][0], v1 = acc[ai][bj][m][1] + bv[bj][1];
                    if (ACT == 1) { f32x2 a = gelu_pk((f32x2){v0[0], v0[1]}), b = gelu_pk((f32x2){v0[2], v0[3]}), c = gelu_pk((f32x2){v1[0], v1[1]}), d = gelu_pk((f32x2){v1[2], v1[3]});
                        v0 = (f32x4){a.x, a.y, b.x, b.y}; v1 = (f32x4){c.x, c.y, d.x, d.y}; }
                    v0 = v0 * sc; v1 = v1 * sc; u32x4 w; w.x = cvt_pk_bf16(v0[0], v0[1]); w.y = cvt_pk_bf16(v0[2], v0[3]); w.z = cvt_pk_bf16(v1[0], v1[1]); w.w = cvt_pk_bf16(v1[2], v1[3]);
                    *(u32x4*)(rowp + bj * HALF) = w; } }
    }
};
struct EpiResid {
    static constexpr bool PERM = false, AFTER_DRAIN = false;
    const float* x; float* out; float* sspart; int ldc;
    __device__ __forceinline__ void operator()(const f32x4 (&acc)[2][2][4][2], const Unit& u, int wr, int wc, int fr, int fq) const {
        const int row0 = u.pm * BM + wr * 64 + fr, col0 = u.pn * BM + wc * 32 + 4 * fq;
#pragma unroll
        for (int ai = 0; ai < 2; ++ai)
#pragma unroll
            for (int m = 0; m < 4; ++m) {
                const int row = row0 + ai * HALF + m * 16; float ss = 0.f;
#pragma unroll
                for (int bj = 0; bj < 2; ++bj)
#pragma unroll
                    for (int n = 0; n < 2; ++n) {
                        const size_t off = (size_t)row * ldc + col0 + bj * HALF + n * 16;
                        const f32x4 xv = *(const f32x4*)(x + off); const f32x4 v = acc[ai][bj][m][n] + xv;
                        *(f32x4*)(out + off) = v; ss += (v[0] * v[0] + v[1] * v[1]) + (v[2] * v[2] + v[3] * v[3]);
                    }
                ss += __shfl_xor(ss, 16); ss += __shfl_xor(ss, 32);
                if (fq == 0) sspart[(size_t)row * 32 + u.pn * 4 + wc] = ss;
            }
    }
};

template <class Epi, class Sched, bool ALIGN_EPI = false, bool SP2 = false>
__device__ __forceinline__ void gemm_phase(PG8_LAS unsigned char* lds, const Gemm g, const Sched& S, const Epi& E) {
    const int tid = threadIdx.x, wid = __builtin_amdgcn_readfirstlane(tid >> 6), lane = tid & 63, wr = wid >> 2, wc = wid & 3, fr = lane & 15, fq = lane >> 4;
    const int K = g.K, nt = K / BK;
    unsigned voffA[2], voffB[2];
#pragma unroll
    for (int i = 0; i < 2; ++i) { int R, C; stage_rc(tid * 16 + i * 8192, R, C); const int Rb = Epi::PERM ? ((R & ~31) + perm32(R & 31)) : R;
        voffA[i] = (unsigned)(R * K + C) * 2u; voffB[i] = (unsigned)(Rb * K + C) * 2u; }
    const size_t kstep = (size_t)(BK * 2);
    const size_t hstep = (size_t)HALF * K * 2;
    const size_t tstep = 2 * hstep;
    const unsigned ldsw = (unsigned)wid * 1024u;
    const int aoff = lds_byte(wr * 64 + fr, fq * 8), boff = lds_byte(wc * 32 + fr, fq * 8);
#define PG8_SA(b, h) (((b) * 2 + (h)) * HTB)
#define PG8_SB(b, h) ((4 + (b) * 2 + (h)) * HTB)
#define PG8_STAGE(bufoff, gbase, voff) do { _Pragma("unroll") for (int _i = 0; _i < 2; ++_i) \
        __builtin_amdgcn_global_load_lds((const unsigned*)((const char*)(gbase) + (voff)[_i]), (PG8_LAS unsigned*)(lds + (bufoff) + ldsw + _i * 8192), 16, 0, 0); } while (0)
#define PG8_LDA(dst, b, h) do { _Pragma("unroll") for (int m = 0; m < 4; ++m) _Pragma("unroll") for (int k = 0; k < 2; ++k) dst[m][k] = *(const PG8_LAS bf16x8*)(lds + PG8_SA(b, h) + aoff + m * 2048 + k * 1024); } while (0)
#define PG8_LDB(dst, b, h) do { _Pragma("unroll") for (int n = 0; n < 2; ++n) _Pragma("unroll") for (int k = 0; k < 2; ++k) dst[n][k] = *(const PG8_LAS bf16x8*)(lds + PG8_SB(b, h) + boff + n * 2048 + k * 1024); } while (0)
#define PG8_MMA(ai, bj, At, Bt) do { __builtin_amdgcn_s_setprio(1); _Pragma("unroll") for (int m = 0; m < 4; ++m) _Pragma("unroll") for (int n = 0; n < 2; ++n) _Pragma("unroll") for (int k = 0; k < 2; ++k) \
        acc[ai][bj][m][n] = __builtin_amdgcn_mfma_f32_16x16x32_bf16(Bt[n][k], At[m][k], acc[ai][bj][m][n], 0, 0, 0); __builtin_amdgcn_s_setprio(0); } while (0)
#define PG8_WAIT_V(n) asm volatile("s_waitcnt vmcnt(" #n ")" ::: "memory")
#define PG8_WAIT_L(n) asm volatile("s_waitcnt lgkmcnt(" #n ")" ::: "memory")
#define PG8_BAR __builtin_amdgcn_s_barrier()
#define PG8_SCHED __builtin_amdgcn_sched_barrier(0)
    Unit cur, nxt; int ui = 0;
    if (!S.next(0, cur)) return;
    f32x4 acc[2][2][4][2];
#pragma unroll
    for (int a = 0; a < 2; ++a)
#pragma unroll
        for (int b = 0; b < 2; ++b)
#pragma unroll
            for (int m = 0; m < 4; ++m)
#pragma unroll
                for (int n = 0; n < 2; ++n) acc[a][b][m][n] = (f32x4){0.f, 0.f, 0.f, 0.f};
    bf16x8 At[4][2], B0[2][2], B1[2][2];
    const char* cA = (const char*)g.A + (size_t)cur.pm * tstep; const char* cB = (const char*)g.Bt + (size_t)cur.pn * tstep;
    S.a_ready(cur);
    if constexpr (SP2) {
        PG8_STAGE(PG8_SB(0, 0), cB, voffB); PG8_STAGE(PG8_SB(0, 1), cB + hstep, voffB); PG8_STAGE(PG8_SA(0, 0), cA, voffA); PG8_STAGE(PG8_SA(0, 1), cA + hstep, voffA);
        if (wr == 1) PG8_BAR;
        PG8_WAIT_V(2); PG8_BAR;
        PG8_STAGE(PG8_SB(1, 0), cB + kstep, voffB); PG8_STAGE(PG8_SA(1, 0), cA + kstep, voffA); PG8_STAGE(PG8_SB(1, 1), cB + hstep + kstep, voffB);
        PG8_WAIT_V(6); PG8_BAR;
    } else {
        PG8_STAGE(PG8_SB(0, 0), cB, voffB); PG8_STAGE(PG8_SA(0, 0), cA, voffA); PG8_STAGE(PG8_SB(0, 1), cB + hstep, voffB); PG8_STAGE(PG8_SA(0, 1), cA + hstep, voffA);
        if (wr == 1) PG8_BAR;
        PG8_WAIT_V(4); PG8_BAR;
        PG8_STAGE(PG8_SB(1, 0), cB + kstep, voffB); PG8_STAGE(PG8_SA(1, 0), cA + kstep, voffA); PG8_STAGE(PG8_SB(1, 1), cB + hstep + kstep, voffB);
        PG8_WAIT_V(6); PG8_BAR;
    }
    for (;;) {
        const bool has_next = S.next(ui + 1, nxt);
        const char* nA = has_next ? (const char*)g.A + (size_t)nxt.pm * tstep : cA; const char* nB = has_next ? (const char*)g.Bt + (size_t)nxt.pn * tstep : cB;
        for (int t = 0; t < nt; t += 2) {
            const bool last = (t == nt - 2);
            const char* a1 = cA + (size_t)(t + 1) * kstep;
            const char* a2 = last ? nA : cA + (size_t)(t + 2) * kstep; const char* b2 = last ? nB : cB + (size_t)(t + 2) * kstep;
            const char* a3 = a2 + kstep; const char* b3 = b2 + kstep;
            if (last && has_next) S.a_ready(nxt);
            if constexpr (SP2) {
            PG8_LDB(B0, 0, 0); PG8_LDB(B1, 0, 1); PG8_SCHED; PG8_LDA(At, 0, 0); PG8_STAGE(PG8_SA(1, 1), a1 + hstep, voffA);
            PG8_WAIT_V(8); PG8_WAIT_L(0); PG8_BAR; PG8_MMA(0, 0, At, B0); PG8_MMA(0, 1, At, B1); PG8_BAR; PG8_SCHED;
            PG8_LDA(At, 0, 1); PG8_STAGE(PG8_SB(0, 0), b2, voffB); PG8_STAGE(PG8_SB(0, 1), b2 + hstep, voffB); PG8_STAGE(PG8_SA(0, 0), a2, voffA);
            PG8_WAIT_V(8); PG8_WAIT_L(0); PG8_BAR; PG8_MMA(1, 0, At, B0); PG8_MMA(1, 1, At, B1); PG8_BAR; PG8_SCHED;
            PG8_LDB(B0, 1, 0); PG8_LDB(B1, 1, 1); PG8_SCHED; PG8_LDA(At, 1, 0); PG8_STAGE(PG8_SA(0, 1), a2 + hstep, voffA);
            PG8_WAIT_V(8); PG8_WAIT_L(0); PG8_BAR; PG8_MMA(0, 0, At, B0); PG8_MMA(0, 1, At, B1); PG8_BAR; PG8_SCHED;
            PG8_LDA(At, 1, 1); PG8_STAGE(PG8_SB(1, 0), b3, voffB); PG8_STAGE(PG8_SB(1, 1), b3 + hstep, voffB); PG8_STAGE(PG8_SA(1, 0), a3, voffA);
            PG8_WAIT_V(8); PG8_WAIT_L(0); PG8_BAR; PG8_MMA(1, 0, At, B0); PG8_MMA(1, 1, At, B1); PG8_BAR; PG8_SCHED;
            } else {
            PG8_LDB(B0, 0, 0); PG8_SCHED; PG8_LDA(At, 0, 0); PG8_STAGE(PG8_SA(1, 1), a1 + hstep, voffA);
            PG8_WAIT_L(8); PG8_BAR; PG8_WAIT_L(0); PG8_MMA(0, 0, At, B0); PG8_BAR; PG8_SCHED;
            PG8_LDB(B1, 0, 1); PG8_STAGE(PG8_SB(0, 0), b2, voffB);
            PG8_BAR; PG8_WAIT_L(0); PG8_MMA(0, 1, At, B1); PG8_BAR;
            PG8_LDA(At, 0, 1); PG8_STAGE(PG8_SA(0, 0), a2, voffA);
            PG8_BAR; PG8_WAIT_L(0); PG8_MMA(1, 0, At, B0); PG8_BAR; PG8_SCHED;
            PG8_STAGE(PG8_SB(0, 1), b2 + hstep, voffB);
            PG8_WAIT_V(6); PG8_BAR; PG8_MMA(1, 1, At, B1); PG8_BAR;
            PG8_LDB(B0, 1, 0); PG8_SCHED; PG8_LDA(At, 1, 0); PG8_STAGE(PG8_SA(0, 1), a2 + hstep, voffA);
            PG8_WAIT_L(8); PG8_BAR; PG8_WAIT_L(0); PG8_MMA(0, 0, At, B0); PG8_BAR; PG8_SCHED;
            PG8_LDB(B1, 1, 1); PG8_STAGE(PG8_SB(1, 0), b3, voffB);
            PG8_BAR; PG8_WAIT_L(0); PG8_MMA(0, 1, At, B1); PG8_BAR;
            PG8_LDA(At, 1, 1); PG8_STAGE(PG8_SA(1, 0), a3, voffA);
            PG8_BAR; PG8_WAIT_L(0); PG8_MMA(1, 0, At, B0); PG8_BAR; PG8_SCHED;
            PG8_STAGE(PG8_SB(1, 1), b3 + hstep, voffB);
            PG8_WAIT_V(6); PG8_BAR; PG8_MMA(1, 1, At, B1); PG8_BAR;
            }
        }
        if constexpr (ALIGN_EPI) { if (wr == 0) PG8_BAR; }
        if constexpr (!Epi::AFTER_DRAIN) { E(acc, cur, wr, wc, fr, fq); S.done(cur); }
        if (!has_next) break;
#pragma unroll
        for (int a = 0; a < 2; ++a)
#pragma unroll
            for (int b = 0; b < 2; ++b)
#pragma unroll
                for (int m = 0; m < 4; ++m)
#pragma unroll
                    for (int n = 0; n < 2; ++n) acc[a][b][m][n] = (f32x4){0.f, 0.f, 0.f, 0.f};
        cur = nxt; cA = nA; cB = nB; ++ui;
        if constexpr (ALIGN_EPI) { if (wr == 1) PG8_BAR; }
    }
    PG8_WAIT_V(0);
    if constexpr (!ALIGN_EPI) { if (wr == 0) PG8_BAR; }
    PG8_BAR;
    if constexpr (Epi::AFTER_DRAIN) { E.fused(acc, cur, wr, wc, fr, fq, lds, wid, lane); S.done(cur); }
#undef PG8_SA
#undef PG8_SB
#undef PG8_STAGE
#undef PG8_LDA
#undef PG8_LDB
#undef PG8_MMA
#undef PG8_WAIT_V
#undef PG8_WAIT_L
#undef PG8_BAR
#undef PG8_SCHED
}
}
constexpr int T = 8192, D = 2048, NIN = 6528, NINP = 6656, RW = 1024, NH = 16, HD = 64, CH = 64, NCH = T / CH;
constexpr int C_R = 0, C_K = 1024, C_V = 2048, C_WD = 3072, C_AD = 3136, C_G = 3200, C_AQ = 4224, C_AK = 5248, C_AV = 5376, C_AG = 5504;
constexpr float RMS_EPS = 1e-5f, LNX_EPS = 64e-5f;
constexpr int NWAVES = 8, NTHR = 512;
constexpr size_t MiB = 1u << 20;
constexpr size_t WS_WTIN = 1 * MiB;
constexpr size_t WS_XN = 27 * MiB;
constexpr size_t WS_WTOUT = 59 * MiB;
constexpr size_t WS_UPT = 67 * MiB;
constexpr size_t WS_SSP = 68 * MiB;
constexpr size_t WS_PROJ = 70 * MiB;
constexpr size_t WS_SCR = 174 * MiB;
constexpr size_t WS_MIX = 1 * MiB;
constexpr int LDS_BYTES = 147456;

#define GAS __attribute__((address_space(1)))
#define LAS __attribute__((address_space(3)))
typedef unsigned short bf16;
typedef unsigned v4u __attribute__((ext_vector_type(4)));
typedef unsigned v2u __attribute__((ext_vector_type(2)));
typedef float f32x4 __attribute__((ext_vector_type(4)));
typedef float f32x16 __attribute__((ext_vector_type(16)));
typedef short bf16x8 __attribute__((ext_vector_type(8)));
typedef __bf16 bf16x2_t __attribute__((ext_vector_type(2)));
__device__ __forceinline__ unsigned pk2(float a, float b) { bf16x2_t v; v[0] = (__bf16)a; v[1] = (__bf16)b; return __builtin_bit_cast(unsigned, v); }
__device__ __forceinline__ float bflo(unsigned u) { return __uint_as_float(u << 16); }
__device__ __forceinline__ float bfhi(unsigned u) { return __uint_as_float(u & 0xffff0000u); }
__device__ __forceinline__ void unpack8(const v4u& p, float (&f)[8]) { f[0] = bflo(p.x); f[1] = bfhi(p.x); f[2] = bflo(p.y); f[3] = bfhi(p.y); f[4] = bflo(p.z); f[5] = bfhi(p.z); f[6] = bflo(p.w); f[7] = bfhi(p.w); }
__device__ __forceinline__ v4u pack8(const float (&f)[8]) { v4u o; o.x = pk2(f[0], f[1]); o.y = pk2(f[2], f[3]); o.z = pk2(f[4], f[5]); o.w = pk2(f[6], f[7]); return o; }
__device__ __forceinline__ float wave_sum(float v) {
#pragma unroll
    for (int o = 1; o < 64; o <<= 1) v += __shfl_xor(v, o);
    return v;
}
__device__ __forceinline__ float sum8(float v) { v += __shfl_xor(v, 1); v += __shfl_xor(v, 2); v += __shfl_xor(v, 4); return v; }
__device__ __forceinline__ float sigmoidf_(float x) { return 1.f / (1.f + __expf(-x)); }
__device__ __forceinline__ float siluf_(float x) { return x / (1.f + __expf(-x)); }

struct Args { const float* in[16]; float* out; unsigned char* ws; int ph_lo, ph_hi; };

__device__ __forceinline__ void p0_transpose_item(const float* W, int K, int N, bf16* WT, LAS float* scr, int item, int lane) {
    const int nblk = N / 32, kb = item / nblk, nb = item % nblk, k0 = 64 * kb, n0 = 32 * nb;
#pragma unroll 8
    for (int i = 0; i < 32; ++i) { const int kk = 2 * i + (lane >> 5); scr[kk * 33 + (lane & 31)] = W[(size_t)(k0 + kk) * N + n0 + (lane & 31)]; }
    asm volatile("s_waitcnt lgkmcnt(0)" ::: "memory");
    const int c = lane & 7;
#pragma unroll
    for (int j = 0; j < 4; ++j) { const int n = (lane >> 3) + 8 * j; const LAS float* s = scr + (8 * c) * 33 + n;
        v4u o; o.x = pk2(s[0 * 33], s[1 * 33]); o.y = pk2(s[2 * 33], s[3 * 33]); o.z = pk2(s[4 * 33], s[5 * 33]); o.w = pk2(s[6 * 33], s[7 * 33]);
        *(v4u*)(WT + (size_t)(n0 + n) * K + k0 + 8 * c) = o; }
    asm volatile("s_waitcnt lgkmcnt(0)" ::: "memory");
}
__device__ __forceinline__ void p0_prologue(const Args& a, LAS unsigned char* lds, int vcu, int G, int wave, int lane) {
    LAS float* scr = (LAS float*)(lds + wave * 16384);
    const int gw = vcu * NWAVES + wave, NGW = G * NWAVES;
    bf16* wtin = (bf16*)(a.ws + WS_WTIN); bf16* wtout = (bf16*)(a.ws + WS_WTOUT); bf16* upt = (bf16*)(a.ws + WS_UPT); bf16* aupt = upt + 65536;
    constexpr int I_IN = (D / 64) * (NIN / 32), I_OUT = (D / 64) * (D / 32), I_UP = RW / 32;
    constexpr int NITEMS = I_IN + I_OUT + 2 * I_UP;
    for (int it = gw; it < NITEMS; it += NGW) {
        int r = it;
        if (r < I_IN) { p0_transpose_item(a.in[2], D, NIN, wtin, scr, r, lane); continue; } r -= I_IN;
        if (r < I_OUT) { p0_transpose_item(a.in[14], D, D, wtout, scr, r, lane); continue; } r -= I_OUT;
        if (r < I_UP) { p0_transpose_item(a.in[5], 64, RW, upt, scr, r, lane); continue; } r -= I_UP;
        p0_transpose_item(a.in[7], 64, RW, aupt, scr, r, lane);
    }
    { v4u z = {0u, 0u, 0u, 0u}; v4u* p = (v4u*)(wtin + (size_t)NIN * D); const int n16 = (NINP - NIN) * D * 2 / 16;
      for (int i = gw * 64 + lane; i < n16; i += NGW * 64) p[i] = z; }
    const float* gain = a.in[1];
    for (int m = gw; m < T; m += NGW) {
        const f32x4* xr = (const f32x4*)(a.in[0] + (size_t)m * D) + lane; f32x4 v[8]; float s = 0.f;
#pragma unroll
        for (int j = 0; j < 8; ++j) { v[j] = xr[64 * j]; s += (v[j].x * v[j].x + v[j].y * v[j].y) + (v[j].z * v[j].z + v[j].w * v[j].w); }
        const float rstd = 1.f / sqrtf(wave_sum(s) * (1.f / D) + RMS_EPS);
        v2u* o8 = (v2u*)((bf16*)(a.ws + WS_XN) + (size_t)m * D) + lane;
#pragma unroll
        for (int j = 0; j < 8; ++j) { const f32x4 g = *((const f32x4*)gain + lane + 64 * j); v2u o; o.x = pk2(v[j].x * rstd * g.x, v[j].y * rstd * g.y); o.y = pk2(v[j].z * rstd * g.z, v[j].w * rstd * g.w); o8[64 * j] = o; }
    }
}
__device__ __forceinline__ void final_norm(const Args& a, int vcu, int G, int wave, int lane) {
    const int gw = vcu * NWAVES + wave, NGW = G * NWAVES; const float* ssp = (const float*)(a.ws + WS_SSP); const float* gain = a.in[15];
    for (int m = gw; m < T; m += NGW) {
        float s = (lane < 32) ? ssp[(size_t)m * 32 + lane] : 0.f; s = wave_sum(s);
        const float rstd = 1.f / sqrtf(s * (1.f / D) + RMS_EPS);
        f32x4* xr = (f32x4*)(a.out + (size_t)m * D) + lane;
#pragma unroll
        for (int j = 0; j < 8; ++j) { f32x4 v = xr[64 * j]; const f32x4 g = *((const f32x4*)gain + lane + 64 * j); v.x *= rstd * g.x; v.y *= rstd * g.y; v.z *= rstd * g.z; v.w *= rstd * g.w; xr[64 * j] = v; }
    }
}
#define MFMA32(a_, b_, c_) __builtin_amdgcn_mfma_f32_32x32x16_bf16((a_), (b_), (c_), 0, 0, 0)
#define MFMA16(a_, b_, c_) __builtin_amdgcn_mfma_f32_16x16x32_bf16((a_), (b_), (c_), 0, 0, 0)
__device__ __forceinline__ v4u ldg16(const bf16* p) { return *(const v4u*)p; }
__device__ __forceinline__ void load_shift8(const bf16* proj, int row, int col, const float* mu, float (&o)[8]) {
    const v4u p = ldg16(proj + (size_t)row * NINP + col); v4u q = {0u, 0u, 0u, 0u};
    if (row > 0) q = ldg16(proj + (size_t)(row - 1) * NINP + col);
    float pf[8], qf[8]; unpack8(p, pf); unpack8(q, qf);
    const f32x4 m0 = *(const f32x4*)(mu + col), m1 = *(const f32x4*)(mu + col + 4);
    const float mf[8] = {m0.x, m0.y, m0.z, m0.w, m1.x, m1.y, m1.z, m1.w};
#pragma unroll
    for (int j = 0; j < 8; ++j) o[j] = pf[j] + (qf[j] - pf[j]) * mf[j];
}
__device__ __forceinline__ void ld8f(const float* p, float (&o)[8]) { const f32x4 a = *(const f32x4*)p, b = *(const f32x4*)(p + 4); o[0] = a.x; o[1] = a.y; o[2] = a.z; o[3] = a.w; o[4] = b.x; o[5] = b.y; o[6] = b.z; o[7] = b.w; }

constexpr int VP = 168;
__device__ __forceinline__ void attn_unit(const Args& a, LAS unsigned char* lds, int unit, int tid, int wave, int lane) {
    const bf16* proj = (const bf16*)(a.ws + WS_PROJ); bf16* mix = (bf16*)(a.ws + WS_MIX);
    const int qb = unit >> 1, kvh = unit & 1, q0 = qb * 32, kbase = q0 - 128, hq = kvh * 8 + wave;
    LAS bf16* VT = (LAS bf16*)lds;
    __syncthreads();
    for (int idx = tid; idx < 160 * 8; idx += NTHR) {
        const int key = idx >> 3, d8 = (idx & 7) * 8, tk = kbase + key;
        v4u p = {0u, 0u, 0u, 0u};
        if (tk >= 0) p = ldg16(proj + (size_t)tk * NINP + C_AV + kvh * 64 + d8);
        const unsigned w[4] = {p.x, p.y, p.z, p.w};
#pragma unroll
        for (int j = 0; j < 4; ++j) { VT[(d8 + 2 * j) * VP + key] = (bf16)(w[j] & 0xffffu); VT[(d8 + 2 * j + 1) * VP + key] = (bf16)(w[j] >> 16); }
    }
    __syncthreads();
    const int r = lane & 31, h = lane >> 5;
    bf16x8 bq[4];
    { const bf16* qrow = proj + (size_t)(q0 + r) * NINP + C_AQ + hq * 64 + 8 * h;
#pragma unroll
      for (int s = 0; s < 4; ++s) bq[s] = *(const bf16x8*)(qrow + 16 * s); }
    const float slope = exp2f(-0.5f * (float)(hq + 1)), sink = a.in[13][hq];
    f32x16 sc[5]; float mx = sink;
#pragma unroll
    for (int kt = 0; kt < 5; ++kt) {
        const int tkb = kbase + 32 * kt;
        f32x16 acc; for (int i = 0; i < 16; ++i) acc[i] = 0.f;
        if (tkb >= 0) {
            const bf16* krow = proj + (size_t)(tkb + r) * NINP + C_AK + kvh * 64 + 8 * h;
#pragma unroll
            for (int s = 0; s < 4; ++s) acc = MFMA32(*(const bf16x8*)(krow + 16 * s), bq[s], acc);
        }
#pragma unroll
        for (int i = 0; i < 16; ++i) {
            const int key = tkb + (i & 3) + 8 * (i >> 2) + 4 * h, dist = (q0 + r) - key;
            const bool valid = (tkb >= 0) && (dist >= 0) && (dist < 128);
            const float v = valid ? acc[i] * 0.125f - slope * (float)dist : -1e30f;
            sc[kt][i] = v; mx = fmaxf(mx, v);
        }
        __builtin_amdgcn_sched_barrier(0);
    }
    mx = fmaxf(mx, __shfl_xor(mx, 32));
    float sum = 0.f;
#pragma unroll
    for (int kt = 0; kt < 5; ++kt)
#pragma unroll
        for (int i = 0; i < 16; ++i) { const float p = __expf(sc[kt][i] - mx); sc[kt][i] = p; sum += p; }
    sum += __shfl_xor(sum, 32); sum += __expf(sink - mx);
    f32x16 o[2]; for (int i = 0; i < 16; ++i) { o[0][i] = 0.f; o[1][i] = 0.f; }
#pragma unroll
    for (int kt = 0; kt < 5; ++kt) {
        if (kbase + 32 * kt >= 0) {
#pragma unroll
            for (int s = 0; s < 2; ++s) {
                v4u pw; pw.x = pk2(sc[kt][8 * s + 0], sc[kt][8 * s + 1]); pw.y = pk2(sc[kt][8 * s + 2], sc[kt][8 * s + 3]); pw.z = pk2(sc[kt][8 * s + 4], sc[kt][8 * s + 5]); pw.w = pk2(sc[kt][8 * s + 6], sc[kt][8 * s + 7]);
                const bf16x8 pb = __builtin_bit_cast(bf16x8, pw);
#pragma unroll
                for (int dt = 0; dt < 2; ++dt) {
                    const LAS bf16* vp = VT + (32 * dt + r) * VP + 32 * kt + 16 * s + 4 * h;
                    const v2u lo = *(const LAS v2u*)vp, hi = *(const LAS v2u*)(vp + 8);
                    v4u vw; vw.x = lo.x; vw.y = lo.y; vw.z = hi.x; vw.w = hi.y;
                    o[dt] = MFMA32(__builtin_bit_cast(bf16x8, vw), pb, o[dt]);
                }
            }
        }
    }
    const float inv = 1.f / sum;
#pragma unroll
    for (int dt = 0; dt < 2; ++dt)
#pragma unroll
        for (int g4 = 0; g4 < 4; ++g4) {
            const int d0 = 32 * dt + 8 * g4 + 4 * h;
            const v2u gp = *(const v2u*)(proj + (size_t)(q0 + r) * NINP + C_AG + hq * 64 + d0);
            v2u w; w.x = pk2(o[dt][4 * g4 + 0] * inv * siluf_(bflo(gp.x)), o[dt][4 * g4 + 1] * inv * siluf_(bfhi(gp.x)));
            w.y = pk2(o[dt][4 * g4 + 2] * inv * siluf_(bflo(gp.y)), o[dt][4 * g4 + 3] * inv * siluf_(bfhi(gp.y)));
            *(v2u*)(mix + (size_t)(q0 + r) * D + RW + hq * 64 + d0) = w;
        }
}

struct Prep { float r[8], kp[8], v[8], g[8], w[8], lw[8], kk[8], b[8], bonus; };
__device__ __forceinline__ void rwkv_prep(const Args& a, LAS unsigned char* lds, int h, int t0, int tid, int wave, int lane, Prep& P) {
    const bf16* proj = (const bf16*)(a.ws + WS_PROJ); const bf16* upt = (const bf16*)(a.ws + WS_UPT); const bf16* aupt = upt + 65536;
    LAS bf16* TW = (LAS bf16*)lds; LAS bf16* ADm = TW + 64 * 72; LAS float* Z = (LAS float*)(lds + 18432); LAS float* AP = Z + 64 * 68;
    const int t = tid >> 3, c8 = (tid & 7) * 8, ch = h * 64 + c8, row = t0 + t;
    const float* mu = a.in[3];
    { float x[8]; load_shift8(proj, row, C_WD + c8, mu, x);
#pragma unroll
      for (int j = 0; j < 8; ++j) x[j] = tanhf(x[j]);
      *(LAS v4u*)(TW + t * 72 + c8) = pack8(x);
      load_shift8(proj, row, C_AD + c8, mu, x); *(LAS v4u*)(ADm + t * 72 + c8) = pack8(x); }
    __syncthreads();
    { const int rt = wave & 3, cp = (wave >> 2) * 2, fr = lane & 15, fq = lane >> 4;
      bf16x8 aT[2], aA[2];
#pragma unroll
      for (int s = 0; s < 2; ++s) { aT[s] = *(const LAS bf16x8*)(TW + (16 * rt + fr) * 72 + 32 * s + 8 * fq); aA[s] = *(const LAS bf16x8*)(ADm + (16 * rt + fr) * 72 + 32 * s + 8 * fq); }
#pragma unroll
      for (int ci = 0; ci < 2; ++ci) { const int ct = cp + ci; f32x4 z = {0.f, 0.f, 0.f, 0.f}, ap = {0.f, 0.f, 0.f, 0.f};
#pragma unroll
          for (int s = 0; s < 2; ++s) { const size_t bo = (size_t)(h * 64 + 16 * ct + fr) * 64 + 32 * s + 8 * fq;
              z = MFMA16(aT[s], *(const bf16x8*)(upt + bo), z); ap = MFMA16(aA[s], *(const bf16x8*)(aupt + bo), ap); }
#pragma unroll
          for (int j = 0; j < 4; ++j) { Z[(16 * rt + 4 * fq + j) * 68 + 16 * ct + fr] = z[j]; AP[(16 * rt + 4 * fq + j) * 68 + 16 * ct + fr] = ap[j]; } } }
    __syncthreads();
    float zz[8], aa[8], kr[8], c0[8], c1[8];
#pragma unroll
    for (int j = 0; j < 8; ++j) { zz[j] = Z[t * 68 + c8 + j]; aa[j] = AP[t * 68 + c8 + j]; }
    load_shift8(proj, row, C_R + ch, mu, P.r); load_shift8(proj, row, C_K + ch, mu, kr); load_shift8(proj, row, C_V + ch, mu, P.v); load_shift8(proj, row, C_G + ch, mu, P.g);
    ld8f(a.in[4] + ch, c0); ld8f(a.in[6] + ch, c1);
#pragma unroll
    for (int j = 0; j < 8; ++j) { const float z = c0[j] + zz[j]; const float sp = fmaxf(-z, 0.f) + log1pf(__expf(-fabsf(z))); const float wl = -sp - 0.5f; P.lw[j] = -__expf(wl); P.w[j] = __expf(P.lw[j]); aa[j] = sigmoidf_(c1[j] + aa[j]); }
    ld8f(a.in[8] + ch, c0); ld8f(a.in[9] + ch, c1);
    float ss = 0.f;
#pragma unroll
    for (int j = 0; j < 8; ++j) { P.kk[j] = kr[j] * c0[j]; ss += P.kk[j] * P.kk[j]; P.kp[j] = kr[j] * (1.f + (aa[j] - 1.f) * c1[j]); }
    ss = sum8(ss); const float rn = 1.f / fmaxf(sqrtf(ss), 1e-12f);
    ld8f(a.in[10] + ch, c0);
    float bs = 0.f;
#pragma unroll
    for (int j = 0; j < 8; ++j) { P.kk[j] *= rn; P.b[j] = P.kk[j] * aa[j]; bs += P.r[j] * P.kp[j] * c0[j]; }
    P.bonus = sum8(bs);
}
__device__ __forceinline__ void rwkv_out8(const Args& a, const float (&y)[8], const float (&v)[8], const float (&g)[8], float bonus, int row, int ch) {
    bf16* mix = (bf16*)(a.ws + WS_MIX);
    float s = 0.f;
#pragma unroll
    for (int j = 0; j < 8; ++j) s += y[j];
    const float mean = sum8(s) * (1.f / 64.f); float q = 0.f;
#pragma unroll
    for (int j = 0; j < 8; ++j) { const float d = y[j] - mean; q += d * d; }
    const float rstd = 1.f / sqrtf(sum8(q) * (1.f / 64.f) + LNX_EPS);
    float lg[8], lb[8], o[8]; ld8f(a.in[11] + ch, lg); ld8f(a.in[12] + ch, lb);
#pragma unroll
    for (int j = 0; j < 8; ++j) { const float yn = (y[j] - mean) * rstd * lg[j] + lb[j] + bonus * v[j]; o[j] = yn * siluf_(g[j]); }
    *(v4u*)(mix + (size_t)row * D + ch) = pack8(o);
}
__device__ __forceinline__ void rwkv_seq_head(const Args& a, LAS unsigned char* lds, int h, int tid, int wave, int lane) {
    LAS float* SR = (LAS float*)lds; LAS float* SW = SR + 4096; LAS float* SK = SW + 4096; LAS float* SKK = SK + 4096; LAS float* SB = SKK + 4096; LAS float* SV = SB + 4096; LAS float* SY = SV + 4096;
    const int t = tid >> 3, c8 = (tid & 7) * 8, ch = h * 64 + c8;
    float S[64];
#pragma unroll
    for (int k = 0; k < 64; ++k) S[k] = 0.f;
    for (int c = 0; c < NCH; ++c) {
        const int t0 = c * CH; Prep P;
        rwkv_prep(a, lds, h, t0, tid, wave, lane, P);
        __syncthreads();
#pragma unroll
        for (int j = 0; j < 8; ++j) { const int o = t * 64 + c8 + j; SR[o] = P.r[j]; SW[o] = P.w[j]; SK[o] = P.kp[j]; SKK[o] = P.kk[j]; SB[o] = P.b[j]; SV[o] = P.v[j]; }
        __syncthreads();
        if (wave == 0) {
            for (int tt = 0; tt < CH; ++tt) {
                float s0 = 0.f, s1 = 0.f, s2 = 0.f, s3 = 0.f;
#pragma unroll
                for (int k4 = 0; k4 < 16; ++k4) { const f32x4 q = *(const LAS f32x4*)(SKK + tt * 64 + 4 * k4); s0 += S[4 * k4] * q.x; s1 += S[4 * k4 + 1] * q.y; s2 += S[4 * k4 + 2] * q.z; s3 += S[4 * k4 + 3] * q.w; }
                const float sa = -((s0 + s1) + (s2 + s3)); const float vv = SV[tt * 64 + lane];
                float y0 = 0.f, y1 = 0.f, y2 = 0.f, y3 = 0.f;
#pragma unroll
                for (int k4 = 0; k4 < 16; ++k4) {
                    const f32x4 w = *(const LAS f32x4*)(SW + tt * 64 + 4 * k4), b = *(const LAS f32x4*)(SB + tt * 64 + 4 * k4), kq = *(const LAS f32x4*)(SK + tt * 64 + 4 * k4), rr = *(const LAS f32x4*)(SR + tt * 64 + 4 * k4);
                    S[4 * k4] = S[4 * k4] * w.x + sa * b.x + vv * kq.x; y0 += S[4 * k4] * rr.x;
                    S[4 * k4 + 1] = S[4 * k4 + 1] * w.y + sa * b.y + vv * kq.y; y1 += S[4 * k4 + 1] * rr.y;
                    S[4 * k4 + 2] = S[4 * k4 + 2] * w.z + sa * b.z + vv * kq.z; y2 += S[4 * k4 + 2] * rr.z;
                    S[4 * k4 + 3] = S[4 * k4 + 3] * w.w + sa * b.w + vv * kq.w; y3 += S[4 * k4 + 3] * rr.w;
                }
                SY[tt * 64 + lane] = (y0 + y1) + (y2 + y3);
            }
        }
        __syncthreads();
        float y[8];
#pragma unroll
        for (int j = 0; j < 8; ++j) y[j] = SY[t * 64 + c8 + j];
        rwkv_out8(a, y, P.v, P.g, P.bonus, t0 + t, ch);
    }
}
#ifndef ONE_LAUNCH
#define ONE_LAUNCH 1
#endif
constexpr int NPHASE = 5;
__global__ void __launch_bounds__(NTHR, 2) mega(Args a) {
    extern __shared__ __attribute__((aligned(16))) unsigned char lds_[];
    LAS unsigned char* lds = (LAS unsigned char*)lds_;
    const int tid = threadIdx.x, lane = tid & 63, wave = __builtin_amdgcn_readfirstlane(tid >> 6);
    const int G = gridDim.x, bx = blockIdx.x, vcu = (G % 8 == 0) ? (bx % 8) * (G / 8) + bx / 8 : bx;
    cg::grid_group grid = cg::this_grid();
#define IN(k) (a.ph_lo <= (k) && (k) < a.ph_hi)
#define SEAM(k) do { if (IN(k) && IN((k) + 1)) grid.sync(); } while (0)
    if (IN(0)) { p0_prologue(a, lds, vcu, G, wave, lane); }
    SEAM(0);
    if (IN(1)) {
        pg8::Gemm g{(const pg8::bf16_t*)(a.ws + WS_XN), (const pg8::bf16_t*)(a.ws + WS_WTIN), T, NINP, D}; pg8::StaticOrder S; S.init(T, NINP, G, bx);
        pg8::EpiBf16<0> E{(pg8::bf16_t*)(a.ws + WS_PROJ), NINP, nullptr, 0, 0, 1.f};
        pg8::gemm_phase<pg8::EpiBf16<0>, pg8::StaticOrder, true, true>(lds, g, S, E);
    }
    SEAM(1);
    if (IN(2)) {
        if (bx < NH) rwkv_seq_head(a, lds, bx, tid, wave, lane);
        else for (int u = bx - NH; u < 512; u += G - NH) attn_unit(a, lds, u, tid, wave, lane);
    }
    SEAM(2);
    if (IN(3)) {
        pg8::Gemm g{(const pg8::bf16_t*)(a.ws + WS_MIX), (const pg8::bf16_t*)(a.ws + WS_WTOUT), T, D, D}; pg8::StaticOrder S; S.init(T, D, G, bx);
        pg8::EpiResid E{a.in[0], a.out, (float*)(a.ws + WS_SSP), D};
        pg8::gemm_phase<pg8::EpiResid, pg8::StaticOrder, true, true>(lds, g, S, E);
    }
    SEAM(3);
    if (IN(4)) final_norm(a, vcu, G, wave, lane);
#undef IN
#undef SEAM
}

extern "C" void kernel_launch(void* const* d_in, const int* in_sizes, int n_in, void* d_out, int out_size, void* d_ws, size_t ws_size, hipStream_t stream) {
    static int grid = 0;
    if (grid == 0) {
        int dev = 0, cus = 0;
        if (hipGetDevice(&dev) != hipSuccess || hipDeviceGetAttribute(&cus, hipDeviceAttributeMultiprocessorCount, dev) != hipSuccess) { fprintf(stderr, "kernel_launch: device query failed\n"); grid = -1; return; }
        if (hipFuncSetAttribute((const void*)mega, hipFuncAttributeMaxDynamicSharedMemorySize, LDS_BYTES) != hipSuccess) { fprintf(stderr, "kernel_launch: hipFuncSetAttribute failed\n"); grid = -1; return; }
        (void)hipGetLastError();
        grid = cus;
    }
    if (grid < 0) return;
    Args a{};
    for (int i = 0; i < 16; ++i) a.in[i] = (const float*)d_in[i];
    a.out = (float*)d_out; a.ws = (unsigned char*)d_ws;
#if ONE_LAUNCH
    a.ph_lo = 0; a.ph_hi = NPHASE;
    void* args[] = {&a};
    hipError_t e = hipLaunchCooperativeKernel((const void*)mega, dim3(grid), dim3(NTHR), args, LDS_BYTES, stream);
    if (e != hipSuccess) fprintf(stderr, "cooperative launch failed: %s (grid %d)\n", hipGetErrorString(e), grid);
#else
    for (int p = 0; p < NPHASE; ++p) { a.ph_lo = p; a.ph_hi = p + 1; hipLaunchKernelGGL(mega, dim3(grid), dim3(NTHR), LDS_BYTES, stream, a); }
#endif
}
```

```cpp
#include <hip/hip_runtime.h>
#include <hip/hip_cooperative_groups.h>
#include <cstdio>
#include <cstdint>
namespace cg = cooperative_groups;
namespace pg8 {
#define PG8_LAS __attribute__((address_space(3)))
typedef unsigned short bf16_t;
typedef short bf16x8 __attribute__((ext_vector_type(8)));
typedef float f32x4 __attribute__((ext_vector_type(4)));
typedef unsigned u32x4 __attribute__((ext_vector_type(4)));
constexpr int BM = 256, BK = 64, HALF = 128, HTB = HALF * BK * 2  , STAGE_BYTES = 8 * HTB, NXCD = 8, WGM = 8;

__host__ __device__ __forceinline__ int lds_byte(int r, int c) { const int st = (r >> 4) * 2 + (c >> 5), rr = r & 15, cc = c & 31, ob = rr * 64 + cc * 2; return st * 1024 + (ob ^ (((ob >> 9) & 1) << 5)); }
__host__ __device__ __forceinline__ void stage_rc(int b, int& R, int& C) { const int st = b / 1024, sb = b % 1024, swz = sb ^ (((sb >> 9) & 1) << 5); R = (st >> 1) * 16 + swz / 64; C = (st & 1) * 32 + (swz % 64) / 2; }
__host__ __device__ __forceinline__ int perm32(int rho) { const int n = rho >> 4, i = rho & 15; return 8 * (i >> 2) + 4 * n + (i & 3); }

struct Unit { int pm, pn; };
struct Gemm { const bf16_t* A; const bf16_t* Bt; int M, N, K; };

struct StaticOrder {
    int nM, nN, nwg, G, c;
    __host__ __device__ void init(int M, int N, int G_, int c_) { nM = M / BM; nN = N / BM; nwg = nM * nN; G = G_; c = c_; }
    __host__ __device__ bool next(int i, Unit& u) const {
        const long L = (long)i * G + c; if (L >= nwg) return false;
        int wgid = (int)L; { const int q = nwg / NXCD, r = nwg % NXCD, xcd = wgid % NXCD, off = wgid / NXCD; wgid = (xcd < r ? xcd * (q + 1) : r * (q + 1) + (xcd - r) * q) + off; }
        const int nig = WGM * nN, gid = wgid / nig, fm = gid * WGM, gsz = (nM - fm) < WGM ? (nM - fm) : WGM;
        u.pm = fm + ((wgid % nig) % gsz); u.pn = (wgid % nig) / gsz; return true;
    }
    __device__ __forceinline__ void a_ready(const Unit&) const {}
    __device__ __forceinline__ void done(const Unit&) const {}
};

__device__ __forceinline__ unsigned cvt_pk_bf16(float lo, float hi) { unsigned r; asm volatile("v_cvt_pk_bf16_f32 %0, %1, %2" : "=v"(r) : "v"(lo), "v"(hi)); return r; }
typedef float f32x2 __attribute__((ext_vector_type(2)));
__device__ __forceinline__ f32x2 gelu_pk(f32x2 v) {
    const f32x2 av = __builtin_elementwise_abs(v), d = av * 0.2316418882f + 1.0f;
    f32x2 t; t.x = __builtin_amdgcn_rcpf(d.x); t.y = __builtin_amdgcn_rcpf(d.y);
    f32x2 q = t * 0.5307027145f + (-0.7265760135f); q = q * t + 0.7107068705f; q = q * t + (-0.142248368f); q = q * t + 0.127414796f; q = q * t;
    const f32x2 s = (v * v) * (-0.72134752044f);
    f32x2 e; e.x = __builtin_amdgcn_exp2f(s.x); e.y = __builtin_amdgcn_exp2f(s.y);
    const f32x2 m = v * (q * e), r = v - m;
    f32x2 o; o.x = v.x < 0.f ? m.x : r.x; o.y = v.y < 0.f ? m.y : r.y; return o;
}

template <int ACT  > struct EpiBf16 {
    static constexpr bool PERM = true, AFTER_DRAIN = false; static_assert(ACT == 0 || ACT == 1, "EpiBf16: ACT is 0 (none) or 1 (gelu_pk)");
    bf16_t* O; int ldc; const float* bias; int split_cols; size_t split_stride; float scale0;
    __device__ __forceinline__ void operator()(const f32x4 (&acc)[2][2][4][2], const Unit& u, int wr, int wc, int fr, int fq) const {
        const int row0 = u.pm * BM + wr * 64 + fr; int colt = u.pn * BM; bf16_t* base = O;
        float sc = 1.f; if (split_cols) { const int t = colt / split_cols; base += (size_t)t * split_stride; colt -= t * split_cols; if (t == 0) sc = scale0; }
        const int col0 = colt + wc * 32 + 8 * fq, bcol0 = u.pn * BM + wc * 32 + 8 * fq;
        f32x4 bv[2][2];
#pragma unroll
        for (int bj = 0; bj < 2; ++bj)
#pragma unroll
            for (int n = 0; n < 2; ++n) bv[bj][n] = bias ? *(const f32x4*)(bias + bcol0 + bj * HALF + 4 * n) : (f32x4){0.f, 0.f, 0.f, 0.f};
#pragma unroll
        for (int ai = 0; ai < 2; ++ai)
#pragma unroll
            for (int m = 0; m < 4; ++m) { bf16_t* rowp = base + (size_t)(row0 + ai * HALF + m * 16) * ldc + col0;
#pragma unroll
                for (int bj = 0; bj < 2; ++bj) { f32x4 v0 = acc[ai][bj][m][0] + bv[bj][0], v1 = acc[ai][bj][m][1] + bv[bj][1];
                    if (ACT == 1) { f32x2 a = gelu_pk((f32x2){v0[0], v0[1]}), b = gelu_pk((f32x2){v0[2], v0[3]}), c = gelu_pk((f32x2){v1[0], v1[1]}), d = gelu_pk((f32x2){v1[2], v1[3]});
                        v0 = (f32x4){a.x, a.y, b.x, b.y}; v1 = (f32x4){c.x, c.y, d.x, d.y}; }
                    v0 = v0 * sc; v1 = v1 * sc; u32x4 w; w.x = cvt_pk_bf16(v0[0], v0[1]); w.y = cvt_pk_bf16(v0[2], v0[3]); w.z = cvt_pk_bf16(v1[0], v1[1]); w.w = cvt_pk_bf16(v1[2], v1[3]);
                    *(u32x4*)(rowp + bj * HALF) = w; } }
    }
};
struct EpiResid {
    static constexpr bool PERM = false, AFTER_DRAIN = false;
    const float* x; float* out; float* sspart; int ldc;
    __device__ __forceinline__ void operator()(const f32x4 (&acc)[2][2][4][2], const Unit& u, int wr, int wc, int fr, int fq) const {
        const int row0 = u.pm * BM + wr * 64 + fr, col0 = u.pn * BM + wc * 32 + 4 * fq;
#pragma unroll
        for (int ai = 0; ai < 2; ++ai)
#pragma unroll
            for (int m = 0; m < 4; ++m) {
                const int row = row0 + ai * HALF + m * 16; float ss = 0.f;
#pragma unroll
                for (int bj = 0; bj < 2; ++bj)
#pragma unroll
                    for (int n = 0; n < 2; ++n) {
                        const size_t off = (size_t)row * ldc + col0 + bj * HALF + n * 16;
                        const f32x4 xv = *(const f32x4*)(x + off); const f32x4 v = acc[ai][bj][m][n] + xv;
                        *(f32x4*)(out + off) = v; ss += (v[0] * v[0] + v[1] * v[1]) + (v[2] * v[2] + v[3] * v[3]);
                    }
                ss += __shfl_xor(ss, 16); ss += __shfl_xor(ss, 32);
                if (fq == 0) sspart[(size_t)row * 32 + u.pn * 4 + wc] = ss;
            }
    }
};

template <class Epi, class Sched, bool ALIGN_EPI = false, bool SP2 = false>
__device__ __forceinline__ void gemm_phase(PG8_LAS unsigned char* lds, const Gemm g, const Sched& S, const Epi& E) {
    const int tid = threadIdx.x, wid = __builtin_amdgcn_readfirstlane(tid >> 6), lane = tid & 63, wr = wid >> 2, wc = wid & 3, fr = lane & 15, fq = lane >> 4;
    const int K = g.K, nt = K / BK;
    unsigned voffA[2], voffB[2];
#pragma unroll
    for (int i = 0; i < 2; ++i) { int R, C; stage_rc(tid * 16 + i * 8192, R, C); const int Rb = Epi::PERM ? ((R & ~31) + perm32(R & 31)) : R;
        voffA[i] = (unsigned)(R * K + C) * 2u; voffB[i] = (unsigned)(Rb * K + C) * 2u; }
    const size_t kstep = (size_t)(BK * 2);
    const size_t hstep = (size_t)HALF * K * 2;
    const size_t tstep = 2 * hstep;
    const unsigned ldsw = (unsigned)wid * 1024u;
    const int aoff = lds_byte(wr * 64 + fr, fq * 8), boff = lds_byte(wc * 32 + fr, fq * 8);
#define PG8_SA(b, h) (((b) * 2 + (h)) * HTB)
#define PG8_SB(b, h) ((4 + (b) * 2 + (h)) * HTB)
#define PG8_STAGE(bufoff, gbase, voff) do { _Pragma("unroll") for (int _i = 0; _i < 2; ++_i) \
        __builtin_amdgcn_global_load_lds((const unsigned*)((const char*)(gbase) + (voff)[_i]), (PG8_LAS unsigned*)(lds + (bufoff) + ldsw + _i * 8192), 16, 0, 0); } while (0)
#define PG8_LDA(dst, b, h) do { _Pragma("unroll") for (int m = 0; m < 4; ++m) _Pragma("unroll") for (int k = 0; k < 2; ++k) dst[m][k] = *(const PG8_LAS bf16x8*)(lds + PG8_SA(b, h) + aoff + m * 2048 + k * 1024); } while (0)
#define PG8_LDB(dst, b, h) do { _Pragma("unroll") for (int n = 0; n < 2; ++n) _Pragma("unroll") for (int k = 0; k < 2; ++k) dst[n][k] = *(const PG8_LAS bf16x8*)(lds + PG8_SB(b, h) + boff + n * 2048 + k * 1024); } while (0)
#define PG8_MMA(ai, bj, At, Bt) do { __builtin_amdgcn_s_setprio(1); _Pragma("unroll") for (int m = 0; m < 4; ++m) _Pragma("unroll") for (int n = 0; n < 2; ++n) _Pragma("unroll") for (int k = 0; k < 2; ++k) \
        acc[ai][bj][m][n] = __builtin_amdgcn_mfma_f32_16x16x32_bf16(Bt[n][k], At[m][k], acc[ai][bj][m][n], 0, 0, 0); __builtin_amdgcn_s_setprio(0); } while (0)
#define PG8_WAIT_V(n) asm volatile("s_waitcnt vmcnt(" #n ")" ::: "memory")
#define PG8_WAIT_L(n) asm volatile("s_waitcnt lgkmcnt(" #n ")" ::: "memory")
#define PG8_BAR __builtin_amdgcn_s_barrier()
#define PG8_SCHED __builtin_amdgcn_sched_barrier(0)
    Unit cur, nxt; int ui = 0;
    if (!S.next(0, cur)) return;
    f32x4 acc[2][2][4][2];
#pragma unroll
    for (int a = 0; a < 2; ++a)
#pragma unroll
        for (int b = 0; b < 2; ++b)
#pragma unroll
            for (int m = 0; m < 4; ++m)
#pragma unroll
                for (int n = 0; n < 2; ++n) acc[a][b][m][n] = (f32x4){0.f, 0.f, 0.f, 0.f};
    bf16x8 At[4][2], B0[2][2], B1[2][2];
    const char* cA = (const char*)g.A + (size_t)cur.pm * tstep; const char* cB = (const char*)g.Bt + (size_t)cur.pn * tstep;
    S.a_ready(cur);
    if constexpr (SP2) {
        PG8_STAGE(PG8_SB(0, 0), cB, voffB); PG8_STAGE(PG8_SB(0, 1), cB + hstep, voffB); PG8_STAGE(PG8_SA(0, 0), cA, voffA); PG8_STAGE(PG8_SA(0, 1), cA + hstep, voffA);
        if (wr == 1) PG8_BAR;
        PG8_WAIT_V(2); PG8_BAR;
        PG8_STAGE(PG8_SB(1, 0), cB + kstep, voffB); PG8_STAGE(PG8_SA(1, 0), cA + kstep, voffA); PG8_STAGE(PG8_SB(1, 1), cB + hstep + kstep, voffB);
        PG8_WAIT_V(6); PG8_BAR;
    } else {
        PG8_STAGE(PG8_SB(0, 0), cB, voffB); PG8_STAGE(PG8_SA(0, 0), cA, voffA); PG8_STAGE(PG8_SB(0, 1), cB + hstep, voffB); PG8_STAGE(PG8_SA(0, 1), cA + hstep, voffA);
        if (wr == 1) PG8_BAR;
        PG8_WAIT_V(4); PG8_BAR;
        PG8_STAGE(PG8_SB(1, 0), cB + kstep, voffB); PG8_STAGE(PG8_SA(1, 0), cA + kstep, voffA); PG8_STAGE(PG8_SB(1, 1), cB + hstep + kstep, voffB);
        PG8_WAIT_V(6); PG8_BAR;
    }
    for (;;) {
        const bool has_next = S.next(ui + 1, nxt);
        const char* nA = has_next ? (const char*)g.A + (size_t)nxt.pm * tstep : cA; const char* nB = has_next ? (const char*)g.Bt + (size_t)nxt.pn * tstep : cB;
        for (int t = 0; t < nt; t += 2) {
            const bool last = (t == nt - 2);
            const char* a1 = cA + (size_t)(t + 1) * kstep;
            const char* a2 = last ? nA : cA + (size_t)(t + 2) * kstep; const char* b2 = last ? nB : cB + (size_t)(t + 2) * kstep;
            const char* a3 = a2 + kstep; const char* b3 = b2 + kstep;
            if (last && has_next) S.a_ready(nxt);
            if constexpr (SP2) {
            PG8_LDB(B0, 0, 0); PG8_LDB(B1, 0, 1); PG8_SCHED; PG8_LDA(At, 0, 0); PG8_STAGE(PG8_SA(1, 1), a1 + hstep, voffA);
            PG8_WAIT_V(8); PG8_WAIT_L(0); PG8_BAR; PG8_MMA(0, 0, At, B0); PG8_MMA(0, 1, At, B1); PG8_BAR; PG8_SCHED;
            PG8_LDA(At, 0, 1); PG8_STAGE(PG8_SB(0, 0), b2, voffB); PG8_STAGE(PG8_SB(0, 1), b2 + hstep, voffB); PG8_STAGE(PG8_SA(0, 0), a2, voffA);
            PG8_WAIT_V(8); PG8_WAIT_L(0); PG8_BAR; PG8_MMA(1, 0, At, B0); PG8_MMA(1, 1, At, B1); PG8_BAR; PG8_SCHED;
            PG8_LDB(B0, 1, 0); PG8_LDB(B1, 1, 1); PG8_SCHED; PG8_LDA(At, 1, 0); PG8_STAGE(PG8_SA(0, 1), a2 + hstep, voffA);
            PG8_WAIT_V(8); PG8_WAIT_L(0); PG8_BAR; PG8_MMA(0, 0, At, B0); PG8_MMA(0, 1, At, B1); PG8_BAR; PG8_SCHED;
            PG8_LDA(At, 1, 1); PG8_STAGE(PG8_SB(1, 0), b3, voffB); PG8_STAGE(PG8_SB(1, 1), b3 + hstep, voffB); PG8_STAGE(PG8_SA(1, 0), a3, voffA);
            PG8_WAIT_V(8); PG8_WAIT_L(0); PG8_BAR; PG8_MMA(1, 0, At, B0); PG8_MMA(1, 1, At, B1); PG8_BAR; PG8_SCHED;
            } else {
            PG8_LDB(B0, 0, 0); PG8_SCHED; PG8_LDA(At, 0, 0); PG8_STAGE(PG8_SA(1, 1), a1 + hstep, voffA);
            PG8_WAIT_L(8); PG8_BAR; PG8_WAIT_L(0); PG8_MMA(0, 0, At, B0); PG8_BAR; PG8_SCHED;
            PG8_LDB(B1, 0, 1); PG8_STAGE(PG8_SB(0, 0), b2, voffB);
            PG8_BAR; PG8_WAIT_L(0); PG8_MMA(0, 1, At, B1); PG8_BAR;
            PG8_LDA(At, 0, 1); PG8_STAGE(PG8_SA(0, 0), a2, voffA);
            PG8_BAR; PG8_WAIT_L(0); PG8_MMA(1, 0, At, B0); PG8_BAR; PG8_SCHED;
            PG8_STAGE(PG8_SB(0, 1), b2 + hstep, voffB);
            PG8_WAIT_V(6); PG8_BAR; PG8_MMA(1, 1, At, B1); PG8_BAR;
            PG8_LDB(B0, 1, 0); PG8_SCHED; PG8_LDA(At, 1, 0); PG8_STAGE(PG8_SA(0, 1), a2 + hstep, voffA);
            PG8_WAIT_L(8); PG8_BAR; PG8_WAIT_L(0); PG8_MMA(0, 0, At, B0); PG8_BAR; PG8_SCHED;
            PG8_LDB(B1, 1, 1); PG8_STAGE(PG8_SB(1, 0), b3, voffB);
            PG8_BAR; PG8_WAIT_L(0); PG8_MMA(0, 1, At, B1); PG8_BAR;
            PG8_LDA(At, 1, 1); PG8_STAGE(PG8_SA(1, 0), a3, voffA);
            PG8_BAR; PG8_WAIT_L(0); PG8_MMA(1, 0, At, B0); PG8_BAR; PG8_SCHED;
            PG8_STAGE(PG8_SB(1, 1), b3 + hstep, voffB);
            PG8_WAIT_V(6); PG8_BAR; PG8_MMA(1, 1, At, B1); PG8_BAR;
            }
        }
        if constexpr (ALIGN_EPI) { if (wr == 0) PG8_BAR; }
        if constexpr (!Epi::AFTER_DRAIN) { E(acc, cur, wr, wc, fr, fq); S.done(cur); }
        if (!has_next) break;
#pragma unroll
        for (int a = 0; a < 2; ++a)
#pragma unroll
            for (int b = 0; b < 2; ++b)
#pragma unroll
                for (int m = 0; m < 4; ++m)
#pragma unroll
                    for (int n = 0; n < 2; ++n) acc[a][b][m][n] = (f32x4){0.f, 0.f, 0.f, 0.f};
        cur = nxt; cA = nA; cB = nB; ++ui;
        if constexpr (ALIGN_EPI) { if (wr == 1) PG8_BAR; }
    }
    PG8_WAIT_V(0);
    if constexpr (!ALIGN_EPI) { if (wr == 0) PG8_BAR; }
    PG8_BAR;
    if constexpr (Epi::AFTER_DRAIN) { E.fused(acc, cur, wr, wc, fr, fq, lds, wid, lane); S.done(cur); }
#undef PG8_SA
#undef PG8_SB
#undef PG8_STAGE
#undef PG8_LDA
#undef PG8_LDB
#undef PG8_MMA
#undef PG8_WAIT_V
#undef PG8_WAIT_L
#undef PG8_BAR
#undef PG8_SCHED
}
}
constexpr int T = 8192, D = 2048, NIN = 6528, NINP = 6656, RW = 1024, NH = 16, HD = 64, CH = 64, NCH = T / CH;
constexpr int C_R = 0, C_K = 1024, C_V = 2048, C_WD = 3072, C_AD = 3136, C_G = 3200, C_AQ = 4224, C_AK = 5248, C_AV = 5376, C_AG = 5504;
constexpr float RMS_EPS = 1e-5f, LNX_EPS = 64e-5f;
constexpr int NWAVES = 8, NTHR = 512;
constexpr size_t MiB = 1u << 20;
constexpr size_t WS_WTIN = 1 * MiB;
constexpr size_t WS_XN = 27 * MiB;
constexpr size_t WS_WTOUT = 59 * MiB;
constexpr size_t WS_UPT = 67 * MiB;
constexpr size_t WS_SSP = 68 * MiB;
constexpr size_t WS_PROJ = 70 * MiB;
constexpr size_t WS_SCR = 174 * MiB;
constexpr size_t WS_MIX = 1 * MiB;
constexpr int LDS_BYTES = 147456;

#define GAS __attribute__((address_space(1)))
#define LAS __attribute__((address_space(3)))
typedef unsigned short bf16;
typedef unsigned v4u __attribute__((ext_vector_type(4)));
typedef unsigned v2u __attribute__((ext_vector_type(2)));
typedef float f32x4 __attribute__((ext_vector_type(4)));
typedef float f32x16 __attribute__((ext_vector_type(16)));
typedef short bf16x8 __attribute__((ext_vector_type(8)));
typedef __bf16 bf16x2_t __attribute__((ext_vector_type(2)));
__device__ __forceinline__ unsigned pk2(float a, float b) { bf16x2_t v; v[0] = (__bf16)a; v[1] = (__bf16)b; return __builtin_bit_cast(unsigned, v); }
__device__ __forceinline__ float bflo(unsigned u) { return __uint_as_float(u << 16); }
__device__ __forceinline__ float bfhi(unsigned u) { return __uint_as_float(u & 0xffff0000u); }
__device__ __forceinline__ void unpack8(const v4u& p, float (&f)[8]) { f[0] = bflo(p.x); f[1] = bfhi(p.x); f[2] = bflo(p.y); f[3] = bfhi(p.y); f[4] = bflo(p.z); f[5] = bfhi(p.z); f[6] = bflo(p.w); f[7] = bfhi(p.w); }
__device__ __forceinline__ v4u pack8(const float (&f)[8]) { v4u o; o.x = pk2(f[0], f[1]); o.y = pk2(f[2], f[3]); o.z = pk2(f[4], f[5]); o.w = pk2(f[6], f[7]); return o; }
__device__ __forceinline__ float wave_sum(float v) {
#pragma unroll
    for (int o = 1; o < 64; o <<= 1) v += __shfl_xor(v, o);
    return v;
}
__device__ __forceinline__ float sum8(float v) { v += __shfl_xor(v, 1); v += __shfl_xor(v, 2); v += __shfl_xor(v, 4); return v; }
__device__ __forceinline__ float sigmoidf_(float x) { return 1.f / (1.f + __expf(-x)); }
__device__ __forceinline__ float siluf_(float x) { return x / (1.f + __expf(-x)); }

struct Args { const float* in[16]; float* out; unsigned char* ws; int ph_lo, ph_hi; };

__device__ __forceinline__ void p0_transpose_item(const float* W, int K, int N, bf16* WT, LAS float* scr, int item, int lane) {
    const int nblk = N / 32, kb = item / nblk, nb = item % nblk, k0 = 64 * kb, n0 = 32 * nb;
#pragma unroll 8
    for (int i = 0; i < 32; ++i) { const int kk = 2 * i + (lane >> 5); scr[kk * 33 + (lane & 31)] = W[(size_t)(k0 + kk) * N + n0 + (lane & 31)]; }
    asm volatile("s_waitcnt lgkmcnt(0)" ::: "memory");
    const int c = lane & 7;
#pragma unroll
    for (int j = 0; j < 4; ++j) { const int n = (lane >> 3) + 8 * j; const LAS float* s = scr + (8 * c) * 33 + n;
        v4u o; o.x = pk2(s[0 * 33], s[1 * 33]); o.y = pk2(s[2 * 33], s[3 * 33]); o.z = pk2(s[4 * 33], s[5 * 33]); o.w = pk2(s[6 * 33], s[7 * 33]);
        *(v4u*)(WT + (size_t)(n0 + n) * K + k0 + 8 * c) = o; }
    asm volatile("s_waitcnt lgkmcnt(0)" ::: "memory");
}
__device__ __forceinline__ void p0_prologue(const Args& a, LAS unsigned char* lds, int vcu, int G, int wave, int lane) {
    LAS float* scr = (LAS float*)(lds + wave * 16384);
    const int gw = vcu * NWAVES + wave, NGW = G * NWAVES;
    bf16* wtin = (bf16*)(a.ws + WS_WTIN); bf16* wtout = (bf16*)(a.ws + WS_WTOUT); bf16* upt = (bf16*)(a.ws + WS_UPT); bf16* aupt = upt + 65536;
    constexpr int I_IN = (D / 64) * (NIN / 32), I_OUT = (D / 64) * (D / 32), I_UP = RW / 32;
    constexpr int NITEMS = I_IN + I_OUT + 2 * I_UP;
    for (int it = gw; it < NITEMS; it += NGW) {
        int r = it;
        if (r < I_IN) { p0_transpose_item(a.in[2], D, NIN, wtin, scr, r, lane); continue; } r -= I_IN;
        if (r < I_OUT) { p0_transpose_item(a.in[14], D, D, wtout, scr, r, lane); continue; } r -= I_OUT;
        if (r < I_UP) { p0_transpose_item(a.in[5], 64, RW, upt, scr, r, lane); continue; } r -= I_UP;
        p0_transpose_item(a.in[7], 64, RW, aupt, scr, r, lane);
    }
    { v4u z = {0u, 0u, 0u, 0u}; v4u* p = (v4u*)(wtin + (size_t)NIN * D); const int n16 = (NINP - NIN) * D * 2 / 16;
      for (int i = gw * 64 + lane; i < n16; i += NGW * 64) p[i] = z; }
    const float* gain = a.in[1];
    for (int m = gw; m < T; m += NGW) {
        const f32x4* xr = (const f32x4*)(a.in[0] + (size_t)m * D) + lane; f32x4 v[8]; float s = 0.f;
#pragma unroll
        for (int j = 0; j < 8; ++j) { v[j] = xr[64 * j]; s += (v[j].x * v[j].x + v[j].y * v[j].y) + (v[j].z * v[j].z + v[j].w * v[j].w); }
        const float rstd = 1.f / sqrtf(wave_sum(s) * (1.f / D) + RMS_EPS);
        v2u* o8 = (v2u*)((bf16*)(a.ws + WS_XN) + (size_t)m * D) + lane;
#pragma unroll
        for (int j = 0; j < 8; ++j) { const f32x4 g = *((const f32x4*)gain + lane + 64 * j); v2u o; o.x = pk2(v[j].x * rstd * g.x, v[j].y * rstd * g.y); o.y = pk2(v[j].z * rstd * g.z, v[j].w * rstd * g.w); o8[64 * j] = o; }
    }
}
__device__ __forceinline__ void final_norm(const Args& a, int vcu, int G, int wave, int lane) {
    const int gw = vcu * NWAVES + wave, NGW = G * NWAVES; const float* ssp = (const float*)(a.ws + WS_SSP); const float* gain = a.in[15];
    for (int m = gw; m < T; m += NGW) {
        float s = (lane < 32) ? ssp[(size_t)m * 32 + lane] : 0.f; s = wave_sum(s);
        const float rstd = 1.f / sqrtf(s * (1.f / D) + RMS_EPS);
        f32x4* xr = (f32x4*)(a.out + (size_t)m * D) + lane;
#pragma unroll
        for (int j = 0; j < 8; ++j) { f32x4 v = xr[64 * j]; const f32x4 g = *((const f32x4*)gain + lane + 64 * j); v.x *= rstd * g.x; v.y *= rstd * g.y; v.z *= rstd * g.z; v.w *= rstd * g.w; xr[64 * j] = v; }
    }
}
#define MFMA32(a_, b_, c_) __builtin_amdgcn_mfma_f32_32x32x16_bf16((a_), (b_), (c_), 0, 0, 0)
#define MFMA16(a_, b_, c_) __builtin_amdgcn_mfma_f32_16x16x32_bf16((a_), (b_), (c_), 0, 0, 0)
__device__ __forceinline__ v4u ldg16(const bf16* p) { return *(const v4u*)p; }
__device__ __forceinline__ void load_shift8(const bf16* proj, int row, int col, const float* mu, float (&o)[8]) {
    const v4u p = ldg16(proj + (size_t)row * NINP + col); v4u q = {0u, 0u, 0u, 0u};
    if (row > 0) q = ldg16(proj + (size_t)(row - 1) * NINP + col);
    float pf[8], qf[8]; unpack8(p, pf); unpack8(q, qf);
    const f32x4 m0 = *(const f32x4*)(mu + col), m1 = *(const f32x4*)(mu + col + 4);
    const float mf[8] = {m0.x, m0.y, m0.z, m0.w, m1.x, m1.y, m1.z, m1.w};
#pragma unroll
    for (int j = 0; j < 8; ++j) o[j] = pf[j] + (qf[j] - pf[j]) * mf[j];
}
__device__ __forceinline__ void ld8f(const float* p, float (&o)[8]) { const f32x4 a = *(const f32x4*)p, b = *(const f32x4*)(p + 4); o[0] = a.x; o[1] = a.y; o[2] = a.z; o[3] = a.w; o[4] = b.x; o[5] = b.y; o[6] = b.z; o[7] = b.w; }

constexpr int VP = 168;
__device__ __forceinline__ void attn_unit(const Args& a, LAS unsigned char* lds, int unit, int tid, int wave, int lane) {
    const bf16* proj = (const bf16*)(a.ws + WS_PROJ); bf16* mix = (bf16*)(a.ws + WS_MIX);
    const int qb = unit >> 1, kvh = unit & 1, q0 = qb * 32, kbase = q0 - 128, hq = kvh * 8 + wave;
    LAS bf16* VT = (LAS bf16*)lds;
    __syncthreads();
    for (int idx = tid; idx < 160 * 8; idx += NTHR) {
        const int key = idx >> 3, d8 = (idx & 7) * 8, tk = kbase + key;
        v4u p = {0u, 0u, 0u, 0u};
        if (tk >= 0) p = ldg16(proj + (size_t)tk * NINP + C_AV + kvh * 64 + d8);
        const unsigned w[4] = {p.x, p.y, p.z, p.w};
#pragma unroll
        for (int j = 0; j < 4; ++j) { VT[(d8 + 2 * j) * VP + key] = (bf16)(w[j] & 0xffffu); VT[(d8 + 2 * j + 1) * VP + key] = (bf16)(w[j] >> 16); }
    }
    __syncthreads();
    const int r = lane & 31, h = lane >> 5;
    bf16x8 bq[4];
    { const bf16* qrow = proj + (size_t)(q0 + r) * NINP + C_AQ + hq * 64 + 8 * h;
#pragma unroll
      for (int s = 0; s < 4; ++s) bq[s] = *(const bf16x8*)(qrow + 16 * s); }
    const float slope = exp2f(-0.5f * (float)(hq + 1)), sink = a.in[13][hq];
    f32x16 sc[5]; float mx = sink;
#pragma unroll
    for (int kt = 0; kt < 5; ++kt) {
        const int tkb = kbase + 32 * kt;
        f32x16 acc; for (int i = 0; i < 16; ++i) acc[i] = 0.f;
        if (tkb >= 0) {
            const bf16* krow = proj + (size_t)(tkb + r) * NINP + C_AK + kvh * 64 + 8 * h;
#pragma unroll
            for (int s = 0; s < 4; ++s) acc = MFMA32(*(const bf16x8*)(krow + 16 * s), bq[s], acc);
        }
#pragma unroll
        for (int i = 0; i < 16; ++i) {
            const int key = tkb + (i & 3) + 8 * (i >> 2) + 4 * h, dist = (q0 + r) - key;
            const bool valid = (tkb >= 0) && (dist >= 0) && (dist < 128);
            const float v = valid ? acc[i] * 0.125f - slope * (float)dist : -1e30f;
            sc[kt][i] = v; mx = fmaxf(mx, v);
        }
        __builtin_amdgcn_sched_barrier(0);
    }
    mx = fmaxf(mx, __shfl_xor(mx, 32));
    float sum = 0.f;
#pragma unroll
    for (int kt = 0; kt < 5; ++kt)
#pragma unroll
        for (int i = 0; i < 16; ++i) { const float p = __expf(sc[kt][i] - mx); sc[kt][i] = p; sum += p; }
    sum += __shfl_xor(sum, 32); sum += __expf(sink - mx);
    f32x16 o[2]; for (int i = 0; i < 16; ++i) { o[0][i] = 0.f; o[1][i] = 0.f; }
#pragma unroll
    for (int kt = 0; kt < 5; ++kt) {
        if (kbase + 32 * kt >= 0) {
#pragma unroll
            for (int s = 0; s < 2; ++s) {
                v4u pw; pw.x = pk2(sc[kt][8 * s + 0], sc[kt][8 * s + 1]); pw.y = pk2(sc[kt][8 * s + 2], sc[kt][8 * s + 3]); pw.z = pk2(sc[kt][8 * s + 4], sc[kt][8 * s + 5]); pw.w = pk2(sc[kt][8 * s + 6], sc[kt][8 * s + 7]);
                const bf16x8 pb = __builtin_bit_cast(bf16x8, pw);
#pragma unroll
                for (int dt = 0; dt < 2; ++dt) {
                    const LAS bf16* vp = VT + (32 * dt + r) * VP + 32 * kt + 16 * s + 4 * h;
                    const v2u lo = *(const LAS v2u*)vp, hi = *(const LAS v2u*)(vp + 8);
                    v4u vw; vw.x = lo.x; vw.y = lo.y; vw.z = hi.x; vw.w = hi.y;
                    o[dt] = MFMA32(__builtin_bit_cast(bf16x8, vw), pb, o[dt]);
                }
            }
        }
    }
    const float inv = 1.f / sum;
#pragma unroll
    for (int dt = 0; dt < 2; ++dt)
#pragma unroll
        for (int g4 = 0; g4 < 4; ++g4) {
            const int d0 = 32 * dt + 8 * g4 + 4 * h;
            const v2u gp = *(const v2u*)(proj + (size_t)(q0 + r) * NINP + C_AG + hq * 64 + d0);
            v2u w; w.x = pk2(o[dt][4 * g4 + 0] * inv * siluf_(bflo(gp.x)), o[dt][4 * g4 + 1] * inv * siluf_(bfhi(gp.x)));
            w.y = pk2(o[dt][4 * g4 + 2] * inv * siluf_(bflo(gp.y)), o[dt][4 * g4 + 3] * inv * siluf_(bfhi(gp.y)));
            *(v2u*)(mix + (size_t)(q0 + r) * D + RW + hq * 64 + d0) = w;
        }
}

struct Prep { float r[8], kp[8], v[8], g[8], w[8], lw[8], kk[8], b[8], bonus; };
__device__ __forceinline__ void rwkv_prep(const Args& a, LAS unsigned char* lds, int h, int t0, int tid, int wave, int lane, Prep& P) {
    const bf16* proj = (const bf16*)(a.ws + WS_PROJ); const bf16* upt = (const bf16*)(a.ws + WS_UPT); const bf16* aupt = upt + 65536;
    LAS bf16* TW = (LAS bf16*)lds; LAS bf16* ADm = TW + 64 * 72; LAS float* Z = (LAS float*)(lds + 18432); LAS float* AP = Z + 64 * 68;
    const int t = tid >> 3, c8 = (tid & 7) * 8, ch = h * 64 + c8, row = t0 + t;
    const float* mu = a.in[3];
    { float x[8]; load_shift8(proj, row, C_WD + c8, mu, x);
#pragma unroll
      for (int j = 0; j < 8; ++j) x[j] = tanhf(x[j]);
      *(LAS v4u*)(TW + t * 72 + c8) = pack8(x);
      load_shift8(proj, row, C_AD + c8, mu, x); *(LAS v4u*)(ADm + t * 72 + c8) = pack8(x); }
    __syncthreads();
    { const int rt = wave & 3, cp = (wave >> 2) * 2, fr = lane & 15, fq = lane >> 4;
      bf16x8 aT[2], aA[2];
#pragma unroll
      for (int s = 0; s < 2; ++s) { aT[s] = *(const LAS bf16x8*)(TW + (16 * rt + fr) * 72 + 32 * s + 8 * fq); aA[s] = *(const LAS bf16x8*)(ADm + (16 * rt + fr) * 72 + 32 * s + 8 * fq); }
#pragma unroll
      for (int ci = 0; ci < 2; ++ci) { const int ct = cp + ci; f32x4 z = {0.f, 0.f, 0.f, 0.f}, ap = {0.f, 0.f, 0.f, 0.f};
#pragma unroll
          for (int s = 0; s < 2; ++s) { const size_t bo = (size_t)(h * 64 + 16 * ct + fr) * 64 + 32 * s + 8 * fq;
              z = MFMA16(aT[s], *(const bf16x8*)(upt + bo), z); ap = MFMA16(aA[s], *(const bf16x8*)(aupt + bo), ap); }
#pragma unroll
          for (int j = 0; j < 4; ++j) { Z[(16 * rt + 4 * fq + j) * 68 + 16 * ct + fr] = z[j]; AP[(16 * rt + 4 * fq + j) * 68 + 16 * ct + fr] = ap[j]; } } }
    __syncthreads();
    float zz[8], aa[8], kr[8], c0[8], c1[8];
#pragma unroll
    for (int j = 0; j < 8; ++j) { zz[j] = Z[t * 68 + c8 + j]; aa[j] = AP[t * 68 + c8 + j]; }
    load_shift8(proj, row, C_R + ch, mu, P.r); load_shift8(proj, row, C_K + ch, mu, kr); load_shift8(proj, row, C_V + ch, mu, P.v); load_shift8(proj, row, C_G + ch, mu, P.g);
    ld8f(a.in[4] + ch, c0); ld8f(a.in[6] + ch, c1);
#pragma unroll
    for (int j = 0; j < 8; ++j) { const float z = c0[j] + zz[j]; const float sp = fmaxf(-z, 0.f) + log1pf(__expf(-fabsf(z))); const float wl = -sp - 0.5f; P.lw[j] = -__expf(wl); P.w[j] = __expf(P.lw[j]); aa[j] = sigmoidf_(c1[j] + aa[j]); }
    ld8f(a.in[8] + ch, c0); ld8f(a.in[9] + ch, c1);
    float ss = 0.f;
#pragma unroll
    for (int j = 0; j < 8; ++j) { P.kk[j] = kr[j] * c0[j]; ss += P.kk[j] * P.kk[j]; P.kp[j] = kr[j] * (1.f + (aa[j] - 1.f) * c1[j]); }
    ss = sum8(ss); const float rn = 1.f / fmaxf(sqrtf(ss), 1e-12f);
    ld8f(a.in[10] + ch, c0);
    float bs = 0.f;
#pragma unroll
    for (int j = 0; j < 8; ++j) { P.kk[j] *= rn; P.b[j] = P.kk[j] * aa[j]; bs += P.r[j] * P.kp[j] * c0[j]; }
    P.bonus = sum8(bs);
}
__device__ __forceinline__ void rwkv_out8(const Args& a, const float (&y)[8], const float (&v)[8], const float (&g)[8], float bonus, int row, int ch) {
    bf16* mix = (bf16*)(a.ws + WS_MIX);
    float s = 0.f;
#pragma unroll
    for (int j = 0; j < 8; ++j) s += y[j];
    const float mean = sum8(s) * (1.f / 64.f); float q = 0.f;
#pragma unroll
    for (int j = 0; j < 8; ++j) { const float d = y[j] - mean; q += d * d; }
    const float rstd = 1.f / sqrtf(sum8(q) * (1.f / 64.f) + LNX_EPS);
    float lg[8], lb[8], o[8]; ld8f(a.in[11] + ch, lg); ld8f(a.in[12] + ch, lb);
#pragma unroll
    for (int j = 0; j < 8; ++j) { const float yn = (y[j] - mean) * rstd * lg[j] + lb[j] + bonus * v[j]; o[j] = yn * siluf_(g[j]); }
    *(v4u*)(mix + (size_t)row * D + ch) = pack8(o);
}
constexpr size_t WS_MF = 174 * MiB, WS_QF = 190 * MiB, WS_SF = 206 * MiB, WS_BON = 222 * MiB;
constexpr size_t OUT_NF = 0, OUT_Y2 = 32 * MiB;
constexpr int MP = 72;
constexpr int L_AT = 0, L_ATT = 9216, L_BT = 18432, L_KT = 27648, L_RT = 36864, L_BHT = 46080, L_KHT = 55296, L_VT = 64512, L_LW = 73728, L_P = 73728, L_PT = 82944,
              L_AAK = 92160, L_ARB = 101376, L_ARK = 110592, L_TM = 119808, L_SEG = 119808, L_GC = 129024, L_WT = L_AT, L_X1T = L_BT, L_U2T = L_KT;
struct WTile { int ta, tb0, fr, fq; };
__device__ __forceinline__ bf16x8 ldfrag(const LAS bf16* M, int tile, int s, const WTile& w) { return *(const LAS bf16x8*)(M + (16 * tile + w.fr) * MP + 32 * s + 8 * w.fq); }
__device__ __forceinline__ void mm2(const LAS bf16* A, const LAS bf16* B, const WTile& w, f32x4 (&acc)[2]) {
#pragma unroll
    for (int s = 0; s < 2; ++s) { const bf16x8 af = ldfrag(A, w.ta, s, w);
#pragma unroll
        for (int ci = 0; ci < 2; ++ci) acc[ci] = MFMA16(af, ldfrag(B, w.tb0 + ci, s, w), acc[ci]); }
}
__device__ __forceinline__ void st_T(LAS bf16* X, int ta, int tb, const WTile& w, const f32x4& v) { v2u o; o.x = pk2(v[0], v[1]); o.y = pk2(v[2], v[3]); *(LAS v2u*)(X + (16 * tb + w.fr) * MP + 16 * ta + 4 * w.fq) = o; }
__device__ __forceinline__ void st_N(LAS bf16* X, int ta, int tb, const WTile& w, const f32x4& v) {
    const unsigned a = pk2(v[0], v[1]), b = pk2(v[2], v[3]); LAS bf16* p = X + (16 * ta + 4 * w.fq) * MP + 16 * tb + w.fr;
    p[0] = (bf16)(a & 0xffffu); p[MP] = (bf16)(a >> 16); p[2 * MP] = (bf16)(b & 0xffffu); p[3 * MP] = (bf16)(b >> 16);
}
#define ZERO2(x) do { x[0] = (f32x4){0.f, 0.f, 0.f, 0.f}; x[1] = (f32x4){0.f, 0.f, 0.f, 0.f}; } while (0)
template <int MODE> __device__ __forceinline__ void mask2(f32x4 (&acc)[2], const WTile& w) {
#pragma unroll
    for (int ci = 0; ci < 2; ++ci)
#pragma unroll
        for (int j = 0; j < 4; ++j) { const int row = 16 * w.ta + 4 * w.fq + j, col = 16 * (w.tb0 + ci) + w.fr;
            const bool keep = MODE == 0 ? (row < col) : (MODE == 1 ? (row <= col) : (col < row)); if (!keep) acc[ci][j] = 0.f; }
}
__device__ __forceinline__ void st_bf16x8_T(LAS bf16* X, int c8, int t, const float (&v)[8]) {
    const v4u p = pack8(v); const unsigned w[4] = {p.x, p.y, p.z, p.w};
#pragma unroll
    for (int j = 0; j < 4; ++j) { X[(c8 + 2 * j) * MP + t] = (bf16)(w[j] & 0xffffu); X[(c8 + 2 * j + 1) * MP + t] = (bf16)(w[j] >> 16); }
}

__device__ __forceinline__ void rwkv_chunk_prep(const Args& a, LAS unsigned char* lds, int unit, int tid, int wave, int lane) {
    const int c = unit >> 4, h = unit & 15, t0 = c * CH, t = tid >> 3, c8 = (tid & 7) * 8;
    LAS bf16* At = (LAS bf16*)(lds + L_AT); LAS bf16* AtT = (LAS bf16*)(lds + L_ATT); LAS bf16* Bt = (LAS bf16*)(lds + L_BT); LAS bf16* Kt = (LAS bf16*)(lds + L_KT);
    LAS bf16* Rt = (LAS bf16*)(lds + L_RT); LAS bf16* BhT = (LAS bf16*)(lds + L_BHT); LAS bf16* KhT = (LAS bf16*)(lds + L_KHT); LAS bf16* VT = (LAS bf16*)(lds + L_VT);
    LAS float* LW = (LAS float*)(lds + L_LW); LAS bf16* Pm = (LAS bf16*)(lds + L_P); LAS bf16* PT = (LAS bf16*)(lds + L_PT);
    LAS bf16* AAK = (LAS bf16*)(lds + L_AAK); LAS bf16* ARB = (LAS bf16*)(lds + L_ARB); LAS bf16* ARK = (LAS bf16*)(lds + L_ARK); LAS bf16* TM = (LAS bf16*)(lds + L_TM);
    LAS float* SEG = (LAS float*)(lds + L_SEG); LAS float* GC = (LAS float*)(lds + L_GC);
    LAS bf16* WT = (LAS bf16*)(lds + L_WT); LAS bf16* X1T = (LAS bf16*)(lds + L_X1T); LAS bf16* U2T = (LAS bf16*)(lds + L_U2T);
    __syncthreads();
    Prep P; rwkv_prep(a, lds, h, t0, tid, wave, lane, P);
    if ((tid & 7) == 0) ((float*)(a.ws + WS_BON))[(size_t)(t0 + t) * 16 + h] = P.bonus;
#pragma unroll
    for (int j = 0; j < 8; ++j) LW[t * 68 + c8 + j] = P.lw[j];
    __syncthreads();
    { const int cc = tid & 63, sg = tid >> 6; float run = 0.f;
#pragma unroll
      for (int i = 0; i < 8; ++i) { run += LW[(8 * sg + i) * 68 + cc]; LW[(8 * sg + i) * 68 + cc] = run; }
      SEG[sg * 64 + cc] = run; }
    __syncthreads();
    {
        float Lt[8], LC[8];
#pragma unroll
        for (int j = 0; j < 8; ++j) { float off = 0.f, tot = 0.f;
#pragma unroll
            for (int s = 0; s < 8; ++s) { const float sv = SEG[s * 64 + c8 + j]; tot += sv; if (s < (t >> 3)) off += sv; }
            Lt[j] = LW[t * 68 + c8 + j] + off; LC[j] = tot; }
        if (t == 0) {
#pragma unroll
            for (int j = 0; j < 8; ++j) GC[c8 + j] = __expf(LC[j]); }
        float x[8], y[8];
#pragma unroll
        for (int j = 0; j < 8; ++j) x[j] = -P.kk[j] * __expf(Lt[j] - P.lw[j]);
        *(LAS v4u*)(At + t * MP + c8) = pack8(x); st_bf16x8_T(AtT, c8, t, x);
#pragma unroll
        for (int j = 0; j < 8; ++j) { const float e = __expf(-Lt[j]); x[j] = P.b[j] * e; y[j] = P.kp[j] * e; }
        *(LAS v4u*)(Bt + t * MP + c8) = pack8(x); *(LAS v4u*)(Kt + t * MP + c8) = pack8(y);
#pragma unroll
        for (int j = 0; j < 8; ++j) x[j] = P.r[j] * __expf(Lt[j]);
        *(LAS v4u*)(Rt + t * MP + c8) = pack8(x);
#pragma unroll
        for (int j = 0; j < 8; ++j) { const float e = __expf(LC[j] - Lt[j]); x[j] = P.b[j] * e; y[j] = P.kp[j] * e; }
        st_bf16x8_T(BhT, c8, t, x); st_bf16x8_T(KhT, c8, t, y); st_bf16x8_T(VT, c8, t, P.v);
    }
    __syncthreads();
    WTile w; w.ta = wave & 3; w.tb0 = (wave >> 2) * 2; w.fr = lane & 15; w.fq = lane >> 4;
    f32x4 acc[2], Tacc[2];
    ZERO2(Tacc); mm2(At, Bt, w, Tacc); mask2<2>(Tacc, w);
    ZERO2(acc); mm2(Kt, At, w, acc); mask2<0>(acc, w);
    f32x4 rb[2], rk[2]; ZERO2(rb); mm2(Bt, Rt, w, rb); mask2<1>(rb, w); ZERO2(rk); mm2(Kt, Rt, w, rk); mask2<1>(rk, w);
    __syncthreads();
#pragma unroll
    for (int ci = 0; ci < 2; ++ci) { st_N(Pm, w.ta, w.tb0 + ci, w, Tacc[ci]); st_T(PT, w.ta, w.tb0 + ci, w, Tacc[ci]);
        st_T(AAK, w.ta, w.tb0 + ci, w, acc[ci]); st_T(ARB, w.ta, w.tb0 + ci, w, rb[ci]); st_T(ARK, w.ta, w.tb0 + ci, w, rk[ci]);
#pragma unroll
        for (int j = 0; j < 4; ++j) if (16 * w.ta + 4 * w.fq + j == 16 * (w.tb0 + ci) + w.fr) Tacc[ci][j] += 1.f;
        st_N(TM, w.ta, w.tb0 + ci, w, Tacc[ci]); }
    __syncthreads();
#pragma unroll 1
    for (int n = 0; n < 5; ++n) {
        ZERO2(acc); mm2(Pm, PT, w, acc);
        __syncthreads();
#pragma unroll
        for (int ci = 0; ci < 2; ++ci) { if (n < 4) st_N(Pm, w.ta, w.tb0 + ci, w, acc[ci]); st_T(PT, w.ta, w.tb0 + ci, w, acc[ci]); }
        __syncthreads();
        mm2(TM, PT, w, Tacc);
        __syncthreads();
#pragma unroll
        for (int ci = 0; ci < 2; ++ci) st_N(TM, w.ta, w.tb0 + ci, w, Tacc[ci]);
        __syncthreads();
    }
    ZERO2(acc); mm2(TM, AtT, w, acc); ZERO2(rb); mm2(AAK, VT, w, rb);
#pragma unroll
    for (int ci = 0; ci < 2; ++ci) { st_T(WT, w.ta, w.tb0 + ci, w, acc[ci]); st_T(X1T, w.ta, w.tb0 + ci, w, rb[ci]); }
    __syncthreads();
    const size_t ub = (size_t)unit * 4096;
    { ZERO2(acc); mm2(TM, X1T, w, acc);
#pragma unroll
      for (int ci = 0; ci < 2; ++ci) st_T(U2T, w.ta, w.tb0 + ci, w, acc[ci]);
      bf16* MF = (bf16*)(a.ws + WS_MF) + ub; bf16* QF = (bf16*)(a.ws + WS_QF) + ub;
      ZERO2(acc); mm2(WT, BhT, w, acc);
      ZERO2(rb); mm2(WT, ARB, w, rb);
#pragma unroll
      for (int ci = 0; ci < 2; ++ci) { const int tb = w.tb0 + ci; const int col = 16 * tb + w.fr; const float gc = GC[col];
          f32x4 m = acc[ci];
#pragma unroll
          for (int j = 0; j < 4; ++j) if (16 * w.ta + 4 * w.fq + j == col) m[j] += gc;
          const size_t fo = (size_t)((tb * 2 + (w.ta >> 1)) * 64 + lane) * 8 + 4 * (w.ta & 1);
          v2u o; o.x = pk2(m[0], m[1]); o.y = pk2(m[2], m[3]); *(v2u*)(MF + fo) = o;
          const v2u rr = *(const LAS v2u*)(Rt + col * MP + 16 * w.ta + 4 * w.fq);
          f32x4 q = rb[ci]; q[0] += bflo(rr.x); q[1] += bfhi(rr.x); q[2] += bflo(rr.y); q[3] += bfhi(rr.y);
          o.x = pk2(q[0], q[1]); o.y = pk2(q[2], q[3]); *(v2u*)(QF + fo) = o; } }
    __syncthreads();
    { float* NF = (float*)((unsigned char*)a.out + OUT_NF) + ub; float* Y2 = (float*)((unsigned char*)a.out + OUT_Y2) + ub;
      ZERO2(acc); mm2(BhT, U2T, w, acc); mm2(KhT, VT, w, acc);
      ZERO2(rb); mm2(U2T, ARB, w, rb); mm2(VT, ARK, w, rb);
#pragma unroll
      for (int ci = 0; ci < 2; ++ci) { const int tb = w.tb0 + ci;
          *(f32x4*)(NF + (size_t)((tb * 4 + w.ta) * 64 + lane) * 4) = acc[ci];
          *(f32x4*)(Y2 + (size_t)(16 * tb + w.fr) * 64 + 16 * w.ta + 4 * w.fq) = rb[ci]; } }
}

constexpr int KR = 4, NR = NCH / KR, SLOT = 12288, RBUF = KR * SLOT, NPIECE = RBUF / 16, LPT = 7;
__device__ __forceinline__ const v4u* sp_src(const Args& a, int h, int cg, int r, int p) {
    const int cc = p / 768, q = p % 768, c = r * KR + cc; const size_t ub = (size_t)(c * 16 + h) * 4096;
    return q < 512 ? (const v4u*)((const bf16*)(a.ws + WS_MF) + ub) + q : (const v4u*)((const float*)((const unsigned char*)a.out + OUT_NF) + ub + cg * 1024) + (q - 512);
}
__device__ __forceinline__ void state_pass(const Args& a, LAS unsigned char* lds, int b, int tid, int wave, int lane) {
    const int h = b >> 2, cg = b & 3, lt = tid - 64;
    v4u ra[LPT], rb[LPT];
    if (wave != 0) {
#pragma unroll
        for (int i = 0; i < LPT; ++i) { const int p = lt + 448 * i; if (p < NPIECE) ra[i] = *sp_src(a, h, cg, 0, p); }
#pragma unroll
        for (int i = 0; i < LPT; ++i) { const int p = lt + 448 * i; if (p < NPIECE) *(LAS v4u*)(lds + p * 16) = ra[i]; }
#pragma unroll
        for (int i = 0; i < LPT; ++i) { const int p = lt + 448 * i; if (p < NPIECE) ra[i] = *sp_src(a, h, cg, 1, p); }
    }
    f32x4 st[4];
#pragma unroll
    for (int i = 0; i < 4; ++i) st[i] = (f32x4){0.f, 0.f, 0.f, 0.f};
    __syncthreads();
    bf16* SF = (bf16*)(a.ws + WS_SF);
#define SP_ROUND(r_, RA, RB) do { \
        if (wave != 0) { \
            if ((r_) + 2 < NR) { _Pragma("unroll") for (int i = 0; i < LPT; ++i) { const int p = lt + 448 * i; if (p < NPIECE) RB[i] = *sp_src(a, h, cg, (r_) + 2, p); } } \
            if ((r_) + 1 < NR) { _Pragma("unroll") for (int i = 0; i < LPT; ++i) { const int p = lt + 448 * i; if (p < NPIECE) *(LAS v4u*)(lds + (((r_) + 1) & 1) * RBUF + p * 16) = RA[i]; } } \
        } else { \
            _Pragma("unroll") for (int cc = 0; cc < KR; ++cc) { \
                const LAS unsigned char* sl = lds + ((r_) & 1) * RBUF + cc * SLOT; const int c = (r_) * KR + cc; \
                v4u b0, b1; b0.x = pk2(st[0][0], st[0][1]); b0.y = pk2(st[0][2], st[0][3]); b0.z = pk2(st[1][0], st[1][1]); b0.w = pk2(st[1][2], st[1][3]); \
                b1.x = pk2(st[2][0], st[2][1]); b1.y = pk2(st[2][2], st[2][3]); b1.z = pk2(st[3][0], st[3][1]); b1.w = pk2(st[3][2], st[3][3]); \
                v4u* sfo = (v4u*)(SF + (size_t)(c * 16 + h) * 4096) + (cg * 2) * 64 + lane; sfo[0] = b0; sfo[64] = b1; \
                const bf16x8 f0 = __builtin_bit_cast(bf16x8, b0), f1 = __builtin_bit_cast(bf16x8, b1); \
                _Pragma("unroll") for (int rt = 0; rt < 4; ++rt) { \
                    f32x4 n = *(const LAS f32x4*)(sl + 8192 + (rt * 64 + lane) * 16); \
                    n = MFMA16(*(const LAS bf16x8*)(sl + ((rt * 2 + 0) * 64 + lane) * 16), f0, n); \
                    n = MFMA16(*(const LAS bf16x8*)(sl + ((rt * 2 + 1) * 64 + lane) * 16), f1, n); st[rt] = n; } \
            } \
        } \
        __syncthreads(); } while (0)
#pragma unroll 1
    for (int r = 0; r < NR; r += 2) { SP_ROUND(r, ra, rb); SP_ROUND(r + 1, rb, ra); }
#undef SP_ROUND
}

__device__ __forceinline__ void rwkv_out_unit(const Args& a, LAS unsigned char* lds, int unit, int tid, int wave, int lane) {
    const int c = unit >> 4, h = unit & 15, t0 = c * CH, t = tid >> 3, c8 = (tid & 7) * 8, ch = h * 64 + c8;
    const size_t ub = (size_t)unit * 4096;
    const bf16* QF = (const bf16*)(a.ws + WS_QF) + ub; const bf16* SF = (const bf16*)(a.ws + WS_SF) + ub; const float* Y2 = (const float*)((const unsigned char*)a.out + OUT_Y2) + ub;
    LAS float* SY = (LAS float*)lds;
    const int ta = wave & 3, tb0 = (wave >> 2) * 2, fr = lane & 15, fq = lane >> 4;
    f32x4 acc[2]; ZERO2(acc);
#pragma unroll
    for (int s = 0; s < 2; ++s) { const bf16x8 af = *(const bf16x8*)(QF + (size_t)((ta * 2 + s) * 64 + lane) * 8);
#pragma unroll
        for (int ci = 0; ci < 2; ++ci) acc[ci] = MFMA16(af, *(const bf16x8*)(SF + (size_t)(((tb0 + ci) * 2 + s) * 64 + lane) * 8), acc[ci]); }
    __syncthreads();
#pragma unroll
    for (int ci = 0; ci < 2; ++ci)
#pragma unroll
        for (int j = 0; j < 4; ++j) SY[(16 * ta + 4 * fq + j) * 68 + 16 * (tb0 + ci) + fr] = acc[ci][j];
    __syncthreads();
    float y[8], y2[8], v[8], g[8];
    ld8f(Y2 + t * 64 + c8, y2);
#pragma unroll
    for (int j = 0; j < 8; ++j) y[j] = SY[t * 68 + c8 + j] + y2[j];
    const bf16* proj = (const bf16*)(a.ws + WS_PROJ);
    load_shift8(proj, t0 + t, C_V + ch, a.in[3], v); load_shift8(proj, t0 + t, C_G + ch, a.in[3], g);
    const float bonus = ((const float*)(a.ws + WS_BON))[(size_t)(t0 + t) * 16 + h];
    rwkv_out8(a, y, v, g, bonus, t0 + t, ch);
}
#ifndef ONE_LAUNCH
#define ONE_LAUNCH 1
#endif
constexpr int NPHASE = 7;
__global__ void __launch_bounds__(NTHR, 2) mega(Args a) {
    extern __shared__ __attribute__((aligned(16))) unsigned char lds_[];
    LAS unsigned char* lds = (LAS unsigned char*)lds_;
    const int tid = threadIdx.x, lane = tid & 63, wave = __builtin_amdgcn_readfirstlane(tid >> 6);
    const int G = gridDim.x, bx = blockIdx.x, vcu = (G % 8 == 0) ? (bx % 8) * (G / 8) + bx / 8 : bx;
    cg::grid_group grid = cg::this_grid();
#define IN(k) (a.ph_lo <= (k) && (k) < a.ph_hi)
#define SEAM(k) do { if (IN(k) && IN((k) + 1)) grid.sync(); } while (0)
    if (IN(0)) { p0_prologue(a, lds, vcu, G, wave, lane); }
    SEAM(0);
    if (IN(1)) {
        pg8::Gemm g{(const pg8::bf16_t*)(a.ws + WS_XN), (const pg8::bf16_t*)(a.ws + WS_WTIN), T, NINP, D}; pg8::StaticOrder S; S.init(T, NINP, G, bx);
        pg8::EpiBf16<0> E{(pg8::bf16_t*)(a.ws + WS_PROJ), NINP, nullptr, 0, 0, 1.f};
        pg8::gemm_phase<pg8::EpiBf16<0>, pg8::StaticOrder, true, true>(lds, g, S, E);
    }
    SEAM(1);
    if (IN(2)) {
        for (int it = bx; it < 512; it += G) attn_unit(a, lds, it, tid, wave, lane);
        for (int it = bx; it < NCH * NH; it += G) rwkv_chunk_prep(a, lds, it, tid, wave, lane);
    }
    SEAM(2);
    if (IN(3)) { if (bx < 64) state_pass(a, lds, bx, tid, wave, lane); }
    SEAM(3);
    if (IN(4)) { for (int u = bx; u < NCH * NH; u += G) rwkv_out_unit(a, lds, u, tid, wave, lane); }
    SEAM(4);
    if (IN(5)) {
        pg8::Gemm g{(const pg8::bf16_t*)(a.ws + WS_MIX), (const pg8::bf16_t*)(a.ws + WS_WTOUT), T, D, D}; pg8::StaticOrder S; S.init(T, D, G, bx);
        pg8::EpiResid E{a.in[0], a.out, (float*)(a.ws + WS_SSP), D};
        pg8::gemm_phase<pg8::EpiResid, pg8::StaticOrder, true, true>(lds, g, S, E);
    }
    SEAM(5);
    if (IN(6)) final_norm(a, vcu, G, wave, lane);
#undef IN
#undef SEAM
}

extern "C" void kernel_launch(void* const* d_in, const int* in_sizes, int n_in, void* d_out, int out_size, void* d_ws, size_t ws_size, hipStream_t stream) {
    static int grid = 0;
    if (grid == 0) {
        int dev = 0, cus = 0;
        if (hipGetDevice(&dev) != hipSuccess || hipDeviceGetAttribute(&cus, hipDeviceAttributeMultiprocessorCount, dev) != hipSuccess) { fprintf(stderr, "kernel_launch: device query failed\n"); grid = -1; return; }
        if (hipFuncSetAttribute((const void*)mega, hipFuncAttributeMaxDynamicSharedMemorySize, LDS_BYTES) != hipSuccess) { fprintf(stderr, "kernel_launch: hipFuncSetAttribute failed\n"); grid = -1; return; }
        (void)hipGetLastError();
        grid = cus;
    }
    if (grid < 0) return;
    Args a{};
    for (int i = 0; i < 16; ++i) a.in[i] = (const float*)d_in[i];
    a.out = (float*)d_out; a.ws = (unsigned char*)d_ws;
#if ONE_LAUNCH
    a.ph_lo = 0; a.ph_hi = NPHASE;
    void* args[] = {&a};
    hipError_t e = hipLaunchCooperativeKernel((const void*)mega, dim3(grid), dim3(NTHR), args, LDS_BYTES, stream);
    if (e != hipSuccess) fprintf(stderr, "cooperative launch failed: %s (grid %d)\n", hipGetErrorString(e), grid);
#else
    for (int p = 0; p < NPHASE; ++p) { a.ph_lo = p; a.ph_hi = p + 1; hipLaunchKernelGGL(mega, dim3(grid), dim3(NTHR), LDS_BYTES, stream, a); }
#endif
}
```

```cpp
#define ONE 1
#include <hip/hip_runtime.h>
#include <hip/hip_cooperative_groups.h>
#include <cstdio>
#include <cstdint>
namespace cg = cooperative_groups;
namespace pg8 {
#define PG8_LAS __attribute__((address_space(3)))
typedef unsigned short bf16_t;
typedef short bf16x8 __attribute__((ext_vector_type(8)));
typedef float f32x4 __attribute__((ext_vector_type(4)));
typedef unsigned u32x4 __attribute__((ext_vector_type(4)));
constexpr int BM = 256, BK = 64, HALF = 128, HTB = HALF * BK * 2  , STAGE_BYTES = 8 * HTB, NXCD = 8, WGM = 8;

__host__ __device__ __forceinline__ int lds_byte(int r, int c) { const int st = (r >> 4) * 2 + (c >> 5), rr = r & 15, cc = c & 31, ob = rr * 64 + cc * 2; return st * 1024 + (ob ^ (((ob >> 9) & 1) << 5)); }
__host__ __device__ __forceinline__ void stage_rc(int b, int& R, int& C) { const int st = b / 1024, sb = b % 1024, swz = sb ^ (((sb >> 9) & 1) << 5); R = (st >> 1) * 16 + swz / 64; C = (st & 1) * 32 + (swz % 64) / 2; }
__host__ __device__ __forceinline__ int perm32(int rho) { const int n = rho >> 4, i = rho & 15; return 8 * (i >> 2) + 4 * n + (i & 3); }

struct Unit { int pm, pn; };
struct Gemm { const bf16_t* A; const bf16_t* Bt; int M, N, K; };

struct StaticOrder {
    int nM, nN, nwg, G, c;
    __host__ __device__ void init(int M, int N, int G_, int c_) { nM = M / BM; nN = N / BM; nwg = nM * nN; G = G_; c = c_; }
    __host__ __device__ bool next(int i, Unit& u) const {
        const long L = (long)i * G + c; if (L >= nwg) return false;
        int wgid = (int)L; { const int q = nwg / NXCD, r = nwg % NXCD, xcd = wgid % NXCD, off = wgid / NXCD; wgid = (xcd < r ? xcd * (q + 1) : r * (q + 1) + (xcd - r) * q) + off; }
        const int nig = WGM * nN, gid = wgid / nig, fm = gid * WGM, gsz = (nM - fm) < WGM ? (nM - fm) : WGM;
        u.pm = fm + ((wgid % nig) % gsz); u.pn = (wgid % nig) / gsz; return true;
    }
    __device__ __forceinline__ void a_ready(const Unit&) const {}
    __device__ __forceinline__ void done(const Unit&) const {}
};

__device__ __forceinline__ unsigned cvt_pk_bf16(float lo, float hi) { unsigned r; asm volatile("v_cvt_pk_bf16_f32 %0, %1, %2" : "=v"(r) : "v"(lo), "v"(hi)); return r; }
typedef float f32x2 __attribute__((ext_vector_type(2)));
__device__ __forceinline__ f32x2 gelu_pk(f32x2 v) {
    const f32x2 av = __builtin_elementwise_abs(v), d = av * 0.2316418882f + 1.0f;
    f32x2 t; t.x = __builtin_amdgcn_rcpf(d.x); t.y = __builtin_amdgcn_rcpf(d.y);
    f32x2 q = t * 0.5307027145f + (-0.7265760135f); q = q * t + 0.7107068705f; q = q * t + (-0.142248368f); q = q * t + 0.127414796f; q = q * t;
    const f32x2 s = (v * v) * (-0.72134752044f);
    f32x2 e; e.x = __builtin_amdgcn_exp2f(s.x); e.y = __builtin_amdgcn_exp2f(s.y);
    const f32x2 m = v * (q * e), r = v - m;
    f32x2 o; o.x = v.x < 0.f ? m.x : r.x; o.y = v.y < 0.f ? m.y : r.y; return o;
}

template <int ACT  > struct EpiBf16 {
    static constexpr bool PERM = true, AFTER_DRAIN = false; static_assert(ACT == 0 || ACT == 1, "EpiBf16: ACT is 0 (none) or 1 (gelu_pk)");
    bf16_t* O; int ldc; const float* bias; int split_cols; size_t split_stride; float scale0;
    __device__ __forceinline__ void operator()(const f32x4 (&acc)[2][2][4][2], const Unit& u, int wr, int wc, int fr, int fq) const {
        const int row0 = u.pm * BM + wr * 64 + fr; int colt = u.pn * BM; bf16_t* base = O;
        float sc = 1.f; if (split_cols) { const int t = colt / split_cols; base += (size_t)t * split_stride; colt -= t * split_cols; if (t == 0) sc = scale0; }
        const int col0 = colt + wc * 32 + 8 * fq, bcol0 = u.pn * BM + wc * 32 + 8 * fq;
        f32x4 bv[2][2];
#pragma unroll
        for (int bj = 0; bj < 2; ++bj)
#pragma unroll
            for (int n = 0; n < 2; ++n) bv[bj][n] = bias ? *(const f32x4*)(bias + bcol0 + bj * HALF + 4 * n) : (f32x4){0.f, 0.f, 0.f, 0.f};
#pragma unroll
        for (int ai = 0; ai < 2; ++ai)
#pragma unroll
            for (int m = 0; m < 4; ++m) { bf16_t* rowp = base + (size_t)(row0 + ai * HALF + m * 16) * ldc + col0;
#pragma unroll
                for (int bj = 0; bj < 2; ++bj) { f32x4 v0 = acc[ai][bj][m][0] + bv[bj][0], v1 = acc[ai][bj][m][1] + bv[bj][1];
                    if (ACT == 1) { f32x2 a = gelu_pk((f32x2){v0[0], v0[1]}), b = gelu_pk((f32x2){v0[2], v0[3]}), c = gelu_pk((f32x2){v1[0], v1[1]}), d = gelu_pk((f32x2){v1[2], v1[3]});
                        v0 = (f32x4){a.x, a.y, b.x, b.y}; v1 = (f32x4){c.x, c.y, d.x, d.y}; }
                    v0 = v0 * sc; v1 = v1 * sc; u32x4 w; w.x = cvt_pk_bf16(v0[0], v0[1]); w.y = cvt_pk_bf16(v0[2], v0[3]); w.z = cvt_pk_bf16(v1[0], v1[1]); w.w = cvt_pk_bf16(v1[2], v1[3]);
                    *(u32x4*)(rowp + bj * HALF) = w; } }
    }
};
struct EpiResid {
    static constexpr bool PERM = false, AFTER_DRAIN = false;
    const float* x; float* out; float* sspart; int ldc;
    __device__ __forceinline__ void operator()(const f32x4 (&acc)[2][2][4][2], const Unit& u, int wr, int wc, int fr, int fq) const {
        const int row0 = u.pm * BM + wr * 64 + fr, col0 = u.pn * BM + wc * 32 + 4 * fq;
#pragma unroll
        for (int ai = 0; ai < 2; ++ai)
#pragma unroll
            for (int m = 0; m < 4; ++m) {
                const int row = row0 + ai * HALF + m * 16; float ss = 0.f;
#pragma unroll
                for (int bj = 0; bj < 2; ++bj)
#pragma unroll
                    for (int n = 0; n < 2; ++n) {
                        const size_t off = (size_t)row * ldc + col0 + bj * HALF + n * 16;
                        const f32x4 xv = *(const f32x4*)(x + off); const f32x4 v = acc[ai][bj][m][n] + xv;
                        *(f32x4*)(out + off) = v; ss += (v[0] * v[0] + v[1] * v[1]) + (v[2] * v[2] + v[3] * v[3]);
                    }
                ss += __shfl_xor(ss, 16); ss += __shfl_xor(ss, 32);
                if (fq == 0) sspart[(size_t)row * 32 + u.pn * 4 + wc] = ss;
            }
    }
};

template <class Epi, class Sched, bool ALIGN_EPI = false, bool SP2 = false>
__device__ __forceinline__ void gemm_phase(PG8_LAS unsigned char* lds, const Gemm g, const Sched& S, const Epi& E) {
    const int tid = threadIdx.x, wid = __builtin_amdgcn_readfirstlane(tid >> 6), lane = tid & 63, wr = wid >> 2, wc = wid & 3, fr = lane & 15, fq = lane >> 4;
    const int K = g.K, nt = K / BK;
    unsigned voffA[2], voffB[2];
#pragma unroll
    for (int i = 0; i < 2; ++i) { int R, C; stage_rc(tid * 16 + i * 8192, R, C); const int Rb = Epi::PERM ? ((R & ~31) + perm32(R & 31)) : R;
        voffA[i] = (unsigned)(R * K + C) * 2u; voffB[i] = (unsigned)(Rb * K + C) * 2u; }
    const size_t kstep = (size_t)(BK * 2);
    const size_t hstep = (size_t)HALF * K * 2;
    const size_t tstep = 2 * hstep;
    const unsigned ldsw = (unsigned)wid * 1024u;
    const int aoff = lds_byte(wr * 64 + fr, fq * 8), boff = lds_byte(wc * 32 + fr, fq * 8);
#define PG8_SA(b, h) (((b) * 2 + (h)) * HTB)
#define PG8_SB(b, h) ((4 + (b) * 2 + (h)) * HTB)
#define PG8_STAGE(bufoff, gbase, voff) do { _Pragma("unroll") for (int _i = 0; _i < 2; ++_i) \
        __builtin_amdgcn_global_load_lds((const unsigned*)((const char*)(gbase) + (voff)[_i]), (PG8_LAS unsigned*)(lds + (bufoff) + ldsw + _i * 8192), 16, 0, 0); } while (0)
#define PG8_LDA(dst, b, h) do { _Pragma("unroll") for (int m = 0; m < 4; ++m) _Pragma("unroll") for (int k = 0; k < 2; ++k) dst[m][k] = *(const PG8_LAS bf16x8*)(lds + PG8_SA(b, h) + aoff + m * 2048 + k * 1024); } while (0)
#define PG8_LDB(dst, b, h) do { _Pragma("unroll") for (int n = 0; n < 2; ++n) _Pragma("unroll") for (int k = 0; k < 2; ++k) dst[n][k] = *(const PG8_LAS bf16x8*)(lds + PG8_SB(b, h) + boff + n * 2048 + k * 1024); } while (0)
#define PG8_MMA(ai, bj, At, Bt) do { __builtin_amdgcn_s_setprio(1); _Pragma("unroll") for (int m = 0; m < 4; ++m) _Pragma("unroll") for (int n = 0; n < 2; ++n) _Pragma("unroll") for (int k = 0; k < 2; ++k) \
        acc[ai][bj][m][n] = __builtin_amdgcn_mfma_f32_16x16x32_bf16(Bt[n][k], At[m][k], acc[ai][bj][m][n], 0, 0, 0); __builtin_amdgcn_s_setprio(0); } while (0)
#define PG8_WAIT_V(n) asm volatile("s_waitcnt vmcnt(" #n ")" ::: "memory")
#define PG8_WAIT_L(n) asm volatile("s_waitcnt lgkmcnt(" #n ")" ::: "memory")
#define PG8_BAR __builtin_amdgcn_s_barrier()
#define PG8_SCHED __builtin_amdgcn_sched_barrier(0)
    Unit cur, nxt; int ui = 0;
    if (!S.next(0, cur)) return;
    f32x4 acc[2][2][4][2];
#pragma unroll
    for (int a = 0; a < 2; ++a)
#pragma unroll
        for (int b = 0; b < 2; ++b)
#pragma unroll
            for (int m = 0; m < 4; ++m)
#pragma unroll
                for (int n = 0; n < 2; ++n) acc[a][b][m][n] = (f32x4){0.f, 0.f, 0.f, 0.f};
    bf16x8 At[4][2], B0[2][2], B1[2][2];
    const char* cA = (const char*)g.A + (size_t)cur.pm * tstep; const char* cB = (const char*)g.Bt + (size_t)cur.pn * tstep;
    S.a_ready(cur);
    if constexpr (SP2) {
        PG8_STAGE(PG8_SB(0, 0), cB, voffB); PG8_STAGE(PG8_SB(0, 1), cB + hstep, voffB); PG8_STAGE(PG8_SA(0, 0), cA, voffA); PG8_STAGE(PG8_SA(0, 1), cA + hstep, voffA);
        if (wr == 1) PG8_BAR;
        PG8_WAIT_V(2); PG8_BAR;
        PG8_STAGE(PG8_SB(1, 0), cB + kstep, voffB); PG8_STAGE(PG8_SA(1, 0), cA + kstep, voffA); PG8_STAGE(PG8_SB(1, 1), cB + hstep + kstep, voffB);
        PG8_WAIT_V(6); PG8_BAR;
    } else {
        PG8_STAGE(PG8_SB(0, 0), cB, voffB); PG8_STAGE(PG8_SA(0, 0), cA, voffA); PG8_STAGE(PG8_SB(0, 1), cB + hstep, voffB); PG8_STAGE(PG8_SA(0, 1), cA + hstep, voffA);
        if (wr == 1) PG8_BAR;
        PG8_WAIT_V(4); PG8_BAR;
        PG8_STAGE(PG8_SB(1, 0), cB + kstep, voffB); PG8_STAGE(PG8_SA(1, 0), cA + kstep, voffA); PG8_STAGE(PG8_SB(1, 1), cB + hstep + kstep, voffB);
        PG8_WAIT_V(6); PG8_BAR;
    }
    for (;;) {
        const bool has_next = S.next(ui + 1, nxt);
        const char* nA = has_next ? (const char*)g.A + (size_t)nxt.pm * tstep : cA; const char* nB = has_next ? (const char*)g.Bt + (size_t)nxt.pn * tstep : cB;
        for (int t = 0; t < nt; t += 2) {
            const bool last = (t == nt - 2);
            const char* a1 = cA + (size_t)(t + 1) * kstep;
            const char* a2 = last ? nA : cA + (size_t)(t + 2) * kstep; const char* b2 = last ? nB : cB + (size_t)(t + 2) * kstep;
            const char* a3 = a2 + kstep; const char* b3 = b2 + kstep;
            if (last && has_next) S.a_ready(nxt);
            if constexpr (SP2) {
            PG8_LDB(B0, 0, 0); PG8_LDB(B1, 0, 1); PG8_SCHED; PG8_LDA(At, 0, 0); PG8_STAGE(PG8_SA(1, 1), a1 + hstep, voffA);
            PG8_WAIT_V(8); PG8_WAIT_L(0); PG8_BAR; PG8_MMA(0, 0, At, B0); PG8_MMA(0, 1, At, B1); PG8_BAR; PG8_SCHED;
            PG8_LDA(At, 0, 1); PG8_STAGE(PG8_SB(0, 0), b2, voffB); PG8_STAGE(PG8_SB(0, 1), b2 + hstep, voffB); PG8_STAGE(PG8_SA(0, 0), a2, voffA);
            PG8_WAIT_V(8); PG8_WAIT_L(0); PG8_BAR; PG8_MMA(1, 0, At, B0); PG8_MMA(1, 1, At, B1); PG8_BAR; PG8_SCHED;
            PG8_LDB(B0, 1, 0); PG8_LDB(B1, 1, 1); PG8_SCHED; PG8_LDA(At, 1, 0); PG8_STAGE(PG8_SA(0, 1), a2 + hstep, voffA);
            PG8_WAIT_V(8); PG8_WAIT_L(0); PG8_BAR; PG8_MMA(0, 0, At, B0); PG8_MMA(0, 1, At, B1); PG8_BAR; PG8_SCHED;
            PG8_LDA(At, 1, 1); PG8_STAGE(PG8_SB(1, 0), b3, voffB); PG8_STAGE(PG8_SB(1, 1), b3 + hstep, voffB); PG8_STAGE(PG8_SA(1, 0), a3, voffA);
            PG8_WAIT_V(8); PG8_WAIT_L(0); PG8_BAR; PG8_MMA(1, 0, At, B0); PG8_MMA(1, 1, At, B1); PG8_BAR; PG8_SCHED;
            } else {
            PG8_LDB(B0, 0, 0); PG8_SCHED; PG8_LDA(At, 0, 0); PG8_STAGE(PG8_SA(1, 1), a1 + hstep, voffA);
            PG8_WAIT_L(8); PG8_BAR; PG8_WAIT_L(0); PG8_MMA(0, 0, At, B0); PG8_BAR; PG8_SCHED;
            PG8_LDB(B1, 0, 1); PG8_STAGE(PG8_SB(0, 0), b2, voffB);
            PG8_BAR; PG8_WAIT_L(0); PG8_MMA(0, 1, At, B1); PG8_BAR;
            PG8_LDA(At, 0, 1); PG8_STAGE(PG8_SA(0, 0), a2, voffA);
            PG8_BAR; PG8_WAIT_L(0); PG8_MMA(1, 0, At, B0); PG8_BAR; PG8_SCHED;
            PG8_STAGE(PG8_SB(0, 1), b2 + hstep, voffB);
            PG8_WAIT_V(6); PG8_BAR; PG8_MMA(1, 1, At, B1); PG8_BAR;
            PG8_LDB(B0, 1, 0); PG8_SCHED; PG8_LDA(At, 1, 0); PG8_STAGE(PG8_SA(0, 1), a2 + hstep, voffA);
            PG8_WAIT_L(8); PG8_BAR; PG8_WAIT_L(0); PG8_MMA(0, 0, At, B0); PG8_BAR; PG8_SCHED;
            PG8_LDB(B1, 1, 1); PG8_STAGE(PG8_SB(1, 0), b3, voffB);
            PG8_BAR; PG8_WAIT_L(0); PG8_MMA(0, 1, At, B1); PG8_BAR;
            PG8_LDA(At, 1, 1); PG8_STAGE(PG8_SA(1, 0), a3, voffA);
            PG8_BAR; PG8_WAIT_L(0); PG8_MMA(1, 0, At, B0); PG8_BAR; PG8_SCHED;
            PG8_STAGE(PG8_SB(1, 1), b3 + hstep, voffB);
            PG8_WAIT_V(6); PG8_BAR; PG8_MMA(1, 1, At, B1); PG8_BAR;
            }
        }
        if constexpr (ALIGN_EPI) { if (wr == 0) PG8_BAR; }
        if constexpr (!Epi::AFTER_DRAIN) { E(acc, cur, wr, wc, fr, fq); S.done(cur); }
        if (!has_next) break;
#pragma unroll
        for (int a = 0; a < 2; ++a)
#pragma unroll
            for (int b = 0; b < 2; ++b)
#pragma unroll
                for (int m = 0; m < 4; ++m)
#pragma unroll
                    for (int n = 0; n < 2; ++n) acc[a][b][m][n] = (f32x4){0.f, 0.f, 0.f, 0.f};
        cur = nxt; cA = nA; cB = nB; ++ui;
        if constexpr (ALIGN_EPI) { if (wr == 1) PG8_BAR; }
    }
    PG8_WAIT_V(0);
    if constexpr (!ALIGN_EPI) { if (wr == 0) PG8_BAR; }
    PG8_BAR;
    if constexpr (Epi::AFTER_DRAIN) { E.fused(acc, cur, wr, wc, fr, fq, lds, wid, lane); S.done(cur); }
#undef PG8_SA
#undef PG8_SB
#undef PG8_STAGE
#undef PG8_LDA
#undef PG8_LDB
#undef PG8_MMA
#undef PG8_WAIT_V
#undef PG8_WAIT_L
#undef PG8_BAR
#undef PG8_SCHED
}
}
constexpr int T = 8192, D = 2048, NIN = 6528, NINP = 6656, RW = 1024, NH = 16, HD = 64, CH = 64, NCH = T / CH;
constexpr int C_R = 0, C_K = 1024, C_V = 2048, C_WD = 3072, C_AD = 3136, C_G = 3200, C_AQ = 4224, C_AK = 5248, C_AV = 5376, C_AG = 5504;
constexpr float RMS_EPS = 1e-5f, LNX_EPS = 64e-5f;
constexpr int NWAVES = 8, NTHR = 512;
constexpr size_t MiB = 1u << 20;
constexpr size_t WS_WTIN = 1 * MiB;
constexpr size_t WS_XN = 27 * MiB;
constexpr size_t WS_WTOUT = 59 * MiB;
constexpr size_t WS_UPT = 67 * MiB;
constexpr size_t WS_SSP = 68 * MiB;
constexpr size_t WS_PROJ = 70 * MiB;
constexpr size_t WS_SCR = 174 * MiB;
constexpr size_t WS_MIX = 1 * MiB;
constexpr int LDS_BYTES = 147456;

#define GAS __attribute__((address_space(1)))
#define LAS __attribute__((address_space(3)))
typedef unsigned short bf16;
typedef unsigned v4u __attribute__((ext_vector_type(4)));
typedef unsigned v2u __attribute__((ext_vector_type(2)));
typedef float f32x4 __attribute__((ext_vector_type(4)));
typedef float f32x16 __attribute__((ext_vector_type(16)));
typedef short bf16x8 __attribute__((ext_vector_type(8)));
typedef __bf16 bf16x2_t __attribute__((ext_vector_type(2)));
__device__ __forceinline__ unsigned pk2(float a, float b) { bf16x2_t v; v[0] = (__bf16)a; v[1] = (__bf16)b; return __builtin_bit_cast(unsigned, v); }
__device__ __forceinline__ float bflo(unsigned u) { return __uint_as_float(u << 16); }
__device__ __forceinline__ float bfhi(unsigned u) { return __uint_as_float(u & 0xffff0000u); }
__device__ __forceinline__ void unpack8(const v4u& p, float (&f)[8]) { f[0] = bflo(p.x); f[1] = bfhi(p.x); f[2] = bflo(p.y); f[3] = bfhi(p.y); f[4] = bflo(p.z); f[5] = bfhi(p.z); f[6] = bflo(p.w); f[7] = bfhi(p.w); }
__device__ __forceinline__ v4u pack8(const float (&f)[8]) { v4u o; o.x = pk2(f[0], f[1]); o.y = pk2(f[2], f[3]); o.z = pk2(f[4], f[5]); o.w = pk2(f[6], f[7]); return o; }
__device__ __forceinline__ float wave_sum(float v) {
#pragma unroll
    for (int o = 1; o < 64; o <<= 1) v += __shfl_xor(v, o);
    return v;
}
__device__ __forceinline__ float sum8(float v) { v += __shfl_xor(v, 1); v += __shfl_xor(v, 2); v += __shfl_xor(v, 4); return v; }
__device__ __forceinline__ float sigmoidf_(float x) { return 1.f / (1.f + __expf(-x)); }
__device__ __forceinline__ float siluf_(float x) { return x / (1.f + __expf(-x)); }

__device__ __forceinline__ void bar_lds() { asm volatile("s_waitcnt lgkmcnt(0)" ::: "memory"); __builtin_amdgcn_s_barrier(); asm volatile("" ::: "memory"); }
struct Args { const float* in[16]; float* out; unsigned char* ws; int ph_lo, ph_hi; };

__device__ __forceinline__ void p0_transpose_item(const float* W, int K, int N, bf16* WT, LAS float* scr, int item, int lane) {
    const int nblk = N / 32, kb = item / nblk, nb = item % nblk, k0 = 64 * kb, n0 = 32 * nb;
    { f32x4 v[8];
#pragma unroll
      for (int i = 0; i < 8; ++i) v[i] = *(const f32x4*)(W + (size_t)(k0 + 8 * i + (lane >> 3)) * N + n0 + 4 * (lane & 7));
#pragma unroll
      for (int i = 0; i < 8; ++i) { LAS float* d = scr + (8 * i + (lane >> 3)) * 33 + 4 * (lane & 7); d[0] = v[i].x; d[1] = v[i].y; d[2] = v[i].z; d[3] = v[i].w; } }
    asm volatile("s_waitcnt lgkmcnt(0)" ::: "memory");
    const int c = lane & 7;
#pragma unroll
    for (int j = 0; j < 4; ++j) { const int n = (lane >> 3) + 8 * j; const LAS float* s = scr + (8 * c) * 33 + n;
        v4u o; o.x = pk2(s[0 * 33], s[1 * 33]); o.y = pk2(s[2 * 33], s[3 * 33]); o.z = pk2(s[4 * 33], s[5 * 33]); o.w = pk2(s[6 * 33], s[7 * 33]);
        *(v4u*)(WT + (size_t)(n0 + n) * K + k0 + 8 * c) = o; }
    asm volatile("s_waitcnt lgkmcnt(0)" ::: "memory");
}
__device__ __forceinline__ void p0_prologue(const Args& a, LAS unsigned char* lds, int vcu, int G, int wave, int lane) {
    LAS float* scr = (LAS float*)(lds + wave * 16384);
    const int gw = vcu * NWAVES + wave, NGW = G * NWAVES;
    bf16* wtin = (bf16*)(a.ws + WS_WTIN); bf16* wtout = (bf16*)(a.ws + WS_WTOUT); bf16* upt = (bf16*)(a.ws + WS_UPT); bf16* aupt = upt + 65536;
    constexpr int I_IN = (D / 64) * (NIN / 32), I_OUT = (D / 64) * (D / 32), I_UP = RW / 32;
    constexpr int NITEMS = I_IN + I_OUT + 2 * I_UP;
    for (int it = gw; it < NITEMS; it += NGW) {
        int r = it;
        if (r < I_IN) { p0_transpose_item(a.in[2], D, NIN, wtin, scr, r, lane); continue; } r -= I_IN;
        if (r < I_OUT) { p0_transpose_item(a.in[14], D, D, wtout, scr, r, lane); continue; } r -= I_OUT;
        if (r < I_UP) { p0_transpose_item(a.in[5], 64, RW, upt, scr, r, lane); continue; } r -= I_UP;
        p0_transpose_item(a.in[7], 64, RW, aupt, scr, r, lane);
    }
    { v4u z = {0u, 0u, 0u, 0u}; v4u* p = (v4u*)(wtin + (size_t)NIN * D); const int n16 = (NINP - NIN) * D * 2 / 16;
      for (int i = gw * 64 + lane; i < n16; i += NGW * 64) p[i] = z; }
    const float* gain = a.in[1];
    for (int m = gw; m < T; m += 2 * NGW) {
        const int m2 = m + NGW;
        const f32x4* xr = (const f32x4*)(a.in[0] + (size_t)m * D) + lane; const f32x4* xr2 = (const f32x4*)(a.in[0] + (size_t)(m2 < T ? m2 : m) * D) + lane;
        f32x4 v[8], u[8]; float s = 0.f, s2 = 0.f;
#pragma unroll
        for (int j = 0; j < 8; ++j) { v[j] = xr[64 * j]; u[j] = xr2[64 * j]; }
#pragma unroll
        for (int j = 0; j < 8; ++j) { s += (v[j].x * v[j].x + v[j].y * v[j].y) + (v[j].z * v[j].z + v[j].w * v[j].w); s2 += (u[j].x * u[j].x + u[j].y * u[j].y) + (u[j].z * u[j].z + u[j].w * u[j].w); }
        const float rstd = 1.f / sqrtf(wave_sum(s) * (1.f / D) + RMS_EPS), rstd2 = 1.f / sqrtf(wave_sum(s2) * (1.f / D) + RMS_EPS);
        v2u* o8 = (v2u*)((bf16*)(a.ws + WS_XN) + (size_t)m * D) + lane; v2u* o82 = (v2u*)((bf16*)(a.ws + WS_XN) + (size_t)m2 * D) + lane;
#pragma unroll
        for (int j = 0; j < 8; ++j) { const f32x4 g = *((const f32x4*)gain + lane + 64 * j); v2u o; o.x = pk2(v[j].x * rstd * g.x, v[j].y * rstd * g.y); o.y = pk2(v[j].z * rstd * g.z, v[j].w * rstd * g.w); o8[64 * j] = o;
            if (m2 < T) { o.x = pk2(u[j].x * rstd2 * g.x, u[j].y * rstd2 * g.y); o.y = pk2(u[j].z * rstd2 * g.z, u[j].w * rstd2 * g.w); o82[64 * j] = o; } }
    }
}
__device__ __forceinline__ void final_norm(const Args& a, int vcu, int G, int wave, int lane) {
    const int gw = vcu * NWAVES + wave, NGW = G * NWAVES; const float* ssp = (const float*)(a.ws + WS_SSP); const float* gain = a.in[15];
    for (int m = gw; m < T; m += NGW) {
        float s = (lane < 32) ? ssp[(size_t)m * 32 + lane] : 0.f; s = wave_sum(s);
        const float rstd = 1.f / sqrtf(s * (1.f / D) + RMS_EPS);
        f32x4* xr = (f32x4*)(a.out + (size_t)m * D) + lane;
#pragma unroll
        for (int j = 0; j < 8; ++j) { f32x4 v = xr[64 * j]; const f32x4 g = *((const f32x4*)gain + lane + 64 * j); v.x *= rstd * g.x; v.y *= rstd * g.y; v.z *= rstd * g.z; v.w *= rstd * g.w; xr[64 * j] = v; }
    }
}
#define XB_TMO      128
#define XB_XCNT(j)  (256  + 64 * (j))
#define XB_XSUB(j)  (1280 + 64 * (j))
#define XB_XGEN(j)  (2304 + 64 * (j))
#define XB_TOP      3328
#define XB_TOPGEN   3392
#define XCD_BAR_WORDS 3456
#define XB_SPIN_CAP (1u << 18)

__device__ __forceinline__ unsigned xb_ld(unsigned* p)              { return __hip_atomic_load(p, __ATOMIC_RELAXED, __HIP_MEMORY_SCOPE_AGENT); }
__device__ __forceinline__ unsigned xb_add(unsigned* p, unsigned v) { return __hip_atomic_fetch_add(p, v, __ATOMIC_RELAXED, __HIP_MEMORY_SCOPE_AGENT); }
__device__ __forceinline__ unsigned xb_xcc_id() { return (unsigned)__builtin_amdgcn_s_getreg((3 << 11) | 20) & 0xFu; }
#define XB_SPIN(cond, bar) do { unsigned _sp = 0; while (cond) { __builtin_amdgcn_s_sleep(1); \
    if ((++_sp & 255u) == 0u) { if (xb_ld(&(bar)[XB_TMO])) break; if (_sp > XB_SPIN_CAP) { atomicAdd(&(bar)[XB_TMO], 1u); break; } } } } while (0)

struct XcdBarrier {
    unsigned* bar; unsigned x;
    volatile LAS unsigned* st;
};

__device__ __forceinline__ XcdBarrier xcd_barrier_post(unsigned* bar, volatile LAS unsigned* st) {
    XcdBarrier b; b.bar = bar; b.x = xb_xcc_id(); b.st = st;
    if (threadIdx.x == 0) (void)xb_add(&bar[XB_XCNT(b.x)], 1u);
    return b;
}
__device__ __forceinline__ void xcd_barrier_complete(unsigned* bar, unsigned x, unsigned& nloc, unsigned& nx) {
    const unsigned G = gridDim.x * gridDim.y * gridDim.z;
    unsigned sum, cnt, mine, sp = 0u;
    for (;;) {
        sum = 0u; cnt = 0u; mine = 0u;
#pragma unroll
        for (unsigned j = 0; j < 16; ++j) { const unsigned c = xb_ld(&bar[XB_XCNT(j)]); sum += c; cnt += (c > 0u) ? 1u : 0u; mine = (j == x) ? c : mine; }
        if (sum == G) break;
        __builtin_amdgcn_s_sleep(1);
        if ((++sp & 255u) == 0u) { if (xb_ld(&bar[XB_TMO])) break; if (sp > XB_SPIN_CAP) { atomicAdd(&bar[XB_TMO], 1u); break; } }
    }
    nloc = mine > 0u ? mine : 1u; nx = cnt > 0u ? cnt : 1u;
}

__device__ __forceinline__ void xcd_barrier(const XcdBarrier& b) {
    asm volatile("s_waitcnt vmcnt(0)" ::: "memory");
    __syncthreads();
    if (threadIdx.x == 0) {
        unsigned* bar = b.bar;
        __builtin_amdgcn_s_waitcnt(0);
        unsigned nloc = b.st[0], nx = b.st[1];
        if (nloc == 0u) { xcd_barrier_complete(bar, b.x, nloc, nx); b.st[0] = nloc; b.st[1] = nx; }
        const unsigned old = xb_add(&bar[XB_XSUB(b.x)], 1u);
        const unsigned gen = old / nloc;
        if (old + 1u == (gen + 1u) * nloc) {
            __builtin_amdgcn_fence(__ATOMIC_RELEASE, "agent");
            asm volatile("s_waitcnt vmcnt(0)" ::: "memory");
            const unsigned og = xb_add(&bar[XB_TOP], 1u);
            const unsigned tg = og / nx;
            if (og + 1u == (tg + 1u) * nx) xb_add(&bar[XB_TOPGEN], 1u);
            else XB_SPIN(xb_ld(&bar[XB_TOPGEN]) == tg, bar);
            __builtin_amdgcn_fence(__ATOMIC_ACQUIRE, "agent");
            xb_add(&bar[XB_XGEN(b.x)], 1u);
            asm volatile("s_waitcnt vmcnt(0)" ::: "memory");
        } else {
            XB_SPIN(xb_ld(&bar[XB_XGEN(b.x)]) == gen, bar);
            __builtin_amdgcn_fence(__ATOMIC_ACQUIRE, "agent");
            asm volatile("s_waitcnt vmcnt(0)" ::: "memory");
        }
    }
    __syncthreads();
}

#define MFMA32(a_, b_, c_) __builtin_amdgcn_mfma_f32_32x32x16_bf16((a_), (b_), (c_), 0, 0, 0)
#define MFMA16(a_, b_, c_) __builtin_amdgcn_mfma_f32_16x16x32_bf16((a_), (b_), (c_), 0, 0, 0)
__device__ __forceinline__ v4u ldg16(const bf16* p) { return *(const v4u*)p; }
__device__ __forceinline__ void load_shift8(const bf16* proj, int row, int col, const float* mu, float (&o)[8]) {
    const v4u p = ldg16(proj + (size_t)row * NINP + col); v4u q = {0u, 0u, 0u, 0u};
    if (row > 0) q = ldg16(proj + (size_t)(row - 1) * NINP + col);
    float pf[8], qf[8]; unpack8(p, pf); unpack8(q, qf);
    const f32x4 m0 = *(const f32x4*)(mu + col), m1 = *(const f32x4*)(mu + col + 4);
    const float mf[8] = {m0.x, m0.y, m0.z, m0.w, m1.x, m1.y, m1.z, m1.w};
#pragma unroll
    for (int j = 0; j < 8; ++j) o[j] = pf[j] + (qf[j] - pf[j]) * mf[j];
}
__device__ __forceinline__ void ld8f(const float* p, float (&o)[8]) { const f32x4 a = *(const f32x4*)p, b = *(const f32x4*)(p + 4); o[0] = a.x; o[1] = a.y; o[2] = a.z; o[3] = a.w; o[4] = b.x; o[5] = b.y; o[6] = b.z; o[7] = b.w; }

constexpr int VP = 168;
__device__ __forceinline__ void attn_unit(const Args& a, LAS unsigned char* lds, int unit, int tid, int wave, int lane) {
    const bf16* proj = (const bf16*)(a.ws + WS_PROJ); bf16* mix = (bf16*)(a.ws + WS_MIX);
    const int qb = unit >> 1, kvh = unit & 1, q0 = qb * 32, kbase = q0 - 128, hq = kvh * 8 + wave;
    LAS bf16* VT = (LAS bf16*)lds;
    bar_lds();
    for (int idx = tid; idx < 160 * 8; idx += NTHR) {
        const int key = idx >> 3, d8 = (idx & 7) * 8, tk = kbase + key;
        v4u p = {0u, 0u, 0u, 0u};
        if (tk >= 0) p = ldg16(proj + (size_t)tk * NINP + C_AV + kvh * 64 + d8);
        const unsigned w[4] = {p.x, p.y, p.z, p.w};
#pragma unroll
        for (int j = 0; j < 4; ++j) { VT[(d8 + 2 * j) * VP + key] = (bf16)(w[j] & 0xffffu); VT[(d8 + 2 * j + 1) * VP + key] = (bf16)(w[j] >> 16); }
    }
    bar_lds();
    const int r = lane & 31, h = lane >> 5;
    bf16x8 bq[4];
    { const bf16* qrow = proj + (size_t)(q0 + r) * NINP + C_AQ + hq * 64 + 8 * h;
#pragma unroll
      for (int s = 0; s < 4; ++s) bq[s] = *(const bf16x8*)(qrow + 16 * s); }
    const float slope = exp2f(-0.5f * (float)(hq + 1)), sink = a.in[13][hq];
    f32x16 sc[5]; float mx = sink;
#pragma unroll
    for (int kt = 0; kt < 5; ++kt) {
        const int tkb = kbase + 32 * kt;
        f32x16 acc; for (int i = 0; i < 16; ++i) acc[i] = 0.f;
        if (tkb >= 0) {
            const bf16* krow = proj + (size_t)(tkb + r) * NINP + C_AK + kvh * 64 + 8 * h;
#pragma unroll
            for (int s = 0; s < 4; ++s) acc = MFMA32(*(const bf16x8*)(krow + 16 * s), bq[s], acc);
        }
#pragma unroll
        for (int i = 0; i < 16; ++i) {
            const int key = tkb + (i & 3) + 8 * (i >> 2) + 4 * h, dist = (q0 + r) - key;
            const bool valid = (tkb >= 0) && (dist >= 0) && (dist < 128);
            const float v = valid ? acc[i] * 0.125f - slope * (float)dist : -1e30f;
            sc[kt][i] = v; mx = fmaxf(mx, v);
        }
        __builtin_amdgcn_sched_barrier(0);
    }
    mx = fmaxf(mx, __shfl_xor(mx, 32));
    float sum = 0.f;
#pragma unroll
    for (int kt = 0; kt < 5; ++kt)
#pragma unroll
        for (int i = 0; i < 16; ++i) { const float p = __expf(sc[kt][i] - mx); sc[kt][i] = p; sum += p; }
    sum += __shfl_xor(sum, 32); sum += __expf(sink - mx);
    f32x16 o[2]; for (int i = 0; i < 16; ++i) { o[0][i] = 0.f; o[1][i] = 0.f; }
#pragma unroll
    for (int kt = 0; kt < 5; ++kt) {
        if (kbase + 32 * kt >= 0) {
#pragma unroll
            for (int s = 0; s < 2; ++s) {
                v4u pw; pw.x = pk2(sc[kt][8 * s + 0], sc[kt][8 * s + 1]); pw.y = pk2(sc[kt][8 * s + 2], sc[kt][8 * s + 3]); pw.z = pk2(sc[kt][8 * s + 4], sc[kt][8 * s + 5]); pw.w = pk2(sc[kt][8 * s + 6], sc[kt][8 * s + 7]);
                const bf16x8 pb = __builtin_bit_cast(bf16x8, pw);
#pragma unroll
                for (int dt = 0; dt < 2; ++dt) {
                    const LAS bf16* vp = VT + (32 * dt + r) * VP + 32 * kt + 16 * s + 4 * h;
                    const v2u lo = *(const LAS v2u*)vp, hi = *(const LAS v2u*)(vp + 8);
                    v4u vw; vw.x = lo.x; vw.y = lo.y; vw.z = hi.x; vw.w = hi.y;
                    o[dt] = MFMA32(__builtin_bit_cast(bf16x8, vw), pb, o[dt]);
                }
            }
        }
    }
    const float inv = 1.f / sum;
#pragma unroll
    for (int dt = 0; dt < 2; ++dt)
#pragma unroll
        for (int g4 = 0; g4 < 4; ++g4) {
            const int d0 = 32 * dt + 8 * g4 + 4 * h;
            const v2u gp = *(const v2u*)(proj + (size_t)(q0 + r) * NINP + C_AG + hq * 64 + d0);
            v2u w; w.x = pk2(o[dt][4 * g4 + 0] * inv * siluf_(bflo(gp.x)), o[dt][4 * g4 + 1] * inv * siluf_(bfhi(gp.x)));
            w.y = pk2(o[dt][4 * g4 + 2] * inv * siluf_(bflo(gp.y)), o[dt][4 * g4 + 3] * inv * siluf_(bfhi(gp.y)));
            *(v2u*)(mix + (size_t)(q0 + r) * D + RW + hq * 64 + d0) = w;
        }
}

struct Prep { float r[8], kp[8], v[8], g[8], w[8], lw[8], kk[8], b[8], bonus; };
__device__ __forceinline__ void rwkv_prep(const Args& a, LAS unsigned char* lds, int h, int t0, int tid, int wave, int lane, Prep& P) {
    const bf16* proj = (const bf16*)(a.ws + WS_PROJ); const bf16* upt = (const bf16*)(a.ws + WS_UPT); const bf16* aupt = upt + 65536;
    LAS bf16* TW = (LAS bf16*)lds; LAS bf16* ADm = TW + 64 * 72; LAS float* Z = (LAS float*)(lds + 18432); LAS float* AP = Z + 64 * 68;
    const int t = tid >> 3, c8 = (tid & 7) * 8, ch = h * 64 + c8, row = t0 + t;
    const float* mu = a.in[3];
    { float x[8]; load_shift8(proj, row, C_WD + c8, mu, x);
#pragma unroll
      for (int j = 0; j < 8; ++j) x[j] = 1.f - 2.f * __builtin_amdgcn_rcpf(1.f + __expf(2.f * x[j]));
      *(LAS v4u*)(TW + t * 72 + c8) = pack8(x);
      load_shift8(proj, row, C_AD + c8, mu, x); *(LAS v4u*)(ADm + t * 72 + c8) = pack8(x); }
    bar_lds();
    { const int rt = wave & 3, cp = (wave >> 2) * 2, fr = lane & 15, fq = lane >> 4;
      bf16x8 aT[2], aA[2];
#pragma unroll
      for (int s = 0; s < 2; ++s) { aT[s] = *(const LAS bf16x8*)(TW + (16 * rt + fr) * 72 + 32 * s + 8 * fq); aA[s] = *(const LAS bf16x8*)(ADm + (16 * rt + fr) * 72 + 32 * s + 8 * fq); }
#pragma unroll
      for (int ci = 0; ci < 2; ++ci) { const int ct = cp + ci; f32x4 z = {0.f, 0.f, 0.f, 0.f}, ap = {0.f, 0.f, 0.f, 0.f};
#pragma unroll
          for (int s = 0; s < 2; ++s) { const size_t bo = (size_t)(h * 64 + 16 * ct + fr) * 64 + 32 * s + 8 * fq;
              z = MFMA16(aT[s], *(const bf16x8*)(upt + bo), z); ap = MFMA16(aA[s], *(const bf16x8*)(aupt + bo), ap); }
#pragma unroll
          for (int j = 0; j < 4; ++j) { Z[(16 * rt + 4 * fq + j) * 68 + 16 * ct + fr] = z[j]; AP[(16 * rt + 4 * fq + j) * 68 + 16 * ct + fr] = ap[j]; } } }
    bar_lds();
    float zz[8], aa[8], kr[8], c0[8], c1[8];
#pragma unroll
    for (int j = 0; j < 8; ++j) { zz[j] = Z[t * 68 + c8 + j]; aa[j] = AP[t * 68 + c8 + j]; }
    load_shift8(proj, row, C_R + ch, mu, P.r); load_shift8(proj, row, C_K + ch, mu, kr); load_shift8(proj, row, C_V + ch, mu, P.v); load_shift8(proj, row, C_G + ch, mu, P.g);
    ld8f(a.in[4] + ch, c0); ld8f(a.in[6] + ch, c1);
#pragma unroll
    for (int j = 0; j < 8; ++j) { const float z = c0[j] + zz[j]; const float sp = (z < -15.f) ? -z : __logf(1.f + __expf(-z)); const float wl = -sp - 0.5f; P.lw[j] = -__expf(wl); P.w[j] = __expf(P.lw[j]); aa[j] = sigmoidf_(c1[j] + aa[j]); }
    ld8f(a.in[8] + ch, c0); ld8f(a.in[9] + ch, c1);
    float ss = 0.f;
#pragma unroll
    for (int j = 0; j < 8; ++j) { P.kk[j] = kr[j] * c0[j]; ss += P.kk[j] * P.kk[j]; P.kp[j] = kr[j] * (1.f + (aa[j] - 1.f) * c1[j]); }
    ss = sum8(ss); const float rn = 1.f / fmaxf(sqrtf(ss), 1e-12f);
    ld8f(a.in[10] + ch, c0);
    float bs = 0.f;
#pragma unroll
    for (int j = 0; j < 8; ++j) { P.kk[j] *= rn; P.b[j] = P.kk[j] * aa[j]; bs += P.r[j] * P.kp[j] * c0[j]; }
    P.bonus = sum8(bs);
}
__device__ __forceinline__ void rwkv_out8(const Args& a, const float (&y)[8], const float (&v)[8], const float (&g)[8], float bonus, int row, int ch) {
    bf16* mix = (bf16*)(a.ws + WS_MIX);
    float s = 0.f;
#pragma unroll
    for (int j = 0; j < 8; ++j) s += y[j];
    const float mean = sum8(s) * (1.f / 64.f); float q = 0.f;
#pragma unroll
    for (int j = 0; j < 8; ++j) { const float d = y[j] - mean; q += d * d; }
    const float rstd = 1.f / sqrtf(sum8(q) * (1.f / 64.f) + LNX_EPS);
    float lg[8], lb[8], o[8]; ld8f(a.in[11] + ch, lg); ld8f(a.in[12] + ch, lb);
#pragma unroll
    for (int j = 0; j < 8; ++j) { const float yn = (y[j] - mean) * rstd * lg[j] + lb[j] + bonus * v[j]; o[j] = yn * siluf_(g[j]); }
    *(v4u*)(mix + (size_t)row * D + ch) = pack8(o);
}
constexpr size_t WS_MF = 174 * MiB, WS_QF = 190 * MiB, WS_SF = 206 * MiB, WS_BON = 222 * MiB;
constexpr size_t OUT_NF = 0, OUT_Y2 = 32 * MiB;
constexpr int MP = 72;
constexpr int L_AT = 0, L_ATT = 9216, L_BT = 18432, L_KT = 27648, L_RT = 36864, L_BHT = 46080, L_KHT = 55296, L_VT = 64512, L_LW = 73728, L_P = 73728, L_PT = 82944,
              L_AAK = 92160, L_ARB = 101376, L_ARK = 110592, L_TM = 119808, L_SEG = 119808, L_GC = 129024, L_WT = L_AT, L_X1T = L_BT, L_U2T = L_KT;
struct WTile { int ta, tb0, fr, fq; };
__device__ __forceinline__ bf16x8 ldfrag(const LAS bf16* M, int tile, int s, const WTile& w) { return *(const LAS bf16x8*)(M + (16 * tile + w.fr) * MP + 32 * s + 8 * w.fq); }
__device__ __forceinline__ void mm2(const LAS bf16* A, const LAS bf16* B, const WTile& w, f32x4 (&acc)[2]) {
#pragma unroll
    for (int s = 0; s < 2; ++s) { const bf16x8 af = ldfrag(A, w.ta, s, w);
#pragma unroll
        for (int ci = 0; ci < 2; ++ci) acc[ci] = MFMA16(af, ldfrag(B, w.tb0 + ci, s, w), acc[ci]); }
}
__device__ __forceinline__ void st_T(LAS bf16* X, int ta, int tb, const WTile& w, const f32x4& v) { v2u o; o.x = pk2(v[0], v[1]); o.y = pk2(v[2], v[3]); *(LAS v2u*)(X + (16 * tb + w.fr) * MP + 16 * ta + 4 * w.fq) = o; }
__device__ __forceinline__ void st_N(LAS bf16* X, int ta, int tb, const WTile& w, const f32x4& v) {
    const unsigned a = pk2(v[0], v[1]), b = pk2(v[2], v[3]); LAS bf16* p = X + (16 * ta + 4 * w.fq) * MP + 16 * tb + w.fr;
    p[0] = (bf16)(a & 0xffffu); p[MP] = (bf16)(a >> 16); p[2 * MP] = (bf16)(b & 0xffffu); p[3 * MP] = (bf16)(b >> 16);
}
#define ZERO2(x) do { x[0] = (f32x4){0.f, 0.f, 0.f, 0.f}; x[1] = (f32x4){0.f, 0.f, 0.f, 0.f}; } while (0)
template <int MODE> __device__ __forceinline__ void mask2(f32x4 (&acc)[2], const WTile& w) {
#pragma unroll
    for (int ci = 0; ci < 2; ++ci)
#pragma unroll
        for (int j = 0; j < 4; ++j) { const int row = 16 * w.ta + 4 * w.fq + j, col = 16 * (w.tb0 + ci) + w.fr;
            const bool keep = MODE == 0 ? (row < col) : (MODE == 1 ? (row <= col) : (col < row)); if (!keep) acc[ci][j] = 0.f; }
}
__device__ __forceinline__ void st_bf16x8_T(LAS bf16* X, int c8, int t, const float (&v)[8]) {
    const v4u p = pack8(v); const unsigned w[4] = {p.x, p.y, p.z, p.w};
#pragma unroll
    for (int j = 0; j < 4; ++j) { X[(c8 + 2 * j) * MP + t] = (bf16)(w[j] & 0xffffu); X[(c8 + 2 * j + 1) * MP + t] = (bf16)(w[j] >> 16); }
}

__device__ __forceinline__ void rwkv_chunk_prep(const Args& a, LAS unsigned char* lds, int unit, int tid, int wave, int lane) {
    const int c = unit >> 4, h = unit & 15, t0 = c * CH, t = tid >> 3, c8 = (tid & 7) * 8;
    LAS bf16* At = (LAS bf16*)(lds + L_AT); LAS bf16* AtT = (LAS bf16*)(lds + L_ATT); LAS bf16* Bt = (LAS bf16*)(lds + L_BT); LAS bf16* Kt = (LAS bf16*)(lds + L_KT);
    LAS bf16* Rt = (LAS bf16*)(lds + L_RT); LAS bf16* BhT = (LAS bf16*)(lds + L_BHT); LAS bf16* KhT = (LAS bf16*)(lds + L_KHT); LAS bf16* VT = (LAS bf16*)(lds + L_VT);
    LAS float* LW = (LAS float*)(lds + L_LW); LAS bf16* Pm = (LAS bf16*)(lds + L_P); LAS bf16* PT = (LAS bf16*)(lds + L_PT);
    LAS bf16* AAK = (LAS bf16*)(lds + L_AAK); LAS bf16* ARB = (LAS bf16*)(lds + L_ARB); LAS bf16* ARK = (LAS bf16*)(lds + L_ARK); LAS bf16* TM = (LAS bf16*)(lds + L_TM);
    LAS float* SEG = (LAS float*)(lds + L_SEG); LAS float* GC = (LAS float*)(lds + L_GC);
    LAS bf16* WT = (LAS bf16*)(lds + L_WT); LAS bf16* X1T = (LAS bf16*)(lds + L_X1T); LAS bf16* U2T = (LAS bf16*)(lds + L_U2T);
    bar_lds();
    Prep P; rwkv_prep(a, lds, h, t0, tid, wave, lane, P);
#ifdef PROBE_PREP2
    bar_lds(); rwkv_prep(a, lds, h, t0, tid, wave, lane, P);
#endif
    if ((tid & 7) == 0) ((float*)(a.ws + WS_BON))[(size_t)(t0 + t) * 16 + h] = P.bonus;
#pragma unroll
    for (int j = 0; j < 8; ++j) LW[t * 68 + c8 + j] = P.lw[j];
    bar_lds();
    { const int cc = tid & 63, sg = tid >> 6; float run = 0.f;
#pragma unroll
      for (int i = 0; i < 8; ++i) { run += LW[(8 * sg + i) * 68 + cc]; LW[(8 * sg + i) * 68 + cc] = run; }
      SEG[sg * 64 + cc] = run; }
    bar_lds();
    {
        float Lt[8], LC[8];
#pragma unroll
        for (int j = 0; j < 8; ++j) { float off = 0.f, tot = 0.f;
#pragma unroll
            for (int s = 0; s < 8; ++s) { const float sv = SEG[s * 64 + c8 + j]; tot += sv; if (s < (t >> 3)) off += sv; }
            Lt[j] = LW[t * 68 + c8 + j] + off; LC[j] = tot; }
        if (t == 0) {
#pragma unroll
            for (int j = 0; j < 8; ++j) GC[c8 + j] = __expf(LC[j]); }
        float x[8], y[8];
#pragma unroll
        for (int j = 0; j < 8; ++j) x[j] = -P.kk[j] * __expf(Lt[j] - P.lw[j]);
        *(LAS v4u*)(At + t * MP + c8) = pack8(x); st_bf16x8_T(AtT, c8, t, x);
#pragma unroll
        for (int j = 0; j < 8; ++j) { const float e = __expf(-Lt[j]); x[j] = P.b[j] * e; y[j] = P.kp[j] * e; }
        *(LAS v4u*)(Bt + t * MP + c8) = pack8(x); *(LAS v4u*)(Kt + t * MP + c8) = pack8(y);
#pragma unroll
        for (int j = 0; j < 8; ++j) x[j] = P.r[j] * __expf(Lt[j]);
        *(LAS v4u*)(Rt + t * MP + c8) = pack8(x);
#pragma unroll
        for (int j = 0; j < 8; ++j) { const float e = __expf(LC[j] - Lt[j]); x[j] = P.b[j] * e; y[j] = P.kp[j] * e; }
        st_bf16x8_T(BhT, c8, t, x); st_bf16x8_T(KhT, c8, t, y); st_bf16x8_T(VT, c8, t, P.v);
    }
    bar_lds();
    WTile w; w.ta = wave & 3; w.tb0 = (wave >> 2) * 2; w.fr = lane & 15; w.fq = lane >> 4;
    f32x4 acc[2], Tacc[2];
    ZERO2(Tacc); mm2(At, Bt, w, Tacc); mask2<2>(Tacc, w);
    ZERO2(acc); mm2(Kt, At, w, acc); mask2<0>(acc, w);
    f32x4 rb[2], rk[2]; ZERO2(rb); mm2(Bt, Rt, w, rb); mask2<1>(rb, w); ZERO2(rk); mm2(Kt, Rt, w, rk); mask2<1>(rk, w);
    bar_lds();
#pragma unroll
    for (int ci = 0; ci < 2; ++ci) { st_N(Pm, w.ta, w.tb0 + ci, w, Tacc[ci]); st_T(PT, w.ta, w.tb0 + ci, w, Tacc[ci]);
        st_T(AAK, w.ta, w.tb0 + ci, w, acc[ci]); st_T(ARB, w.ta, w.tb0 + ci, w, rb[ci]); st_T(ARK, w.ta, w.tb0 + ci, w, rk[ci]);
#pragma unroll
        for (int j = 0; j < 4; ++j) if (16 * w.ta + 4 * w.fq + j == 16 * (w.tb0 + ci) + w.fr) Tacc[ci][j] += 1.f;
        st_N(TM, w.ta, w.tb0 + ci, w, Tacc[ci]); }
    bar_lds();
#pragma unroll 1
#ifdef PROBE_NEU2
    for (int n = 0; n < 10; ++n) {
#else
    for (int n = 0; n < 5; ++n) {
#endif
        ZERO2(acc); mm2(Pm, PT, w, acc);
        bar_lds();
#pragma unroll
        for (int ci = 0; ci < 2; ++ci) { st_N(Pm, w.ta, w.tb0 + ci, w, acc[ci]); st_T(PT, w.ta, w.tb0 + ci, w, acc[ci]); }
        bar_lds();
        mm2(TM, PT, w, Tacc);
        bar_lds();
#pragma unroll
        for (int ci = 0; ci < 2; ++ci) st_N(TM, w.ta, w.tb0 + ci, w, Tacc[ci]);
        bar_lds();
    }
    ZERO2(acc); mm2(TM, AtT, w, acc); ZERO2(rb); mm2(AAK, VT, w, rb);
#pragma unroll
    for (int ci = 0; ci < 2; ++ci) { st_T(WT, w.ta, w.tb0 + ci, w, acc[ci]); st_T(X1T, w.ta, w.tb0 + ci, w, rb[ci]); }
    bar_lds();
    const size_t ub = (size_t)unit * 4096;
    { ZERO2(acc); mm2(TM, X1T, w, acc);
#pragma unroll
      for (int ci = 0; ci < 2; ++ci) st_T(U2T, w.ta, w.tb0 + ci, w, acc[ci]);
      bf16* MF = (bf16*)(a.ws + WS_MF) + ub; bf16* QF = (bf16*)(a.ws + WS_QF) + ub;
      ZERO2(acc); mm2(WT, BhT, w, acc);
      ZERO2(rb); mm2(WT, ARB, w, rb);
#pragma unroll
      for (int ci = 0; ci < 2; ++ci) { const int tb = w.tb0 + ci; const int col = 16 * tb + w.fr; const float gc = GC[col];
          f32x4 m = acc[ci];
#pragma unroll
          for (int j = 0; j < 4; ++j) if (16 * w.ta + 4 * w.fq + j == col) m[j] += gc;
          const size_t fo = (size_t)((tb * 2 + (w.ta >> 1)) * 64 + lane) * 8 + 4 * (w.ta & 1);
          v2u o; o.x = pk2(m[0], m[1]); o.y = pk2(m[2], m[3]); *(v2u*)(MF + fo) = o;
          const v2u rr = *(const LAS v2u*)(Rt + col * MP + 16 * w.ta + 4 * w.fq);
          f32x4 q = rb[ci]; q[0] += bflo(rr.x); q[1] += bfhi(rr.x); q[2] += bflo(rr.y); q[3] += bfhi(rr.y);
          o.x = pk2(q[0], q[1]); o.y = pk2(q[2], q[3]); *(v2u*)(QF + fo) = o; } }
    bar_lds();
    { float* NF = (float*)((unsigned char*)a.out + OUT_NF) + ub; float* Y2 = (float*)((unsigned char*)a.out + OUT_Y2) + ub;
      ZERO2(acc); mm2(BhT, U2T, w, acc); mm2(KhT, VT, w, acc);
      ZERO2(rb); mm2(U2T, ARB, w, rb); mm2(VT, ARK, w, rb);
#pragma unroll
      for (int ci = 0; ci < 2; ++ci) { const int tb = w.tb0 + ci;
          *(f32x4*)(NF + (size_t)((tb * 4 + w.ta) * 64 + lane) * 4) = acc[ci];
          *(f32x4*)(Y2 + (size_t)(16 * tb + w.fr) * 64 + 16 * w.ta + 4 * w.fq) = rb[ci]; } }
}

constexpr int KR = 4, NR = NCH / KR, SLOT = 12288, RBUF = KR * SLOT, NPIECE = RBUF / 16, LPT = 7;
__device__ __forceinline__ const v4u* sp_src(const Args& a, int h, int cg, int r, int p) {
    const int cc = p / 768, q = p % 768, c = r * KR + cc; const size_t ub = (size_t)(c * 16 + h) * 4096;
    return q < 512 ? (const v4u*)((const bf16*)(a.ws + WS_MF) + ub) + q : (const v4u*)((const float*)((const unsigned char*)a.out + OUT_NF) + ub + cg * 1024) + (q - 512);
}
__device__ __forceinline__ void state_pass(const Args& a, LAS unsigned char* lds, int b, int tid, int wave, int lane) {
    const int h = b >> 2, cg = b & 3, lt = tid - 64;
    v4u ra[LPT], rb[LPT];
    if (wave != 0) {
#pragma unroll
        for (int i = 0; i < LPT; ++i) { const int p = lt + 448 * i; if (p < NPIECE) ra[i] = *sp_src(a, h, cg, 0, p); }
#pragma unroll
        for (int i = 0; i < LPT; ++i) { const int p = lt + 448 * i; if (p < NPIECE) *(LAS v4u*)(lds + p * 16) = ra[i]; }
#pragma unroll
        for (int i = 0; i < LPT; ++i) { const int p = lt + 448 * i; if (p < NPIECE) ra[i] = *sp_src(a, h, cg, 1, p); }
    }
    f32x4 st[4];
#pragma unroll
    for (int i = 0; i < 4; ++i) st[i] = (f32x4){0.f, 0.f, 0.f, 0.f};
    bar_lds();
    bf16* SF = (bf16*)(a.ws + WS_SF);
#define SP_ROUND(r_, RA, RB) do { \
        if (wave != 0) { \
            if ((r_) + 2 < NR) { _Pragma("unroll") for (int i = 0; i < LPT; ++i) { const int p = lt + 448 * i; if (p < NPIECE) RB[i] = *sp_src(a, h, cg, (r_) + 2, p); } } \
            if ((r_) + 1 < NR) { _Pragma("unroll") for (int i = 0; i < LPT; ++i) { const int p = lt + 448 * i; if (p < NPIECE) *(LAS v4u*)(lds + (((r_) + 1) & 1) * RBUF + p * 16) = RA[i]; } } \
        } else { \
            _Pragma("unroll") for (int cc = 0; cc < KR; ++cc) { \
                const LAS unsigned char* sl = lds + ((r_) & 1) * RBUF + cc * SLOT; const int c = (r_) * KR + cc; \
                v4u b0, b1; b0.x = pk2(st[0][0], st[0][1]); b0.y = pk2(st[0][2], st[0][3]); b0.z = pk2(st[1][0], st[1][1]); b0.w = pk2(st[1][2], st[1][3]); \
                b1.x = pk2(st[2][0], st[2][1]); b1.y = pk2(st[2][2], st[2][3]); b1.z = pk2(st[3][0], st[3][1]); b1.w = pk2(st[3][2], st[3][3]); \
                v4u* sfo = (v4u*)(SF + (size_t)(c * 16 + h) * 4096) + (cg * 2) * 64 + lane; sfo[0] = b0; sfo[64] = b1; \
                const bf16x8 f0 = __builtin_bit_cast(bf16x8, b0), f1 = __builtin_bit_cast(bf16x8, b1); \
                _Pragma("unroll") for (int rt = 0; rt < 4; ++rt) { \
                    f32x4 n = *(const LAS f32x4*)(sl + 8192 + (rt * 64 + lane) * 16); \
                    n = MFMA16(*(const LAS bf16x8*)(sl + ((rt * 2 + 0) * 64 + lane) * 16), f0, n); \
                    n = MFMA16(*(const LAS bf16x8*)(sl + ((rt * 2 + 1) * 64 + lane) * 16), f1, n); st[rt] = n; } \
            } \
        } \
        bar_lds(); } while (0)
#pragma unroll 1
    for (int r = 0; r < NR; r += 2) { SP_ROUND(r, ra, rb); SP_ROUND(r + 1, rb, ra); }
#undef SP_ROUND
}

__device__ __forceinline__ void rwkv_out_unit(const Args& a, LAS unsigned char* lds, int unit, int tid, int wave, int lane) {
    const int c = unit >> 4, h = unit & 15, t0 = c * CH, t = tid >> 3, c8 = (tid & 7) * 8, ch = h * 64 + c8;
    const size_t ub = (size_t)unit * 4096;
    const bf16* QF = (const bf16*)(a.ws + WS_QF) + ub; const bf16* SF = (const bf16*)(a.ws + WS_SF) + ub; const float* Y2 = (const float*)((const unsigned char*)a.out + OUT_Y2) + ub;
    LAS float* SY = (LAS float*)lds;
    const int ta = wave & 3, tb0 = (wave >> 2) * 2, fr = lane & 15, fq = lane >> 4;
    bf16x8 af[2], bfr[2][2];
#pragma unroll
    for (int s = 0; s < 2; ++s) { af[s] = *(const bf16x8*)(QF + (size_t)((ta * 2 + s) * 64 + lane) * 8);
#pragma unroll
        for (int ci = 0; ci < 2; ++ci) bfr[s][ci] = *(const bf16x8*)(SF + (size_t)(((tb0 + ci) * 2 + s) * 64 + lane) * 8); }
    float y2[8], v[8], g[8];
    ld8f(Y2 + t * 64 + c8, y2);
    const bf16* proj = (const bf16*)(a.ws + WS_PROJ);
    load_shift8(proj, t0 + t, C_V + ch, a.in[3], v); load_shift8(proj, t0 + t, C_G + ch, a.in[3], g);
    const float bonus = ((const float*)(a.ws + WS_BON))[(size_t)(t0 + t) * 16 + h];
    f32x4 acc[2]; ZERO2(acc);
#pragma unroll
    for (int s = 0; s < 2; ++s)
#pragma unroll
        for (int ci = 0; ci < 2; ++ci) acc[ci] = MFMA16(af[s], bfr[s][ci], acc[ci]);
    bar_lds();
#pragma unroll
    for (int ci = 0; ci < 2; ++ci)
#pragma unroll
        for (int j = 0; j < 4; ++j) SY[(16 * ta + 4 * fq + j) * 68 + 16 * (tb0 + ci) + fr] = acc[ci][j];
    bar_lds();
    float y[8];
#pragma unroll
    for (int j = 0; j < 8; ++j) y[j] = SY[t * 68 + c8 + j] + y2[j];
    rwkv_out8(a, y, v, g, bonus, t0 + t, ch);
}
#ifndef HOSTDUP
#define HOSTDUP -1
#endif
#ifndef ONE_LAUNCH
#define ONE_LAUNCH 1
#endif
#if HOSTDUP != -1 || defined(MULTI)
#undef ONE_LAUNCH
#define ONE_LAUNCH 0
#endif
constexpr int NPHASE = 7;
__global__ void __launch_bounds__(NTHR, 2) mega(Args a) {
    extern __shared__ __attribute__((aligned(16))) unsigned char lds_[];
    LAS unsigned char* lds = (LAS unsigned char*)lds_;
    const int tid = threadIdx.x, lane = tid & 63, wave = __builtin_amdgcn_readfirstlane(tid >> 6);
    const int G = gridDim.x, bx = blockIdx.x, vcu = (G % 8 == 0) ? (bx % 8) * (G / 8) + bx / 8 : bx;
    cg::grid_group grid = cg::this_grid();
    volatile LAS unsigned* xst = (volatile LAS unsigned*)(lds + 131072 + 64);
    if (tid < 2) xst[tid] = 0u;
    __syncthreads();
    XcdBarrier xbar; xbar.bar = (unsigned*)a.ws; xbar.x = 0; xbar.st = xst;
    if (a.ph_hi - a.ph_lo > 1) xbar = xcd_barrier_post((unsigned*)a.ws, xst);
#define IN(k) (a.ph_lo <= (k) && (k) < a.ph_hi)
#define SEAM(k) do { if (IN(k) && IN((k) + 1)) { if ((k) == 0) grid.sync(); else xcd_barrier(xbar); } } while (0)
    if (IN(0)) { p0_prologue(a, lds, vcu, G, wave, lane); }
    SEAM(0);
    if (IN(1)) {
        pg8::Gemm g{(const pg8::bf16_t*)(a.ws + WS_XN), (const pg8::bf16_t*)(a.ws + WS_WTIN), T, NINP, D}; pg8::StaticOrder S; S.init(T, NINP, G, bx);
        pg8::EpiBf16<0> E{(pg8::bf16_t*)(a.ws + WS_PROJ), NINP, nullptr, 0, 0, 1.f};
        pg8::gemm_phase<pg8::EpiBf16<0>, pg8::StaticOrder, true, true>(lds, g, S, E);
    }
    SEAM(1);
    if (IN(2)) {
        for (int it = bx; it < 512; it += G) attn_unit(a, lds, it, tid, wave, lane);
        for (int it = bx; it < NCH * NH; it += G) rwkv_chunk_prep(a, lds, it, tid, wave, lane);
    }
    SEAM(2);
    if (IN(3)) { if (bx < 64) state_pass(a, lds, bx, tid, wave, lane); }
    SEAM(3);
    if (IN(4)) { for (int u = bx; u < NCH * NH; u += G) rwkv_out_unit(a, lds, u, tid, wave, lane); }
    SEAM(4);
    if (IN(5)) {
        pg8::Gemm g{(const pg8::bf16_t*)(a.ws + WS_MIX), (const pg8::bf16_t*)(a.ws + WS_WTOUT), T, D, D}; pg8::StaticOrder S; S.init(T, D, G, bx);
        pg8::EpiResid E{a.in[0], a.out, (float*)(a.ws + WS_SSP), D};
        pg8::gemm_phase<pg8::EpiResid, pg8::StaticOrder, true, true>(lds, g, S, E);
    }
    SEAM(5);
    if (IN(6)) final_norm(a, vcu, G, wave, lane);
#undef IN
#undef SEAM
}

extern "C" void kernel_launch(void* const* d_in, const int* in_sizes, int n_in, void* d_out, int out_size, void* d_ws, size_t ws_size, hipStream_t stream) {
    static int grid = 0;
    if (grid == 0) {
        int dev = 0, cus = 0;
        if (hipGetDevice(&dev) != hipSuccess || hipDeviceGetAttribute(&cus, hipDeviceAttributeMultiprocessorCount, dev) != hipSuccess) { fprintf(stderr, "kernel_launch: device query failed\n"); grid = -1; return; }
        if (hipFuncSetAttribute((const void*)mega, hipFuncAttributeMaxDynamicSharedMemorySize, LDS_BYTES) != hipSuccess) { fprintf(stderr, "kernel_launch: hipFuncSetAttribute failed\n"); grid = -1; return; }
        (void)hipGetLastError();
        grid = cus;
    }
    if (grid < 0) return;
    Args a{};
    for (int i = 0; i < 16; ++i) a.in[i] = (const float*)d_in[i];
    a.out = (float*)d_out; a.ws = (unsigned char*)d_ws;
#if ONE_LAUNCH
    (void)hipMemsetAsync(d_ws, 0, 16384, stream);
    a.ph_lo = 0; a.ph_hi = NPHASE;
    void* args[] = {&a};
    hipError_t e = hipLaunchCooperativeKernel((const void*)mega, dim3(grid), dim3(NTHR), args, LDS_BYTES, stream);
    if (e != hipSuccess) fprintf(stderr, "cooperative launch failed: %s (grid %d)\n", hipGetErrorString(e), grid);
#else
    for (int p = 0; p < NPHASE; ++p) for (int rep = 0; rep < (p == HOSTDUP ? 2 : 1); ++rep) { a.ph_lo = p; a.ph_hi = p + 1; hipLaunchKernelGGL(mega, dim3(grid), dim3(NTHR), LDS_BYTES, stream, a); }
#endif
}
```

```cpp
#define ONE 1
#include <hip/hip_runtime.h>
#include <hip/hip_cooperative_groups.h>
#include <cstdio>
#include <cstdint>
namespace cg = cooperative_groups;
namespace pg8 {
#define PG8_LAS __attribute__((address_space(3)))
typedef unsigned short bf16_t;
typedef short bf16x8 __attribute__((ext_vector_type(8)));
typedef float f32x4 __attribute__((ext_vector_type(4)));
typedef unsigned u32x4 __attribute__((ext_vector_type(4)));
constexpr int BM = 256, BK = 64, HALF = 128, HTB = HALF * BK * 2  , STAGE_BYTES = 8 * HTB, NXCD = 8, WGM = 8;

__host__ __device__ __forceinline__ int lds_byte(int r, int c) { const int st = (r >> 4) * 2 + (c >> 5), rr = r & 15, cc = c & 31, ob = rr * 64 + cc * 2; return st * 1024 + (ob ^ (((ob >> 9) & 1) << 5)); }
__host__ __device__ __forceinline__ void stage_rc(int b, int& R, int& C) { const int st = b / 1024, sb = b % 1024, swz = sb ^ (((sb >> 9) & 1) << 5); R = (st >> 1) * 16 + swz / 64; C = (st & 1) * 32 + (swz % 64) / 2; }
__host__ __device__ __forceinline__ int perm32(int rho) { const int n = rho >> 4, i = rho & 15; return 8 * (i >> 2) + 4 * n + (i & 3); }

struct Unit { int pm, pn; };
struct Gemm { const bf16_t* A; const bf16_t* Bt; int M, N, K; };

struct StaticOrder {
    int nM, nN, nwg, G, c;
    __host__ __device__ void init(int M, int N, int G_, int c_) { nM = M / BM; nN = N / BM; nwg = nM * nN; G = G_; c = c_; }
    __host__ __device__ bool next(int i, Unit& u) const {
        const long L = (long)i * G + c; if (L >= nwg) return false;
        int wgid = (int)L; { const int q = nwg / NXCD, r = nwg % NXCD, xcd = wgid % NXCD, off = wgid / NXCD; wgid = (xcd < r ? xcd * (q + 1) : r * (q + 1) + (xcd - r) * q) + off; }
        const int nig = WGM * nN, gid = wgid / nig, fm = gid * WGM, gsz = (nM - fm) < WGM ? (nM - fm) : WGM;
        u.pm = fm + ((wgid % nig) % gsz); u.pn = (wgid % nig) / gsz; return true;
    }
    __device__ __forceinline__ void a_ready(const Unit&) const {}
    __device__ __forceinline__ void done(const Unit&) const {}
};

__device__ __forceinline__ unsigned cvt_pk_bf16(float lo, float hi) { unsigned r; asm volatile("v_cvt_pk_bf16_f32 %0, %1, %2" : "=v"(r) : "v"(lo), "v"(hi)); return r; }
typedef float f32x2 __attribute__((ext_vector_type(2)));
__device__ __forceinline__ f32x2 gelu_pk(f32x2 v) {
    const f32x2 av = __builtin_elementwise_abs(v), d = av * 0.2316418882f + 1.0f;
    f32x2 t; t.x = __builtin_amdgcn_rcpf(d.x); t.y = __builtin_amdgcn_rcpf(d.y);
    f32x2 q = t * 0.5307027145f + (-0.7265760135f); q = q * t + 0.7107068705f; q = q * t + (-0.142248368f); q = q * t + 0.127414796f; q = q * t;
    const f32x2 s = (v * v) * (-0.72134752044f);
    f32x2 e; e.x = __builtin_amdgcn_exp2f(s.x); e.y = __builtin_amdgcn_exp2f(s.y);
    const f32x2 m = v * (q * e), r = v - m;
    f32x2 o; o.x = v.x < 0.f ? m.x : r.x; o.y = v.y < 0.f ? m.y : r.y; return o;
}

template <int ACT  > struct EpiBf16 {
    static constexpr bool PERM = true, AFTER_DRAIN = false; static_assert(ACT == 0 || ACT == 1, "EpiBf16: ACT is 0 (none) or 1 (gelu_pk)");
    bf16_t* O; int ldc; const float* bias; int split_cols; size_t split_stride; float scale0;
    __device__ __forceinline__ void operator()(const f32x4 (&acc)[2][2][4][2], const Unit& u, int wr, int wc, int fr, int fq) const {
        const int row0 = u.pm * BM + wr * 64 + fr; int colt = u.pn * BM; bf16_t* base = O;
        float sc = 1.f; if (split_cols) { const int t = colt / split_cols; base += (size_t)t * split_stride; colt -= t * split_cols; if (t == 0) sc = scale0; }
        const int col0 = colt + wc * 32 + 8 * fq, bcol0 = u.pn * BM + wc * 32 + 8 * fq;
        f32x4 bv[2][2];
#pragma unroll
        for (int bj = 0; bj < 2; ++bj)
#pragma unroll
            for (int n = 0; n < 2; ++n) bv[bj][n] = bias ? *(const f32x4*)(bias + bcol0 + bj * HALF + 4 * n) : (f32x4){0.f, 0.f, 0.f, 0.f};
#pragma unroll
        for (int ai = 0; ai < 2; ++ai)
#pragma unroll
            for (int m = 0; m < 4; ++m) { bf16_t* rowp = base + (size_t)(row0 + ai * HALF + m * 16) * ldc + col0;
#pragma unroll
                for (int bj = 0; bj < 2; ++bj) { f32x4 v0 = acc[ai][bj][m][0] + bv[bj][0], v1 = acc[ai][bj][m][1] + bv[bj][1];
                    if (ACT == 1) { f32x2 a = gelu_pk((f32x2){v0[0], v0[1]}), b = gelu_pk((f32x2){v0[2], v0[3]}), c = gelu_pk((f32x2){v1[0], v1[1]}), d = gelu_pk((f32x2){v1[2], v1[3]});
                        v0 = (f32x4){a.x, a.y, b.x, b.y}; v1 = (f32x4){c.x, c.y, d.x, d.y}; }
                    v0 = v0 * sc; v1 = v1 * sc; u32x4 w; w.x = cvt_pk_bf16(v0[0], v0[1]); w.y = cvt_pk_bf16(v0[2], v0[3]); w.z = cvt_pk_bf16(v1[0], v1[1]); w.w = cvt_pk_bf16(v1[2], v1[3]);
                    *(u32x4*)(rowp + bj * HALF) = w; } }
    }
};
struct EpiResid {
    static constexpr bool PERM = false, AFTER_DRAIN = false;
    const float* x; float* out; float* sspart; int ldc;
    __device__ __forceinline__ void operator()(const f32x4 (&acc)[2][2][4][2], const Unit& u, int wr, int wc, int fr, int fq) const {
        const int row0 = u.pm * BM + wr * 64 + fr, col0 = u.pn * BM + wc * 32 + 4 * fq;
#pragma unroll
        for (int ai = 0; ai < 2; ++ai)
#pragma unroll
            for (int m = 0; m < 4; ++m) {
                const int row = row0 + ai * HALF + m * 16; float ss = 0.f;
#pragma unroll
                for (int bj = 0; bj < 2; ++bj)
#pragma unroll
                    for (int n = 0; n < 2; ++n) {
                        const size_t off = (size_t)row * ldc + col0 + bj * HALF + n * 16;
                        const f32x4 xv = *(const f32x4*)(x + off); const f32x4 v = acc[ai][bj][m][n] + xv;
                        *(f32x4*)(out + off) = v; ss += (v[0] * v[0] + v[1] * v[1]) + (v[2] * v[2] + v[3] * v[3]);
                    }
                ss += __shfl_xor(ss, 16); ss += __shfl_xor(ss, 32);
                if (fq == 0) sspart[(size_t)row * 32 + u.pn * 4 + wc] = ss;
            }
    }
};

template <class Epi, class Sched, bool ALIGN_EPI = false, bool SP2 = false>
__device__ __forceinline__ void gemm_phase(PG8_LAS unsigned char* lds, const Gemm g, const Sched& S, const Epi& E) {
    const int tid = threadIdx.x, wid = __builtin_amdgcn_readfirstlane(tid >> 6), lane = tid & 63, wr = wid >> 2, wc = wid & 3, fr = lane & 15, fq = lane >> 4;
    const int K = g.K, nt = K / BK;
    unsigned voffA[2], voffB[2];
#pragma unroll
    for (int i = 0; i < 2; ++i) { int R, C; stage_rc(tid * 16 + i * 8192, R, C); const int Rb = Epi::PERM ? ((R & ~31) + perm32(R & 31)) : R;
        voffA[i] = (unsigned)(R * K + C) * 2u; voffB[i] = (unsigned)(Rb * K + C) * 2u; }
    const size_t kstep = (size_t)(BK * 2);
    const size_t hstep = (size_t)HALF * K * 2;
    const size_t tstep = 2 * hstep;
    const unsigned ldsw = (unsigned)wid * 1024u;
    const int aoff = lds_byte(wr * 64 + fr, fq * 8), boff = lds_byte(wc * 32 + fr, fq * 8);
#define PG8_SA(b, h) (((b) * 2 + (h)) * HTB)
#define PG8_SB(b, h) ((4 + (b) * 2 + (h)) * HTB)
#define PG8_STAGE(bufoff, gbase, voff) do { _Pragma("unroll") for (int _i = 0; _i < 2; ++_i) \
        __builtin_amdgcn_global_load_lds((const unsigned*)((const char*)(gbase) + (voff)[_i]), (PG8_LAS unsigned*)(lds + (bufoff) + ldsw + _i * 8192), 16, 0, 0); } while (0)
#define PG8_LDA(dst, b, h) do { _Pragma("unroll") for (int m = 0; m < 4; ++m) _Pragma("unroll") for (int k = 0; k < 2; ++k) dst[m][k] = *(const PG8_LAS bf16x8*)(lds + PG8_SA(b, h) + aoff + m * 2048 + k * 1024); } while (0)
#define PG8_LDB(dst, b, h) do { _Pragma("unroll") for (int n = 0; n < 2; ++n) _Pragma("unroll") for (int k = 0; k < 2; ++k) dst[n][k] = *(const PG8_LAS bf16x8*)(lds + PG8_SB(b, h) + boff + n * 2048 + k * 1024); } while (0)
#define PG8_MMA(ai, bj, At, Bt) do { __builtin_amdgcn_s_setprio(1); _Pragma("unroll") for (int m = 0; m < 4; ++m) _Pragma("unroll") for (int n = 0; n < 2; ++n) _Pragma("unroll") for (int k = 0; k < 2; ++k) \
        acc[ai][bj][m][n] = __builtin_amdgcn_mfma_f32_16x16x32_bf16(Bt[n][k], At[m][k], acc[ai][bj][m][n], 0, 0, 0); __builtin_amdgcn_s_setprio(0); } while (0)
#define PG8_WAIT_V(n) asm volatile("s_waitcnt vmcnt(" #n ")" ::: "memory")
#define PG8_WAIT_L(n) asm volatile("s_waitcnt lgkmcnt(" #n ")" ::: "memory")
#define PG8_BAR __builtin_amdgcn_s_barrier()
#define PG8_SCHED __builtin_amdgcn_sched_barrier(0)
    Unit cur, nxt; int ui = 0;
    if (!S.next(0, cur)) return;
    f32x4 acc[2][2][4][2];
#pragma unroll
    for (int a = 0; a < 2; ++a)
#pragma unroll
        for (int b = 0; b < 2; ++b)
#pragma unroll
            for (int m = 0; m < 4; ++m)
#pragma unroll
                for (int n = 0; n < 2; ++n) acc[a][b][m][n] = (f32x4){0.f, 0.f, 0.f, 0.f};
    bf16x8 At[4][2], B0[2][2], B1[2][2];
    const char* cA = (const char*)g.A + (size_t)cur.pm * tstep; const char* cB = (const char*)g.Bt + (size_t)cur.pn * tstep;
    S.a_ready(cur);
    if constexpr (SP2) {
        PG8_STAGE(PG8_SB(0, 0), cB, voffB); PG8_STAGE(PG8_SB(0, 1), cB + hstep, voffB); PG8_STAGE(PG8_SA(0, 0), cA, voffA); PG8_STAGE(PG8_SA(0, 1), cA + hstep, voffA);
        if (wr == 1) PG8_BAR;
        PG8_WAIT_V(2); PG8_BAR;
        PG8_STAGE(PG8_SB(1, 0), cB + kstep, voffB); PG8_STAGE(PG8_SA(1, 0), cA + kstep, voffA); PG8_STAGE(PG8_SB(1, 1), cB + hstep + kstep, voffB);
        PG8_WAIT_V(6); PG8_BAR;
    } else {
        PG8_STAGE(PG8_SB(0, 0), cB, voffB); PG8_STAGE(PG8_SA(0, 0), cA, voffA); PG8_STAGE(PG8_SB(0, 1), cB + hstep, voffB); PG8_STAGE(PG8_SA(0, 1), cA + hstep, voffA);
        if (wr == 1) PG8_BAR;
        PG8_WAIT_V(4); PG8_BAR;
        PG8_STAGE(PG8_SB(1, 0), cB + kstep, voffB); PG8_STAGE(PG8_SA(1, 0), cA + kstep, voffA); PG8_STAGE(PG8_SB(1, 1), cB + hstep + kstep, voffB);
        PG8_WAIT_V(6); PG8_BAR;
    }
    for (;;) {
        const bool has_next = S.next(ui + 1, nxt);
        const char* nA = has_next ? (const char*)g.A + (size_t)nxt.pm * tstep : cA; const char* nB = has_next ? (const char*)g.Bt + (size_t)nxt.pn * tstep : cB;
        for (int t = 0; t < nt; t += 2) {
            const bool last = (t == nt - 2);
            const char* a1 = cA + (size_t)(t + 1) * kstep;
            const char* a2 = last ? nA : cA + (size_t)(t + 2) * kstep; const char* b2 = last ? nB : cB + (size_t)(t + 2) * kstep;
            const char* a3 = a2 + kstep; const char* b3 = b2 + kstep;
            if (last && has_next) S.a_ready(nxt);
            if constexpr (SP2) {
            PG8_LDB(B0, 0, 0); PG8_LDB(B1, 0, 1); PG8_SCHED; PG8_LDA(At, 0, 0); PG8_STAGE(PG8_SA(1, 1), a1 + hstep, voffA);
            PG8_WAIT_V(8); PG8_WAIT_L(0); PG8_BAR; PG8_MMA(0, 0, At, B0); PG8_MMA(0, 1, At, B1); PG8_BAR; PG8_SCHED;
            PG8_LDA(At, 0, 1); PG8_STAGE(PG8_SB(0, 0), b2, voffB); PG8_STAGE(PG8_SB(0, 1), b2 + hstep, voffB); PG8_STAGE(PG8_SA(0, 0), a2, voffA);
            PG8_WAIT_V(8); PG8_WAIT_L(0); PG8_BAR; PG8_MMA(1, 0, At, B0); PG8_MMA(1, 1, At, B1); PG8_BAR; PG8_SCHED;
            PG8_LDB(B0, 1, 0); PG8_LDB(B1, 1, 1); PG8_SCHED; PG8_LDA(At, 1, 0); PG8_STAGE(PG8_SA(0, 1), a2 + hstep, voffA);
            PG8_WAIT_V(8); PG8_WAIT_L(0); PG8_BAR; PG8_MMA(0, 0, At, B0); PG8_MMA(0, 1, At, B1); PG8_BAR; PG8_SCHED;
            PG8_LDA(At, 1, 1); PG8_STAGE(PG8_SB(1, 0), b3, voffB); PG8_STAGE(PG8_SB(1, 1), b3 + hstep, voffB); PG8_STAGE(PG8_SA(1, 0), a3, voffA);
            PG8_WAIT_V(8); PG8_WAIT_L(0); PG8_BAR; PG8_MMA(1, 0, At, B0); PG8_MMA(1, 1, At, B1); PG8_BAR; PG8_SCHED;
            } else {
            PG8_LDB(B0, 0, 0); PG8_SCHED; PG8_LDA(At, 0, 0); PG8_STAGE(PG8_SA(1, 1), a1 + hstep, voffA);
            PG8_WAIT_L(8); PG8_BAR; PG8_WAIT_L(0); PG8_MMA(0, 0, At, B0); PG8_BAR; PG8_SCHED;
            PG8_LDB(B1, 0, 1); PG8_STAGE(PG8_SB(0, 0), b2, voffB);
            PG8_BAR; PG8_WAIT_L(0); PG8_MMA(0, 1, At, B1); PG8_BAR;
            PG8_LDA(At, 0, 1); PG8_STAGE(PG8_SA(0, 0), a2, voffA);
            PG8_BAR; PG8_WAIT_L(0); PG8_MMA(1, 0, At, B0); PG8_BAR; PG8_SCHED;
            PG8_STAGE(PG8_SB(0, 1), b2 + hstep, voffB);
            PG8_WAIT_V(6); PG8_BAR; PG8_MMA(1, 1, At, B1); PG8_BAR;
            PG8_LDB(B0, 1, 0); PG8_SCHED; PG8_LDA(At, 1, 0); PG8_STAGE(PG8_SA(0, 1), a2 + hstep, voffA);
            PG8_WAIT_L(8); PG8_BAR; PG8_WAIT_L(0); PG8_MMA(0, 0, At, B0); PG8_BAR; PG8_SCHED;
            PG8_LDB(B1, 1, 1); PG8_STAGE(PG8_SB(1, 0), b3, voffB);
            PG8_BAR; PG8_WAIT_L(0); PG8_MMA(0, 1, At, B1); PG8_BAR;
            PG8_LDA(At, 1, 1); PG8_STAGE(PG8_SA(1, 0), a3, voffA);
            PG8_BAR; PG8_WAIT_L(0); PG8_MMA(1, 0, At, B0); PG8_BAR; PG8_SCHED;
            PG8_STAGE(PG8_SB(1, 1), b3 + hstep, voffB);
            PG8_WAIT_V(6); PG8_BAR; PG8_MMA(1, 1, At, B1); PG8_BAR;
            }
        }
        if constexpr (ALIGN_EPI) { if (wr == 0) PG8_BAR; }
        if constexpr (!Epi::AFTER_DRAIN) { E(acc, cur, wr, wc, fr, fq); S.done(cur); }
        if (!has_next) break;
#pragma unroll
        for (int a = 0; a < 2; ++a)
#pragma unroll
            for (int b = 0; b < 2; ++b)
#pragma unroll
                for (int m = 0; m < 4; ++m)
#pragma unroll
                    for (int n = 0; n < 2; ++n) acc[a][b][m][n] = (f32x4){0.f, 0.f, 0.f, 0.f};
        cur = nxt; cA = nA; cB = nB; ++ui;
        if constexpr (ALIGN_EPI) { if (wr == 1) PG8_BAR; }
    }
    PG8_WAIT_V(0);
    if constexpr (!ALIGN_EPI) { if (wr == 0) PG8_BAR; }
    PG8_BAR;
    if constexpr (Epi::AFTER_DRAIN) { E.fused(acc, cur, wr, wc, fr, fq, lds, wid, lane); S.done(cur); }
#undef PG8_SA
#undef PG8_SB
#undef PG8_STAGE
#undef PG8_LDA
#undef PG8_LDB
#undef PG8_MMA
#undef PG8_WAIT_V
#undef PG8_WAIT_L
#undef PG8_BAR
#undef PG8_SCHED
}
}
constexpr int T = 8192, D = 2048, NIN = 6528, NINP = 6656, RW = 1024, NH = 16, HD = 64, CH = 64, NCH = T / CH;
constexpr int C_R = 0, C_K = 1024, C_V = 2048, C_WD = 3072, C_AD = 3136, C_G = 3200, C_AQ = 4224, C_AK = 5248, C_AV = 5376, C_AG = 5504;
constexpr float RMS_EPS = 1e-5f, LNX_EPS = 64e-5f;
constexpr int NWAVES = 8, NTHR = 512;
constexpr size_t MiB = 1u << 20;
constexpr size_t WS_WTIN = 1 * MiB;
constexpr size_t WS_XN = 27 * MiB;
constexpr size_t WS_WTOUT = 59 * MiB;
constexpr size_t WS_UPT = 67 * MiB;
constexpr size_t WS_SSP = 68 * MiB;
constexpr size_t WS_PROJ = 70 * MiB;
constexpr size_t WS_SCR = 174 * MiB;
constexpr size_t WS_MIX = 1 * MiB;
constexpr int LDS_BYTES = 147456;

#define GAS __attribute__((address_space(1)))
#define LAS __attribute__((address_space(3)))
typedef unsigned short bf16;
typedef unsigned v4u __attribute__((ext_vector_type(4)));
typedef unsigned v2u __attribute__((ext_vector_type(2)));
typedef float f32x4 __attribute__((ext_vector_type(4)));
typedef float f32x16 __attribute__((ext_vector_type(16)));
typedef short bf16x8 __attribute__((ext_vector_type(8)));
typedef __bf16 bf16x2_t __attribute__((ext_vector_type(2)));
__device__ __forceinline__ unsigned pk2(float a, float b) { bf16x2_t v; v[0] = (__bf16)a; v[1] = (__bf16)b; return __builtin_bit_cast(unsigned, v); }
__device__ __forceinline__ float bflo(unsigned u) { return __uint_as_float(u << 16); }
__device__ __forceinline__ float bfhi(unsigned u) { return __uint_as_float(u & 0xffff0000u); }
__device__ __forceinline__ void unpack8(const v4u& p, float (&f)[8]) { f[0] = bflo(p.x); f[1] = bfhi(p.x); f[2] = bflo(p.y); f[3] = bfhi(p.y); f[4] = bflo(p.z); f[5] = bfhi(p.z); f[6] = bflo(p.w); f[7] = bfhi(p.w); }
__device__ __forceinline__ v4u pack8(const float (&f)[8]) { v4u o; o.x = pk2(f[0], f[1]); o.y = pk2(f[2], f[3]); o.z = pk2(f[4], f[5]); o.w = pk2(f[6], f[7]); return o; }
__device__ __forceinline__ float wave_sum(float v) {
#pragma unroll
    for (int o = 1; o < 64; o <<= 1) v += __shfl_xor(v, o);
    return v;
}
__device__ __forceinline__ float sum8(float v) { v += __shfl_xor(v, 1); v += __shfl_xor(v, 2); v += __shfl_xor(v, 4); return v; }
__device__ __forceinline__ float sigmoidf_(float x) { return 1.f / (1.f + __expf(-x)); }
__device__ __forceinline__ float siluf_(float x) { return x / (1.f + __expf(-x)); }

__device__ __forceinline__ void bar_lds() { asm volatile("s_waitcnt lgkmcnt(0)" ::: "memory"); __builtin_amdgcn_s_barrier(); asm volatile("" ::: "memory"); }
struct Args { const float* in[16]; float* out; unsigned char* ws; int ph_lo, ph_hi; };

__device__ __forceinline__ void p0_transpose_item(const float* W, int K, int N, bf16* WT, LAS float* scr, int item, int lane) {
    const int nblk = N / 32, kb = item / nblk, nb = item % nblk, k0 = 64 * kb, n0 = 32 * nb;
    { f32x4 v[8];
#pragma unroll
      for (int i = 0; i < 8; ++i) v[i] = *(const f32x4*)(W + (size_t)(k0 + 8 * i + (lane >> 3)) * N + n0 + 4 * (lane & 7));
#pragma unroll
      for (int i = 0; i < 8; ++i) { LAS float* d = scr + (8 * i + (lane >> 3)) * 33 + 4 * (lane & 7); d[0] = v[i].x; d[1] = v[i].y; d[2] = v[i].z; d[3] = v[i].w; } }
    asm volatile("s_waitcnt lgkmcnt(0)" ::: "memory");
    const int c = lane & 7;
#pragma unroll
    for (int j = 0; j < 4; ++j) { const int n = (lane >> 3) + 8 * j; const LAS float* s = scr + (8 * c) * 33 + n;
        v4u o; o.x = pk2(s[0 * 33], s[1 * 33]); o.y = pk2(s[2 * 33], s[3 * 33]); o.z = pk2(s[4 * 33], s[5 * 33]); o.w = pk2(s[6 * 33], s[7 * 33]);
        *(v4u*)(WT + (size_t)(n0 + n) * K + k0 + 8 * c) = o; }
    asm volatile("s_waitcnt lgkmcnt(0)" ::: "memory");
}
__device__ __forceinline__ void p0_prologue(const Args& a, LAS unsigned char* lds, int vcu, int G, int wave, int lane) {
    LAS float* scr = (LAS float*)(lds + wave * 16384);
    const int gw = vcu * NWAVES + wave, NGW = G * NWAVES;
    bf16* wtin = (bf16*)(a.ws + WS_WTIN); bf16* wtout = (bf16*)(a.ws + WS_WTOUT); bf16* upt = (bf16*)(a.ws + WS_UPT); bf16* aupt = upt + 65536;
    constexpr int I_IN = (D / 64) * (NIN / 32), I_OUT = (D / 64) * (D / 32), I_UP = RW / 32;
    constexpr int NITEMS = I_IN + I_OUT + 2 * I_UP;
    for (int it = gw; it < NITEMS; it += NGW) {
        int r = it;
        if (r < I_IN) { p0_transpose_item(a.in[2], D, NIN, wtin, scr, r, lane); continue; } r -= I_IN;
        if (r < I_OUT) { p0_transpose_item(a.in[14], D, D, wtout, scr, r, lane); continue; } r -= I_OUT;
        if (r < I_UP) { p0_transpose_item(a.in[5], 64, RW, upt, scr, r, lane); continue; } r -= I_UP;
        p0_transpose_item(a.in[7], 64, RW, aupt, scr, r, lane);
    }
    { v4u z = {0u, 0u, 0u, 0u}; v4u* p = (v4u*)(wtin + (size_t)NIN * D); const int n16 = (NINP - NIN) * D * 2 / 16;
      for (int i = gw * 64 + lane; i < n16; i += NGW * 64) p[i] = z; }
    const float* gain = a.in[1];
    for (int m = gw; m < T; m += 2 * NGW) {
        const int m2 = m + NGW;
        const f32x4* xr = (const f32x4*)(a.in[0] + (size_t)m * D) + lane; const f32x4* xr2 = (const f32x4*)(a.in[0] + (size_t)(m2 < T ? m2 : m) * D) + lane;
        f32x4 v[8], u[8]; float s = 0.f, s2 = 0.f;
#pragma unroll
        for (int j = 0; j < 8; ++j) { v[j] = xr[64 * j]; u[j] = xr2[64 * j]; }
#pragma unroll
        for (int j = 0; j < 8; ++j) { s += (v[j].x * v[j].x + v[j].y * v[j].y) + (v[j].z * v[j].z + v[j].w * v[j].w); s2 += (u[j].x * u[j].x + u[j].y * u[j].y) + (u[j].z * u[j].z + u[j].w * u[j].w); }
        const float rstd = 1.f / sqrtf(wave_sum(s) * (1.f / D) + RMS_EPS), rstd2 = 1.f / sqrtf(wave_sum(s2) * (1.f / D) + RMS_EPS);
        v2u* o8 = (v2u*)((bf16*)(a.ws + WS_XN) + (size_t)m * D) + lane; v2u* o82 = (v2u*)((bf16*)(a.ws + WS_XN) + (size_t)m2 * D) + lane;
#pragma unroll
        for (int j = 0; j < 8; ++j) { const f32x4 g = *((const f32x4*)gain + lane + 64 * j); v2u o; o.x = pk2(v[j].x * rstd * g.x, v[j].y * rstd * g.y); o.y = pk2(v[j].z * rstd * g.z, v[j].w * rstd * g.w); o8[64 * j] = o;
            if (m2 < T) { o.x = pk2(u[j].x * rstd2 * g.x, u[j].y * rstd2 * g.y); o.y = pk2(u[j].z * rstd2 * g.z, u[j].w * rstd2 * g.w); o82[64 * j] = o; } }
    }
}
__device__ __forceinline__ void final_norm(const Args& a, int vcu, int G, int wave, int lane) {
    const int gw = vcu * NWAVES + wave, NGW = G * NWAVES; const float* ssp = (const float*)(a.ws + WS_SSP); const float* gain = a.in[15];
    for (int m = gw; m < T; m += NGW) {
        float s = (lane < 32) ? ssp[(size_t)m * 32 + lane] : 0.f; s = wave_sum(s);
        const float rstd = 1.f / sqrtf(s * (1.f / D) + RMS_EPS);
        f32x4* xr = (f32x4*)(a.out + (size_t)m * D) + lane;
#pragma unroll
        for (int j = 0; j < 8; ++j) { f32x4 v = xr[64 * j]; const f32x4 g = *((const f32x4*)gain + lane + 64 * j); v.x *= rstd * g.x; v.y *= rstd * g.y; v.z *= rstd * g.z; v.w *= rstd * g.w; xr[64 * j] = v; }
    }
}
#define XB_TMO      128
#define XB_XCNT(j)  (256  + 64 * (j))
#define XB_XSUB(j)  (1280 + 64 * (j))
#define XB_XGEN(j)  (2304 + 64 * (j))
#define XB_TOP      3328
#define XB_TOPGEN   3392
#define XCD_BAR_WORDS 3456
#define XB_SPIN_CAP (1u << 18)

__device__ __forceinline__ unsigned xb_ld(unsigned* p)              { return __hip_atomic_load(p, __ATOMIC_RELAXED, __HIP_MEMORY_SCOPE_AGENT); }
__device__ __forceinline__ unsigned xb_add(unsigned* p, unsigned v) { return __hip_atomic_fetch_add(p, v, __ATOMIC_RELAXED, __HIP_MEMORY_SCOPE_AGENT); }
__device__ __forceinline__ unsigned xb_xcc_id() { return (unsigned)__builtin_amdgcn_s_getreg((3 << 11) | 20) & 0xFu; }
#define XB_SPIN(cond, bar) do { unsigned _sp = 0; while (cond) { __builtin_amdgcn_s_sleep(1); \
    if ((++_sp & 255u) == 0u) { if (xb_ld(&(bar)[XB_TMO])) break; if (_sp > XB_SPIN_CAP) { atomicAdd(&(bar)[XB_TMO], 1u); break; } } } } while (0)

struct XcdBarrier {
    unsigned* bar; unsigned x;
    volatile LAS unsigned* st;
};

__device__ __forceinline__ XcdBarrier xcd_barrier_post(unsigned* bar, volatile LAS unsigned* st) {
    XcdBarrier b; b.bar = bar; b.x = xb_xcc_id(); b.st = st;
    if (threadIdx.x == 0) (void)xb_add(&bar[XB_XCNT(b.x)], 1u);
    return b;
}
__device__ __forceinline__ void xcd_barrier_complete(unsigned* bar, unsigned x, unsigned& nloc, unsigned& nx) {
    const unsigned G = gridDim.x * gridDim.y * gridDim.z;
    unsigned sum, cnt, mine, sp = 0u;
    for (;;) {
        sum = 0u; cnt = 0u; mine = 0u;
#pragma unroll
        for (unsigned j = 0; j < 16; ++j) { const unsigned c = xb_ld(&bar[XB_XCNT(j)]); sum += c; cnt += (c > 0u) ? 1u : 0u; mine = (j == x) ? c : mine; }
        if (sum == G) break;
        __builtin_amdgcn_s_sleep(1);
        if ((++sp & 255u) == 0u) { if (xb_ld(&bar[XB_TMO])) break; if (sp > XB_SPIN_CAP) { atomicAdd(&bar[XB_TMO], 1u); break; } }
    }
    nloc = mine > 0u ? mine : 1u; nx = cnt > 0u ? cnt : 1u;
}

__device__ __forceinline__ void xcd_barrier(const XcdBarrier& b) {
    asm volatile("s_waitcnt vmcnt(0)" ::: "memory");
    __syncthreads();
    if (threadIdx.x == 0) {
        unsigned* bar = b.bar;
        __builtin_amdgcn_s_waitcnt(0);
        unsigned nloc = b.st[0], nx = b.st[1];
        if (nloc == 0u) { xcd_barrier_complete(bar, b.x, nloc, nx); b.st[0] = nloc; b.st[1] = nx; }
        const unsigned old = xb_add(&bar[XB_XSUB(b.x)], 1u);
        const unsigned gen = old / nloc;
        if (old + 1u == (gen + 1u) * nloc) {
            __builtin_amdgcn_fence(__ATOMIC_RELEASE, "agent");
            asm volatile("s_waitcnt vmcnt(0)" ::: "memory");
            const unsigned og = xb_add(&bar[XB_TOP], 1u);
            const unsigned tg = og / nx;
            if (og + 1u == (tg + 1u) * nx) xb_add(&bar[XB_TOPGEN], 1u);
            else XB_SPIN(xb_ld(&bar[XB_TOPGEN]) == tg, bar);
            __builtin_amdgcn_fence(__ATOMIC_ACQUIRE, "agent");
            xb_add(&bar[XB_XGEN(b.x)], 1u);
            asm volatile("s_waitcnt vmcnt(0)" ::: "memory");
        } else {
            XB_SPIN(xb_ld(&bar[XB_XGEN(b.x)]) == gen, bar);
            __builtin_amdgcn_fence(__ATOMIC_ACQUIRE, "agent");
            asm volatile("s_waitcnt vmcnt(0)" ::: "memory");
        }
    }
    __syncthreads();
}

#define MFMA32(a_, b_, c_) __builtin_amdgcn_mfma_f32_32x32x16_bf16((a_), (b_), (c_), 0, 0, 0)
#define MFMA16(a_, b_, c_) __builtin_amdgcn_mfma_f32_16x16x32_bf16((a_), (b_), (c_), 0, 0, 0)
__device__ __forceinline__ v4u ldg16(const bf16* p) { return *(const v4u*)p; }
__device__ __forceinline__ void load_shift8(const bf16* proj, int row, int col, const float* mu, float (&o)[8]) {
    const v4u p = ldg16(proj + (size_t)row * NINP + col); v4u q = {0u, 0u, 0u, 0u};
    if (row > 0) q = ldg16(proj + (size_t)(row - 1) * NINP + col);
    float pf[8], qf[8]; unpack8(p, pf); unpack8(q, qf);
    const f32x4 m0 = *(const f32x4*)(mu + col), m1 = *(const f32x4*)(mu + col + 4);
    const float mf[8] = {m0.x, m0.y, m0.z, m0.w, m1.x, m1.y, m1.z, m1.w};
#pragma unroll
    for (int j = 0; j < 8; ++j) o[j] = pf[j] + (qf[j] - pf[j]) * mf[j];
}
__device__ __forceinline__ void ld8f(const float* p, float (&o)[8]) { const f32x4 a = *(const f32x4*)p, b = *(const f32x4*)(p + 4); o[0] = a.x; o[1] = a.y; o[2] = a.z; o[3] = a.w; o[4] = b.x; o[5] = b.y; o[6] = b.z; o[7] = b.w; }

constexpr int VP = 168;
__device__ __forceinline__ void attn_unit(const Args& a, LAS unsigned char* lds, int unit, int tid, int wave, int lane) {
    const bf16* proj = (const bf16*)(a.ws + WS_PROJ); bf16* mix = (bf16*)(a.ws + WS_MIX);
    const int qb = unit >> 1, kvh = unit & 1, q0 = qb * 32, kbase = q0 - 128, hq = kvh * 8 + wave;
    LAS bf16* VT = (LAS bf16*)lds;
    bar_lds();
    for (int idx = tid; idx < 160 * 8; idx += NTHR) {
        const int key = idx >> 3, d8 = (idx & 7) * 8, tk = kbase + key;
        v4u p = {0u, 0u, 0u, 0u};
        if (tk >= 0) p = ldg16(proj + (size_t)tk * NINP + C_AV + kvh * 64 + d8);
        const unsigned w[4] = {p.x, p.y, p.z, p.w};
#pragma unroll
        for (int j = 0; j < 4; ++j) { VT[(d8 + 2 * j) * VP + key] = (bf16)(w[j] & 0xffffu); VT[(d8 + 2 * j + 1) * VP + key] = (bf16)(w[j] >> 16); }
    }
    bar_lds();
    const int r = lane & 31, h = lane >> 5;
    bf16x8 bq[4];
    { const bf16* qrow = proj + (size_t)(q0 + r) * NINP + C_AQ + hq * 64 + 8 * h;
#pragma unroll
      for (int s = 0; s < 4; ++s) bq[s] = *(const bf16x8*)(qrow + 16 * s); }
    const float slope = exp2f(-0.5f * (float)(hq + 1)), sink = a.in[13][hq];
    f32x16 sc[5]; float mx = sink;
#pragma unroll
    for (int kt = 0; kt < 5; ++kt) {
        const int tkb = kbase + 32 * kt;
        f32x16 acc; for (int i = 0; i < 16; ++i) acc[i] = 0.f;
        if (tkb >= 0) {
            const bf16* krow = proj + (size_t)(tkb + r) * NINP + C_AK + kvh * 64 + 8 * h;
#pragma unroll
            for (int s = 0; s < 4; ++s) acc = MFMA32(*(const bf16x8*)(krow + 16 * s), bq[s], acc);
        }
#pragma unroll
        for (int i = 0; i < 16; ++i) {
            const int key = tkb + (i & 3) + 8 * (i >> 2) + 4 * h, dist = (q0 + r) - key;
            const bool valid = (tkb >= 0) && (dist >= 0) && (dist < 128);
            const float v = valid ? acc[i] * 0.125f - slope * (float)dist : -1e30f;
            sc[kt][i] = v; mx = fmaxf(mx, v);
        }
        __builtin_amdgcn_sched_barrier(0);
    }
    mx = fmaxf(mx, __shfl_xor(mx, 32));
    float sum = 0.f;
#pragma unroll
    for (int kt = 0; kt < 5; ++kt)
#pragma unroll
        for (int i = 0; i < 16; ++i) { const float p = __expf(sc[kt][i] - mx); sc[kt][i] = p; sum += p; }
    sum += __shfl_xor(sum, 32); sum += __expf(sink - mx);
    f32x16 o[2]; for (int i = 0; i < 16; ++i) { o[0][i] = 0.f; o[1][i] = 0.f; }
#pragma unroll
    for (int kt = 0; kt < 5; ++kt) {
        if (kbase + 32 * kt >= 0) {
#pragma unroll
            for (int s = 0; s < 2; ++s) {
                v4u pw; pw.x = pk2(sc[kt][8 * s + 0], sc[kt][8 * s + 1]); pw.y = pk2(sc[kt][8 * s + 2], sc[kt][8 * s + 3]); pw.z = pk2(sc[kt][8 * s + 4], sc[kt][8 * s + 5]); pw.w = pk2(sc[kt][8 * s + 6], sc[kt][8 * s + 7]);
                const bf16x8 pb = __builtin_bit_cast(bf16x8, pw);
#pragma unroll
                for (int dt = 0; dt < 2; ++dt) {
                    const LAS bf16* vp = VT + (32 * dt + r) * VP + 32 * kt + 16 * s + 4 * h;
                    const v2u lo = *(const LAS v2u*)vp, hi = *(const LAS v2u*)(vp + 8);
                    v4u vw; vw.x = lo.x; vw.y = lo.y; vw.z = hi.x; vw.w = hi.y;
                    o[dt] = MFMA32(__builtin_bit_cast(bf16x8, vw), pb, o[dt]);
                }
            }
        }
    }
    const float inv = 1.f / sum;
#pragma unroll
    for (int dt = 0; dt < 2; ++dt)
#pragma unroll
        for (int g4 = 0; g4 < 4; ++g4) {
            const int d0 = 32 * dt + 8 * g4 + 4 * h;
            const v2u gp = *(const v2u*)(proj + (size_t)(q0 + r) * NINP + C_AG + hq * 64 + d0);
            v2u w; w.x = pk2(o[dt][4 * g4 + 0] * inv * siluf_(bflo(gp.x)), o[dt][4 * g4 + 1] * inv * siluf_(bfhi(gp.x)));
            w.y = pk2(o[dt][4 * g4 + 2] * inv * siluf_(bflo(gp.y)), o[dt][4 * g4 + 3] * inv * siluf_(bfhi(gp.y)));
            *(v2u*)(mix + (size_t)(q0 + r) * D + RW + hq * 64 + d0) = w;
        }
}

struct Prep { float r[8], kp[8], v[8], g[8], w[8], lw[8], kk[8], b[8], bonus; };
__device__ __forceinline__ void rwkv_prep(const Args& a, LAS unsigned char* lds, int h, int t0, int tid, int wave, int lane, Prep& P) {
    const bf16* proj = (const bf16*)(a.ws + WS_PROJ); const bf16* upt = (const bf16*)(a.ws + WS_UPT); const bf16* aupt = upt + 65536;
    LAS bf16* TW = (LAS bf16*)lds; LAS bf16* ADm = TW + 64 * 72; LAS float* Z = (LAS float*)(lds + 18432); LAS float* AP = Z + 64 * 68;
    const int t = tid >> 3, c8 = (tid & 7) * 8, ch = h * 64 + c8, row = t0 + t;
    const float* mu = a.in[3];
    { float x[8]; load_shift8(proj, row, C_WD + c8, mu, x);
#pragma unroll
      for (int j = 0; j < 8; ++j) x[j] = 1.f - 2.f * __builtin_amdgcn_rcpf(1.f + __expf(2.f * x[j]));
      *(LAS v4u*)(TW + t * 72 + c8) = pack8(x);
      load_shift8(proj, row, C_AD + c8, mu, x); *(LAS v4u*)(ADm + t * 72 + c8) = pack8(x); }
    bar_lds();
    { const int rt = wave & 3, cp = (wave >> 2) * 2, fr = lane & 15, fq = lane >> 4;
      bf16x8 aT[2], aA[2];
#pragma unroll
      for (int s = 0; s < 2; ++s) { aT[s] = *(const LAS bf16x8*)(TW + (16 * rt + fr) * 72 + 32 * s + 8 * fq); aA[s] = *(const LAS bf16x8*)(ADm + (16 * rt + fr) * 72 + 32 * s + 8 * fq); }
#pragma unroll
      for (int ci = 0; ci < 2; ++ci) { const int ct = cp + ci; f32x4 z = {0.f, 0.f, 0.f, 0.f}, ap = {0.f, 0.f, 0.f, 0.f};
#pragma unroll
          for (int s = 0; s < 2; ++s) { const size_t bo = (size_t)(h * 64 + 16 * ct + fr) * 64 + 32 * s + 8 * fq;
              z = MFMA16(aT[s], *(const bf16x8*)(upt + bo), z); ap = MFMA16(aA[s], *(const bf16x8*)(aupt + bo), ap); }
#pragma unroll
          for (int j = 0; j < 4; ++j) { Z[(16 * rt + 4 * fq + j) * 68 + 16 * ct + fr] = z[j]; AP[(16 * rt + 4 * fq + j) * 68 + 16 * ct + fr] = ap[j]; } } }
    bar_lds();
    float zz[8], aa[8], kr[8], c0[8], c1[8];
#pragma unroll
    for (int j = 0; j < 8; ++j) { zz[j] = Z[t * 68 + c8 + j]; aa[j] = AP[t * 68 + c8 + j]; }
    load_shift8(proj, row, C_R + ch, mu, P.r); load_shift8(proj, row, C_K + ch, mu, kr); load_shift8(proj, row, C_V + ch, mu, P.v); load_shift8(proj, row, C_G + ch, mu, P.g);
    ld8f(a.in[4] + ch, c0); ld8f(a.in[6] + ch, c1);
#pragma unroll
    for (int j = 0; j < 8; ++j) { const float z = c0[j] + zz[j]; const float sp = (z < -15.f) ? -z : __logf(1.f + __expf(-z)); const float wl = -sp - 0.5f; P.lw[j] = -__expf(wl); P.w[j] = __expf(P.lw[j]); aa[j] = sigmoidf_(c1[j] + aa[j]); }
    ld8f(a.in[8] + ch, c0); ld8f(a.in[9] + ch, c1);
    float ss = 0.f;
#pragma unroll
    for (int j = 0; j < 8; ++j) { P.kk[j] = kr[j] * c0[j]; ss += P.kk[j] * P.kk[j]; P.kp[j] = kr[j] * (1.f + (aa[j] - 1.f) * c1[j]); }
    ss = sum8(ss); const float rn = 1.f / fmaxf(sqrtf(ss), 1e-12f);
    ld8f(a.in[10] + ch, c0);
    float bs = 0.f;
#pragma unroll
    for (int j = 0; j < 8; ++j) { P.kk[j] *= rn; P.b[j] = P.kk[j] * aa[j]; bs += P.r[j] * P.kp[j] * c0[j]; }
    P.bonus = sum8(bs);
}
__device__ __forceinline__ void rwkv_out8(const Args& a, const float (&y)[8], const float (&v)[8], const float (&g)[8], float bonus, int row, int ch) {
    bf16* mix = (bf16*)(a.ws + WS_MIX);
    float s = 0.f;
#pragma unroll
    for (int j = 0; j < 8; ++j) s += y[j];
    const float mean = sum8(s) * (1.f / 64.f); float q = 0.f;
#pragma unroll
    for (int j = 0; j < 8; ++j) { const float d = y[j] - mean; q += d * d; }
    const float rstd = 1.f / sqrtf(sum8(q) * (1.f / 64.f) + LNX_EPS);
    float lg[8], lb[8], o[8]; ld8f(a.in[11] + ch, lg); ld8f(a.in[12] + ch, lb);
#pragma unroll
    for (int j = 0; j < 8; ++j) { const float yn = (y[j] - mean) * rstd * lg[j] + lb[j] + bonus * v[j]; o[j] = yn * siluf_(g[j]); }
    *(v4u*)(mix + (size_t)row * D + ch) = pack8(o);
}
constexpr size_t WS_MF = 174 * MiB, WS_QF = 190 * MiB, WS_SF = 206 * MiB, WS_BON = 222 * MiB;
constexpr size_t OUT_NF = 0, OUT_Y2 = 32 * MiB;
constexpr int MP = 72;
constexpr int L_AT = 0, L_ATT = 9216, L_BT = 18432, L_KT = 27648, L_RT = 36864, L_BHT = 46080, L_KHT = 55296, L_VT = 64512, L_LW = 73728, L_P = 73728, L_PT = 82944,
              L_AAK = 92160, L_ARB = 101376, L_ARK = 110592, L_TM = 119808, L_SEG = 119808, L_GC = 129024, L_WT = L_AT, L_X1T = L_BT, L_U2T = L_KT;
struct WTile { int ta, tb0, fr, fq; };
__device__ __forceinline__ bf16x8 ldfrag(const LAS bf16* M, int tile, int s, const WTile& w) { return *(const LAS bf16x8*)(M + (16 * tile + w.fr) * MP + 32 * s + 8 * w.fq); }
__device__ __forceinline__ void mm2(const LAS bf16* A, const LAS bf16* B, const WTile& w, f32x4 (&acc)[2]) {
#pragma unroll
    for (int s = 0; s < 2; ++s) { const bf16x8 af = ldfrag(A, w.ta, s, w);
#pragma unroll
        for (int ci = 0; ci < 2; ++ci) acc[ci] = MFMA16(af, ldfrag(B, w.tb0 + ci, s, w), acc[ci]); }
}
__device__ __forceinline__ void st_T(LAS bf16* X, int ta, int tb, const WTile& w, const f32x4& v) { v2u o; o.x = pk2(v[0], v[1]); o.y = pk2(v[2], v[3]); *(LAS v2u*)(X + (16 * tb + w.fr) * MP + 16 * ta + 4 * w.fq) = o; }
__device__ __forceinline__ void st_N(LAS bf16* X, int ta, int tb, const WTile& w, const f32x4& v) {
    const unsigned a = pk2(v[0], v[1]), b = pk2(v[2], v[3]); LAS bf16* p = X + (16 * ta + 4 * w.fq) * MP + 16 * tb + w.fr;
    p[0] = (bf16)(a & 0xffffu); p[MP] = (bf16)(a >> 16); p[2 * MP] = (bf16)(b & 0xffffu); p[3 * MP] = (bf16)(b >> 16);
}
#define ZERO2(x) do { x[0] = (f32x4){0.f, 0.f, 0.f, 0.f}; x[1] = (f32x4){0.f, 0.f, 0.f, 0.f}; } while (0)
template <int MODE> __device__ __forceinline__ void mask2(f32x4 (&acc)[2], const WTile& w) {
#pragma unroll
    for (int ci = 0; ci < 2; ++ci)
#pragma unroll
        for (int j = 0; j < 4; ++j) { const int row = 16 * w.ta + 4 * w.fq + j, col = 16 * (w.tb0 + ci) + w.fr;
            const bool keep = MODE == 0 ? (row < col) : (MODE == 1 ? (row <= col) : (col < row)); if (!keep) acc[ci][j] = 0.f; }
}
__device__ __forceinline__ void st_bf16x8_T(LAS bf16* X, int c8, int t, const float (&v)[8]) {
    const v4u p = pack8(v); const unsigned w[4] = {p.x, p.y, p.z, p.w};
#pragma unroll
    for (int j = 0; j < 4; ++j) { X[(c8 + 2 * j) * MP + t] = (bf16)(w[j] & 0xffffu); X[(c8 + 2 * j + 1) * MP + t] = (bf16)(w[j] >> 16); }
}

__device__ __forceinline__ void rwkv_chunk_prep(const Args& a, LAS unsigned char* lds, int unit, int tid, int wave, int lane) {
    const int c = unit >> 4, h = unit & 15, t0 = c * CH, t = tid >> 3, c8 = (tid & 7) * 8;
    LAS bf16* At = (LAS bf16*)(lds + L_AT); LAS bf16* AtT = (LAS bf16*)(lds + L_ATT); LAS bf16* Bt = (LAS bf16*)(lds + L_BT); LAS bf16* Kt = (LAS bf16*)(lds + L_KT);
    LAS bf16* Rt = (LAS bf16*)(lds + L_RT); LAS bf16* BhT = (LAS bf16*)(lds + L_BHT); LAS bf16* KhT = (LAS bf16*)(lds + L_KHT); LAS bf16* VT = (LAS bf16*)(lds + L_VT);
    LAS float* LW = (LAS float*)(lds + L_LW); LAS bf16* Pm = (LAS bf16*)(lds + L_P); LAS bf16* PT = (LAS bf16*)(lds + L_PT);
    LAS bf16* AAK = (LAS bf16*)(lds + L_AAK); LAS bf16* ARB = (LAS bf16*)(lds + L_ARB); LAS bf16* ARK = (LAS bf16*)(lds + L_ARK); LAS bf16* TM = (LAS bf16*)(lds + L_TM);
    LAS float* SEG = (LAS float*)(lds + L_SEG); LAS float* GC = (LAS float*)(lds + L_GC);
    LAS bf16* WT = (LAS bf16*)(lds + L_WT); LAS bf16* X1T = (LAS bf16*)(lds + L_X1T); LAS bf16* U2T = (LAS bf16*)(lds + L_U2T);
    bar_lds();
    Prep P; rwkv_prep(a, lds, h, t0, tid, wave, lane, P);
#ifdef PROBE_PREP2
    bar_lds(); rwkv_prep(a, lds, h, t0, tid, wave, lane, P);
#endif
    if ((tid & 7) == 0) ((float*)(a.ws + WS_BON))[(size_t)(t0 + t) * 16 + h] = P.bonus;
#pragma unroll
    for (int j = 0; j < 8; ++j) LW[t * 68 + c8 + j] = P.lw[j];
    bar_lds();
    { const int cc = tid & 63, sg = tid >> 6; float run = 0.f;
#pragma unroll
      for (int i = 0; i < 8; ++i) { run += LW[(8 * sg + i) * 68 + cc]; LW[(8 * sg + i) * 68 + cc] = run; }
      SEG[sg * 64 + cc] = run; }
    bar_lds();
    {
        float Lt[8], LC[8];
#pragma unroll
        for (int j = 0; j < 8; ++j) { float off = 0.f, tot = 0.f;
#pragma unroll
            for (int s = 0; s < 8; ++s) { const float sv = SEG[s * 64 + c8 + j]; tot += sv; if (s < (t >> 3)) off += sv; }
            Lt[j] = LW[t * 68 + c8 + j] + off; LC[j] = tot; }
        if (t == 0) {
#pragma unroll
            for (int j = 0; j < 8; ++j) GC[c8 + j] = __expf(LC[j]); }
        float x[8], y[8];
#pragma unroll
        for (int j = 0; j < 8; ++j) x[j] = -P.kk[j] * __expf(Lt[j] - P.lw[j]);
        *(LAS v4u*)(At + t * MP + c8) = pack8(x); st_bf16x8_T(AtT, c8, t, x);
#pragma unroll
        for (int j = 0; j < 8; ++j) { const float e = __expf(-Lt[j]); x[j] = P.b[j] * e; y[j] = P.kp[j] * e; }
        *(LAS v4u*)(Bt + t * MP + c8) = pack8(x); *(LAS v4u*)(Kt + t * MP + c8) = pack8(y);
#pragma unroll
        for (int j = 0; j < 8; ++j) x[j] = P.r[j] * __expf(Lt[j]);
        *(LAS v4u*)(Rt + t * MP + c8) = pack8(x);
#pragma unroll
        for (int j = 0; j < 8; ++j) { const float e = __expf(LC[j] - Lt[j]); x[j] = P.b[j] * e; y[j] = P.kp[j] * e; }
        st_bf16x8_T(BhT, c8, t, x); st_bf16x8_T(KhT, c8, t, y); st_bf16x8_T(VT, c8, t, P.v);
    }
    bar_lds();
    WTile w; w.ta = wave & 3; w.tb0 = (wave >> 2) * 2; w.fr = lane & 15; w.fq = lane >> 4;
    f32x4 acc[2], Tacc[2];
    ZERO2(Tacc); mm2(At, Bt, w, Tacc); mask2<2>(Tacc, w);
    ZERO2(acc); mm2(Kt, At, w, acc); mask2<0>(acc, w);
    f32x4 rb[2], rk[2]; ZERO2(rb); mm2(Bt, Rt, w, rb); mask2<1>(rb, w); ZERO2(rk); mm2(Kt, Rt, w, rk); mask2<1>(rk, w);
    bar_lds();
#pragma unroll
    for (int ci = 0; ci < 2; ++ci) { st_N(Pm, w.ta, w.tb0 + ci, w, Tacc[ci]); st_T(PT, w.ta, w.tb0 + ci, w, Tacc[ci]);
        st_T(AAK, w.ta, w.tb0 + ci, w, acc[ci]); st_T(ARB, w.ta, w.tb0 + ci, w, rb[ci]); st_T(ARK, w.ta, w.tb0 + ci, w, rk[ci]);
#pragma unroll
        for (int j = 0; j < 4; ++j) if (16 * w.ta + 4 * w.fq + j == 16 * (w.tb0 + ci) + w.fr) Tacc[ci][j] += 1.f;
        st_N(TM, w.ta, w.tb0 + ci, w, Tacc[ci]); }
    bar_lds();
#pragma unroll 1
#ifdef PROBE_NEU2
    for (int n = 0; n < 10; ++n) {
#else
    for (int n = 0; n < 5; ++n) {
#endif
        ZERO2(acc); mm2(Pm, PT, w, acc);
        bar_lds();
#pragma unroll
        for (int ci = 0; ci < 2; ++ci) { st_N(Pm, w.ta, w.tb0 + ci, w, acc[ci]); st_T(PT, w.ta, w.tb0 + ci, w, acc[ci]); }
        bar_lds();
        mm2(TM, PT, w, Tacc);
        bar_lds();
#pragma unroll
        for (int ci = 0; ci < 2; ++ci) st_N(TM, w.ta, w.tb0 + ci, w, Tacc[ci]);
        bar_lds();
    }
    ZERO2(acc); mm2(TM, AtT, w, acc); ZERO2(rb); mm2(AAK, VT, w, rb);
#pragma unroll
    for (int ci = 0; ci < 2; ++ci) { st_T(WT, w.ta, w.tb0 + ci, w, acc[ci]); st_T(X1T, w.ta, w.tb0 + ci, w, rb[ci]); }
    bar_lds();
    const size_t ub = (size_t)unit * 4096;
    { ZERO2(acc); mm2(TM, X1T, w, acc);
#pragma unroll
      for (int ci = 0; ci < 2; ++ci) st_T(U2T, w.ta, w.tb0 + ci, w, acc[ci]);
      bf16* MF = (bf16*)(a.ws + WS_MF) + ub; bf16* QF = (bf16*)(a.ws + WS_QF) + ub;
      ZERO2(acc); mm2(WT, BhT, w, acc);
      ZERO2(rb); mm2(WT, ARB, w, rb);
#pragma unroll
      for (int ci = 0; ci < 2; ++ci) { const int tb = w.tb0 + ci; const int col = 16 * tb + w.fr; const float gc = GC[col];
          f32x4 m = acc[ci];
#pragma unroll
          for (int j = 0; j < 4; ++j) if (16 * w.ta + 4 * w.fq + j == col) m[j] += gc;
          const size_t fo = (size_t)((tb * 2 + (w.ta >> 1)) * 64 + lane) * 8 + 4 * (w.ta & 1);
          v2u o; o.x = pk2(m[0], m[1]); o.y = pk2(m[2], m[3]); *(v2u*)(MF + fo) = o;
          const v2u rr = *(const LAS v2u*)(Rt + col * MP + 16 * w.ta + 4 * w.fq);
          f32x4 q = rb[ci]; q[0] += bflo(rr.x); q[1] += bfhi(rr.x); q[2] += bflo(rr.y); q[3] += bfhi(rr.y);
          o.x = pk2(q[0], q[1]); o.y = pk2(q[2], q[3]); *(v2u*)(QF + fo) = o; } }
    bar_lds();
    { float* NF = (float*)((unsigned char*)a.out + OUT_NF) + ub; float* Y2 = (float*)((unsigned char*)a.out + OUT_Y2) + ub;
      ZERO2(acc); mm2(BhT, U2T, w, acc); mm2(KhT, VT, w, acc);
      ZERO2(rb); mm2(U2T, ARB, w, rb); mm2(VT, ARK, w, rb);
#pragma unroll
      for (int ci = 0; ci < 2; ++ci) { const int tb = w.tb0 + ci;
          *(f32x4*)(NF + (size_t)((tb * 4 + w.ta) * 64 + lane) * 4) = acc[ci];
          *(f32x4*)(Y2 + (size_t)(16 * tb + w.fr) * 64 + 16 * w.ta + 4 * w.fq) = rb[ci]; } }
}

constexpr int KR = 4, NR = NCH / KR, SLOT = 12288, RBUF = KR * SLOT, NPIECE = RBUF / 16, LPT = 7;
__device__ __forceinline__ const v4u* sp_src(const Args& a, int h, int cg, int r, int p) {
    const int cc = p / 768, q = p % 768, c = r * KR + cc; const size_t ub = (size_t)(c * 16 + h) * 4096;
    return q < 512 ? (const v4u*)((const bf16*)(a.ws + WS_MF) + ub) + q : (const v4u*)((const float*)((const unsigned char*)a.out + OUT_NF) + ub + cg * 1024) + (q - 512);
}
__device__ __forceinline__ void state_pass(const Args& a, LAS unsigned char* lds, int b, int tid, int wave, int lane) {
    const int h = b >> 2, cg = b & 3, lt = tid - 64;
    v4u ra[LPT], rb[LPT];
    if (wave != 0) {
#pragma unroll
        for (int i = 0; i < LPT; ++i) { const int p = lt + 448 * i; if (p < NPIECE) ra[i] = *sp_src(a, h, cg, 0, p); }
#pragma unroll
        for (int i = 0; i < LPT; ++i) { const int p = lt + 448 * i; if (p < NPIECE) *(LAS v4u*)(lds + p * 16) = ra[i]; }
#pragma unroll
        for (int i = 0; i < LPT; ++i) { const int p = lt + 448 * i; if (p < NPIECE) ra[i] = *sp_src(a, h, cg, 1, p); }
    }
    f32x4 st[4];
#pragma unroll
    for (int i = 0; i < 4; ++i) st[i] = (f32x4){0.f, 0.f, 0.f, 0.f};
    bar_lds();
    bf16* SF = (bf16*)(a.ws + WS_SF);
#define SP_ROUND(r_, RA, RB) do { \
        if (wave != 0) { \
            if ((r_) + 2 < NR) { _Pragma("unroll") for (int i = 0; i < LPT; ++i) { const int p = lt + 448 * i; if (p < NPIECE) RB[i] = *sp_src(a, h, cg, (r_) + 2, p); } } \
            if ((r_) + 1 < NR) { _Pragma("unroll") for (int i = 0; i < LPT; ++i) { const int p = lt + 448 * i; if (p < NPIECE) *(LAS v4u*)(lds + (((r_) + 1) & 1) * RBUF + p * 16) = RA[i]; } } \
        } else { \
            _Pragma("unroll") for (int cc = 0; cc < KR; ++cc) { \
                const LAS unsigned char* sl = lds + ((r_) & 1) * RBUF + cc * SLOT; const int c = (r_) * KR + cc; \
                v4u b0, b1; b0.x = pk2(st[0][0], st[0][1]); b0.y = pk2(st[0][2], st[0][3]); b0.z = pk2(st[1][0], st[1][1]); b0.w = pk2(st[1][2], st[1][3]); \
                b1.x = pk2(st[2][0], st[2][1]); b1.y = pk2(st[2][2], st[2][3]); b1.z = pk2(st[3][0], st[3][1]); b1.w = pk2(st[3][2], st[3][3]); \
                v4u* sfo = (v4u*)(SF + (size_t)(c * 16 + h) * 4096) + (cg * 2) * 64 + lane; sfo[0] = b0; sfo[64] = b1; \
                const bf16x8 f0 = __builtin_bit_cast(bf16x8, b0), f1 = __builtin_bit_cast(bf16x8, b1); \
                _Pragma("unroll") for (int rt = 0; rt < 4; ++rt) { \
                    f32x4 n = *(const LAS f32x4*)(sl + 8192 + (rt * 64 + lane) * 16); \
                    n = MFMA16(*(const LAS bf16x8*)(sl + ((rt * 2 + 0) * 64 + lane) * 16), f0, n); \
                    n = MFMA16(*(const LAS bf16x8*)(sl + ((rt * 2 + 1) * 64 + lane) * 16), f1, n); st[rt] = n; } \
            } \
        } \
        bar_lds(); } while (0)
#pragma unroll 1
    for (int r = 0; r < NR; r += 2) { SP_ROUND(r, ra, rb); SP_ROUND(r + 1, rb, ra); }
#undef SP_ROUND
}

__device__ __forceinline__ void rwkv_out_unit(const Args& a, LAS unsigned char* lds, int unit, int tid, int wave, int lane) {
    const int c = unit >> 4, h = unit & 15, t0 = c * CH, t = tid >> 3, c8 = (tid & 7) * 8, ch = h * 64 + c8;
    const size_t ub = (size_t)unit * 4096;
    const bf16* QF = (const bf16*)(a.ws + WS_QF) + ub; const bf16* SF = (const bf16*)(a.ws + WS_SF) + ub; const float* Y2 = (const float*)((const unsigned char*)a.out + OUT_Y2) + ub;
    LAS float* SY = (LAS float*)lds;
    const int ta = wave & 3, tb0 = (wave >> 2) * 2, fr = lane & 15, fq = lane >> 4;
    bf16x8 af[2], bfr[2][2];
#pragma unroll
    for (int s = 0; s < 2; ++s) { af[s] = *(const bf16x8*)(QF + (size_t)((ta * 2 + s) * 64 + lane) * 8);
#pragma unroll
        for (int ci = 0; ci < 2; ++ci) bfr[s][ci] = *(const bf16x8*)(SF + (size_t)(((tb0 + ci) * 2 + s) * 64 + lane) * 8); }
    float y2[8], v[8], g[8];
    ld8f(Y2 + t * 64 + c8, y2);
    const bf16* proj = (const bf16*)(a.ws + WS_PROJ);
    load_shift8(proj, t0 + t, C_V + ch, a.in[3], v); load_shift8(proj, t0 + t, C_G + ch, a.in[3], g);
    const float bonus = ((const float*)(a.ws + WS_BON))[(size_t)(t0 + t) * 16 + h];
    f32x4 acc[2]; ZERO2(acc);
#pragma unroll
    for (int s = 0; s < 2; ++s)
#pragma unroll
        for (int ci = 0; ci < 2; ++ci) acc[ci] = MFMA16(af[s], bfr[s][ci], acc[ci]);
    bar_lds();
#pragma unroll
    for (int ci = 0; ci < 2; ++ci)
#pragma unroll
        for (int j = 0; j < 4; ++j) SY[(16 * ta + 4 * fq + j) * 68 + 16 * (tb0 + ci) + fr] = acc[ci][j];
    bar_lds();
    float y[8];
#pragma unroll
    for (int j = 0; j < 8; ++j) y[j] = SY[t * 68 + c8 + j] + y2[j];
    rwkv_out8(a, y, v, g, bonus, t0 + t, ch);
}
#ifndef HOSTDUP
#define HOSTDUP -1
#endif
#ifndef ONE_LAUNCH
#define ONE_LAUNCH 1
#endif
#if HOSTDUP != -1 || defined(MULTI)
#undef ONE_LAUNCH
#define ONE_LAUNCH 0
#endif
constexpr int NPHASE = 7;
__global__ void __launch_bounds__(NTHR, 2) mega(Args a) {
    extern __shared__ __attribute__((aligned(16))) unsigned char lds_[];
    LAS unsigned char* lds = (LAS unsigned char*)lds_;
    const int tid = threadIdx.x, lane = tid & 63, wave = __builtin_amdgcn_readfirstlane(tid >> 6);
    const int G = gridDim.x, bx = blockIdx.x, vcu = (G % 8 == 0) ? (bx % 8) * (G / 8) + bx / 8 : bx;
    cg::grid_group grid = cg::this_grid();
    volatile LAS unsigned* xst = (volatile LAS unsigned*)(lds + 131072 + 64);
    if (tid < 2) xst[tid] = 0u;
    __syncthreads();
    XcdBarrier xbar; xbar.bar = (unsigned*)a.ws; xbar.x = 0; xbar.st = xst;
    if (a.ph_hi - a.ph_lo > 1) xbar = xcd_barrier_post((unsigned*)a.ws, xst);
#define IN(k) (a.ph_lo <= (k) && (k) < a.ph_hi)
#define SEAM(k) do { if (IN(k) && IN((k) + 1)) xcd_barrier(xbar); } while (0)
    if (a.ph_lo < 0) grid.sync();
    if (IN(0)) { p0_prologue(a, lds, vcu, G, wave, lane); }
    SEAM(0);
    if (IN(1)) {
        pg8::Gemm g{(const pg8::bf16_t*)(a.ws + WS_XN), (const pg8::bf16_t*)(a.ws + WS_WTIN), T, NINP, D}; pg8::StaticOrder S; S.init(T, NINP, G, bx);
        pg8::EpiBf16<0> E{(pg8::bf16_t*)(a.ws + WS_PROJ), NINP, nullptr, 0, 0, 1.f};
        pg8::gemm_phase<pg8::EpiBf16<0>, pg8::StaticOrder, true, true>(lds, g, S, E);
    }
    SEAM(1);
    if (IN(2)) {
        for (int it = bx; it < 512; it += G) attn_unit(a, lds, it, tid, wave, lane);
        for (int it = bx; it < NCH * NH; it += G) rwkv_chunk_prep(a, lds, it, tid, wave, lane);
    }
    SEAM(2);
    if (IN(3)) { if (bx < 64) state_pass(a, lds, bx, tid, wave, lane); }
    SEAM(3);
    if (IN(4)) { for (int u = bx; u < NCH * NH; u += G) rwkv_out_unit(a, lds, u, tid, wave, lane); }
    SEAM(4);
    if (IN(5)) {
        pg8::Gemm g{(const pg8::bf16_t*)(a.ws + WS_MIX), (const pg8::bf16_t*)(a.ws + WS_WTOUT), T, D, D}; pg8::StaticOrder S; S.init(T, D, G, bx);
        pg8::EpiResid E{a.in[0], a.out, (float*)(a.ws + WS_SSP), D};
        pg8::gemm_phase<pg8::EpiResid, pg8::StaticOrder, true, true>(lds, g, S, E);
    }
    SEAM(5);
    if (IN(6)) final_norm(a, vcu, G, wave, lane);
#undef IN
#undef SEAM
}

extern "C" void kernel_launch(void* const* d_in, const int* in_sizes, int n_in, void* d_out, int out_size, void* d_ws, size_t ws_size, hipStream_t stream) {
    static int grid = 0;
    if (grid == 0) {
        int dev = 0, cus = 0;
        if (hipGetDevice(&dev) != hipSuccess || hipDeviceGetAttribute(&cus, hipDeviceAttributeMultiprocessorCount, dev) != hipSuccess) { fprintf(stderr, "kernel_launch: device query failed\n"); grid = -1; return; }
        if (hipFuncSetAttribute((const void*)mega, hipFuncAttributeMaxDynamicSharedMemorySize, LDS_BYTES) != hipSuccess) { fprintf(stderr, "kernel_launch: hipFuncSetAttribute failed\n"); grid = -1; return; }
        (void)hipGetLastError();
        grid = cus;
    }
    if (grid < 0) return;
    Args a{};
    for (int i = 0; i < 16; ++i) a.in[i] = (const float*)d_in[i];
    a.out = (float*)d_out; a.ws = (unsigned char*)d_ws;
#if ONE_LAUNCH
    (void)hipMemsetAsync(d_ws, 0, 16384, stream);
    a.ph_lo = 0; a.ph_hi = NPHASE;
    void* args[] = {&a};
    hipError_t e = hipLaunchCooperativeKernel((const void*)mega, dim3(grid), dim3(NTHR), args, LDS_BYTES, stream);
    if (e != hipSuccess) fprintf(stderr, "cooperative launch failed: %s (grid %d)\n", hipGetErrorString(e), grid);
#else
    for (int p = 0; p < NPHASE; ++p) for (int rep = 0; rep < (p == HOSTDUP ? 2 : 1); ++rep) { a.ph_lo = p; a.ph_hi = p + 1; hipLaunchKernelGGL(mega, dim3(grid), dim3(NTHR), LDS_BYTES, stream, a); }
#endif
}
```

```cpp
#define ONE 1
#include <hip/hip_runtime.h>
#include <hip/hip_cooperative_groups.h>
#include <cstdio>
#include <cstdint>
namespace cg = cooperative_groups;
namespace pg8 {
#define PG8_LAS __attribute__((address_space(3)))
typedef unsigned short bf16_t;
typedef short bf16x8 __attribute__((ext_vector_type(8)));
typedef float f32x4 __attribute__((ext_vector_type(4)));
typedef unsigned u32x4 __attribute__((ext_vector_type(4)));
constexpr int BM = 256, BK = 64, HALF = 128, HTB = HALF * BK * 2  , STAGE_BYTES = 8 * HTB, NXCD = 8, WGM = 8;

__host__ __device__ __forceinline__ int lds_byte(int r, int c) { const int st = (r >> 4) * 2 + (c >> 5), rr = r & 15, cc = c & 31, ob = rr * 64 + cc * 2; return st * 1024 + (ob ^ (((ob >> 9) & 1) << 5)); }
__host__ __device__ __forceinline__ void stage_rc(int b, int& R, int& C) { const int st = b / 1024, sb = b % 1024, swz = sb ^ (((sb >> 9) & 1) << 5); R = (st >> 1) * 16 + swz / 64; C = (st & 1) * 32 + (swz % 64) / 2; }
__host__ __device__ __forceinline__ int perm32(int rho) { const int n = rho >> 4, i = rho & 15; return 8 * (i >> 2) + 4 * n + (i & 3); }

struct Unit { int pm, pn; };
struct Gemm { const bf16_t* A; const bf16_t* Bt; int M, N, K; };

struct StaticOrder {
    int nM, nN, nwg, G, c;
    __host__ __device__ void init(int M, int N, int G_, int c_) { nM = M / BM; nN = N / BM; nwg = nM * nN; G = G_; c = c_; }
    __host__ __device__ bool next(int i, Unit& u) const {
        const long L = (long)i * G + c; if (L >= nwg) return false;
        int wgid = (int)L; { const int q = nwg / NXCD, r = nwg % NXCD, xcd = wgid % NXCD, off = wgid / NXCD; wgid = (xcd < r ? xcd * (q + 1) : r * (q + 1) + (xcd - r) * q) + off; }
        const int nig = WGM * nN, gid = wgid / nig, fm = gid * WGM, gsz = (nM - fm) < WGM ? (nM - fm) : WGM;
        u.pm = fm + ((wgid % nig) % gsz); u.pn = (wgid % nig) / gsz; return true;
    }
    __device__ __forceinline__ void a_ready(const Unit&) const {}
    __device__ __forceinline__ void done(const Unit&) const {}
};

__device__ __forceinline__ unsigned cvt_pk_bf16(float lo, float hi) { unsigned r; asm volatile("v_cvt_pk_bf16_f32 %0, %1, %2" : "=v"(r) : "v"(lo), "v"(hi)); return r; }
typedef float f32x2 __attribute__((ext_vector_type(2)));
__device__ __forceinline__ f32x2 gelu_pk(f32x2 v) {
    const f32x2 av = __builtin_elementwise_abs(v), d = av * 0.2316418882f + 1.0f;
    f32x2 t; t.x = __builtin_amdgcn_rcpf(d.x); t.y = __builtin_amdgcn_rcpf(d.y);
    f32x2 q = t * 0.5307027145f + (-0.7265760135f); q = q * t + 0.7107068705f; q = q * t + (-0.142248368f); q = q * t + 0.127414796f; q = q * t;
    const f32x2 s = (v * v) * (-0.72134752044f);
    f32x2 e; e.x = __builtin_amdgcn_exp2f(s.x); e.y = __builtin_amdgcn_exp2f(s.y);
    const f32x2 m = v * (q * e), r = v - m;
    f32x2 o; o.x = v.x < 0.f ? m.x : r.x; o.y = v.y < 0.f ? m.y : r.y; return o;
}

template <int ACT  > struct EpiBf16 {
    static constexpr bool PERM = true, AFTER_DRAIN = false; static_assert(ACT == 0 || ACT == 1, "EpiBf16: ACT is 0 (none) or 1 (gelu_pk)");
    bf16_t* O; int ldc; const float* bias; int split_cols; size_t split_stride; float scale0;
    __device__ __forceinline__ void operator()(const f32x4 (&acc)[2][2][4][2], const Unit& u, int wr, int wc, int fr, int fq) const {
        const int row0 = u.pm * BM + wr * 64 + fr; int colt = u.pn * BM; bf16_t* base = O;
        float sc = 1.f; if (split_cols) { const int t = colt / split_cols; base += (size_t)t * split_stride; colt -= t * split_cols; if (t == 0) sc = scale0; }
        const int col0 = colt + wc * 32 + 8 * fq, bcol0 = u.pn * BM + wc * 32 + 8 * fq;
        f32x4 bv[2][2];
#pragma unroll
        for (int bj = 0; bj < 2; ++bj)
#pragma unroll
            for (int n = 0; n < 2; ++n) bv[bj][n] = bias ? *(const f32x4*)(bias + bcol0 + bj * HALF + 4 * n) : (f32x4){0.f, 0.f, 0.f, 0.f};
#pragma unroll
        for (int ai = 0; ai < 2; ++ai)
#pragma unroll
            for (int m = 0; m < 4; ++m) { bf16_t* rowp = base + (size_t)(row0 + ai * HALF + m * 16) * ldc + col0;
#pragma unroll
                for (int bj = 0; bj < 2; ++bj) { f32x4 v0 = acc[ai][bj][m][0] + bv[bj][0], v1 = acc[ai][bj][m][1] + bv[bj][1];
                    if (ACT == 1) { f32x2 a = gelu_pk((f32x2){v0[0], v0[1]}), b = gelu_pk((f32x2){v0[2], v0[3]}), c = gelu_pk((f32x2){v1[0], v1[1]}), d = gelu_pk((f32x2){v1[2], v1[3]});
                        v0 = (f32x4){a.x, a.y, b.x, b.y}; v1 = (f32x4){c.x, c.y, d.x, d.y}; }
                    v0 = v0 * sc; v1 = v1 * sc; u32x4 w; w.x = cvt_pk_bf16(v0[0], v0[1]); w.y = cvt_pk_bf16(v0[2], v0[3]); w.z = cvt_pk_bf16(v1[0], v1[1]); w.w = cvt_pk_bf16(v1[2], v1[3]);
                    *(u32x4*)(rowp + bj * HALF) = w; } }
    }
};
struct EpiResid {
    static constexpr bool PERM = false, AFTER_DRAIN = false;
    const float* x; float* out; float* sspart; int ldc;
    __device__ __forceinline__ void operator()(const f32x4 (&acc)[2][2][4][2], const Unit& u, int wr, int wc, int fr, int fq) const {
        const int row0 = u.pm * BM + wr * 64 + fr, col0 = u.pn * BM + wc * 32 + 4 * fq;
#pragma unroll
        for (int ai = 0; ai < 2; ++ai)
#pragma unroll
            for (int m = 0; m < 4; ++m) {
                const int row = row0 + ai * HALF + m * 16; float ss = 0.f;
#pragma unroll
                for (int bj = 0; bj < 2; ++bj)
#pragma unroll
                    for (int n = 0; n < 2; ++n) {
                        const size_t off = (size_t)row * ldc + col0 + bj * HALF + n * 16;
                        const f32x4 xv = *(const f32x4*)(x + off); const f32x4 v = acc[ai][bj][m][n] + xv;
                        *(f32x4*)(out + off) = v; ss += (v[0] * v[0] + v[1] * v[1]) + (v[2] * v[2] + v[3] * v[3]);
                    }
                ss += __shfl_xor(ss, 16); ss += __shfl_xor(ss, 32);
                if (fq == 0) sspart[(size_t)row * 32 + u.pn * 4 + wc] = ss;
            }
    }
};
struct EpiResidNorm {
    static constexpr bool PERM = false, AFTER_DRAIN = true;
    const float* x; float* out; float* ssp; unsigned* cnt; const float* gain; int ldc; float eps;
    __device__ __forceinline__ void fused(f32x4 (&acc)[2][2][4][2], const Unit& u, int wr, int wc, int fr, int fq, PG8_LAS unsigned char* lds, int wid, int lane) const {
        const int row0 = u.pm * BM + wr * 64 + fr, col0 = u.pn * BM + wc * 32 + 4 * fq;
#pragma unroll
        for (int ai = 0; ai < 2; ++ai)
#pragma unroll
            for (int m = 0; m < 4; ++m) {
                const int row = row0 + ai * HALF + m * 16; float ss = 0.f;
#pragma unroll
                for (int bj = 0; bj < 2; ++bj)
#pragma unroll
                    for (int n = 0; n < 2; ++n) {
                        const f32x4 xv = *(const f32x4*)(x + (size_t)row * ldc + col0 + bj * HALF + n * 16); const f32x4 v = acc[ai][bj][m][n] + xv;
                        acc[ai][bj][m][n] = v; ss += (v[0] * v[0] + v[1] * v[1]) + (v[2] * v[2] + v[3] * v[3]);
                    }
                ss += __shfl_xor(ss, 16); ss += __shfl_xor(ss, 32);
                if (fq == 0) __hip_atomic_store(ssp + (size_t)row * 32 + u.pn * 4 + wc, ss, __ATOMIC_RELAXED, __HIP_MEMORY_SCOPE_AGENT);
            }
        asm volatile("s_waitcnt vmcnt(0)" ::: "memory");
        __syncthreads();
        unsigned* c = cnt + 64 * u.pm;
        if (threadIdx.x == 0) {
            __hip_atomic_fetch_add(c, 1u, __ATOMIC_RELEASE, __HIP_MEMORY_SCOPE_AGENT);
            unsigned spins = 0;
            while (__hip_atomic_load(c, __ATOMIC_RELAXED, __HIP_MEMORY_SCOPE_AGENT) < 8u) { __builtin_amdgcn_s_sleep(2); if (++spins > (1u << 22)) break; }
            __builtin_amdgcn_fence(__ATOMIC_ACQUIRE, "agent");
        }
        __syncthreads();
        PG8_LAS float* S = (PG8_LAS float*)lds;
        if (threadIdx.x < 256) {
            const float* p = ssp + (size_t)(u.pm * BM + threadIdx.x) * 32; float s = 0.f;
#pragma unroll
            for (int i = 0; i < 32; ++i) s += __hip_atomic_load(p + i, __ATOMIC_RELAXED, __HIP_MEMORY_SCOPE_AGENT);
            S[threadIdx.x] = 1.0f / sqrtf(s * (1.0f / 2048.0f) + eps);
        }
        __syncthreads();
#pragma unroll
        for (int bj = 0; bj < 2; ++bj)
#pragma unroll
            for (int n = 0; n < 2; ++n) {
                const f32x4 g = *(const f32x4*)(gain + col0 + bj * HALF + n * 16);
#pragma unroll
                for (int ai = 0; ai < 2; ++ai)
#pragma unroll
                    for (int m = 0; m < 4; ++m) {
                        const int lr = wr * 64 + fr + ai * HALF + m * 16; const float rs = S[lr];
                        f32x4 v = acc[ai][bj][m][n]; v[0] *= rs * g[0]; v[1] *= rs * g[1]; v[2] *= rs * g[2]; v[3] *= rs * g[3];
                        *(f32x4*)(out + (size_t)(u.pm * BM + lr) * ldc + col0 + bj * HALF + n * 16) = v;
                    }
            }
    }
};

template <class Epi, class Sched, bool ALIGN_EPI = false, bool SP2 = false>
__device__ __forceinline__ void gemm_phase(PG8_LAS unsigned char* lds, const Gemm g, const Sched& S, const Epi& E) {
    const int tid = threadIdx.x, wid = __builtin_amdgcn_readfirstlane(tid >> 6), lane = tid & 63, wr = wid >> 2, wc = wid & 3, fr = lane & 15, fq = lane >> 4;
    const int K = g.K, nt = K / BK;
    unsigned voffA[2], voffB[2];
#pragma unroll
    for (int i = 0; i < 2; ++i) { int R, C; stage_rc(tid * 16 + i * 8192, R, C); const int Rb = Epi::PERM ? ((R & ~31) + perm32(R & 31)) : R;
        voffA[i] = (unsigned)(R * K + C) * 2u; voffB[i] = (unsigned)(Rb * K + C) * 2u; }
    const size_t kstep = (size_t)(BK * 2);
    const size_t hstep = (size_t)HALF * K * 2;
    const size_t tstep = 2 * hstep;
    const unsigned ldsw = (unsigned)wid * 1024u;
    const int aoff = lds_byte(wr * 64 + fr, fq * 8), boff = lds_byte(wc * 32 + fr, fq * 8);
#define PG8_SA(b, h) (((b) * 2 + (h)) * HTB)
#define PG8_SB(b, h) ((4 + (b) * 2 + (h)) * HTB)
#define PG8_STAGE(bufoff, gbase, voff) do { _Pragma("unroll") for (int _i = 0; _i < 2; ++_i) \
        __builtin_amdgcn_global_load_lds((const unsigned*)((const char*)(gbase) + (voff)[_i]), (PG8_LAS unsigned*)(lds + (bufoff) + ldsw + _i * 8192), 16, 0, 0); } while (0)
#define PG8_LDA(dst, b, h) do { _Pragma("unroll") for (int m = 0; m < 4; ++m) _Pragma("unroll") for (int k = 0; k < 2; ++k) dst[m][k] = *(const PG8_LAS bf16x8*)(lds + PG8_SA(b, h) + aoff + m * 2048 + k * 1024); } while (0)
#define PG8_LDB(dst, b, h) do { _Pragma("unroll") for (int n = 0; n < 2; ++n) _Pragma("unroll") for (int k = 0; k < 2; ++k) dst[n][k] = *(const PG8_LAS bf16x8*)(lds + PG8_SB(b, h) + boff + n * 2048 + k * 1024); } while (0)
#define PG8_MMA(ai, bj, At, Bt) do { __builtin_amdgcn_s_setprio(1); _Pragma("unroll") for (int m = 0; m < 4; ++m) _Pragma("unroll") for (int n = 0; n < 2; ++n) _Pragma("unroll") for (int k = 0; k < 2; ++k) \
        acc[ai][bj][m][n] = __builtin_amdgcn_mfma_f32_16x16x32_bf16(Bt[n][k], At[m][k], acc[ai][bj][m][n], 0, 0, 0); __builtin_amdgcn_s_setprio(0); } while (0)
#define PG8_WAIT_V(n) asm volatile("s_waitcnt vmcnt(" #n ")" ::: "memory")
#define PG8_WAIT_L(n) asm volatile("s_waitcnt lgkmcnt(" #n ")" ::: "memory")
#define PG8_BAR __builtin_amdgcn_s_barrier()
#define PG8_SCHED __builtin_amdgcn_sched_barrier(0)
    Unit cur, nxt; int ui = 0;
    if (!S.next(0, cur)) return;
    f32x4 acc[2][2][4][2];
#pragma unroll
    for (int a = 0; a < 2; ++a)
#pragma unroll
        for (int b = 0; b < 2; ++b)
#pragma unroll
            for (int m = 0; m < 4; ++m)
#pragma unroll
                for (int n = 0; n < 2; ++n) acc[a][b][m][n] = (f32x4){0.f, 0.f, 0.f, 0.f};
    bf16x8 At[4][2], B0[2][2], B1[2][2];
    const char* cA = (const char*)g.A + (size_t)cur.pm * tstep; const char* cB = (const char*)g.Bt + (size_t)cur.pn * tstep;
    S.a_ready(cur);
    if constexpr (SP2) {
        PG8_STAGE(PG8_SB(0, 0), cB, voffB); PG8_STAGE(PG8_SB(0, 1), cB + hstep, voffB); PG8_STAGE(PG8_SA(0, 0), cA, voffA); PG8_STAGE(PG8_SA(0, 1), cA + hstep, voffA);
        if (wr == 1) PG8_BAR;
        PG8_WAIT_V(2); PG8_BAR;
        PG8_STAGE(PG8_SB(1, 0), cB + kstep, voffB); PG8_STAGE(PG8_SA(1, 0), cA + kstep, voffA); PG8_STAGE(PG8_SB(1, 1), cB + hstep + kstep, voffB);
        PG8_WAIT_V(6); PG8_BAR;
    } else {
        PG8_STAGE(PG8_SB(0, 0), cB, voffB); PG8_STAGE(PG8_SA(0, 0), cA, voffA); PG8_STAGE(PG8_SB(0, 1), cB + hstep, voffB); PG8_STAGE(PG8_SA(0, 1), cA + hstep, voffA);
        if (wr == 1) PG8_BAR;
        PG8_WAIT_V(4); PG8_BAR;
        PG8_STAGE(PG8_SB(1, 0), cB + kstep, voffB); PG8_STAGE(PG8_SA(1, 0), cA + kstep, voffA); PG8_STAGE(PG8_SB(1, 1), cB + hstep + kstep, voffB);
        PG8_WAIT_V(6); PG8_BAR;
    }
    for (;;) {
        const bool has_next = S.next(ui + 1, nxt);
        const char* nA = has_next ? (const char*)g.A + (size_t)nxt.pm * tstep : cA; const char* nB = has_next ? (const char*)g.Bt + (size_t)nxt.pn * tstep : cB;
        for (int t = 0; t < nt; t += 2) {
            const bool last = (t == nt - 2);
            const char* a1 = cA + (size_t)(t + 1) * kstep;
            const char* a2 = last ? nA : cA + (size_t)(t + 2) * kstep; const char* b2 = last ? nB : cB + (size_t)(t + 2) * kstep;
            const char* a3 = a2 + kstep; const char* b3 = b2 + kstep;
            if (last && has_next) S.a_ready(nxt);
            if constexpr (SP2) {
            PG8_LDB(B0, 0, 0); PG8_LDB(B1, 0, 1); PG8_SCHED; PG8_LDA(At, 0, 0); PG8_STAGE(PG8_SA(1, 1), a1 + hstep, voffA);
            PG8_WAIT_V(8); PG8_WAIT_L(0); PG8_BAR; PG8_MMA(0, 0, At, B0); PG8_MMA(0, 1, At, B1); PG8_BAR; PG8_SCHED;
            PG8_LDA(At, 0, 1); PG8_STAGE(PG8_SB(0, 0), b2, voffB); PG8_STAGE(PG8_SB(0, 1), b2 + hstep, voffB); PG8_STAGE(PG8_SA(0, 0), a2, voffA);
            PG8_WAIT_V(8); PG8_WAIT_L(0); PG8_BAR; PG8_MMA(1, 0, At, B0); PG8_MMA(1, 1, At, B1); PG8_BAR; PG8_SCHED;
            PG8_LDB(B0, 1, 0); PG8_LDB(B1, 1, 1); PG8_SCHED; PG8_LDA(At, 1, 0); PG8_STAGE(PG8_SA(0, 1), a2 + hstep, voffA);
            PG8_WAIT_V(8); PG8_WAIT_L(0); PG8_BAR; PG8_MMA(0, 0, At, B0); PG8_MMA(0, 1, At, B1); PG8_BAR; PG8_SCHED;
            PG8_LDA(At, 1, 1); PG8_STAGE(PG8_SB(1, 0), b3, voffB); PG8_STAGE(PG8_SB(1, 1), b3 + hstep, voffB); PG8_STAGE(PG8_SA(1, 0), a3, voffA);
            PG8_WAIT_V(8); PG8_WAIT_L(0); PG8_BAR; PG8_MMA(1, 0, At, B0); PG8_MMA(1, 1, At, B1); PG8_BAR; PG8_SCHED;
            } else {
            PG8_LDB(B0, 0, 0); PG8_SCHED; PG8_LDA(At, 0, 0); PG8_STAGE(PG8_SA(1, 1), a1 + hstep, voffA);
            PG8_WAIT_L(8); PG8_BAR; PG8_WAIT_L(0); PG8_MMA(0, 0, At, B0); PG8_BAR; PG8_SCHED;
            PG8_LDB(B1, 0, 1); PG8_STAGE(PG8_SB(0, 0), b2, voffB);
            PG8_BAR; PG8_WAIT_L(0); PG8_MMA(0, 1, At, B1); PG8_BAR;
            PG8_LDA(At, 0, 1); PG8_STAGE(PG8_SA(0, 0), a2, voffA);
            PG8_BAR; PG8_WAIT_L(0); PG8_MMA(1, 0, At, B0); PG8_BAR; PG8_SCHED;
            PG8_STAGE(PG8_SB(0, 1), b2 + hstep, voffB);
            PG8_WAIT_V(6); PG8_BAR; PG8_MMA(1, 1, At, B1); PG8_BAR;
            PG8_LDB(B0, 1, 0); PG8_SCHED; PG8_LDA(At, 1, 0); PG8_STAGE(PG8_SA(0, 1), a2 + hstep, voffA);
            PG8_WAIT_L(8); PG8_BAR; PG8_WAIT_L(0); PG8_MMA(0, 0, At, B0); PG8_BAR; PG8_SCHED;
            PG8_LDB(B1, 1, 1); PG8_STAGE(PG8_SB(1, 0), b3, voffB);
            PG8_BAR; PG8_WAIT_L(0); PG8_MMA(0, 1, At, B1); PG8_BAR;
            PG8_LDA(At, 1, 1); PG8_STAGE(PG8_SA(1, 0), a3, voffA);
            PG8_BAR; PG8_WAIT_L(0); PG8_MMA(1, 0, At, B0); PG8_BAR; PG8_SCHED;
            PG8_STAGE(PG8_SB(1, 1), b3 + hstep, voffB);
            PG8_WAIT_V(6); PG8_BAR; PG8_MMA(1, 1, At, B1); PG8_BAR;
            }
        }
        if constexpr (ALIGN_EPI) { if (wr == 0) PG8_BAR; }
        if constexpr (!Epi::AFTER_DRAIN) { E(acc, cur, wr, wc, fr, fq); S.done(cur); }
        if (!has_next) break;
#pragma unroll
        for (int a = 0; a < 2; ++a)
#pragma unroll
            for (int b = 0; b < 2; ++b)
#pragma unroll
                for (int m = 0; m < 4; ++m)
#pragma unroll
                    for (int n = 0; n < 2; ++n) acc[a][b][m][n] = (f32x4){0.f, 0.f, 0.f, 0.f};
        cur = nxt; cA = nA; cB = nB; ++ui;
        if constexpr (ALIGN_EPI) { if (wr == 1) PG8_BAR; }
    }
    PG8_WAIT_V(0);
    if constexpr (!ALIGN_EPI) { if (wr == 0) PG8_BAR; }
    PG8_BAR;
    if constexpr (Epi::AFTER_DRAIN) { E.fused(acc, cur, wr, wc, fr, fq, lds, wid, lane); S.done(cur); }
#undef PG8_SA
#undef PG8_SB
#undef PG8_STAGE
#undef PG8_LDA
#undef PG8_LDB
#undef PG8_MMA
#undef PG8_WAIT_V
#undef PG8_WAIT_L
#undef PG8_BAR
#undef PG8_SCHED
}
}
constexpr int T = 8192, D = 2048, NIN = 6528, NINP = 6656, RW = 1024, NH = 16, HD = 64, CH = 64, NCH = T / CH;
constexpr int C_R = 0, C_K = 1024, C_V = 2048, C_WD = 3072, C_AD = 3136, C_G = 3200, C_AQ = 4224, C_AK = 5248, C_AV = 5376, C_AG = 5504;
constexpr float RMS_EPS = 1e-5f, LNX_EPS = 64e-5f;
constexpr int NWAVES = 8, NTHR = 512;
constexpr size_t MiB = 1u << 20;
constexpr size_t WS_WTIN = 1 * MiB;
constexpr size_t WS_XN = 27 * MiB;
constexpr size_t WS_WTOUT = 59 * MiB;
constexpr size_t WS_UPT = 67 * MiB;
constexpr size_t WS_SSP = 68 * MiB;
constexpr size_t WS_PROJ = 70 * MiB;
constexpr size_t WS_SCR = 174 * MiB;
constexpr size_t WS_MIX = 1 * MiB;
constexpr size_t WS_P32 = 223 * MiB;
constexpr int LDS_BYTES = 163840;

#define GAS __attribute__((address_space(1)))
#define LAS __attribute__((address_space(3)))
typedef unsigned short bf16;
typedef unsigned v4u __attribute__((ext_vector_type(4)));
typedef unsigned v2u __attribute__((ext_vector_type(2)));
typedef float f32x4 __attribute__((ext_vector_type(4)));
typedef float f32x16 __attribute__((ext_vector_type(16)));
typedef short bf16x8 __attribute__((ext_vector_type(8)));
typedef __bf16 bf16x2_t __attribute__((ext_vector_type(2)));
__device__ __forceinline__ unsigned pk2(float a, float b) { bf16x2_t v; v[0] = (__bf16)a; v[1] = (__bf16)b; return __builtin_bit_cast(unsigned, v); }
__device__ __forceinline__ float bflo(unsigned u) { return __uint_as_float(u << 16); }
__device__ __forceinline__ float bfhi(unsigned u) { return __uint_as_float(u & 0xffff0000u); }
__device__ __forceinline__ void unpack8(const v4u& p, float (&f)[8]) { f[0] = bflo(p.x); f[1] = bfhi(p.x); f[2] = bflo(p.y); f[3] = bfhi(p.y); f[4] = bflo(p.z); f[5] = bfhi(p.z); f[6] = bflo(p.w); f[7] = bfhi(p.w); }
__device__ __forceinline__ v4u pack8(const float (&f)[8]) { v4u o; o.x = pk2(f[0], f[1]); o.y = pk2(f[2], f[3]); o.z = pk2(f[4], f[5]); o.w = pk2(f[6], f[7]); return o; }
__device__ __forceinline__ float wave_sum(float v) {
#pragma unroll
    for (int o = 1; o < 64; o <<= 1) v += __shfl_xor(v, o);
    return v;
}
__device__ __forceinline__ float sum8(float v) { v += __shfl_xor(v, 1); v += __shfl_xor(v, 2); v += __shfl_xor(v, 4); return v; }
__device__ __forceinline__ float sigmoidf_(float x) { return 1.f / (1.f + __expf(-x)); }
__device__ __forceinline__ float siluf_(float x) { return x / (1.f + __expf(-x)); }

__device__ __forceinline__ void bar_lds() { asm volatile("s_waitcnt lgkmcnt(0)" ::: "memory"); __builtin_amdgcn_s_barrier(); asm volatile("" ::: "memory"); }
struct Args { const float* in[16]; float* out; unsigned char* ws; int ph_lo, ph_hi; };

struct TItem { const float* W; bf16* WT; int K, N, k0, n0; };
__device__ __forceinline__ bool p0_item(const Args& a, int it, TItem& o) {
    constexpr int I_IN = (D / 64) * (NIN / 32), I_OUT = (D / 64) * (D / 32), I_UP = RW / 32;
    bf16* wtin = (bf16*)(a.ws + WS_WTIN); bf16* wtout = (bf16*)(a.ws + WS_WTOUT); bf16* upt = (bf16*)(a.ws + WS_UPT); bf16* aupt = upt + 65536;
    int r = it;
    if (r < I_IN) { o.W = a.in[2]; o.WT = wtin; o.K = D; o.N = NIN; }
    else if ((r -= I_IN) < I_OUT) { o.W = a.in[14]; o.WT = wtout; o.K = D; o.N = D; }
    else if ((r -= I_OUT) < I_UP) { o.W = a.in[5]; o.WT = upt; o.K = 64; o.N = RW; }
    else if ((r -= I_UP) < I_UP) { o.W = a.in[7]; o.WT = aupt; o.K = 64; o.N = RW; }
    else return false;
    const int nblk = o.N / 32; o.k0 = 64 * (r / nblk); o.n0 = 32 * (r % nblk); return true;
}
__device__ __forceinline__ void p0_ld(const TItem& t, int lane, f32x4 (&v)[8]) {
#pragma unroll
    for (int i = 0; i < 8; ++i) v[i] = *(const f32x4*)(t.W + (size_t)(t.k0 + 8 * i + (lane >> 3)) * t.N + t.n0 + 4 * (lane & 7));
}
__device__ __forceinline__ void p0_st(const TItem& t, int lane, const f32x4 (&v)[8], LAS float* scr) {
#pragma unroll
    for (int i = 0; i < 8; ++i) { LAS float* d = scr + (8 * i + (lane >> 3)) * 33 + 4 * (lane & 7); d[0] = v[i].x; d[1] = v[i].y; d[2] = v[i].z; d[3] = v[i].w; }
    asm volatile("s_waitcnt lgkmcnt(0)" ::: "memory");
    const int c = lane & 7;
#pragma unroll
    for (int j = 0; j < 4; ++j) { const int n = (lane >> 3) + 8 * j; const LAS float* s = scr + (8 * c) * 33 + n;
        v4u o; o.x = pk2(s[0 * 33], s[1 * 33]); o.y = pk2(s[2 * 33], s[3 * 33]); o.z = pk2(s[4 * 33], s[5 * 33]); o.w = pk2(s[6 * 33], s[7 * 33]);
        *(v4u*)(t.WT + (size_t)(t.n0 + n) * t.K + t.k0 + 8 * c) = o; }
    asm volatile("s_waitcnt lgkmcnt(0)" ::: "memory");
}
__device__ __forceinline__ void p0_prologue(const Args& a, LAS unsigned char* lds, int vcu, int G, int wave, int lane) {
    LAS float* scr = (LAS float*)(lds + wave * 16384);
    const int gw = vcu * NWAVES + wave, NGW = G * NWAVES;
    bf16* wtin = (bf16*)(a.ws + WS_WTIN);
    for (int it = gw; ; it += 2 * NGW) {
        TItem t0, t1; f32x4 v0[8], v1[8];
        const bool h0 = p0_item(a, it, t0), h1 = p0_item(a, it + NGW, t1);
        if (!h0) break;
        p0_ld(t0, lane, v0); if (h1) p0_ld(t1, lane, v1);
        p0_st(t0, lane, v0, scr); if (h1) p0_st(t1, lane, v1, scr);
    }
    { v4u z = {0u, 0u, 0u, 0u}; v4u* p = (v4u*)(wtin + (size_t)NIN * D); const int n16 = (NINP - NIN) * D * 2 / 16;
      for (int i = gw * 64 + lane; i < n16; i += NGW * 64) p[i] = z; }
    const float* gain = a.in[1];
    for (int m = gw; m < T; m += 2 * NGW) {
        const int m2 = m + NGW;
        const f32x4* xr = (const f32x4*)(a.in[0] + (size_t)m * D) + lane; const f32x4* xr2 = (const f32x4*)(a.in[0] + (size_t)(m2 < T ? m2 : m) * D) + lane;
        f32x4 v[8], u[8]; float s = 0.f, s2 = 0.f;
#pragma unroll
        for (int j = 0; j < 8; ++j) { v[j] = xr[64 * j]; u[j] = xr2[64 * j]; }
#pragma unroll
        for (int j = 0; j < 8; ++j) { s += (v[j].x * v[j].x + v[j].y * v[j].y) + (v[j].z * v[j].z + v[j].w * v[j].w); s2 += (u[j].x * u[j].x + u[j].y * u[j].y) + (u[j].z * u[j].z + u[j].w * u[j].w); }
        const float rstd = 1.f / sqrtf(wave_sum(s) * (1.f / D) + RMS_EPS), rstd2 = 1.f / sqrtf(wave_sum(s2) * (1.f / D) + RMS_EPS);
        v2u* o8 = (v2u*)((bf16*)(a.ws + WS_XN) + (size_t)m * D) + lane; v2u* o82 = (v2u*)((bf16*)(a.ws + WS_XN) + (size_t)m2 * D) + lane;
#pragma unroll
        for (int j = 0; j < 8; ++j) { const f32x4 g = *((const f32x4*)gain + lane + 64 * j); v2u o; o.x = pk2(v[j].x * rstd * g.x, v[j].y * rstd * g.y); o.y = pk2(v[j].z * rstd * g.z, v[j].w * rstd * g.w); o8[64 * j] = o;
            if (m2 < T) { o.x = pk2(u[j].x * rstd2 * g.x, u[j].y * rstd2 * g.y); o.y = pk2(u[j].z * rstd2 * g.z, u[j].w * rstd2 * g.w); o82[64 * j] = o; } }
    }
}
__device__ __forceinline__ void final_norm(const Args& a, int vcu, int G, int wave, int lane) {
    const int gw = vcu * NWAVES + wave, NGW = G * NWAVES; const float* ssp = (const float*)(a.ws + WS_SSP); const float* gain = a.in[15];
    for (int m = gw; m < T; m += NGW) {
        float s = (lane < 32) ? ssp[(size_t)m * 32 + lane] : 0.f; s = wave_sum(s);
        const float rstd = 1.f / sqrtf(s * (1.f / D) + RMS_EPS);
        f32x4* xr = (f32x4*)(a.out + (size_t)m * D) + lane;
#pragma unroll
        for (int j = 0; j < 8; ++j) { f32x4 v = xr[64 * j]; const f32x4 g = *((const f32x4*)gain + lane + 64 * j); v.x *= rstd * g.x; v.y *= rstd * g.y; v.z *= rstd * g.z; v.w *= rstd * g.w; xr[64 * j] = v; }
    }
}
#define XB_TMO      128
#define XB_XCNT(j)  (256  + 64 * (j))
#define XB_XSUB(j)  (1280 + 64 * (j))
#define XB_XGEN(j)  (2304 + 64 * (j))
#define XB_TOP      3328
#define XB_TOPGEN   3392
#define XCD_BAR_WORDS 3456
#define XB_SPIN_CAP (1u << 18)

__device__ __forceinline__ unsigned xb_ld(unsigned* p)              { return __hip_atomic_load(p, __ATOMIC_RELAXED, __HIP_MEMORY_SCOPE_AGENT); }
__device__ __forceinline__ unsigned xb_add(unsigned* p, unsigned v) { return __hip_atomic_fetch_add(p, v, __ATOMIC_RELAXED, __HIP_MEMORY_SCOPE_AGENT); }
__device__ __forceinline__ unsigned xb_xcc_id() { return (unsigned)__builtin_amdgcn_s_getreg((3 << 11) | 20) & 0xFu; }
#define XB_SPIN(cond, bar) do { unsigned _sp = 0; while (cond) { __builtin_amdgcn_s_sleep(1); \
    if ((++_sp & 255u) == 0u) { if (xb_ld(&(bar)[XB_TMO])) break; if (_sp > XB_SPIN_CAP) { atomicAdd(&(bar)[XB_TMO], 1u); break; } } } } while (0)

struct XcdBarrier {
    unsigned* bar; unsigned x;
    volatile LAS unsigned* st;
};

__device__ __forceinline__ XcdBarrier xcd_barrier_post(unsigned* bar, volatile LAS unsigned* st) {
    XcdBarrier b; b.bar = bar; b.x = xb_xcc_id(); b.st = st;
    if (threadIdx.x == 0) (void)xb_add(&bar[XB_XCNT(b.x)], 1u);
    return b;
}
__device__ __forceinline__ void xcd_barrier_complete(unsigned* bar, unsigned x, unsigned& nloc, unsigned& nx) {
    const unsigned G = gridDim.x * gridDim.y * gridDim.z;
    unsigned sum, cnt, mine, sp = 0u;
    for (;;) {
        sum = 0u; cnt = 0u; mine = 0u;
#pragma unroll
        for (unsigned j = 0; j < 16; ++j) { const unsigned c = xb_ld(&bar[XB_XCNT(j)]); sum += c; cnt += (c > 0u) ? 1u : 0u; mine = (j == x) ? c : mine; }
        if (sum == G) break;
        __builtin_amdgcn_s_sleep(1);
        if ((++sp & 255u) == 0u) { if (xb_ld(&bar[XB_TMO])) break; if (sp > XB_SPIN_CAP) { atomicAdd(&bar[XB_TMO], 1u); break; } }
    }
    nloc = mine > 0u ? mine : 1u; nx = cnt > 0u ? cnt : 1u;
}

__device__ __forceinline__ void xcd_barrier(const XcdBarrier& b) {
    asm volatile("s_waitcnt vmcnt(0)" ::: "memory");
    __syncthreads();
    if (threadIdx.x == 0) {
        unsigned* bar = b.bar;
        __builtin_amdgcn_s_waitcnt(0);
        unsigned nloc = b.st[0], nx = b.st[1];
        if (nloc == 0u) { xcd_barrier_complete(bar, b.x, nloc, nx); b.st[0] = nloc; b.st[1] = nx; }
        const unsigned old = xb_add(&bar[XB_XSUB(b.x)], 1u);
        const unsigned gen = old / nloc;
        if (old + 1u == (gen + 1u) * nloc) {
            __builtin_amdgcn_fence(__ATOMIC_RELEASE, "agent");
            asm volatile("s_waitcnt vmcnt(0)" ::: "memory");
            const unsigned og = xb_add(&bar[XB_TOP], 1u);
            const unsigned tg = og / nx;
            if (og + 1u == (tg + 1u) * nx) xb_add(&bar[XB_TOPGEN], 1u);
            else XB_SPIN(xb_ld(&bar[XB_TOPGEN]) == tg, bar);
            __builtin_amdgcn_fence(__ATOMIC_ACQUIRE, "agent");
            xb_add(&bar[XB_XGEN(b.x)], 1u);
            asm volatile("s_waitcnt vmcnt(0)" ::: "memory");
        } else {
            XB_SPIN(xb_ld(&bar[XB_XGEN(b.x)]) == gen, bar);
            __builtin_amdgcn_fence(__ATOMIC_ACQUIRE, "agent");
            asm volatile("s_waitcnt vmcnt(0)" ::: "memory");
        }
    }
    __syncthreads();
}

#define MFMA32(a_, b_, c_) __builtin_amdgcn_mfma_f32_32x32x16_bf16((a_), (b_), (c_), 0, 0, 0)
#define MFMA16(a_, b_, c_) __builtin_amdgcn_mfma_f32_16x16x32_bf16((a_), (b_), (c_), 0, 0, 0)
__device__ __forceinline__ v4u ldg16(const bf16* p) { return *(const v4u*)p; }
__device__ __forceinline__ void load_shift8(const bf16* proj, int row, int col, const float* mu, float (&o)[8]) {
    const v4u p = ldg16(proj + (size_t)row * NINP + col); v4u q = {0u, 0u, 0u, 0u};
    if (row > 0) q = ldg16(proj + (size_t)(row - 1) * NINP + col);
    float pf[8], qf[8]; unpack8(p, pf); unpack8(q, qf);
    const f32x4 m0 = *(const f32x4*)(mu + col), m1 = *(const f32x4*)(mu + col + 4);
    const float mf[8] = {m0.x, m0.y, m0.z, m0.w, m1.x, m1.y, m1.z, m1.w};
#pragma unroll
    for (int j = 0; j < 8; ++j) o[j] = pf[j] + (qf[j] - pf[j]) * mf[j];
}
__device__ __forceinline__ void ld8f(const float* p, float (&o)[8]) { const f32x4 a = *(const f32x4*)p, b = *(const f32x4*)(p + 4); o[0] = a.x; o[1] = a.y; o[2] = a.z; o[3] = a.w; o[4] = b.x; o[5] = b.y; o[6] = b.z; o[7] = b.w; }

constexpr int VP = 168;
__device__ __forceinline__ void attn_unit(const Args& a, LAS unsigned char* lds, int unit, int tid, int wave, int lane) {
    const bf16* proj = (const bf16*)(a.ws + WS_PROJ); bf16* mix = (bf16*)(a.ws + WS_MIX);
    const int qb = unit >> 1, kvh = unit & 1, q0 = qb * 32, kbase = q0 - 128, hq = kvh * 8 + wave;
    LAS bf16* VT = (LAS bf16*)lds;
    bar_lds();
    for (int idx = tid; idx < 160 * 8; idx += NTHR) {
        const int key = idx >> 3, d8 = (idx & 7) * 8, tk = kbase + key;
        v4u p = {0u, 0u, 0u, 0u};
        if (tk >= 0) p = ldg16(proj + (size_t)tk * NINP + C_AV + kvh * 64 + d8);
        const unsigned w[4] = {p.x, p.y, p.z, p.w};
#pragma unroll
        for (int j = 0; j < 4; ++j) { VT[(d8 + 2 * j) * VP + key] = (bf16)(w[j] & 0xffffu); VT[(d8 + 2 * j + 1) * VP + key] = (bf16)(w[j] >> 16); }
    }
    bar_lds();
    const int r = lane & 31, h = lane >> 5;
    bf16x8 bq[4];
    { const bf16* qrow = proj + (size_t)(q0 + r) * NINP + C_AQ + hq * 64 + 8 * h;
#pragma unroll
      for (int s = 0; s < 4; ++s) bq[s] = *(const bf16x8*)(qrow + 16 * s); }
    const float slope = exp2f(-0.5f * (float)(hq + 1)), sink = a.in[13][hq];
    f32x16 sc[5]; float mx = sink;
#pragma unroll
    for (int kt = 0; kt < 5; ++kt) {
        const int tkb = kbase + 32 * kt;
        f32x16 acc; for (int i = 0; i < 16; ++i) acc[i] = 0.f;
        if (tkb >= 0) {
            const bf16* krow = proj + (size_t)(tkb + r) * NINP + C_AK + kvh * 64 + 8 * h;
#pragma unroll
            for (int s = 0; s < 4; ++s) acc = MFMA32(*(const bf16x8*)(krow + 16 * s), bq[s], acc);
        }
#pragma unroll
        for (int i = 0; i < 16; ++i) {
            const int key = tkb + (i & 3) + 8 * (i >> 2) + 4 * h, dist = (q0 + r) - key;
            const bool valid = (tkb >= 0) && (dist >= 0) && (dist < 128);
            const float v = valid ? acc[i] * 0.125f - slope * (float)dist : -1e30f;
            sc[kt][i] = v; mx = fmaxf(mx, v);
        }
        __builtin_amdgcn_sched_barrier(0);
    }
    mx = fmaxf(mx, __shfl_xor(mx, 32));
    float sum = 0.f;
#pragma unroll
    for (int kt = 0; kt < 5; ++kt)
#pragma unroll
        for (int i = 0; i < 16; ++i) { const float p = __expf(sc[kt][i] - mx); sc[kt][i] = p; sum += p; }
    sum += __shfl_xor(sum, 32); sum += __expf(sink - mx);
    f32x16 o[2]; for (int i = 0; i < 16; ++i) { o[0][i] = 0.f; o[1][i] = 0.f; }
#pragma unroll
    for (int kt = 0; kt < 5; ++kt) {
        if (kbase + 32 * kt >= 0) {
#pragma unroll
            for (int s = 0; s < 2; ++s) {
                v4u pw; pw.x = pk2(sc[kt][8 * s + 0], sc[kt][8 * s + 1]); pw.y = pk2(sc[kt][8 * s + 2], sc[kt][8 * s + 3]); pw.z = pk2(sc[kt][8 * s + 4], sc[kt][8 * s + 5]); pw.w = pk2(sc[kt][8 * s + 6], sc[kt][8 * s + 7]);
                const bf16x8 pb = __builtin_bit_cast(bf16x8, pw);
#pragma unroll
                for (int dt = 0; dt < 2; ++dt) {
                    const LAS bf16* vp = VT + (32 * dt + r) * VP + 32 * kt + 16 * s + 4 * h;
                    const v2u lo = *(const LAS v2u*)vp, hi = *(const LAS v2u*)(vp + 8);
                    v4u vw; vw.x = lo.x; vw.y = lo.y; vw.z = hi.x; vw.w = hi.y;
                    o[dt] = MFMA32(__builtin_bit_cast(bf16x8, vw), pb, o[dt]);
                }
            }
        }
    }
    const float inv = 1.f / sum;
#pragma unroll
    for (int dt = 0; dt < 2; ++dt)
#pragma unroll
        for (int g4 = 0; g4 < 4; ++g4) {
            const int d0 = 32 * dt + 8 * g4 + 4 * h;
            float g0, g1, g2, g3;
            { const v2u gp = *(const v2u*)(proj + (size_t)(q0 + r) * NINP + C_AG + hq * 64 + d0); g0 = bflo(gp.x); g1 = bfhi(gp.x); g2 = bflo(gp.y); g3 = bfhi(gp.y); }
            v2u w; w.x = pk2(o[dt][4 * g4 + 0] * inv * siluf_(g0), o[dt][4 * g4 + 1] * inv * siluf_(g1));
            w.y = pk2(o[dt][4 * g4 + 2] * inv * siluf_(g2), o[dt][4 * g4 + 3] * inv * siluf_(g3));
            *(v2u*)(mix + (size_t)(q0 + r) * D + RW + hq * 64 + d0) = w;
        }
}

struct Prep { float r[8], kp[8], v[8], g[8], w[8], lw[8], kk[8], b[8], bonus; };
__device__ __forceinline__ void rwkv_prep(const Args& a, LAS unsigned char* lds, int h, int t0, int tid, int wave, int lane, Prep& P) {
    const bf16* proj = (const bf16*)(a.ws + WS_PROJ); const bf16* upt = (const bf16*)(a.ws + WS_UPT); const bf16* aupt = upt + 65536;
    LAS bf16* TW = (LAS bf16*)lds; LAS bf16* ADm = TW + 64 * 72; LAS float* Z = (LAS float*)(lds + 18432); LAS float* AP = Z + 64 * 68;
    const int t = tid >> 3, c8 = (tid & 7) * 8, ch = h * 64 + c8, row = t0 + t;
    const float* mu = a.in[3];
    { float x[8]; load_shift8(proj, row, C_WD + c8, mu, x);
#pragma unroll
      for (int j = 0; j < 8; ++j) x[j] = 1.f - 2.f * __builtin_amdgcn_rcpf(1.f + __expf(2.f * x[j]));
      *(LAS v4u*)(TW + t * 72 + c8) = pack8(x);
      load_shift8(proj, row, C_AD + c8, mu, x); *(LAS v4u*)(ADm + t * 72 + c8) = pack8(x); }
    bar_lds();
    { const int rt = wave & 3, cp = (wave >> 2) * 2, fr = lane & 15, fq = lane >> 4;
      bf16x8 aT[2], aA[2];
#pragma unroll
      for (int s = 0; s < 2; ++s) { aT[s] = *(const LAS bf16x8*)(TW + (16 * rt + fr) * 72 + 32 * s + 8 * fq); aA[s] = *(const LAS bf16x8*)(ADm + (16 * rt + fr) * 72 + 32 * s + 8 * fq); }
#pragma unroll
      for (int ci = 0; ci < 2; ++ci) { const int ct = cp + ci; f32x4 z = {0.f, 0.f, 0.f, 0.f}, ap = {0.f, 0.f, 0.f, 0.f};
#pragma unroll
          for (int s = 0; s < 2; ++s) { const size_t bo = (size_t)(h * 64 + 16 * ct + fr) * 64 + 32 * s + 8 * fq;
              z = MFMA16(aT[s], *(const bf16x8*)(upt + bo), z); ap = MFMA16(aA[s], *(const bf16x8*)(aupt + bo), ap); }
#pragma unroll
          for (int j = 0; j < 4; ++j) { Z[(16 * rt + 4 * fq + j) * 68 + 16 * ct + fr] = z[j]; AP[(16 * rt + 4 * fq + j) * 68 + 16 * ct + fr] = ap[j]; } } }
    bar_lds();
    float zz[8], aa[8], kr[8], c0[8], c1[8];
#pragma unroll
    for (int j = 0; j < 8; ++j) { zz[j] = Z[t * 68 + c8 + j]; aa[j] = AP[t * 68 + c8 + j]; }
    load_shift8(proj, row, C_R + ch, mu, P.r); load_shift8(proj, row, C_K + ch, mu, kr); load_shift8(proj, row, C_V + ch, mu, P.v); load_shift8(proj, row, C_G + ch, mu, P.g);
    ld8f(a.in[4] + ch, c0); ld8f(a.in[6] + ch, c1);
#pragma unroll
    for (int j = 0; j < 8; ++j) { const float z = c0[j] + zz[j]; const float sp = (z < -15.f) ? -z : __logf(1.f + __expf(-z)); const float wl = -sp - 0.5f; P.lw[j] = -__expf(wl); P.w[j] = __expf(P.lw[j]); aa[j] = sigmoidf_(c1[j] + aa[j]); }
    ld8f(a.in[8] + ch, c0); ld8f(a.in[9] + ch, c1);
    float ss = 0.f;
#pragma unroll
    for (int j = 0; j < 8; ++j) { P.kk[j] = kr[j] * c0[j]; ss += P.kk[j] * P.kk[j]; P.kp[j] = kr[j] * (1.f + (aa[j] - 1.f) * c1[j]); }
    ss = sum8(ss); const float rn = 1.f / fmaxf(sqrtf(ss), 1e-12f);
    ld8f(a.in[10] + ch, c0);
    float bs = 0.f;
#pragma unroll
    for (int j = 0; j < 8; ++j) { P.kk[j] *= rn; P.b[j] = P.kk[j] * aa[j]; bs += P.r[j] * P.kp[j] * c0[j]; }
    P.bonus = sum8(bs);
}
__device__ __forceinline__ void rwkv_out8(const Args& a, const float (&y)[8], const float (&v)[8], const float (&g)[8], float bonus, int row, int ch) {
    bf16* mix = (bf16*)(a.ws + WS_MIX);
    float s = 0.f;
#pragma unroll
    for (int j = 0; j < 8; ++j) s += y[j];
    const float mean = sum8(s) * (1.f / 64.f); float q = 0.f;
#pragma unroll
    for (int j = 0; j < 8; ++j) { const float d = y[j] - mean; q += d * d; }
    const float rstd = 1.f / sqrtf(sum8(q) * (1.f / 64.f) + LNX_EPS);
    float lg[8], lb[8], o[8]; ld8f(a.in[11] + ch, lg); ld8f(a.in[12] + ch, lb);
#pragma unroll
    for (int j = 0; j < 8; ++j) { const float yn = (y[j] - mean) * rstd * lg[j] + lb[j] + bonus * v[j]; o[j] = yn * siluf_(g[j]); }
    *(v4u*)(mix + (size_t)row * D + ch) = pack8(o);
}
constexpr size_t WS_MF = 174 * MiB, WS_QF = 190 * MiB, WS_SF = 206 * MiB, WS_BON = 222 * MiB;
constexpr size_t OUT_NF = 0, OUT_Y2 = 32 * MiB;
constexpr int MP = 72;
constexpr int L_AT = 0, L_ATT = 9216, L_BT = 18432, L_KT = 27648, L_RT = 36864, L_BHT = 46080, L_KHT = 55296, L_VT = 64512, L_LW = 73728, L_P = 73728, L_PT = 82944,
              L_AAK = 92160, L_ARB = 101376, L_ARK = 110592, L_TM = 119808, L_SEG = 119808, L_GC = 129024, L_WT = L_AT, L_X1T = L_BT, L_U2T = L_KT;
struct WTile { int ta, tb0, fr, fq; };
__device__ __forceinline__ bf16x8 ldfrag(const LAS bf16* M, int tile, int s, const WTile& w) { return *(const LAS bf16x8*)(M + (16 * tile + w.fr) * MP + 32 * s + 8 * w.fq); }
__device__ __forceinline__ void mm2(const LAS bf16* A, const LAS bf16* B, const WTile& w, f32x4 (&acc)[2]) {
#pragma unroll
    for (int s = 0; s < 2; ++s) { const bf16x8 af = ldfrag(A, w.ta, s, w);
#pragma unroll
        for (int ci = 0; ci < 2; ++ci) acc[ci] = MFMA16(af, ldfrag(B, w.tb0 + ci, s, w), acc[ci]); }
}
__device__ __forceinline__ void st_T(LAS bf16* X, int ta, int tb, const WTile& w, const f32x4& v) { v2u o; o.x = pk2(v[0], v[1]); o.y = pk2(v[2], v[3]); *(LAS v2u*)(X + (16 * tb + w.fr) * MP + 16 * ta + 4 * w.fq) = o; }
__device__ __forceinline__ void st_N(LAS bf16* X, int ta, int tb, const WTile& w, const f32x4& v) {
    const unsigned a = pk2(v[0], v[1]), b = pk2(v[2], v[3]); LAS bf16* p = X + (16 * ta + 4 * w.fq) * MP + 16 * tb + w.fr;
    p[0] = (bf16)(a & 0xffffu); p[MP] = (bf16)(a >> 16); p[2 * MP] = (bf16)(b & 0xffffu); p[3 * MP] = (bf16)(b >> 16);
}
#define ZERO2(x) do { x[0] = (f32x4){0.f, 0.f, 0.f, 0.f}; x[1] = (f32x4){0.f, 0.f, 0.f, 0.f}; } while (0)
template <int MODE> __device__ __forceinline__ void mask2(f32x4 (&acc)[2], const WTile& w) {
#pragma unroll
    for (int ci = 0; ci < 2; ++ci)
#pragma unroll
        for (int j = 0; j < 4; ++j) { const int row = 16 * w.ta + 4 * w.fq + j, col = 16 * (w.tb0 + ci) + w.fr;
            const bool keep = MODE == 0 ? (row < col) : (MODE == 1 ? (row <= col) : (col < row)); if (!keep) acc[ci][j] = 0.f; }
}
__device__ __forceinline__ void st_bf16x8_T(LAS bf16* X, int c8, int t, const float (&v)[8]) {
    const v4u p = pack8(v); const unsigned w[4] = {p.x, p.y, p.z, p.w};
#pragma unroll
    for (int j = 0; j < 4; ++j) { X[(c8 + 2 * j) * MP + t] = (bf16)(w[j] & 0xffffu); X[(c8 + 2 * j + 1) * MP + t] = (bf16)(w[j] >> 16); }
}

__device__ __forceinline__ void rwkv_chunk_prep(const Args& a, LAS unsigned char* lds, int unit, int tid, int wave, int lane) {
    const int c = unit >> 4, h = unit & 15, t0 = c * CH, t = tid >> 3, c8 = (tid & 7) * 8;
    LAS bf16* At = (LAS bf16*)(lds + L_AT); LAS bf16* AtT = (LAS bf16*)(lds + L_ATT); LAS bf16* Bt = (LAS bf16*)(lds + L_BT); LAS bf16* Kt = (LAS bf16*)(lds + L_KT);
    LAS bf16* Rt = (LAS bf16*)(lds + L_RT); LAS bf16* BhT = (LAS bf16*)(lds + L_BHT); LAS bf16* KhT = (LAS bf16*)(lds + L_KHT); LAS bf16* VT = (LAS bf16*)(lds + L_VT);
    LAS float* LW = (LAS float*)(lds + L_LW); LAS bf16* Pm = (LAS bf16*)(lds + L_P); LAS bf16* PT = (LAS bf16*)(lds + L_PT);
    LAS bf16* AAK = (LAS bf16*)(lds + L_AAK); LAS bf16* ARB = (LAS bf16*)(lds + L_ARB); LAS bf16* ARK = (LAS bf16*)(lds + L_ARK); LAS bf16* TM = (LAS bf16*)(lds + L_TM);
    LAS float* SEG = (LAS float*)(lds + L_SEG); LAS float* GC = (LAS float*)(lds + L_GC);
    LAS bf16* WT = (LAS bf16*)(lds + L_WT); LAS bf16* X1T = (LAS bf16*)(lds + L_X1T); LAS bf16* U2T = (LAS bf16*)(lds + L_U2T);
    bar_lds();
    Prep P; rwkv_prep(a, lds, h, t0, tid, wave, lane, P);
#ifdef PROBE_PREP2
    bar_lds(); rwkv_prep(a, lds, h, t0, tid, wave, lane, P);
#endif
    if ((tid & 7) == 0) ((float*)(a.ws + WS_BON))[(size_t)(t0 + t) * 16 + h] = P.bonus;
#pragma unroll
    for (int j = 0; j < 8; ++j) LW[t * 68 + c8 + j] = P.lw[j];
    bar_lds();
    { const int cc = tid & 63, sg = tid >> 6; float run = 0.f;
#pragma unroll
      for (int i = 0; i < 8; ++i) { run += LW[(8 * sg + i) * 68 + cc]; LW[(8 * sg + i) * 68 + cc] = run; }
      SEG[sg * 64 + cc] = run; }
    bar_lds();
    {
        float Lt[8], LC[8];
#pragma unroll
        for (int j = 0; j < 8; ++j) { float off = 0.f, tot = 0.f;
#pragma unroll
            for (int s = 0; s < 8; ++s) { const float sv = SEG[s * 64 + c8 + j]; tot += sv; if (s < (t >> 3)) off += sv; }
            Lt[j] = LW[t * 68 + c8 + j] + off; LC[j] = tot; }
        if (t == 0) {
#pragma unroll
            for (int j = 0; j < 8; ++j) GC[c8 + j] = __expf(LC[j]); }
        float x[8], y[8];
#pragma unroll
        for (int j = 0; j < 8; ++j) x[j] = -P.kk[j] * __expf(Lt[j] - P.lw[j]);
        *(LAS v4u*)(At + t * MP + c8) = pack8(x); st_bf16x8_T(AtT, c8, t, x);
#pragma unroll
        for (int j = 0; j < 8; ++j) { const float e = __expf(-Lt[j]); x[j] = P.b[j] * e; y[j] = P.kp[j] * e; }
        *(LAS v4u*)(Bt + t * MP + c8) = pack8(x); *(LAS v4u*)(Kt + t * MP + c8) = pack8(y);
#pragma unroll
        for (int j = 0; j < 8; ++j) x[j] = P.r[j] * __expf(Lt[j]);
        *(LAS v4u*)(Rt + t * MP + c8) = pack8(x);
#pragma unroll
        for (int j = 0; j < 8; ++j) { const float e = __expf(LC[j] - Lt[j]); x[j] = P.b[j] * e; y[j] = P.kp[j] * e; }
        st_bf16x8_T(BhT, c8, t, x); st_bf16x8_T(KhT, c8, t, y); st_bf16x8_T(VT, c8, t, P.v);
    }
    bar_lds();
    WTile w; w.ta = wave & 3; w.tb0 = (wave >> 2) * 2; w.fr = lane & 15; w.fq = lane >> 4;
    f32x4 acc[2], Tacc[2];
    ZERO2(Tacc); mm2(At, Bt, w, Tacc); mask2<2>(Tacc, w);
    ZERO2(acc); mm2(Kt, At, w, acc); mask2<0>(acc, w);
    f32x4 rb[2], rk[2]; ZERO2(rb); mm2(Bt, Rt, w, rb); mask2<1>(rb, w); ZERO2(rk); mm2(Kt, Rt, w, rk); mask2<1>(rk, w);
    bar_lds();
#pragma unroll
    for (int ci = 0; ci < 2; ++ci) { st_N(Pm, w.ta, w.tb0 + ci, w, Tacc[ci]); st_T(PT, w.ta, w.tb0 + ci, w, Tacc[ci]);
        st_T(AAK, w.ta, w.tb0 + ci, w, acc[ci]); st_T(ARB, w.ta, w.tb0 + ci, w, rb[ci]); st_T(ARK, w.ta, w.tb0 + ci, w, rk[ci]);
#pragma unroll
        for (int j = 0; j < 4; ++j) if (16 * w.ta + 4 * w.fq + j == 16 * (w.tb0 + ci) + w.fr) Tacc[ci][j] += 1.f;
        st_N(TM, w.ta, w.tb0 + ci, w, Tacc[ci]); }
    bar_lds();
#pragma unroll 1
#ifdef PROBE_NEU2
    for (int n = 0; n < 10; ++n) {
#else
    for (int n = 0; n < 5; ++n) {
#endif
        ZERO2(acc); mm2(Pm, PT, w, acc);
        bar_lds();
#pragma unroll
        for (int ci = 0; ci < 2; ++ci) { st_N(Pm, w.ta, w.tb0 + ci, w, acc[ci]); st_T(PT, w.ta, w.tb0 + ci, w, acc[ci]); }
        bar_lds();
        mm2(TM, PT, w, Tacc);
        bar_lds();
#pragma unroll
        for (int ci = 0; ci < 2; ++ci) st_N(TM, w.ta, w.tb0 + ci, w, Tacc[ci]);
        bar_lds();
    }
    ZERO2(acc); mm2(TM, AtT, w, acc); ZERO2(rb); mm2(AAK, VT, w, rb);
#pragma unroll
    for (int ci = 0; ci < 2; ++ci) { st_T(WT, w.ta, w.tb0 + ci, w, acc[ci]); st_T(X1T, w.ta, w.tb0 + ci, w, rb[ci]); }
    bar_lds();
    const size_t ub = (size_t)unit * 4096;
    { ZERO2(acc); mm2(TM, X1T, w, acc);
#pragma unroll
      for (int ci = 0; ci < 2; ++ci) st_T(U2T, w.ta, w.tb0 + ci, w, acc[ci]);
      bf16* MF = (bf16*)(a.ws + WS_MF) + ub; bf16* QF = (bf16*)(a.ws + WS_QF) + ub;
      ZERO2(acc); mm2(WT, BhT, w, acc);
      ZERO2(rb); mm2(WT, ARB, w, rb);
#pragma unroll
      for (int ci = 0; ci < 2; ++ci) { const int tb = w.tb0 + ci; const int col = 16 * tb + w.fr; const float gc = GC[col];
          f32x4 m = acc[ci];
#pragma unroll
          for (int j = 0; j < 4; ++j) if (16 * w.ta + 4 * w.fq + j == col) m[j] += gc;
          const size_t fo = (size_t)((tb * 2 + (w.ta >> 1)) * 64 + lane) * 8 + 4 * (w.ta & 1);
          v2u o; o.x = pk2(m[0], m[1]); o.y = pk2(m[2], m[3]); *(v2u*)(MF + fo) = o;
          const v2u rr = *(const LAS v2u*)(Rt + col * MP + 16 * w.ta + 4 * w.fq);
          f32x4 q = rb[ci]; q[0] += bflo(rr.x); q[1] += bfhi(rr.x); q[2] += bflo(rr.y); q[3] += bfhi(rr.y);
          o.x = pk2(q[0], q[1]); o.y = pk2(q[2], q[3]); *(v2u*)(QF + fo) = o; } }
    bar_lds();
    { float* NF = (float*)((unsigned char*)a.out + OUT_NF) + ub; float* Y2 = (float*)((unsigned char*)a.out + OUT_Y2) + ub;
      ZERO2(acc); mm2(BhT, U2T, w, acc); mm2(KhT, VT, w, acc);
      ZERO2(rb); mm2(U2T, ARB, w, rb); mm2(VT, ARK, w, rb);
#pragma unroll
      for (int ci = 0; ci < 2; ++ci) { const int tb = w.tb0 + ci;
          *(f32x4*)(NF + (size_t)((tb * 4 + w.ta) * 64 + lane) * 4) = acc[ci];
          *(f32x4*)(Y2 + (size_t)(16 * tb + w.fr) * 64 + 16 * w.ta + 4 * w.fq) = rb[ci]; } }
}

constexpr int KR = 4, NR = NCH / KR, SLOT = 12288, RBUF = KR * SLOT, NPIECE = RBUF / 16, LPT = 7;
__device__ __forceinline__ const v4u* sp_src(const Args& a, int h, int cg, int r, int p) {
    const int cc = p / 768, q = p % 768, c = r * KR + cc; const size_t ub = (size_t)(c * 16 + h) * 4096;
    return q < 512 ? (const v4u*)((const bf16*)(a.ws + WS_MF) + ub) + q : (const v4u*)((const float*)((const unsigned char*)a.out + OUT_NF) + ub + cg * 1024) + (q - 512);
}
__device__ __forceinline__ void state_pass(const Args& a, LAS unsigned char* lds, int b, int tid, int wave, int lane) {
    const int h = b >> 2, cg = b & 3, lt = tid - 64;
    v4u ra[LPT], rb[LPT];
    if (wave != 0) {
#pragma unroll
        for (int i = 0; i < LPT; ++i) { const int p = lt + 448 * i; if (p < NPIECE) ra[i] = *sp_src(a, h, cg, 0, p); }
#pragma unroll
        for (int i = 0; i < LPT; ++i) { const int p = lt + 448 * i; if (p < NPIECE) *(LAS v4u*)(lds + p * 16) = ra[i]; }
#pragma unroll
        for (int i = 0; i < LPT; ++i) { const int p = lt + 448 * i; if (p < NPIECE) ra[i] = *sp_src(a, h, cg, 1, p); }
    }
    f32x4 st[4];
#pragma unroll
    for (int i = 0; i < 4; ++i) st[i] = (f32x4){0.f, 0.f, 0.f, 0.f};
    bar_lds();
    bf16* SF = (bf16*)(a.ws + WS_SF);
#define SP_ROUND(r_, RA, RB) do { \
        if (wave != 0) { \
            if ((r_) + 2 < NR) { _Pragma("unroll") for (int i = 0; i < LPT; ++i) { const int p = lt + 448 * i; if (p < NPIECE) RB[i] = *sp_src(a, h, cg, (r_) + 2, p); } } \
            if ((r_) + 1 < NR) { _Pragma("unroll") for (int i = 0; i < LPT; ++i) { const int p = lt + 448 * i; if (p < NPIECE) *(LAS v4u*)(lds + (((r_) + 1) & 1) * RBUF + p * 16) = RA[i]; } } \
        } else { \
            _Pragma("unroll") for (int cc = 0; cc < KR; ++cc) { \
                const LAS unsigned char* sl = lds + ((r_) & 1) * RBUF + cc * SLOT; const int c = (r_) * KR + cc; \
                v4u b0, b1; b0.x = pk2(st[0][0], st[0][1]); b0.y = pk2(st[0][2], st[0][3]); b0.z = pk2(st[1][0], st[1][1]); b0.w = pk2(st[1][2], st[1][3]); \
                b1.x = pk2(st[2][0], st[2][1]); b1.y = pk2(st[2][2], st[2][3]); b1.z = pk2(st[3][0], st[3][1]); b1.w = pk2(st[3][2], st[3][3]); \
                v4u* sfo = (v4u*)(SF + (size_t)(c * 16 + h) * 4096) + (cg * 2) * 64 + lane; sfo[0] = b0; sfo[64] = b1; \
                const bf16x8 f0 = __builtin_bit_cast(bf16x8, b0), f1 = __builtin_bit_cast(bf16x8, b1); \
                _Pragma("unroll") for (int rt = 0; rt < 4; ++rt) { \
                    f32x4 n = *(const LAS f32x4*)(sl + 8192 + (rt * 64 + lane) * 16); \
                    n = MFMA16(*(const LAS bf16x8*)(sl + ((rt * 2 + 0) * 64 + lane) * 16), f0, n); \
                    n = MFMA16(*(const LAS bf16x8*)(sl + ((rt * 2 + 1) * 64 + lane) * 16), f1, n); st[rt] = n; } \
            } \
        } \
        bar_lds(); } while (0)
#pragma unroll 1
    for (int r = 0; r < NR; r += 2) { SP_ROUND(r, ra, rb); SP_ROUND(r + 1, rb, ra); }
#undef SP_ROUND
}

__device__ __forceinline__ void rwkv_out_unit(const Args& a, LAS unsigned char* lds, int unit, int tid, int wave, int lane) {
    const int c = unit >> 4, h = unit & 15, t0 = c * CH, t = tid >> 3, c8 = (tid & 7) * 8, ch = h * 64 + c8;
    const size_t ub = (size_t)unit * 4096;
    const bf16* QF = (const bf16*)(a.ws + WS_QF) + ub; const bf16* SF = (const bf16*)(a.ws + WS_SF) + ub; const float* Y2 = (const float*)((const unsigned char*)a.out + OUT_Y2) + ub;
    LAS float* SY = (LAS float*)lds;
    const int ta = wave & 3, tb0 = (wave >> 2) * 2, fr = lane & 15, fq = lane >> 4;
    bf16x8 af[2], bfr[2][2];
#pragma unroll
    for (int s = 0; s < 2; ++s) { af[s] = *(const bf16x8*)(QF + (size_t)((ta * 2 + s) * 64 + lane) * 8);
#pragma unroll
        for (int ci = 0; ci < 2; ++ci) bfr[s][ci] = *(const bf16x8*)(SF + (size_t)(((tb0 + ci) * 2 + s) * 64 + lane) * 8); }
    float y2[8], v[8], g[8];
    ld8f(Y2 + t * 64 + c8, y2);
    const bf16* proj = (const bf16*)(a.ws + WS_PROJ);
    load_shift8(proj, t0 + t, C_V + ch, a.in[3], v); load_shift8(proj, t0 + t, C_G + ch, a.in[3], g);
    const float bonus = ((const float*)(a.ws + WS_BON))[(size_t)(t0 + t) * 16 + h];
    f32x4 acc[2]; ZERO2(acc);
#pragma unroll
    for (int s = 0; s < 2; ++s)
#pragma unroll
        for (int ci = 0; ci < 2; ++ci) acc[ci] = MFMA16(af[s], bfr[s][ci], acc[ci]);
    bar_lds();
#pragma unroll
    for (int ci = 0; ci < 2; ++ci)
#pragma unroll
        for (int j = 0; j < 4; ++j) SY[(16 * ta + 4 * fq + j) * 68 + 16 * (tb0 + ci) + fr] = acc[ci][j];
    bar_lds();
    float y[8];
#pragma unroll
    for (int j = 0; j < 8; ++j) y[j] = SY[t * 68 + c8 + j] + y2[j];
    rwkv_out8(a, y, v, g, bonus, t0 + t, ch);
}
constexpr int L2_SEG = 129280, L2_XST = 131328, L2_TW = 131584, L2_ADM = 140800, L2_X1T = 150016;
struct PF { v4u p[4], q[4]; };
__device__ __forceinline__ void pf_issue(PF& f, const bf16* proj, int row, int ch) {
    const int cols[4] = {C_R, C_K, C_V, C_G};
#pragma unroll
    for (int i = 0; i < 4; ++i) { f.p[i] = ldg16(proj + (size_t)row * NINP + cols[i] + ch); f.q[i] = (v4u){0u, 0u, 0u, 0u}; if (row > 0) f.q[i] = ldg16(proj + (size_t)(row - 1) * NINP + cols[i] + ch); }
}
__device__ __forceinline__ void pf_shift(const v4u& p, const v4u& q, const float (&mf)[8], float (&o)[8]) {
    float pf[8], qf[8]; unpack8(p, pf); unpack8(q, qf);
#pragma unroll
    for (int j = 0; j < 8; ++j) o[j] = pf[j] + (qf[j] - pf[j]) * mf[j];
}
template <bool DOP, bool DOT> __device__ __forceinline__ void neu_stage(const LAS bf16* Pin, const LAS bf16* PTin, LAS bf16* Pout, LAS bf16* PTout, const LAS bf16* TMin, LAS bf16* TMout, const WTile& w, f32x4 (&Tacc)[2]) {
    f32x4 acc[2];
    if (DOP) { ZERO2(acc); mm2(Pin, PTin, w, acc); }
    if (DOT) mm2(TMin, PTin, w, Tacc);
#pragma unroll
    for (int ci = 0; ci < 2; ++ci) {
        if (DOP) { st_N(Pout, w.ta, w.tb0 + ci, w, acc[ci]); st_T(PTout, w.ta, w.tb0 + ci, w, acc[ci]); }
        if (DOT) st_N(TMout, w.ta, w.tb0 + ci, w, Tacc[ci]);
    }
    bar_lds();
}
__device__ __forceinline__ void rwkv_chunk_group(const Args& a, LAS unsigned char* lds, int item, int tid, int wave, int lane) {
    const int c = item >> 1, hg = item & 1, t0 = c * CH, t = tid >> 3, c8 = (tid & 7) * 8, row = t0 + t;
    const bf16* proj = (const bf16*)(a.ws + WS_PROJ); const bf16* upt = (const bf16*)(a.ws + WS_UPT); const bf16* aupt = upt + 65536; const float* mu = a.in[3];
    LAS bf16* TW = (LAS bf16*)(lds + L2_TW); LAS bf16* ADm = (LAS bf16*)(lds + L2_ADM);
    WTile w; w.ta = wave & 3; w.tb0 = (wave >> 2) * 2; w.fr = lane & 15; w.fq = lane >> 4;
    bar_lds();
    { float x[8]; load_shift8(proj, row, C_WD + c8, mu, x);
#pragma unroll
      for (int j = 0; j < 8; ++j) x[j] = 1.f - 2.f * __builtin_amdgcn_rcpf(1.f + __expf(2.f * x[j]));
      *(LAS v4u*)(TW + t * 72 + c8) = pack8(x);
      load_shift8(proj, row, C_AD + c8, mu, x); *(LAS v4u*)(ADm + t * 72 + c8) = pack8(x); }
    PF pf; pf_issue(pf, proj, row, hg * 512 + c8);
#pragma unroll 1
    for (int hh = 0; hh < 8; ++hh) {
        const int h = hg * 8 + hh, ch = h * 64 + c8, unit = c * 16 + h;
        LAS unsigned char* L = lds; asm volatile("" : "+v"(L));
        LAS bf16* At = (LAS bf16*)(L + L_AT); LAS bf16* AtT = (LAS bf16*)(L + L_ATT); LAS bf16* Bt = (LAS bf16*)(L + L_BT); LAS bf16* Kt = (LAS bf16*)(L + L_KT);
        LAS bf16* Rt = (LAS bf16*)(L + L_RT); LAS bf16* BhT = (LAS bf16*)(L + L_BHT); LAS bf16* KhT = (LAS bf16*)(L + L_KHT); LAS bf16* VT = (LAS bf16*)(L + L_VT);
        LAS bf16* P0 = (LAS bf16*)(L + L_P); LAS bf16* PT0 = (LAS bf16*)(L + L_PT); LAS bf16* TM0 = (LAS bf16*)(L + L_TM);
        LAS bf16* P1 = At; LAS bf16* PT1 = Bt; LAS bf16* TM1 = Kt;
        LAS bf16* AAK = (LAS bf16*)(L + L_AAK); LAS bf16* ARB = (LAS bf16*)(L + L_ARB); LAS bf16* ARK = (LAS bf16*)(L + L_ARK);
        LAS float* SEG = (LAS float*)(L + L2_SEG); LAS float* GC = (LAS float*)(L + L_GC);
        LAS bf16* X1T = (LAS bf16*)(L + L2_X1T);
        LAS float* Z = (LAS float*)(L + 18432); LAS float* AP = Z + 64 * 68;
        LAS bf16* WT = At; LAS bf16* U2T = Bt;
        float pw0[8], pa0[8], pkk[8], pka[8], prk[8], mur[8], muk[8], muv[8];
        ld8f(a.in[4] + ch, pw0); ld8f(a.in[6] + ch, pa0); ld8f(a.in[8] + ch, pkk); ld8f(a.in[9] + ch, pka); ld8f(a.in[10] + ch, prk);
        ld8f(mu + C_R + ch, mur); ld8f(mu + C_K + ch, muk); ld8f(mu + C_V + ch, muv);
        bar_lds();
        { const int rt = w.ta, cp = w.tb0, fr = w.fr, fq = w.fq;
          bf16x8 aT[2], aA[2];
#pragma unroll
          for (int s = 0; s < 2; ++s) { aT[s] = *(const LAS bf16x8*)(TW + (16 * rt + fr) * 72 + 32 * s + 8 * fq); aA[s] = *(const LAS bf16x8*)(ADm + (16 * rt + fr) * 72 + 32 * s + 8 * fq); }
#pragma unroll
          for (int ci = 0; ci < 2; ++ci) { const int ct = cp + ci; f32x4 z = {0.f, 0.f, 0.f, 0.f}, ap = {0.f, 0.f, 0.f, 0.f};
#pragma unroll
              for (int s = 0; s < 2; ++s) { const size_t bo = (size_t)(h * 64 + 16 * ct + fr) * 64 + 32 * s + 8 * fq;
                  z = MFMA16(aT[s], *(const bf16x8*)(upt + bo), z); ap = MFMA16(aA[s], *(const bf16x8*)(aupt + bo), ap); }
#pragma unroll
              for (int j = 0; j < 4; ++j) { Z[(16 * rt + 4 * fq + j) * 68 + 16 * ct + fr] = z[j]; AP[(16 * rt + 4 * fq + j) * 68 + 16 * ct + fr] = ap[j]; } } }
        bar_lds();
        float r[8], kp[8], vv[8], lw[8], wd[8], kk[8], bb[8];
        { float zz[8], aa[8], kr[8];
#pragma unroll
          for (int j = 0; j < 8; ++j) { zz[j] = Z[t * 68 + c8 + j]; aa[j] = AP[t * 68 + c8 + j]; }
          pf_shift(pf.p[0], pf.q[0], mur, r); pf_shift(pf.p[1], pf.q[1], muk, kr); pf_shift(pf.p[2], pf.q[2], muv, vv);
#pragma unroll
          for (int j = 0; j < 8; ++j) { const float z = pw0[j] + zz[j]; const float sp = (z < -15.f) ? -z : __logf(1.f + __expf(-z)); lw[j] = -__expf(-sp - 0.5f); wd[j] = __expf(lw[j]); aa[j] = sigmoidf_(pa0[j] + aa[j]); }
          float ss = 0.f;
#pragma unroll
          for (int j = 0; j < 8; ++j) { kk[j] = kr[j] * pkk[j]; ss += kk[j] * kk[j]; kp[j] = kr[j] * (1.f + (aa[j] - 1.f) * pka[j]); }
          ss = sum8(ss); const float rn = 1.f / fmaxf(sqrtf(ss), 1e-12f);
          float bs = 0.f;
#pragma unroll
          for (int j = 0; j < 8; ++j) { kk[j] *= rn; bb[j] = kk[j] * aa[j]; bs += r[j] * kp[j] * prk[j]; }
          bs = sum8(bs);
          if ((tid & 7) == 0) ((float*)(a.ws + WS_BON))[(size_t)row * 16 + h] = bs; }
        if (hh < 7) pf_issue(pf, proj, row, ch + 64);
        float Lt[8];
#pragma unroll
        for (int j = 0; j < 8; ++j) { float x = lw[j];
#pragma unroll
            for (int d = 8; d < 64; d <<= 1) { const float y = __shfl_up(x, d); if (lane >= d) x += y; }
            Lt[j] = x; }
        if ((lane >> 3) == 7) {
#pragma unroll
            for (int j = 0; j < 8; ++j) SEG[wave * 64 + c8 + j] = Lt[j]; }
        bar_lds();
        {
            float gc[8], x[8], y[8];
            { float off[8], tot[8];
#pragma unroll
              for (int j = 0; j < 8; ++j) { off[j] = 0.f; tot[j] = 0.f; }
#pragma unroll
              for (int s = 0; s < 8; ++s) { const f32x4 s0 = *(const LAS f32x4*)(SEG + s * 64 + c8), s1 = *(const LAS f32x4*)(SEG + s * 64 + c8 + 4);
                  const float sv[8] = {s0.x, s0.y, s0.z, s0.w, s1.x, s1.y, s1.z, s1.w};
#pragma unroll
                  for (int j = 0; j < 8; ++j) { tot[j] += sv[j]; if (s < wave) off[j] += sv[j]; } }
#pragma unroll
              for (int j = 0; j < 8; ++j) { Lt[j] += off[j]; gc[j] = __expf(tot[j]); } }
            if (t == 0) {
#pragma unroll
                for (int j = 0; j < 8; ++j) GC[c8 + j] = gc[j]; }
            float e1[8], ie1[8];
#pragma unroll
            for (int j = 0; j < 8; ++j) { e1[j] = __expf(Lt[j]); ie1[j] = __builtin_amdgcn_rcpf(e1[j]); }
#pragma unroll
            for (int j = 0; j < 8; ++j) x[j] = -kk[j] * e1[j] * __builtin_amdgcn_rcpf(wd[j]);
            *(LAS v4u*)(At + t * MP + c8) = pack8(x); st_bf16x8_T(AtT, c8, t, x);
#pragma unroll
            for (int j = 0; j < 8; ++j) { x[j] = bb[j] * ie1[j]; y[j] = kp[j] * ie1[j]; }
            *(LAS v4u*)(Bt + t * MP + c8) = pack8(x); *(LAS v4u*)(Kt + t * MP + c8) = pack8(y);
#pragma unroll
            for (int j = 0; j < 8; ++j) x[j] = r[j] * e1[j];
            *(LAS v4u*)(Rt + t * MP + c8) = pack8(x);
#pragma unroll
            for (int j = 0; j < 8; ++j) { const float e = gc[j] * ie1[j]; x[j] = bb[j] * e; y[j] = kp[j] * e; }
            st_bf16x8_T(BhT, c8, t, x); st_bf16x8_T(KhT, c8, t, y); st_bf16x8_T(VT, c8, t, vv);
        }
        bar_lds();
        f32x4 acc[2], Tacc[2], rb[2], rk[2];
        ZERO2(Tacc); mm2(At, Bt, w, Tacc); mask2<2>(Tacc, w);
        ZERO2(acc); mm2(Kt, At, w, acc); mask2<0>(acc, w);
        ZERO2(rb); mm2(Bt, Rt, w, rb); mask2<1>(rb, w); ZERO2(rk); mm2(Kt, Rt, w, rk); mask2<1>(rk, w);
        bar_lds();
#pragma unroll
        for (int ci = 0; ci < 2; ++ci) { st_N(P1, w.ta, w.tb0 + ci, w, Tacc[ci]); st_T(PT1, w.ta, w.tb0 + ci, w, Tacc[ci]);
            st_T(AAK, w.ta, w.tb0 + ci, w, acc[ci]); st_T(ARB, w.ta, w.tb0 + ci, w, rb[ci]); st_T(ARK, w.ta, w.tb0 + ci, w, rk[ci]);
#pragma unroll
            for (int j = 0; j < 4; ++j) if (16 * w.ta + 4 * w.fq + j == 16 * (w.tb0 + ci) + w.fr) Tacc[ci][j] += 1.f;
            st_N(TM1, w.ta, w.tb0 + ci, w, Tacc[ci]); }
        bar_lds();
        { ZERO2(acc); mm2(AAK, VT, w, acc);
#pragma unroll
          for (int ci = 0; ci < 2; ++ci) st_T(X1T, w.ta, w.tb0 + ci, w, acc[ci]); }
        neu_stage<true, false>(P1, PT1, P0, PT0, nullptr, nullptr, w, Tacc);
#pragma unroll 1
        for (int n = 0; n < 2; ++n) {
            neu_stage<true, true>(P0, PT0, P1, PT1, TM1, TM0, w, Tacc);
            neu_stage<true, true>(P1, PT1, P0, PT0, TM0, TM1, w, Tacc);
        }
        neu_stage<false, true>(P0, PT0, nullptr, nullptr, TM1, TM0, w, Tacc);
        ZERO2(acc); mm2(TM0, AtT, w, acc); ZERO2(rb); mm2(TM0, X1T, w, rb);
#pragma unroll
        for (int ci = 0; ci < 2; ++ci) { st_T(WT, w.ta, w.tb0 + ci, w, acc[ci]); st_T(U2T, w.ta, w.tb0 + ci, w, rb[ci]); }
        bar_lds();
        const size_t ub = (size_t)unit * 4096;
        { bf16* MF = (bf16*)(a.ws + WS_MF) + ub; bf16* QF = (bf16*)(a.ws + WS_QF) + ub;
          ZERO2(acc); mm2(WT, BhT, w, acc); ZERO2(rb); mm2(WT, ARB, w, rb);
#pragma unroll
          for (int ci = 0; ci < 2; ++ci) { const int tb = w.tb0 + ci; const int col = 16 * tb + w.fr; const float gcv = GC[col];
              f32x4 m = acc[ci];
#pragma unroll
              for (int j = 0; j < 4; ++j) if (16 * w.ta + 4 * w.fq + j == col) m[j] += gcv;
              const size_t fo = (size_t)((tb * 2 + (w.ta >> 1)) * 64 + lane) * 8 + 4 * (w.ta & 1);
              v2u o; o.x = pk2(m[0], m[1]); o.y = pk2(m[2], m[3]); *(v2u*)(MF + fo) = o;
              const v2u rr = *(const LAS v2u*)(Rt + col * MP + 16 * w.ta + 4 * w.fq);
              f32x4 q = rb[ci]; q[0] += bflo(rr.x); q[1] += bfhi(rr.x); q[2] += bflo(rr.y); q[3] += bfhi(rr.y);
              o.x = pk2(q[0], q[1]); o.y = pk2(q[2], q[3]); *(v2u*)(QF + fo) = o; }
          float* NF = (float*)((unsigned char*)a.out + OUT_NF) + ub; float* Y2 = (float*)((unsigned char*)a.out + OUT_Y2) + ub;
          ZERO2(acc); mm2(BhT, U2T, w, acc); mm2(KhT, VT, w, acc);
          ZERO2(rb); mm2(U2T, ARB, w, rb); mm2(VT, ARK, w, rb);
#pragma unroll
          for (int ci = 0; ci < 2; ++ci) { const int tb = w.tb0 + ci;
              *(f32x4*)(NF + (size_t)((tb * 4 + w.ta) * 64 + lane) * 4) = acc[ci];
              *(f32x4*)(Y2 + (size_t)(16 * tb + w.fr) * 64 + 16 * w.ta + 4 * w.fq) = rb[ci]; } }
    }
}
#ifndef HOSTDUP
#define HOSTDUP -1
#endif
#ifndef ONE_LAUNCH
#define ONE_LAUNCH 1
#endif
#if HOSTDUP != -1 || defined(MULTI)
#undef ONE_LAUNCH
#define ONE_LAUNCH 0
#endif
constexpr int NPHASE = 7;
__global__ void __launch_bounds__(NTHR, 2) mega(Args a) {
    extern __shared__ __attribute__((aligned(16))) unsigned char lds_[];
    LAS unsigned char* lds = (LAS unsigned char*)lds_;
    const int tid = threadIdx.x, lane = tid & 63, wave = __builtin_amdgcn_readfirstlane(tid >> 6);
    const int G = gridDim.x, bx = blockIdx.x, vcu = (G % 8 == 0) ? (bx % 8) * (G / 8) + bx / 8 : bx;
    cg::grid_group grid = cg::this_grid();
    volatile LAS unsigned* xst = (volatile LAS unsigned*)(lds + L2_XST);
    if (tid < 2) xst[tid] = 0u;
    __syncthreads();
    XcdBarrier xbar; xbar.bar = (unsigned*)a.ws; xbar.x = 0; xbar.st = xst;
    if (a.ph_hi - a.ph_lo > 1) xbar = xcd_barrier_post((unsigned*)a.ws, xst);
#ifdef PROBE_TS
    unsigned long long ts_[10];
#define STAMP(i) do { ts_[i] = __builtin_amdgcn_s_memrealtime(); } while (0)
#else
#define STAMP(i) do {} while (0)
#endif
    STAMP(0);
#define IN(k) (a.ph_lo <= (k) && (k) < a.ph_hi)
#define SEAM(k) do { if (IN(k) && IN((k) + 1)) xcd_barrier(xbar); } while (0)
    if (a.ph_lo < 0) grid.sync();
    if (IN(0)) { p0_prologue(a, lds, vcu, G, wave, lane); }
    SEAM(0); STAMP(1);
    if (IN(1)) {
        pg8::Gemm g{(const pg8::bf16_t*)(a.ws + WS_XN), (const pg8::bf16_t*)(a.ws + WS_WTIN), T, NINP, D}; pg8::StaticOrder S; S.init(T, NINP, G, bx);
        pg8::EpiBf16<0> E{(pg8::bf16_t*)(a.ws + WS_PROJ), NINP, nullptr, 0, 0, 1.f};
        pg8::gemm_phase<pg8::EpiBf16<0>, pg8::StaticOrder, true, true>(lds, g, S, E);
    }
    SEAM(1); STAMP(2);
    if (IN(2)) {
        for (int it = bx; it < NCH * 2; it += G) rwkv_chunk_group(a, lds, it, tid, wave, lane);
    }
    SEAM(2); STAMP(3);
    if (IN(3)) { if (bx < 64) state_pass(a, lds, bx, tid, wave, lane); else for (int it = bx - 64; it < 512; it += G - 64) attn_unit(a, lds, it, tid, wave, lane); }
    SEAM(3); STAMP(4);
    if (IN(4)) { for (int u = bx; u < NCH * NH; u += G) rwkv_out_unit(a, lds, u, tid, wave, lane); }
    SEAM(4); STAMP(5);
    if (IN(5)) {
        pg8::Gemm g{(const pg8::bf16_t*)(a.ws + WS_MIX), (const pg8::bf16_t*)(a.ws + WS_WTOUT), T, D, D}; pg8::StaticOrder S; S.init(T, D, G, bx);
        if (G == 256 && a.ph_hi - a.ph_lo > 1) {
            pg8::EpiResidNorm E{a.in[0], a.out, (float*)(a.ws + WS_SSP), (unsigned*)a.ws + 4096, a.in[15], D, RMS_EPS};
            pg8::gemm_phase<pg8::EpiResidNorm, pg8::StaticOrder, false, true>(lds, g, S, E);
        } else {
            pg8::EpiResid E{a.in[0], a.out, (float*)(a.ws + WS_SSP), D};
            pg8::gemm_phase<pg8::EpiResid, pg8::StaticOrder, true, true>(lds, g, S, E);
        }
    }
    if (!(G == 256 && a.ph_hi - a.ph_lo > 1)) { SEAM(5); } STAMP(6);
    if (IN(6) && !(G == 256 && a.ph_hi - a.ph_lo > 1)) final_norm(a, vcu, G, wave, lane);
#ifdef PROBE_TS
    STAMP(7); __syncthreads();
    if (bx == 0 && tid == 0) { const int k_ = PROBE_TS; const unsigned long long d_ = (k_ == 8) ? ts_[8] - ts_[2] : ts_[k_ + 1] - ts_[k_]; a.out[0] = (float)d_ * 0.01f; }
#endif
#undef IN
#undef SEAM
}

extern "C" void kernel_launch(void* const* d_in, const int* in_sizes, int n_in, void* d_out, int out_size, void* d_ws, size_t ws_size, hipStream_t stream) {
    static int grid = 0;
    if (grid == 0) {
        int dev = 0, cus = 0;
        if (hipGetDevice(&dev) != hipSuccess || hipDeviceGetAttribute(&cus, hipDeviceAttributeMultiprocessorCount, dev) != hipSuccess) { fprintf(stderr, "kernel_launch: device query failed\n"); grid = -1; return; }
        if (hipFuncSetAttribute((const void*)mega, hipFuncAttributeMaxDynamicSharedMemorySize, LDS_BYTES) != hipSuccess) { fprintf(stderr, "kernel_launch: hipFuncSetAttribute failed\n"); grid = -1; return; }
        (void)hipGetLastError();
        grid = cus;
    }
    if (grid < 0) return;
    Args a{};
    for (int i = 0; i < 16; ++i) a.in[i] = (const float*)d_in[i];
    a.out = (float*)d_out; a.ws = (unsigned char*)d_ws;
#if ONE_LAUNCH
    (void)hipMemsetAsync(d_ws, 0, 32768, stream);
    a.ph_lo = 0; a.ph_hi = NPHASE;
    void* args[] = {&a};
    hipError_t e = hipLaunchCooperativeKernel((const void*)mega, dim3(grid), dim3(NTHR), args, LDS_BYTES, stream);
    if (e != hipSuccess) fprintf(stderr, "cooperative launch failed: %s (grid %d)\n", hipGetErrorString(e), grid);
#else
    for (int p = 0; p < NPHASE; ++p) for (int rep = 0; rep < (p == HOSTDUP ? 2 : 1); ++rep) { a.ph_lo = p; a.ph_hi = p + 1; hipLaunchKernelGGL(mega, dim3(grid), dim3(NTHR), LDS_BYTES, stream, a); }
#endif
}
```

```cpp
#define ONE 1
#include <hip/hip_runtime.h>
#include <hip/hip_cooperative_groups.h>
#include <cstdio>
#include <cstdint>
namespace cg = cooperative_groups;
namespace pg8 {
#define PG8_LAS __attribute__((address_space(3)))
typedef unsigned short bf16_t;
typedef short bf16x8 __attribute__((ext_vector_type(8)));
typedef float f32x4 __attribute__((ext_vector_type(4)));
typedef unsigned u32x4 __attribute__((ext_vector_type(4)));
constexpr int BM = 256, BK = 64, HALF = 128, HTB = HALF * BK * 2  , STAGE_BYTES = 8 * HTB, NXCD = 8, WGM = 8;

__host__ __device__ __forceinline__ int lds_byte(int r, int c) { const int st = (r >> 4) * 2 + (c >> 5), rr = r & 15, cc = c & 31, ob = rr * 64 + cc * 2; return st * 1024 + (ob ^ (((ob >> 9) & 1) << 5)); }
__host__ __device__ __forceinline__ void stage_rc(int b, int& R, int& C) { const int st = b / 1024, sb = b % 1024, swz = sb ^ (((sb >> 9) & 1) << 5); R = (st >> 1) * 16 + swz / 64; C = (st & 1) * 32 + (swz % 64) / 2; }
__host__ __device__ __forceinline__ int perm32(int rho) { const int n = rho >> 4, i = rho & 15; return 8 * (i >> 2) + 4 * n + (i & 3); }

struct Unit { int pm, pn; };
struct Gemm { const bf16_t* A; const bf16_t* Bt; int M, N, K; };

struct StaticOrder {
    int nM, nN, nwg, G, c;
    __host__ __device__ void init(int M, int N, int G_, int c_) { nM = M / BM; nN = N / BM; nwg = nM * nN; G = G_; c = c_; }
    __host__ __device__ bool next(int i, Unit& u) const {
        const long L = (long)i * G + c; if (L >= nwg) return false;
        int wgid = (int)L; { const int q = nwg / NXCD, r = nwg % NXCD, xcd = wgid % NXCD, off = wgid / NXCD; wgid = (xcd < r ? xcd * (q + 1) : r * (q + 1) + (xcd - r) * q) + off; }
        const int nig = WGM * nN, gid = wgid / nig, fm = gid * WGM, gsz = (nM - fm) < WGM ? (nM - fm) : WGM;
        u.pm = fm + ((wgid % nig) % gsz); u.pn = (wgid % nig) / gsz; return true;
    }
    __device__ __forceinline__ void a_ready(const Unit&) const {}
    __device__ __forceinline__ void done(const Unit&) const {}
};

__device__ __forceinline__ unsigned cvt_pk_bf16(float lo, float hi) { unsigned r; asm volatile("v_cvt_pk_bf16_f32 %0, %1, %2" : "=v"(r) : "v"(lo), "v"(hi)); return r; }
typedef float f32x2 __attribute__((ext_vector_type(2)));
__device__ __forceinline__ f32x2 gelu_pk(f32x2 v) {
    const f32x2 av = __builtin_elementwise_abs(v), d = av * 0.2316418882f + 1.0f;
    f32x2 t; t.x = __builtin_amdgcn_rcpf(d.x); t.y = __builtin_amdgcn_rcpf(d.y);
    f32x2 q = t * 0.5307027145f + (-0.7265760135f); q = q * t + 0.7107068705f; q = q * t + (-0.142248368f); q = q * t + 0.127414796f; q = q * t;
    const f32x2 s = (v * v) * (-0.72134752044f);
    f32x2 e; e.x = __builtin_amdgcn_exp2f(s.x); e.y = __builtin_amdgcn_exp2f(s.y);
    const f32x2 m = v * (q * e), r = v - m;
    f32x2 o; o.x = v.x < 0.f ? m.x : r.x; o.y = v.y < 0.f ? m.y : r.y; return o;
}

template <int ACT  > struct EpiBf16 {
    static constexpr bool PERM = true, AFTER_DRAIN = false; static_assert(ACT == 0 || ACT == 1, "EpiBf16: ACT is 0 (none) or 1 (gelu_pk)");
    bf16_t* O; int ldc; const float* bias; int split_cols; size_t split_stride; float scale0;
    __device__ __forceinline__ void operator()(const f32x4 (&acc)[2][2][4][2], const Unit& u, int wr, int wc, int fr, int fq) const {
        const int row0 = u.pm * BM + wr * 64 + fr; int colt = u.pn * BM; bf16_t* base = O;
        float sc = 1.f; if (split_cols) { const int t = colt / split_cols; base += (size_t)t * split_stride; colt -= t * split_cols; if (t == 0) sc = scale0; }
        const int col0 = colt + wc * 32 + 8 * fq, bcol0 = u.pn * BM + wc * 32 + 8 * fq;
        f32x4 bv[2][2];
#pragma unroll
        for (int bj = 0; bj < 2; ++bj)
#pragma unroll
            for (int n = 0; n < 2; ++n) bv[bj][n] = bias ? *(const f32x4*)(bias + bcol0 + bj * HALF + 4 * n) : (f32x4){0.f, 0.f, 0.f, 0.f};
#pragma unroll
        for (int ai = 0; ai < 2; ++ai)
#pragma unroll
            for (int m = 0; m < 4; ++m) { bf16_t* rowp = base + (size_t)(row0 + ai * HALF + m * 16) * ldc + col0;
#pragma unroll
                for (int bj = 0; bj < 2; ++bj) { f32x4 v0 = acc[ai][bj][m][0] + bv[bj][0], v1 = acc[ai][bj][m][1] + bv[bj][1];
                    if (ACT == 1) { f32x2 a = gelu_pk((f32x2){v0[0], v0[1]}), b = gelu_pk((f32x2){v0[2], v0[3]}), c = gelu_pk((f32x2){v1[0], v1[1]}), d = gelu_pk((f32x2){v1[2], v1[3]});
                        v0 = (f32x4){a.x, a.y, b.x, b.y}; v1 = (f32x4){c.x, c.y, d.x, d.y}; }
                    v0 = v0 * sc; v1 = v1 * sc; u32x4 w; w.x = cvt_pk_bf16(v0[0], v0[1]); w.y = cvt_pk_bf16(v0[2], v0[3]); w.z = cvt_pk_bf16(v1[0], v1[1]); w.w = cvt_pk_bf16(v1[2], v1[3]);
                    *(u32x4*)(rowp + bj * HALF) = w; } }
    }
};
struct EpiResid {
    static constexpr bool PERM = false, AFTER_DRAIN = false;
    const float* x; float* out; float* sspart; int ldc;
    __device__ __forceinline__ void operator()(const f32x4 (&acc)[2][2][4][2], const Unit& u, int wr, int wc, int fr, int fq) const {
        const int row0 = u.pm * BM + wr * 64 + fr, col0 = u.pn * BM + wc * 32 + 4 * fq;
#pragma unroll
        for (int ai = 0; ai < 2; ++ai)
#pragma unroll
            for (int m = 0; m < 4; ++m) {
                const int row = row0 + ai * HALF + m * 16; float ss = 0.f;
#pragma unroll
                for (int bj = 0; bj < 2; ++bj)
#pragma unroll
                    for (int n = 0; n < 2; ++n) {
                        const size_t off = (size_t)row * ldc + col0 + bj * HALF + n * 16;
                        const f32x4 xv = *(const f32x4*)(x + off); const f32x4 v = acc[ai][bj][m][n] + xv;
                        *(f32x4*)(out + off) = v; ss += (v[0] * v[0] + v[1] * v[1]) + (v[2] * v[2] + v[3] * v[3]);
                    }
                ss += __shfl_xor(ss, 16); ss += __shfl_xor(ss, 32);
                if (fq == 0) sspart[(size_t)row * 32 + u.pn * 4 + wc] = ss;
            }
    }
};
struct EpiResidNorm {
    static constexpr bool PERM = false, AFTER_DRAIN = true;
    const float* x; float* out; float* ssp; unsigned* cnt; const float* gain; int ldc; float eps;
    __device__ __forceinline__ void fused(f32x4 (&acc)[2][2][4][2], const Unit& u, int wr, int wc, int fr, int fq, PG8_LAS unsigned char* lds, int wid, int lane) const {
        const int row0 = u.pm * BM + wr * 64 + fr, col0 = u.pn * BM + wc * 32 + 4 * fq;
#pragma unroll
        for (int ai = 0; ai < 2; ++ai)
#pragma unroll
            for (int m = 0; m < 4; ++m) {
                const int row = row0 + ai * HALF + m * 16; float ss = 0.f;
#pragma unroll
                for (int bj = 0; bj < 2; ++bj)
#pragma unroll
                    for (int n = 0; n < 2; ++n) {
                        const f32x4 xv = *(const f32x4*)(x + (size_t)row * ldc + col0 + bj * HALF + n * 16); const f32x4 v = acc[ai][bj][m][n] + xv;
                        acc[ai][bj][m][n] = v; ss += (v[0] * v[0] + v[1] * v[1]) + (v[2] * v[2] + v[3] * v[3]);
                    }
                ss += __shfl_xor(ss, 16); ss += __shfl_xor(ss, 32);
                if (fq == 0) __hip_atomic_store(ssp + (size_t)row * 32 + u.pn * 4 + wc, ss, __ATOMIC_RELAXED, __HIP_MEMORY_SCOPE_AGENT);
            }
        asm volatile("s_waitcnt vmcnt(0)" ::: "memory");
        __syncthreads();
        unsigned* c = cnt + 64 * u.pm;
        if (threadIdx.x == 0) {
            __hip_atomic_fetch_add(c, 1u, __ATOMIC_RELEASE, __HIP_MEMORY_SCOPE_AGENT);
            unsigned spins = 0;
            while (__hip_atomic_load(c, __ATOMIC_RELAXED, __HIP_MEMORY_SCOPE_AGENT) < 8u) { __builtin_amdgcn_s_sleep(2); if (++spins > (1u << 22)) break; }
            __builtin_amdgcn_fence(__ATOMIC_ACQUIRE, "agent");
        }
        __syncthreads();
        PG8_LAS float* S = (PG8_LAS float*)lds;
        if (threadIdx.x < 256) {
            const float* p = ssp + (size_t)(u.pm * BM + threadIdx.x) * 32; float s = 0.f;
#pragma unroll
            for (int i = 0; i < 32; ++i) s += __hip_atomic_load(p + i, __ATOMIC_RELAXED, __HIP_MEMORY_SCOPE_AGENT);
            S[threadIdx.x] = 1.0f / sqrtf(s * (1.0f / 2048.0f) + eps);
        }
        __syncthreads();
#pragma unroll
        for (int bj = 0; bj < 2; ++bj)
#pragma unroll
            for (int n = 0; n < 2; ++n) {
                const f32x4 g = *(const f32x4*)(gain + col0 + bj * HALF + n * 16);
#pragma unroll
                for (int ai = 0; ai < 2; ++ai)
#pragma unroll
                    for (int m = 0; m < 4; ++m) {
                        const int lr = wr * 64 + fr + ai * HALF + m * 16; const float rs = S[lr];
                        f32x4 v = acc[ai][bj][m][n]; v[0] *= rs * g[0]; v[1] *= rs * g[1]; v[2] *= rs * g[2]; v[3] *= rs * g[3];
                        *(f32x4*)(out + (size_t)(u.pm * BM + lr) * ldc + col0 + bj * HALF + n * 16) = v;
                    }
            }
    }
};

template <class Epi, class Sched, bool ALIGN_EPI = false, bool SP2 = false>
__device__ __forceinline__ void gemm_phase(PG8_LAS unsigned char* lds, const Gemm g, const Sched& S, const Epi& E) {
    const int tid = threadIdx.x, wid = __builtin_amdgcn_readfirstlane(tid >> 6), lane = tid & 63, wr = wid >> 2, wc = wid & 3, fr = lane & 15, fq = lane >> 4;
    const int K = g.K, nt = K / BK;
    unsigned voffA[2], voffB[2];
#pragma unroll
    for (int i = 0; i < 2; ++i) { int R, C; stage_rc(tid * 16 + i * 8192, R, C); const int Rb = Epi::PERM ? ((R & ~31) + perm32(R & 31)) : R;
        voffA[i] = (unsigned)(R * K + C) * 2u; voffB[i] = (unsigned)(Rb * K + C) * 2u; }
    const size_t kstep = (size_t)(BK * 2);
    const size_t hstep = (size_t)HALF * K * 2;
    const size_t tstep = 2 * hstep;
    const unsigned ldsw = (unsigned)wid * 1024u;
    const int aoff = lds_byte(wr * 64 + fr, fq * 8), boff = lds_byte(wc * 32 + fr, fq * 8);
#define PG8_SA(b, h) (((b) * 2 + (h)) * HTB)
#define PG8_SB(b, h) ((4 + (b) * 2 + (h)) * HTB)
#define PG8_STAGE(bufoff, gbase, voff) do { _Pragma("unroll") for (int _i = 0; _i < 2; ++_i) \
        __builtin_amdgcn_global_load_lds((const unsigned*)((const char*)(gbase) + (voff)[_i]), (PG8_LAS unsigned*)(lds + (bufoff) + ldsw + _i * 8192), 16, 0, 0); } while (0)
#define PG8_LDA(dst, b, h) do { _Pragma("unroll") for (int m = 0; m < 4; ++m) _Pragma("unroll") for (int k = 0; k < 2; ++k) dst[m][k] = *(const PG8_LAS bf16x8*)(lds + PG8_SA(b, h) + aoff + m * 2048 + k * 1024); } while (0)
#define PG8_LDB(dst, b, h) do { _Pragma("unroll") for (int n = 0; n < 2; ++n) _Pragma("unroll") for (int k = 0; k < 2; ++k) dst[n][k] = *(const PG8_LAS bf16x8*)(lds + PG8_SB(b, h) + boff + n * 2048 + k * 1024); } while (0)
#define PG8_MMA(ai, bj, At, Bt) do { __builtin_amdgcn_s_setprio(1); _Pragma("unroll") for (int m = 0; m < 4; ++m) _Pragma("unroll") for (int n = 0; n < 2; ++n) _Pragma("unroll") for (int k = 0; k < 2; ++k) \
        acc[ai][bj][m][n] = __builtin_amdgcn_mfma_f32_16x16x32_bf16(Bt[n][k], At[m][k], acc[ai][bj][m][n], 0, 0, 0); __builtin_amdgcn_s_setprio(0); } while (0)
#define PG8_WAIT_V(n) asm volatile("s_waitcnt vmcnt(" #n ")" ::: "memory")
#define PG8_WAIT_L(n) asm volatile("s_waitcnt lgkmcnt(" #n ")" ::: "memory")
#define PG8_BAR __builtin_amdgcn_s_barrier()
#define PG8_SCHED __builtin_amdgcn_sched_barrier(0)
    Unit cur, nxt; int ui = 0;
    if (!S.next(0, cur)) return;
    f32x4 acc[2][2][4][2];
#pragma unroll
    for (int a = 0; a < 2; ++a)
#pragma unroll
        for (int b = 0; b < 2; ++b)
#pragma unroll
            for (int m = 0; m < 4; ++m)
#pragma unroll
                for (int n = 0; n < 2; ++n) acc[a][b][m][n] = (f32x4){0.f, 0.f, 0.f, 0.f};
    bf16x8 At[4][2], B0[2][2], B1[2][2];
    const char* cA = (const char*)g.A + (size_t)cur.pm * tstep; const char* cB = (const char*)g.Bt + (size_t)cur.pn * tstep;
    S.a_ready(cur);
    if constexpr (SP2) {
        PG8_STAGE(PG8_SB(0, 0), cB, voffB); PG8_STAGE(PG8_SB(0, 1), cB + hstep, voffB); PG8_STAGE(PG8_SA(0, 0), cA, voffA); PG8_STAGE(PG8_SA(0, 1), cA + hstep, voffA);
        if (wr == 1) PG8_BAR;
        PG8_WAIT_V(2); PG8_BAR;
        PG8_STAGE(PG8_SB(1, 0), cB + kstep, voffB); PG8_STAGE(PG8_SA(1, 0), cA + kstep, voffA); PG8_STAGE(PG8_SB(1, 1), cB + hstep + kstep, voffB);
        PG8_WAIT_V(6); PG8_BAR;
    } else {
        PG8_STAGE(PG8_SB(0, 0), cB, voffB); PG8_STAGE(PG8_SA(0, 0), cA, voffA); PG8_STAGE(PG8_SB(0, 1), cB + hstep, voffB); PG8_STAGE(PG8_SA(0, 1), cA + hstep, voffA);
        if (wr == 1) PG8_BAR;
        PG8_WAIT_V(4); PG8_BAR;
        PG8_STAGE(PG8_SB(1, 0), cB + kstep, voffB); PG8_STAGE(PG8_SA(1, 0), cA + kstep, voffA); PG8_STAGE(PG8_SB(1, 1), cB + hstep + kstep, voffB);
        PG8_WAIT_V(6); PG8_BAR;
    }
    for (;;) {
        const bool has_next = S.next(ui + 1, nxt);
        const char* nA = has_next ? (const char*)g.A + (size_t)nxt.pm * tstep : cA; const char* nB = has_next ? (const char*)g.Bt + (size_t)nxt.pn * tstep : cB;
        for (int t = 0; t < nt; t += 2) {
            const bool last = (t == nt - 2);
            const char* a1 = cA + (size_t)(t + 1) * kstep;
            const char* a2 = last ? nA : cA + (size_t)(t + 2) * kstep; const char* b2 = last ? nB : cB + (size_t)(t + 2) * kstep;
            const char* a3 = a2 + kstep; const char* b3 = b2 + kstep;
            if (last && has_next) S.a_ready(nxt);
            if constexpr (SP2) {
            PG8_LDB(B0, 0, 0); PG8_LDB(B1, 0, 1); PG8_SCHED; PG8_LDA(At, 0, 0); PG8_STAGE(PG8_SA(1, 1), a1 + hstep, voffA);
            PG8_WAIT_V(8); PG8_WAIT_L(0); PG8_BAR; PG8_MMA(0, 0, At, B0); PG8_MMA(0, 1, At, B1); PG8_BAR; PG8_SCHED;
            PG8_LDA(At, 0, 1); PG8_STAGE(PG8_SB(0, 0), b2, voffB); PG8_STAGE(PG8_SB(0, 1), b2 + hstep, voffB); PG8_STAGE(PG8_SA(0, 0), a2, voffA);
            PG8_WAIT_V(8); PG8_WAIT_L(0); PG8_BAR; PG8_MMA(1, 0, At, B0); PG8_MMA(1, 1, At, B1); PG8_BAR; PG8_SCHED;
            PG8_LDB(B0, 1, 0); PG8_LDB(B1, 1, 1); PG8_SCHED; PG8_LDA(At, 1, 0); PG8_STAGE(PG8_SA(0, 1), a2 + hstep, voffA);
            PG8_WAIT_V(8); PG8_WAIT_L(0); PG8_BAR; PG8_MMA(0, 0, At, B0); PG8_MMA(0, 1, At, B1); PG8_BAR; PG8_SCHED;
            PG8_LDA(At, 1, 1); PG8_STAGE(PG8_SB(1, 0), b3, voffB); PG8_STAGE(PG8_SB(1, 1), b3 + hstep, voffB); PG8_STAGE(PG8_SA(1, 0), a3, voffA);
            PG8_WAIT_V(8); PG8_WAIT_L(0); PG8_BAR; PG8_MMA(1, 0, At, B0); PG8_MMA(1, 1, At, B1); PG8_BAR; PG8_SCHED;
            } else {
            PG8_LDB(B0, 0, 0); PG8_SCHED; PG8_LDA(At, 0, 0); PG8_STAGE(PG8_SA(1, 1), a1 + hstep, voffA);
            PG8_WAIT_L(8); PG8_BAR; PG8_WAIT_L(0); PG8_MMA(0, 0, At, B0); PG8_BAR; PG8_SCHED;
            PG8_LDB(B1, 0, 1); PG8_STAGE(PG8_SB(0, 0), b2, voffB);
            PG8_BAR; PG8_WAIT_L(0); PG8_MMA(0, 1, At, B1); PG8_BAR;
            PG8_LDA(At, 0, 1); PG8_STAGE(PG8_SA(0, 0), a2, voffA);
            PG8_BAR; PG8_WAIT_L(0); PG8_MMA(1, 0, At, B0); PG8_BAR; PG8_SCHED;
            PG8_STAGE(PG8_SB(0, 1), b2 + hstep, voffB);
            PG8_WAIT_V(6); PG8_BAR; PG8_MMA(1, 1, At, B1); PG8_BAR;
            PG8_LDB(B0, 1, 0); PG8_SCHED; PG8_LDA(At, 1, 0); PG8_STAGE(PG8_SA(0, 1), a2 + hstep, voffA);
            PG8_WAIT_L(8); PG8_BAR; PG8_WAIT_L(0); PG8_MMA(0, 0, At, B0); PG8_BAR; PG8_SCHED;
            PG8_LDB(B1, 1, 1); PG8_STAGE(PG8_SB(1, 0), b3, voffB);
            PG8_BAR; PG8_WAIT_L(0); PG8_MMA(0, 1, At, B1); PG8_BAR;
            PG8_LDA(At, 1, 1); PG8_STAGE(PG8_SA(1, 0), a3, voffA);
            PG8_BAR; PG8_WAIT_L(0); PG8_MMA(1, 0, At, B0); PG8_BAR; PG8_SCHED;
            PG8_STAGE(PG8_SB(1, 1), b3 + hstep, voffB);
            PG8_WAIT_V(6); PG8_BAR; PG8_MMA(1, 1, At, B1); PG8_BAR;
            }
        }
        if constexpr (ALIGN_EPI) { if (wr == 0) PG8_BAR; }
        if constexpr (!Epi::AFTER_DRAIN) { E(acc, cur, wr, wc, fr, fq); S.done(cur); }
        if (!has_next) break;
#pragma unroll
        for (int a = 0; a < 2; ++a)
#pragma unroll
            for (int b = 0; b < 2; ++b)
#pragma unroll
                for (int m = 0; m < 4; ++m)
#pragma unroll
                    for (int n = 0; n < 2; ++n) acc[a][b][m][n] = (f32x4){0.f, 0.f, 0.f, 0.f};
        cur = nxt; cA = nA; cB = nB; ++ui;
        if constexpr (ALIGN_EPI) { if (wr == 1) PG8_BAR; }
    }
    PG8_WAIT_V(0);
    if constexpr (!ALIGN_EPI) { if (wr == 0) PG8_BAR; }
    PG8_BAR;
    if constexpr (Epi::AFTER_DRAIN) { E.fused(acc, cur, wr, wc, fr, fq, lds, wid, lane); S.done(cur); }
#undef PG8_SA
#undef PG8_SB
#undef PG8_STAGE
#undef PG8_LDA
#undef PG8_LDB
#undef PG8_MMA
#undef PG8_WAIT_V
#undef PG8_WAIT_L
#undef PG8_BAR
#undef PG8_SCHED
}
}
constexpr int T = 8192, D = 2048, NIN = 6528, NINP = 6656, RW = 1024, NH = 16, HD = 64, CH = 64, NCH = T / CH;
constexpr int C_R = 0, C_K = 1024, C_V = 2048, C_WD = 3072, C_AD = 3136, C_G = 3200, C_AQ = 4224, C_AK = 5248, C_AV = 5376, C_AG = 5504;
constexpr float RMS_EPS = 1e-5f, LNX_EPS = 64e-5f;
constexpr int NWAVES = 8, NTHR = 512;
constexpr size_t MiB = 1u << 20;
constexpr size_t WS_WTIN = 1 * MiB;
constexpr size_t WS_XN = 27 * MiB;
constexpr size_t WS_WTOUT = 59 * MiB;
constexpr size_t WS_UPT = 67 * MiB;
constexpr size_t WS_SSP = 68 * MiB;
constexpr size_t WS_PROJ = 70 * MiB;
constexpr size_t WS_SCR = 174 * MiB;
constexpr size_t WS_MIX = 1 * MiB;
constexpr size_t WS_P32 = 223 * MiB;
constexpr int LDS_BYTES = 163840;

#define GAS __attribute__((address_space(1)))
#define LAS __attribute__((address_space(3)))
typedef unsigned short bf16;
typedef unsigned v4u __attribute__((ext_vector_type(4)));
typedef unsigned v2u __attribute__((ext_vector_type(2)));
typedef float f32x4 __attribute__((ext_vector_type(4)));
typedef float f32x16 __attribute__((ext_vector_type(16)));
typedef short bf16x8 __attribute__((ext_vector_type(8)));
typedef __bf16 bf16x2_t __attribute__((ext_vector_type(2)));
__device__ __forceinline__ unsigned pk2(float a, float b) { bf16x2_t v; v[0] = (__bf16)a; v[1] = (__bf16)b; return __builtin_bit_cast(unsigned, v); }
__device__ __forceinline__ float bflo(unsigned u) { return __uint_as_float(u << 16); }
__device__ __forceinline__ float bfhi(unsigned u) { return __uint_as_float(u & 0xffff0000u); }
__device__ __forceinline__ void unpack8(const v4u& p, float (&f)[8]) { f[0] = bflo(p.x); f[1] = bfhi(p.x); f[2] = bflo(p.y); f[3] = bfhi(p.y); f[4] = bflo(p.z); f[5] = bfhi(p.z); f[6] = bflo(p.w); f[7] = bfhi(p.w); }
__device__ __forceinline__ v4u pack8(const float (&f)[8]) { v4u o; o.x = pk2(f[0], f[1]); o.y = pk2(f[2], f[3]); o.z = pk2(f[4], f[5]); o.w = pk2(f[6], f[7]); return o; }
__device__ __forceinline__ float wave_sum(float v) {
#pragma unroll
    for (int o = 1; o < 64; o <<= 1) v += __shfl_xor(v, o);
    return v;
}
__device__ __forceinline__ float sum8(float v) { v += __shfl_xor(v, 1); v += __shfl_xor(v, 2); v += __shfl_xor(v, 4); return v; }
__device__ __forceinline__ float sigmoidf_(float x) { return 1.f / (1.f + __expf(-x)); }
__device__ __forceinline__ float siluf_(float x) { return x / (1.f + __expf(-x)); }

__device__ __forceinline__ void bar_lds() { asm volatile("s_waitcnt lgkmcnt(0)" ::: "memory"); __builtin_amdgcn_s_barrier(); asm volatile("" ::: "memory"); }
struct Args { const float* in[16]; float* out; unsigned char* ws; int ph_lo, ph_hi; };

struct TItem { const float* W; bf16* WT; int K, N, k0, n0; };
__device__ __forceinline__ bool p0_item(const Args& a, int it, TItem& o) {
    constexpr int I_IN = (D / 64) * (NIN / 32), I_OUT = (D / 64) * (D / 32), I_UP = RW / 32;
    bf16* wtin = (bf16*)(a.ws + WS_WTIN); bf16* wtout = (bf16*)(a.ws + WS_WTOUT); bf16* upt = (bf16*)(a.ws + WS_UPT); bf16* aupt = upt + 65536;
    int r = it;
    if (r < 0) { r += I_OUT; if (r < 0) return false; o.W = a.in[14]; o.WT = wtout; o.K = D; o.N = D; }
    else if (r < I_IN) { o.W = a.in[2]; o.WT = wtin; o.K = D; o.N = NIN; }
    else if ((r -= I_IN) < I_UP) { o.W = a.in[5]; o.WT = upt; o.K = 64; o.N = RW; }
    else if ((r -= I_UP) < I_UP) { o.W = a.in[7]; o.WT = aupt; o.K = 64; o.N = RW; }
    else return false;
    const int nblk = o.N / 32; o.k0 = 64 * (r / nblk); o.n0 = 32 * (r % nblk); return true;
}
__device__ __forceinline__ void p0_ld(const TItem& t, int lane, f32x4 (&v)[8]) {
#pragma unroll
    for (int i = 0; i < 8; ++i) v[i] = *(const f32x4*)(t.W + (size_t)(t.k0 + 8 * i + (lane >> 3)) * t.N + t.n0 + 4 * (lane & 7));
}
__device__ __forceinline__ void p0_st(const TItem& t, int lane, const f32x4 (&v)[8], LAS float* scr) {
#pragma unroll
    for (int i = 0; i < 8; ++i) { LAS float* d = scr + (8 * i + (lane >> 3)) * 33 + 4 * (lane & 7); d[0] = v[i].x; d[1] = v[i].y; d[2] = v[i].z; d[3] = v[i].w; }
    asm volatile("s_waitcnt lgkmcnt(0)" ::: "memory");
    const int c = lane & 7;
#pragma unroll
    for (int j = 0; j < 4; ++j) { const int n = (lane >> 3) + 8 * j; const LAS float* s = scr + (8 * c) * 33 + n;
        v4u o; o.x = pk2(s[0 * 33], s[1 * 33]); o.y = pk2(s[2 * 33], s[3 * 33]); o.z = pk2(s[4 * 33], s[5 * 33]); o.w = pk2(s[6 * 33], s[7 * 33]);
        *(v4u*)(t.WT + (size_t)(t.n0 + n) * t.K + t.k0 + 8 * c) = o; }
    asm volatile("s_waitcnt lgkmcnt(0)" ::: "memory");
}
__device__ __forceinline__ void wout_transposes(const Args& a, LAS unsigned char* lds, int gw, int NGW, int wave, int lane) {
    LAS float* scr = (LAS float*)(lds + wave * 16384);
    constexpr int I_OUT = (D / 64) * (D / 32);
    for (int it = gw - I_OUT; it < 0; it += NGW) { TItem t0; f32x4 v0[8]; if (!p0_item(a, it, t0)) break; p0_ld(t0, lane, v0); p0_st(t0, lane, v0, scr); }
}
__device__ __forceinline__ void p0_prologue(const Args& a, LAS unsigned char* lds, int vcu, int G, int wave, int lane) {
    LAS float* scr = (LAS float*)(lds + wave * 16384);
    const int gw = vcu * NWAVES + wave, NGW = G * NWAVES;
    bf16* wtin = (bf16*)(a.ws + WS_WTIN);
#ifdef PROBE_P0X
    for (int rep_ = 0; rep_ < 2; ++rep_)
#endif
    for (int it = gw; ; it += 2 * NGW) {
        TItem t0, t1; f32x4 v0[8], v1[8];
        const bool h0 = p0_item(a, it, t0), h1 = p0_item(a, it + NGW, t1);
        if (!h0) break;
        p0_ld(t0, lane, v0); if (h1) p0_ld(t1, lane, v1);
        p0_st(t0, lane, v0, scr); if (h1) p0_st(t1, lane, v1, scr);
    }
    { v4u z = {0u, 0u, 0u, 0u}; v4u* p = (v4u*)(wtin + (size_t)NIN * D); const int n16 = (NINP - NIN) * D * 2 / 16;
      for (int i = gw * 64 + lane; i < n16; i += NGW * 64) p[i] = z; }
    const float* gain = a.in[1];
#ifdef PROBE_P0R
    for (int rep_ = 0; rep_ < 2; ++rep_)
#endif
    for (int m = gw; m < T; m += 2 * NGW) {
        const int m2 = m + NGW;
        const f32x4* xr = (const f32x4*)(a.in[0] + (size_t)m * D) + lane; const f32x4* xr2 = (const f32x4*)(a.in[0] + (size_t)(m2 < T ? m2 : m) * D) + lane;
        f32x4 v[8], u[8]; float s = 0.f, s2 = 0.f;
#pragma unroll
        for (int j = 0; j < 8; ++j) { v[j] = xr[64 * j]; u[j] = xr2[64 * j]; }
#pragma unroll
        for (int j = 0; j < 8; ++j) { s += (v[j].x * v[j].x + v[j].y * v[j].y) + (v[j].z * v[j].z + v[j].w * v[j].w); s2 += (u[j].x * u[j].x + u[j].y * u[j].y) + (u[j].z * u[j].z + u[j].w * u[j].w); }
        const float rstd = 1.f / sqrtf(wave_sum(s) * (1.f / D) + RMS_EPS), rstd2 = 1.f / sqrtf(wave_sum(s2) * (1.f / D) + RMS_EPS);
        v2u* o8 = (v2u*)((bf16*)(a.ws + WS_XN) + (size_t)m * D) + lane; v2u* o82 = (v2u*)((bf16*)(a.ws + WS_XN) + (size_t)m2 * D) + lane;
#pragma unroll
        for (int j = 0; j < 8; ++j) { const f32x4 g = *((const f32x4*)gain + lane + 64 * j); v2u o; o.x = pk2(v[j].x * rstd * g.x, v[j].y * rstd * g.y); o.y = pk2(v[j].z * rstd * g.z, v[j].w * rstd * g.w); o8[64 * j] = o;
            if (m2 < T) { o.x = pk2(u[j].x * rstd2 * g.x, u[j].y * rstd2 * g.y); o.y = pk2(u[j].z * rstd2 * g.z, u[j].w * rstd2 * g.w); o82[64 * j] = o; } }
    }
}
__device__ __forceinline__ void final_norm(const Args& a, int vcu, int G, int wave, int lane) {
    const int gw = vcu * NWAVES + wave, NGW = G * NWAVES; const float* ssp = (const float*)(a.ws + WS_SSP); const float* gain = a.in[15];
    for (int m = gw; m < T; m += NGW) {
        float s = (lane < 32) ? ssp[(size_t)m * 32 + lane] : 0.f; s = wave_sum(s);
        const float rstd = 1.f / sqrtf(s * (1.f / D) + RMS_EPS);
        f32x4* xr = (f32x4*)(a.out + (size_t)m * D) + lane;
#pragma unroll
        for (int j = 0; j < 8; ++j) { f32x4 v = xr[64 * j]; const f32x4 g = *((const f32x4*)gain + lane + 64 * j); v.x *= rstd * g.x; v.y *= rstd * g.y; v.z *= rstd * g.z; v.w *= rstd * g.w; xr[64 * j] = v; }
    }
}
#define XB_TMO      128
#define XB_XCNT(j)  (256  + 64 * (j))
#define XB_XSUB(j)  (1280 + 64 * (j))
#define XB_XGEN(j)  (2304 + 64 * (j))
#define XB_TOP      3328
#define XB_TOPGEN   3392
#define XCD_BAR_WORDS 3456
#define XB_SPIN_CAP (1u << 18)

__device__ __forceinline__ unsigned xb_ld(unsigned* p)              { return __hip_atomic_load(p, __ATOMIC_RELAXED, __HIP_MEMORY_SCOPE_AGENT); }
__device__ __forceinline__ unsigned xb_add(unsigned* p, unsigned v) { return __hip_atomic_fetch_add(p, v, __ATOMIC_RELAXED, __HIP_MEMORY_SCOPE_AGENT); }
__device__ __forceinline__ unsigned xb_xcc_id() { return (unsigned)__builtin_amdgcn_s_getreg((3 << 11) | 20) & 0xFu; }
#define XB_SPIN(cond, bar) do { unsigned _sp = 0; while (cond) { __builtin_amdgcn_s_sleep(1); \
    if ((++_sp & 255u) == 0u) { if (xb_ld(&(bar)[XB_TMO])) break; if (_sp > XB_SPIN_CAP) { atomicAdd(&(bar)[XB_TMO], 1u); break; } } } } while (0)

struct XcdBarrier {
    unsigned* bar; unsigned x;
    volatile LAS unsigned* st;
};

__device__ __forceinline__ XcdBarrier xcd_barrier_post(unsigned* bar, volatile LAS unsigned* st) {
    XcdBarrier b; b.bar = bar; b.x = xb_xcc_id(); b.st = st;
    if (threadIdx.x == 0) (void)xb_add(&bar[XB_XCNT(b.x)], 1u);
    return b;
}
__device__ __forceinline__ void xcd_barrier_complete(unsigned* bar, unsigned x, unsigned& nloc, unsigned& nx) {
    const unsigned G = gridDim.x * gridDim.y * gridDim.z;
    unsigned sum, cnt, mine, sp = 0u;
    for (;;) {
        sum = 0u; cnt = 0u; mine = 0u;
#pragma unroll
        for (unsigned j = 0; j < 16; ++j) { const unsigned c = xb_ld(&bar[XB_XCNT(j)]); sum += c; cnt += (c > 0u) ? 1u : 0u; mine = (j == x) ? c : mine; }
        if (sum == G) break;
        __builtin_amdgcn_s_sleep(1);
        if ((++sp & 255u) == 0u) { if (xb_ld(&bar[XB_TMO])) break; if (sp > XB_SPIN_CAP) { atomicAdd(&bar[XB_TMO], 1u); break; } }
    }
    nloc = mine > 0u ? mine : 1u; nx = cnt > 0u ? cnt : 1u;
}

__device__ __forceinline__ void xcd_barrier(const XcdBarrier& b) {
    asm volatile("s_waitcnt vmcnt(0)" ::: "memory");
    __syncthreads();
    if (threadIdx.x == 0) {
        unsigned* bar = b.bar;
        __builtin_amdgcn_s_waitcnt(0);
        unsigned nloc = b.st[0], nx = b.st[1];
        if (nloc == 0u) { xcd_barrier_complete(bar, b.x, nloc, nx); b.st[0] = nloc; b.st[1] = nx; }
        const unsigned old = xb_add(&bar[XB_XSUB(b.x)], 1u);
        const unsigned gen = old / nloc;
        if (old + 1u == (gen + 1u) * nloc) {
            __builtin_amdgcn_fence(__ATOMIC_RELEASE, "agent");
            asm volatile("s_waitcnt vmcnt(0)" ::: "memory");
            const unsigned og = xb_add(&bar[XB_TOP], 1u);
            const unsigned tg = og / nx;
            if (og + 1u == (tg + 1u) * nx) xb_add(&bar[XB_TOPGEN], 1u);
            else XB_SPIN(xb_ld(&bar[XB_TOPGEN]) == tg, bar);
            __builtin_amdgcn_fence(__ATOMIC_ACQUIRE, "agent");
            xb_add(&bar[XB_XGEN(b.x)], 1u);
            asm volatile("s_waitcnt vmcnt(0)" ::: "memory");
        } else {
            XB_SPIN(xb_ld(&bar[XB_XGEN(b.x)]) == gen, bar);
            __builtin_amdgcn_fence(__ATOMIC_ACQUIRE, "agent");
            asm volatile("s_waitcnt vmcnt(0)" ::: "memory");
        }
    }
    __syncthreads();
}

#define MFMA32(a_, b_, c_) __builtin_amdgcn_mfma_f32_32x32x16_bf16((a_), (b_), (c_), 0, 0, 0)
#define MFMA16(a_, b_, c_) __builtin_amdgcn_mfma_f32_16x16x32_bf16((a_), (b_), (c_), 0, 0, 0)
__device__ __forceinline__ v4u ldg16(const bf16* p) { return *(const v4u*)p; }
__device__ __forceinline__ void load_shift8(const bf16* proj, int row, int col, const float* mu, float (&o)[8]) {
    const v4u p = ldg16(proj + (size_t)row * NINP + col); v4u q = {0u, 0u, 0u, 0u};
    if (row > 0) q = ldg16(proj + (size_t)(row - 1) * NINP + col);
    float pf[8], qf[8]; unpack8(p, pf); unpack8(q, qf);
    const f32x4 m0 = *(const f32x4*)(mu + col), m1 = *(const f32x4*)(mu + col + 4);
    const float mf[8] = {m0.x, m0.y, m0.z, m0.w, m1.x, m1.y, m1.z, m1.w};
#pragma unroll
    for (int j = 0; j < 8; ++j) o[j] = pf[j] + (qf[j] - pf[j]) * mf[j];
}
__device__ __forceinline__ void ld8f(const float* p, float (&o)[8]) { const f32x4 a = *(const f32x4*)p, b = *(const f32x4*)(p + 4); o[0] = a.x; o[1] = a.y; o[2] = a.z; o[3] = a.w; o[4] = b.x; o[5] = b.y; o[6] = b.z; o[7] = b.w; }

constexpr int VP = 168;
__device__ __forceinline__ void attn_unit(const Args& a, LAS unsigned char* lds, int unit, int tid, int wave, int lane) {
    const bf16* proj = (const bf16*)(a.ws + WS_PROJ); bf16* mix = (bf16*)(a.ws + WS_MIX);
    const int qb = unit >> 1, kvh = unit & 1, q0 = qb * 32, kbase = q0 - 128, hq = kvh * 8 + wave;
    LAS bf16* VT = (LAS bf16*)lds;
    bar_lds();
    for (int idx = tid; idx < 160 * 8; idx += NTHR) {
        const int key = idx >> 3, d8 = (idx & 7) * 8, tk = kbase + key;
        v4u p = {0u, 0u, 0u, 0u};
        if (tk >= 0) p = ldg16(proj + (size_t)tk * NINP + C_AV + kvh * 64 + d8);
        const unsigned w[4] = {p.x, p.y, p.z, p.w};
#pragma unroll
        for (int j = 0; j < 4; ++j) { VT[(d8 + 2 * j) * VP + key] = (bf16)(w[j] & 0xffffu); VT[(d8 + 2 * j + 1) * VP + key] = (bf16)(w[j] >> 16); }
    }
    bar_lds();
    const int r = lane & 31, h = lane >> 5;
    bf16x8 bq[4];
    { const bf16* qrow = proj + (size_t)(q0 + r) * NINP + C_AQ + hq * 64 + 8 * h;
#pragma unroll
      for (int s = 0; s < 4; ++s) bq[s] = *(const bf16x8*)(qrow + 16 * s); }
    const float slope = exp2f(-0.5f * (float)(hq + 1)), sink = a.in[13][hq];
    f32x16 sc[5]; float mx = sink;
#pragma unroll
    for (int kt = 0; kt < 5; ++kt) {
        const int tkb = kbase + 32 * kt;
        f32x16 acc; for (int i = 0; i < 16; ++i) acc[i] = 0.f;
        if (tkb >= 0) {
            const bf16* krow = proj + (size_t)(tkb + r) * NINP + C_AK + kvh * 64 + 8 * h;
#pragma unroll
            for (int s = 0; s < 4; ++s) acc = MFMA32(*(const bf16x8*)(krow + 16 * s), bq[s], acc);
        }
#pragma unroll
        for (int i = 0; i < 16; ++i) {
            const int key = tkb + (i & 3) + 8 * (i >> 2) + 4 * h, dist = (q0 + r) - key;
            const bool valid = (tkb >= 0) && (dist >= 0) && (dist < 128);
            const float v = valid ? acc[i] * 0.125f - slope * (float)dist : -1e30f;
            sc[kt][i] = v; mx = fmaxf(mx, v);
        }
        __builtin_amdgcn_sched_barrier(0);
    }
    mx = fmaxf(mx, __shfl_xor(mx, 32));
    float sum = 0.f;
#pragma unroll
    for (int kt = 0; kt < 5; ++kt)
#pragma unroll
        for (int i = 0; i < 16; ++i) { const float p = __expf(sc[kt][i] - mx); sc[kt][i] = p; sum += p; }
    sum += __shfl_xor(sum, 32); sum += __expf(sink - mx);
    f32x16 o[2]; for (int i = 0; i < 16; ++i) { o[0][i] = 0.f; o[1][i] = 0.f; }
#pragma unroll
    for (int kt = 0; kt < 5; ++kt) {
        if (kbase + 32 * kt >= 0) {
#pragma unroll
            for (int s = 0; s < 2; ++s) {
                v4u pw; pw.x = pk2(sc[kt][8 * s + 0], sc[kt][8 * s + 1]); pw.y = pk2(sc[kt][8 * s + 2], sc[kt][8 * s + 3]); pw.z = pk2(sc[kt][8 * s + 4], sc[kt][8 * s + 5]); pw.w = pk2(sc[kt][8 * s + 6], sc[kt][8 * s + 7]);
                const bf16x8 pb = __builtin_bit_cast(bf16x8, pw);
#pragma unroll
                for (int dt = 0; dt < 2; ++dt) {
                    const LAS bf16* vp = VT + (32 * dt + r) * VP + 32 * kt + 16 * s + 4 * h;
                    const v2u lo = *(const LAS v2u*)vp, hi = *(const LAS v2u*)(vp + 8);
                    v4u vw; vw.x = lo.x; vw.y = lo.y; vw.z = hi.x; vw.w = hi.y;
                    o[dt] = MFMA32(__builtin_bit_cast(bf16x8, vw), pb, o[dt]);
                }
            }
        }
    }
    const float inv = 1.f / sum;
#pragma unroll
    for (int dt = 0; dt < 2; ++dt)
#pragma unroll
        for (int g4 = 0; g4 < 4; ++g4) {
            const int d0 = 32 * dt + 8 * g4 + 4 * h;
            float g0, g1, g2, g3;
            { const v2u gp = *(const v2u*)(proj + (size_t)(q0 + r) * NINP + C_AG + hq * 64 + d0); g0 = bflo(gp.x); g1 = bfhi(gp.x); g2 = bflo(gp.y); g3 = bfhi(gp.y); }
            v2u w; w.x = pk2(o[dt][4 * g4 + 0] * inv * siluf_(g0), o[dt][4 * g4 + 1] * inv * siluf_(g1));
            w.y = pk2(o[dt][4 * g4 + 2] * inv * siluf_(g2), o[dt][4 * g4 + 3] * inv * siluf_(g3));
            *(v2u*)(mix + (size_t)(q0 + r) * D + RW + hq * 64 + d0) = w;
        }
}

struct Prep { float r[8], kp[8], v[8], g[8], w[8], lw[8], kk[8], b[8], bonus; };
__device__ __forceinline__ void rwkv_prep(const Args& a, LAS unsigned char* lds, int h, int t0, int tid, int wave, int lane, Prep& P) {
    const bf16* proj = (const bf16*)(a.ws + WS_PROJ); const bf16* upt = (const bf16*)(a.ws + WS_UPT); const bf16* aupt = upt + 65536;
    LAS bf16* TW = (LAS bf16*)lds; LAS bf16* ADm = TW + 64 * 72; LAS float* Z = (LAS float*)(lds + 18432); LAS float* AP = Z + 64 * 68;
    const int t = tid >> 3, c8 = (tid & 7) * 8, ch = h * 64 + c8, row = t0 + t;
    const float* mu = a.in[3];
    { float x[8]; load_shift8(proj, row, C_WD + c8, mu, x);
#pragma unroll
      for (int j = 0; j < 8; ++j) x[j] = 1.f - 2.f * __builtin_amdgcn_rcpf(1.f + __expf(2.f * x[j]));
      *(LAS v4u*)(TW + t * 72 + c8) = pack8(x);
      load_shift8(proj, row, C_AD + c8, mu, x); *(LAS v4u*)(ADm + t * 72 + c8) = pack8(x); }
    bar_lds();
    { const int rt = wave & 3, cp = (wave >> 2) * 2, fr = lane & 15, fq = lane >> 4;
      bf16x8 aT[2], aA[2];
#pragma unroll
      for (int s = 0; s < 2; ++s) { aT[s] = *(const LAS bf16x8*)(TW + (16 * rt + fr) * 72 + 32 * s + 8 * fq); aA[s] = *(const LAS bf16x8*)(ADm + (16 * rt + fr) * 72 + 32 * s + 8 * fq); }
#pragma unroll
      for (int ci = 0; ci < 2; ++ci) { const int ct = cp + ci; f32x4 z = {0.f, 0.f, 0.f, 0.f}, ap = {0.f, 0.f, 0.f, 0.f};
#pragma unroll
          for (int s = 0; s < 2; ++s) { const size_t bo = (size_t)(h * 64 + 16 * ct + fr) * 64 + 32 * s + 8 * fq;
              z = MFMA16(aT[s], *(const bf16x8*)(upt + bo), z); ap = MFMA16(aA[s], *(const bf16x8*)(aupt + bo), ap); }
#pragma unroll
          for (int j = 0; j < 4; ++j) { Z[(16 * rt + 4 * fq + j) * 68 + 16 * ct + fr] = z[j]; AP[(16 * rt + 4 * fq + j) * 68 + 16 * ct + fr] = ap[j]; } } }
    bar_lds();
    float zz[8], aa[8], kr[8], c0[8], c1[8];
#pragma unroll
    for (int j = 0; j < 8; ++j) { zz[j] = Z[t * 68 + c8 + j]; aa[j] = AP[t * 68 + c8 + j]; }
    load_shift8(proj, row, C_R + ch, mu, P.r); load_shift8(proj, row, C_K + ch, mu, kr); load_shift8(proj, row, C_V + ch, mu, P.v); load_shift8(proj, row, C_G + ch, mu, P.g);
    ld8f(a.in[4] + ch, c0); ld8f(a.in[6] + ch, c1);
#pragma unroll
    for (int j = 0; j < 8; ++j) { const float z = c0[j] + zz[j]; const float sp = (z < -15.f) ? -z : __logf(1.f + __expf(-z)); const float wl = -sp - 0.5f; P.lw[j] = -__expf(wl); P.w[j] = __expf(P.lw[j]); aa[j] = sigmoidf_(c1[j] + aa[j]); }
    ld8f(a.in[8] + ch, c0); ld8f(a.in[9] + ch, c1);
    float ss = 0.f;
#pragma unroll
    for (int j = 0; j < 8; ++j) { P.kk[j] = kr[j] * c0[j]; ss += P.kk[j] * P.kk[j]; P.kp[j] = kr[j] * (1.f + (aa[j] - 1.f) * c1[j]); }
    ss = sum8(ss); const float rn = 1.f / fmaxf(sqrtf(ss), 1e-12f);
    ld8f(a.in[10] + ch, c0);
    float bs = 0.f;
#pragma unroll
    for (int j = 0; j < 8; ++j) { P.kk[j] *= rn; P.b[j] = P.kk[j] * aa[j]; bs += P.r[j] * P.kp[j] * c0[j]; }
    P.bonus = sum8(bs);
}
__device__ __forceinline__ void rwkv_out8(const Args& a, const float (&y)[8], const float (&v)[8], const float (&g)[8], float bonus, int row, int ch) {
    bf16* mix = (bf16*)(a.ws + WS_MIX);
    float s = 0.f;
#pragma unroll
    for (int j = 0; j < 8; ++j) s += y[j];
    const float mean = sum8(s) * (1.f / 64.f); float q = 0.f;
#pragma unroll
    for (int j = 0; j < 8; ++j) { const float d = y[j] - mean; q += d * d; }
    const float rstd = 1.f / sqrtf(sum8(q) * (1.f / 64.f) + LNX_EPS);
    float lg[8], lb[8], o[8]; ld8f(a.in[11] + ch, lg); ld8f(a.in[12] + ch, lb);
#pragma unroll
    for (int j = 0; j < 8; ++j) { const float yn = (y[j] - mean) * rstd * lg[j] + lb[j] + bonus * v[j]; o[j] = yn * siluf_(g[j]); }
    *(v4u*)(mix + (size_t)row * D + ch) = pack8(o);
}
constexpr size_t WS_MF = 174 * MiB, WS_QF = 190 * MiB, WS_SF = 206 * MiB, WS_BON = 222 * MiB;
constexpr size_t OUT_NF = 0, OUT_Y2 = 32 * MiB;
constexpr int MP = 72;
constexpr int L_AT = 0, L_ATT = 9216, L_BT = 18432, L_KT = 27648, L_RT = 36864, L_BHT = 46080, L_KHT = 55296, L_VT = 64512, L_LW = 73728, L_P = 73728, L_PT = 82944,
              L_AAK = 92160, L_ARB = 101376, L_ARK = 110592, L_TM = 119808, L_SEG = 119808, L_GC = 129024, L_WT = L_AT, L_X1T = L_BT, L_U2T = L_KT;
struct WTile { int ta, tb0, fr, fq; };
__device__ __forceinline__ bf16x8 ldfrag(const LAS bf16* M, int tile, int s, const WTile& w) { return *(const LAS bf16x8*)(M + (16 * tile + w.fr) * MP + 32 * s + 8 * w.fq); }
__device__ __forceinline__ void mm2(const LAS bf16* A, const LAS bf16* B, const WTile& w, f32x4 (&acc)[2]) {
#pragma unroll
    for (int s = 0; s < 2; ++s) { const bf16x8 af = ldfrag(A, w.ta, s, w);
#pragma unroll
        for (int ci = 0; ci < 2; ++ci) acc[ci] = MFMA16(af, ldfrag(B, w.tb0 + ci, s, w), acc[ci]); }
}
__device__ __forceinline__ void st_T(LAS bf16* X, int ta, int tb, const WTile& w, const f32x4& v) { v2u o; o.x = pk2(v[0], v[1]); o.y = pk2(v[2], v[3]); *(LAS v2u*)(X + (16 * tb + w.fr) * MP + 16 * ta + 4 * w.fq) = o; }
__device__ __forceinline__ void st_N(LAS bf16* X, int ta, int tb, const WTile& w, const f32x4& v) {
    const unsigned a = pk2(v[0], v[1]), b = pk2(v[2], v[3]); LAS bf16* p = X + (16 * ta + 4 * w.fq) * MP + 16 * tb + w.fr;
    p[0] = (bf16)(a & 0xffffu); p[MP] = (bf16)(a >> 16); p[2 * MP] = (bf16)(b & 0xffffu); p[3 * MP] = (bf16)(b >> 16);
}
#define ZERO2(x) do { x[0] = (f32x4){0.f, 0.f, 0.f, 0.f}; x[1] = (f32x4){0.f, 0.f, 0.f, 0.f}; } while (0)
template <int MODE> __device__ __forceinline__ void mask2(f32x4 (&acc)[2], const WTile& w) {
#pragma unroll
    for (int ci = 0; ci < 2; ++ci)
#pragma unroll
        for (int j = 0; j < 4; ++j) { const int row = 16 * w.ta + 4 * w.fq + j, col = 16 * (w.tb0 + ci) + w.fr;
            const bool keep = MODE == 0 ? (row < col) : (MODE == 1 ? (row <= col) : (col < row)); if (!keep) acc[ci][j] = 0.f; }
}
__device__ __forceinline__ void st_bf16x8_T(LAS bf16* X, int c8, int t, const float (&v)[8]) {
    const v4u p = pack8(v); const unsigned w[4] = {p.x, p.y, p.z, p.w};
#pragma unroll
    for (int j = 0; j < 4; ++j) { X[(c8 + 2 * j) * MP + t] = (bf16)(w[j] & 0xffffu); X[(c8 + 2 * j + 1) * MP + t] = (bf16)(w[j] >> 16); }
}

__device__ __forceinline__ void rwkv_chunk_prep(const Args& a, LAS unsigned char* lds, int unit, int tid, int wave, int lane) {
    const int c = unit >> 4, h = unit & 15, t0 = c * CH, t = tid >> 3, c8 = (tid & 7) * 8;
    LAS bf16* At = (LAS bf16*)(lds + L_AT); LAS bf16* AtT = (LAS bf16*)(lds + L_ATT); LAS bf16* Bt = (LAS bf16*)(lds + L_BT); LAS bf16* Kt = (LAS bf16*)(lds + L_KT);
    LAS bf16* Rt = (LAS bf16*)(lds + L_RT); LAS bf16* BhT = (LAS bf16*)(lds + L_BHT); LAS bf16* KhT = (LAS bf16*)(lds + L_KHT); LAS bf16* VT = (LAS bf16*)(lds + L_VT);
    LAS float* LW = (LAS float*)(lds + L_LW); LAS bf16* Pm = (LAS bf16*)(lds + L_P); LAS bf16* PT = (LAS bf16*)(lds + L_PT);
    LAS bf16* AAK = (LAS bf16*)(lds + L_AAK); LAS bf16* ARB = (LAS bf16*)(lds + L_ARB); LAS bf16* ARK = (LAS bf16*)(lds + L_ARK); LAS bf16* TM = (LAS bf16*)(lds + L_TM);
    LAS float* SEG = (LAS float*)(lds + L_SEG); LAS float* GC = (LAS float*)(lds + L_GC);
    LAS bf16* WT = (LAS bf16*)(lds + L_WT); LAS bf16* X1T = (LAS bf16*)(lds + L_X1T); LAS bf16* U2T = (LAS bf16*)(lds + L_U2T);
    bar_lds();
    Prep P; rwkv_prep(a, lds, h, t0, tid, wave, lane, P);
#ifdef PROBE_PREP2
    bar_lds(); rwkv_prep(a, lds, h, t0, tid, wave, lane, P);
#endif
    if ((tid & 7) == 0) ((float*)(a.ws + WS_BON))[(size_t)(t0 + t) * 16 + h] = P.bonus;
#pragma unroll
    for (int j = 0; j < 8; ++j) LW[t * 68 + c8 + j] = P.lw[j];
    bar_lds();
    { const int cc = tid & 63, sg = tid >> 6; float run = 0.f;
#pragma unroll
      for (int i = 0; i < 8; ++i) { run += LW[(8 * sg + i) * 68 + cc]; LW[(8 * sg + i) * 68 + cc] = run; }
      SEG[sg * 64 + cc] = run; }
    bar_lds();
    {
        float Lt[8], LC[8];
#pragma unroll
        for (int j = 0; j < 8; ++j) { float off = 0.f, tot = 0.f;
#pragma unroll
            for (int s = 0; s < 8; ++s) { const float sv = SEG[s * 64 + c8 + j]; tot += sv; if (s < (t >> 3)) off += sv; }
            Lt[j] = LW[t * 68 + c8 + j] + off; LC[j] = tot; }
        if (t == 0) {
#pragma unroll
            for (int j = 0; j < 8; ++j) GC[c8 + j] = __expf(LC[j]); }
        float x[8], y[8];
#pragma unroll
        for (int j = 0; j < 8; ++j) x[j] = -P.kk[j] * __expf(Lt[j] - P.lw[j]);
        *(LAS v4u*)(At + t * MP + c8) = pack8(x); st_bf16x8_T(AtT, c8, t, x);
#pragma unroll
        for (int j = 0; j < 8; ++j) { const float e = __expf(-Lt[j]); x[j] = P.b[j] * e; y[j] = P.kp[j] * e; }
        *(LAS v4u*)(Bt + t * MP + c8) = pack8(x); *(LAS v4u*)(Kt + t * MP + c8) = pack8(y);
#pragma unroll
        for (int j = 0; j < 8; ++j) x[j] = P.r[j] * __expf(Lt[j]);
        *(LAS v4u*)(Rt + t * MP + c8) = pack8(x);
#pragma unroll
        for (int j = 0; j < 8; ++j) { const float e = __expf(LC[j] - Lt[j]); x[j] = P.b[j] * e; y[j] = P.kp[j] * e; }
        st_bf16x8_T(BhT, c8, t, x); st_bf16x8_T(KhT, c8, t, y); st_bf16x8_T(VT, c8, t, P.v);
    }
    bar_lds();
    WTile w; w.ta = wave & 3; w.tb0 = (wave >> 2) * 2; w.fr = lane & 15; w.fq = lane >> 4;
    f32x4 acc[2], Tacc[2];
    ZERO2(Tacc); mm2(At, Bt, w, Tacc); mask2<2>(Tacc, w);
    ZERO2(acc); mm2(Kt, At, w, acc); mask2<0>(acc, w);
    f32x4 rb[2], rk[2]; ZERO2(rb); mm2(Bt, Rt, w, rb); mask2<1>(rb, w); ZERO2(rk); mm2(Kt, Rt, w, rk); mask2<1>(rk, w);
    bar_lds();
#pragma unroll
    for (int ci = 0; ci < 2; ++ci) { st_N(Pm, w.ta, w.tb0 + ci, w, Tacc[ci]); st_T(PT, w.ta, w.tb0 + ci, w, Tacc[ci]);
        st_T(AAK, w.ta, w.tb0 + ci, w, acc[ci]); st_T(ARB, w.ta, w.tb0 + ci, w, rb[ci]); st_T(ARK, w.ta, w.tb0 + ci, w, rk[ci]);
#pragma unroll
        for (int j = 0; j < 4; ++j) if (16 * w.ta + 4 * w.fq + j == 16 * (w.tb0 + ci) + w.fr) Tacc[ci][j] += 1.f;
        st_N(TM, w.ta, w.tb0 + ci, w, Tacc[ci]); }
    bar_lds();
#pragma unroll 1
#ifdef PROBE_NEU2
    for (int n = 0; n < 10; ++n) {
#else
    for (int n = 0; n < 5; ++n) {
#endif
        ZERO2(acc); mm2(Pm, PT, w, acc);
        bar_lds();
#pragma unroll
        for (int ci = 0; ci < 2; ++ci) { st_N(Pm, w.ta, w.tb0 + ci, w, acc[ci]); st_T(PT, w.ta, w.tb0 + ci, w, acc[ci]); }
        bar_lds();
        mm2(TM, PT, w, Tacc);
        bar_lds();
#pragma unroll
        for (int ci = 0; ci < 2; ++ci) st_N(TM, w.ta, w.tb0 + ci, w, Tacc[ci]);
        bar_lds();
    }
    ZERO2(acc); mm2(TM, AtT, w, acc); ZERO2(rb); mm2(AAK, VT, w, rb);
#pragma unroll
    for (int ci = 0; ci < 2; ++ci) { st_T(WT, w.ta, w.tb0 + ci, w, acc[ci]); st_T(X1T, w.ta, w.tb0 + ci, w, rb[ci]); }
    bar_lds();
    const size_t ub = (size_t)unit * 4096;
    { ZERO2(acc); mm2(TM, X1T, w, acc);
#pragma unroll
      for (int ci = 0; ci < 2; ++ci) st_T(U2T, w.ta, w.tb0 + ci, w, acc[ci]);
      bf16* MF = (bf16*)(a.ws + WS_MF) + ub; bf16* QF = (bf16*)(a.ws + WS_QF) + ub;
      ZERO2(acc); mm2(WT, BhT, w, acc);
      ZERO2(rb); mm2(WT, ARB, w, rb);
#pragma unroll
      for (int ci = 0; ci < 2; ++ci) { const int tb = w.tb0 + ci; const int col = 16 * tb + w.fr; const float gc = GC[col];
          f32x4 m = acc[ci];
#pragma unroll
          for (int j = 0; j < 4; ++j) if (16 * w.ta + 4 * w.fq + j == col) m[j] += gc;
          const size_t fo = (size_t)((tb * 2 + (w.ta >> 1)) * 64 + lane) * 8 + 4 * (w.ta & 1);
          v2u o; o.x = pk2(m[0], m[1]); o.y = pk2(m[2], m[3]); *(v2u*)(MF + fo) = o;
          const v2u rr = *(const LAS v2u*)(Rt + col * MP + 16 * w.ta + 4 * w.fq);
          f32x4 q = rb[ci]; q[0] += bflo(rr.x); q[1] += bfhi(rr.x); q[2] += bflo(rr.y); q[3] += bfhi(rr.y);
          o.x = pk2(q[0], q[1]); o.y = pk2(q[2], q[3]); *(v2u*)(QF + fo) = o; } }
    bar_lds();
    { float* NF = (float*)((unsigned char*)a.out + OUT_NF) + ub; float* Y2 = (float*)((unsigned char*)a.out + OUT_Y2) + ub;
      ZERO2(acc); mm2(BhT, U2T, w, acc); mm2(KhT, VT, w, acc);
      ZERO2(rb); mm2(U2T, ARB, w, rb); mm2(VT, ARK, w, rb);
#pragma unroll
      for (int ci = 0; ci < 2; ++ci) { const int tb = w.tb0 + ci;
          *(f32x4*)(NF + (size_t)((tb * 4 + w.ta) * 64 + lane) * 4) = acc[ci];
          *(f32x4*)(Y2 + (size_t)(16 * tb + w.fr) * 64 + 16 * w.ta + 4 * w.fq) = rb[ci]; } }
}

constexpr int KR = 4, NR = NCH / KR, SLOT = 10240, RBUF = KR * SLOT, NPIECE = RBUF / 16, LPT = 6, PPC = SLOT / 16;
__device__ __forceinline__ const v4u* sp_src(const Args& a, int h, int cg, int r, int p) {
    const int cc = p / PPC, q = p % PPC, c = r * KR + cc; const size_t ub = (size_t)(c * 16 + h) * 4096;
    return q < 512 ? (const v4u*)((const bf16*)(a.ws + WS_MF) + ub) + q : (const v4u*)((const bf16*)((const unsigned char*)a.out + OUT_NF) + ub + cg * 1024) + (q - 512);
}
__device__ __forceinline__ void state_pass(const Args& a, LAS unsigned char* lds, int b, int tid, int wave, int lane) {
    const int h = b >> 2, cg = b & 3, lt = tid - 64;
    v4u ra[LPT], rb[LPT];
    if (wave != 0) {
#pragma unroll
        for (int i = 0; i < LPT; ++i) { const int p = lt + 448 * i; if (p < NPIECE) ra[i] = *sp_src(a, h, cg, 0, p); }
#pragma unroll
        for (int i = 0; i < LPT; ++i) { const int p = lt + 448 * i; if (p < NPIECE) *(LAS v4u*)(lds + p * 16) = ra[i]; }
#pragma unroll
        for (int i = 0; i < LPT; ++i) { const int p = lt + 448 * i; if (p < NPIECE) ra[i] = *sp_src(a, h, cg, 1, p); }
    }
    f32x4 st[4];
#pragma unroll
    for (int i = 0; i < 4; ++i) st[i] = (f32x4){0.f, 0.f, 0.f, 0.f};
    bar_lds();
    bf16* SF = (bf16*)(a.ws + WS_SF);
#define SP_ROUND(r_, RA, RB) do { \
        if (wave != 0) { \
            if ((r_) + 2 < NR) { _Pragma("unroll") for (int i = 0; i < LPT; ++i) { const int p = lt + 448 * i; if (p < NPIECE) RB[i] = *sp_src(a, h, cg, (r_) + 2, p); } } \
            if ((r_) + 1 < NR) { _Pragma("unroll") for (int i = 0; i < LPT; ++i) { const int p = lt + 448 * i; if (p < NPIECE) *(LAS v4u*)(lds + (((r_) + 1) & 1) * RBUF + p * 16) = RA[i]; } } \
        } else { \
            _Pragma("unroll") for (int cc = 0; cc < KR; ++cc) { \
                const LAS unsigned char* sl = lds + ((r_) & 1) * RBUF + cc * SLOT; const int c = (r_) * KR + cc; \
                v4u b0, b1; b0.x = pk2(st[0][0], st[0][1]); b0.y = pk2(st[0][2], st[0][3]); b0.z = pk2(st[1][0], st[1][1]); b0.w = pk2(st[1][2], st[1][3]); \
                b1.x = pk2(st[2][0], st[2][1]); b1.y = pk2(st[2][2], st[2][3]); b1.z = pk2(st[3][0], st[3][1]); b1.w = pk2(st[3][2], st[3][3]); \
                v4u* sfo = (v4u*)(SF + (size_t)(c * 16 + h) * 4096) + (cg * 2) * 64 + lane; sfo[0] = b0; sfo[64] = b1; \
                const bf16x8 f0 = __builtin_bit_cast(bf16x8, b0), f1 = __builtin_bit_cast(bf16x8, b1); \
                _Pragma("unroll") for (int rt = 0; rt < 4; ++rt) { \
                    const v2u nb_ = *(const LAS v2u*)(sl + 8192 + (rt * 64 + lane) * 8); f32x4 n = {bflo(nb_.x), bfhi(nb_.x), bflo(nb_.y), bfhi(nb_.y)}; \
                    n = MFMA16(*(const LAS bf16x8*)(sl + ((rt * 2 + 0) * 64 + lane) * 16), f0, n); \
                    n = MFMA16(*(const LAS bf16x8*)(sl + ((rt * 2 + 1) * 64 + lane) * 16), f1, n); st[rt] = n; } \
            } \
        } \
        bar_lds(); } while (0)
#pragma unroll 1
    for (int r = 0; r < NR; r += 2) { SP_ROUND(r, ra, rb); SP_ROUND(r + 1, rb, ra); }
#undef SP_ROUND
}

__device__ __forceinline__ void rwkv_out_unit(const Args& a, LAS unsigned char* lds, int unit, int tid, int wave, int lane) {
    const int c = unit >> 4, h = unit & 15, t0 = c * CH, t = tid >> 3, c8 = (tid & 7) * 8, ch = h * 64 + c8;
    const size_t ub = (size_t)unit * 4096;
    const bf16* QF = (const bf16*)(a.ws + WS_QF) + ub; const bf16* SF = (const bf16*)(a.ws + WS_SF) + ub; const bf16* Y2 = (const bf16*)((const unsigned char*)a.out + OUT_Y2) + ub;
    LAS float* SY = (LAS float*)lds;
    const int ta = wave & 3, tb0 = (wave >> 2) * 2, fr = lane & 15, fq = lane >> 4;
    bf16x8 af[2], bfr[2][2];
#pragma unroll
    for (int s = 0; s < 2; ++s) { af[s] = *(const bf16x8*)(QF + (size_t)((ta * 2 + s) * 64 + lane) * 8);
#pragma unroll
        for (int ci = 0; ci < 2; ++ci) bfr[s][ci] = *(const bf16x8*)(SF + (size_t)(((tb0 + ci) * 2 + s) * 64 + lane) * 8); }
    float y2[8], v[8], g[8];
    unpack8(ldg16(Y2 + t * 64 + c8), y2);
    const bf16* proj = (const bf16*)(a.ws + WS_PROJ);
    load_shift8(proj, t0 + t, C_V + ch, a.in[3], v); load_shift8(proj, t0 + t, C_G + ch, a.in[3], g);
    const float bonus = ((const float*)(a.ws + WS_BON))[(size_t)(t0 + t) * 16 + h];
    f32x4 acc[2]; ZERO2(acc);
#pragma unroll
    for (int s = 0; s < 2; ++s)
#pragma unroll
        for (int ci = 0; ci < 2; ++ci) acc[ci] = MFMA16(af[s], bfr[s][ci], acc[ci]);
    bar_lds();
#pragma unroll
    for (int ci = 0; ci < 2; ++ci)
#pragma unroll
        for (int j = 0; j < 4; ++j) SY[(16 * ta + 4 * fq + j) * 68 + 16 * (tb0 + ci) + fr] = acc[ci][j];
    bar_lds();
    float y[8];
#pragma unroll
    for (int j = 0; j < 8; ++j) y[j] = SY[t * 68 + c8 + j] + y2[j];
    rwkv_out8(a, y, v, g, bonus, t0 + t, ch);
}
constexpr int L2_SEG = 129280, L2_XST = 131328, L2_TW = 131584, L2_ADM = 140800, L2_X1T = 150016;
struct PF { v4u p[4], q[4]; };
__device__ __forceinline__ void pf_issue(PF& f, const bf16* proj, int row, int ch) {
    const int cols[4] = {C_R, C_K, C_V, C_G};
#pragma unroll
    for (int i = 0; i < 4; ++i) { f.p[i] = ldg16(proj + (size_t)row * NINP + cols[i] + ch); f.q[i] = (v4u){0u, 0u, 0u, 0u}; if (row > 0) f.q[i] = ldg16(proj + (size_t)(row - 1) * NINP + cols[i] + ch); }
}
__device__ __forceinline__ void pf_shift(const v4u& p, const v4u& q, const float (&mf)[8], float (&o)[8]) {
    float pf[8], qf[8]; unpack8(p, pf); unpack8(q, qf);
#pragma unroll
    for (int j = 0; j < 8; ++j) o[j] = pf[j] + (qf[j] - pf[j]) * mf[j];
}
template <bool DOP, bool DOT> __device__ __forceinline__ void neu_stage(const LAS bf16* Pin, const LAS bf16* PTin, LAS bf16* Pout, LAS bf16* PTout, const LAS bf16* TMin, LAS bf16* TMout, const WTile& w, f32x4 (&Tacc)[2]) {
    f32x4 acc[2];
    if (DOP) { ZERO2(acc); mm2(Pin, PTin, w, acc); }
    if (DOT) mm2(TMin, PTin, w, Tacc);
#pragma unroll
    for (int ci = 0; ci < 2; ++ci) {
        if (DOP) { st_N(Pout, w.ta, w.tb0 + ci, w, acc[ci]); st_T(PTout, w.ta, w.tb0 + ci, w, acc[ci]); }
        if (DOT) st_N(TMout, w.ta, w.tb0 + ci, w, Tacc[ci]);
    }
    bar_lds();
}
__device__ __forceinline__ void rwkv_chunk_group(const Args& a, LAS unsigned char* lds, int item, int tid, int wave, int lane) {
    const int c = item >> 1, hg = item & 1, t0 = c * CH, t = tid >> 3, c8 = (tid & 7) * 8, row = t0 + t;
    const bf16* proj = (const bf16*)(a.ws + WS_PROJ); const bf16* upt = (const bf16*)(a.ws + WS_UPT); const bf16* aupt = upt + 65536; const float* mu = a.in[3];
    LAS bf16* TW = (LAS bf16*)(lds + L2_TW); LAS bf16* ADm = (LAS bf16*)(lds + L2_ADM);
    WTile w; w.ta = wave & 3; w.tb0 = (wave >> 2) * 2; w.fr = lane & 15; w.fq = lane >> 4;
    bar_lds();
    { float x[8]; load_shift8(proj, row, C_WD + c8, mu, x);
#pragma unroll
      for (int j = 0; j < 8; ++j) x[j] = 1.f - 2.f * __builtin_amdgcn_rcpf(1.f + __expf(2.f * x[j]));
      *(LAS v4u*)(TW + t * 72 + c8) = pack8(x);
      load_shift8(proj, row, C_AD + c8, mu, x); *(LAS v4u*)(ADm + t * 72 + c8) = pack8(x); }
    PF pf; pf_issue(pf, proj, row, hg * 512 + c8);
#pragma unroll 1
    for (int hh = 0; hh < 8; ++hh) {
        const int h = hg * 8 + hh, ch = h * 64 + c8, unit = c * 16 + h;
        LAS unsigned char* L = lds; asm volatile("" : "+v"(L));
        LAS bf16* At = (LAS bf16*)(L + L_AT); LAS bf16* AtT = (LAS bf16*)(L + L_ATT); LAS bf16* Bt = (LAS bf16*)(L + L_BT); LAS bf16* Kt = (LAS bf16*)(L + L_KT);
        LAS bf16* Rt = (LAS bf16*)(L + L_RT); LAS bf16* BhT = (LAS bf16*)(L + L_BHT); LAS bf16* KhT = (LAS bf16*)(L + L_KHT); LAS bf16* VT = (LAS bf16*)(L + L_VT);
        LAS bf16* P0 = (LAS bf16*)(L + L_P); LAS bf16* PT0 = (LAS bf16*)(L + L_PT); LAS bf16* TM0 = (LAS bf16*)(L + L_TM);
        LAS bf16* P1 = At; LAS bf16* PT1 = Bt; LAS bf16* TM1 = Kt;
        LAS bf16* AAK = (LAS bf16*)(L + L_AAK); LAS bf16* ARB = (LAS bf16*)(L + L_ARB); LAS bf16* ARK = (LAS bf16*)(L + L_ARK);
        LAS float* SEG = (LAS float*)(L + L2_SEG); LAS float* GC = (LAS float*)(L + L_GC);
        LAS bf16* X1T = (LAS bf16*)(L + L2_X1T);
        LAS float* Z = (LAS float*)(L + 18432); LAS float* AP = Z + 64 * 68;
        LAS bf16* WT = At; LAS bf16* U2T = Bt;
        float pw0[8], pa0[8], pkk[8], pka[8], prk[8], mur[8], muk[8], muv[8];
        ld8f(a.in[4] + ch, pw0); ld8f(a.in[6] + ch, pa0); ld8f(a.in[8] + ch, pkk); ld8f(a.in[9] + ch, pka); ld8f(a.in[10] + ch, prk);
        ld8f(mu + C_R + ch, mur); ld8f(mu + C_K + ch, muk); ld8f(mu + C_V + ch, muv);
        bar_lds();
#ifdef PROBE_G
        if (blockIdx.x == 0 && tid == 0 && hh == 3) ((unsigned long long*)(a.ws + 65536))[0] = __builtin_amdgcn_s_memrealtime();
#endif

        { const int rt = w.ta, cp = w.tb0, fr = w.fr, fq = w.fq;
          bf16x8 aT[2], aA[2];
#pragma unroll
          for (int s = 0; s < 2; ++s) { aT[s] = *(const LAS bf16x8*)(TW + (16 * rt + fr) * 72 + 32 * s + 8 * fq); aA[s] = *(const LAS bf16x8*)(ADm + (16 * rt + fr) * 72 + 32 * s + 8 * fq); }
#pragma unroll
          for (int ci = 0; ci < 2; ++ci) { const int ct = cp + ci; f32x4 z = {0.f, 0.f, 0.f, 0.f}, ap = {0.f, 0.f, 0.f, 0.f};
#pragma unroll
              for (int s = 0; s < 2; ++s) { const size_t bo = (size_t)(h * 64 + 16 * ct + fr) * 64 + 32 * s + 8 * fq;
                  z = MFMA16(aT[s], *(const bf16x8*)(upt + bo), z); ap = MFMA16(aA[s], *(const bf16x8*)(aupt + bo), ap); }
#pragma unroll
              for (int j = 0; j < 4; ++j) { Z[(16 * rt + 4 * fq + j) * 68 + 16 * ct + fr] = z[j]; AP[(16 * rt + 4 * fq + j) * 68 + 16 * ct + fr] = ap[j]; } } }
        bar_lds();
#ifdef PROBE_G
        if (blockIdx.x == 0 && tid == 0 && hh == 3) ((unsigned long long*)(a.ws + 65536))[1] = __builtin_amdgcn_s_memrealtime();
#endif
        float r[8], kp[8], vv[8], lw[8], wd[8], kk[8], bb[8];
        { float zz[8], aa[8], kr[8];
#pragma unroll
          for (int j = 0; j < 8; ++j) { zz[j] = Z[t * 68 + c8 + j]; aa[j] = AP[t * 68 + c8 + j]; }
          pf_shift(pf.p[0], pf.q[0], mur, r); pf_shift(pf.p[1], pf.q[1], muk, kr); pf_shift(pf.p[2], pf.q[2], muv, vv);
#pragma unroll
          for (int j = 0; j < 8; ++j) { const float z = pw0[j] + zz[j]; const float sp = (z < -15.f) ? -z : __logf(1.f + __expf(-z)); lw[j] = -__expf(-sp - 0.5f); wd[j] = __expf(lw[j]); aa[j] = sigmoidf_(pa0[j] + aa[j]); }
          float ss = 0.f;
#pragma unroll
          for (int j = 0; j < 8; ++j) { kk[j] = kr[j] * pkk[j]; ss += kk[j] * kk[j]; kp[j] = kr[j] * (1.f + (aa[j] - 1.f) * pka[j]); }
          ss = sum8(ss); const float rn = 1.f / fmaxf(sqrtf(ss), 1e-12f);
          float bs = 0.f;
#pragma unroll
          for (int j = 0; j < 8; ++j) { kk[j] *= rn; bb[j] = kk[j] * aa[j]; bs += r[j] * kp[j] * prk[j]; }
          bs = sum8(bs);
          if ((tid & 7) == 0) ((float*)(a.ws + WS_BON))[(size_t)row * 16 + h] = bs; }
        if (hh < 7) pf_issue(pf, proj, row, ch + 64);
        float Lt[8];
#pragma unroll
        for (int j = 0; j < 8; ++j) { float x = lw[j];
#pragma unroll
            for (int d = 8; d < 64; d <<= 1) { const float y = __shfl_up(x, d); if (lane >= d) x += y; }
            Lt[j] = x; }
        if ((lane >> 3) == 7) {
#pragma unroll
            for (int j = 0; j < 8; ++j) SEG[wave * 64 + c8 + j] = Lt[j]; }
        bar_lds();
        {
            float gc[8], x[8], y[8];
            { float off[8], tot[8];
#pragma unroll
              for (int j = 0; j < 8; ++j) { off[j] = 0.f; tot[j] = 0.f; }
#pragma unroll
              for (int s = 0; s < 8; ++s) { const f32x4 s0 = *(const LAS f32x4*)(SEG + s * 64 + c8), s1 = *(const LAS f32x4*)(SEG + s * 64 + c8 + 4);
                  const float sv[8] = {s0.x, s0.y, s0.z, s0.w, s1.x, s1.y, s1.z, s1.w};
#pragma unroll
                  for (int j = 0; j < 8; ++j) { tot[j] += sv[j]; if (s < wave) off[j] += sv[j]; } }
#pragma unroll
              for (int j = 0; j < 8; ++j) { Lt[j] += off[j]; gc[j] = __expf(tot[j]); } }
            if (t == 0) {
#pragma unroll
                for (int j = 0; j < 8; ++j) GC[c8 + j] = gc[j]; }
            float e1[8], ie1[8];
#pragma unroll
            for (int j = 0; j < 8; ++j) { e1[j] = __expf(Lt[j]); ie1[j] = __builtin_amdgcn_rcpf(e1[j]); }
#pragma unroll
            for (int j = 0; j < 8; ++j) x[j] = -kk[j] * e1[j] * __builtin_amdgcn_rcpf(wd[j]);
            *(LAS v4u*)(At + t * MP + c8) = pack8(x); st_bf16x8_T(AtT, c8, t, x);
#pragma unroll
            for (int j = 0; j < 8; ++j) { x[j] = bb[j] * ie1[j]; y[j] = kp[j] * ie1[j]; }
            *(LAS v4u*)(Bt + t * MP + c8) = pack8(x); *(LAS v4u*)(Kt + t * MP + c8) = pack8(y);
#pragma unroll
            for (int j = 0; j < 8; ++j) x[j] = r[j] * e1[j];
            *(LAS v4u*)(Rt + t * MP + c8) = pack8(x);
#pragma unroll
            for (int j = 0; j < 8; ++j) { const float e = gc[j] * ie1[j]; x[j] = bb[j] * e; y[j] = kp[j] * e; }
            st_bf16x8_T(BhT, c8, t, x); st_bf16x8_T(KhT, c8, t, y); st_bf16x8_T(VT, c8, t, vv);
        }
        bar_lds();
#ifdef PROBE_G
        if (blockIdx.x == 0 && tid == 0 && hh == 3) ((unsigned long long*)(a.ws + 65536))[2] = __builtin_amdgcn_s_memrealtime();
#endif
        f32x4 acc[2], Tacc[2], rb[2], rk[2];
        ZERO2(Tacc); mm2(At, Bt, w, Tacc); mask2<2>(Tacc, w);
        ZERO2(acc); mm2(Kt, At, w, acc); mask2<0>(acc, w);
        ZERO2(rb); mm2(Bt, Rt, w, rb); mask2<1>(rb, w); ZERO2(rk); mm2(Kt, Rt, w, rk); mask2<1>(rk, w);
        bar_lds();
#pragma unroll
        for (int ci = 0; ci < 2; ++ci) { st_N(P1, w.ta, w.tb0 + ci, w, Tacc[ci]); st_T(PT1, w.ta, w.tb0 + ci, w, Tacc[ci]);
            st_T(AAK, w.ta, w.tb0 + ci, w, acc[ci]); st_T(ARB, w.ta, w.tb0 + ci, w, rb[ci]); st_T(ARK, w.ta, w.tb0 + ci, w, rk[ci]);
#pragma unroll
            for (int j = 0; j < 4; ++j) if (16 * w.ta + 4 * w.fq + j == 16 * (w.tb0 + ci) + w.fr) Tacc[ci][j] += 1.f;
            st_N(TM1, w.ta, w.tb0 + ci, w, Tacc[ci]); }
        bar_lds();
#ifdef PROBE_G
        if (blockIdx.x == 0 && tid == 0 && hh == 3) ((unsigned long long*)(a.ws + 65536))[3] = __builtin_amdgcn_s_memrealtime();
#endif
        { ZERO2(acc); mm2(AAK, VT, w, acc);
#pragma unroll
          for (int ci = 0; ci < 2; ++ci) st_T(X1T, w.ta, w.tb0 + ci, w, acc[ci]); }
        neu_stage<true, false>(P1, PT1, P0, PT0, nullptr, nullptr, w, Tacc);
#pragma unroll 1
        for (int n = 0; n < 2; ++n) {
            neu_stage<true, true>(P0, PT0, P1, PT1, TM1, TM0, w, Tacc);
            neu_stage<true, true>(P1, PT1, P0, PT0, TM0, TM1, w, Tacc);
        }
        neu_stage<false, true>(P0, PT0, nullptr, nullptr, TM1, TM0, w, Tacc);

#ifdef PROBE_G
        if (blockIdx.x == 0 && tid == 0 && hh == 3) ((unsigned long long*)(a.ws + 65536))[4] = __builtin_amdgcn_s_memrealtime();
#endif
        ZERO2(acc); mm2(TM0, AtT, w, acc); ZERO2(rb); mm2(TM0, X1T, w, rb);
#pragma unroll
        for (int ci = 0; ci < 2; ++ci) { st_T(WT, w.ta, w.tb0 + ci, w, acc[ci]); st_T(U2T, w.ta, w.tb0 + ci, w, rb[ci]); }
        bar_lds();
        const size_t ub = (size_t)unit * 4096;
        { bf16* MF = (bf16*)(a.ws + WS_MF) + ub; bf16* QF = (bf16*)(a.ws + WS_QF) + ub;
          ZERO2(acc); mm2(WT, BhT, w, acc); ZERO2(rb); mm2(WT, ARB, w, rb);
#pragma unroll
          for (int ci = 0; ci < 2; ++ci) { const int tb = w.tb0 + ci; const int col = 16 * tb + w.fr; const float gcv = GC[col];
              f32x4 m = acc[ci];
#pragma unroll
              for (int j = 0; j < 4; ++j) if (16 * w.ta + 4 * w.fq + j == col) m[j] += gcv;
              const size_t fo = (size_t)((tb * 2 + (w.ta >> 1)) * 64 + lane) * 8 + 4 * (w.ta & 1);
              v2u o; o.x = pk2(m[0], m[1]); o.y = pk2(m[2], m[3]); *(v2u*)(MF + fo) = o;
              const v2u rr = *(const LAS v2u*)(Rt + col * MP + 16 * w.ta + 4 * w.fq);
              f32x4 q = rb[ci]; q[0] += bflo(rr.x); q[1] += bfhi(rr.x); q[2] += bflo(rr.y); q[3] += bfhi(rr.y);
              o.x = pk2(q[0], q[1]); o.y = pk2(q[2], q[3]); *(v2u*)(QF + fo) = o; }
          bf16* NF = (bf16*)((unsigned char*)a.out + OUT_NF) + ub; bf16* Y2 = (bf16*)((unsigned char*)a.out + OUT_Y2) + ub;
          ZERO2(acc); mm2(BhT, U2T, w, acc); mm2(KhT, VT, w, acc);
          ZERO2(rb); mm2(U2T, ARB, w, rb); mm2(VT, ARK, w, rb);
#pragma unroll
          for (int ci = 0; ci < 2; ++ci) { const int tb = w.tb0 + ci;
              v2u o; o.x = pk2(acc[ci][0], acc[ci][1]); o.y = pk2(acc[ci][2], acc[ci][3]); *(v2u*)(NF + (size_t)((tb * 4 + w.ta) * 64 + lane) * 4) = o;
              o.x = pk2(rb[ci][0], rb[ci][1]); o.y = pk2(rb[ci][2], rb[ci][3]); *(v2u*)(Y2 + (size_t)(16 * tb + w.fr) * 64 + 16 * w.ta + 4 * w.fq) = o; } }

#ifdef PROBE_G
        if (blockIdx.x == 0 && tid == 0 && hh == 3) ((unsigned long long*)(a.ws + 65536))[5] = __builtin_amdgcn_s_memrealtime();
#endif
    }
}
#ifndef HOSTDUP
#define HOSTDUP -1
#endif
#ifndef ONE_LAUNCH
#define ONE_LAUNCH 1
#endif
#if HOSTDUP != -1 || defined(MULTI)
#undef ONE_LAUNCH
#define ONE_LAUNCH 0
#endif
constexpr int NPHASE = 7;
__global__ void __launch_bounds__(NTHR, 2) mega(Args a) {
    extern __shared__ __attribute__((aligned(16))) unsigned char lds_[];
    LAS unsigned char* lds = (LAS unsigned char*)lds_;
    const int tid = threadIdx.x, lane = tid & 63, wave = __builtin_amdgcn_readfirstlane(tid >> 6);
    const int G = gridDim.x, bx = blockIdx.x, vcu = (G % 8 == 0) ? (bx % 8) * (G / 8) + bx / 8 : bx;
    cg::grid_group grid = cg::this_grid();
    volatile LAS unsigned* xst = (volatile LAS unsigned*)(lds + L2_XST);
    if (tid < 2) xst[tid] = 0u;
    __syncthreads();
    XcdBarrier xbar; xbar.bar = (unsigned*)a.ws; xbar.x = 0; xbar.st = xst;
    if (a.ph_hi - a.ph_lo > 1) xbar = xcd_barrier_post((unsigned*)a.ws, xst);
#ifndef PROBE_Q
#define PROBE_Q 1
#endif
#ifdef PROBE_TS
    unsigned long long ts_[10];
#define STAMP(i) do { ts_[i] = __builtin_amdgcn_s_memrealtime(); } while (0)
#else
#define STAMP(i) do {} while (0)
#endif
    STAMP(0);
#define IN(k) (a.ph_lo <= (k) && (k) < a.ph_hi)
#define SEAM(k) do { if (IN(k) && IN((k) + 1)) xcd_barrier(xbar); } while (0)
    if (a.ph_lo < 0) grid.sync();
    if (IN(0)) { p0_prologue(a, lds, vcu, G, wave, lane); }
    SEAM(0); STAMP(1);
    if (IN(1)) {
        pg8::Gemm g{(const pg8::bf16_t*)(a.ws + WS_XN), (const pg8::bf16_t*)(a.ws + WS_WTIN), T, NINP, D}; pg8::StaticOrder S; S.init(T, NINP, G, bx);
        pg8::EpiBf16<0> E{(pg8::bf16_t*)(a.ws + WS_PROJ), NINP, nullptr, 0, 0, 1.f};
        pg8::gemm_phase<pg8::EpiBf16<0>, pg8::StaticOrder, true, true>(lds, g, S, E);
    }
    SEAM(1); STAMP(2);
    if (IN(2)) {
        for (int it = bx; it < NCH * 2; it += G) rwkv_chunk_group(a, lds, it, tid, wave, lane);
    }
    SEAM(2); STAMP(3);
    if (IN(3)) { if (bx < 64) state_pass(a, lds, bx, tid, wave, lane); else { for (int it = bx - 64; it < 512; it += G - 64) attn_unit(a, lds, it, tid, wave, lane);
            bar_lds(); wout_transposes(a, lds, (bx - 64) * NWAVES + wave, (G - 64) * NWAVES, wave, lane); } }
    SEAM(3); STAMP(4);
    if (IN(4)) { for (int u = bx; u < NCH * NH; u += G) rwkv_out_unit(a, lds, u, tid, wave, lane); }
    SEAM(4); STAMP(5);
    if (IN(5)) {
        pg8::Gemm g{(const pg8::bf16_t*)(a.ws + WS_MIX), (const pg8::bf16_t*)(a.ws + WS_WTOUT), T, D, D}; pg8::StaticOrder S; S.init(T, D, G, bx);
        if (G == 256 && a.ph_hi - a.ph_lo > 1) {
            pg8::EpiResidNorm E{a.in[0], a.out, (float*)(a.ws + WS_SSP), (unsigned*)a.ws + 4096, a.in[15], D, RMS_EPS};
            pg8::gemm_phase<pg8::EpiResidNorm, pg8::StaticOrder, false, true>(lds, g, S, E);
        } else {
            pg8::EpiResid E{a.in[0], a.out, (float*)(a.ws + WS_SSP), D};
            pg8::gemm_phase<pg8::EpiResid, pg8::StaticOrder, true, true>(lds, g, S, E);
        }
    }
    if (!(G == 256 && a.ph_hi - a.ph_lo > 1)) { SEAM(5); } STAMP(6);
    if (IN(6) && !(G == 256 && a.ph_hi - a.ph_lo > 1)) final_norm(a, vcu, G, wave, lane);
#ifdef PROBE_G
    __syncthreads();
    if (bx == 0 && tid == 0) { const unsigned long long* g_ = (const unsigned long long*)(a.ws + 65536); a.out[0] = (float)(g_[PROBE_G + 1] - g_[PROBE_G]) * 0.1f; }
#endif
#ifdef PROBE_TS
    STAMP(7); __syncthreads();
    if (bx == 0 && tid == 0) { const int k_ = PROBE_TS; const unsigned long long d_ = (k_ == 8) ? ts_[8] - ts_[2] : ts_[k_ + 1] - ts_[k_]; a.out[0] = (float)(((int)((float)d_ * 0.01f) / PROBE_Q) * PROBE_Q + PROBE_Q / 2); }
#endif
#undef IN
#undef SEAM
}

extern "C" void kernel_launch(void* const* d_in, const int* in_sizes, int n_in, void* d_out, int out_size, void* d_ws, size_t ws_size, hipStream_t stream) {
    static int grid = 0;
    if (grid == 0) {
        int dev = 0, cus = 0;
        if (hipGetDevice(&dev) != hipSuccess || hipDeviceGetAttribute(&cus, hipDeviceAttributeMultiprocessorCount, dev) != hipSuccess) { fprintf(stderr, "kernel_launch: device query failed\n"); grid = -1; return; }
        if (hipFuncSetAttribute((const void*)mega, hipFuncAttributeMaxDynamicSharedMemorySize, LDS_BYTES) != hipSuccess) { fprintf(stderr, "kernel_launch: hipFuncSetAttribute failed\n"); grid = -1; return; }
        (void)hipGetLastError();
        grid = cus;
    }
    if (grid < 0) return;
    Args a{};
    for (int i = 0; i < 16; ++i) a.in[i] = (const float*)d_in[i];
    a.out = (float*)d_out; a.ws = (unsigned char*)d_ws;
#if ONE_LAUNCH
    (void)hipMemsetAsync(d_ws, 0, 32768, stream);
    a.ph_lo = 0; a.ph_hi = NPHASE;
    void* args[] = {&a};
    hipError_t e = hipLaunchCooperativeKernel((const void*)mega, dim3(grid), dim3(NTHR), args, LDS_BYTES, stream);
    if (e != hipSuccess) fprintf(stderr, "cooperative launch failed: %s (grid %d)\n", hipGetErrorString(e), grid);
#else
    for (int p = 0; p < NPHASE; ++p) for (int rep = 0; rep < (p == HOSTDUP ? 2 : 1); ++rep) { a.ph_lo = p; a.ph_hi = p + 1; hipLaunchKernelGGL(mega, dim3(grid), dim3(NTHR), LDS_BYTES, stream, a); }
#endif
}
```

```cpp
#define ONE 1
#include <hip/hip_runtime.h>
#include <hip/hip_cooperative_groups.h>
#include <cstdio>
#include <cstdint>
namespace cg = cooperative_groups;
namespace pg8 {
#define PG8_LAS __attribute__((address_space(3)))
typedef unsigned short bf16_t;
typedef short bf16x8 __attribute__((ext_vector_type(8)));
typedef float f32x4 __attribute__((ext_vector_type(4)));
typedef unsigned u32x4 __attribute__((ext_vector_type(4)));
constexpr int BM = 256, BK = 64, HALF = 128, HTB = HALF * BK * 2  , STAGE_BYTES = 8 * HTB, NXCD = 8, WGM = 8;

__host__ __device__ __forceinline__ int lds_byte(int r, int c) { const int st = (r >> 4) * 2 + (c >> 5), rr = r & 15, cc = c & 31, ob = rr * 64 + cc * 2; return st * 1024 + (ob ^ (((ob >> 9) & 1) << 5)); }
__host__ __device__ __forceinline__ void stage_rc(int b, int& R, int& C) { const int st = b / 1024, sb = b % 1024, swz = sb ^ (((sb >> 9) & 1) << 5); R = (st >> 1) * 16 + swz / 64; C = (st & 1) * 32 + (swz % 64) / 2; }
__host__ __device__ __forceinline__ int perm32(int rho) { const int n = rho >> 4, i = rho & 15; return 8 * (i >> 2) + 4 * n + (i & 3); }

struct Unit { int pm, pn; };
struct Gemm { const bf16_t* A; const bf16_t* Bt; int M, N, K; };

struct StaticOrder {
    int nM, nN, nwg, G, c;
    __host__ __device__ void init(int M, int N, int G_, int c_) { nM = M / BM; nN = N / BM; nwg = nM * nN; G = G_; c = c_; }
    __host__ __device__ bool next(int i, Unit& u) const {
        const long L = (long)i * G + c; if (L >= nwg) return false;
        int wgid = (int)L; { const int q = nwg / NXCD, r = nwg % NXCD, xcd = wgid % NXCD, off = wgid / NXCD; wgid = (xcd < r ? xcd * (q + 1) : r * (q + 1) + (xcd - r) * q) + off; }
        const int nig = WGM * nN, gid = wgid / nig, fm = gid * WGM, gsz = (nM - fm) < WGM ? (nM - fm) : WGM;
        u.pm = fm + ((wgid % nig) % gsz); u.pn = (wgid % nig) / gsz; return true;
    }
    __device__ __forceinline__ void a_ready(const Unit&) const {}
    __device__ __forceinline__ void done(const Unit&) const {}
};

__device__ __forceinline__ unsigned cvt_pk_bf16(float lo, float hi) { unsigned r; asm volatile("v_cvt_pk_bf16_f32 %0, %1, %2" : "=v"(r) : "v"(lo), "v"(hi)); return r; }
typedef float f32x2 __attribute__((ext_vector_type(2)));
__device__ __forceinline__ f32x2 gelu_pk(f32x2 v) {
    const f32x2 av = __builtin_elementwise_abs(v), d = av * 0.2316418882f + 1.0f;
    f32x2 t; t.x = __builtin_amdgcn_rcpf(d.x); t.y = __builtin_amdgcn_rcpf(d.y);
    f32x2 q = t * 0.5307027145f + (-0.7265760135f); q = q * t + 0.7107068705f; q = q * t + (-0.142248368f); q = q * t + 0.127414796f; q = q * t;
    const f32x2 s = (v * v) * (-0.72134752044f);
    f32x2 e; e.x = __builtin_amdgcn_exp2f(s.x); e.y = __builtin_amdgcn_exp2f(s.y);
    const f32x2 m = v * (q * e), r = v - m;
    f32x2 o; o.x = v.x < 0.f ? m.x : r.x; o.y = v.y < 0.f ? m.y : r.y; return o;
}

template <int ACT  > struct EpiBf16 {
    static constexpr bool PERM = true, AFTER_DRAIN = false; static_assert(ACT == 0 || ACT == 1, "EpiBf16: ACT is 0 (none) or 1 (gelu_pk)");
    bf16_t* O; int ldc; const float* bias; int split_cols; size_t split_stride; float scale0;
    __device__ __forceinline__ void operator()(const f32x4 (&acc)[2][2][4][2], const Unit& u, int wr, int wc, int fr, int fq) const {
        const int row0 = u.pm * BM + wr * 64 + fr; int colt = u.pn * BM; bf16_t* base = O;
        float sc = 1.f; if (split_cols) { const int t = colt / split_cols; base += (size_t)t * split_stride; colt -= t * split_cols; if (t == 0) sc = scale0; }
        const int col0 = colt + wc * 32 + 8 * fq, bcol0 = u.pn * BM + wc * 32 + 8 * fq;
        f32x4 bv[2][2];
#pragma unroll
        for (int bj = 0; bj < 2; ++bj)
#pragma unroll
            for (int n = 0; n < 2; ++n) bv[bj][n] = bias ? *(const f32x4*)(bias + bcol0 + bj * HALF + 4 * n) : (f32x4){0.f, 0.f, 0.f, 0.f};
#pragma unroll
        for (int ai = 0; ai < 2; ++ai)
#pragma unroll
            for (int m = 0; m < 4; ++m) { bf16_t* rowp = base + (size_t)(row0 + ai * HALF + m * 16) * ldc + col0;
#pragma unroll
                for (int bj = 0; bj < 2; ++bj) { f32x4 v0 = acc[ai][bj][m][0] + bv[bj][0], v1 = acc[ai][bj][m][1] + bv[bj][1];
                    if (ACT == 1) { f32x2 a = gelu_pk((f32x2){v0[0], v0[1]}), b = gelu_pk((f32x2){v0[2], v0[3]}), c = gelu_pk((f32x2){v1[0], v1[1]}), d = gelu_pk((f32x2){v1[2], v1[3]});
                        v0 = (f32x4){a.x, a.y, b.x, b.y}; v1 = (f32x4){c.x, c.y, d.x, d.y}; }
                    v0 = v0 * sc; v1 = v1 * sc; u32x4 w; w.x = cvt_pk_bf16(v0[0], v0[1]); w.y = cvt_pk_bf16(v0[2], v0[3]); w.z = cvt_pk_bf16(v1[0], v1[1]); w.w = cvt_pk_bf16(v1[2], v1[3]);
                    *(u32x4*)(rowp + bj * HALF) = w; } }
    }
};
struct EpiResid {
    static constexpr bool PERM = false, AFTER_DRAIN = false;
    const float* x; float* out; float* sspart; int ldc;
    __device__ __forceinline__ void operator()(const f32x4 (&acc)[2][2][4][2], const Unit& u, int wr, int wc, int fr, int fq) const {
        const int row0 = u.pm * BM + wr * 64 + fr, col0 = u.pn * BM + wc * 32 + 4 * fq;
#pragma unroll
        for (int ai = 0; ai < 2; ++ai)
#pragma unroll
            for (int m = 0; m < 4; ++m) {
                const int row = row0 + ai * HALF + m * 16; float ss = 0.f;
#pragma unroll
                for (int bj = 0; bj < 2; ++bj)
#pragma unroll
                    for (int n = 0; n < 2; ++n) {
                        const size_t off = (size_t)row * ldc + col0 + bj * HALF + n * 16;
                        const f32x4 xv = *(const f32x4*)(x + off); const f32x4 v = acc[ai][bj][m][n] + xv;
                        *(f32x4*)(out + off) = v; ss += (v[0] * v[0] + v[1] * v[1]) + (v[2] * v[2] + v[3] * v[3]);
                    }
                ss += __shfl_xor(ss, 16); ss += __shfl_xor(ss, 32);
                if (fq == 0) sspart[(size_t)row * 32 + u.pn * 4 + wc] = ss;
            }
    }
};

struct OneTile {
    int pm, pn;
    __host__ __device__ bool next(int i, Unit& u) const { if (i != 0) return false; u.pm = pm; u.pn = pn; return true; }
    __device__ __forceinline__ void a_ready(const Unit&) const {}
    __device__ __forceinline__ void done(const Unit&) const {}
};
struct EpiResidNorm {
    static constexpr bool PERM = false, AFTER_DRAIN = true;
    const float* x; float* out; float* ssp; unsigned* cnt; const float* gain; int ldc; float eps;
    __device__ __forceinline__ void fused(f32x4 (&acc)[2][2][4][2], const Unit& u, int wr, int wc, int fr, int fq, PG8_LAS unsigned char* lds, int wid, int lane) const {
        const int row0 = u.pm * BM + wr * 64 + fr, col0 = u.pn * BM + wc * 32 + 4 * fq;
#pragma unroll
        for (int ai = 0; ai < 2; ++ai)
#pragma unroll
            for (int m = 0; m < 4; ++m) {
                const int row = row0 + ai * HALF + m * 16; float ss = 0.f;
#pragma unroll
                for (int bj = 0; bj < 2; ++bj)
#pragma unroll
                    for (int n = 0; n < 2; ++n) {
                        const f32x4 xv = *(const f32x4*)(x + (size_t)row * ldc + col0 + bj * HALF + n * 16); const f32x4 v = acc[ai][bj][m][n] + xv;
                        acc[ai][bj][m][n] = v; ss += (v[0] * v[0] + v[1] * v[1]) + (v[2] * v[2] + v[3] * v[3]);
                    }
                ss += __shfl_xor(ss, 16); ss += __shfl_xor(ss, 32);
                if (fq == 0) __hip_atomic_store(ssp + (size_t)row * 32 + u.pn * 4 + wc, ss, __ATOMIC_RELAXED, __HIP_MEMORY_SCOPE_AGENT);
            }
        asm volatile("s_waitcnt vmcnt(0)" ::: "memory");
        __syncthreads();
        unsigned* c = cnt + 64 * u.pm;
        if (threadIdx.x == 0) {
            __hip_atomic_fetch_add(c, 1u, __ATOMIC_RELEASE, __HIP_MEMORY_SCOPE_AGENT);
            unsigned spins = 0;
            while (__hip_atomic_load(c, __ATOMIC_RELAXED, __HIP_MEMORY_SCOPE_AGENT) < 8u) { __builtin_amdgcn_s_sleep(2); if (++spins > (1u << 22)) break; }
            __builtin_amdgcn_fence(__ATOMIC_ACQUIRE, "agent");
        }
        __syncthreads();
        PG8_LAS float* S = (PG8_LAS float*)lds;
        if (threadIdx.x < 256) {
            const float* p = ssp + (size_t)(u.pm * BM + threadIdx.x) * 32; float s = 0.f;
#pragma unroll
            for (int i = 0; i < 32; ++i) s += __hip_atomic_load(p + i, __ATOMIC_RELAXED, __HIP_MEMORY_SCOPE_AGENT);
            S[threadIdx.x] = 1.0f / sqrtf(s * (1.0f / 2048.0f) + eps);
        }
        __syncthreads();
#pragma unroll
        for (int bj = 0; bj < 2; ++bj)
#pragma unroll
            for (int n = 0; n < 2; ++n) {
                const f32x4 g = *(const f32x4*)(gain + col0 + bj * HALF + n * 16);
#pragma unroll
                for (int ai = 0; ai < 2; ++ai)
#pragma unroll
                    for (int m = 0; m < 4; ++m) {
                        const int lr = wr * 64 + fr + ai * HALF + m * 16; const float rs = S[lr];
                        f32x4 v = acc[ai][bj][m][n]; v[0] *= rs * g[0]; v[1] *= rs * g[1]; v[2] *= rs * g[2]; v[3] *= rs * g[3];
                        *(f32x4*)(out + (size_t)(u.pm * BM + lr) * ldc + col0 + bj * HALF + n * 16) = v;
                    }
            }
    }
};

template <class Epi, class Sched, bool ALIGN_EPI = false, bool SP2 = false>
__device__ __forceinline__ void gemm_phase(PG8_LAS unsigned char* lds, const Gemm g, const Sched& S, const Epi& E) {
    const int tid = threadIdx.x, wid = __builtin_amdgcn_readfirstlane(tid >> 6), lane = tid & 63, wr = wid >> 2, wc = wid & 3, fr = lane & 15, fq = lane >> 4;
    const int K = g.K, nt = K / BK;
    unsigned voffA[2], voffB[2];
#pragma unroll
    for (int i = 0; i < 2; ++i) { int R, C; stage_rc(tid * 16 + i * 8192, R, C); const int Rb = Epi::PERM ? ((R & ~31) + perm32(R & 31)) : R;
        voffA[i] = (unsigned)(R * K + C) * 2u; voffB[i] = (unsigned)(Rb * K + C) * 2u; }
    const size_t kstep = (size_t)(BK * 2);
    const size_t hstep = (size_t)HALF * K * 2;
    const size_t tstep = 2 * hstep;
    const unsigned ldsw = (unsigned)wid * 1024u;
    const int aoff = lds_byte(wr * 64 + fr, fq * 8), boff = lds_byte(wc * 32 + fr, fq * 8);
#define PG8_SA(b, h) (((b) * 2 + (h)) * HTB)
#define PG8_SB(b, h) ((4 + (b) * 2 + (h)) * HTB)
#define PG8_STAGE(bufoff, gbase, voff) do { _Pragma("unroll") for (int _i = 0; _i < 2; ++_i) \
        __builtin_amdgcn_global_load_lds((const unsigned*)((const char*)(gbase) + (voff)[_i]), (PG8_LAS unsigned*)(lds + (bufoff) + ldsw + _i * 8192), 16, 0, 0); } while (0)
#define PG8_LDA(dst, b, h) do { _Pragma("unroll") for (int m = 0; m < 4; ++m) _Pragma("unroll") for (int k = 0; k < 2; ++k) dst[m][k] = *(const PG8_LAS bf16x8*)(lds + PG8_SA(b, h) + aoff + m * 2048 + k * 1024); } while (0)
#define PG8_LDB(dst, b, h) do { _Pragma("unroll") for (int n = 0; n < 2; ++n) _Pragma("unroll") for (int k = 0; k < 2; ++k) dst[n][k] = *(const PG8_LAS bf16x8*)(lds + PG8_SB(b, h) + boff + n * 2048 + k * 1024); } while (0)
#define PG8_MMA(ai, bj, At, Bt) do { __builtin_amdgcn_s_setprio(1); _Pragma("unroll") for (int m = 0; m < 4; ++m) _Pragma("unroll") for (int n = 0; n < 2; ++n) _Pragma("unroll") for (int k = 0; k < 2; ++k) \
        acc[ai][bj][m][n] = __builtin_amdgcn_mfma_f32_16x16x32_bf16(Bt[n][k], At[m][k], acc[ai][bj][m][n], 0, 0, 0); __builtin_amdgcn_s_setprio(0); } while (0)
#define PG8_WAIT_V(n) asm volatile("s_waitcnt vmcnt(" #n ")" ::: "memory")
#define PG8_WAIT_L(n) asm volatile("s_waitcnt lgkmcnt(" #n ")" ::: "memory")
#define PG8_BAR __builtin_amdgcn_s_barrier()
#define PG8_SCHED __builtin_amdgcn_sched_barrier(0)
    Unit cur, nxt; int ui = 0;
    if (!S.next(0, cur)) return;
    f32x4 acc[2][2][4][2];
#pragma unroll
    for (int a = 0; a < 2; ++a)
#pragma unroll
        for (int b = 0; b < 2; ++b)
#pragma unroll
            for (int m = 0; m < 4; ++m)
#pragma unroll
                for (int n = 0; n < 2; ++n) acc[a][b][m][n] = (f32x4){0.f, 0.f, 0.f, 0.f};
    bf16x8 At[4][2], B0[2][2], B1[2][2];
    const char* cA = (const char*)g.A + (size_t)cur.pm * tstep; const char* cB = (const char*)g.Bt + (size_t)cur.pn * tstep;
    S.a_ready(cur);
    if constexpr (SP2) {
        PG8_STAGE(PG8_SB(0, 0), cB, voffB); PG8_STAGE(PG8_SB(0, 1), cB + hstep, voffB); PG8_STAGE(PG8_SA(0, 0), cA, voffA); PG8_STAGE(PG8_SA(0, 1), cA + hstep, voffA);
        if (wr == 1) PG8_BAR;
        PG8_WAIT_V(2); PG8_BAR;
        PG8_STAGE(PG8_SB(1, 0), cB + kstep, voffB); PG8_STAGE(PG8_SA(1, 0), cA + kstep, voffA); PG8_STAGE(PG8_SB(1, 1), cB + hstep + kstep, voffB);
        PG8_WAIT_V(6); PG8_BAR;
    } else {
        PG8_STAGE(PG8_SB(0, 0), cB, voffB); PG8_STAGE(PG8_SA(0, 0), cA, voffA); PG8_STAGE(PG8_SB(0, 1), cB + hstep, voffB); PG8_STAGE(PG8_SA(0, 1), cA + hstep, voffA);
        if (wr == 1) PG8_BAR;
        PG8_WAIT_V(4); PG8_BAR;
        PG8_STAGE(PG8_SB(1, 0), cB + kstep, voffB); PG8_STAGE(PG8_SA(1, 0), cA + kstep, voffA); PG8_STAGE(PG8_SB(1, 1), cB + hstep + kstep, voffB);
        PG8_WAIT_V(6); PG8_BAR;
    }
    for (;;) {
        const bool has_next = S.next(ui + 1, nxt);
        const char* nA = has_next ? (const char*)g.A + (size_t)nxt.pm * tstep : cA; const char* nB = has_next ? (const char*)g.Bt + (size_t)nxt.pn * tstep : cB;
        for (int t = 0; t < nt; t += 2) {
            const bool last = (t == nt - 2);
            const char* a1 = cA + (size_t)(t + 1) * kstep;
            const char* a2 = last ? nA : cA + (size_t)(t + 2) * kstep; const char* b2 = last ? nB : cB + (size_t)(t + 2) * kstep;
            const char* a3 = a2 + kstep; const char* b3 = b2 + kstep;
            if (last && has_next) S.a_ready(nxt);
            if constexpr (SP2) {
            PG8_LDB(B0, 0, 0); PG8_LDB(B1, 0, 1); PG8_SCHED; PG8_LDA(At, 0, 0); PG8_STAGE(PG8_SA(1, 1), a1 + hstep, voffA);
            PG8_WAIT_V(8); PG8_WAIT_L(0); PG8_BAR; PG8_MMA(0, 0, At, B0); PG8_MMA(0, 1, At, B1); PG8_BAR; PG8_SCHED;
            PG8_LDA(At, 0, 1); PG8_STAGE(PG8_SB(0, 0), b2, voffB); PG8_STAGE(PG8_SB(0, 1), b2 + hstep, voffB); PG8_STAGE(PG8_SA(0, 0), a2, voffA);
            PG8_WAIT_V(8); PG8_WAIT_L(0); PG8_BAR; PG8_MMA(1, 0, At, B0); PG8_MMA(1, 1, At, B1); PG8_BAR; PG8_SCHED;
            PG8_LDB(B0, 1, 0); PG8_LDB(B1, 1, 1); PG8_SCHED; PG8_LDA(At, 1, 0); PG8_STAGE(PG8_SA(0, 1), a2 + hstep, voffA);
            PG8_WAIT_V(8); PG8_WAIT_L(0); PG8_BAR; PG8_MMA(0, 0, At, B0); PG8_MMA(0, 1, At, B1); PG8_BAR; PG8_SCHED;
            PG8_LDA(At, 1, 1); PG8_STAGE(PG8_SB(1, 0), b3, voffB); PG8_STAGE(PG8_SB(1, 1), b3 + hstep, voffB); PG8_STAGE(PG8_SA(1, 0), a3, voffA);
            PG8_WAIT_V(8); PG8_WAIT_L(0); PG8_BAR; PG8_MMA(1, 0, At, B0); PG8_MMA(1, 1, At, B1); PG8_BAR; PG8_SCHED;
            } else {
            PG8_LDB(B0, 0, 0); PG8_SCHED; PG8_LDA(At, 0, 0); PG8_STAGE(PG8_SA(1, 1), a1 + hstep, voffA);
            PG8_WAIT_L(8); PG8_BAR; PG8_WAIT_L(0); PG8_MMA(0, 0, At, B0); PG8_BAR; PG8_SCHED;
            PG8_LDB(B1, 0, 1); PG8_STAGE(PG8_SB(0, 0), b2, voffB);
            PG8_BAR; PG8_WAIT_L(0); PG8_MMA(0, 1, At, B1); PG8_BAR;
            PG8_LDA(At, 0, 1); PG8_STAGE(PG8_SA(0, 0), a2, voffA);
            PG8_BAR; PG8_WAIT_L(0); PG8_MMA(1, 0, At, B0); PG8_BAR; PG8_SCHED;
            PG8_STAGE(PG8_SB(0, 1), b2 + hstep, voffB);
            PG8_WAIT_V(6); PG8_BAR; PG8_MMA(1, 1, At, B1); PG8_BAR;
            PG8_LDB(B0, 1, 0); PG8_SCHED; PG8_LDA(At, 1, 0); PG8_STAGE(PG8_SA(0, 1), a2 + hstep, voffA);
            PG8_WAIT_L(8); PG8_BAR; PG8_WAIT_L(0); PG8_MMA(0, 0, At, B0); PG8_BAR; PG8_SCHED;
            PG8_LDB(B1, 1, 1); PG8_STAGE(PG8_SB(1, 0), b3, voffB);
            PG8_BAR; PG8_WAIT_L(0); PG8_MMA(0, 1, At, B1); PG8_BAR;
            PG8_LDA(At, 1, 1); PG8_STAGE(PG8_SA(1, 0), a3, voffA);
            PG8_BAR; PG8_WAIT_L(0); PG8_MMA(1, 0, At, B0); PG8_BAR; PG8_SCHED;
            PG8_STAGE(PG8_SB(1, 1), b3 + hstep, voffB);
            PG8_WAIT_V(6); PG8_BAR; PG8_MMA(1, 1, At, B1); PG8_BAR;
            }
        }
        if constexpr (ALIGN_EPI) { if (wr == 0) PG8_BAR; }
        if constexpr (!Epi::AFTER_DRAIN) { E(acc, cur, wr, wc, fr, fq); S.done(cur); }
        if (!has_next) break;
#pragma unroll
        for (int a = 0; a < 2; ++a)
#pragma unroll
            for (int b = 0; b < 2; ++b)
#pragma unroll
                for (int m = 0; m < 4; ++m)
#pragma unroll
                    for (int n = 0; n < 2; ++n) acc[a][b][m][n] = (f32x4){0.f, 0.f, 0.f, 0.f};
        cur = nxt; cA = nA; cB = nB; ++ui;
        if constexpr (ALIGN_EPI) { if (wr == 1) PG8_BAR; }
    }
    PG8_WAIT_V(0);
    if constexpr (!ALIGN_EPI) { if (wr == 0) PG8_BAR; }
    PG8_BAR;
    if constexpr (Epi::AFTER_DRAIN) { E.fused(acc, cur, wr, wc, fr, fq, lds, wid, lane); S.done(cur); }
#undef PG8_SA
#undef PG8_SB
#undef PG8_STAGE
#undef PG8_LDA
#undef PG8_LDB
#undef PG8_MMA
#undef PG8_WAIT_V
#undef PG8_WAIT_L
#undef PG8_BAR
#undef PG8_SCHED
}
}
constexpr int T = 8192, D = 2048, NIN = 6528, NINP = 6656, RW = 1024, NH = 16, HD = 64, CH = 64, NCH = T / CH;
constexpr int C_R = 0, C_K = 1024, C_V = 2048, C_WD = 3072, C_AD = 3136, C_G = 3200, C_AQ = 4224, C_AK = 5248, C_AV = 5376, C_AG = 5504;
constexpr float RMS_EPS = 1e-5f, LNX_EPS = 64e-5f;
constexpr int NWAVES = 8, NTHR = 512;
constexpr size_t MiB = 1u << 20;
constexpr size_t WS_WTIN = 1 * MiB;
constexpr size_t WS_XN = 27 * MiB;
constexpr size_t WS_WTOUT = 59 * MiB;
constexpr size_t WS_UPT = 67 * MiB;
constexpr size_t WS_SSP = 68 * MiB;
constexpr size_t WS_PROJ = 70 * MiB;
constexpr size_t WS_SCR = 174 * MiB;
constexpr size_t WS_MIX = 223 * MiB;
constexpr size_t WS_P32 = 223 * MiB;
constexpr int LDS_BYTES = 163840;

#define GAS __attribute__((address_space(1)))
#define LAS __attribute__((address_space(3)))
typedef unsigned short bf16;
typedef unsigned v4u __attribute__((ext_vector_type(4)));
typedef unsigned v2u __attribute__((ext_vector_type(2)));
typedef float f32x4 __attribute__((ext_vector_type(4)));
typedef float f32x16 __attribute__((ext_vector_type(16)));
typedef short bf16x8 __attribute__((ext_vector_type(8)));
typedef __bf16 bf16x2_t __attribute__((ext_vector_type(2)));
__device__ __forceinline__ unsigned pk2(float a, float b) { bf16x2_t v; v[0] = (__bf16)a; v[1] = (__bf16)b; return __builtin_bit_cast(unsigned, v); }
__device__ __forceinline__ float bflo(unsigned u) { return __uint_as_float(u << 16); }
__device__ __forceinline__ float bfhi(unsigned u) { return __uint_as_float(u & 0xffff0000u); }
__device__ __forceinline__ void unpack8(const v4u& p, float (&f)[8]) { f[0] = bflo(p.x); f[1] = bfhi(p.x); f[2] = bflo(p.y); f[3] = bfhi(p.y); f[4] = bflo(p.z); f[5] = bfhi(p.z); f[6] = bflo(p.w); f[7] = bfhi(p.w); }
__device__ __forceinline__ v4u pack8(const float (&f)[8]) { v4u o; o.x = pk2(f[0], f[1]); o.y = pk2(f[2], f[3]); o.z = pk2(f[4], f[5]); o.w = pk2(f[6], f[7]); return o; }
__device__ __forceinline__ float wave_sum(float v) {
#pragma unroll
    for (int o = 1; o < 64; o <<= 1) v += __shfl_xor(v, o);
    return v;
}
__device__ __forceinline__ float sum8(float v) { v += __shfl_xor(v, 1); v += __shfl_xor(v, 2); v += __shfl_xor(v, 4); return v; }
__device__ __forceinline__ float sigmoidf_(float x) { return 1.f / (1.f + __expf(-x)); }
__device__ __forceinline__ float siluf_(float x) { return x / (1.f + __expf(-x)); }

__device__ __forceinline__ void bar_lds() { asm volatile("s_waitcnt lgkmcnt(0)" ::: "memory"); __builtin_amdgcn_s_barrier(); asm volatile("" ::: "memory"); }
struct Args { const float* in[16]; float* out; unsigned char* ws; int ph_lo, ph_hi; };

struct TItem { const float* W; bf16* WT; int K, N, k0, n0; };
__device__ __forceinline__ bool p0_item(const Args& a, int it, TItem& o) {
    constexpr int I_IN = (D / 64) * (NIN / 32), I_OUT = (D / 64) * (D / 32), I_UP = RW / 32;
    bf16* wtin = (bf16*)(a.ws + WS_WTIN); bf16* wtout = (bf16*)(a.ws + WS_WTOUT); bf16* upt = (bf16*)(a.ws + WS_UPT); bf16* aupt = upt + 65536;
    int r = it;
    if (r < 0) { r += I_OUT; if (r < 0) return false; o.W = a.in[14]; o.WT = wtout; o.K = D; o.N = D; }
    else if (r < I_IN) { o.W = a.in[2]; o.WT = wtin; o.K = D; o.N = NIN; }
    else if ((r -= I_IN) < I_UP) { o.W = a.in[5]; o.WT = upt; o.K = 64; o.N = RW; }
    else if ((r -= I_UP) < I_UP) { o.W = a.in[7]; o.WT = aupt; o.K = 64; o.N = RW; }
    else return false;
    const int nblk = o.N / 32; o.k0 = 64 * (r / nblk); o.n0 = 32 * (r % nblk); return true;
}
__device__ __forceinline__ void p0_ld(const TItem& t, int lane, f32x4 (&v)[8]) {
#pragma unroll
    for (int i = 0; i < 8; ++i) v[i] = *(const f32x4*)(t.W + (size_t)(t.k0 + 8 * i + (lane >> 3)) * t.N + t.n0 + 4 * (lane & 7));
}
__device__ __forceinline__ void p0_st(const TItem& t, int lane, const f32x4 (&v)[8], LAS float* scr) {
#pragma unroll
    for (int i = 0; i < 8; ++i) { LAS float* d = scr + (8 * i + (lane >> 3)) * 33 + 4 * (lane & 7); d[0] = v[i].x; d[1] = v[i].y; d[2] = v[i].z; d[3] = v[i].w; }
    asm volatile("s_waitcnt lgkmcnt(0)" ::: "memory");
    const int c = lane & 7;
#pragma unroll
    for (int j = 0; j < 4; ++j) { const int n = (lane >> 3) + 8 * j; const LAS float* s = scr + (8 * c) * 33 + n;
        v4u o; o.x = pk2(s[0 * 33], s[1 * 33]); o.y = pk2(s[2 * 33], s[3 * 33]); o.z = pk2(s[4 * 33], s[5 * 33]); o.w = pk2(s[6 * 33], s[7 * 33]);
        *(v4u*)(t.WT + (size_t)(t.n0 + n) * t.K + t.k0 + 8 * c) = o; }
    asm volatile("s_waitcnt lgkmcnt(0)" ::: "memory");
}
__device__ __forceinline__ void wout_transposes(const Args& a, LAS unsigned char* lds, int gw, int NGW, int wave, int lane) {
    LAS float* scr = (LAS float*)(lds + wave * 16384);
    constexpr int I_OUT = (D / 64) * (D / 32);
    for (int it = gw - I_OUT; it < 0; it += NGW) { TItem t0; f32x4 v0[8]; if (!p0_item(a, it, t0)) break; p0_ld(t0, lane, v0); p0_st(t0, lane, v0, scr); }
}
__device__ __forceinline__ void p0_prologue(const Args& a, LAS unsigned char* lds, int vcu, int G, int wave, int lane) {
    LAS float* scr = (LAS float*)(lds + wave * 16384);
    const int gw = vcu * NWAVES + wave, NGW = G * NWAVES;
    bf16* wtin = (bf16*)(a.ws + WS_WTIN);
#ifdef PROBE_P0X
    for (int rep_ = 0; rep_ < 2; ++rep_)
#endif
    for (int it = gw; ; it += 2 * NGW) {
        TItem t0, t1; f32x4 v0[8], v1[8];
        const bool h0 = p0_item(a, it, t0), h1 = p0_item(a, it + NGW, t1);
        if (!h0) break;
        p0_ld(t0, lane, v0); if (h1) p0_ld(t1, lane, v1);
        p0_st(t0, lane, v0, scr); if (h1) p0_st(t1, lane, v1, scr);
    }
    wout_transposes(a, lds, gw, NGW, wave, lane);
    { v4u z = {0u, 0u, 0u, 0u}; v4u* p = (v4u*)(wtin + (size_t)NIN * D); const int n16 = (NINP - NIN) * D * 2 / 16;
      for (int i = gw * 64 + lane; i < n16; i += NGW * 64) p[i] = z; }
    const float* gain = a.in[1];
#ifdef PROBE_P0R
    for (int rep_ = 0; rep_ < 2; ++rep_)
#endif
    for (int m = gw; m < T; m += 2 * NGW) {
        const int m2 = m + NGW;
        const f32x4* xr = (const f32x4*)(a.in[0] + (size_t)m * D) + lane; const f32x4* xr2 = (const f32x4*)(a.in[0] + (size_t)(m2 < T ? m2 : m) * D) + lane;
        f32x4 v[8], u[8]; float s = 0.f, s2 = 0.f;
#pragma unroll
        for (int j = 0; j < 8; ++j) { v[j] = xr[64 * j]; u[j] = xr2[64 * j]; }
#pragma unroll
        for (int j = 0; j < 8; ++j) { s += (v[j].x * v[j].x + v[j].y * v[j].y) + (v[j].z * v[j].z + v[j].w * v[j].w); s2 += (u[j].x * u[j].x + u[j].y * u[j].y) + (u[j].z * u[j].z + u[j].w * u[j].w); }
        const float rstd = 1.f / sqrtf(wave_sum(s) * (1.f / D) + RMS_EPS), rstd2 = 1.f / sqrtf(wave_sum(s2) * (1.f / D) + RMS_EPS);
        v2u* o8 = (v2u*)((bf16*)(a.ws + WS_XN) + (size_t)m * D) + lane; v2u* o82 = (v2u*)((bf16*)(a.ws + WS_XN) + (size_t)m2 * D) + lane;
#pragma unroll
        for (int j = 0; j < 8; ++j) { const f32x4 g = *((const f32x4*)gain + lane + 64 * j); v2u o; o.x = pk2(v[j].x * rstd * g.x, v[j].y * rstd * g.y); o.y = pk2(v[j].z * rstd * g.z, v[j].w * rstd * g.w); o8[64 * j] = o;
            if (m2 < T) { o.x = pk2(u[j].x * rstd2 * g.x, u[j].y * rstd2 * g.y); o.y = pk2(u[j].z * rstd2 * g.z, u[j].w * rstd2 * g.w); o82[64 * j] = o; } }
    }
}
__device__ __forceinline__ void final_norm(const Args& a, int vcu, int G, int wave, int lane) {
    const int gw = vcu * NWAVES + wave, NGW = G * NWAVES; const float* ssp = (const float*)(a.ws + WS_SSP); const float* gain = a.in[15];
    for (int m = gw; m < T; m += NGW) {
        float s = (lane < 32) ? ssp[(size_t)m * 32 + lane] : 0.f; s = wave_sum(s);
        const float rstd = 1.f / sqrtf(s * (1.f / D) + RMS_EPS);
        f32x4* xr = (f32x4*)(a.out + (size_t)m * D) + lane;
#pragma unroll
        for (int j = 0; j < 8; ++j) { f32x4 v = xr[64 * j]; const f32x4 g = *((const f32x4*)gain + lane + 64 * j); v.x *= rstd * g.x; v.y *= rstd * g.y; v.z *= rstd * g.z; v.w *= rstd * g.w; xr[64 * j] = v; }
    }
}
#define XB_TMO      128
#define XB_XCNT(j)  (256  + 64 * (j))
#define XB_XSUB(j)  (1280 + 64 * (j))
#define XB_XGEN(j)  (2304 + 64 * (j))
#define XB_TOP      3328
#define XB_TOPGEN   3392
#define XCD_BAR_WORDS 3456
#define XB_SPIN_CAP (1u << 18)

__device__ __forceinline__ unsigned xb_ld(unsigned* p)              { return __hip_atomic_load(p, __ATOMIC_RELAXED, __HIP_MEMORY_SCOPE_AGENT); }
__device__ __forceinline__ unsigned xb_add(unsigned* p, unsigned v) { return __hip_atomic_fetch_add(p, v, __ATOMIC_RELAXED, __HIP_MEMORY_SCOPE_AGENT); }
__device__ __forceinline__ unsigned xb_xcc_id() { return (unsigned)__builtin_amdgcn_s_getreg((3 << 11) | 20) & 0xFu; }
#define XB_SPIN(cond, bar) do { unsigned _sp = 0; while (cond) { __builtin_amdgcn_s_sleep(1); \
    if ((++_sp & 255u) == 0u) { if (xb_ld(&(bar)[XB_TMO])) break; if (_sp > XB_SPIN_CAP) { atomicAdd(&(bar)[XB_TMO], 1u); break; } } } } while (0)

struct XcdBarrier {
    unsigned* bar; unsigned x;
    volatile LAS unsigned* st;
};

__device__ __forceinline__ XcdBarrier xcd_barrier_post(unsigned* bar, volatile LAS unsigned* st) {
    XcdBarrier b; b.bar = bar; b.x = xb_xcc_id(); b.st = st;
    if (threadIdx.x == 0) (void)xb_add(&bar[XB_XCNT(b.x)], 1u);
    return b;
}
__device__ __forceinline__ void xcd_barrier_complete(unsigned* bar, unsigned x, unsigned& nloc, unsigned& nx) {
    const unsigned G = gridDim.x * gridDim.y * gridDim.z;
    unsigned sum, cnt, mine, sp = 0u;
    for (;;) {
        sum = 0u; cnt = 0u; mine = 0u;
#pragma unroll
        for (unsigned j = 0; j < 16; ++j) { const unsigned c = xb_ld(&bar[XB_XCNT(j)]); sum += c; cnt += (c > 0u) ? 1u : 0u; mine = (j == x) ? c : mine; }
        if (sum == G) break;
        __builtin_amdgcn_s_sleep(1);
        if ((++sp & 255u) == 0u) { if (xb_ld(&bar[XB_TMO])) break; if (sp > XB_SPIN_CAP) { atomicAdd(&bar[XB_TMO], 1u); break; } }
    }
    nloc = mine > 0u ? mine : 1u; nx = cnt > 0u ? cnt : 1u;
}

__device__ __forceinline__ void xcd_barrier(const XcdBarrier& b) {
    asm volatile("s_waitcnt vmcnt(0)" ::: "memory");
    __syncthreads();
    if (threadIdx.x == 0) {
        unsigned* bar = b.bar;
        __builtin_amdgcn_s_waitcnt(0);
        unsigned nloc = b.st[0], nx = b.st[1];
        if (nloc == 0u) { xcd_barrier_complete(bar, b.x, nloc, nx); b.st[0] = nloc; b.st[1] = nx; }
        const unsigned old = xb_add(&bar[XB_XSUB(b.x)], 1u);
        const unsigned gen = old / nloc;
        if (old + 1u == (gen + 1u) * nloc) {
            __builtin_amdgcn_fence(__ATOMIC_RELEASE, "agent");
            asm volatile("s_waitcnt vmcnt(0)" ::: "memory");
            const unsigned og = xb_add(&bar[XB_TOP], 1u);
            const unsigned tg = og / nx;
            if (og + 1u == (tg + 1u) * nx) xb_add(&bar[XB_TOPGEN], 1u);
            else XB_SPIN(xb_ld(&bar[XB_TOPGEN]) == tg, bar);
            __builtin_amdgcn_fence(__ATOMIC_ACQUIRE, "agent");
            xb_add(&bar[XB_XGEN(b.x)], 1u);
            asm volatile("s_waitcnt vmcnt(0)" ::: "memory");
        } else {
            XB_SPIN(xb_ld(&bar[XB_XGEN(b.x)]) == gen, bar);
            __builtin_amdgcn_fence(__ATOMIC_ACQUIRE, "agent");
            asm volatile("s_waitcnt vmcnt(0)" ::: "memory");
        }
    }
    __syncthreads();
}

#define MFMA32(a_, b_, c_) __builtin_amdgcn_mfma_f32_32x32x16_bf16((a_), (b_), (c_), 0, 0, 0)
#define MFMA16(a_, b_, c_) __builtin_amdgcn_mfma_f32_16x16x32_bf16((a_), (b_), (c_), 0, 0, 0)
__device__ __forceinline__ v4u ldg16(const bf16* p) { return *(const v4u*)p; }
__device__ __forceinline__ void load_shift8(const bf16* proj, int row, int col, const float* mu, float (&o)[8]) {
    const v4u p = ldg16(proj + (size_t)row * NINP + col); v4u q = {0u, 0u, 0u, 0u};
    if (row > 0) q = ldg16(proj + (size_t)(row - 1) * NINP + col);
    float pf[8], qf[8]; unpack8(p, pf); unpack8(q, qf);
    const f32x4 m0 = *(const f32x4*)(mu + col), m1 = *(const f32x4*)(mu + col + 4);
    const float mf[8] = {m0.x, m0.y, m0.z, m0.w, m1.x, m1.y, m1.z, m1.w};
#pragma unroll
    for (int j = 0; j < 8; ++j) o[j] = pf[j] + (qf[j] - pf[j]) * mf[j];
}
__device__ __forceinline__ void ld8f(const float* p, float (&o)[8]) { const f32x4 a = *(const f32x4*)p, b = *(const f32x4*)(p + 4); o[0] = a.x; o[1] = a.y; o[2] = a.z; o[3] = a.w; o[4] = b.x; o[5] = b.y; o[6] = b.z; o[7] = b.w; }

constexpr int VP = 168;
__device__ __forceinline__ void attn_unit(const Args& a, LAS unsigned char* lds, int unit, int tid, int wave, int lane) {
    const bf16* proj = (const bf16*)(a.ws + WS_PROJ); bf16* mix = (bf16*)(a.ws + WS_MIX);
    const int qb = unit >> 1, kvh = unit & 1, q0 = qb * 32, kbase = q0 - 128, hq = kvh * 8 + wave;
    LAS bf16* VT = (LAS bf16*)lds;
    const int r = lane & 31, h = lane >> 5;
    bf16x8 bq[4];
    { const bf16* qrow = proj + (size_t)(q0 + r) * NINP + C_AQ + hq * 64 + 8 * h;
#pragma unroll
      for (int s = 0; s < 4; ++s) bq[s] = *(const bf16x8*)(qrow + 16 * s); }
    const float slope = exp2f(-0.5f * (float)(hq + 1)), sink = a.in[13][hq];
    f32x16 sc[5]; float mx = sink;
    bf16x8 kf[5][4];
#pragma unroll
    for (int kt = 0; kt < 5; ++kt) { const int tkb = kbase + 32 * kt;
        if (tkb >= 0) { const bf16* krow = proj + (size_t)(tkb + r) * NINP + C_AK + kvh * 64 + 8 * h;
#pragma unroll
            for (int s = 0; s < 4; ++s) kf[kt][s] = *(const bf16x8*)(krow + 16 * s); } }
    v2u gpre[2][4];
#pragma unroll
    for (int dt = 0; dt < 2; ++dt)
#pragma unroll
        for (int g4 = 0; g4 < 4; ++g4) gpre[dt][g4] = *(const v2u*)(proj + (size_t)(q0 + r) * NINP + C_AG + hq * 64 + 32 * dt + 8 * g4 + 4 * h);
    bar_lds();
    for (int idx = tid; idx < 160 * 8; idx += NTHR) {
        const int key = idx >> 3, d8 = (idx & 7) * 8, tk = kbase + key;
        v4u p = {0u, 0u, 0u, 0u};
        if (tk >= 0) p = ldg16(proj + (size_t)tk * NINP + C_AV + kvh * 64 + d8);
        const unsigned w[4] = {p.x, p.y, p.z, p.w};
#pragma unroll
        for (int j = 0; j < 4; ++j) { VT[(d8 + 2 * j) * VP + key] = (bf16)(w[j] & 0xffffu); VT[(d8 + 2 * j + 1) * VP + key] = (bf16)(w[j] >> 16); }
    }
    bar_lds();
    const float L2E = 1.44269504f, SA = 0.125f * L2E, SB = slope * L2E, sinkl = sink * L2E;
    mx = sinkl;
#pragma unroll
    for (int kt = 0; kt < 5; ++kt) {
        const int tkb = kbase + 32 * kt;
        if (tkb >= 0) {
            f32x16 acc; for (int i = 0; i < 16; ++i) acc[i] = 0.f;
#pragma unroll
            for (int s = 0; s < 4; ++s) acc = MFMA32(kf[kt][s], bq[s], acc);
            const int dli = (q0 + r) - tkb - 4 * h; const float base = -SB * (float)dli;
#pragma unroll
            for (int i = 0; i < 16; ++i) {
                const int ci = (i & 3) + 8 * (i >> 2);
                float v = __builtin_fmaf(acc[i], SA, __builtin_fmaf(SB, (float)ci, base));
                if (kt == 0) v = (dli - ci < 128) ? v : -1e30f;
                if (kt == 4) v = (dli - ci >= 0) ? v : -1e30f;
                sc[kt][i] = v; mx = fmaxf(mx, v);
            }
        } else {
#pragma unroll
            for (int i = 0; i < 16; ++i) sc[kt][i] = -1e30f;
        }
    }
    mx = fmaxf(mx, __shfl_xor(mx, 32));
    float sum = 0.f;
#pragma unroll
    for (int kt = 0; kt < 5; ++kt)
#pragma unroll
        for (int i = 0; i < 16; ++i) { const float p = __builtin_amdgcn_exp2f(sc[kt][i] - mx); sc[kt][i] = p; sum += p; }
    sum += __shfl_xor(sum, 32); sum += __builtin_amdgcn_exp2f(sinkl - mx);
    f32x16 o[2]; for (int i = 0; i < 16; ++i) { o[0][i] = 0.f; o[1][i] = 0.f; }
#pragma unroll
    for (int kt = 0; kt < 5; ++kt) {
        if (kbase + 32 * kt >= 0) {
#pragma unroll
            for (int s = 0; s < 2; ++s) {
                v4u pw; pw.x = pk2(sc[kt][8 * s + 0], sc[kt][8 * s + 1]); pw.y = pk2(sc[kt][8 * s + 2], sc[kt][8 * s + 3]); pw.z = pk2(sc[kt][8 * s + 4], sc[kt][8 * s + 5]); pw.w = pk2(sc[kt][8 * s + 6], sc[kt][8 * s + 7]);
                const bf16x8 pb = __builtin_bit_cast(bf16x8, pw);
#pragma unroll
                for (int dt = 0; dt < 2; ++dt) {
                    const LAS bf16* vp = VT + (32 * dt + r) * VP + 32 * kt + 16 * s + 4 * h;
                    const v2u lo = *(const LAS v2u*)vp, hi = *(const LAS v2u*)(vp + 8);
                    v4u vw; vw.x = lo.x; vw.y = lo.y; vw.z = hi.x; vw.w = hi.y;
                    o[dt] = MFMA32(__builtin_bit_cast(bf16x8, vw), pb, o[dt]);
                }
            }
        }
    }
    const float inv = 1.f / sum;
#pragma unroll
    for (int dt = 0; dt < 2; ++dt)
#pragma unroll
        for (int g4 = 0; g4 < 4; ++g4) {
            const int d0 = 32 * dt + 8 * g4 + 4 * h;
            float g0, g1, g2, g3;
            { const v2u gp = gpre[dt][g4]; g0 = bflo(gp.x); g1 = bfhi(gp.x); g2 = bflo(gp.y); g3 = bfhi(gp.y); }
            v2u w; w.x = pk2(o[dt][4 * g4 + 0] * inv * siluf_(g0), o[dt][4 * g4 + 1] * inv * siluf_(g1));
            w.y = pk2(o[dt][4 * g4 + 2] * inv * siluf_(g2), o[dt][4 * g4 + 3] * inv * siluf_(g3));
            *(v2u*)(mix + (size_t)(q0 + r) * D + RW + hq * 64 + d0) = w;
        }
}

struct Prep { float r[8], kp[8], v[8], g[8], w[8], lw[8], kk[8], b[8], bonus; };
__device__ __forceinline__ void rwkv_prep(const Args& a, LAS unsigned char* lds, int h, int t0, int tid, int wave, int lane, Prep& P) {
    const bf16* proj = (const bf16*)(a.ws + WS_PROJ); const bf16* upt = (const bf16*)(a.ws + WS_UPT); const bf16* aupt = upt + 65536;
    LAS bf16* TW = (LAS bf16*)lds; LAS bf16* ADm = TW + 64 * 72; LAS float* Z = (LAS float*)(lds + 18432); LAS float* AP = Z + 64 * 68;
    const int t = tid >> 3, c8 = (tid & 7) * 8, ch = h * 64 + c8, row = t0 + t;
    const float* mu = a.in[3];
    { float x[8]; load_shift8(proj, row, C_WD + c8, mu, x);
#pragma unroll
      for (int j = 0; j < 8; ++j) x[j] = 1.f - 2.f * __builtin_amdgcn_rcpf(1.f + __expf(2.f * x[j]));
      *(LAS v4u*)(TW + t * 72 + c8) = pack8(x);
      load_shift8(proj, row, C_AD + c8, mu, x); *(LAS v4u*)(ADm + t * 72 + c8) = pack8(x); }
    bar_lds();
    { const int rt = wave & 3, cp = (wave >> 2) * 2, fr = lane & 15, fq = lane >> 4;
      bf16x8 aT[2], aA[2];
#pragma unroll
      for (int s = 0; s < 2; ++s) { aT[s] = *(const LAS bf16x8*)(TW + (16 * rt + fr) * 72 + 32 * s + 8 * fq); aA[s] = *(const LAS bf16x8*)(ADm + (16 * rt + fr) * 72 + 32 * s + 8 * fq); }
#pragma unroll
      for (int ci = 0; ci < 2; ++ci) { const int ct = cp + ci; f32x4 z = {0.f, 0.f, 0.f, 0.f}, ap = {0.f, 0.f, 0.f, 0.f};
#pragma unroll
          for (int s = 0; s < 2; ++s) { const size_t bo = (size_t)(h * 64 + 16 * ct + fr) * 64 + 32 * s + 8 * fq;
              z = MFMA16(aT[s], *(const bf16x8*)(upt + bo), z); ap = MFMA16(aA[s], *(const bf16x8*)(aupt + bo), ap); }
#pragma unroll
          for (int j = 0; j < 4; ++j) { Z[(16 * rt + 4 * fq + j) * 68 + 16 * ct + fr] = z[j]; AP[(16 * rt + 4 * fq + j) * 68 + 16 * ct + fr] = ap[j]; } } }
    bar_lds();
    float zz[8], aa[8], kr[8], c0[8], c1[8];
#pragma unroll
    for (int j = 0; j < 8; ++j) { zz[j] = Z[t * 68 + c8 + j]; aa[j] = AP[t * 68 + c8 + j]; }
    load_shift8(proj, row, C_R + ch, mu, P.r); load_shift8(proj, row, C_K + ch, mu, kr); load_shift8(proj, row, C_V + ch, mu, P.v); load_shift8(proj, row, C_G + ch, mu, P.g);
    ld8f(a.in[4] + ch, c0); ld8f(a.in[6] + ch, c1);
#pragma unroll
    for (int j = 0; j < 8; ++j) { const float z = c0[j] + zz[j]; const float sp = (z < -15.f) ? -z : __logf(1.f + __expf(-z)); const float wl = -sp - 0.5f; P.lw[j] = -__expf(wl); P.w[j] = __expf(P.lw[j]); aa[j] = sigmoidf_(c1[j] + aa[j]); }
    ld8f(a.in[8] + ch, c0); ld8f(a.in[9] + ch, c1);
    float ss = 0.f;
#pragma unroll
    for (int j = 0; j < 8; ++j) { P.kk[j] = kr[j] * c0[j]; ss += P.kk[j] * P.kk[j]; P.kp[j] = kr[j] * (1.f + (aa[j] - 1.f) * c1[j]); }
    ss = sum8(ss); const float rn = 1.f / fmaxf(sqrtf(ss), 1e-12f);
    ld8f(a.in[10] + ch, c0);
    float bs = 0.f;
#pragma unroll
    for (int j = 0; j < 8; ++j) { P.kk[j] *= rn; P.b[j] = P.kk[j] * aa[j]; bs += P.r[j] * P.kp[j] * c0[j]; }
    P.bonus = sum8(bs);
}
__device__ __forceinline__ void rwkv_out8(const Args& a, const float (&y)[8], const float (&v)[8], const float (&g)[8], float bonus, int row, int ch) {
    bf16* mix = (bf16*)(a.ws + WS_MIX);
    float s = 0.f;
#pragma unroll
    for (int j = 0; j < 8; ++j) s += y[j];
    const float mean = sum8(s) * (1.f / 64.f); float q = 0.f;
#pragma unroll
    for (int j = 0; j < 8; ++j) { const float d = y[j] - mean; q += d * d; }
    const float rstd = 1.f / sqrtf(sum8(q) * (1.f / 64.f) + LNX_EPS);
    float lg[8], lb[8], o[8]; ld8f(a.in[11] + ch, lg); ld8f(a.in[12] + ch, lb);
#pragma unroll
    for (int j = 0; j < 8; ++j) { const float yn = (y[j] - mean) * rstd * lg[j] + lb[j] + bonus * v[j]; o[j] = yn * siluf_(g[j]); }
    *(v4u*)(mix + (size_t)row * D + ch) = pack8(o);
}
constexpr size_t WS_MF = 174 * MiB, WS_QF = 190 * MiB, WS_SF = 206 * MiB, WS_BON = 222 * MiB;
constexpr size_t OUT_NF = 0, OUT_Y2 = 32 * MiB;
constexpr int MP = 72;
constexpr int L_AT = 0, L_ATT = 9216, L_BT = 18432, L_KT = 27648, L_RT = 36864, L_BHT = 46080, L_KHT = 55296, L_VT = 64512, L_LW = 73728, L_P = 73728, L_PT = 82944,
              L_AAK = 92160, L_ARB = 101376, L_ARK = 110592, L_TM = 119808, L_SEG = 119808, L_GC = 129024, L_WT = L_AT, L_X1T = L_BT, L_U2T = L_KT;
struct WTile { int ta, tb0, fr, fq; };
__device__ __forceinline__ bf16x8 ldfrag(const LAS bf16* M, int tile, int s, const WTile& w) { return *(const LAS bf16x8*)(M + (16 * tile + w.fr) * MP + 32 * s + 8 * w.fq); }
__device__ __forceinline__ void mm2(const LAS bf16* A, const LAS bf16* B, const WTile& w, f32x4 (&acc)[2]) {
#pragma unroll
    for (int s = 0; s < 2; ++s) { const bf16x8 af = ldfrag(A, w.ta, s, w);
#pragma unroll
        for (int ci = 0; ci < 2; ++ci) acc[ci] = MFMA16(af, ldfrag(B, w.tb0 + ci, s, w), acc[ci]); }
}
__device__ __forceinline__ void st_T(LAS bf16* X, int ta, int tb, const WTile& w, const f32x4& v) { v2u o; o.x = pk2(v[0], v[1]); o.y = pk2(v[2], v[3]); *(LAS v2u*)(X + (16 * tb + w.fr) * MP + 16 * ta + 4 * w.fq) = o; }
__device__ __forceinline__ void st_N(LAS bf16* X, int ta, int tb, const WTile& w, const f32x4& v) {
    const unsigned a = pk2(v[0], v[1]), b = pk2(v[2], v[3]); LAS bf16* p = X + (16 * ta + 4 * w.fq) * MP + 16 * tb + w.fr;
    p[0] = (bf16)(a & 0xffffu); p[MP] = (bf16)(a >> 16); p[2 * MP] = (bf16)(b & 0xffffu); p[3 * MP] = (bf16)(b >> 16);
}
#define ZERO2(x) do { x[0] = (f32x4){0.f, 0.f, 0.f, 0.f}; x[1] = (f32x4){0.f, 0.f, 0.f, 0.f}; } while (0)
template <int MODE> __device__ __forceinline__ void mask2(f32x4 (&acc)[2], const WTile& w) {
#pragma unroll
    for (int ci = 0; ci < 2; ++ci)
#pragma unroll
        for (int j = 0; j < 4; ++j) { const int row = 16 * w.ta + 4 * w.fq + j, col = 16 * (w.tb0 + ci) + w.fr;
            const bool keep = MODE == 0 ? (row < col) : (MODE == 1 ? (row <= col) : (col < row)); if (!keep) acc[ci][j] = 0.f; }
}
__device__ __forceinline__ void st_bf16x8_T(LAS bf16* X, int c8, int t, const float (&v)[8]) {
    const v4u p = pack8(v); const unsigned w[4] = {p.x, p.y, p.z, p.w};
#pragma unroll
    for (int j = 0; j < 4; ++j) { X[(c8 + 2 * j) * MP + t] = (bf16)(w[j] & 0xffffu); X[(c8 + 2 * j + 1) * MP + t] = (bf16)(w[j] >> 16); }
}

__device__ __forceinline__ void rwkv_chunk_prep(const Args& a, LAS unsigned char* lds, int unit, int tid, int wave, int lane) {
    const int c = unit >> 4, h = unit & 15, t0 = c * CH, t = tid >> 3, c8 = (tid & 7) * 8;
    LAS bf16* At = (LAS bf16*)(lds + L_AT); LAS bf16* AtT = (LAS bf16*)(lds + L_ATT); LAS bf16* Bt = (LAS bf16*)(lds + L_BT); LAS bf16* Kt = (LAS bf16*)(lds + L_KT);
    LAS bf16* Rt = (LAS bf16*)(lds + L_RT); LAS bf16* BhT = (LAS bf16*)(lds + L_BHT); LAS bf16* KhT = (LAS bf16*)(lds + L_KHT); LAS bf16* VT = (LAS bf16*)(lds + L_VT);
    LAS float* LW = (LAS float*)(lds + L_LW); LAS bf16* Pm = (LAS bf16*)(lds + L_P); LAS bf16* PT = (LAS bf16*)(lds + L_PT);
    LAS bf16* AAK = (LAS bf16*)(lds + L_AAK); LAS bf16* ARB = (LAS bf16*)(lds + L_ARB); LAS bf16* ARK = (LAS bf16*)(lds + L_ARK); LAS bf16* TM = (LAS bf16*)(lds + L_TM);
    LAS float* SEG = (LAS float*)(lds + L_SEG); LAS float* GC = (LAS float*)(lds + L_GC);
    LAS bf16* WT = (LAS bf16*)(lds + L_WT); LAS bf16* X1T = (LAS bf16*)(lds + L_X1T); LAS bf16* U2T = (LAS bf16*)(lds + L_U2T);
    bar_lds();
    Prep P; rwkv_prep(a, lds, h, t0, tid, wave, lane, P);
#ifdef PROBE_PREP2
    bar_lds(); rwkv_prep(a, lds, h, t0, tid, wave, lane, P);
#endif
    if ((tid & 7) == 0) ((float*)(a.ws + WS_BON))[(size_t)(t0 + t) * 16 + h] = P.bonus;
#pragma unroll
    for (int j = 0; j < 8; ++j) LW[t * 68 + c8 + j] = P.lw[j];
    bar_lds();
    { const int cc = tid & 63, sg = tid >> 6; float run = 0.f;
#pragma unroll
      for (int i = 0; i < 8; ++i) { run += LW[(8 * sg + i) * 68 + cc]; LW[(8 * sg + i) * 68 + cc] = run; }
      SEG[sg * 64 + cc] = run; }
    bar_lds();
    {
        float Lt[8], LC[8];
#pragma unroll
        for (int j = 0; j < 8; ++j) { float off = 0.f, tot = 0.f;
#pragma unroll
            for (int s = 0; s < 8; ++s) { const float sv = SEG[s * 64 + c8 + j]; tot += sv; if (s < (t >> 3)) off += sv; }
            Lt[j] = LW[t * 68 + c8 + j] + off; LC[j] = tot; }
        if (t == 0) {
#pragma unroll
            for (int j = 0; j < 8; ++j) GC[c8 + j] = __expf(LC[j]); }
        float x[8], y[8];
#pragma unroll
        for (int j = 0; j < 8; ++j) x[j] = -P.kk[j] * __expf(Lt[j] - P.lw[j]);
        *(LAS v4u*)(At + t * MP + c8) = pack8(x); st_bf16x8_T(AtT, c8, t, x);
#pragma unroll
        for (int j = 0; j < 8; ++j) { const float e = __expf(-Lt[j]); x[j] = P.b[j] * e; y[j] = P.kp[j] * e; }
        *(LAS v4u*)(Bt + t * MP + c8) = pack8(x); *(LAS v4u*)(Kt + t * MP + c8) = pack8(y);
#pragma unroll
        for (int j = 0; j < 8; ++j) x[j] = P.r[j] * __expf(Lt[j]);
        *(LAS v4u*)(Rt + t * MP + c8) = pack8(x);
#pragma unroll
        for (int j = 0; j < 8; ++j) { const float e = __expf(LC[j] - Lt[j]); x[j] = P.b[j] * e; y[j] = P.kp[j] * e; }
        st_bf16x8_T(BhT, c8, t, x); st_bf16x8_T(KhT, c8, t, y); st_bf16x8_T(VT, c8, t, P.v);
    }
    bar_lds();
    WTile w; w.ta = wave & 3; w.tb0 = (wave >> 2) * 2; w.fr = lane & 15; w.fq = lane >> 4;
    f32x4 acc[2], Tacc[2];
    ZERO2(Tacc); mm2(At, Bt, w, Tacc); mask2<2>(Tacc, w);
    ZERO2(acc); mm2(Kt, At, w, acc); mask2<0>(acc, w);
    f32x4 rb[2], rk[2]; ZERO2(rb); mm2(Bt, Rt, w, rb); mask2<1>(rb, w); ZERO2(rk); mm2(Kt, Rt, w, rk); mask2<1>(rk, w);
    bar_lds();
#pragma unroll
    for (int ci = 0; ci < 2; ++ci) { st_N(Pm, w.ta, w.tb0 + ci, w, Tacc[ci]); st_T(PT, w.ta, w.tb0 + ci, w, Tacc[ci]);
        st_T(AAK, w.ta, w.tb0 + ci, w, acc[ci]); st_T(ARB, w.ta, w.tb0 + ci, w, rb[ci]); st_T(ARK, w.ta, w.tb0 + ci, w, rk[ci]);
#pragma unroll
        for (int j = 0; j < 4; ++j) if (16 * w.ta + 4 * w.fq + j == 16 * (w.tb0 + ci) + w.fr) Tacc[ci][j] += 1.f;
        st_N(TM, w.ta, w.tb0 + ci, w, Tacc[ci]); }
    bar_lds();
#pragma unroll 1
#ifdef PROBE_NEU2
    for (int n = 0; n < 10; ++n) {
#else
    for (int n = 0; n < 5; ++n) {
#endif
        ZERO2(acc); mm2(Pm, PT, w, acc);
        bar_lds();
#pragma unroll
        for (int ci = 0; ci < 2; ++ci) { st_N(Pm, w.ta, w.tb0 + ci, w, acc[ci]); st_T(PT, w.ta, w.tb0 + ci, w, acc[ci]); }
        bar_lds();
        mm2(TM, PT, w, Tacc);
        bar_lds();
#pragma unroll
        for (int ci = 0; ci < 2; ++ci) st_N(TM, w.ta, w.tb0 + ci, w, Tacc[ci]);
        bar_lds();
    }
    ZERO2(acc); mm2(TM, AtT, w, acc); ZERO2(rb); mm2(AAK, VT, w, rb);
#pragma unroll
    for (int ci = 0; ci < 2; ++ci) { st_T(WT, w.ta, w.tb0 + ci, w, acc[ci]); st_T(X1T, w.ta, w.tb0 + ci, w, rb[ci]); }
    bar_lds();
    const size_t ub = (size_t)unit * 4096;
    { ZERO2(acc); mm2(TM, X1T, w, acc);
#pragma unroll
      for (int ci = 0; ci < 2; ++ci) st_T(U2T, w.ta, w.tb0 + ci, w, acc[ci]);
      bf16* MF = (bf16*)(a.ws + WS_MF) + ub; bf16* QF = (bf16*)(a.ws + WS_QF) + ub;
      ZERO2(acc); mm2(WT, BhT, w, acc);
      ZERO2(rb); mm2(WT, ARB, w, rb);
#pragma unroll
      for (int ci = 0; ci < 2; ++ci) { const int tb = w.tb0 + ci; const int col = 16 * tb + w.fr; const float gc = GC[col];
          f32x4 m = acc[ci];
#pragma unroll
          for (int j = 0; j < 4; ++j) if (16 * w.ta + 4 * w.fq + j == col) m[j] += gc;
          const size_t fo = (size_t)((tb * 2 + (w.ta >> 1)) * 64 + lane) * 8 + 4 * (w.ta & 1);
          v2u o; o.x = pk2(m[0], m[1]); o.y = pk2(m[2], m[3]); *(v2u*)(MF + fo) = o;
          const v2u rr = *(const LAS v2u*)(Rt + col * MP + 16 * w.ta + 4 * w.fq);
          f32x4 q = rb[ci]; q[0] += bflo(rr.x); q[1] += bfhi(rr.x); q[2] += bflo(rr.y); q[3] += bfhi(rr.y);
          o.x = pk2(q[0], q[1]); o.y = pk2(q[2], q[3]); *(v2u*)(QF + fo) = o; } }
    bar_lds();
    { float* NF = (float*)((unsigned char*)a.out + OUT_NF) + ub; float* Y2 = (float*)((unsigned char*)a.out + OUT_Y2) + ub;
      ZERO2(acc); mm2(BhT, U2T, w, acc); mm2(KhT, VT, w, acc);
      ZERO2(rb); mm2(U2T, ARB, w, rb); mm2(VT, ARK, w, rb);
#pragma unroll
      for (int ci = 0; ci < 2; ++ci) { const int tb = w.tb0 + ci;
          *(f32x4*)(NF + (size_t)((tb * 4 + w.ta) * 64 + lane) * 4) = acc[ci];
          *(f32x4*)(Y2 + (size_t)(16 * tb + w.fr) * 64 + 16 * w.ta + 4 * w.fq) = rb[ci]; } }
}

constexpr int KR = 4, NR = NCH / KR, SLOT = 10240, RBUF = KR * SLOT, NPIECE = RBUF / 16, LPT = 6, PPC = SLOT / 16;
__device__ __forceinline__ const v4u* sp_src(const Args& a, int h, int cg, int r, int p) {
    const int cc = p / PPC, q = p % PPC, c = r * KR + cc; const size_t ub = (size_t)(c * 16 + h) * 4096;
    return q < 512 ? (const v4u*)((const bf16*)(a.ws + WS_MF) + ub) + q : (const v4u*)((const bf16*)((const unsigned char*)a.out + OUT_NF) + ub + cg * 1024) + (q - 512);
}
__device__ __forceinline__ void state_pass(const Args& a, LAS unsigned char* lds, int b, int tid, int wave, int lane) {
    const int h = b >> 2, cg = b & 3, lt = tid - 64;
    v4u ra[LPT], rb[LPT];
    if (wave != 0) {
#pragma unroll
        for (int i = 0; i < LPT; ++i) { const int p = lt + 448 * i; if (p < NPIECE) ra[i] = *sp_src(a, h, cg, 0, p); }
#pragma unroll
        for (int i = 0; i < LPT; ++i) { const int p = lt + 448 * i; if (p < NPIECE) *(LAS v4u*)(lds + p * 16) = ra[i]; }
#pragma unroll
        for (int i = 0; i < LPT; ++i) { const int p = lt + 448 * i; if (p < NPIECE) ra[i] = *sp_src(a, h, cg, 1, p); }
    }
    f32x4 st[4];
#pragma unroll
    for (int i = 0; i < 4; ++i) st[i] = (f32x4){0.f, 0.f, 0.f, 0.f};
    bar_lds();
    bf16* SF = (bf16*)(a.ws + WS_SF);
#define SP_ROUND(r_, RA, RB) do { \
        if (wave != 0) { \
            if ((r_) + 2 < NR) { _Pragma("unroll") for (int i = 0; i < LPT; ++i) { const int p = lt + 448 * i; if (p < NPIECE) RB[i] = *sp_src(a, h, cg, (r_) + 2, p); } } \
            if ((r_) + 1 < NR) { _Pragma("unroll") for (int i = 0; i < LPT; ++i) { const int p = lt + 448 * i; if (p < NPIECE) *(LAS v4u*)(lds + (((r_) + 1) & 1) * RBUF + p * 16) = RA[i]; } } \
        } else { \
            _Pragma("unroll") for (int cc = 0; cc < KR; ++cc) { \
                const LAS unsigned char* sl = lds + ((r_) & 1) * RBUF + cc * SLOT; const int c = (r_) * KR + cc; \
                v4u b0, b1; b0.x = pk2(st[0][0], st[0][1]); b0.y = pk2(st[0][2], st[0][3]); b0.z = pk2(st[1][0], st[1][1]); b0.w = pk2(st[1][2], st[1][3]); \
                b1.x = pk2(st[2][0], st[2][1]); b1.y = pk2(st[2][2], st[2][3]); b1.z = pk2(st[3][0], st[3][1]); b1.w = pk2(st[3][2], st[3][3]); \
                v4u* sfo = (v4u*)(SF + (size_t)(c * 16 + h) * 4096) + (cg * 2) * 64 + lane; sfo[0] = b0; sfo[64] = b1; \
                const bf16x8 f0 = __builtin_bit_cast(bf16x8, b0), f1 = __builtin_bit_cast(bf16x8, b1); \
                _Pragma("unroll") for (int rt = 0; rt < 4; ++rt) { \
                    const v2u nb_ = *(const LAS v2u*)(sl + 8192 + (rt * 64 + lane) * 8); f32x4 n = {bflo(nb_.x), bfhi(nb_.x), bflo(nb_.y), bfhi(nb_.y)}; \
                    n = MFMA16(*(const LAS bf16x8*)(sl + ((rt * 2 + 0) * 64 + lane) * 16), f0, n); \
                    n = MFMA16(*(const LAS bf16x8*)(sl + ((rt * 2 + 1) * 64 + lane) * 16), f1, n); st[rt] = n; } \
            } \
        } \
        bar_lds(); } while (0)
#pragma unroll 1
    for (int r = 0; r < NR; r += 2) { SP_ROUND(r, ra, rb); SP_ROUND(r + 1, rb, ra); }
#undef SP_ROUND
}

__device__ __forceinline__ void rwkv_out_unit(const Args& a, LAS unsigned char* lds, int unit, int tid, int wave, int lane) {
    const int c = unit >> 4, h = unit & 15, t0 = c * CH, t = tid >> 3, c8 = (tid & 7) * 8, ch = h * 64 + c8;
    const size_t ub = (size_t)unit * 4096;
    const bf16* QF = (const bf16*)(a.ws + WS_QF) + ub; const bf16* SF = (const bf16*)(a.ws + WS_SF) + ub; const bf16* Y2 = (const bf16*)((const unsigned char*)a.out + OUT_Y2) + ub;
    LAS float* SY = (LAS float*)lds;
    const int ta = wave & 3, tb0 = (wave >> 2) * 2, fr = lane & 15, fq = lane >> 4;
    bf16x8 af[2], bfr[2][2];
#pragma unroll
    for (int s = 0; s < 2; ++s) { af[s] = *(const bf16x8*)(QF + (size_t)((ta * 2 + s) * 64 + lane) * 8);
#pragma unroll
        for (int ci = 0; ci < 2; ++ci) bfr[s][ci] = *(const bf16x8*)(SF + (size_t)(((tb0 + ci) * 2 + s) * 64 + lane) * 8); }
    float y2[8], v[8], g[8];
    unpack8(ldg16(Y2 + t * 64 + c8), y2);
    const bf16* proj = (const bf16*)(a.ws + WS_PROJ);
    load_shift8(proj, t0 + t, C_V + ch, a.in[3], v); load_shift8(proj, t0 + t, C_G + ch, a.in[3], g);
    const float bonus = ((const float*)(a.ws + WS_BON))[(size_t)(t0 + t) * 16 + h];
    f32x4 acc[2]; ZERO2(acc);
#pragma unroll
    for (int s = 0; s < 2; ++s)
#pragma unroll
        for (int ci = 0; ci < 2; ++ci) acc[ci] = MFMA16(af[s], bfr[s][ci], acc[ci]);
    bar_lds();
#pragma unroll
    for (int ci = 0; ci < 2; ++ci)
#pragma unroll
        for (int j = 0; j < 4; ++j) SY[(16 * ta + 4 * fq + j) * 68 + 16 * (tb0 + ci) + fr] = acc[ci][j];
    bar_lds();
    float y[8];
#pragma unroll
    for (int j = 0; j < 8; ++j) y[j] = SY[t * 68 + c8 + j] + y2[j];
    rwkv_out8(a, y, v, g, bonus, t0 + t, ch);
}
constexpr int L2_SEG = 129280, L2_XST = 131328, L2_TW = 131584, L2_ADM = 140800, L2_X1T = 150016;
struct PF { v4u p[4], q[4]; };
__device__ __forceinline__ void pf_issue(PF& f, const bf16* proj, int row, int ch) {
    const int cols[4] = {C_R, C_K, C_V, C_G};
#pragma unroll
    for (int i = 0; i < 4; ++i) { f.p[i] = ldg16(proj + (size_t)row * NINP + cols[i] + ch); f.q[i] = (v4u){0u, 0u, 0u, 0u}; if (row > 0) f.q[i] = ldg16(proj + (size_t)(row - 1) * NINP + cols[i] + ch); }
}
__device__ __forceinline__ void pf_shift(const v4u& p, const v4u& q, const float (&mf)[8], float (&o)[8]) {
    float pf[8], qf[8]; unpack8(p, pf); unpack8(q, qf);
#pragma unroll
    for (int j = 0; j < 8; ++j) o[j] = pf[j] + (qf[j] - pf[j]) * mf[j];
}
template <bool DOP, bool DOT> __device__ __forceinline__ void neu_stage(const LAS bf16* Pin, const LAS bf16* PTin, LAS bf16* Pout, LAS bf16* PTout, const LAS bf16* TMin, LAS bf16* TMout, const WTile& w, f32x4 (&Tacc)[2]) {
    f32x4 acc[2];
    if (DOP) { ZERO2(acc); mm2(Pin, PTin, w, acc); }
    if (DOT) mm2(TMin, PTin, w, Tacc);
#pragma unroll
    for (int ci = 0; ci < 2; ++ci) {
        if (DOP) { st_N(Pout, w.ta, w.tb0 + ci, w, acc[ci]); st_T(PTout, w.ta, w.tb0 + ci, w, acc[ci]); }
        if (DOT) st_N(TMout, w.ta, w.tb0 + ci, w, Tacc[ci]);
    }
    bar_lds();
}
__device__ __forceinline__ void rwkv_chunk_group(const Args& a, LAS unsigned char* lds, int item, int tid, int wave, int lane) {
    const int c = item >> 1, hg = item & 1, t0 = c * CH, t = tid >> 3, c8 = (tid & 7) * 8, row = t0 + t;
    const bf16* proj = (const bf16*)(a.ws + WS_PROJ); const bf16* upt = (const bf16*)(a.ws + WS_UPT); const bf16* aupt = upt + 65536; const float* mu = a.in[3];
    LAS bf16* TW = (LAS bf16*)(lds + L2_TW); LAS bf16* ADm = (LAS bf16*)(lds + L2_ADM);
    WTile w; w.ta = wave & 3; w.tb0 = (wave >> 2) * 2; w.fr = lane & 15; w.fq = lane >> 4;
    bar_lds();
    { float x[8]; load_shift8(proj, row, C_WD + c8, mu, x);
#pragma unroll
      for (int j = 0; j < 8; ++j) x[j] = 1.f - 2.f * __builtin_amdgcn_rcpf(1.f + __expf(2.f * x[j]));
      *(LAS v4u*)(TW + t * 72 + c8) = pack8(x);
      load_shift8(proj, row, C_AD + c8, mu, x); *(LAS v4u*)(ADm + t * 72 + c8) = pack8(x); }
    PF pf; pf_issue(pf, proj, row, hg * 512 + c8);
#pragma unroll 1
    for (int hh = 0; hh < 8; ++hh) {
        const int h = hg * 8 + hh, ch = h * 64 + c8, unit = c * 16 + h;
        LAS unsigned char* L = lds; asm volatile("" : "+v"(L));
        LAS bf16* At = (LAS bf16*)(L + L_AT); LAS bf16* AtT = (LAS bf16*)(L + L_ATT); LAS bf16* Bt = (LAS bf16*)(L + L_BT); LAS bf16* Kt = (LAS bf16*)(L + L_KT);
        LAS bf16* Rt = (LAS bf16*)(L + L_RT); LAS bf16* BhT = (LAS bf16*)(L + L_BHT); LAS bf16* KhT = (LAS bf16*)(L + L_KHT); LAS bf16* VT = (LAS bf16*)(L + L_VT);
        LAS bf16* P0 = (LAS bf16*)(L + L_P); LAS bf16* PT0 = (LAS bf16*)(L + L_PT); LAS bf16* TM0 = (LAS bf16*)(L + L_TM);
        LAS bf16* P1 = At; LAS bf16* PT1 = Bt; LAS bf16* TM1 = Kt;
        LAS bf16* AAK = (LAS bf16*)(L + L_AAK); LAS bf16* ARB = (LAS bf16*)(L + L_ARB); LAS bf16* ARK = (LAS bf16*)(L + L_ARK);
        LAS float* SEG = (LAS float*)(L + L2_SEG); LAS float* GC = (LAS float*)(L + L_GC);
        LAS bf16* X1T = (LAS bf16*)(L + L2_X1T);
        LAS float* Z = (LAS float*)(L + 18432); LAS float* AP = Z + 64 * 68;
        LAS bf16* WT = At; LAS bf16* U2T = Bt;
        bf16x8 bU[2][2], bA[2][2];
#pragma unroll
        for (int ci = 0; ci < 2; ++ci)
#pragma unroll
            for (int s = 0; s < 2; ++s) { const size_t bo = (size_t)(h * 64 + 16 * (w.tb0 + ci) + w.fr) * 64 + 32 * s + 8 * w.fq; bU[ci][s] = *(const bf16x8*)(upt + bo); bA[ci][s] = *(const bf16x8*)(aupt + bo); }
        float pw0[8], pa0[8], pkk[8], pka[8], prk[8], mur[8], muk[8], muv[8];
        ld8f(a.in[4] + ch, pw0); ld8f(a.in[6] + ch, pa0); ld8f(a.in[8] + ch, pkk); ld8f(a.in[9] + ch, pka); ld8f(a.in[10] + ch, prk);
        ld8f(mu + C_R + ch, mur); ld8f(mu + C_K + ch, muk); ld8f(mu + C_V + ch, muv);
        bar_lds();
#ifdef PROBE_G
        if (blockIdx.x == 0 && tid == 0 && hh == 3) ((unsigned long long*)(a.ws + 65536))[0] = __builtin_amdgcn_s_memrealtime();
#endif

        { const int rt = w.ta, cp = w.tb0, fr = w.fr, fq = w.fq;
          bf16x8 aT[2], aA[2];
#pragma unroll
          for (int s = 0; s < 2; ++s) { aT[s] = *(const LAS bf16x8*)(TW + (16 * rt + fr) * 72 + 32 * s + 8 * fq); aA[s] = *(const LAS bf16x8*)(ADm + (16 * rt + fr) * 72 + 32 * s + 8 * fq); }
#pragma unroll
          for (int ci = 0; ci < 2; ++ci) { const int ct = cp + ci; f32x4 z = {0.f, 0.f, 0.f, 0.f}, ap = {0.f, 0.f, 0.f, 0.f};
#pragma unroll
              for (int s = 0; s < 2; ++s) { z = MFMA16(aT[s], bU[ci][s], z); ap = MFMA16(aA[s], bA[ci][s], ap); }
#pragma unroll
              for (int j = 0; j < 4; ++j) { Z[(16 * rt + 4 * fq + j) * 68 + 16 * ct + fr] = z[j]; AP[(16 * rt + 4 * fq + j) * 68 + 16 * ct + fr] = ap[j]; } } }
        bar_lds();
#ifdef PROBE_G
        if (blockIdx.x == 0 && tid == 0 && hh == 3) ((unsigned long long*)(a.ws + 65536))[1] = __builtin_amdgcn_s_memrealtime();
#endif
        float r[8], kp[8], vv[8], lw[8], wd[8], kk[8], bb[8];
        { float zz[8], aa[8], kr[8];
#pragma unroll
          for (int j = 0; j < 8; ++j) { zz[j] = Z[t * 68 + c8 + j]; aa[j] = AP[t * 68 + c8 + j]; }
          pf_shift(pf.p[0], pf.q[0], mur, r); pf_shift(pf.p[1], pf.q[1], muk, kr); pf_shift(pf.p[2], pf.q[2], muv, vv);
#pragma unroll
          for (int j = 0; j < 8; ++j) { const float z = pw0[j] + zz[j]; const float sp = (z < -15.f) ? -z : __logf(1.f + __expf(-z)); lw[j] = -__expf(-sp - 0.5f); wd[j] = __expf(lw[j]); aa[j] = sigmoidf_(pa0[j] + aa[j]); }
          float ss = 0.f;
#pragma unroll
          for (int j = 0; j < 8; ++j) { kk[j] = kr[j] * pkk[j]; ss += kk[j] * kk[j]; kp[j] = kr[j] * (1.f + (aa[j] - 1.f) * pka[j]); }
          ss = sum8(ss); const float rn = 1.f / fmaxf(sqrtf(ss), 1e-12f);
          float bs = 0.f;
#pragma unroll
          for (int j = 0; j < 8; ++j) { kk[j] *= rn; bb[j] = kk[j] * aa[j]; bs += r[j] * kp[j] * prk[j]; }
          bs = sum8(bs);
          if ((tid & 7) == 0) ((float*)(a.ws + WS_BON))[(size_t)row * 16 + h] = bs; }
        if (hh < 7) pf_issue(pf, proj, row, ch + 64);
        float Lt[8];
#pragma unroll
        for (int j = 0; j < 8; ++j) { float x = lw[j];
#pragma unroll
            for (int d = 8; d < 64; d <<= 1) { const float y = __shfl_up(x, d); if (lane >= d) x += y; }
            Lt[j] = x; }
        if ((lane >> 3) == 7) {
#pragma unroll
            for (int j = 0; j < 8; ++j) SEG[wave * 64 + c8 + j] = Lt[j]; }
        bar_lds();
        {
            float gc[8], x[8], y[8];
            { float off[8], tot[8];
#pragma unroll
              for (int j = 0; j < 8; ++j) { off[j] = 0.f; tot[j] = 0.f; }
#pragma unroll
              for (int s = 0; s < 8; ++s) { const f32x4 s0 = *(const LAS f32x4*)(SEG + s * 64 + c8), s1 = *(const LAS f32x4*)(SEG + s * 64 + c8 + 4);
                  const float sv[8] = {s0.x, s0.y, s0.z, s0.w, s1.x, s1.y, s1.z, s1.w};
#pragma unroll
                  for (int j = 0; j < 8; ++j) { tot[j] += sv[j]; if (s < wave) off[j] += sv[j]; } }
#pragma unroll
              for (int j = 0; j < 8; ++j) { Lt[j] += off[j]; gc[j] = __expf(tot[j]); } }
            if (t == 0) {
#pragma unroll
                for (int j = 0; j < 8; ++j) GC[c8 + j] = gc[j]; }
            float e1[8], ie1[8];
#pragma unroll
            for (int j = 0; j < 8; ++j) { e1[j] = __expf(Lt[j]); ie1[j] = __builtin_amdgcn_rcpf(e1[j]); }
#pragma unroll
            for (int j = 0; j < 8; ++j) x[j] = -kk[j] * e1[j] * __builtin_amdgcn_rcpf(wd[j]);
            *(LAS v4u*)(At + t * MP + c8) = pack8(x); st_bf16x8_T(AtT, c8, t, x);
#pragma unroll
            for (int j = 0; j < 8; ++j) { x[j] = bb[j] * ie1[j]; y[j] = kp[j] * ie1[j]; }
            *(LAS v4u*)(Bt + t * MP + c8) = pack8(x); *(LAS v4u*)(Kt + t * MP + c8) = pack8(y);
#pragma unroll
            for (int j = 0; j < 8; ++j) x[j] = r[j] * e1[j];
            *(LAS v4u*)(Rt + t * MP + c8) = pack8(x);
#pragma unroll
            for (int j = 0; j < 8; ++j) { const float e = gc[j] * ie1[j]; x[j] = bb[j] * e; y[j] = kp[j] * e; }
            st_bf16x8_T(BhT, c8, t, x); st_bf16x8_T(KhT, c8, t, y); st_bf16x8_T(VT, c8, t, vv);
        }
        bar_lds();
#ifdef PROBE_G
        if (blockIdx.x == 0 && tid == 0 && hh == 3) ((unsigned long long*)(a.ws + 65536))[2] = __builtin_amdgcn_s_memrealtime();
#endif
        f32x4 acc[2], Tacc[2], rb[2], rk[2];
        ZERO2(Tacc); mm2(At, Bt, w, Tacc); mask2<2>(Tacc, w);
        ZERO2(acc); mm2(Kt, At, w, acc); mask2<0>(acc, w);
        ZERO2(rb); mm2(Bt, Rt, w, rb); mask2<1>(rb, w); ZERO2(rk); mm2(Kt, Rt, w, rk); mask2<1>(rk, w);
        bar_lds();
#pragma unroll
        for (int ci = 0; ci < 2; ++ci) { st_N(P1, w.ta, w.tb0 + ci, w, Tacc[ci]); st_T(PT1, w.ta, w.tb0 + ci, w, Tacc[ci]);
            st_T(AAK, w.ta, w.tb0 + ci, w, acc[ci]); st_T(ARB, w.ta, w.tb0 + ci, w, rb[ci]); st_T(ARK, w.ta, w.tb0 + ci, w, rk[ci]);
#pragma unroll
            for (int j = 0; j < 4; ++j) if (16 * w.ta + 4 * w.fq + j == 16 * (w.tb0 + ci) + w.fr) Tacc[ci][j] += 1.f;
            st_N(TM1, w.ta, w.tb0 + ci, w, Tacc[ci]); }
        bar_lds();
#ifdef PROBE_G
        if (blockIdx.x == 0 && tid == 0 && hh == 3) ((unsigned long long*)(a.ws + 65536))[3] = __builtin_amdgcn_s_memrealtime();
#endif
        { ZERO2(acc); mm2(AAK, VT, w, acc);
#pragma unroll
          for (int ci = 0; ci < 2; ++ci) st_T(X1T, w.ta, w.tb0 + ci, w, acc[ci]); }
        neu_stage<true, false>(P1, PT1, P0, PT0, nullptr, nullptr, w, Tacc);
#pragma unroll 1
        for (int n = 0; n < 2; ++n) {
            neu_stage<true, true>(P0, PT0, P1, PT1, TM1, TM0, w, Tacc);
            neu_stage<true, true>(P1, PT1, P0, PT0, TM0, TM1, w, Tacc);
        }
        neu_stage<false, true>(P0, PT0, nullptr, nullptr, TM1, TM0, w, Tacc);

#ifdef PROBE_G
        if (blockIdx.x == 0 && tid == 0 && hh == 3) ((unsigned long long*)(a.ws + 65536))[4] = __builtin_amdgcn_s_memrealtime();
#endif
        ZERO2(acc); mm2(TM0, AtT, w, acc); ZERO2(rb); mm2(TM0, X1T, w, rb);
#pragma unroll
        for (int ci = 0; ci < 2; ++ci) { st_T(WT, w.ta, w.tb0 + ci, w, acc[ci]); st_T(U2T, w.ta, w.tb0 + ci, w, rb[ci]); }
        bar_lds();
        const size_t ub = (size_t)unit * 4096;
        { bf16* MF = (bf16*)(a.ws + WS_MF) + ub; bf16* QF = (bf16*)(a.ws + WS_QF) + ub;
          ZERO2(acc); mm2(WT, BhT, w, acc); ZERO2(rb); mm2(WT, ARB, w, rb);
#pragma unroll
          for (int ci = 0; ci < 2; ++ci) { const int tb = w.tb0 + ci; const int col = 16 * tb + w.fr; const float gcv = GC[col];
              f32x4 m = acc[ci];
#pragma unroll
              for (int j = 0; j < 4; ++j) if (16 * w.ta + 4 * w.fq + j == col) m[j] += gcv;
              const size_t fo = (size_t)((tb * 2 + (w.ta >> 1)) * 64 + lane) * 8 + 4 * (w.ta & 1);
              v2u o; o.x = pk2(m[0], m[1]); o.y = pk2(m[2], m[3]); *(v2u*)(MF + fo) = o;
              const v2u rr = *(const LAS v2u*)(Rt + col * MP + 16 * w.ta + 4 * w.fq);
              f32x4 q = rb[ci]; q[0] += bflo(rr.x); q[1] += bfhi(rr.x); q[2] += bflo(rr.y); q[3] += bfhi(rr.y);
              o.x = pk2(q[0], q[1]); o.y = pk2(q[2], q[3]); *(v2u*)(QF + fo) = o; }
          bf16* NF = (bf16*)((unsigned char*)a.out + OUT_NF) + ub; bf16* Y2 = (bf16*)((unsigned char*)a.out + OUT_Y2) + ub;
          ZERO2(acc); mm2(BhT, U2T, w, acc); mm2(KhT, VT, w, acc);
          ZERO2(rb); mm2(U2T, ARB, w, rb); mm2(VT, ARK, w, rb);
#pragma unroll
          for (int ci = 0; ci < 2; ++ci) { const int tb = w.tb0 + ci;
              v2u o; o.x = pk2(acc[ci][0], acc[ci][1]); o.y = pk2(acc[ci][2], acc[ci][3]); *(v2u*)(NF + (size_t)((tb * 4 + w.ta) * 64 + lane) * 4) = o;
              o.x = pk2(rb[ci][0], rb[ci][1]); o.y = pk2(rb[ci][2], rb[ci][3]); *(v2u*)(Y2 + (size_t)(16 * tb + w.fr) * 64 + 16 * w.ta + 4 * w.fq) = o; } }

#ifdef PROBE_G
        if (blockIdx.x == 0 && tid == 0 && hh == 3) ((unsigned long long*)(a.ws + 65536))[5] = __builtin_amdgcn_s_memrealtime();
#endif
    }
}
#ifndef HOSTDUP
#define HOSTDUP -1
#endif
#ifndef ONE_LAUNCH
#define ONE_LAUNCH 1
#endif
#if HOSTDUP != -1 || defined(MULTI)
#undef ONE_LAUNCH
#define ONE_LAUNCH 0
#endif
constexpr int NPHASE = 7;
__global__ void __launch_bounds__(NTHR, 2) mega(Args a) {
    extern __shared__ __attribute__((aligned(16))) unsigned char lds_[];
    LAS unsigned char* lds = (LAS unsigned char*)lds_;
    const int tid = threadIdx.x, lane = tid & 63, wave = __builtin_amdgcn_readfirstlane(tid >> 6);
    const int G = gridDim.x, bx = blockIdx.x, vcu = (G % 8 == 0) ? (bx % 8) * (G / 8) + bx / 8 : bx;
    cg::grid_group grid = cg::this_grid();
    volatile LAS unsigned* xst = (volatile LAS unsigned*)(lds + L2_XST);
    if (tid < 2) xst[tid] = 0u;
    __syncthreads();
    XcdBarrier xbar; xbar.bar = (unsigned*)a.ws; xbar.x = 0; xbar.st = xst;
    if (a.ph_hi - a.ph_lo > 1) xbar = xcd_barrier_post((unsigned*)a.ws, xst);
#ifndef PROBE_Q
#define PROBE_Q 1
#endif
#ifdef PROBE_TS
    unsigned long long ts_[10];
#define STAMP(i) do { ts_[i] = __builtin_amdgcn_s_memrealtime(); } while (0)
#else
#define STAMP(i) do {} while (0)
#endif
    STAMP(0);
#define IN(k) (a.ph_lo <= (k) && (k) < a.ph_hi)
#define SEAM(k) do { if (IN(k) && IN((k) + 1)) xcd_barrier(xbar); } while (0)
    if (a.ph_lo < 0) grid.sync();
    if (IN(0)) { p0_prologue(a, lds, vcu, G, wave, lane); }
    SEAM(0); STAMP(1);
    if (IN(1)) {
        constexpr int N1 = 6144;
        pg8::Gemm g{(const pg8::bf16_t*)(a.ws + WS_XN), (const pg8::bf16_t*)(a.ws + WS_WTIN), T, (G == 256 ? N1 : NINP), D}; pg8::StaticOrder S; S.init(T, (G == 256 ? N1 : NINP), G, bx);
        pg8::EpiBf16<0> E{(pg8::bf16_t*)(a.ws + WS_PROJ), NINP, nullptr, 0, 0, 1.f};
        pg8::gemm_phase<pg8::EpiBf16<0>, pg8::StaticOrder, true, true>(lds, g, S, E);
    }
    SEAM(1); STAMP(2);
    if (IN(2)) {
        for (int it = bx; it < NCH * 2; it += G) rwkv_chunk_group(a, lds, it, tid, wave, lane);
    }
    SEAM(2); STAMP(3);
    if (IN(3)) {
        if (bx < 64) state_pass(a, lds, bx, tid, wave, lane);
        else if (G == 256 && bx < 128) {
            pg8::Gemm g{(const pg8::bf16_t*)(a.ws + WS_XN), (const pg8::bf16_t*)(a.ws + WS_WTIN), T, NINP, D}; pg8::OneTile S{(bx - 64) >> 1, 24 + ((bx - 64) & 1)};
            pg8::EpiBf16<0> E{(pg8::bf16_t*)(a.ws + WS_PROJ), NINP, nullptr, 0, 0, 1.f};
            pg8::gemm_phase<pg8::EpiBf16<0>, pg8::OneTile, true, true>(lds, g, S, E);
        } else if (G == 256) { for (int it = bx - 128; it < 256; it += 128) attn_unit(a, lds, 2 * it, tid, wave, lane); }
    }
    SEAM(3); STAMP(4);
    if (IN(4)) {
        if (G == 256) { for (int it = bx; it < 256; it += G) attn_unit(a, lds, 2 * it + 1, tid, wave, lane); }
        else { for (int it = bx; it < 512; it += G) attn_unit(a, lds, it, tid, wave, lane); }
        STAMP(8);
        for (int u = bx; u < NCH * NH; u += G) rwkv_out_unit(a, lds, u, tid, wave, lane);
    }
    SEAM(4); STAMP(5);
    if (IN(5)) {
        pg8::Gemm g{(const pg8::bf16_t*)(a.ws + WS_MIX), (const pg8::bf16_t*)(a.ws + WS_WTOUT), T, D, D}; pg8::StaticOrder S; S.init(T, D, G, bx);
        if (G == 256 && a.ph_hi - a.ph_lo > 1) {
            pg8::EpiResidNorm E{a.in[0], a.out, (float*)(a.ws + WS_SSP), (unsigned*)a.ws + 4096, a.in[15], D, RMS_EPS};
            pg8::gemm_phase<pg8::EpiResidNorm, pg8::StaticOrder, false, true>(lds, g, S, E);
        } else {
            pg8::EpiResid E{a.in[0], a.out, (float*)(a.ws + WS_SSP), D};
            pg8::gemm_phase<pg8::EpiResid, pg8::StaticOrder, true, true>(lds, g, S, E);
        }
    }
    if (!(G == 256 && a.ph_hi - a.ph_lo > 1)) { SEAM(5); } STAMP(6);
    if (IN(6) && !(G == 256 && a.ph_hi - a.ph_lo > 1)) final_norm(a, vcu, G, wave, lane);
#ifdef PROBE_G
    __syncthreads();
    if (bx == 0 && tid == 0) { const unsigned long long* g_ = (const unsigned long long*)(a.ws + 65536); a.out[0] = (float)(g_[PROBE_G + 1] - g_[PROBE_G]) * 0.1f; }
#endif
#ifdef PROBE_TS
    STAMP(7); __syncthreads();
    if (bx == 0 && tid == 0) { const int k_ = PROBE_TS; const unsigned long long d_ = (k_ == 8) ? ts_[8] - ts_[4] : ts_[k_ + 1] - ts_[k_]; a.out[0] = (float)(((int)((float)d_ * 0.01f) / PROBE_Q) * PROBE_Q + PROBE_Q / 2); }
#endif
#undef IN
#undef SEAM
}

extern "C" void kernel_launch(void* const* d_in, const int* in_sizes, int n_in, void* d_out, int out_size, void* d_ws, size_t ws_size, hipStream_t stream) {
    static int grid = 0;
    if (grid == 0) {
        int dev = 0, cus = 0;
        if (hipGetDevice(&dev) != hipSuccess || hipDeviceGetAttribute(&cus, hipDeviceAttributeMultiprocessorCount, dev) != hipSuccess) { fprintf(stderr, "kernel_launch: device query failed\n"); grid = -1; return; }
        if (hipFuncSetAttribute((const void*)mega, hipFuncAttributeMaxDynamicSharedMemorySize, LDS_BYTES) != hipSuccess) { fprintf(stderr, "kernel_launch: hipFuncSetAttribute failed\n"); grid = -1; return; }
        (void)hipGetLastError();
        grid = cus;
    }
    if (grid < 0) return;
    Args a{};
    for (int i = 0; i < 16; ++i) a.in[i] = (const float*)d_in[i];
    a.out = (float*)d_out; a.ws = (unsigned char*)d_ws;
#if ONE_LAUNCH
    (void)hipMemsetAsync(d_ws, 0, 32768, stream);
    a.ph_lo = 0; a.ph_hi = NPHASE;
    void* args[] = {&a};
    hipError_t e = hipLaunchCooperativeKernel((const void*)mega, dim3(grid), dim3(NTHR), args, LDS_BYTES, stream);
    if (e != hipSuccess) fprintf(stderr, "cooperative launch failed: %s (grid %d)\n", hipGetErrorString(e), grid);
#else
    for (int p = 0; p < NPHASE; ++p) for (int rep = 0; rep < (p == HOSTDUP ? 2 : 1); ++rep) { a.ph_lo = p; a.ph_hi = p + 1; hipLaunchKernelGGL(mega, dim3(grid), dim3(NTHR), LDS_BYTES, stream, a); }
#endif
}
```

```cpp
#define ONE 1
#include <hip/hip_runtime.h>
#include <hip/hip_cooperative_groups.h>
#include <cstdio>
#include <cstdint>
namespace cg = cooperative_groups;
namespace pg8 {
#define PG8_LAS __attribute__((address_space(3)))
typedef unsigned short bf16_t;
typedef short bf16x8 __attribute__((ext_vector_type(8)));
typedef float f32x4 __attribute__((ext_vector_type(4)));
typedef unsigned u32x4 __attribute__((ext_vector_type(4)));
constexpr int BM = 256, BK = 64, HALF = 128, HTB = HALF * BK * 2  , STAGE_BYTES = 8 * HTB, NXCD = 8, WGM = 8;

__host__ __device__ __forceinline__ int lds_byte(int r, int c) { const int st = (r >> 4) * 2 + (c >> 5), rr = r & 15, cc = c & 31, ob = rr * 64 + cc * 2; return st * 1024 + (ob ^ (((ob >> 9) & 1) << 5)); }
__host__ __device__ __forceinline__ void stage_rc(int b, int& R, int& C) { const int st = b / 1024, sb = b % 1024, swz = sb ^ (((sb >> 9) & 1) << 5); R = (st >> 1) * 16 + swz / 64; C = (st & 1) * 32 + (swz % 64) / 2; }
__host__ __device__ __forceinline__ int perm32(int rho) { const int n = rho >> 4, i = rho & 15; return 8 * (i >> 2) + 4 * n + (i & 3); }

struct Unit { int pm, pn; };
struct Gemm { const bf16_t* A; const bf16_t* Bt; int M, N, K; };

struct StaticOrder {
    int nM, nN, nwg, G, c;
    __host__ __device__ void init(int M, int N, int G_, int c_) { nM = M / BM; nN = N / BM; nwg = nM * nN; G = G_; c = c_; }
    __host__ __device__ bool next(int i, Unit& u) const {
        const long L = (long)i * G + c; if (L >= nwg) return false;
        int wgid = (int)L; { const int q = nwg / NXCD, r = nwg % NXCD, xcd = wgid % NXCD, off = wgid / NXCD; wgid = (xcd < r ? xcd * (q + 1) : r * (q + 1) + (xcd - r) * q) + off; }
        const int nig = WGM * nN, gid = wgid / nig, fm = gid * WGM, gsz = (nM - fm) < WGM ? (nM - fm) : WGM;
        u.pm = fm + ((wgid % nig) % gsz); u.pn = (wgid % nig) / gsz; return true;
    }
    __device__ __forceinline__ void a_ready(const Unit&) const {}
    __device__ __forceinline__ void done(const Unit&) const {}
};

__device__ __forceinline__ unsigned cvt_pk_bf16(float lo, float hi) { unsigned r; asm volatile("v_cvt_pk_bf16_f32 %0, %1, %2" : "=v"(r) : "v"(lo), "v"(hi)); return r; }
typedef float f32x2 __attribute__((ext_vector_type(2)));
__device__ __forceinline__ f32x2 gelu_pk(f32x2 v) {
    const f32x2 av = __builtin_elementwise_abs(v), d = av * 0.2316418882f + 1.0f;
    f32x2 t; t.x = __builtin_amdgcn_rcpf(d.x); t.y = __builtin_amdgcn_rcpf(d.y);
    f32x2 q = t * 0.5307027145f + (-0.7265760135f); q = q * t + 0.7107068705f; q = q * t + (-0.142248368f); q = q * t + 0.127414796f; q = q * t;
    const f32x2 s = (v * v) * (-0.72134752044f);
    f32x2 e; e.x = __builtin_amdgcn_exp2f(s.x); e.y = __builtin_amdgcn_exp2f(s.y);
    const f32x2 m = v * (q * e), r = v - m;
    f32x2 o; o.x = v.x < 0.f ? m.x : r.x; o.y = v.y < 0.f ? m.y : r.y; return o;
}

template <int ACT  > struct EpiBf16 {
    static constexpr bool PERM = true, AFTER_DRAIN = false; static_assert(ACT == 0 || ACT == 1, "EpiBf16: ACT is 0 (none) or 1 (gelu_pk)");
    bf16_t* O; int ldc; const float* bias; int split_cols; size_t split_stride; float scale0;
    __device__ __forceinline__ void operator()(const f32x4 (&acc)[2][2][4][2], const Unit& u, int wr, int wc, int fr, int fq) const {
        const int row0 = u.pm * BM + wr * 64 + fr; int colt = u.pn * BM; bf16_t* base = O;
        float sc = 1.f; if (split_cols) { const int t = colt / split_cols; base += (size_t)t * split_stride; colt -= t * split_cols; if (t == 0) sc = scale0; }
        const int col0 = colt + wc * 32 + 8 * fq, bcol0 = u.pn * BM + wc * 32 + 8 * fq;
        f32x4 bv[2][2];
#pragma unroll
        for (int bj = 0; bj < 2; ++bj)
#pragma unroll
            for (int n = 0; n < 2; ++n) bv[bj][n] = bias ? *(const f32x4*)(bias + bcol0 + bj * HALF + 4 * n) : (f32x4){0.f, 0.f, 0.f, 0.f};
#pragma unroll
        for (int ai = 0; ai < 2; ++ai)
#pragma unroll
            for (int m = 0; m < 4; ++m) { bf16_t* rowp = base + (size_t)(row0 + ai * HALF + m * 16) * ldc + col0;
#pragma unroll
                for (int bj = 0; bj < 2; ++bj) { f32x4 v0 = acc[ai][bj][m][0] + bv[bj][0], v1 = acc[ai][bj][m][1] + bv[bj][1];
                    if (ACT == 1) { f32x2 a = gelu_pk((f32x2){v0[0], v0[1]}), b = gelu_pk((f32x2){v0[2], v0[3]}), c = gelu_pk((f32x2){v1[0], v1[1]}), d = gelu_pk((f32x2){v1[2], v1[3]});
                        v0 = (f32x4){a.x, a.y, b.x, b.y}; v1 = (f32x4){c.x, c.y, d.x, d.y}; }
                    v0 = v0 * sc; v1 = v1 * sc; u32x4 w; w.x = cvt_pk_bf16(v0[0], v0[1]); w.y = cvt_pk_bf16(v0[2], v0[3]); w.z = cvt_pk_bf16(v1[0], v1[1]); w.w = cvt_pk_bf16(v1[2], v1[3]);
                    *(u32x4*)(rowp + bj * HALF) = w; } }
    }
};
struct EpiResid {
    static constexpr bool PERM = false, AFTER_DRAIN = false;
    const float* x; float* out; float* sspart; int ldc;
    __device__ __forceinline__ void operator()(const f32x4 (&acc)[2][2][4][2], const Unit& u, int wr, int wc, int fr, int fq) const {
        const int row0 = u.pm * BM + wr * 64 + fr, col0 = u.pn * BM + wc * 32 + 4 * fq;
#pragma unroll
        for (int ai = 0; ai < 2; ++ai)
#pragma unroll
            for (int m = 0; m < 4; ++m) {
                const int row = row0 + ai * HALF + m * 16; float ss = 0.f;
#pragma unroll
                for (int bj = 0; bj < 2; ++bj)
#pragma unroll
                    for (int n = 0; n < 2; ++n) {
                        const size_t off = (size_t)row * ldc + col0 + bj * HALF + n * 16;
                        const f32x4 xv = *(const f32x4*)(x + off); const f32x4 v = acc[ai][bj][m][n] + xv;
                        *(f32x4*)(out + off) = v; ss += (v[0] * v[0] + v[1] * v[1]) + (v[2] * v[2] + v[3] * v[3]);
                    }
                ss += __shfl_xor(ss, 16); ss += __shfl_xor(ss, 32);
                if (fq == 0) sspart[(size_t)row * 32 + u.pn * 4 + wc] = ss;
            }
    }
};

struct OneTile {
    int pm, pn;
    __host__ __device__ bool next(int i, Unit& u) const { if (i != 0) return false; u.pm = pm; u.pn = pn; return true; }
    __device__ __forceinline__ void a_ready(const Unit&) const {}
    __device__ __forceinline__ void done(const Unit&) const {}
};
struct EpiResidNorm {
    static constexpr bool PERM = false, AFTER_DRAIN = true;
    const float* x; float* out; float* ssp; unsigned* cnt; const float* gain; int ldc; float eps;
    __device__ __forceinline__ void fused(f32x4 (&acc)[2][2][4][2], const Unit& u, int wr, int wc, int fr, int fq, PG8_LAS unsigned char* lds, int wid, int lane) const {
        const int row0 = u.pm * BM + wr * 64 + fr, col0 = u.pn * BM + wc * 32 + 4 * fq;
#pragma unroll
        for (int ai = 0; ai < 2; ++ai)
#pragma unroll
            for (int m = 0; m < 4; ++m) {
                const int row = row0 + ai * HALF + m * 16; float ss = 0.f;
#pragma unroll
                for (int bj = 0; bj < 2; ++bj)
#pragma unroll
                    for (int n = 0; n < 2; ++n) {
                        const f32x4 xv = *(const f32x4*)(x + (size_t)row * ldc + col0 + bj * HALF + n * 16); const f32x4 v = acc[ai][bj][m][n] + xv;
                        acc[ai][bj][m][n] = v; ss += (v[0] * v[0] + v[1] * v[1]) + (v[2] * v[2] + v[3] * v[3]);
                    }
                ss += __shfl_xor(ss, 16); ss += __shfl_xor(ss, 32);
                if (fq == 0) __hip_atomic_store(ssp + (size_t)row * 32 + u.pn * 4 + wc, ss, __ATOMIC_RELAXED, __HIP_MEMORY_SCOPE_AGENT);
            }
        asm volatile("s_waitcnt vmcnt(0)" ::: "memory");
        __syncthreads();
        unsigned* c = cnt + 64 * u.pm;
        if (threadIdx.x == 0) {
            __hip_atomic_fetch_add(c, 1u, __ATOMIC_RELEASE, __HIP_MEMORY_SCOPE_AGENT);
            unsigned spins = 0;
            while (__hip_atomic_load(c, __ATOMIC_RELAXED, __HIP_MEMORY_SCOPE_AGENT) < 8u) { __builtin_amdgcn_s_sleep(2); if (++spins > (1u << 22)) break; }
            __builtin_amdgcn_fence(__ATOMIC_ACQUIRE, "agent");
        }
        __syncthreads();
        PG8_LAS float* S = (PG8_LAS float*)lds;
        if (threadIdx.x < 256) {
            const float* p = ssp + (size_t)(u.pm * BM + threadIdx.x) * 32; float s = 0.f;
#pragma unroll
            for (int i = 0; i < 32; ++i) s += __hip_atomic_load(p + i, __ATOMIC_RELAXED, __HIP_MEMORY_SCOPE_AGENT);
            S[threadIdx.x] = 1.0f / sqrtf(s * (1.0f / 2048.0f) + eps);
        }
        __syncthreads();
#pragma unroll
        for (int bj = 0; bj < 2; ++bj)
#pragma unroll
            for (int n = 0; n < 2; ++n) {
                const f32x4 g = *(const f32x4*)(gain + col0 + bj * HALF + n * 16);
#pragma unroll
                for (int ai = 0; ai < 2; ++ai)
#pragma unroll
                    for (int m = 0; m < 4; ++m) {
                        const int lr = wr * 64 + fr + ai * HALF + m * 16; const float rs = S[lr];
                        f32x4 v = acc[ai][bj][m][n]; v[0] *= rs * g[0]; v[1] *= rs * g[1]; v[2] *= rs * g[2]; v[3] *= rs * g[3];
                        *(f32x4*)(out + (size_t)(u.pm * BM + lr) * ldc + col0 + bj * HALF + n * 16) = v;
                    }
            }
    }
};

template <class Epi, class Sched, bool ALIGN_EPI = false, bool SP2 = false>
__device__ __forceinline__ void gemm_phase(PG8_LAS unsigned char* lds, const Gemm g, const Sched& S, const Epi& E) {
    const int tid = threadIdx.x, wid = __builtin_amdgcn_readfirstlane(tid >> 6), lane = tid & 63, wr = wid >> 2, wc = wid & 3, fr = lane & 15, fq = lane >> 4;
    const int K = g.K, nt = K / BK;
    unsigned voffA[2], voffB[2];
#pragma unroll
    for (int i = 0; i < 2; ++i) { int R, C; stage_rc(tid * 16 + i * 8192, R, C); const int Rb = Epi::PERM ? ((R & ~31) + perm32(R & 31)) : R;
        voffA[i] = (unsigned)(R * K + C) * 2u; voffB[i] = (unsigned)(Rb * K + C) * 2u; }
    const size_t kstep = (size_t)(BK * 2);
    const size_t hstep = (size_t)HALF * K * 2;
    const size_t tstep = 2 * hstep;
    const unsigned ldsw = (unsigned)wid * 1024u;
    const int aoff = lds_byte(wr * 64 + fr, fq * 8), boff = lds_byte(wc * 32 + fr, fq * 8);
#define PG8_SA(b, h) (((b) * 2 + (h)) * HTB)
#define PG8_SB(b, h) ((4 + (b) * 2 + (h)) * HTB)
#define PG8_STAGE(bufoff, gbase, voff) do { _Pragma("unroll") for (int _i = 0; _i < 2; ++_i) \
        __builtin_amdgcn_global_load_lds((const unsigned*)((const char*)(gbase) + (voff)[_i]), (PG8_LAS unsigned*)(lds + (bufoff) + ldsw + _i * 8192), 16, 0, 0); } while (0)
#define PG8_LDA(dst, b, h) do { _Pragma("unroll") for (int m = 0; m < 4; ++m) _Pragma("unroll") for (int k = 0; k < 2; ++k) dst[m][k] = *(const PG8_LAS bf16x8*)(lds + PG8_SA(b, h) + aoff + m * 2048 + k * 1024); } while (0)
#define PG8_LDB(dst, b, h) do { _Pragma("unroll") for (int n = 0; n < 2; ++n) _Pragma("unroll") for (int k = 0; k < 2; ++k) dst[n][k] = *(const PG8_LAS bf16x8*)(lds + PG8_SB(b, h) + boff + n * 2048 + k * 1024); } while (0)
#define PG8_MMA(ai, bj, At, Bt) do { __builtin_amdgcn_s_setprio(1); _Pragma("unroll") for (int m = 0; m < 4; ++m) _Pragma("unroll") for (int n = 0; n < 2; ++n) _Pragma("unroll") for (int k = 0; k < 2; ++k) \
        acc[ai][bj][m][n] = __builtin_amdgcn_mfma_f32_16x16x32_bf16(Bt[n][k], At[m][k], acc[ai][bj][m][n], 0, 0, 0); __builtin_amdgcn_s_setprio(0); } while (0)
#define PG8_WAIT_V(n) asm volatile("s_waitcnt vmcnt(" #n ")" ::: "memory")
#define PG8_WAIT_L(n) asm volatile("s_waitcnt lgkmcnt(" #n ")" ::: "memory")
#define PG8_BAR __builtin_amdgcn_s_barrier()
#define PG8_SCHED __builtin_amdgcn_sched_barrier(0)
    Unit cur, nxt; int ui = 0;
    if (!S.next(0, cur)) return;
    f32x4 acc[2][2][4][2];
#pragma unroll
    for (int a = 0; a < 2; ++a)
#pragma unroll
        for (int b = 0; b < 2; ++b)
#pragma unroll
            for (int m = 0; m < 4; ++m)
#pragma unroll
                for (int n = 0; n < 2; ++n) acc[a][b][m][n] = (f32x4){0.f, 0.f, 0.f, 0.f};
    bf16x8 At[4][2], B0[2][2], B1[2][2];
    const char* cA = (const char*)g.A + (size_t)cur.pm * tstep; const char* cB = (const char*)g.Bt + (size_t)cur.pn * tstep;
    S.a_ready(cur);
    if constexpr (SP2) {
        PG8_STAGE(PG8_SB(0, 0), cB, voffB); PG8_STAGE(PG8_SB(0, 1), cB + hstep, voffB); PG8_STAGE(PG8_SA(0, 0), cA, voffA); PG8_STAGE(PG8_SA(0, 1), cA + hstep, voffA);
        if (wr == 1) PG8_BAR;
        PG8_WAIT_V(2); PG8_BAR;
        PG8_STAGE(PG8_SB(1, 0), cB + kstep, voffB); PG8_STAGE(PG8_SA(1, 0), cA + kstep, voffA); PG8_STAGE(PG8_SB(1, 1), cB + hstep + kstep, voffB);
        PG8_WAIT_V(6); PG8_BAR;
    } else {
        PG8_STAGE(PG8_SB(0, 0), cB, voffB); PG8_STAGE(PG8_SA(0, 0), cA, voffA); PG8_STAGE(PG8_SB(0, 1), cB + hstep, voffB); PG8_STAGE(PG8_SA(0, 1), cA + hstep, voffA);
        if (wr == 1) PG8_BAR;
        PG8_WAIT_V(4); PG8_BAR;
        PG8_STAGE(PG8_SB(1, 0), cB + kstep, voffB); PG8_STAGE(PG8_SA(1, 0), cA + kstep, voffA); PG8_STAGE(PG8_SB(1, 1), cB + hstep + kstep, voffB);
        PG8_WAIT_V(6); PG8_BAR;
    }
    for (;;) {
        const bool has_next = S.next(ui + 1, nxt);
        const char* nA = has_next ? (const char*)g.A + (size_t)nxt.pm * tstep : cA; const char* nB = has_next ? (const char*)g.Bt + (size_t)nxt.pn * tstep : cB;
        for (int t = 0; t < nt; t += 2) {
            const bool last = (t == nt - 2);
            const char* a1 = cA + (size_t)(t + 1) * kstep;
            const char* a2 = last ? nA : cA + (size_t)(t + 2) * kstep; const char* b2 = last ? nB : cB + (size_t)(t + 2) * kstep;
            const char* a3 = a2 + kstep; const char* b3 = b2 + kstep;
            if (last && has_next) S.a_ready(nxt);
            if constexpr (SP2) {
            PG8_LDB(B0, 0, 0); PG8_LDB(B1, 0, 1); PG8_SCHED; PG8_LDA(At, 0, 0); PG8_STAGE(PG8_SA(1, 1), a1 + hstep, voffA);
            PG8_WAIT_V(8); PG8_WAIT_L(0); PG8_BAR; PG8_MMA(0, 0, At, B0); PG8_MMA(0, 1, At, B1); PG8_BAR; PG8_SCHED;
            PG8_LDA(At, 0, 1); PG8_STAGE(PG8_SB(0, 0), b2, voffB); PG8_STAGE(PG8_SB(0, 1), b2 + hstep, voffB); PG8_STAGE(PG8_SA(0, 0), a2, voffA);
            PG8_WAIT_V(8); PG8_WAIT_L(0); PG8_BAR; PG8_MMA(1, 0, At, B0); PG8_MMA(1, 1, At, B1); PG8_BAR; PG8_SCHED;
            PG8_LDB(B0, 1, 0); PG8_LDB(B1, 1, 1); PG8_SCHED; PG8_LDA(At, 1, 0); PG8_STAGE(PG8_SA(0, 1), a2 + hstep, voffA);
            PG8_WAIT_V(8); PG8_WAIT_L(0); PG8_BAR; PG8_MMA(0, 0, At, B0); PG8_MMA(0, 1, At, B1); PG8_BAR; PG8_SCHED;
            PG8_LDA(At, 1, 1); PG8_STAGE(PG8_SB(1, 0), b3, voffB); PG8_STAGE(PG8_SB(1, 1), b3 + hstep, voffB); PG8_STAGE(PG8_SA(1, 0), a3, voffA);
            PG8_WAIT_V(8); PG8_WAIT_L(0); PG8_BAR; PG8_MMA(1, 0, At, B0); PG8_MMA(1, 1, At, B1); PG8_BAR; PG8_SCHED;
            } else {
            PG8_LDB(B0, 0, 0); PG8_SCHED; PG8_LDA(At, 0, 0); PG8_STAGE(PG8_SA(1, 1), a1 + hstep, voffA);
            PG8_WAIT_L(8); PG8_BAR; PG8_WAIT_L(0); PG8_MMA(0, 0, At, B0); PG8_BAR; PG8_SCHED;
            PG8_LDB(B1, 0, 1); PG8_STAGE(PG8_SB(0, 0), b2, voffB);
            PG8_BAR; PG8_WAIT_L(0); PG8_MMA(0, 1, At, B1); PG8_BAR;
            PG8_LDA(At, 0, 1); PG8_STAGE(PG8_SA(0, 0), a2, voffA);
            PG8_BAR; PG8_WAIT_L(0); PG8_MMA(1, 0, At, B0); PG8_BAR; PG8_SCHED;
            PG8_STAGE(PG8_SB(0, 1), b2 + hstep, voffB);
            PG8_WAIT_V(6); PG8_BAR; PG8_MMA(1, 1, At, B1); PG8_BAR;
            PG8_LDB(B0, 1, 0); PG8_SCHED; PG8_LDA(At, 1, 0); PG8_STAGE(PG8_SA(0, 1), a2 + hstep, voffA);
            PG8_WAIT_L(8); PG8_BAR; PG8_WAIT_L(0); PG8_MMA(0, 0, At, B0); PG8_BAR; PG8_SCHED;
            PG8_LDB(B1, 1, 1); PG8_STAGE(PG8_SB(1, 0), b3, voffB);
            PG8_BAR; PG8_WAIT_L(0); PG8_MMA(0, 1, At, B1); PG8_BAR;
            PG8_LDA(At, 1, 1); PG8_STAGE(PG8_SA(1, 0), a3, voffA);
            PG8_BAR; PG8_WAIT_L(0); PG8_MMA(1, 0, At, B0); PG8_BAR; PG8_SCHED;
            PG8_STAGE(PG8_SB(1, 1), b3 + hstep, voffB);
            PG8_WAIT_V(6); PG8_BAR; PG8_MMA(1, 1, At, B1); PG8_BAR;
            }
        }
        if constexpr (ALIGN_EPI) { if (wr == 0) PG8_BAR; }
        if constexpr (!Epi::AFTER_DRAIN) { E(acc, cur, wr, wc, fr, fq); S.done(cur); }
        if (!has_next) break;
#pragma unroll
        for (int a = 0; a < 2; ++a)
#pragma unroll
            for (int b = 0; b < 2; ++b)
#pragma unroll
                for (int m = 0; m < 4; ++m)
#pragma unroll
                    for (int n = 0; n < 2; ++n) acc[a][b][m][n] = (f32x4){0.f, 0.f, 0.f, 0.f};
        cur = nxt; cA = nA; cB = nB; ++ui;
        if constexpr (ALIGN_EPI) { if (wr == 1) PG8_BAR; }
    }
    PG8_WAIT_V(0);
    if constexpr (!ALIGN_EPI) { if (wr == 0) PG8_BAR; }
    PG8_BAR;
    if constexpr (Epi::AFTER_DRAIN) { E.fused(acc, cur, wr, wc, fr, fq, lds, wid, lane); S.done(cur); }
#undef PG8_SA
#undef PG8_SB
#undef PG8_STAGE
#undef PG8_LDA
#undef PG8_LDB
#undef PG8_MMA
#undef PG8_WAIT_V
#undef PG8_WAIT_L
#undef PG8_BAR
#undef PG8_SCHED
}
}
constexpr int T = 8192, D = 2048, NIN = 6528, NINP = 6656, RW = 1024, NH = 16, HD = 64, CH = 64, NCH = T / CH;
constexpr int C_R = 0, C_K = 1024, C_V = 2048, C_WD = 3072, C_AD = 3136, C_G = 3200, C_AQ = 4224, C_AK = 5248, C_AV = 5376, C_AG = 5504;
constexpr float RMS_EPS = 1e-5f, LNX_EPS = 64e-5f;
constexpr int NWAVES = 8, NTHR = 512;
constexpr size_t MiB = 1u << 20;
constexpr size_t WS_WTIN = 1 * MiB;
constexpr size_t WS_XN = 27 * MiB;
constexpr size_t WS_WTOUT = 59 * MiB;
constexpr size_t WS_UPT = 67 * MiB;
constexpr size_t WS_SSP = 68 * MiB;
constexpr size_t WS_PROJ = 70 * MiB;
constexpr size_t WS_SCR = 174 * MiB;
constexpr size_t WS_MIX = 223 * MiB;
constexpr size_t WS_P32 = 223 * MiB;
constexpr int LDS_BYTES = 163840;

#define GAS __attribute__((address_space(1)))
#define LAS __attribute__((address_space(3)))
typedef unsigned short bf16;
typedef unsigned v4u __attribute__((ext_vector_type(4)));
typedef unsigned v2u __attribute__((ext_vector_type(2)));
typedef float f32x4 __attribute__((ext_vector_type(4)));
typedef float f32x16 __attribute__((ext_vector_type(16)));
typedef short bf16x8 __attribute__((ext_vector_type(8)));
typedef __bf16 bf16x2_t __attribute__((ext_vector_type(2)));
__device__ __forceinline__ unsigned pk2(float a, float b) { bf16x2_t v; v[0] = (__bf16)a; v[1] = (__bf16)b; return __builtin_bit_cast(unsigned, v); }
__device__ __forceinline__ float bflo(unsigned u) { return __uint_as_float(u << 16); }
__device__ __forceinline__ float bfhi(unsigned u) { return __uint_as_float(u & 0xffff0000u); }
__device__ __forceinline__ void unpack8(const v4u& p, float (&f)[8]) { f[0] = bflo(p.x); f[1] = bfhi(p.x); f[2] = bflo(p.y); f[3] = bfhi(p.y); f[4] = bflo(p.z); f[5] = bfhi(p.z); f[6] = bflo(p.w); f[7] = bfhi(p.w); }
__device__ __forceinline__ v4u pack8(const float (&f)[8]) { v4u o; o.x = pk2(f[0], f[1]); o.y = pk2(f[2], f[3]); o.z = pk2(f[4], f[5]); o.w = pk2(f[6], f[7]); return o; }
__device__ __forceinline__ float wave_sum(float v) {
#pragma unroll
    for (int o = 1; o < 64; o <<= 1) v += __shfl_xor(v, o);
    return v;
}
__device__ __forceinline__ float sum8(float v) { v += __shfl_xor(v, 1); v += __shfl_xor(v, 2); v += __shfl_xor(v, 4); return v; }
__device__ __forceinline__ float sigmoidf_(float x) { return 1.f / (1.f + __expf(-x)); }
__device__ __forceinline__ float siluf_(float x) { return x / (1.f + __expf(-x)); }

__device__ __forceinline__ void bar_lds() { asm volatile("s_waitcnt lgkmcnt(0)" ::: "memory"); __builtin_amdgcn_s_barrier(); asm volatile("" ::: "memory"); }
struct Args { const float* in[16]; float* out; unsigned char* ws; int ph_lo, ph_hi; };

struct TItem { const float* W; bf16* WT; int K, N, k0, n0; };
__device__ __forceinline__ bool p0_item(const Args& a, int it, TItem& o) {
    constexpr int I_IN = (D / 64) * (NIN / 32), I_OUT = (D / 64) * (D / 32), I_UP = RW / 32;
    bf16* wtin = (bf16*)(a.ws + WS_WTIN); bf16* wtout = (bf16*)(a.ws + WS_WTOUT); bf16* upt = (bf16*)(a.ws + WS_UPT); bf16* aupt = upt + 65536;
    int r = it;
    if (r < 0) { r += I_OUT; if (r < 0) return false; o.W = a.in[14]; o.WT = wtout; o.K = D; o.N = D; }
    else if (r < I_IN) { o.W = a.in[2]; o.WT = wtin; o.K = D; o.N = NIN; }
    else if ((r -= I_IN) < I_UP) { o.W = a.in[5]; o.WT = upt; o.K = 64; o.N = RW; }
    else if ((r -= I_UP) < I_UP) { o.W = a.in[7]; o.WT = aupt; o.K = 64; o.N = RW; }
    else return false;
    const int nblk = o.N / 32; o.k0 = 64 * (r / nblk); o.n0 = 32 * (r % nblk); return true;
}
__device__ __forceinline__ void p0_ld(const TItem& t, int lane, f32x4 (&v)[8]) {
#pragma unroll
    for (int i = 0; i < 8; ++i) v[i] = *(const f32x4*)(t.W + (size_t)(t.k0 + 8 * i + (lane >> 3)) * t.N + t.n0 + 4 * (lane & 7));
}
__device__ __forceinline__ void p0_st(const TItem& t, int lane, const f32x4 (&v)[8], LAS float* scr) {
#pragma unroll
    for (int i = 0; i < 8; ++i) { LAS float* d = scr + (8 * i + (lane >> 3)) * 33 + 4 * (lane & 7); d[0] = v[i].x; d[1] = v[i].y; d[2] = v[i].z; d[3] = v[i].w; }
    asm volatile("s_waitcnt lgkmcnt(0)" ::: "memory");
    const int c = lane & 7;
#pragma unroll
    for (int j = 0; j < 4; ++j) { const int n = (lane >> 3) + 8 * j; const LAS float* s = scr + (8 * c) * 33 + n;
        v4u o; o.x = pk2(s[0 * 33], s[1 * 33]); o.y = pk2(s[2 * 33], s[3 * 33]); o.z = pk2(s[4 * 33], s[5 * 33]); o.w = pk2(s[6 * 33], s[7 * 33]);
        *(v4u*)(t.WT + (size_t)(t.n0 + n) * t.K + t.k0 + 8 * c) = o; }
    asm volatile("s_waitcnt lgkmcnt(0)" ::: "memory");
}
__device__ __forceinline__ void wout_transposes(const Args& a, LAS unsigned char* lds, int gw, int NGW, int wave, int lane) {
    LAS float* scr = (LAS float*)(lds + wave * 16384);
    constexpr int I_OUT = (D / 64) * (D / 32);
    for (int it = gw - I_OUT; it < 0; it += NGW) { TItem t0; f32x4 v0[8]; if (!p0_item(a, it, t0)) break; p0_ld(t0, lane, v0); p0_st(t0, lane, v0, scr); }
}
__device__ __forceinline__ void p0_prologue(const Args& a, LAS unsigned char* lds, int vcu, int G, int wave, int lane) {
    LAS float* scr = (LAS float*)(lds + wave * 16384);
    const int gw = vcu * NWAVES + wave, NGW = G * NWAVES;
    bf16* wtin = (bf16*)(a.ws + WS_WTIN);
#ifdef PROBE_P0X
    for (int rep_ = 0; rep_ < 2; ++rep_)
#endif
    for (int it = gw; ; it += 2 * NGW) {
        TItem t0, t1; f32x4 v0[8], v1[8];
        const bool h0 = p0_item(a, it, t0), h1 = p0_item(a, it + NGW, t1);
        if (!h0) break;
        p0_ld(t0, lane, v0); if (h1) p0_ld(t1, lane, v1);
        p0_st(t0, lane, v0, scr); if (h1) p0_st(t1, lane, v1, scr);
    }
    wout_transposes(a, lds, gw, NGW, wave, lane);
    { v4u z = {0u, 0u, 0u, 0u}; v4u* p = (v4u*)(wtin + (size_t)NIN * D); const int n16 = (NINP - NIN) * D * 2 / 16;
      for (int i = gw * 64 + lane; i < n16; i += NGW * 64) p[i] = z; }
    const float* gain = a.in[1];
#ifdef PROBE_P0R
    for (int rep_ = 0; rep_ < 2; ++rep_)
#endif
    for (int m = gw; m < T; m += 2 * NGW) {
        const int m2 = m + NGW;
        const f32x4* xr = (const f32x4*)(a.in[0] + (size_t)m * D) + lane; const f32x4* xr2 = (const f32x4*)(a.in[0] + (size_t)(m2 < T ? m2 : m) * D) + lane;
        f32x4 v[8], u[8]; float s = 0.f, s2 = 0.f;
#pragma unroll
        for (int j = 0; j < 8; ++j) { v[j] = xr[64 * j]; u[j] = xr2[64 * j]; }
#pragma unroll
        for (int j = 0; j < 8; ++j) { s += (v[j].x * v[j].x + v[j].y * v[j].y) + (v[j].z * v[j].z + v[j].w * v[j].w); s2 += (u[j].x * u[j].x + u[j].y * u[j].y) + (u[j].z * u[j].z + u[j].w * u[j].w); }
        const float rstd = 1.f / sqrtf(wave_sum(s) * (1.f / D) + RMS_EPS), rstd2 = 1.f / sqrtf(wave_sum(s2) * (1.f / D) + RMS_EPS);
        v2u* o8 = (v2u*)((bf16*)(a.ws + WS_XN) + (size_t)m * D) + lane; v2u* o82 = (v2u*)((bf16*)(a.ws + WS_XN) + (size_t)m2 * D) + lane;
#pragma unroll
        for (int j = 0; j < 8; ++j) { const f32x4 g = *((const f32x4*)gain + lane + 64 * j); v2u o; o.x = pk2(v[j].x * rstd * g.x, v[j].y * rstd * g.y); o.y = pk2(v[j].z * rstd * g.z, v[j].w * rstd * g.w); o8[64 * j] = o;
            if (m2 < T) { o.x = pk2(u[j].x * rstd2 * g.x, u[j].y * rstd2 * g.y); o.y = pk2(u[j].z * rstd2 * g.z, u[j].w * rstd2 * g.w); o82[64 * j] = o; } }
    }
}
__device__ __forceinline__ void final_norm(const Args& a, int vcu, int G, int wave, int lane) {
    const int gw = vcu * NWAVES + wave, NGW = G * NWAVES; const float* ssp = (const float*)(a.ws + WS_SSP); const float* gain = a.in[15];
    for (int m = gw; m < T; m += NGW) {
        float s = (lane < 32) ? ssp[(size_t)m * 32 + lane] : 0.f; s = wave_sum(s);
        const float rstd = 1.f / sqrtf(s * (1.f / D) + RMS_EPS);
        f32x4* xr = (f32x4*)(a.out + (size_t)m * D) + lane;
#pragma unroll
        for (int j = 0; j < 8; ++j) { f32x4 v = xr[64 * j]; const f32x4 g = *((const f32x4*)gain + lane + 64 * j); v.x *= rstd * g.x; v.y *= rstd * g.y; v.z *= rstd * g.z; v.w *= rstd * g.w; xr[64 * j] = v; }
    }
}
#define XB_TMO      128
#define XB_XCNT(j)  (256  + 64 * (j))
#define XB_XSUB(j)  (1280 + 64 * (j))
#define XB_XGEN(j)  (2304 + 64 * (j))
#define XB_TOP      3328
#define XB_TOPGEN   3392
#define XCD_BAR_WORDS 3456
#define XB_SPIN_CAP (1u << 18)

__device__ __forceinline__ unsigned xb_ld(unsigned* p)              { return __hip_atomic_load(p, __ATOMIC_RELAXED, __HIP_MEMORY_SCOPE_AGENT); }
__device__ __forceinline__ unsigned xb_add(unsigned* p, unsigned v) { return __hip_atomic_fetch_add(p, v, __ATOMIC_RELAXED, __HIP_MEMORY_SCOPE_AGENT); }
__device__ __forceinline__ unsigned xb_xcc_id() { return (unsigned)__builtin_amdgcn_s_getreg((3 << 11) | 20) & 0xFu; }
#define XB_SPIN(cond, bar) do { unsigned _sp = 0; while (cond) { __builtin_amdgcn_s_sleep(1); \
    if ((++_sp & 255u) == 0u) { if (xb_ld(&(bar)[XB_TMO])) break; if (_sp > XB_SPIN_CAP) { atomicAdd(&(bar)[XB_TMO], 1u); break; } } } } while (0)

struct XcdBarrier {
    unsigned* bar; unsigned x;
    volatile LAS unsigned* st;
};

__device__ __forceinline__ XcdBarrier xcd_barrier_post(unsigned* bar, volatile LAS unsigned* st) {
    XcdBarrier b; b.bar = bar; b.x = xb_xcc_id(); b.st = st;
    if (threadIdx.x == 0) (void)xb_add(&bar[XB_XCNT(b.x)], 1u);
    return b;
}
__device__ __forceinline__ void xcd_barrier_complete(unsigned* bar, unsigned x, unsigned& nloc, unsigned& nx) {
    const unsigned G = gridDim.x * gridDim.y * gridDim.z;
    unsigned sum, cnt, mine, sp = 0u;
    for (;;) {
        sum = 0u; cnt = 0u; mine = 0u;
#pragma unroll
        for (unsigned j = 0; j < 16; ++j) { const unsigned c = xb_ld(&bar[XB_XCNT(j)]); sum += c; cnt += (c > 0u) ? 1u : 0u; mine = (j == x) ? c : mine; }
        if (sum == G) break;
        __builtin_amdgcn_s_sleep(1);
        if ((++sp & 255u) == 0u) { if (xb_ld(&bar[XB_TMO])) break; if (sp > XB_SPIN_CAP) { atomicAdd(&bar[XB_TMO], 1u); break; } }
    }
    nloc = mine > 0u ? mine : 1u; nx = cnt > 0u ? cnt : 1u;
}

__device__ __forceinline__ void xcd_barrier(const XcdBarrier& b) {
    asm volatile("s_waitcnt vmcnt(0)" ::: "memory");
    __syncthreads();
    if (threadIdx.x == 0) {
        unsigned* bar = b.bar;
        __builtin_amdgcn_s_waitcnt(0);
        unsigned nloc = b.st[0], nx = b.st[1];
        if (nloc == 0u) { xcd_barrier_complete(bar, b.x, nloc, nx); b.st[0] = nloc; b.st[1] = nx; }
        const unsigned old = xb_add(&bar[XB_XSUB(b.x)], 1u);
        const unsigned gen = old / nloc;
        if (old + 1u == (gen + 1u) * nloc) {
            __builtin_amdgcn_fence(__ATOMIC_RELEASE, "agent");
            asm volatile("s_waitcnt vmcnt(0)" ::: "memory");
            const unsigned og = xb_add(&bar[XB_TOP], 1u);
            const unsigned tg = og / nx;
            if (og + 1u == (tg + 1u) * nx) xb_add(&bar[XB_TOPGEN], 1u);
            else XB_SPIN(xb_ld(&bar[XB_TOPGEN]) == tg, bar);
            __builtin_amdgcn_fence(__ATOMIC_ACQUIRE, "agent");
            xb_add(&bar[XB_XGEN(b.x)], 1u);
            asm volatile("s_waitcnt vmcnt(0)" ::: "memory");
        } else {
            XB_SPIN(xb_ld(&bar[XB_XGEN(b.x)]) == gen, bar);
            __builtin_amdgcn_fence(__ATOMIC_ACQUIRE, "agent");
            asm volatile("s_waitcnt vmcnt(0)" ::: "memory");
        }
    }
    __syncthreads();
}

#define MFMA32(a_, b_, c_) __builtin_amdgcn_mfma_f32_32x32x16_bf16((a_), (b_), (c_), 0, 0, 0)
#define MFMA16(a_, b_, c_) __builtin_amdgcn_mfma_f32_16x16x32_bf16((a_), (b_), (c_), 0, 0, 0)
__device__ __forceinline__ v4u ldg16(const bf16* p) { return *(const v4u*)p; }
__device__ __forceinline__ void load_shift8(const bf16* proj, int row, int col, const float* mu, float (&o)[8]) {
    const v4u p = ldg16(proj + (size_t)row * NINP + col); v4u q = {0u, 0u, 0u, 0u};
    if (row > 0) q = ldg16(proj + (size_t)(row - 1) * NINP + col);
    float pf[8], qf[8]; unpack8(p, pf); unpack8(q, qf);
    const f32x4 m0 = *(const f32x4*)(mu + col), m1 = *(const f32x4*)(mu + col + 4);
    const float mf[8] = {m0.x, m0.y, m0.z, m0.w, m1.x, m1.y, m1.z, m1.w};
#pragma unroll
    for (int j = 0; j < 8; ++j) o[j] = pf[j] + (qf[j] - pf[j]) * mf[j];
}
__device__ __forceinline__ void ld8f(const float* p, float (&o)[8]) { const f32x4 a = *(const f32x4*)p, b = *(const f32x4*)(p + 4); o[0] = a.x; o[1] = a.y; o[2] = a.z; o[3] = a.w; o[4] = b.x; o[5] = b.y; o[6] = b.z; o[7] = b.w; }

constexpr int VP = 168;
__device__ __forceinline__ void attn_unit(const Args& a, LAS unsigned char* lds, int unit, int tid, int wave, int lane) {
    const bf16* proj = (const bf16*)(a.ws + WS_PROJ); bf16* mix = (bf16*)(a.ws + WS_MIX);
    const int qb = unit >> 1, kvh = unit & 1, q0 = qb * 32, kbase = q0 - 128, hq = kvh * 8 + wave;
    LAS bf16* VT = (LAS bf16*)lds;
    const int r = lane & 31, h = lane >> 5;
    bf16x8 bq[4];
    { const bf16* qrow = proj + (size_t)(q0 + r) * NINP + C_AQ + hq * 64 + 8 * h;
#pragma unroll
      for (int s = 0; s < 4; ++s) bq[s] = *(const bf16x8*)(qrow + 16 * s); }
    const float slope = exp2f(-0.5f * (float)(hq + 1)), sink = a.in[13][hq];
    f32x16 sc[5]; float mx = sink;
    bf16x8 kf[5][4];
#pragma unroll
    for (int kt = 0; kt < 5; ++kt) { const int tkb = kbase + 32 * kt;
        if (tkb >= 0) { const bf16* krow = proj + (size_t)(tkb + r) * NINP + C_AK + kvh * 64 + 8 * h;
#pragma unroll
            for (int s = 0; s < 4; ++s) kf[kt][s] = *(const bf16x8*)(krow + 16 * s); } }
    v2u gpre[2][4];
#pragma unroll
    for (int dt = 0; dt < 2; ++dt)
#pragma unroll
        for (int g4 = 0; g4 < 4; ++g4) gpre[dt][g4] = *(const v2u*)(proj + (size_t)(q0 + r) * NINP + C_AG + hq * 64 + 32 * dt + 8 * g4 + 4 * h);
    bar_lds();
    for (int idx = tid; idx < 160 * 8; idx += NTHR) {
        const int key = idx >> 3, d8 = (idx & 7) * 8, tk = kbase + key;
        v4u p = {0u, 0u, 0u, 0u};
        if (tk >= 0) p = ldg16(proj + (size_t)tk * NINP + C_AV + kvh * 64 + d8);
        const unsigned w[4] = {p.x, p.y, p.z, p.w};
#pragma unroll
        for (int j = 0; j < 4; ++j) { VT[(d8 + 2 * j) * VP + key] = (bf16)(w[j] & 0xffffu); VT[(d8 + 2 * j + 1) * VP + key] = (bf16)(w[j] >> 16); }
    }
    bar_lds();
    const float L2E = 1.44269504f, SA = 0.125f * L2E, SB = slope * L2E, sinkl = sink * L2E;
    mx = sinkl;
#pragma unroll
    for (int kt = 0; kt < 5; ++kt) {
        const int tkb = kbase + 32 * kt;
        if (tkb >= 0) {
            f32x16 acc; for (int i = 0; i < 16; ++i) acc[i] = 0.f;
#pragma unroll
            for (int s = 0; s < 4; ++s) acc = MFMA32(kf[kt][s], bq[s], acc);
            const int dli = (q0 + r) - tkb - 4 * h; const float base = -SB * (float)dli;
#pragma unroll
            for (int i = 0; i < 16; ++i) {
                const int ci = (i & 3) + 8 * (i >> 2);
                float v = __builtin_fmaf(acc[i], SA, __builtin_fmaf(SB, (float)ci, base));
                if (kt == 0) v = (dli - ci < 128) ? v : -1e30f;
                if (kt == 4) v = (dli - ci >= 0) ? v : -1e30f;
                sc[kt][i] = v; mx = fmaxf(mx, v);
            }
        } else {
#pragma unroll
            for (int i = 0; i < 16; ++i) sc[kt][i] = -1e30f;
        }
    }
    mx = fmaxf(mx, __shfl_xor(mx, 32));
    float sum = 0.f;
#pragma unroll
    for (int kt = 0; kt < 5; ++kt)
#pragma unroll
        for (int i = 0; i < 16; ++i) { const float p = __builtin_amdgcn_exp2f(sc[kt][i] - mx); sc[kt][i] = p; sum += p; }
    sum += __shfl_xor(sum, 32); sum += __builtin_amdgcn_exp2f(sinkl - mx);
    f32x16 o[2]; for (int i = 0; i < 16; ++i) { o[0][i] = 0.f; o[1][i] = 0.f; }
#pragma unroll
    for (int kt = 0; kt < 5; ++kt) {
        if (kbase + 32 * kt >= 0) {
#pragma unroll
            for (int s = 0; s < 2; ++s) {
                v4u pw; pw.x = pk2(sc[kt][8 * s + 0], sc[kt][8 * s + 1]); pw.y = pk2(sc[kt][8 * s + 2], sc[kt][8 * s + 3]); pw.z = pk2(sc[kt][8 * s + 4], sc[kt][8 * s + 5]); pw.w = pk2(sc[kt][8 * s + 6], sc[kt][8 * s + 7]);
                const bf16x8 pb = __builtin_bit_cast(bf16x8, pw);
#pragma unroll
                for (int dt = 0; dt < 2; ++dt) {
                    const LAS bf16* vp = VT + (32 * dt + r) * VP + 32 * kt + 16 * s + 4 * h;
                    const v2u lo = *(const LAS v2u*)vp, hi = *(const LAS v2u*)(vp + 8);
                    v4u vw; vw.x = lo.x; vw.y = lo.y; vw.z = hi.x; vw.w = hi.y;
                    o[dt] = MFMA32(__builtin_bit_cast(bf16x8, vw), pb, o[dt]);
                }
            }
        }
    }
    const float inv = 1.f / sum;
#pragma unroll
    for (int dt = 0; dt < 2; ++dt)
#pragma unroll
        for (int g4 = 0; g4 < 4; ++g4) {
            const int d0 = 32 * dt + 8 * g4 + 4 * h;
            float g0, g1, g2, g3;
            { const v2u gp = gpre[dt][g4]; g0 = bflo(gp.x); g1 = bfhi(gp.x); g2 = bflo(gp.y); g3 = bfhi(gp.y); }
            v2u w; w.x = pk2(o[dt][4 * g4 + 0] * inv * siluf_(g0), o[dt][4 * g4 + 1] * inv * siluf_(g1));
            w.y = pk2(o[dt][4 * g4 + 2] * inv * siluf_(g2), o[dt][4 * g4 + 3] * inv * siluf_(g3));
            *(v2u*)(mix + (size_t)(q0 + r) * D + RW + hq * 64 + d0) = w;
        }
}

struct Prep { float r[8], kp[8], v[8], g[8], w[8], lw[8], kk[8], b[8], bonus; };
__device__ __forceinline__ void rwkv_prep(const Args& a, LAS unsigned char* lds, int h, int t0, int tid, int wave, int lane, Prep& P) {
    const bf16* proj = (const bf16*)(a.ws + WS_PROJ); const bf16* upt = (const bf16*)(a.ws + WS_UPT); const bf16* aupt = upt + 65536;
    LAS bf16* TW = (LAS bf16*)lds; LAS bf16* ADm = TW + 64 * 72; LAS float* Z = (LAS float*)(lds + 18432); LAS float* AP = Z + 64 * 68;
    const int t = tid >> 3, c8 = (tid & 7) * 8, ch = h * 64 + c8, row = t0 + t;
    const float* mu = a.in[3];
    { float x[8]; load_shift8(proj, row, C_WD + c8, mu, x);
#pragma unroll
      for (int j = 0; j < 8; ++j) x[j] = 1.f - 2.f * __builtin_amdgcn_rcpf(1.f + __expf(2.f * x[j]));
      *(LAS v4u*)(TW + t * 72 + c8) = pack8(x);
      load_shift8(proj, row, C_AD + c8, mu, x); *(LAS v4u*)(ADm + t * 72 + c8) = pack8(x); }
    bar_lds();
    { const int rt = wave & 3, cp = (wave >> 2) * 2, fr = lane & 15, fq = lane >> 4;
      bf16x8 aT[2], aA[2];
#pragma unroll
      for (int s = 0; s < 2; ++s) { aT[s] = *(const LAS bf16x8*)(TW + (16 * rt + fr) * 72 + 32 * s + 8 * fq); aA[s] = *(const LAS bf16x8*)(ADm + (16 * rt + fr) * 72 + 32 * s + 8 * fq); }
#pragma unroll
      for (int ci = 0; ci < 2; ++ci) { const int ct = cp + ci; f32x4 z = {0.f, 0.f, 0.f, 0.f}, ap = {0.f, 0.f, 0.f, 0.f};
#pragma unroll
          for (int s = 0; s < 2; ++s) { const size_t bo = (size_t)(h * 64 + 16 * ct + fr) * 64 + 32 * s + 8 * fq;
              z = MFMA16(aT[s], *(const bf16x8*)(upt + bo), z); ap = MFMA16(aA[s], *(const bf16x8*)(aupt + bo), ap); }
#pragma unroll
          for (int j = 0; j < 4; ++j) { Z[(16 * rt + 4 * fq + j) * 68 + 16 * ct + fr] = z[j]; AP[(16 * rt + 4 * fq + j) * 68 + 16 * ct + fr] = ap[j]; } } }
    bar_lds();
    float zz[8], aa[8], kr[8], c0[8], c1[8];
#pragma unroll
    for (int j = 0; j < 8; ++j) { zz[j] = Z[t * 68 + c8 + j]; aa[j] = AP[t * 68 + c8 + j]; }
    load_shift8(proj, row, C_R + ch, mu, P.r); load_shift8(proj, row, C_K + ch, mu, kr); load_shift8(proj, row, C_V + ch, mu, P.v); load_shift8(proj, row, C_G + ch, mu, P.g);
    ld8f(a.in[4] + ch, c0); ld8f(a.in[6] + ch, c1);
#pragma unroll
    for (int j = 0; j < 8; ++j) { const float z = c0[j] + zz[j]; const float sp = (z < -15.f) ? -z : __logf(1.f + __expf(-z)); const float wl = -sp - 0.5f; P.lw[j] = -__expf(wl); P.w[j] = __expf(P.lw[j]); aa[j] = sigmoidf_(c1[j] + aa[j]); }
    ld8f(a.in[8] + ch, c0); ld8f(a.in[9] + ch, c1);
    float ss = 0.f;
#pragma unroll
    for (int j = 0; j < 8; ++j) { P.kk[j] = kr[j] * c0[j]; ss += P.kk[j] * P.kk[j]; P.kp[j] = kr[j] * (1.f + (aa[j] - 1.f) * c1[j]); }
    ss = sum8(ss); const float rn = 1.f / fmaxf(sqrtf(ss), 1e-12f);
    ld8f(a.in[10] + ch, c0);
    float bs = 0.f;
#pragma unroll
    for (int j = 0; j < 8; ++j) { P.kk[j] *= rn; P.b[j] = P.kk[j] * aa[j]; bs += P.r[j] * P.kp[j] * c0[j]; }
    P.bonus = sum8(bs);
}
__device__ __forceinline__ void rwkv_out8(const Args& a, const float (&y)[8], const float (&v)[8], const float (&g)[8], float bonus, int row, int ch) {
    bf16* mix = (bf16*)(a.ws + WS_MIX);
    float s = 0.f;
#pragma unroll
    for (int j = 0; j < 8; ++j) s += y[j];
    const float mean = sum8(s) * (1.f / 64.f); float q = 0.f;
#pragma unroll
    for (int j = 0; j < 8; ++j) { const float d = y[j] - mean; q += d * d; }
    const float rstd = 1.f / sqrtf(sum8(q) * (1.f / 64.f) + LNX_EPS);
    float lg[8], lb[8], o[8]; ld8f(a.in[11] + ch, lg); ld8f(a.in[12] + ch, lb);
#pragma unroll
    for (int j = 0; j < 8; ++j) { const float yn = (y[j] - mean) * rstd * lg[j] + lb[j] + bonus * v[j]; o[j] = yn * siluf_(g[j]); }
    *(v4u*)(mix + (size_t)row * D + ch) = pack8(o);
}
constexpr size_t WS_MF = 174 * MiB, WS_QF = 190 * MiB, WS_SF = 206 * MiB, WS_BON = 222 * MiB;
constexpr size_t OUT_NF = 0, OUT_Y2 = 32 * MiB;
constexpr int MP = 72;
constexpr int L_AT = 0, L_ATT = 9216, L_BT = 18432, L_KT = 27648, L_RT = 36864, L_BHT = 46080, L_KHT = 55296, L_VT = 64512, L_LW = 73728, L_P = 73728, L_PT = 82944,
              L_AAK = 92160, L_ARB = 101376, L_ARK = 110592, L_TM = 119808, L_SEG = 119808, L_GC = 129024, L_WT = L_AT, L_X1T = L_BT, L_U2T = L_KT;
struct WTile { int ta, tb0, fr, fq; };
__device__ __forceinline__ bf16x8 ldfrag(const LAS bf16* M, int tile, int s, const WTile& w) { return *(const LAS bf16x8*)(M + (16 * tile + w.fr) * MP + 32 * s + 8 * w.fq); }
__device__ __forceinline__ void mm2(const LAS bf16* A, const LAS bf16* B, const WTile& w, f32x4 (&acc)[2]) {
#pragma unroll
    for (int s = 0; s < 2; ++s) { const bf16x8 af = ldfrag(A, w.ta, s, w);
#pragma unroll
        for (int ci = 0; ci < 2; ++ci) acc[ci] = MFMA16(af, ldfrag(B, w.tb0 + ci, s, w), acc[ci]); }
}
__device__ __forceinline__ void st_T(LAS bf16* X, int ta, int tb, const WTile& w, const f32x4& v) { v2u o; o.x = pk2(v[0], v[1]); o.y = pk2(v[2], v[3]); *(LAS v2u*)(X + (16 * tb + w.fr) * MP + 16 * ta + 4 * w.fq) = o; }
__device__ __forceinline__ void st_N(LAS bf16* X, int ta, int tb, const WTile& w, const f32x4& v) {
    const unsigned a = pk2(v[0], v[1]), b = pk2(v[2], v[3]); LAS bf16* p = X + (16 * ta + 4 * w.fq) * MP + 16 * tb + w.fr;
    p[0] = (bf16)(a & 0xffffu); p[MP] = (bf16)(a >> 16); p[2 * MP] = (bf16)(b & 0xffffu); p[3 * MP] = (bf16)(b >> 16);
}
#define ZERO2(x) do { x[0] = (f32x4){0.f, 0.f, 0.f, 0.f}; x[1] = (f32x4){0.f, 0.f, 0.f, 0.f}; } while (0)
template <int MODE> __device__ __forceinline__ void mask2(f32x4 (&acc)[2], const WTile& w) {
#pragma unroll
    for (int ci = 0; ci < 2; ++ci)
#pragma unroll
        for (int j = 0; j < 4; ++j) { const int row = 16 * w.ta + 4 * w.fq + j, col = 16 * (w.tb0 + ci) + w.fr;
            const bool keep = MODE == 0 ? (row < col) : (MODE == 1 ? (row <= col) : (col < row)); if (!keep) acc[ci][j] = 0.f; }
}
__device__ __forceinline__ void st_bf16x8_T2(LAS bf16* X, int c8, int t, int lane, const float (&v)[8]) {
    const v4u p = pack8(v); const unsigned w[4] = {p.x, p.y, p.z, p.w}; const bool odd = (lane >> 3) & 1;
#pragma unroll
    for (int j = 0; j < 4; ++j) {
        const unsigned q = (unsigned)__builtin_amdgcn_update_dpp(0, (int)w[j], 0x128  , 0xf, 0xf, false);
        const unsigned o = odd ? ((q >> 16) | (w[j] & 0xffff0000u)) : ((w[j] & 0xffffu) | (q << 16));
        *(LAS unsigned*)(X + (c8 + 2 * j + (odd ? 1 : 0)) * MP + (t & ~1)) = o;
    }
}
__device__ __forceinline__ void st_bf16x8_T(LAS bf16* X, int c8, int t, const float (&v)[8]) {
    const v4u p = pack8(v); const unsigned w[4] = {p.x, p.y, p.z, p.w};
#pragma unroll
    for (int j = 0; j < 4; ++j) { X[(c8 + 2 * j) * MP + t] = (bf16)(w[j] & 0xffffu); X[(c8 + 2 * j + 1) * MP + t] = (bf16)(w[j] >> 16); }
}

__device__ __forceinline__ void rwkv_chunk_prep(const Args& a, LAS unsigned char* lds, int unit, int tid, int wave, int lane) {
    const int c = unit >> 4, h = unit & 15, t0 = c * CH, t = tid >> 3, c8 = (tid & 7) * 8;
    LAS bf16* At = (LAS bf16*)(lds + L_AT); LAS bf16* AtT = (LAS bf16*)(lds + L_ATT); LAS bf16* Bt = (LAS bf16*)(lds + L_BT); LAS bf16* Kt = (LAS bf16*)(lds + L_KT);
    LAS bf16* Rt = (LAS bf16*)(lds + L_RT); LAS bf16* BhT = (LAS bf16*)(lds + L_BHT); LAS bf16* KhT = (LAS bf16*)(lds + L_KHT); LAS bf16* VT = (LAS bf16*)(lds + L_VT);
    LAS float* LW = (LAS float*)(lds + L_LW); LAS bf16* Pm = (LAS bf16*)(lds + L_P); LAS bf16* PT = (LAS bf16*)(lds + L_PT);
    LAS bf16* AAK = (LAS bf16*)(lds + L_AAK); LAS bf16* ARB = (LAS bf16*)(lds + L_ARB); LAS bf16* ARK = (LAS bf16*)(lds + L_ARK); LAS bf16* TM = (LAS bf16*)(lds + L_TM);
    LAS float* SEG = (LAS float*)(lds + L_SEG); LAS float* GC = (LAS float*)(lds + L_GC);
    LAS bf16* WT = (LAS bf16*)(lds + L_WT); LAS bf16* X1T = (LAS bf16*)(lds + L_X1T); LAS bf16* U2T = (LAS bf16*)(lds + L_U2T);
    bar_lds();
    Prep P; rwkv_prep(a, lds, h, t0, tid, wave, lane, P);
#ifdef PROBE_PREP2
    bar_lds(); rwkv_prep(a, lds, h, t0, tid, wave, lane, P);
#endif
    if ((tid & 7) == 0) ((float*)(a.ws + WS_BON))[(size_t)(t0 + t) * 16 + h] = P.bonus;
#pragma unroll
    for (int j = 0; j < 8; ++j) LW[t * 68 + c8 + j] = P.lw[j];
    bar_lds();
    { const int cc = tid & 63, sg = tid >> 6; float run = 0.f;
#pragma unroll
      for (int i = 0; i < 8; ++i) { run += LW[(8 * sg + i) * 68 + cc]; LW[(8 * sg + i) * 68 + cc] = run; }
      SEG[sg * 64 + cc] = run; }
    bar_lds();
    {
        float Lt[8], LC[8];
#pragma unroll
        for (int j = 0; j < 8; ++j) { float off = 0.f, tot = 0.f;
#pragma unroll
            for (int s = 0; s < 8; ++s) { const float sv = SEG[s * 64 + c8 + j]; tot += sv; if (s < (t >> 3)) off += sv; }
            Lt[j] = LW[t * 68 + c8 + j] + off; LC[j] = tot; }
        if (t == 0) {
#pragma unroll
            for (int j = 0; j < 8; ++j) GC[c8 + j] = __expf(LC[j]); }
        float x[8], y[8];
#pragma unroll
        for (int j = 0; j < 8; ++j) x[j] = -P.kk[j] * __expf(Lt[j] - P.lw[j]);
        *(LAS v4u*)(At + t * MP + c8) = pack8(x); st_bf16x8_T(AtT, c8, t, x);
#pragma unroll
        for (int j = 0; j < 8; ++j) { const float e = __expf(-Lt[j]); x[j] = P.b[j] * e; y[j] = P.kp[j] * e; }
        *(LAS v4u*)(Bt + t * MP + c8) = pack8(x); *(LAS v4u*)(Kt + t * MP + c8) = pack8(y);
#pragma unroll
        for (int j = 0; j < 8; ++j) x[j] = P.r[j] * __expf(Lt[j]);
        *(LAS v4u*)(Rt + t * MP + c8) = pack8(x);
#pragma unroll
        for (int j = 0; j < 8; ++j) { const float e = __expf(LC[j] - Lt[j]); x[j] = P.b[j] * e; y[j] = P.kp[j] * e; }
        st_bf16x8_T(BhT, c8, t, x); st_bf16x8_T(KhT, c8, t, y); st_bf16x8_T(VT, c8, t, P.v);
    }
    bar_lds();
    WTile w; w.ta = wave & 3; w.tb0 = (wave >> 2) * 2; w.fr = lane & 15; w.fq = lane >> 4;
    f32x4 acc[2], Tacc[2];
    ZERO2(Tacc); mm2(At, Bt, w, Tacc); mask2<2>(Tacc, w);
    ZERO2(acc); mm2(Kt, At, w, acc); mask2<0>(acc, w);
    f32x4 rb[2], rk[2]; ZERO2(rb); mm2(Bt, Rt, w, rb); mask2<1>(rb, w); ZERO2(rk); mm2(Kt, Rt, w, rk); mask2<1>(rk, w);
    bar_lds();
#pragma unroll
    for (int ci = 0; ci < 2; ++ci) { st_N(Pm, w.ta, w.tb0 + ci, w, Tacc[ci]); st_T(PT, w.ta, w.tb0 + ci, w, Tacc[ci]);
        st_T(AAK, w.ta, w.tb0 + ci, w, acc[ci]); st_T(ARB, w.ta, w.tb0 + ci, w, rb[ci]); st_T(ARK, w.ta, w.tb0 + ci, w, rk[ci]);
#pragma unroll
        for (int j = 0; j < 4; ++j) if (16 * w.ta + 4 * w.fq + j == 16 * (w.tb0 + ci) + w.fr) Tacc[ci][j] += 1.f;
        st_N(TM, w.ta, w.tb0 + ci, w, Tacc[ci]); }
    bar_lds();
#pragma unroll 1
#ifdef PROBE_NEU2
    for (int n = 0; n < 10; ++n) {
#else
    for (int n = 0; n < 5; ++n) {
#endif
        ZERO2(acc); mm2(Pm, PT, w, acc);
        bar_lds();
#pragma unroll
        for (int ci = 0; ci < 2; ++ci) { st_N(Pm, w.ta, w.tb0 + ci, w, acc[ci]); st_T(PT, w.ta, w.tb0 + ci, w, acc[ci]); }
        bar_lds();
        mm2(TM, PT, w, Tacc);
        bar_lds();
#pragma unroll
        for (int ci = 0; ci < 2; ++ci) st_N(TM, w.ta, w.tb0 + ci, w, Tacc[ci]);
        bar_lds();
    }
    ZERO2(acc); mm2(TM, AtT, w, acc); ZERO2(rb); mm2(AAK, VT, w, rb);
#pragma unroll
    for (int ci = 0; ci < 2; ++ci) { st_T(WT, w.ta, w.tb0 + ci, w, acc[ci]); st_T(X1T, w.ta, w.tb0 + ci, w, rb[ci]); }
    bar_lds();
    const size_t ub = (size_t)unit * 4096;
    { ZERO2(acc); mm2(TM, X1T, w, acc);
#pragma unroll
      for (int ci = 0; ci < 2; ++ci) st_T(U2T, w.ta, w.tb0 + ci, w, acc[ci]);
      bf16* MF = (bf16*)(a.ws + WS_MF) + ub; bf16* QF = (bf16*)(a.ws + WS_QF) + ub;
      ZERO2(acc); mm2(WT, BhT, w, acc);
      ZERO2(rb); mm2(WT, ARB, w, rb);
#pragma unroll
      for (int ci = 0; ci < 2; ++ci) { const int tb = w.tb0 + ci; const int col = 16 * tb + w.fr; const float gc = GC[col];
          f32x4 m = acc[ci];
#pragma unroll
          for (int j = 0; j < 4; ++j) if (16 * w.ta + 4 * w.fq + j == col) m[j] += gc;
          const size_t fo = (size_t)((tb * 2 + (w.ta >> 1)) * 64 + lane) * 8 + 4 * (w.ta & 1);
          v2u o; o.x = pk2(m[0], m[1]); o.y = pk2(m[2], m[3]); *(v2u*)(MF + fo) = o;
          const v2u rr = *(const LAS v2u*)(Rt + col * MP + 16 * w.ta + 4 * w.fq);
          f32x4 q = rb[ci]; q[0] += bflo(rr.x); q[1] += bfhi(rr.x); q[2] += bflo(rr.y); q[3] += bfhi(rr.y);
          o.x = pk2(q[0], q[1]); o.y = pk2(q[2], q[3]); *(v2u*)(QF + fo) = o; } }
    bar_lds();
    { float* NF = (float*)((unsigned char*)a.out + OUT_NF) + ub; float* Y2 = (float*)((unsigned char*)a.out + OUT_Y2) + ub;
      ZERO2(acc); mm2(BhT, U2T, w, acc); mm2(KhT, VT, w, acc);
      ZERO2(rb); mm2(U2T, ARB, w, rb); mm2(VT, ARK, w, rb);
#pragma unroll
      for (int ci = 0; ci < 2; ++ci) { const int tb = w.tb0 + ci;
          *(f32x4*)(NF + (size_t)((tb * 4 + w.ta) * 64 + lane) * 4) = acc[ci];
          *(f32x4*)(Y2 + (size_t)(16 * tb + w.fr) * 64 + 16 * w.ta + 4 * w.fq) = rb[ci]; } }
}

constexpr int KR = 4, NR = NCH / KR, SLOT = 10240, RBUF = KR * SLOT, NPIECE = RBUF / 16, LPT = 6, PPC = SLOT / 16;
__device__ __forceinline__ const v4u* sp_src(const Args& a, int h, int cg, int r, int p) {
    const int cc = p / PPC, q = p % PPC, c = r * KR + cc; const size_t ub = (size_t)(c * 16 + h) * 4096;
    return q < 512 ? (const v4u*)((const bf16*)(a.ws + WS_MF) + ub) + q : (const v4u*)((const bf16*)((const unsigned char*)a.out + OUT_NF) + ub + cg * 1024) + (q - 512);
}
__device__ __forceinline__ void state_pass(const Args& a, LAS unsigned char* lds, int b, int tid, int wave, int lane) {
    const int h = b & 15, cg = b >> 4, lt = tid - 64;
    v4u ra[LPT], rb[LPT];
    if (wave != 0) {
#pragma unroll
        for (int i = 0; i < LPT; ++i) { const int p = lt + 448 * i; if (p < NPIECE) ra[i] = *sp_src(a, h, cg, 0, p); }
#pragma unroll
        for (int i = 0; i < LPT; ++i) { const int p = lt + 448 * i; if (p < NPIECE) *(LAS v4u*)(lds + p * 16) = ra[i]; }
#pragma unroll
        for (int i = 0; i < LPT; ++i) { const int p = lt + 448 * i; if (p < NPIECE) ra[i] = *sp_src(a, h, cg, 1, p); }
    }
    f32x4 st[4];
#pragma unroll
    for (int i = 0; i < 4; ++i) st[i] = (f32x4){0.f, 0.f, 0.f, 0.f};
    bar_lds();
    bf16* SF = (bf16*)(a.ws + WS_SF);
#define SP_ROUND(r_, RA, RB) do { \
        if (wave != 0) { \
            if ((r_) + 2 < NR) { _Pragma("unroll") for (int i = 0; i < LPT; ++i) { const int p = lt + 448 * i; if (p < NPIECE) RB[i] = *sp_src(a, h, cg, (r_) + 2, p); } } \
            if ((r_) + 1 < NR) { _Pragma("unroll") for (int i = 0; i < LPT; ++i) { const int p = lt + 448 * i; if (p < NPIECE) *(LAS v4u*)(lds + (((r_) + 1) & 1) * RBUF + p * 16) = RA[i]; } } \
        } else { \
            _Pragma("unroll") for (int cc = 0; cc < KR; ++cc) { \
                const LAS unsigned char* sl = lds + ((r_) & 1) * RBUF + cc * SLOT; const int c = (r_) * KR + cc; \
                v4u b0, b1; b0.x = pk2(st[0][0], st[0][1]); b0.y = pk2(st[0][2], st[0][3]); b0.z = pk2(st[1][0], st[1][1]); b0.w = pk2(st[1][2], st[1][3]); \
                b1.x = pk2(st[2][0], st[2][1]); b1.y = pk2(st[2][2], st[2][3]); b1.z = pk2(st[3][0], st[3][1]); b1.w = pk2(st[3][2], st[3][3]); \
                v4u* sfo = (v4u*)(SF + (size_t)(c * 16 + h) * 4096) + (cg * 2) * 64 + lane; sfo[0] = b0; sfo[64] = b1; \
                const bf16x8 f0 = __builtin_bit_cast(bf16x8, b0), f1 = __builtin_bit_cast(bf16x8, b1); \
                _Pragma("unroll") for (int rt = 0; rt < 4; ++rt) { \
                    const v2u nb_ = *(const LAS v2u*)(sl + 8192 + (rt * 64 + lane) * 8); f32x4 n = {bflo(nb_.x), bfhi(nb_.x), bflo(nb_.y), bfhi(nb_.y)}; \
                    n = MFMA16(*(const LAS bf16x8*)(sl + ((rt * 2 + 0) * 64 + lane) * 16), f0, n); \
                    n = MFMA16(*(const LAS bf16x8*)(sl + ((rt * 2 + 1) * 64 + lane) * 16), f1, n); st[rt] = n; } \
            } \
        } \
        bar_lds(); } while (0)
#pragma unroll 1
    for (int r = 0; r < NR; r += 2) { SP_ROUND(r, ra, rb); SP_ROUND(r + 1, rb, ra); }
#undef SP_ROUND
}

__device__ __forceinline__ void rwkv_out_unit(const Args& a, LAS unsigned char* lds, int unit, int tid, int wave, int lane) {
    const int c = unit >> 4, h = unit & 15, t0 = c * CH, t = tid >> 3, c8 = (tid & 7) * 8, ch = h * 64 + c8;
    const size_t ub = (size_t)unit * 4096;
    const bf16* QF = (const bf16*)(a.ws + WS_QF) + ub; const bf16* SF = (const bf16*)(a.ws + WS_SF) + ub; const bf16* Y2 = (const bf16*)((const unsigned char*)a.out + OUT_Y2) + ub;
    LAS float* SY = (LAS float*)lds;
    const int ta = wave & 3, tb0 = (wave >> 2) * 2, fr = lane & 15, fq = lane >> 4;
    bf16x8 af[2], bfr[2][2];
#pragma unroll
    for (int s = 0; s < 2; ++s) { af[s] = *(const bf16x8*)(QF + (size_t)((ta * 2 + s) * 64 + lane) * 8);
#pragma unroll
        for (int ci = 0; ci < 2; ++ci) bfr[s][ci] = *(const bf16x8*)(SF + (size_t)(((tb0 + ci) * 2 + s) * 64 + lane) * 8); }
    float y2[8], v[8], g[8];
    unpack8(ldg16(Y2 + t * 64 + c8), y2);
    const bf16* proj = (const bf16*)(a.ws + WS_PROJ);
    load_shift8(proj, t0 + t, C_V + ch, a.in[3], v); load_shift8(proj, t0 + t, C_G + ch, a.in[3], g);
    const float bonus = ((const float*)(a.ws + WS_BON))[(size_t)(t0 + t) * 16 + h];
    f32x4 acc[2]; ZERO2(acc);
#pragma unroll
    for (int s = 0; s < 2; ++s)
#pragma unroll
        for (int ci = 0; ci < 2; ++ci) acc[ci] = MFMA16(af[s], bfr[s][ci], acc[ci]);
    bar_lds();
#pragma unroll
    for (int ci = 0; ci < 2; ++ci)
#pragma unroll
        for (int j = 0; j < 4; ++j) SY[(16 * ta + 4 * fq + j) * 68 + 16 * (tb0 + ci) + fr] = acc[ci][j];
    bar_lds();
    float y[8];
#pragma unroll
    for (int j = 0; j < 8; ++j) y[j] = SY[t * 68 + c8 + j] + y2[j];
    rwkv_out8(a, y, v, g, bonus, t0 + t, ch);
}
constexpr int L2_SEG = 129280, L2_XST = 131328, L2_TW = 131584, L2_ADM = 140800, L2_X1T = 150016;
struct PF { v4u p[4], q[4]; };
__device__ __forceinline__ void pf_issue(PF& f, const bf16* proj, int row, int ch) {
    const int cols[4] = {C_R, C_K, C_V, C_G};
#pragma unroll
    for (int i = 0; i < 4; ++i) { f.p[i] = ldg16(proj + (size_t)row * NINP + cols[i] + ch); f.q[i] = (v4u){0u, 0u, 0u, 0u}; if (row > 0) f.q[i] = ldg16(proj + (size_t)(row - 1) * NINP + cols[i] + ch); }
}
__device__ __forceinline__ void pf_shift(const v4u& p, const v4u& q, const float (&mf)[8], float (&o)[8]) {
    float pf[8], qf[8]; unpack8(p, pf); unpack8(q, qf);
#pragma unroll
    for (int j = 0; j < 8; ++j) o[j] = pf[j] + (qf[j] - pf[j]) * mf[j];
}
template <bool DOP, bool DOT> __device__ __forceinline__ void neu_stage(const LAS bf16* Pin, const LAS bf16* PTin, LAS bf16* Pout, LAS bf16* PTout, const LAS bf16* TMin, LAS bf16* TMout, const WTile& w, f32x4 (&Tacc)[2]) {
    f32x4 acc[2];
    if (DOP) { ZERO2(acc); mm2(Pin, PTin, w, acc); }
    if (DOT) mm2(TMin, PTin, w, Tacc);
#pragma unroll
    for (int ci = 0; ci < 2; ++ci) {
        if (DOP) { st_N(Pout, w.ta, w.tb0 + ci, w, acc[ci]); st_T(PTout, w.ta, w.tb0 + ci, w, acc[ci]); }
        if (DOT) st_N(TMout, w.ta, w.tb0 + ci, w, Tacc[ci]);
    }
    bar_lds();
}
__device__ __forceinline__ void rwkv_chunk_group(const Args& a, LAS unsigned char* lds, int item, int tid, int wave, int lane) {
    const int c = item >> 1, hg = item & 1, t0 = c * CH, t = tid >> 3, c8 = (tid & 7) * 8, row = t0 + t;
    const bf16* proj = (const bf16*)(a.ws + WS_PROJ); const bf16* upt = (const bf16*)(a.ws + WS_UPT); const bf16* aupt = upt + 65536; const float* mu = a.in[3];
    LAS bf16* TW = (LAS bf16*)(lds + L2_TW); LAS bf16* ADm = (LAS bf16*)(lds + L2_ADM);
    WTile w; w.ta = wave & 3; w.tb0 = (wave >> 2) * 2; w.fr = lane & 15; w.fq = lane >> 4;
    bar_lds();
    { float x[8]; load_shift8(proj, row, C_WD + c8, mu, x);
#pragma unroll
      for (int j = 0; j < 8; ++j) x[j] = 1.f - 2.f * __builtin_amdgcn_rcpf(1.f + __expf(2.f * x[j]));
      *(LAS v4u*)(TW + t * 72 + c8) = pack8(x);
      load_shift8(proj, row, C_AD + c8, mu, x); *(LAS v4u*)(ADm + t * 72 + c8) = pack8(x); }
    PF pf; pf_issue(pf, proj, row, hg * 512 + c8);
#pragma unroll 1
    for (int hh = 0; hh < 8; ++hh) {
        const int h = hg * 8 + hh, ch = h * 64 + c8, unit = c * 16 + h;
        LAS unsigned char* L = lds; asm volatile("" : "+v"(L));
        LAS bf16* At = (LAS bf16*)(L + L_AT); LAS bf16* AtT = (LAS bf16*)(L + L_ATT); LAS bf16* Bt = (LAS bf16*)(L + L_BT); LAS bf16* Kt = (LAS bf16*)(L + L_KT);
        LAS bf16* Rt = (LAS bf16*)(L + L_RT); LAS bf16* BhT = (LAS bf16*)(L + L_BHT); LAS bf16* KhT = (LAS bf16*)(L + L_KHT); LAS bf16* VT = (LAS bf16*)(L + L_VT);
        LAS bf16* P0 = (LAS bf16*)(L + L_P); LAS bf16* PT0 = (LAS bf16*)(L + L_PT); LAS bf16* TM0 = (LAS bf16*)(L + L_TM);
        LAS bf16* P1 = At; LAS bf16* PT1 = Bt; LAS bf16* TM1 = Kt;
        LAS bf16* AAK = (LAS bf16*)(L + L_AAK); LAS bf16* ARB = (LAS bf16*)(L + L_ARB); LAS bf16* ARK = (LAS bf16*)(L + L_ARK);
        LAS float* SEG = (LAS float*)(L + L2_SEG); LAS float* GC = (LAS float*)(L + L_GC);
        LAS bf16* X1T = (LAS bf16*)(L + L2_X1T);
        LAS float* Z = (LAS float*)(L + 18432); LAS float* AP = Z + 64 * 68;
        LAS bf16* WT = At; LAS bf16* U2T = Bt;
        bf16x8 bU[2][2], bA[2][2];
#pragma unroll
        for (int ci = 0; ci < 2; ++ci)
#pragma unroll
            for (int s = 0; s < 2; ++s) { const size_t bo = (size_t)(h * 64 + 16 * (w.tb0 + ci) + w.fr) * 64 + 32 * s + 8 * w.fq; bU[ci][s] = *(const bf16x8*)(upt + bo); bA[ci][s] = *(const bf16x8*)(aupt + bo); }
        float pw0[8], pa0[8], pkk[8], pka[8], prk[8], mur[8], muk[8], muv[8];
        ld8f(a.in[4] + ch, pw0); ld8f(a.in[6] + ch, pa0); ld8f(a.in[8] + ch, pkk); ld8f(a.in[9] + ch, pka); ld8f(a.in[10] + ch, prk);
        ld8f(mu + C_R + ch, mur); ld8f(mu + C_K + ch, muk); ld8f(mu + C_V + ch, muv);
        bar_lds();
#ifdef PROBE_G
        if (blockIdx.x == 0 && tid == 0 && hh == 3) ((unsigned long long*)(a.ws + 65536))[0] = __builtin_amdgcn_s_memrealtime();
#endif

        { const int rt = w.ta, cp = w.tb0, fr = w.fr, fq = w.fq;
          bf16x8 aT[2], aA[2];
#pragma unroll
          for (int s = 0; s < 2; ++s) { aT[s] = *(const LAS bf16x8*)(TW + (16 * rt + fr) * 72 + 32 * s + 8 * fq); aA[s] = *(const LAS bf16x8*)(ADm + (16 * rt + fr) * 72 + 32 * s + 8 * fq); }
#pragma unroll
          for (int ci = 0; ci < 2; ++ci) { const int ct = cp + ci; f32x4 z = {0.f, 0.f, 0.f, 0.f}, ap = {0.f, 0.f, 0.f, 0.f};
#pragma unroll
              for (int s = 0; s < 2; ++s) { z = MFMA16(aT[s], bU[ci][s], z); ap = MFMA16(aA[s], bA[ci][s], ap); }
#pragma unroll
              for (int j = 0; j < 4; ++j) { Z[(16 * rt + 4 * fq + j) * 68 + 16 * ct + fr] = z[j]; AP[(16 * rt + 4 * fq + j) * 68 + 16 * ct + fr] = ap[j]; } } }
        bar_lds();
#ifdef PROBE_G
        if (blockIdx.x == 0 && tid == 0 && hh == 3) ((unsigned long long*)(a.ws + 65536))[1] = __builtin_amdgcn_s_memrealtime();
#endif
        float r[8], kp[8], vv[8], lw[8], kk[8], bb[8];
        { float zz[8], aa[8], kr[8];
#pragma unroll
          for (int j = 0; j < 8; ++j) { zz[j] = Z[t * 68 + c8 + j]; aa[j] = AP[t * 68 + c8 + j]; }
          pf_shift(pf.p[0], pf.q[0], mur, r); pf_shift(pf.p[1], pf.q[1], muk, kr); pf_shift(pf.p[2], pf.q[2], muv, vv);
#pragma unroll
          for (int j = 0; j < 8; ++j) { const float z = pw0[j] + zz[j]; lw[j] = -0.60653066f * __builtin_amdgcn_rcpf(1.f + __expf(-z)); aa[j] = sigmoidf_(pa0[j] + aa[j]); }
          float ss = 0.f;
#pragma unroll
          for (int j = 0; j < 8; ++j) { kk[j] = kr[j] * pkk[j]; ss += kk[j] * kk[j]; kp[j] = kr[j] * (1.f + (aa[j] - 1.f) * pka[j]); }
          ss = sum8(ss); const float rn = 1.f / fmaxf(sqrtf(ss), 1e-12f);
          float bs = 0.f;
#pragma unroll
          for (int j = 0; j < 8; ++j) { kk[j] *= rn; bb[j] = kk[j] * aa[j]; bs += r[j] * kp[j] * prk[j]; }
          bs = sum8(bs);
          if ((tid & 7) == 0) ((float*)(a.ws + WS_BON))[(size_t)row * 16 + h] = bs; }
        if (hh < 7) pf_issue(pf, proj, row, ch + 64);
        float Lt[8];
#pragma unroll
        for (int j = 0; j < 8; ++j) { float x = lw[j];
#pragma unroll
            for (int d = 8; d < 64; d <<= 1) { const float y = __shfl_up(x, d); if (lane >= d) x += y; }
            Lt[j] = x; }
        if ((lane >> 3) == 7) {
#pragma unroll
            for (int j = 0; j < 8; ++j) SEG[wave * 64 + c8 + j] = Lt[j]; }
        bar_lds();
        {
            float gc[8], x[8], y[8];
            { float off[8], tot[8];
#pragma unroll
              for (int j = 0; j < 8; ++j) { off[j] = 0.f; tot[j] = 0.f; }
#pragma unroll
              for (int s = 0; s < 8; ++s) { const f32x4 s0 = *(const LAS f32x4*)(SEG + s * 64 + c8), s1 = *(const LAS f32x4*)(SEG + s * 64 + c8 + 4);
                  const float sv[8] = {s0.x, s0.y, s0.z, s0.w, s1.x, s1.y, s1.z, s1.w};
#pragma unroll
                  for (int j = 0; j < 8; ++j) { tot[j] += sv[j]; if (s < wave) off[j] += sv[j]; } }
#pragma unroll
              for (int j = 0; j < 8; ++j) { Lt[j] += off[j]; gc[j] = __expf(tot[j]); } }
            if (t == 0) {
#pragma unroll
                for (int j = 0; j < 8; ++j) GC[c8 + j] = gc[j]; }
            float e1[8], ie1[8];
#pragma unroll
            for (int j = 0; j < 8; ++j) { e1[j] = __expf(Lt[j]); ie1[j] = __builtin_amdgcn_rcpf(e1[j]); }
#pragma unroll
            for (int j = 0; j < 8; ++j) x[j] = -kk[j] * __expf(Lt[j] - lw[j]);
            *(LAS v4u*)(At + t * MP + c8) = pack8(x); st_bf16x8_T2(AtT, c8, t, lane, x);
#pragma unroll
            for (int j = 0; j < 8; ++j) { x[j] = bb[j] * ie1[j]; y[j] = kp[j] * ie1[j]; }
            *(LAS v4u*)(Bt + t * MP + c8) = pack8(x); *(LAS v4u*)(Kt + t * MP + c8) = pack8(y);
#pragma unroll
            for (int j = 0; j < 8; ++j) x[j] = r[j] * e1[j];
            *(LAS v4u*)(Rt + t * MP + c8) = pack8(x);
#pragma unroll
            for (int j = 0; j < 8; ++j) { const float e = gc[j] * ie1[j]; x[j] = bb[j] * e; y[j] = kp[j] * e; }
            st_bf16x8_T2(BhT, c8, t, lane, x); st_bf16x8_T2(KhT, c8, t, lane, y); st_bf16x8_T2(VT, c8, t, lane, vv);
        }
        bar_lds();
#ifdef PROBE_G
        if (blockIdx.x == 0 && tid == 0 && hh == 3) ((unsigned long long*)(a.ws + 65536))[2] = __builtin_amdgcn_s_memrealtime();
#endif
        f32x4 acc[2], Tacc[2], rb[2], rk[2];
        ZERO2(Tacc); mm2(At, Bt, w, Tacc); mask2<2>(Tacc, w);
        ZERO2(acc); mm2(Kt, At, w, acc); mask2<0>(acc, w);
        ZERO2(rb); mm2(Bt, Rt, w, rb); mask2<1>(rb, w); ZERO2(rk); mm2(Kt, Rt, w, rk); mask2<1>(rk, w);
        bar_lds();
#pragma unroll
        for (int ci = 0; ci < 2; ++ci) { st_N(P1, w.ta, w.tb0 + ci, w, Tacc[ci]); st_T(PT1, w.ta, w.tb0 + ci, w, Tacc[ci]);
            st_T(AAK, w.ta, w.tb0 + ci, w, acc[ci]); st_T(ARB, w.ta, w.tb0 + ci, w, rb[ci]); st_T(ARK, w.ta, w.tb0 + ci, w, rk[ci]);
#pragma unroll
            for (int j = 0; j < 4; ++j) if (16 * w.ta + 4 * w.fq + j == 16 * (w.tb0 + ci) + w.fr) Tacc[ci][j] += 1.f;
            st_N(TM1, w.ta, w.tb0 + ci, w, Tacc[ci]); }
        bar_lds();
#ifdef PROBE_G
        if (blockIdx.x == 0 && tid == 0 && hh == 3) ((unsigned long long*)(a.ws + 65536))[3] = __builtin_amdgcn_s_memrealtime();
#endif
        { ZERO2(acc); mm2(AAK, VT, w, acc);
#pragma unroll
          for (int ci = 0; ci < 2; ++ci) st_T(X1T, w.ta, w.tb0 + ci, w, acc[ci]); }
        neu_stage<true, false>(P1, PT1, P0, PT0, nullptr, nullptr, w, Tacc);
#pragma unroll 1
        for (int n = 0; n < 2; ++n) {
            neu_stage<true, true>(P0, PT0, P1, PT1, TM1, TM0, w, Tacc);
            neu_stage<true, true>(P1, PT1, P0, PT0, TM0, TM1, w, Tacc);
        }
        neu_stage<false, true>(P0, PT0, nullptr, nullptr, TM1, TM0, w, Tacc);

#ifdef PROBE_G
        if (blockIdx.x == 0 && tid == 0 && hh == 3) ((unsigned long long*)(a.ws + 65536))[4] = __builtin_amdgcn_s_memrealtime();
#endif
        ZERO2(acc); mm2(TM0, AtT, w, acc); ZERO2(rb); mm2(TM0, X1T, w, rb);
#pragma unroll
        for (int ci = 0; ci < 2; ++ci) { st_T(WT, w.ta, w.tb0 + ci, w, acc[ci]); st_T(U2T, w.ta, w.tb0 + ci, w, rb[ci]); }
        bar_lds();
        const size_t ub = (size_t)unit * 4096;
        { bf16* MF = (bf16*)(a.ws + WS_MF) + ub; bf16* QF = (bf16*)(a.ws + WS_QF) + ub;
          ZERO2(acc); mm2(WT, BhT, w, acc); ZERO2(rb); mm2(WT, ARB, w, rb);
#pragma unroll
          for (int ci = 0; ci < 2; ++ci) { const int tb = w.tb0 + ci; const int col = 16 * tb + w.fr; const float gcv = GC[col];
              f32x4 m = acc[ci];
#pragma unroll
              for (int j = 0; j < 4; ++j) if (16 * w.ta + 4 * w.fq + j == col) m[j] += gcv;
              const size_t fo = (size_t)((tb * 2 + (w.ta >> 1)) * 64 + lane) * 8 + 4 * (w.ta & 1);
              v2u o; o.x = pk2(m[0], m[1]); o.y = pk2(m[2], m[3]); *(v2u*)(MF + fo) = o;
              const v2u rr = *(const LAS v2u*)(Rt + col * MP + 16 * w.ta + 4 * w.fq);
              f32x4 q = rb[ci]; q[0] += bflo(rr.x); q[1] += bfhi(rr.x); q[2] += bflo(rr.y); q[3] += bfhi(rr.y);
              o.x = pk2(q[0], q[1]); o.y = pk2(q[2], q[3]); *(v2u*)(QF + fo) = o; }
          bf16* NF = (bf16*)((unsigned char*)a.out + OUT_NF) + ub; bf16* Y2 = (bf16*)((unsigned char*)a.out + OUT_Y2) + ub;
          ZERO2(acc); mm2(BhT, U2T, w, acc); mm2(KhT, VT, w, acc);
          ZERO2(rb); mm2(U2T, ARB, w, rb); mm2(VT, ARK, w, rb);
#pragma unroll
          for (int ci = 0; ci < 2; ++ci) { const int tb = w.tb0 + ci;
              v2u o; o.x = pk2(acc[ci][0], acc[ci][1]); o.y = pk2(acc[ci][2], acc[ci][3]); *(v2u*)(NF + (size_t)((tb * 4 + w.ta) * 64 + lane) * 4) = o;
              o.x = pk2(rb[ci][0], rb[ci][1]); o.y = pk2(rb[ci][2], rb[ci][3]); *(v2u*)(Y2 + (size_t)(16 * tb + w.fr) * 64 + 16 * w.ta + 4 * w.fq) = o; } }

#ifdef PROBE_G
        if (blockIdx.x == 0 && tid == 0 && hh == 3) ((unsigned long long*)(a.ws + 65536))[5] = __builtin_amdgcn_s_memrealtime();
#endif
    }
}
#ifndef HOSTDUP
#define HOSTDUP -1
#endif
#ifndef ONE_LAUNCH
#define ONE_LAUNCH 1
#endif
#if HOSTDUP != -1 || defined(MULTI)
#undef ONE_LAUNCH
#define ONE_LAUNCH 0
#endif
constexpr int NPHASE = 7;
__global__ void __launch_bounds__(NTHR, 2) mega(Args a) {
    extern __shared__ __attribute__((aligned(16))) unsigned char lds_[];
    LAS unsigned char* lds = (LAS unsigned char*)lds_;
    const int tid = threadIdx.x, lane = tid & 63, wave = __builtin_amdgcn_readfirstlane(tid >> 6);
    const int G = gridDim.x, bx = blockIdx.x, vcu = (G % 8 == 0) ? (bx % 8) * (G / 8) + bx / 8 : bx;
    cg::grid_group grid = cg::this_grid();
    volatile LAS unsigned* xst = (volatile LAS unsigned*)(lds + L2_XST);
    if (tid < 2) xst[tid] = 0u;
    __syncthreads();
    XcdBarrier xbar; xbar.bar = (unsigned*)a.ws; xbar.x = 0; xbar.st = xst;
    if (a.ph_hi - a.ph_lo > 1) xbar = xcd_barrier_post((unsigned*)a.ws, xst);
#ifndef PROBE_Q
#define PROBE_Q 1
#endif
#ifdef PROBE_TS
    unsigned long long ts_[10];
#define STAMP(i) do { ts_[i] = __builtin_amdgcn_s_memrealtime(); } while (0)
#else
#define STAMP(i) do {} while (0)
#endif
    STAMP(0);
#define IN(k) (a.ph_lo <= (k) && (k) < a.ph_hi)
#define SEAM(k) do { if (IN(k) && IN((k) + 1)) xcd_barrier(xbar); } while (0)
    if (a.ph_lo < 0) grid.sync();
    if (IN(0)) { p0_prologue(a, lds, vcu, G, wave, lane); }
    SEAM(0); STAMP(1);
    if (IN(1)) {
        constexpr int N1 = 6144;
        pg8::Gemm g{(const pg8::bf16_t*)(a.ws + WS_XN), (const pg8::bf16_t*)(a.ws + WS_WTIN), T, (G == 256 ? N1 : NINP), D}; pg8::StaticOrder S; S.init(T, (G == 256 ? N1 : NINP), G, bx);
        pg8::EpiBf16<0> E{(pg8::bf16_t*)(a.ws + WS_PROJ), NINP, nullptr, 0, 0, 1.f};
        pg8::gemm_phase<pg8::EpiBf16<0>, pg8::StaticOrder, true, true>(lds, g, S, E);
    }
    SEAM(1); STAMP(2);
    if (IN(2)) {
        for (int it = bx; it < NCH * 2; it += G) rwkv_chunk_group(a, lds, it, tid, wave, lane);
    }
    SEAM(2); STAMP(3);
    if (IN(3)) {
        if (bx < 64) state_pass(a, lds, bx, tid, wave, lane);
        else if (G == 256 && bx < 128) {
            pg8::Gemm g{(const pg8::bf16_t*)(a.ws + WS_XN), (const pg8::bf16_t*)(a.ws + WS_WTIN), T, NINP, D}; pg8::OneTile S{(bx - 64) >> 1, 24 + ((bx - 64) & 1)};
            pg8::EpiBf16<0> E{(pg8::bf16_t*)(a.ws + WS_PROJ), NINP, nullptr, 0, 0, 1.f};
            pg8::gemm_phase<pg8::EpiBf16<0>, pg8::OneTile, true, true>(lds, g, S, E);
        } else if (G == 256) { for (int it = bx - 128; it < 256; it += 128) attn_unit(a, lds, 2 * it, tid, wave, lane); }
    }
    SEAM(3); STAMP(4);
    if (IN(4)) {
        if (G == 256) { for (int it = bx; it < 256; it += G) attn_unit(a, lds, 2 * it + 1, tid, wave, lane); }
        else { for (int it = bx; it < 512; it += G) attn_unit(a, lds, it, tid, wave, lane); }
        STAMP(8);
        for (int u = bx; u < NCH * NH; u += G) rwkv_out_unit(a, lds, u, tid, wave, lane);
    }
    SEAM(4); STAMP(5);
    if (IN(5)) {
        pg8::Gemm g{(const pg8::bf16_t*)(a.ws + WS_MIX), (const pg8::bf16_t*)(a.ws + WS_WTOUT), T, D, D}; pg8::StaticOrder S; S.init(T, D, G, bx);
        if (G == 256 && a.ph_hi - a.ph_lo > 1) {
            pg8::EpiResidNorm E{a.in[0], a.out, (float*)(a.ws + WS_SSP), (unsigned*)a.ws + 4096, a.in[15], D, RMS_EPS};
            pg8::gemm_phase<pg8::EpiResidNorm, pg8::StaticOrder, false, true>(lds, g, S, E);
        } else {
            pg8::EpiResid E{a.in[0], a.out, (float*)(a.ws + WS_SSP), D};
            pg8::gemm_phase<pg8::EpiResid, pg8::StaticOrder, true, true>(lds, g, S, E);
        }
    }
    if (!(G == 256 && a.ph_hi - a.ph_lo > 1)) { SEAM(5); } STAMP(6);
    if (IN(6) && !(G == 256 && a.ph_hi - a.ph_lo > 1)) final_norm(a, vcu, G, wave, lane);
#ifdef PROBE_G
    __syncthreads();
    if (bx == 0 && tid == 0) { const unsigned long long* g_ = (const unsigned long long*)(a.ws + 65536); a.out[0] = (float)(g_[PROBE_G + 1] - g_[PROBE_G]) * 0.1f; }
#endif
#ifdef PROBE_TS
    STAMP(7); __syncthreads();
    if (bx == 0 && tid == 0) { const int k_ = PROBE_TS; const unsigned long long d_ = (k_ == 9) ? ts_[7] - ts_[0] : (k_ == 8) ? ts_[8] - ts_[4] : ts_[k_ + 1] - ts_[k_]; a.out[0] = (float)(((int)((float)d_ * 0.01f) / PROBE_Q) * PROBE_Q + PROBE_Q / 2); }
#endif
#undef IN
#undef SEAM
}

extern "C" void kernel_launch(void* const* d_in, const int* in_sizes, int n_in, void* d_out, int out_size, void* d_ws, size_t ws_size, hipStream_t stream) {
    static int grid = 0;
    if (grid == 0) {
        int dev = 0, cus = 0;
        if (hipGetDevice(&dev) != hipSuccess || hipDeviceGetAttribute(&cus, hipDeviceAttributeMultiprocessorCount, dev) != hipSuccess) { fprintf(stderr, "kernel_launch: device query failed\n"); grid = -1; return; }
        if (hipFuncSetAttribute((const void*)mega, hipFuncAttributeMaxDynamicSharedMemorySize, LDS_BYTES) != hipSuccess) { fprintf(stderr, "kernel_launch: hipFuncSetAttribute failed\n"); grid = -1; return; }
        (void)hipGetLastError();
        grid = cus;
    }
    if (grid < 0) return;
    Args a{};
    for (int i = 0; i < 16; ++i) a.in[i] = (const float*)d_in[i];
    a.out = (float*)d_out; a.ws = (unsigned char*)d_ws;
#if ONE_LAUNCH
    (void)hipMemsetAsync(d_ws, 0, 32768, stream);
    a.ph_lo = 0; a.ph_hi = NPHASE;
    void* args[] = {&a};
    hipError_t e = hipLaunchCooperativeKernel((const void*)mega, dim3(grid), dim3(NTHR), args, LDS_BYTES, stream);
    if (e != hipSuccess) fprintf(stderr, "cooperative launch failed: %s (grid %d)\n", hipGetErrorString(e), grid);
#else
    for (int p = 0; p < NPHASE; ++p) for (int rep = 0; rep < (p == HOSTDUP ? 2 : 1); ++rep) { a.ph_lo = p; a.ph_hi = p + 1; hipLaunchKernelGGL(mega, dim3(grid), dim3(NTHR), LDS_BYTES, stream, a); }
#endif
}
```

```cpp
#define ONE 1
#include <hip/hip_runtime.h>
#include <hip/hip_cooperative_groups.h>
#include <cstdio>
#include <cstdint>
namespace cg = cooperative_groups;
namespace pg8 {
#define PG8_LAS __attribute__((address_space(3)))
typedef unsigned short bf16_t;
typedef short bf16x8 __attribute__((ext_vector_type(8)));
typedef float f32x4 __attribute__((ext_vector_type(4)));
typedef unsigned u32x4 __attribute__((ext_vector_type(4)));
constexpr int BM = 256, BK = 64, HALF = 128, HTB = HALF * BK * 2  , STAGE_BYTES = 8 * HTB, NXCD = 8, WGM = 8;

__host__ __device__ __forceinline__ int lds_byte(int r, int c) { const int st = (r >> 4) * 2 + (c >> 5), rr = r & 15, cc = c & 31, ob = rr * 64 + cc * 2; return st * 1024 + (ob ^ (((ob >> 9) & 1) << 5)); }
__host__ __device__ __forceinline__ void stage_rc(int b, int& R, int& C) { const int st = b / 1024, sb = b % 1024, swz = sb ^ (((sb >> 9) & 1) << 5); R = (st >> 1) * 16 + swz / 64; C = (st & 1) * 32 + (swz % 64) / 2; }
__host__ __device__ __forceinline__ int perm32(int rho) { const int n = rho >> 4, i = rho & 15; return 8 * (i >> 2) + 4 * n + (i & 3); }

struct Unit { int pm, pn; };
struct Gemm { const bf16_t* A; const bf16_t* Bt; int M, N, K; };

struct StaticOrder {
    int nM, nN, nwg, G, c;
    __host__ __device__ void init(int M, int N, int G_, int c_) { nM = M / BM; nN = N / BM; nwg = nM * nN; G = G_; c = c_; }
    __host__ __device__ bool next(int i, Unit& u) const {
        const long L = (long)i * G + c; if (L >= nwg) return false;
        int wgid = (int)L; { const int q = nwg / NXCD, r = nwg % NXCD, xcd = wgid % NXCD, off = wgid / NXCD; wgid = (xcd < r ? xcd * (q + 1) : r * (q + 1) + (xcd - r) * q) + off; }
        const int nig = WGM * nN, gid = wgid / nig, fm = gid * WGM, gsz = (nM - fm) < WGM ? (nM - fm) : WGM;
        u.pm = fm + ((wgid % nig) % gsz); u.pn = (wgid % nig) / gsz; return true;
    }
    __device__ __forceinline__ void a_ready(const Unit&) const {}
    __device__ __forceinline__ void done(const Unit&) const {}
};

__device__ __forceinline__ unsigned cvt_pk_bf16(float lo, float hi) { unsigned r; asm volatile("v_cvt_pk_bf16_f32 %0, %1, %2" : "=v"(r) : "v"(lo), "v"(hi)); return r; }
typedef float f32x2 __attribute__((ext_vector_type(2)));
__device__ __forceinline__ f32x2 gelu_pk(f32x2 v) {
    const f32x2 av = __builtin_elementwise_abs(v), d = av * 0.2316418882f + 1.0f;
    f32x2 t; t.x = __builtin_amdgcn_rcpf(d.x); t.y = __builtin_amdgcn_rcpf(d.y);
    f32x2 q = t * 0.5307027145f + (-0.7265760135f); q = q * t + 0.7107068705f; q = q * t + (-0.142248368f); q = q * t + 0.127414796f; q = q * t;
    const f32x2 s = (v * v) * (-0.72134752044f);
    f32x2 e; e.x = __builtin_amdgcn_exp2f(s.x); e.y = __builtin_amdgcn_exp2f(s.y);
    const f32x2 m = v * (q * e), r = v - m;
    f32x2 o; o.x = v.x < 0.f ? m.x : r.x; o.y = v.y < 0.f ? m.y : r.y; return o;
}

template <int ACT  > struct EpiBf16 {
    static constexpr bool PERM = true, AFTER_DRAIN = false; static_assert(ACT == 0 || ACT == 1, "EpiBf16: ACT is 0 (none) or 1 (gelu_pk)");
    bf16_t* O; int ldc; const float* bias; int split_cols; size_t split_stride; float scale0;
    __device__ __forceinline__ void operator()(const f32x4 (&acc)[2][2][4][2], const Unit& u, int wr, int wc, int fr, int fq) const {
        const int row0 = u.pm * BM + wr * 64 + fr; int colt = u.pn * BM; bf16_t* base = O;
        float sc = 1.f; if (split_cols) { const int t = colt / split_cols; base += (size_t)t * split_stride; colt -= t * split_cols; if (t == 0) sc = scale0; }
        const int col0 = colt + wc * 32 + 8 * fq, bcol0 = u.pn * BM + wc * 32 + 8 * fq;
        f32x4 bv[2][2];
#pragma unroll
        for (int bj = 0; bj < 2; ++bj)
#pragma unroll
            for (int n = 0; n < 2; ++n) bv[bj][n] = bias ? *(const f32x4*)(bias + bcol0 + bj * HALF + 4 * n) : (f32x4){0.f, 0.f, 0.f, 0.f};
#pragma unroll
        for (int ai = 0; ai < 2; ++ai)
#pragma unroll
            for (int m = 0; m < 4; ++m) { bf16_t* rowp = base + (size_t)(row0 + ai * HALF + m * 16) * ldc + col0;
#pragma unroll
                for (int bj = 0; bj < 2; ++bj) { f32x4 v0 = acc[ai][bj][m][0] + bv[bj][0], v1 = acc[ai][bj][m][1] + bv[bj][1];
                    if (ACT == 1) { f32x2 a = gelu_pk((f32x2){v0[0], v0[1]}), b = gelu_pk((f32x2){v0[2], v0[3]}), c = gelu_pk((f32x2){v1[0], v1[1]}), d = gelu_pk((f32x2){v1[2], v1[3]});
                        v0 = (f32x4){a.x, a.y, b.x, b.y}; v1 = (f32x4){c.x, c.y, d.x, d.y}; }
                    v0 = v0 * sc; v1 = v1 * sc; u32x4 w; w.x = cvt_pk_bf16(v0[0], v0[1]); w.y = cvt_pk_bf16(v0[2], v0[3]); w.z = cvt_pk_bf16(v1[0], v1[1]); w.w = cvt_pk_bf16(v1[2], v1[3]);
                    *(u32x4*)(rowp + bj * HALF) = w; } }
    }
};
struct EpiResid {
    static constexpr bool PERM = false, AFTER_DRAIN = false;
    const float* x; float* out; float* sspart; int ldc;
    __device__ __forceinline__ void operator()(const f32x4 (&acc)[2][2][4][2], const Unit& u, int wr, int wc, int fr, int fq) const {
        const int row0 = u.pm * BM + wr * 64 + fr, col0 = u.pn * BM + wc * 32 + 4 * fq;
#pragma unroll
        for (int ai = 0; ai < 2; ++ai)
#pragma unroll
            for (int m = 0; m < 4; ++m) {
                const int row = row0 + ai * HALF + m * 16; float ss = 0.f;
#pragma unroll
                for (int bj = 0; bj < 2; ++bj)
#pragma unroll
                    for (int n = 0; n < 2; ++n) {
                        const size_t off = (size_t)row * ldc + col0 + bj * HALF + n * 16;
                        const f32x4 xv = *(const f32x4*)(x + off); const f32x4 v = acc[ai][bj][m][n] + xv;
                        *(f32x4*)(out + off) = v; ss += (v[0] * v[0] + v[1] * v[1]) + (v[2] * v[2] + v[3] * v[3]);
                    }
                ss += __shfl_xor(ss, 16); ss += __shfl_xor(ss, 32);
                if (fq == 0) sspart[(size_t)row * 32 + u.pn * 4 + wc] = ss;
            }
    }
};

struct OneTile {
    int pm, pn;
    __host__ __device__ bool next(int i, Unit& u) const { if (i != 0) return false; u.pm = pm; u.pn = pn; return true; }
    __device__ __forceinline__ void a_ready(const Unit&) const {}
    __device__ __forceinline__ void done(const Unit&) const {}
};
struct EpiResidNorm {
    static constexpr bool PERM = false, AFTER_DRAIN = true;
    const float* x; float* out; float* ssp; unsigned* cnt; const float* gain; int ldc; float eps;
    __device__ __forceinline__ void fused(f32x4 (&acc)[2][2][4][2], const Unit& u, int wr, int wc, int fr, int fq, PG8_LAS unsigned char* lds, int wid, int lane) const {
        const int row0 = u.pm * BM + wr * 64 + fr, col0 = u.pn * BM + wc * 32 + 4 * fq;
#pragma unroll
        for (int ai = 0; ai < 2; ++ai)
#pragma unroll
            for (int m = 0; m < 4; ++m) {
                const int row = row0 + ai * HALF + m * 16; float ss = 0.f;
#pragma unroll
                for (int bj = 0; bj < 2; ++bj)
#pragma unroll
                    for (int n = 0; n < 2; ++n) {
                        const f32x4 xv = *(const f32x4*)(x + (size_t)row * ldc + col0 + bj * HALF + n * 16); const f32x4 v = acc[ai][bj][m][n] + xv;
                        acc[ai][bj][m][n] = v; ss += (v[0] * v[0] + v[1] * v[1]) + (v[2] * v[2] + v[3] * v[3]);
                    }
                ss += __shfl_xor(ss, 16); ss += __shfl_xor(ss, 32);
                if (fq == 0) __hip_atomic_store(ssp + (size_t)row * 32 + u.pn * 4 + wc, ss, __ATOMIC_RELAXED, __HIP_MEMORY_SCOPE_AGENT);
            }
        asm volatile("s_waitcnt vmcnt(0)" ::: "memory");
        __syncthreads();
        unsigned* c = cnt + 64 * u.pm;
        if (threadIdx.x == 0) {
            __hip_atomic_fetch_add(c, 1u, __ATOMIC_RELEASE, __HIP_MEMORY_SCOPE_AGENT);
            unsigned spins = 0;
            while (__hip_atomic_load(c, __ATOMIC_RELAXED, __HIP_MEMORY_SCOPE_AGENT) < 8u) { __builtin_amdgcn_s_sleep(2); if (++spins > (1u << 22)) break; }
            __builtin_amdgcn_fence(__ATOMIC_ACQUIRE, "agent");
        }
        __syncthreads();
        PG8_LAS float* S = (PG8_LAS float*)lds;
        if (threadIdx.x < 256) {
            const float* p = ssp + (size_t)(u.pm * BM + threadIdx.x) * 32; float s = 0.f;
#pragma unroll
            for (int i = 0; i < 32; ++i) s += __hip_atomic_load(p + i, __ATOMIC_RELAXED, __HIP_MEMORY_SCOPE_AGENT);
            S[threadIdx.x] = 1.0f / sqrtf(s * (1.0f / 2048.0f) + eps);
        }
        __syncthreads();
#pragma unroll
        for (int bj = 0; bj < 2; ++bj)
#pragma unroll
            for (int n = 0; n < 2; ++n) {
                const f32x4 g = *(const f32x4*)(gain + col0 + bj * HALF + n * 16);
#pragma unroll
                for (int ai = 0; ai < 2; ++ai)
#pragma unroll
                    for (int m = 0; m < 4; ++m) {
                        const int lr = wr * 64 + fr + ai * HALF + m * 16; const float rs = S[lr];
                        f32x4 v = acc[ai][bj][m][n]; v[0] *= rs * g[0]; v[1] *= rs * g[1]; v[2] *= rs * g[2]; v[3] *= rs * g[3];
                        *(f32x4*)(out + (size_t)(u.pm * BM + lr) * ldc + col0 + bj * HALF + n * 16) = v;
                    }
            }
    }
};

template <class Epi, class Sched, bool ALIGN_EPI = false, bool SP2 = false>
__device__ __forceinline__ void gemm_phase(PG8_LAS unsigned char* lds, const Gemm g, const Sched& S, const Epi& E) {
    const int tid = threadIdx.x, wid = __builtin_amdgcn_readfirstlane(tid >> 6), lane = tid & 63, wr = wid >> 2, wc = wid & 3, fr = lane & 15, fq = lane >> 4;
    const int K = g.K, nt = K / BK;
    unsigned voffA[2], voffB[2];
#pragma unroll
    for (int i = 0; i < 2; ++i) { int R, C; stage_rc(tid * 16 + i * 8192, R, C); const int Rb = Epi::PERM ? ((R & ~31) + perm32(R & 31)) : R;
        voffA[i] = (unsigned)(R * K + C) * 2u; voffB[i] = (unsigned)(Rb * K + C) * 2u; }
    const size_t kstep = (size_t)(BK * 2);
    const size_t hstep = (size_t)HALF * K * 2;
    const size_t tstep = 2 * hstep;
    const unsigned ldsw = (unsigned)wid * 1024u;
    const int aoff = lds_byte(wr * 64 + fr, fq * 8), boff = lds_byte(wc * 32 + fr, fq * 8);
#define PG8_SA(b, h) (((b) * 2 + (h)) * HTB)
#define PG8_SB(b, h) ((4 + (b) * 2 + (h)) * HTB)
#define PG8_STAGE(bufoff, gbase, voff) do { _Pragma("unroll") for (int _i = 0; _i < 2; ++_i) \
        __builtin_amdgcn_global_load_lds((const unsigned*)((const char*)(gbase) + (voff)[_i]), (PG8_LAS unsigned*)(lds + (bufoff) + ldsw + _i * 8192), 16, 0, 0); } while (0)
#define PG8_LDA(dst, b, h) do { _Pragma("unroll") for (int m = 0; m < 4; ++m) _Pragma("unroll") for (int k = 0; k < 2; ++k) dst[m][k] = *(const PG8_LAS bf16x8*)(lds + PG8_SA(b, h) + aoff + m * 2048 + k * 1024); } while (0)
#define PG8_LDB(dst, b, h) do { _Pragma("unroll") for (int n = 0; n < 2; ++n) _Pragma("unroll") for (int k = 0; k < 2; ++k) dst[n][k] = *(const PG8_LAS bf16x8*)(lds + PG8_SB(b, h) + boff + n * 2048 + k * 1024); } while (0)
#define PG8_MMA(ai, bj, At, Bt) do { __builtin_amdgcn_s_setprio(1); _Pragma("unroll") for (int m = 0; m < 4; ++m) _Pragma("unroll") for (int n = 0; n < 2; ++n) _Pragma("unroll") for (int k = 0; k < 2; ++k) \
        acc[ai][bj][m][n] = __builtin_amdgcn_mfma_f32_16x16x32_bf16(Bt[n][k], At[m][k], acc[ai][bj][m][n], 0, 0, 0); __builtin_amdgcn_s_setprio(0); } while (0)
#define PG8_WAIT_V(n) asm volatile("s_waitcnt vmcnt(" #n ")" ::: "memory")
#define PG8_WAIT_L(n) asm volatile("s_waitcnt lgkmcnt(" #n ")" ::: "memory")
#define PG8_BAR __builtin_amdgcn_s_barrier()
#define PG8_SCHED __builtin_amdgcn_sched_barrier(0)
    Unit cur, nxt; int ui = 0;
    if (!S.next(0, cur)) return;
    f32x4 acc[2][2][4][2];
#pragma unroll
    for (int a = 0; a < 2; ++a)
#pragma unroll
        for (int b = 0; b < 2; ++b)
#pragma unroll
            for (int m = 0; m < 4; ++m)
#pragma unroll
                for (int n = 0; n < 2; ++n) acc[a][b][m][n] = (f32x4){0.f, 0.f, 0.f, 0.f};
    bf16x8 At[4][2], B0[2][2], B1[2][2];
    const char* cA = (const char*)g.A + (size_t)cur.pm * tstep; const char* cB = (const char*)g.Bt + (size_t)cur.pn * tstep;
    S.a_ready(cur);
    if constexpr (SP2) {
        PG8_STAGE(PG8_SB(0, 0), cB, voffB); PG8_STAGE(PG8_SB(0, 1), cB + hstep, voffB); PG8_STAGE(PG8_SA(0, 0), cA, voffA); PG8_STAGE(PG8_SA(0, 1), cA + hstep, voffA);
        if (wr == 1) PG8_BAR;
        PG8_WAIT_V(2); PG8_BAR;
        PG8_STAGE(PG8_SB(1, 0), cB + kstep, voffB); PG8_STAGE(PG8_SA(1, 0), cA + kstep, voffA); PG8_STAGE(PG8_SB(1, 1), cB + hstep + kstep, voffB);
        PG8_WAIT_V(6); PG8_BAR;
    } else {
        PG8_STAGE(PG8_SB(0, 0), cB, voffB); PG8_STAGE(PG8_SA(0, 0), cA, voffA); PG8_STAGE(PG8_SB(0, 1), cB + hstep, voffB); PG8_STAGE(PG8_SA(0, 1), cA + hstep, voffA);
        if (wr == 1) PG8_BAR;
        PG8_WAIT_V(4); PG8_BAR;
        PG8_STAGE(PG8_SB(1, 0), cB + kstep, voffB); PG8_STAGE(PG8_SA(1, 0), cA + kstep, voffA); PG8_STAGE(PG8_SB(1, 1), cB + hstep + kstep, voffB);
        PG8_WAIT_V(6); PG8_BAR;
    }
    for (;;) {
        const bool has_next = S.next(ui + 1, nxt);
        const char* nA = has_next ? (const char*)g.A + (size_t)nxt.pm * tstep : cA; const char* nB = has_next ? (const char*)g.Bt + (size_t)nxt.pn * tstep : cB;
        for (int t = 0; t < nt; t += 2) {
            const bool last = (t == nt - 2);
            const char* a1 = cA + (size_t)(t + 1) * kstep;
            const char* a2 = last ? nA : cA + (size_t)(t + 2) * kstep; const char* b2 = last ? nB : cB + (size_t)(t + 2) * kstep;
            const char* a3 = a2 + kstep; const char* b3 = b2 + kstep;
            if (last && has_next) S.a_ready(nxt);
            if constexpr (SP2) {
            PG8_LDB(B0, 0, 0); PG8_LDB(B1, 0, 1); PG8_SCHED; PG8_LDA(At, 0, 0); PG8_STAGE(PG8_SA(1, 1), a1 + hstep, voffA);
            PG8_WAIT_V(8); PG8_WAIT_L(0); PG8_BAR; PG8_MMA(0, 0, At, B0); PG8_MMA(0, 1, At, B1); PG8_BAR; PG8_SCHED;
            PG8_LDA(At, 0, 1); PG8_STAGE(PG8_SB(0, 0), b2, voffB); PG8_STAGE(PG8_SB(0, 1), b2 + hstep, voffB); PG8_STAGE(PG8_SA(0, 0), a2, voffA);
            PG8_WAIT_V(8); PG8_WAIT_L(0); PG8_BAR; PG8_MMA(1, 0, At, B0); PG8_MMA(1, 1, At, B1); PG8_BAR; PG8_SCHED;
            PG8_LDB(B0, 1, 0); PG8_LDB(B1, 1, 1); PG8_SCHED; PG8_LDA(At, 1, 0); PG8_STAGE(PG8_SA(0, 1), a2 + hstep, voffA);
            PG8_WAIT_V(8); PG8_WAIT_L(0); PG8_BAR; PG8_MMA(0, 0, At, B0); PG8_MMA(0, 1, At, B1); PG8_BAR; PG8_SCHED;
            PG8_LDA(At, 1, 1); PG8_STAGE(PG8_SB(1, 0), b3, voffB); PG8_STAGE(PG8_SB(1, 1), b3 + hstep, voffB); PG8_STAGE(PG8_SA(1, 0), a3, voffA);
            PG8_WAIT_V(8); PG8_WAIT_L(0); PG8_BAR; PG8_MMA(1, 0, At, B0); PG8_MMA(1, 1, At, B1); PG8_BAR; PG8_SCHED;
            } else {
            PG8_LDB(B0, 0, 0); PG8_SCHED; PG8_LDA(At, 0, 0); PG8_STAGE(PG8_SA(1, 1), a1 + hstep, voffA);
            PG8_WAIT_L(8); PG8_BAR; PG8_WAIT_L(0); PG8_MMA(0, 0, At, B0); PG8_BAR; PG8_SCHED;
            PG8_LDB(B1, 0, 1); PG8_STAGE(PG8_SB(0, 0), b2, voffB);
            PG8_BAR; PG8_WAIT_L(0); PG8_MMA(0, 1, At, B1); PG8_BAR;
            PG8_LDA(At, 0, 1); PG8_STAGE(PG8_SA(0, 0), a2, voffA);
            PG8_BAR; PG8_WAIT_L(0); PG8_MMA(1, 0, At, B0); PG8_BAR; PG8_SCHED;
            PG8_STAGE(PG8_SB(0, 1), b2 + hstep, voffB);
            PG8_WAIT_V(6); PG8_BAR; PG8_MMA(1, 1, At, B1); PG8_BAR;
            PG8_LDB(B0, 1, 0); PG8_SCHED; PG8_LDA(At, 1, 0); PG8_STAGE(PG8_SA(0, 1), a2 + hstep, voffA);
            PG8_WAIT_L(8); PG8_BAR; PG8_WAIT_L(0); PG8_MMA(0, 0, At, B0); PG8_BAR; PG8_SCHED;
            PG8_LDB(B1, 1, 1); PG8_STAGE(PG8_SB(1, 0), b3, voffB);
            PG8_BAR; PG8_WAIT_L(0); PG8_MMA(0, 1, At, B1); PG8_BAR;
            PG8_LDA(At, 1, 1); PG8_STAGE(PG8_SA(1, 0), a3, voffA);
            PG8_BAR; PG8_WAIT_L(0); PG8_MMA(1, 0, At, B0); PG8_BAR; PG8_SCHED;
            PG8_STAGE(PG8_SB(1, 1), b3 + hstep, voffB);
            PG8_WAIT_V(6); PG8_BAR; PG8_MMA(1, 1, At, B1); PG8_BAR;
            }
        }
        if constexpr (ALIGN_EPI) { if (wr == 0) PG8_BAR; }
        if constexpr (!Epi::AFTER_DRAIN) { E(acc, cur, wr, wc, fr, fq); S.done(cur); }
        if (!has_next) break;
#pragma unroll
        for (int a = 0; a < 2; ++a)
#pragma unroll
            for (int b = 0; b < 2; ++b)
#pragma unroll
                for (int m = 0; m < 4; ++m)
#pragma unroll
                    for (int n = 0; n < 2; ++n) acc[a][b][m][n] = (f32x4){0.f, 0.f, 0.f, 0.f};
        cur = nxt; cA = nA; cB = nB; ++ui;
        if constexpr (ALIGN_EPI) { if (wr == 1) PG8_BAR; }
    }
    PG8_WAIT_V(0);
    if constexpr (!ALIGN_EPI) { if (wr == 0) PG8_BAR; }
    PG8_BAR;
    if constexpr (Epi::AFTER_DRAIN) { E.fused(acc, cur, wr, wc, fr, fq, lds, wid, lane); S.done(cur); }
#undef PG8_SA
#undef PG8_SB
#undef PG8_STAGE
#undef PG8_LDA
#undef PG8_LDB
#undef PG8_MMA
#undef PG8_WAIT_V
#undef PG8_WAIT_L
#undef PG8_BAR
#undef PG8_SCHED
}
}
constexpr int T = 8192, D = 2048, NIN = 6528, NINP = 6656, RW = 1024, NH = 16, HD = 64, CH = 64, NCH = T / CH;
constexpr int C_R = 0, C_K = 1024, C_V = 2048, C_WD = 3072, C_AD = 3136, C_G = 3200, C_AQ = 4224, C_AK = 5248, C_AV = 5376, C_AG = 5504;
constexpr float RMS_EPS = 1e-5f, LNX_EPS = 64e-5f;
constexpr int NWAVES = 8, NTHR = 512;
constexpr size_t MiB = 1u << 20;
constexpr size_t WS_WTIN = 1 * MiB;
constexpr size_t WS_XN = 27 * MiB;
constexpr size_t WS_WTOUT = 59 * MiB;
constexpr size_t WS_UPT = 67 * MiB;
constexpr size_t WS_SSP = 68 * MiB;
constexpr size_t WS_PROJ = 70 * MiB;
constexpr size_t WS_SCR = 174 * MiB;
constexpr size_t WS_MIX = 223 * MiB;
constexpr size_t WS_P32 = 223 * MiB;
constexpr int LDS_BYTES = 163840;

#define GAS __attribute__((address_space(1)))
#define LAS __attribute__((address_space(3)))
typedef unsigned short bf16;
typedef unsigned v4u __attribute__((ext_vector_type(4)));
typedef unsigned v2u __attribute__((ext_vector_type(2)));
typedef float f32x4 __attribute__((ext_vector_type(4)));
typedef float f32x16 __attribute__((ext_vector_type(16)));
typedef short bf16x8 __attribute__((ext_vector_type(8)));
typedef __bf16 bf16x2_t __attribute__((ext_vector_type(2)));
__device__ __forceinline__ unsigned pk2(float a, float b) { bf16x2_t v; v[0] = (__bf16)a; v[1] = (__bf16)b; return __builtin_bit_cast(unsigned, v); }
__device__ __forceinline__ float bflo(unsigned u) { return __uint_as_float(u << 16); }
__device__ __forceinline__ float bfhi(unsigned u) { return __uint_as_float(u & 0xffff0000u); }
__device__ __forceinline__ void unpack8(const v4u& p, float (&f)[8]) { f[0] = bflo(p.x); f[1] = bfhi(p.x); f[2] = bflo(p.y); f[3] = bfhi(p.y); f[4] = bflo(p.z); f[5] = bfhi(p.z); f[6] = bflo(p.w); f[7] = bfhi(p.w); }
__device__ __forceinline__ v4u pack8(const float (&f)[8]) { v4u o; o.x = pk2(f[0], f[1]); o.y = pk2(f[2], f[3]); o.z = pk2(f[4], f[5]); o.w = pk2(f[6], f[7]); return o; }
__device__ __forceinline__ float wave_sum(float v) {
#pragma unroll
    for (int o = 1; o < 64; o <<= 1) v += __shfl_xor(v, o);
    return v;
}
__device__ __forceinline__ float sum8(float v) { v += __shfl_xor(v, 1); v += __shfl_xor(v, 2); v += __shfl_xor(v, 4); return v; }
__device__ __forceinline__ float sigmoidf_(float x) { return 1.f / (1.f + __expf(-x)); }
__device__ __forceinline__ float siluf_(float x) { return x / (1.f + __expf(-x)); }

__device__ __forceinline__ void bar_lds() { asm volatile("s_waitcnt lgkmcnt(0)" ::: "memory"); __builtin_amdgcn_s_barrier(); asm volatile("" ::: "memory"); }
struct Args { const float* in[16]; float* out; unsigned char* ws; int ph_lo, ph_hi; };

struct TItem { const float* W; bf16* WT; int K, N, k0, n0; };
__device__ __forceinline__ bool p0_item(const Args& a, int it, TItem& o) {
    constexpr int I_IN = (D / 64) * (NIN / 32), I_OUT = (D / 64) * (D / 32), I_UP = RW / 32;
    bf16* wtin = (bf16*)(a.ws + WS_WTIN); bf16* wtout = (bf16*)(a.ws + WS_WTOUT); bf16* upt = (bf16*)(a.ws + WS_UPT); bf16* aupt = upt + 65536;
    int r = it;
    if (r < 0) { r += I_OUT; if (r < 0) return false; o.W = a.in[14]; o.WT = wtout; o.K = D; o.N = D; }
    else if (r < I_IN) { o.W = a.in[2]; o.WT = wtin; o.K = D; o.N = NIN; }
    else if ((r -= I_IN) < I_UP) { o.W = a.in[5]; o.WT = upt; o.K = 64; o.N = RW; }
    else if ((r -= I_UP) < I_UP) { o.W = a.in[7]; o.WT = aupt; o.K = 64; o.N = RW; }
    else return false;
    const int nblk = o.N / 32; o.k0 = 64 * (r / nblk); o.n0 = 32 * (r % nblk); return true;
}
__device__ __forceinline__ void p0_ld(const TItem& t, int lane, f32x4 (&v)[8]) {
#pragma unroll
    for (int i = 0; i < 8; ++i) v[i] = *(const f32x4*)(t.W + (size_t)(t.k0 + 8 * i + (lane >> 3)) * t.N + t.n0 + 4 * (lane & 7));
}
__device__ __forceinline__ void p0_st(const TItem& t, int lane, const f32x4 (&v)[8], LAS float* scr) {
#pragma unroll
    for (int i = 0; i < 8; ++i) { LAS float* d = scr + (8 * i + (lane >> 3)) * 33 + 4 * (lane & 7); d[0] = v[i].x; d[1] = v[i].y; d[2] = v[i].z; d[3] = v[i].w; }
    asm volatile("s_waitcnt lgkmcnt(0)" ::: "memory");
    const int c = lane & 7;
#pragma unroll
    for (int j = 0; j < 4; ++j) { const int n = (lane >> 3) + 8 * j; const LAS float* s = scr + (8 * c) * 33 + n;
        v4u o; o.x = pk2(s[0 * 33], s[1 * 33]); o.y = pk2(s[2 * 33], s[3 * 33]); o.z = pk2(s[4 * 33], s[5 * 33]); o.w = pk2(s[6 * 33], s[7 * 33]);
        *(v4u*)(t.WT + (size_t)(t.n0 + n) * t.K + t.k0 + 8 * c) = o; }
    asm volatile("s_waitcnt lgkmcnt(0)" ::: "memory");
}
__device__ __forceinline__ void wout_transposes(const Args& a, LAS unsigned char* lds, int gw, int NGW, int wave, int lane) {
    LAS float* scr = (LAS float*)(lds + wave * 16384);
    constexpr int I_OUT = (D / 64) * (D / 32);
    for (int it = gw - I_OUT; it < 0; it += NGW) { TItem t0; f32x4 v0[8]; if (!p0_item(a, it, t0)) break; p0_ld(t0, lane, v0); p0_st(t0, lane, v0, scr); }
}
__device__ __forceinline__ void p0_prologue(const Args& a, LAS unsigned char* lds, int vcu, int G, int wave, int lane) {
    LAS float* scr = (LAS float*)(lds + wave * 16384);
    const int gw = vcu * NWAVES + wave, NGW = G * NWAVES;
    bf16* wtin = (bf16*)(a.ws + WS_WTIN);
#ifdef PROBE_P0X
    for (int rep_ = 0; rep_ < 2; ++rep_)
#endif
    for (int it = gw; ; it += 2 * NGW) {
        TItem t0, t1; f32x4 v0[8], v1[8];
        const bool h0 = p0_item(a, it, t0), h1 = p0_item(a, it + NGW, t1);
        if (!h0) break;
        p0_ld(t0, lane, v0); if (h1) p0_ld(t1, lane, v1);
        p0_st(t0, lane, v0, scr); if (h1) p0_st(t1, lane, v1, scr);
    }
    wout_transposes(a, lds, gw, NGW, wave, lane);
    { v4u z = {0u, 0u, 0u, 0u}; v4u* p = (v4u*)(wtin + (size_t)NIN * D); const int n16 = (NINP - NIN) * D * 2 / 16;
      for (int i = gw * 64 + lane; i < n16; i += NGW * 64) p[i] = z; }
    const float* gain = a.in[1];
#ifdef PROBE_P0R
    for (int rep_ = 0; rep_ < 2; ++rep_)
#endif
    for (int m = gw; m < T; m += 2 * NGW) {
        const int m2 = m + NGW;
        const f32x4* xr = (const f32x4*)(a.in[0] + (size_t)m * D) + lane; const f32x4* xr2 = (const f32x4*)(a.in[0] + (size_t)(m2 < T ? m2 : m) * D) + lane;
        f32x4 v[8], u[8]; float s = 0.f, s2 = 0.f;
#pragma unroll
        for (int j = 0; j < 8; ++j) { v[j] = xr[64 * j]; u[j] = xr2[64 * j]; }
#pragma unroll
        for (int j = 0; j < 8; ++j) { s += (v[j].x * v[j].x + v[j].y * v[j].y) + (v[j].z * v[j].z + v[j].w * v[j].w); s2 += (u[j].x * u[j].x + u[j].y * u[j].y) + (u[j].z * u[j].z + u[j].w * u[j].w); }
        const float rstd = 1.f / sqrtf(wave_sum(s) * (1.f / D) + RMS_EPS), rstd2 = 1.f / sqrtf(wave_sum(s2) * (1.f / D) + RMS_EPS);
        v2u* o8 = (v2u*)((bf16*)(a.ws + WS_XN) + (size_t)m * D) + lane; v2u* o82 = (v2u*)((bf16*)(a.ws + WS_XN) + (size_t)m2 * D) + lane;
#pragma unroll
        for (int j = 0; j < 8; ++j) { const f32x4 g = *((const f32x4*)gain + lane + 64 * j); v2u o; o.x = pk2(v[j].x * rstd * g.x, v[j].y * rstd * g.y); o.y = pk2(v[j].z * rstd * g.z, v[j].w * rstd * g.w); o8[64 * j] = o;
            if (m2 < T) { o.x = pk2(u[j].x * rstd2 * g.x, u[j].y * rstd2 * g.y); o.y = pk2(u[j].z * rstd2 * g.z, u[j].w * rstd2 * g.w); o82[64 * j] = o; } }
    }
}
__device__ __forceinline__ void final_norm(const Args& a, int vcu, int G, int wave, int lane) {
    const int gw = vcu * NWAVES + wave, NGW = G * NWAVES; const float* ssp = (const float*)(a.ws + WS_SSP); const float* gain = a.in[15];
    for (int m = gw; m < T; m += NGW) {
        float s = (lane < 32) ? ssp[(size_t)m * 32 + lane] : 0.f; s = wave_sum(s);
        const float rstd = 1.f / sqrtf(s * (1.f / D) + RMS_EPS);
        f32x4* xr = (f32x4*)(a.out + (size_t)m * D) + lane;
#pragma unroll
        for (int j = 0; j < 8; ++j) { f32x4 v = xr[64 * j]; const f32x4 g = *((const f32x4*)gain + lane + 64 * j); v.x *= rstd * g.x; v.y *= rstd * g.y; v.z *= rstd * g.z; v.w *= rstd * g.w; xr[64 * j] = v; }
    }
}
#define XB_TMO      128
#define XB_XCNT(j)  (256  + 64 * (j))
#define XB_XSUB(j)  (1280 + 64 * (j))
#define XB_XGEN(j)  (2304 + 64 * (j))
#define XB_TOP      3328
#define XB_TOPGEN   3392
#define XCD_BAR_WORDS 3456
#define XB_SPIN_CAP (1u << 18)

__device__ __forceinline__ unsigned xb_ld(unsigned* p)              { return __hip_atomic_load(p, __ATOMIC_RELAXED, __HIP_MEMORY_SCOPE_AGENT); }
__device__ __forceinline__ unsigned xb_add(unsigned* p, unsigned v) { return __hip_atomic_fetch_add(p, v, __ATOMIC_RELAXED, __HIP_MEMORY_SCOPE_AGENT); }
__device__ __forceinline__ unsigned xb_xcc_id() { return (unsigned)__builtin_amdgcn_s_getreg((3 << 11) | 20) & 0xFu; }
#define XB_SPIN(cond, bar) do { unsigned _sp = 0; while (cond) { __builtin_amdgcn_s_sleep(1); \
    if ((++_sp & 255u) == 0u) { if (xb_ld(&(bar)[XB_TMO])) break; if (_sp > XB_SPIN_CAP) { atomicAdd(&(bar)[XB_TMO], 1u); break; } } } } while (0)

struct XcdBarrier {
    unsigned* bar; unsigned x;
    volatile LAS unsigned* st;
};

__device__ __forceinline__ XcdBarrier xcd_barrier_post(unsigned* bar, volatile LAS unsigned* st) {
    XcdBarrier b; b.bar = bar; b.x = xb_xcc_id(); b.st = st;
    if (threadIdx.x == 0) (void)xb_add(&bar[XB_XCNT(b.x)], 1u);
    return b;
}
__device__ __forceinline__ void xcd_barrier_complete(unsigned* bar, unsigned x, unsigned& nloc, unsigned& nx) {
    const unsigned G = gridDim.x * gridDim.y * gridDim.z;
    unsigned sum, cnt, mine, sp = 0u;
    for (;;) {
        sum = 0u; cnt = 0u; mine = 0u;
#pragma unroll
        for (unsigned j = 0; j < 16; ++j) { const unsigned c = xb_ld(&bar[XB_XCNT(j)]); sum += c; cnt += (c > 0u) ? 1u : 0u; mine = (j == x) ? c : mine; }
        if (sum == G) break;
        __builtin_amdgcn_s_sleep(1);
        if ((++sp & 255u) == 0u) { if (xb_ld(&bar[XB_TMO])) break; if (sp > XB_SPIN_CAP) { atomicAdd(&bar[XB_TMO], 1u); break; } }
    }
    nloc = mine > 0u ? mine : 1u; nx = cnt > 0u ? cnt : 1u;
}

__device__ __forceinline__ void xcd_barrier(const XcdBarrier& b) {
    asm volatile("s_waitcnt vmcnt(0)" ::: "memory");
    __syncthreads();
    if (threadIdx.x == 0) {
        unsigned* bar = b.bar;
        __builtin_amdgcn_s_waitcnt(0);
        unsigned nloc = b.st[0], nx = b.st[1];
        if (nloc == 0u) { xcd_barrier_complete(bar, b.x, nloc, nx); b.st[0] = nloc; b.st[1] = nx; }
        const unsigned old = xb_add(&bar[XB_XSUB(b.x)], 1u);
        const unsigned gen = old / nloc;
        if (old + 1u == (gen + 1u) * nloc) {
            __builtin_amdgcn_fence(__ATOMIC_RELEASE, "agent");
            asm volatile("s_waitcnt vmcnt(0)" ::: "memory");
            const unsigned og = xb_add(&bar[XB_TOP], 1u);
            const unsigned tg = og / nx;
            if (og + 1u == (tg + 1u) * nx) xb_add(&bar[XB_TOPGEN], 1u);
            else XB_SPIN(xb_ld(&bar[XB_TOPGEN]) == tg, bar);
            __builtin_amdgcn_fence(__ATOMIC_ACQUIRE, "agent");
            xb_add(&bar[XB_XGEN(b.x)], 1u);
            asm volatile("s_waitcnt vmcnt(0)" ::: "memory");
        } else {
            XB_SPIN(xb_ld(&bar[XB_XGEN(b.x)]) == gen, bar);
            __builtin_amdgcn_fence(__ATOMIC_ACQUIRE, "agent");
            asm volatile("s_waitcnt vmcnt(0)" ::: "memory");
        }
    }
    __syncthreads();
}

#define MFMA32(a_, b_, c_) __builtin_amdgcn_mfma_f32_32x32x16_bf16((a_), (b_), (c_), 0, 0, 0)
#define MFMA16(a_, b_, c_) __builtin_amdgcn_mfma_f32_16x16x32_bf16((a_), (b_), (c_), 0, 0, 0)
__device__ __forceinline__ v4u ldg16(const bf16* p) { return *(const v4u*)p; }
__device__ __forceinline__ void load_shift8(const bf16* proj, int row, int col, const float* mu, float (&o)[8]) {
    const v4u p = ldg16(proj + (size_t)row * NINP + col); v4u q = {0u, 0u, 0u, 0u};
    if (row > 0) q = ldg16(proj + (size_t)(row - 1) * NINP + col);
    float pf[8], qf[8]; unpack8(p, pf); unpack8(q, qf);
    const f32x4 m0 = *(const f32x4*)(mu + col), m1 = *(const f32x4*)(mu + col + 4);
    const float mf[8] = {m0.x, m0.y, m0.z, m0.w, m1.x, m1.y, m1.z, m1.w};
#pragma unroll
    for (int j = 0; j < 8; ++j) o[j] = pf[j] + (qf[j] - pf[j]) * mf[j];
}
__device__ __forceinline__ void ld8f(const float* p, float (&o)[8]) { const f32x4 a = *(const f32x4*)p, b = *(const f32x4*)(p + 4); o[0] = a.x; o[1] = a.y; o[2] = a.z; o[3] = a.w; o[4] = b.x; o[5] = b.y; o[6] = b.z; o[7] = b.w; }

constexpr int VP = 168;
__device__ __forceinline__ void attn_unit(const Args& a, LAS unsigned char* lds, int unit, int tid, int wave, int lane) {
    const bf16* proj = (const bf16*)(a.ws + WS_PROJ); bf16* mix = (bf16*)(a.ws + WS_MIX);
    const int qb = unit >> 1, kvh = unit & 1, q0 = qb * 32, kbase = q0 - 128, hq = kvh * 8 + wave;
    LAS bf16* VT = (LAS bf16*)lds;
    const int r = lane & 31, h = lane >> 5;
    bf16x8 bq[4];
    { const bf16* qrow = proj + (size_t)(q0 + r) * NINP + C_AQ + hq * 64 + 8 * h;
#pragma unroll
      for (int s = 0; s < 4; ++s) bq[s] = *(const bf16x8*)(qrow + 16 * s); }
    const float slope = exp2f(-0.5f * (float)(hq + 1)), sink = a.in[13][hq];
    f32x16 sc[5]; float mx = sink;
    bf16x8 kf[5][4];
#pragma unroll
    for (int kt = 0; kt < 5; ++kt) { const int tkb = kbase + 32 * kt;
        if (tkb >= 0) { const bf16* krow = proj + (size_t)(tkb + r) * NINP + C_AK + kvh * 64 + 8 * h;
#pragma unroll
            for (int s = 0; s < 4; ++s) kf[kt][s] = *(const bf16x8*)(krow + 16 * s); } }
    v2u gpre[2][4];
#pragma unroll
    for (int dt = 0; dt < 2; ++dt)
#pragma unroll
        for (int g4 = 0; g4 < 4; ++g4) gpre[dt][g4] = *(const v2u*)(proj + (size_t)(q0 + r) * NINP + C_AG + hq * 64 + 32 * dt + 8 * g4 + 4 * h);
    bar_lds();
    for (int idx = tid; idx < 160 * 8; idx += NTHR) {
        const int key = idx >> 3, d8 = (idx & 7) * 8, tk = kbase + key;
        v4u p = {0u, 0u, 0u, 0u};
        if (tk >= 0) p = ldg16(proj + (size_t)tk * NINP + C_AV + kvh * 64 + d8);
        const unsigned w[4] = {p.x, p.y, p.z, p.w};
#pragma unroll
        for (int j = 0; j < 4; ++j) { VT[(d8 + 2 * j) * VP + key] = (bf16)(w[j] & 0xffffu); VT[(d8 + 2 * j + 1) * VP + key] = (bf16)(w[j] >> 16); }
    }
    bar_lds();
    const float L2E = 1.44269504f, SA = 0.125f * L2E, SB = slope * L2E, sinkl = sink * L2E;
    mx = sinkl;
#pragma unroll
    for (int kt = 0; kt < 5; ++kt) {
        const int tkb = kbase + 32 * kt;
        if (tkb >= 0) {
            f32x16 acc; for (int i = 0; i < 16; ++i) acc[i] = 0.f;
#pragma unroll
            for (int s = 0; s < 4; ++s) acc = MFMA32(kf[kt][s], bq[s], acc);
            const int dli = (q0 + r) - tkb - 4 * h; const float base = -SB * (float)dli;
#pragma unroll
            for (int i = 0; i < 16; ++i) {
                const int ci = (i & 3) + 8 * (i >> 2);
                float v = __builtin_fmaf(acc[i], SA, __builtin_fmaf(SB, (float)ci, base));
                if (kt == 0) v = (dli - ci < 128) ? v : -1e30f;
                if (kt == 4) v = (dli - ci >= 0) ? v : -1e30f;
                sc[kt][i] = v; mx = fmaxf(mx, v);
            }
        } else {
#pragma unroll
            for (int i = 0; i < 16; ++i) sc[kt][i] = -1e30f;
        }
    }
    mx = fmaxf(mx, __shfl_xor(mx, 32));
    float sum = 0.f;
#pragma unroll
    for (int kt = 0; kt < 5; ++kt)
#pragma unroll
        for (int i = 0; i < 16; ++i) { const float p = __builtin_amdgcn_exp2f(sc[kt][i] - mx); sc[kt][i] = p; sum += p; }
    sum += __shfl_xor(sum, 32); sum += __builtin_amdgcn_exp2f(sinkl - mx);
    f32x16 o[2]; for (int i = 0; i < 16; ++i) { o[0][i] = 0.f; o[1][i] = 0.f; }
#pragma unroll
    for (int kt = 0; kt < 5; ++kt) {
        if (kbase + 32 * kt >= 0) {
#pragma unroll
            for (int s = 0; s < 2; ++s) {
                v4u pw; pw.x = pk2(sc[kt][8 * s + 0], sc[kt][8 * s + 1]); pw.y = pk2(sc[kt][8 * s + 2], sc[kt][8 * s + 3]); pw.z = pk2(sc[kt][8 * s + 4], sc[kt][8 * s + 5]); pw.w = pk2(sc[kt][8 * s + 6], sc[kt][8 * s + 7]);
                const bf16x8 pb = __builtin_bit_cast(bf16x8, pw);
#pragma unroll
                for (int dt = 0; dt < 2; ++dt) {
                    const LAS bf16* vp = VT + (32 * dt + r) * VP + 32 * kt + 16 * s + 4 * h;
                    const v2u lo = *(const LAS v2u*)vp, hi = *(const LAS v2u*)(vp + 8);
                    v4u vw; vw.x = lo.x; vw.y = lo.y; vw.z = hi.x; vw.w = hi.y;
                    o[dt] = MFMA32(__builtin_bit_cast(bf16x8, vw), pb, o[dt]);
                }
            }
        }
    }
    const float inv = 1.f / sum;
#pragma unroll
    for (int dt = 0; dt < 2; ++dt)
#pragma unroll
        for (int g4 = 0; g4 < 4; ++g4) {
            const int d0 = 32 * dt + 8 * g4 + 4 * h;
            float g0, g1, g2, g3;
            { const v2u gp = gpre[dt][g4]; g0 = bflo(gp.x); g1 = bfhi(gp.x); g2 = bflo(gp.y); g3 = bfhi(gp.y); }
            v2u w; w.x = pk2(o[dt][4 * g4 + 0] * inv * siluf_(g0), o[dt][4 * g4 + 1] * inv * siluf_(g1));
            w.y = pk2(o[dt][4 * g4 + 2] * inv * siluf_(g2), o[dt][4 * g4 + 3] * inv * siluf_(g3));
            *(v2u*)(mix + (size_t)(q0 + r) * D + RW + hq * 64 + d0) = w;
        }
}

struct Prep { float r[8], kp[8], v[8], g[8], w[8], lw[8], kk[8], b[8], bonus; };
__device__ __forceinline__ void rwkv_prep(const Args& a, LAS unsigned char* lds, int h, int t0, int tid, int wave, int lane, Prep& P) {
    const bf16* proj = (const bf16*)(a.ws + WS_PROJ); const bf16* upt = (const bf16*)(a.ws + WS_UPT); const bf16* aupt = upt + 65536;
    LAS bf16* TW = (LAS bf16*)lds; LAS bf16* ADm = TW + 64 * 72; LAS float* Z = (LAS float*)(lds + 18432); LAS float* AP = Z + 64 * 68;
    const int t = tid >> 3, c8 = (tid & 7) * 8, ch = h * 64 + c8, row = t0 + t;
    const float* mu = a.in[3];
    { float x[8]; load_shift8(proj, row, C_WD + c8, mu, x);
#pragma unroll
      for (int j = 0; j < 8; ++j) x[j] = 1.f - 2.f * __builtin_amdgcn_rcpf(1.f + __expf(2.f * x[j]));
      *(LAS v4u*)(TW + t * 72 + c8) = pack8(x);
      load_shift8(proj, row, C_AD + c8, mu, x); *(LAS v4u*)(ADm + t * 72 + c8) = pack8(x); }
    bar_lds();
    { const int rt = wave & 3, cp = (wave >> 2) * 2, fr = lane & 15, fq = lane >> 4;
      bf16x8 aT[2], aA[2];
#pragma unroll
      for (int s = 0; s < 2; ++s) { aT[s] = *(const LAS bf16x8*)(TW + (16 * rt + fr) * 72 + 32 * s + 8 * fq); aA[s] = *(const LAS bf16x8*)(ADm + (16 * rt + fr) * 72 + 32 * s + 8 * fq); }
#pragma unroll
      for (int ci = 0; ci < 2; ++ci) { const int ct = cp + ci; f32x4 z = {0.f, 0.f, 0.f, 0.f}, ap = {0.f, 0.f, 0.f, 0.f};
#pragma unroll
          for (int s = 0; s < 2; ++s) { const size_t bo = (size_t)(h * 64 + 16 * ct + fr) * 64 + 32 * s + 8 * fq;
              z = MFMA16(aT[s], *(const bf16x8*)(upt + bo), z); ap = MFMA16(aA[s], *(const bf16x8*)(aupt + bo), ap); }
#pragma unroll
          for (int j = 0; j < 4; ++j) { Z[(16 * rt + 4 * fq + j) * 68 + 16 * ct + fr] = z[j]; AP[(16 * rt + 4 * fq + j) * 68 + 16 * ct + fr] = ap[j]; } } }
    bar_lds();
    float zz[8], aa[8], kr[8], c0[8], c1[8];
#pragma unroll
    for (int j = 0; j < 8; ++j) { zz[j] = Z[t * 68 + c8 + j]; aa[j] = AP[t * 68 + c8 + j]; }
    load_shift8(proj, row, C_R + ch, mu, P.r); load_shift8(proj, row, C_K + ch, mu, kr); load_shift8(proj, row, C_V + ch, mu, P.v); load_shift8(proj, row, C_G + ch, mu, P.g);
    ld8f(a.in[4] + ch, c0); ld8f(a.in[6] + ch, c1);
#pragma unroll
    for (int j = 0; j < 8; ++j) { const float z = c0[j] + zz[j]; const float sp = (z < -15.f) ? -z : __logf(1.f + __expf(-z)); const float wl = -sp - 0.5f; P.lw[j] = -__expf(wl); P.w[j] = __expf(P.lw[j]); aa[j] = sigmoidf_(c1[j] + aa[j]); }
    ld8f(a.in[8] + ch, c0); ld8f(a.in[9] + ch, c1);
    float ss = 0.f;
#pragma unroll
    for (int j = 0; j < 8; ++j) { P.kk[j] = kr[j] * c0[j]; ss += P.kk[j] * P.kk[j]; P.kp[j] = kr[j] * (1.f + (aa[j] - 1.f) * c1[j]); }
    ss = sum8(ss); const float rn = 1.f / fmaxf(sqrtf(ss), 1e-12f);
    ld8f(a.in[10] + ch, c0);
    float bs = 0.f;
#pragma unroll
    for (int j = 0; j < 8; ++j) { P.kk[j] *= rn; P.b[j] = P.kk[j] * aa[j]; bs += P.r[j] * P.kp[j] * c0[j]; }
    P.bonus = sum8(bs);
}
__device__ __forceinline__ void rwkv_out8(const Args& a, const float (&y)[8], const float (&v)[8], const float (&g)[8], float bonus, int row, int ch) {
    bf16* mix = (bf16*)(a.ws + WS_MIX);
    float s = 0.f;
#pragma unroll
    for (int j = 0; j < 8; ++j) s += y[j];
    const float mean = sum8(s) * (1.f / 64.f); float q = 0.f;
#pragma unroll
    for (int j = 0; j < 8; ++j) { const float d = y[j] - mean; q += d * d; }
    const float rstd = 1.f / sqrtf(sum8(q) * (1.f / 64.f) + LNX_EPS);
    float lg[8], lb[8], o[8]; ld8f(a.in[11] + ch, lg); ld8f(a.in[12] + ch, lb);
#pragma unroll
    for (int j = 0; j < 8; ++j) { const float yn = (y[j] - mean) * rstd * lg[j] + lb[j] + bonus * v[j]; o[j] = yn * siluf_(g[j]); }
    *(v4u*)(mix + (size_t)row * D + ch) = pack8(o);
}
constexpr size_t WS_MF = 174 * MiB, WS_QF = 190 * MiB, WS_SF = 206 * MiB, WS_BON = 222 * MiB;
constexpr size_t OUT_NF = 0, OUT_Y2 = 32 * MiB;
constexpr int MP = 72;
constexpr int L_AT = 0, L_ATT = 9216, L_BT = 18432, L_KT = 27648, L_RT = 36864, L_BHT = 46080, L_KHT = 55296, L_VT = 64512, L_LW = 73728, L_P = 73728, L_PT = 82944,
              L_AAK = 92160, L_ARB = 101376, L_ARK = 110592, L_TM = 119808, L_SEG = 119808, L_GC = 129024, L_WT = L_AT, L_X1T = L_BT, L_U2T = L_KT;
struct WTile { int ta, tb0, fr, fq; };
__device__ __forceinline__ bf16x8 ldfrag(const LAS bf16* M, int tile, int s, const WTile& w) { return *(const LAS bf16x8*)(M + (16 * tile + w.fr) * MP + 32 * s + 8 * w.fq); }
__device__ __forceinline__ void mm2(const LAS bf16* A, const LAS bf16* B, const WTile& w, f32x4 (&acc)[2]) {
#pragma unroll
    for (int s = 0; s < 2; ++s) { const bf16x8 af = ldfrag(A, w.ta, s, w);
#pragma unroll
        for (int ci = 0; ci < 2; ++ci) acc[ci] = MFMA16(af, ldfrag(B, w.tb0 + ci, s, w), acc[ci]); }
}
__device__ __forceinline__ void st_T(LAS bf16* X, int ta, int tb, const WTile& w, const f32x4& v) { v2u o; o.x = pk2(v[0], v[1]); o.y = pk2(v[2], v[3]); *(LAS v2u*)(X + (16 * tb + w.fr) * MP + 16 * ta + 4 * w.fq) = o; }
__device__ __forceinline__ void st_N(LAS bf16* X, int ta, int tb, const WTile& w, const f32x4& v) {
    const unsigned a = pk2(v[0], v[1]), b = pk2(v[2], v[3]); LAS bf16* p = X + (16 * ta + 4 * w.fq) * MP + 16 * tb + w.fr;
    p[0] = (bf16)(a & 0xffffu); p[MP] = (bf16)(a >> 16); p[2 * MP] = (bf16)(b & 0xffffu); p[3 * MP] = (bf16)(b >> 16);
}
#define ZERO2(x) do { x[0] = (f32x4){0.f, 0.f, 0.f, 0.f}; x[1] = (f32x4){0.f, 0.f, 0.f, 0.f}; } while (0)
template <int MODE> __device__ __forceinline__ void mask2(f32x4 (&acc)[2], const WTile& w) {
#pragma unroll
    for (int ci = 0; ci < 2; ++ci)
#pragma unroll
        for (int j = 0; j < 4; ++j) { const int row = 16 * w.ta + 4 * w.fq + j, col = 16 * (w.tb0 + ci) + w.fr;
            const bool keep = MODE == 0 ? (row < col) : (MODE == 1 ? (row <= col) : (col < row)); if (!keep) acc[ci][j] = 0.f; }
}
__device__ __forceinline__ void st_bf16x8_T2(LAS bf16* X, int c8, int t, int lane, const float (&v)[8]) {
    const v4u p = pack8(v); const unsigned w[4] = {p.x, p.y, p.z, p.w}; const bool odd = (lane >> 3) & 1;
#pragma unroll
    for (int j = 0; j < 4; ++j) {
        const unsigned q = (unsigned)__builtin_amdgcn_update_dpp(0, (int)w[j], 0x128  , 0xf, 0xf, false);
        const unsigned o = odd ? ((q >> 16) | (w[j] & 0xffff0000u)) : ((w[j] & 0xffffu) | (q << 16));
        *(LAS unsigned*)(X + (c8 + 2 * j + (odd ? 1 : 0)) * MP + (t & ~1)) = o;
    }
}
__device__ __forceinline__ void st_bf16x8_T(LAS bf16* X, int c8, int t, const float (&v)[8]) {
    const v4u p = pack8(v); const unsigned w[4] = {p.x, p.y, p.z, p.w};
#pragma unroll
    for (int j = 0; j < 4; ++j) { X[(c8 + 2 * j) * MP + t] = (bf16)(w[j] & 0xffffu); X[(c8 + 2 * j + 1) * MP + t] = (bf16)(w[j] >> 16); }
}

__device__ __forceinline__ void rwkv_chunk_prep(const Args& a, LAS unsigned char* lds, int unit, int tid, int wave, int lane) {
    const int c = unit >> 4, h = unit & 15, t0 = c * CH, t = tid >> 3, c8 = (tid & 7) * 8;
    LAS bf16* At = (LAS bf16*)(lds + L_AT); LAS bf16* AtT = (LAS bf16*)(lds + L_ATT); LAS bf16* Bt = (LAS bf16*)(lds + L_BT); LAS bf16* Kt = (LAS bf16*)(lds + L_KT);
    LAS bf16* Rt = (LAS bf16*)(lds + L_RT); LAS bf16* BhT = (LAS bf16*)(lds + L_BHT); LAS bf16* KhT = (LAS bf16*)(lds + L_KHT); LAS bf16* VT = (LAS bf16*)(lds + L_VT);
    LAS float* LW = (LAS float*)(lds + L_LW); LAS bf16* Pm = (LAS bf16*)(lds + L_P); LAS bf16* PT = (LAS bf16*)(lds + L_PT);
    LAS bf16* AAK = (LAS bf16*)(lds + L_AAK); LAS bf16* ARB = (LAS bf16*)(lds + L_ARB); LAS bf16* ARK = (LAS bf16*)(lds + L_ARK); LAS bf16* TM = (LAS bf16*)(lds + L_TM);
    LAS float* SEG = (LAS float*)(lds + L_SEG); LAS float* GC = (LAS float*)(lds + L_GC);
    LAS bf16* WT = (LAS bf16*)(lds + L_WT); LAS bf16* X1T = (LAS bf16*)(lds + L_X1T); LAS bf16* U2T = (LAS bf16*)(lds + L_U2T);
    bar_lds();
    Prep P; rwkv_prep(a, lds, h, t0, tid, wave, lane, P);
#ifdef PROBE_PREP2
    bar_lds(); rwkv_prep(a, lds, h, t0, tid, wave, lane, P);
#endif
    if ((tid & 7) == 0) ((float*)(a.ws + WS_BON))[(size_t)(t0 + t) * 16 + h] = P.bonus;
#pragma unroll
    for (int j = 0; j < 8; ++j) LW[t * 68 + c8 + j] = P.lw[j];
    bar_lds();
    { const int cc = tid & 63, sg = tid >> 6; float run = 0.f;
#pragma unroll
      for (int i = 0; i < 8; ++i) { run += LW[(8 * sg + i) * 68 + cc]; LW[(8 * sg + i) * 68 + cc] = run; }
      SEG[sg * 64 + cc] = run; }
    bar_lds();
    {
        float Lt[8], LC[8];
#pragma unroll
        for (int j = 0; j < 8; ++j) { float off = 0.f, tot = 0.f;
#pragma unroll
            for (int s = 0; s < 8; ++s) { const float sv = SEG[s * 64 + c8 + j]; tot += sv; if (s < (t >> 3)) off += sv; }
            Lt[j] = LW[t * 68 + c8 + j] + off; LC[j] = tot; }
        if (t == 0) {
#pragma unroll
            for (int j = 0; j < 8; ++j) GC[c8 + j] = __expf(LC[j]); }
        float x[8], y[8];
#pragma unroll
        for (int j = 0; j < 8; ++j) x[j] = -P.kk[j] * __expf(Lt[j] - P.lw[j]);
        *(LAS v4u*)(At + t * MP + c8) = pack8(x); st_bf16x8_T(AtT, c8, t, x);
#pragma unroll
        for (int j = 0; j < 8; ++j) { const float e = __expf(-Lt[j]); x[j] = P.b[j] * e; y[j] = P.kp[j] * e; }
        *(LAS v4u*)(Bt + t * MP + c8) = pack8(x); *(LAS v4u*)(Kt + t * MP + c8) = pack8(y);
#pragma unroll
        for (int j = 0; j < 8; ++j) x[j] = P.r[j] * __expf(Lt[j]);
        *(LAS v4u*)(Rt + t * MP + c8) = pack8(x);
#pragma unroll
        for (int j = 0; j < 8; ++j) { const float e = __expf(LC[j] - Lt[j]); x[j] = P.b[j] * e; y[j] = P.kp[j] * e; }
        st_bf16x8_T(BhT, c8, t, x); st_bf16x8_T(KhT, c8, t, y); st_bf16x8_T(VT, c8, t, P.v);
    }
    bar_lds();
    WTile w; w.ta = wave & 3; w.tb0 = (wave >> 2) * 2; w.fr = lane & 15; w.fq = lane >> 4;
    f32x4 acc[2], Tacc[2];
    ZERO2(Tacc); mm2(At, Bt, w, Tacc); mask2<2>(Tacc, w);
    ZERO2(acc); mm2(Kt, At, w, acc); mask2<0>(acc, w);
    f32x4 rb[2], rk[2]; ZERO2(rb); mm2(Bt, Rt, w, rb); mask2<1>(rb, w); ZERO2(rk); mm2(Kt, Rt, w, rk); mask2<1>(rk, w);
    bar_lds();
#pragma unroll
    for (int ci = 0; ci < 2; ++ci) { st_N(Pm, w.ta, w.tb0 + ci, w, Tacc[ci]); st_T(PT, w.ta, w.tb0 + ci, w, Tacc[ci]);
        st_T(AAK, w.ta, w.tb0 + ci, w, acc[ci]); st_T(ARB, w.ta, w.tb0 + ci, w, rb[ci]); st_T(ARK, w.ta, w.tb0 + ci, w, rk[ci]);
#pragma unroll
        for (int j = 0; j < 4; ++j) if (16 * w.ta + 4 * w.fq + j == 16 * (w.tb0 + ci) + w.fr) Tacc[ci][j] += 1.f;
        st_N(TM, w.ta, w.tb0 + ci, w, Tacc[ci]); }
    bar_lds();
#pragma unroll 1
#ifdef PROBE_NEU2
    for (int n = 0; n < 10; ++n) {
#else
    for (int n = 0; n < 5; ++n) {
#endif
        ZERO2(acc); mm2(Pm, PT, w, acc);
        bar_lds();
#pragma unroll
        for (int ci = 0; ci < 2; ++ci) { st_N(Pm, w.ta, w.tb0 + ci, w, acc[ci]); st_T(PT, w.ta, w.tb0 + ci, w, acc[ci]); }
        bar_lds();
        mm2(TM, PT, w, Tacc);
        bar_lds();
#pragma unroll
        for (int ci = 0; ci < 2; ++ci) st_N(TM, w.ta, w.tb0 + ci, w, Tacc[ci]);
        bar_lds();
    }
    ZERO2(acc); mm2(TM, AtT, w, acc); ZERO2(rb); mm2(AAK, VT, w, rb);
#pragma unroll
    for (int ci = 0; ci < 2; ++ci) { st_T(WT, w.ta, w.tb0 + ci, w, acc[ci]); st_T(X1T, w.ta, w.tb0 + ci, w, rb[ci]); }
    bar_lds();
    const size_t ub = (size_t)unit * 4096;
    { ZERO2(acc); mm2(TM, X1T, w, acc);
#pragma unroll
      for (int ci = 0; ci < 2; ++ci) st_T(U2T, w.ta, w.tb0 + ci, w, acc[ci]);
      bf16* MF = (bf16*)(a.ws + WS_MF) + ub; bf16* QF = (bf16*)(a.ws + WS_QF) + ub;
      ZERO2(acc); mm2(WT, BhT, w, acc);
      ZERO2(rb); mm2(WT, ARB, w, rb);
#pragma unroll
      for (int ci = 0; ci < 2; ++ci) { const int tb = w.tb0 + ci; const int col = 16 * tb + w.fr; const float gc = GC[col];
          f32x4 m = acc[ci];
#pragma unroll
          for (int j = 0; j < 4; ++j) if (16 * w.ta + 4 * w.fq + j == col) m[j] += gc;
          const size_t fo = (size_t)((tb * 2 + (w.ta >> 1)) * 64 + lane) * 8 + 4 * (w.ta & 1);
          v2u o; o.x = pk2(m[0], m[1]); o.y = pk2(m[2], m[3]); *(v2u*)(MF + fo) = o;
          const v2u rr = *(const LAS v2u*)(Rt + col * MP + 16 * w.ta + 4 * w.fq);
          f32x4 q = rb[ci]; q[0] += bflo(rr.x); q[1] += bfhi(rr.x); q[2] += bflo(rr.y); q[3] += bfhi(rr.y);
          o.x = pk2(q[0], q[1]); o.y = pk2(q[2], q[3]); *(v2u*)(QF + fo) = o; } }
    bar_lds();
    { float* NF = (float*)((unsigned char*)a.out + OUT_NF) + ub; float* Y2 = (float*)((unsigned char*)a.out + OUT_Y2) + ub;
      ZERO2(acc); mm2(BhT, U2T, w, acc); mm2(KhT, VT, w, acc);
      ZERO2(rb); mm2(U2T, ARB, w, rb); mm2(VT, ARK, w, rb);
#pragma unroll
      for (int ci = 0; ci < 2; ++ci) { const int tb = w.tb0 + ci;
          *(f32x4*)(NF + (size_t)((tb * 4 + w.ta) * 64 + lane) * 4) = acc[ci];
          *(f32x4*)(Y2 + (size_t)(16 * tb + w.fr) * 64 + 16 * w.ta + 4 * w.fq) = rb[ci]; } }
}

constexpr int KR = 4, NR = NCH / KR, SLOT = 10240, RBUF = KR * SLOT, NPIECE = RBUF / 16, LPT = 6, PPC = SLOT / 16;
__device__ __forceinline__ const v4u* sp_src(const Args& a, int h, int cg, int r, int p) {
    const int cc = p / PPC, q = p % PPC, c = r * KR + cc; const size_t ub = (size_t)(c * 16 + h) * 4096;
    return q < 512 ? (const v4u*)((const bf16*)(a.ws + WS_MF) + ub) + q : (const v4u*)((const bf16*)((const unsigned char*)a.out + OUT_NF) + ub + cg * 1024) + (q - 512);
}
__device__ __forceinline__ void state_pass(const Args& a, LAS unsigned char* lds, int b, int tid, int wave, int lane) {
    const int h = b & 15, cg = b >> 4, lt = tid - 64;
    v4u ra[LPT], rb[LPT];
    if (wave != 0) {
#pragma unroll
        for (int i = 0; i < LPT; ++i) { const int p = lt + 448 * i; if (p < NPIECE) ra[i] = *sp_src(a, h, cg, 0, p); }
#pragma unroll
        for (int i = 0; i < LPT; ++i) { const int p = lt + 448 * i; if (p < NPIECE) *(LAS v4u*)(lds + p * 16) = ra[i]; }
#pragma unroll
        for (int i = 0; i < LPT; ++i) { const int p = lt + 448 * i; if (p < NPIECE) ra[i] = *sp_src(a, h, cg, 1, p); }
    }
    f32x4 st[4];
#pragma unroll
    for (int i = 0; i < 4; ++i) st[i] = (f32x4){0.f, 0.f, 0.f, 0.f};
    bar_lds();
    bf16* SF = (bf16*)(a.ws + WS_SF);
#define SP_ROUND(r_, RA, RB) do { \
        if (wave != 0) { \
            if ((r_) + 2 < NR) { _Pragma("unroll") for (int i = 0; i < LPT; ++i) { const int p = lt + 448 * i; if (p < NPIECE) RB[i] = *sp_src(a, h, cg, (r_) + 2, p); } } \
            if ((r_) + 1 < NR) { _Pragma("unroll") for (int i = 0; i < LPT; ++i) { const int p = lt + 448 * i; if (p < NPIECE) *(LAS v4u*)(lds + (((r_) + 1) & 1) * RBUF + p * 16) = RA[i]; } } \
        } else { \
            _Pragma("unroll") for (int cc = 0; cc < KR; ++cc) { \
                const LAS unsigned char* sl = lds + ((r_) & 1) * RBUF + cc * SLOT; const int c = (r_) * KR + cc; \
                v4u b0, b1; b0.x = pk2(st[0][0], st[0][1]); b0.y = pk2(st[0][2], st[0][3]); b0.z = pk2(st[1][0], st[1][1]); b0.w = pk2(st[1][2], st[1][3]); \
                b1.x = pk2(st[2][0], st[2][1]); b1.y = pk2(st[2][2], st[2][3]); b1.z = pk2(st[3][0], st[3][1]); b1.w = pk2(st[3][2], st[3][3]); \
                v4u* sfo = (v4u*)(SF + (size_t)(c * 16 + h) * 4096) + (cg * 2) * 64 + lane; sfo[0] = b0; sfo[64] = b1; \
                const bf16x8 f0 = __builtin_bit_cast(bf16x8, b0), f1 = __builtin_bit_cast(bf16x8, b1); \
                _Pragma("unroll") for (int rt = 0; rt < 4; ++rt) { \
                    const v2u nb_ = *(const LAS v2u*)(sl + 8192 + (rt * 64 + lane) * 8); f32x4 n = {bflo(nb_.x), bfhi(nb_.x), bflo(nb_.y), bfhi(nb_.y)}; \
                    n = MFMA16(*(const LAS bf16x8*)(sl + ((rt * 2 + 0) * 64 + lane) * 16), f0, n); \
                    n = MFMA16(*(const LAS bf16x8*)(sl + ((rt * 2 + 1) * 64 + lane) * 16), f1, n); st[rt] = n; } \
            } \
        } \
        bar_lds(); } while (0)
#pragma unroll 1
    for (int r = 0; r < NR; r += 2) { SP_ROUND(r, ra, rb); SP_ROUND(r + 1, rb, ra); }
#undef SP_ROUND
}

__device__ __forceinline__ void rwkv_out_unit(const Args& a, LAS unsigned char* lds, int unit, int tid, int wave, int lane) {
    const int c = unit >> 4, h = unit & 15, t0 = c * CH, t = tid >> 3, c8 = (tid & 7) * 8, ch = h * 64 + c8;
    const size_t ub = (size_t)unit * 4096;
    const bf16* QF = (const bf16*)(a.ws + WS_QF) + ub; const bf16* SF = (const bf16*)(a.ws + WS_SF) + ub; const bf16* Y2 = (const bf16*)((const unsigned char*)a.out + OUT_Y2) + ub;
    LAS float* SY = (LAS float*)lds;
    const int ta = wave & 3, tb0 = (wave >> 2) * 2, fr = lane & 15, fq = lane >> 4;
    bf16x8 af[2], bfr[2][2];
#pragma unroll
    for (int s = 0; s < 2; ++s) { af[s] = *(const bf16x8*)(QF + (size_t)((ta * 2 + s) * 64 + lane) * 8);
#pragma unroll
        for (int ci = 0; ci < 2; ++ci) bfr[s][ci] = *(const bf16x8*)(SF + (size_t)(((tb0 + ci) * 2 + s) * 64 + lane) * 8); }
    float y2[8], v[8], g[8];
    unpack8(ldg16(Y2 + t * 64 + c8), y2);
    const bf16* proj = (const bf16*)(a.ws + WS_PROJ);
    load_shift8(proj, t0 + t, C_V + ch, a.in[3], v); load_shift8(proj, t0 + t, C_G + ch, a.in[3], g);
    const float bonus = ((const float*)(a.ws + WS_BON))[(size_t)(t0 + t) * 16 + h];
    f32x4 acc[2]; ZERO2(acc);
#pragma unroll
    for (int s = 0; s < 2; ++s)
#pragma unroll
        for (int ci = 0; ci < 2; ++ci) acc[ci] = MFMA16(af[s], bfr[s][ci], acc[ci]);
    bar_lds();
#pragma unroll
    for (int ci = 0; ci < 2; ++ci)
#pragma unroll
        for (int j = 0; j < 4; ++j) SY[(16 * ta + 4 * fq + j) * 68 + 16 * (tb0 + ci) + fr] = acc[ci][j];
    bar_lds();
    float y[8];
#pragma unroll
    for (int j = 0; j < 8; ++j) y[j] = SY[t * 68 + c8 + j] + y2[j];
    rwkv_out8(a, y, v, g, bonus, t0 + t, ch);
}
constexpr int L2_SEG = 129280, L2_XST = 131328, L2_TW = 131584, L2_ADM = 140800, L2_X1T = 150016;
struct PF { v4u p[4], q[4]; };
__device__ __forceinline__ void pf_issue(PF& f, const bf16* proj, int row, int ch) {
    const int cols[4] = {C_R, C_K, C_V, C_G};
#pragma unroll
    for (int i = 0; i < 4; ++i) { f.p[i] = ldg16(proj + (size_t)row * NINP + cols[i] + ch); f.q[i] = (v4u){0u, 0u, 0u, 0u}; if (row > 0) f.q[i] = ldg16(proj + (size_t)(row - 1) * NINP + cols[i] + ch); }
}
__device__ __forceinline__ void pf_shift(const v4u& p, const v4u& q, const float (&mf)[8], float (&o)[8]) {
    float pf[8], qf[8]; unpack8(p, pf); unpack8(q, qf);
#pragma unroll
    for (int j = 0; j < 8; ++j) o[j] = pf[j] + (qf[j] - pf[j]) * mf[j];
}
template <bool DOP, bool DOT, bool CHK = false> __device__ __forceinline__ void neu_stage(const LAS bf16* Pin, const LAS bf16* PTin, LAS bf16* Pout, LAS bf16* PTout, const LAS bf16* TMin, LAS bf16* TMout, const WTile& w, f32x4 (&Tacc)[2], LAS unsigned* flag = nullptr) {
    f32x4 acc[2];
    if (DOP) { ZERO2(acc); mm2(Pin, PTin, w, acc); }
    if (DOP && CHK) {
        float m = 0.f;
#pragma unroll
        for (int ci = 0; ci < 2; ++ci)
#pragma unroll
            for (int j = 0; j < 4; ++j) m = fmaxf(m, fabsf(acc[ci][j]));
        if (m > 1e-4f) atomicMax((unsigned*)flag, __float_as_uint(m));
    }
    if (DOT) mm2(TMin, PTin, w, Tacc);
#pragma unroll
    for (int ci = 0; ci < 2; ++ci) {
        if (DOP) { st_N(Pout, w.ta, w.tb0 + ci, w, acc[ci]); st_T(PTout, w.ta, w.tb0 + ci, w, acc[ci]); }
        if (DOT) st_N(TMout, w.ta, w.tb0 + ci, w, Tacc[ci]);
    }
    bar_lds();
}
__device__ __forceinline__ void rwkv_chunk_group(const Args& a, LAS unsigned char* lds, int item, int tid, int wave, int lane) {
    const int c = item >> 1, hg = item & 1, t0 = c * CH, t = tid >> 3, c8 = (tid & 7) * 8, row = t0 + t;
    const bf16* proj = (const bf16*)(a.ws + WS_PROJ); const bf16* upt = (const bf16*)(a.ws + WS_UPT); const bf16* aupt = upt + 65536; const float* mu = a.in[3];
    LAS bf16* TW = (LAS bf16*)(lds + L2_TW); LAS bf16* ADm = (LAS bf16*)(lds + L2_ADM);
    WTile w; w.ta = wave & 3; w.tb0 = (wave >> 2) * 2; w.fr = lane & 15; w.fq = lane >> 4;
    bar_lds();
    { float x[8]; load_shift8(proj, row, C_WD + c8, mu, x);
#pragma unroll
      for (int j = 0; j < 8; ++j) x[j] = 1.f - 2.f * __builtin_amdgcn_rcpf(1.f + __expf(2.f * x[j]));
      *(LAS v4u*)(TW + t * 72 + c8) = pack8(x);
      load_shift8(proj, row, C_AD + c8, mu, x); *(LAS v4u*)(ADm + t * 72 + c8) = pack8(x); }
    PF pf; pf_issue(pf, proj, row, hg * 512 + c8);
#pragma unroll 1
    for (int hh = 0; hh < 8; ++hh) {
        const int h = hg * 8 + hh, ch = h * 64 + c8, unit = c * 16 + h;
        LAS unsigned char* L = lds; asm volatile("" : "+v"(L));
        LAS bf16* At = (LAS bf16*)(L + L_AT); LAS bf16* AtT = (LAS bf16*)(L + L_ATT); LAS bf16* Bt = (LAS bf16*)(L + L_BT); LAS bf16* Kt = (LAS bf16*)(L + L_KT);
        LAS bf16* Rt = (LAS bf16*)(L + L_RT); LAS bf16* BhT = (LAS bf16*)(L + L_BHT); LAS bf16* KhT = (LAS bf16*)(L + L_KHT); LAS bf16* VT = (LAS bf16*)(L + L_VT);
        LAS bf16* P0 = (LAS bf16*)(L + L_P); LAS bf16* PT0 = (LAS bf16*)(L + L_PT); LAS bf16* TM0 = (LAS bf16*)(L + L_TM);
        LAS bf16* P1 = At; LAS bf16* PT1 = Bt; LAS bf16* TM1 = Kt;
        LAS bf16* AAK = (LAS bf16*)(L + L_AAK); LAS bf16* ARB = (LAS bf16*)(L + L_ARB); LAS bf16* ARK = (LAS bf16*)(L + L_ARK);
        LAS float* SEG = (LAS float*)(L + L2_SEG); LAS float* GC = (LAS float*)(L + L_GC);
        LAS bf16* X1T = (LAS bf16*)(L + L2_X1T);
        LAS float* Z = (LAS float*)(L + 18432); LAS float* AP = Z + 64 * 68;
        LAS bf16* WT = At; LAS bf16* U2T = Bt; LAS unsigned* NFLAG = (LAS unsigned*)(L + 159232);
        bf16x8 bU[2][2], bA[2][2];
#pragma unroll
        for (int ci = 0; ci < 2; ++ci)
#pragma unroll
            for (int s = 0; s < 2; ++s) { const size_t bo = (size_t)(h * 64 + 16 * (w.tb0 + ci) + w.fr) * 64 + 32 * s + 8 * w.fq; bU[ci][s] = *(const bf16x8*)(upt + bo); bA[ci][s] = *(const bf16x8*)(aupt + bo); }
        float pw0[8], pa0[8], pkk[8], pka[8], prk[8], mur[8], muk[8], muv[8];
        ld8f(a.in[4] + ch, pw0); ld8f(a.in[6] + ch, pa0); ld8f(a.in[8] + ch, pkk); ld8f(a.in[9] + ch, pka); ld8f(a.in[10] + ch, prk);
        ld8f(mu + C_R + ch, mur); ld8f(mu + C_K + ch, muk); ld8f(mu + C_V + ch, muv);
        bar_lds();
#ifdef PROBE_G
        if (blockIdx.x == 0 && tid == 0 && hh == 3) ((unsigned long long*)(a.ws + 65536))[0] = __builtin_amdgcn_s_memrealtime();
#endif

        { const int rt = w.ta, cp = w.tb0, fr = w.fr, fq = w.fq;
          bf16x8 aT[2], aA[2];
#pragma unroll
          for (int s = 0; s < 2; ++s) { aT[s] = *(const LAS bf16x8*)(TW + (16 * rt + fr) * 72 + 32 * s + 8 * fq); aA[s] = *(const LAS bf16x8*)(ADm + (16 * rt + fr) * 72 + 32 * s + 8 * fq); }
#pragma unroll
          for (int ci = 0; ci < 2; ++ci) { const int ct = cp + ci; f32x4 z = {0.f, 0.f, 0.f, 0.f}, ap = {0.f, 0.f, 0.f, 0.f};
#pragma unroll
              for (int s = 0; s < 2; ++s) { z = MFMA16(aT[s], bU[ci][s], z); ap = MFMA16(aA[s], bA[ci][s], ap); }
#pragma unroll
              for (int j = 0; j < 4; ++j) { Z[(16 * rt + 4 * fq + j) * 68 + 16 * ct + fr] = z[j]; AP[(16 * rt + 4 * fq + j) * 68 + 16 * ct + fr] = ap[j]; } } }
        bar_lds();
#ifdef PROBE_G
        if (blockIdx.x == 0 && tid == 0 && hh == 3) ((unsigned long long*)(a.ws + 65536))[1] = __builtin_amdgcn_s_memrealtime();
#endif
        float r[8], kp[8], vv[8], lw[8], kk[8], bb[8];
        { float zz[8], aa[8], kr[8];
#pragma unroll
          for (int j = 0; j < 8; ++j) { zz[j] = Z[t * 68 + c8 + j]; aa[j] = AP[t * 68 + c8 + j]; }
          pf_shift(pf.p[0], pf.q[0], mur, r); pf_shift(pf.p[1], pf.q[1], muk, kr); pf_shift(pf.p[2], pf.q[2], muv, vv);
#pragma unroll
          for (int j = 0; j < 8; ++j) { const float z = pw0[j] + zz[j]; lw[j] = -0.60653066f * __builtin_amdgcn_rcpf(1.f + __expf(-z)); aa[j] = sigmoidf_(pa0[j] + aa[j]); }
          float ss = 0.f;
#pragma unroll
          for (int j = 0; j < 8; ++j) { kk[j] = kr[j] * pkk[j]; ss += kk[j] * kk[j]; kp[j] = kr[j] * (1.f + (aa[j] - 1.f) * pka[j]); }
          ss = sum8(ss); const float rn = 1.f / fmaxf(sqrtf(ss), 1e-12f);
          float bs = 0.f;
#pragma unroll
          for (int j = 0; j < 8; ++j) { kk[j] *= rn; bb[j] = kk[j] * aa[j]; bs += r[j] * kp[j] * prk[j]; }
          bs = sum8(bs);
          if ((tid & 7) == 0) ((float*)(a.ws + WS_BON))[(size_t)row * 16 + h] = bs; }
        if (hh < 7) pf_issue(pf, proj, row, ch + 64);
        float Lt[8];
#pragma unroll
        for (int j = 0; j < 8; ++j) { float x = lw[j];
#pragma unroll
            for (int d = 8; d < 64; d <<= 1) { const float y = __shfl_up(x, d); if (lane >= d) x += y; }
            Lt[j] = x; }
        if ((lane >> 3) == 7) {
#pragma unroll
            for (int j = 0; j < 8; ++j) SEG[wave * 64 + c8 + j] = Lt[j]; }
        bar_lds();
        {
            float gc[8], x[8], y[8];
            { float off[8], tot[8];
#pragma unroll
              for (int j = 0; j < 8; ++j) { off[j] = 0.f; tot[j] = 0.f; }
#pragma unroll
              for (int s = 0; s < 8; ++s) { const f32x4 s0 = *(const LAS f32x4*)(SEG + s * 64 + c8), s1 = *(const LAS f32x4*)(SEG + s * 64 + c8 + 4);
                  const float sv[8] = {s0.x, s0.y, s0.z, s0.w, s1.x, s1.y, s1.z, s1.w};
#pragma unroll
                  for (int j = 0; j < 8; ++j) { tot[j] += sv[j]; if (s < wave) off[j] += sv[j]; } }
#pragma unroll
              for (int j = 0; j < 8; ++j) { Lt[j] += off[j]; gc[j] = __expf(tot[j]); } }
            if (t == 0) {
#pragma unroll
                for (int j = 0; j < 8; ++j) GC[c8 + j] = gc[j]; }
            float e1[8], ie1[8];
#pragma unroll
            for (int j = 0; j < 8; ++j) { e1[j] = __expf(Lt[j]); ie1[j] = __builtin_amdgcn_rcpf(e1[j]); }
#pragma unroll
            for (int j = 0; j < 8; ++j) x[j] = -kk[j] * __expf(Lt[j] - lw[j]);
            *(LAS v4u*)(At + t * MP + c8) = pack8(x); st_bf16x8_T2(AtT, c8, t, lane, x);
#pragma unroll
            for (int j = 0; j < 8; ++j) { x[j] = bb[j] * ie1[j]; y[j] = kp[j] * ie1[j]; }
            *(LAS v4u*)(Bt + t * MP + c8) = pack8(x); *(LAS v4u*)(Kt + t * MP + c8) = pack8(y);
#pragma unroll
            for (int j = 0; j < 8; ++j) x[j] = r[j] * e1[j];
            *(LAS v4u*)(Rt + t * MP + c8) = pack8(x);
#pragma unroll
            for (int j = 0; j < 8; ++j) { const float e = gc[j] * ie1[j]; x[j] = bb[j] * e; y[j] = kp[j] * e; }
            st_bf16x8_T2(BhT, c8, t, lane, x); st_bf16x8_T2(KhT, c8, t, lane, y); st_bf16x8_T2(VT, c8, t, lane, vv);
        }
        bar_lds();
#ifdef PROBE_G
        if (blockIdx.x == 0 && tid == 0 && hh == 3) ((unsigned long long*)(a.ws + 65536))[2] = __builtin_amdgcn_s_memrealtime();
#endif
        f32x4 acc[2], Tacc[2], rb[2], rk[2];
        ZERO2(Tacc); mm2(At, Bt, w, Tacc); mask2<2>(Tacc, w);
        ZERO2(acc); mm2(Kt, At, w, acc); mask2<0>(acc, w);
        ZERO2(rb); mm2(Bt, Rt, w, rb); mask2<1>(rb, w); ZERO2(rk); mm2(Kt, Rt, w, rk); mask2<1>(rk, w);
        bar_lds();
#pragma unroll
        for (int ci = 0; ci < 2; ++ci) { st_N(P1, w.ta, w.tb0 + ci, w, Tacc[ci]); st_T(PT1, w.ta, w.tb0 + ci, w, Tacc[ci]);
            st_T(AAK, w.ta, w.tb0 + ci, w, acc[ci]); st_T(ARB, w.ta, w.tb0 + ci, w, rb[ci]); st_T(ARK, w.ta, w.tb0 + ci, w, rk[ci]);
#pragma unroll
            for (int j = 0; j < 4; ++j) if (16 * w.ta + 4 * w.fq + j == 16 * (w.tb0 + ci) + w.fr) Tacc[ci][j] += 1.f;
            st_N(TM1, w.ta, w.tb0 + ci, w, Tacc[ci]); }
        if (tid == 0) *NFLAG = 0u;
        bar_lds();
#ifdef PROBE_G
        if (blockIdx.x == 0 && tid == 0 && hh == 3) ((unsigned long long*)(a.ws + 65536))[3] = __builtin_amdgcn_s_memrealtime();
#endif
        { ZERO2(acc); mm2(AAK, VT, w, acc);
#pragma unroll
          for (int ci = 0; ci < 2; ++ci) st_T(X1T, w.ta, w.tb0 + ci, w, acc[ci]); }
        neu_stage<true, false>(P1, PT1, P0, PT0, nullptr, nullptr, w, Tacc);
        int nrep = 1; asm volatile("" : "+s"(nrep));
#pragma unroll 1
        for (int n = 0; n < nrep; ++n) {
            neu_stage<true, true>(P0, PT0, P1, PT1, TM1, TM0, w, Tacc);
            neu_stage<true, true, true>(P1, PT1, P0, PT0, TM0, TM1, w, Tacc, NFLAG);
        }
        if (*NFLAG != 0u) {
            neu_stage<true, true>(P0, PT0, P1, PT1, TM1, TM0, w, Tacc);
            neu_stage<true, true>(P1, PT1, P0, PT0, TM0, TM1, w, Tacc);
        }
        neu_stage<false, true>(P0, PT0, nullptr, nullptr, TM1, TM0, w, Tacc);

#ifdef PROBE_G
        if (blockIdx.x == 0 && tid == 0 && hh == 3) ((unsigned long long*)(a.ws + 65536))[4] = __builtin_amdgcn_s_memrealtime();
#endif
        ZERO2(acc); mm2(TM0, AtT, w, acc); ZERO2(rb); mm2(TM0, X1T, w, rb);
#pragma unroll
        for (int ci = 0; ci < 2; ++ci) { st_T(WT, w.ta, w.tb0 + ci, w, acc[ci]); st_T(U2T, w.ta, w.tb0 + ci, w, rb[ci]); }
        bar_lds();
        const size_t ub = (size_t)unit * 4096;
        { bf16* MF = (bf16*)(a.ws + WS_MF) + ub; bf16* QF = (bf16*)(a.ws + WS_QF) + ub;
          ZERO2(acc); mm2(WT, BhT, w, acc); ZERO2(rb); mm2(WT, ARB, w, rb);
#pragma unroll
          for (int ci = 0; ci < 2; ++ci) { const int tb = w.tb0 + ci; const int col = 16 * tb + w.fr; const float gcv = GC[col];
              f32x4 m = acc[ci];
#pragma unroll
              for (int j = 0; j < 4; ++j) if (16 * w.ta + 4 * w.fq + j == col) m[j] += gcv;
              const size_t fo = (size_t)((tb * 2 + (w.ta >> 1)) * 64 + lane) * 8 + 4 * (w.ta & 1);
              v2u o; o.x = pk2(m[0], m[1]); o.y = pk2(m[2], m[3]); *(v2u*)(MF + fo) = o;
              const v2u rr = *(const LAS v2u*)(Rt + col * MP + 16 * w.ta + 4 * w.fq);
              f32x4 q = rb[ci]; q[0] += bflo(rr.x); q[1] += bfhi(rr.x); q[2] += bflo(rr.y); q[3] += bfhi(rr.y);
              o.x = pk2(q[0], q[1]); o.y = pk2(q[2], q[3]); *(v2u*)(QF + fo) = o; }
          bf16* NF = (bf16*)((unsigned char*)a.out + OUT_NF) + ub; bf16* Y2 = (bf16*)((unsigned char*)a.out + OUT_Y2) + ub;
          ZERO2(acc); mm2(BhT, U2T, w, acc); mm2(KhT, VT, w, acc);
          ZERO2(rb); mm2(U2T, ARB, w, rb); mm2(VT, ARK, w, rb);
#pragma unroll
          for (int ci = 0; ci < 2; ++ci) { const int tb = w.tb0 + ci;
              v2u o; o.x = pk2(acc[ci][0], acc[ci][1]); o.y = pk2(acc[ci][2], acc[ci][3]); *(v2u*)(NF + (size_t)((tb * 4 + w.ta) * 64 + lane) * 4) = o;
              o.x = pk2(rb[ci][0], rb[ci][1]); o.y = pk2(rb[ci][2], rb[ci][3]); *(v2u*)(Y2 + (size_t)(16 * tb + w.fr) * 64 + 16 * w.ta + 4 * w.fq) = o; } }

#ifdef PROBE_G
        if (blockIdx.x == 0 && tid == 0 && hh == 3) ((unsigned long long*)(a.ws + 65536))[5] = __builtin_amdgcn_s_memrealtime();
#endif
    }
}
#ifndef HOSTDUP
#define HOSTDUP -1
#endif
#ifndef ONE_LAUNCH
#define ONE_LAUNCH 1
#endif
#if HOSTDUP != -1 || defined(MULTI)
#undef ONE_LAUNCH
#define ONE_LAUNCH 0
#endif
constexpr int NPHASE = 7;
__global__ void __launch_bounds__(NTHR, 2) mega(Args a) {
    extern __shared__ __attribute__((aligned(16))) unsigned char lds_[];
    LAS unsigned char* lds = (LAS unsigned char*)lds_;
    const int tid = threadIdx.x, lane = tid & 63, wave = __builtin_amdgcn_readfirstlane(tid >> 6);
    const int G = gridDim.x, bx = blockIdx.x, vcu = (G % 8 == 0) ? (bx % 8) * (G / 8) + bx / 8 : bx;
    cg::grid_group grid = cg::this_grid();
    volatile LAS unsigned* xst = (volatile LAS unsigned*)(lds + L2_XST);
    if (tid < 2) xst[tid] = 0u;
    __syncthreads();
    XcdBarrier xbar; xbar.bar = (unsigned*)a.ws; xbar.x = 0; xbar.st = xst;
    if (a.ph_hi - a.ph_lo > 1) xbar = xcd_barrier_post((unsigned*)a.ws, xst);
#ifndef PROBE_Q
#define PROBE_Q 1
#endif
#ifdef PROBE_TS
    unsigned long long ts_[10];
#define STAMP(i) do { ts_[i] = __builtin_amdgcn_s_memrealtime(); } while (0)
#else
#define STAMP(i) do {} while (0)
#endif
    STAMP(0);
#define IN(k) (a.ph_lo <= (k) && (k) < a.ph_hi)
#define SEAM(k) do { if (IN(k) && IN((k) + 1)) xcd_barrier(xbar); } while (0)
    if (a.ph_lo < 0) grid.sync();
    if (IN(0)) { p0_prologue(a, lds, vcu, G, wave, lane); }
    SEAM(0); STAMP(1);
    if (IN(1)) {
        constexpr int N1 = 6144;
        pg8::Gemm g{(const pg8::bf16_t*)(a.ws + WS_XN), (const pg8::bf16_t*)(a.ws + WS_WTIN), T, (G == 256 ? N1 : NINP), D}; pg8::StaticOrder S; S.init(T, (G == 256 ? N1 : NINP), G, bx);
        pg8::EpiBf16<0> E{(pg8::bf16_t*)(a.ws + WS_PROJ), NINP, nullptr, 0, 0, 1.f};
        pg8::gemm_phase<pg8::EpiBf16<0>, pg8::StaticOrder, true, true>(lds, g, S, E);
    }
    SEAM(1); STAMP(2);
    if (IN(2)) {
        for (int it = bx; it < NCH * 2; it += G) rwkv_chunk_group(a, lds, it, tid, wave, lane);
    }
    SEAM(2); STAMP(3);
    if (IN(3)) {
        if (bx < 64) state_pass(a, lds, bx, tid, wave, lane);
        else if (G == 256 && bx < 128) {
            pg8::Gemm g{(const pg8::bf16_t*)(a.ws + WS_XN), (const pg8::bf16_t*)(a.ws + WS_WTIN), T, NINP, D}; pg8::OneTile S{(bx - 64) >> 1, 24 + ((bx - 64) & 1)};
            pg8::EpiBf16<0> E{(pg8::bf16_t*)(a.ws + WS_PROJ), NINP, nullptr, 0, 0, 1.f};
            pg8::gemm_phase<pg8::EpiBf16<0>, pg8::OneTile, true, true>(lds, g, S, E);
        } else if (G == 256) { for (int it = bx - 128; it < 256; it += 128) attn_unit(a, lds, 2 * it, tid, wave, lane); }
    }
    SEAM(3); STAMP(4);
    if (IN(4)) {
        if (G == 256) { for (int it = bx; it < 256; it += G) attn_unit(a, lds, 2 * it + 1, tid, wave, lane); }
        else { for (int it = bx; it < 512; it += G) attn_unit(a, lds, it, tid, wave, lane); }
        STAMP(8);
        for (int u = bx; u < NCH * NH; u += G) rwkv_out_unit(a, lds, u, tid, wave, lane);
    }
    SEAM(4); STAMP(5);
    if (IN(5)) {
        pg8::Gemm g{(const pg8::bf16_t*)(a.ws + WS_MIX), (const pg8::bf16_t*)(a.ws + WS_WTOUT), T, D, D}; pg8::StaticOrder S; S.init(T, D, G, bx);
        if (G == 256 && a.ph_hi - a.ph_lo > 1) {
            pg8::EpiResidNorm E{a.in[0], a.out, (float*)(a.ws + WS_SSP), (unsigned*)a.ws + 4096, a.in[15], D, RMS_EPS};
            pg8::gemm_phase<pg8::EpiResidNorm, pg8::StaticOrder, false, true>(lds, g, S, E);
        } else {
            pg8::EpiResid E{a.in[0], a.out, (float*)(a.ws + WS_SSP), D};
            pg8::gemm_phase<pg8::EpiResid, pg8::StaticOrder, true, true>(lds, g, S, E);
        }
    }
    if (!(G == 256 && a.ph_hi - a.ph_lo > 1)) { SEAM(5); } STAMP(6);
    if (IN(6) && !(G == 256 && a.ph_hi - a.ph_lo > 1)) final_norm(a, vcu, G, wave, lane);
#ifdef PROBE_G
    __syncthreads();
    if (bx == 0 && tid == 0) { const unsigned long long* g_ = (const unsigned long long*)(a.ws + 65536); a.out[0] = (float)(g_[PROBE_G + 1] - g_[PROBE_G]) * 0.1f; }
#endif
#ifdef PROBE_TS
    STAMP(7); __syncthreads();
    if (bx == 0 && tid == 0) { const int k_ = PROBE_TS; const unsigned long long d_ = (k_ == 9) ? ts_[7] - ts_[0] : (k_ == 8) ? ts_[8] - ts_[4] : ts_[k_ + 1] - ts_[k_]; a.out[0] = (float)(((int)((float)d_ * 0.01f) / PROBE_Q) * PROBE_Q + PROBE_Q / 2); }
#endif
#undef IN
#undef SEAM
}

extern "C" void kernel_launch(void* const* d_in, const int* in_sizes, int n_in, void* d_out, int out_size, void* d_ws, size_t ws_size, hipStream_t stream) {
    static int grid = 0;
    if (grid == 0) {
        int dev = 0, cus = 0;
        if (hipGetDevice(&dev) != hipSuccess || hipDeviceGetAttribute(&cus, hipDeviceAttributeMultiprocessorCount, dev) != hipSuccess) { fprintf(stderr, "kernel_launch: device query failed\n"); grid = -1; return; }
        if (hipFuncSetAttribute((const void*)mega, hipFuncAttributeMaxDynamicSharedMemorySize, LDS_BYTES) != hipSuccess) { fprintf(stderr, "kernel_launch: hipFuncSetAttribute failed\n"); grid = -1; return; }
        (void)hipGetLastError();
        grid = cus;
    }
    if (grid < 0) return;
    Args a{};
    for (int i = 0; i < 16; ++i) a.in[i] = (const float*)d_in[i];
    a.out = (float*)d_out; a.ws = (unsigned char*)d_ws;
#if ONE_LAUNCH
    (void)hipMemsetAsync(d_ws, 0, 32768, stream);
    a.ph_lo = 0; a.ph_hi = NPHASE;
    void* args[] = {&a};
#ifdef PROBE_PLAIN
    hipLaunchKernelGGL(mega, dim3(grid), dim3(NTHR), LDS_BYTES, stream, a); hipError_t e = hipSuccess; (void)args;
#else
    hipError_t e = hipLaunchCooperativeKernel((const void*)mega, dim3(grid), dim3(NTHR), args, LDS_BYTES, stream);
#endif
    if (e != hipSuccess) fprintf(stderr, "cooperative launch failed: %s (grid %d)\n", hipGetErrorString(e), grid);
#else
    for (int p = 0; p < NPHASE; ++p) for (int rep = 0; rep < (p == HOSTDUP ? 2 : 1); ++rep) { a.ph_lo = p; a.ph_hi = p + 1; hipLaunchKernelGGL(mega, dim3(grid), dim3(NTHR), LDS_BYTES, stream, a); }
#endif
}
```

```cpp
#define ONE 1
#include <hip/hip_runtime.h>
#include <hip/hip_cooperative_groups.h>
#include <cstdio>
#include <cstdint>
namespace cg = cooperative_groups;
namespace pg8 {
#define PG8_LAS __attribute__((address_space(3)))
typedef unsigned short bf16_t;
typedef short bf16x8 __attribute__((ext_vector_type(8)));
typedef float f32x4 __attribute__((ext_vector_type(4)));
typedef unsigned u32x4 __attribute__((ext_vector_type(4)));
constexpr int BM = 256, BK = 64, HALF = 128, HTB = HALF * BK * 2  , STAGE_BYTES = 8 * HTB, NXCD = 8, WGM = 8;

__host__ __device__ __forceinline__ int lds_byte(int r, int c) { const int st = (r >> 4) * 2 + (c >> 5), rr = r & 15, cc = c & 31, ob = rr * 64 + cc * 2; return st * 1024 + (ob ^ (((ob >> 9) & 1) << 5)); }
__host__ __device__ __forceinline__ void stage_rc(int b, int& R, int& C) { const int st = b / 1024, sb = b % 1024, swz = sb ^ (((sb >> 9) & 1) << 5); R = (st >> 1) * 16 + swz / 64; C = (st & 1) * 32 + (swz % 64) / 2; }
__host__ __device__ __forceinline__ int perm32(int rho) { const int n = rho >> 4, i = rho & 15; return 8 * (i >> 2) + 4 * n + (i & 3); }

struct Unit { int pm, pn; };
struct Gemm { const bf16_t* A; const bf16_t* Bt; int M, N, K; };

struct StaticOrder {
    int nM, nN, nwg, G, c;
    __host__ __device__ void init(int M, int N, int G_, int c_) { nM = M / BM; nN = N / BM; nwg = nM * nN; G = G_; c = c_; }
    __host__ __device__ bool next(int i, Unit& u) const {
        const long L = (long)i * G + c; if (L >= nwg) return false;
        int wgid = (int)L; { const int q = nwg / NXCD, r = nwg % NXCD, xcd = wgid % NXCD, off = wgid / NXCD; wgid = (xcd < r ? xcd * (q + 1) : r * (q + 1) + (xcd - r) * q) + off; }
        const int nig = WGM * nN, gid = wgid / nig, fm = gid * WGM, gsz = (nM - fm) < WGM ? (nM - fm) : WGM;
        u.pm = fm + ((wgid % nig) % gsz); u.pn = (wgid % nig) / gsz; return true;
    }
    __device__ __forceinline__ void a_ready(const Unit&) const {}
    __device__ __forceinline__ void done(const Unit&) const {}
};

__device__ __forceinline__ unsigned cvt_pk_bf16(float lo, float hi) { unsigned r; asm volatile("v_cvt_pk_bf16_f32 %0, %1, %2" : "=v"(r) : "v"(lo), "v"(hi)); return r; }
typedef float f32x2 __attribute__((ext_vector_type(2)));
__device__ __forceinline__ f32x2 gelu_pk(f32x2 v) {
    const f32x2 av = __builtin_elementwise_abs(v), d = av * 0.2316418882f + 1.0f;
    f32x2 t; t.x = __builtin_amdgcn_rcpf(d.x); t.y = __builtin_amdgcn_rcpf(d.y);
    f32x2 q = t * 0.5307027145f + (-0.7265760135f); q = q * t + 0.7107068705f; q = q * t + (-0.142248368f); q = q * t + 0.127414796f; q = q * t;
    const f32x2 s = (v * v) * (-0.72134752044f);
    f32x2 e; e.x = __builtin_amdgcn_exp2f(s.x); e.y = __builtin_amdgcn_exp2f(s.y);
    const f32x2 m = v * (q * e), r = v - m;
    f32x2 o; o.x = v.x < 0.f ? m.x : r.x; o.y = v.y < 0.f ? m.y : r.y; return o;
}

template <int ACT  > struct EpiBf16 {
    static constexpr bool PERM = true, AFTER_DRAIN = false; static_assert(ACT == 0 || ACT == 1, "EpiBf16: ACT is 0 (none) or 1 (gelu_pk)");
    bf16_t* O; int ldc; const float* bias; int split_cols; size_t split_stride; float scale0;
    __device__ __forceinline__ void operator()(const f32x4 (&acc)[2][2][4][2], const Unit& u, int wr, int wc, int fr, int fq) const {
        const int row0 = u.pm * BM + wr * 64 + fr; int colt = u.pn * BM; bf16_t* base = O;
        float sc = 1.f; if (split_cols) { const int t = colt / split_cols; base += (size_t)t * split_stride; colt -= t * split_cols; if (t == 0) sc = scale0; }
        const int col0 = colt + wc * 32 + 8 * fq, bcol0 = u.pn * BM + wc * 32 + 8 * fq;
        f32x4 bv[2][2];
#pragma unroll
        for (int bj = 0; bj < 2; ++bj)
#pragma unroll
            for (int n = 0; n < 2; ++n) bv[bj][n] = bias ? *(const f32x4*)(bias + bcol0 + bj * HALF + 4 * n) : (f32x4){0.f, 0.f, 0.f, 0.f};
#pragma unroll
        for (int ai = 0; ai < 2; ++ai)
#pragma unroll
            for (int m = 0; m < 4; ++m) { bf16_t* rowp = base + (size_t)(row0 + ai * HALF + m * 16) * ldc + col0;
#pragma unroll
                for (int bj = 0; bj < 2; ++bj) { f32x4 v0 = acc[ai][bj][m][0] + bv[bj][0], v1 = acc[ai][bj][m][1] + bv[bj][1];
                    if (ACT == 1) { f32x2 a = gelu_pk((f32x2){v0[0], v0[1]}), b = gelu_pk((f32x2){v0[2], v0[3]}), c = gelu_pk((f32x2){v1[0], v1[1]}), d = gelu_pk((f32x2){v1[2], v1[3]});
                        v0 = (f32x4){a.x, a.y, b.x, b.y}; v1 = (f32x4){c.x, c.y, d.x, d.y}; }
                    v0 = v0 * sc; v1 = v1 * sc; u32x4 w; w.x = cvt_pk_bf16(v0[0], v0[1]); w.y = cvt_pk_bf16(v0[2], v0[3]); w.z = cvt_pk_bf16(v1[0], v1[1]); w.w = cvt_pk_bf16(v1[2], v1[3]);
                    *(u32x4*)(rowp + bj * HALF) = w; } }
    }
};
struct EpiResid {
    static constexpr bool PERM = false, AFTER_DRAIN = false;
    const float* x; float* out; float* sspart; int ldc;
    __device__ __forceinline__ void operator()(const f32x4 (&acc)[2][2][4][2], const Unit& u, int wr, int wc, int fr, int fq) const {
        const int row0 = u.pm * BM + wr * 64 + fr, col0 = u.pn * BM + wc * 32 + 4 * fq;
#pragma unroll
        for (int ai = 0; ai < 2; ++ai)
#pragma unroll
            for (int m = 0; m < 4; ++m) {
                const int row = row0 + ai * HALF + m * 16; float ss = 0.f;
#pragma unroll
                for (int bj = 0; bj < 2; ++bj)
#pragma unroll
                    for (int n = 0; n < 2; ++n) {
                        const size_t off = (size_t)row * ldc + col0 + bj * HALF + n * 16;
                        const f32x4 xv = *(const f32x4*)(x + off); const f32x4 v = acc[ai][bj][m][n] + xv;
                        *(f32x4*)(out + off) = v; ss += (v[0] * v[0] + v[1] * v[1]) + (v[2] * v[2] + v[3] * v[3]);
                    }
                ss += __shfl_xor(ss, 16); ss += __shfl_xor(ss, 32);
                if (fq == 0) sspart[(size_t)row * 32 + u.pn * 4 + wc] = ss;
            }
    }
};

struct OneTile {
    int pm, pn;
    __host__ __device__ bool next(int i, Unit& u) const { if (i != 0) return false; u.pm = pm; u.pn = pn; return true; }
    __device__ __forceinline__ void a_ready(const Unit&) const {}
    __device__ __forceinline__ void done(const Unit&) const {}
};
struct EpiResidNorm {
    static constexpr bool PERM = false, AFTER_DRAIN = true;
    const float* x; float* out; float* ssp; unsigned* cnt; const float* gain; int ldc; float eps;
    __device__ __forceinline__ void fused(f32x4 (&acc)[2][2][4][2], const Unit& u, int wr, int wc, int fr, int fq, PG8_LAS unsigned char* lds, int wid, int lane) const {
        const int row0 = u.pm * BM + wr * 64 + fr, col0 = u.pn * BM + wc * 32 + 4 * fq;
#pragma unroll
        for (int ai = 0; ai < 2; ++ai) {
            f32x4 xv[4][2][2];
#pragma unroll
            for (int m = 0; m < 4; ++m)
#pragma unroll
                for (int bj = 0; bj < 2; ++bj)
#pragma unroll
                    for (int n = 0; n < 2; ++n) xv[m][bj][n] = *(const f32x4*)(x + (size_t)(row0 + ai * HALF + m * 16) * ldc + col0 + bj * HALF + n * 16);
#pragma unroll
            for (int m = 0; m < 4; ++m) {
                const int row = row0 + ai * HALF + m * 16; float ss = 0.f;
#pragma unroll
                for (int bj = 0; bj < 2; ++bj)
#pragma unroll
                    for (int n = 0; n < 2; ++n) {
                        const f32x4 v = acc[ai][bj][m][n] + xv[m][bj][n];
                        acc[ai][bj][m][n] = v; ss += (v[0] * v[0] + v[1] * v[1]) + (v[2] * v[2] + v[3] * v[3]);
                    }
                ss += __shfl_xor(ss, 16); ss += __shfl_xor(ss, 32);
                if (fq == 0) __hip_atomic_store(ssp + (size_t)row * 32 + u.pn * 4 + wc, ss, __ATOMIC_RELAXED, __HIP_MEMORY_SCOPE_AGENT);
            }
        }
        asm volatile("s_waitcnt vmcnt(0)" ::: "memory");
        __syncthreads();
        unsigned* c = cnt + 64 * u.pm;
        if (threadIdx.x == 0) {
            __hip_atomic_fetch_add(c, 1u, __ATOMIC_RELEASE, __HIP_MEMORY_SCOPE_AGENT);
            unsigned spins = 0;
            while (__hip_atomic_load(c, __ATOMIC_RELAXED, __HIP_MEMORY_SCOPE_AGENT) < 8u) { __builtin_amdgcn_s_sleep(2); if (++spins > (1u << 22)) break; }
            __builtin_amdgcn_fence(__ATOMIC_ACQUIRE, "agent");
        }
        __syncthreads();
        PG8_LAS float* S = (PG8_LAS float*)lds;
        if (threadIdx.x < 256) {
            const float* p = ssp + (size_t)(u.pm * BM + threadIdx.x) * 32; float s = 0.f;
#pragma unroll
            for (int i = 0; i < 32; ++i) s += __hip_atomic_load(p + i, __ATOMIC_RELAXED, __HIP_MEMORY_SCOPE_AGENT);
            S[threadIdx.x] = 1.0f / sqrtf(s * (1.0f / 2048.0f) + eps);
        }
        __syncthreads();
#pragma unroll
        for (int bj = 0; bj < 2; ++bj)
#pragma unroll
            for (int n = 0; n < 2; ++n) {
                const f32x4 g = *(const f32x4*)(gain + col0 + bj * HALF + n * 16);
#pragma unroll
                for (int ai = 0; ai < 2; ++ai)
#pragma unroll
                    for (int m = 0; m < 4; ++m) {
                        const int lr = wr * 64 + fr + ai * HALF + m * 16; const float rs = S[lr];
                        f32x4 v = acc[ai][bj][m][n]; v[0] *= rs * g[0]; v[1] *= rs * g[1]; v[2] *= rs * g[2]; v[3] *= rs * g[3];
                        *(f32x4*)(out + (size_t)(u.pm * BM + lr) * ldc + col0 + bj * HALF + n * 16) = v;
                    }
            }
    }
};

template <class Epi, class Sched, bool ALIGN_EPI = false, bool SP2 = false>
__device__ __forceinline__ void gemm_phase(PG8_LAS unsigned char* lds, const Gemm g, const Sched& S, const Epi& E) {
    const int tid = threadIdx.x, wid = __builtin_amdgcn_readfirstlane(tid >> 6), lane = tid & 63, wr = wid >> 2, wc = wid & 3, fr = lane & 15, fq = lane >> 4;
    const int K = g.K, nt = K / BK;
    unsigned voffA[2], voffB[2];
#pragma unroll
    for (int i = 0; i < 2; ++i) { int R, C; stage_rc(tid * 16 + i * 8192, R, C); const int Rb = Epi::PERM ? ((R & ~31) + perm32(R & 31)) : R;
        voffA[i] = (unsigned)(R * K + C) * 2u; voffB[i] = (unsigned)(Rb * K + C) * 2u; }
    const size_t kstep = (size_t)(BK * 2);
    const size_t hstep = (size_t)HALF * K * 2;
    const size_t tstep = 2 * hstep;
    const unsigned ldsw = (unsigned)wid * 1024u;
    const int aoff = lds_byte(wr * 64 + fr, fq * 8), boff = lds_byte(wc * 32 + fr, fq * 8);
#define PG8_SA(b, h) (((b) * 2 + (h)) * HTB)
#define PG8_SB(b, h) ((4 + (b) * 2 + (h)) * HTB)
#define PG8_STAGE(bufoff, gbase, voff) do { _Pragma("unroll") for (int _i = 0; _i < 2; ++_i) \
        __builtin_amdgcn_global_load_lds((const unsigned*)((const char*)(gbase) + (voff)[_i]), (PG8_LAS unsigned*)(lds + (bufoff) + ldsw + _i * 8192), 16, 0, 0); } while (0)
#define PG8_LDA(dst, b, h) do { _Pragma("unroll") for (int m = 0; m < 4; ++m) _Pragma("unroll") for (int k = 0; k < 2; ++k) dst[m][k] = *(const PG8_LAS bf16x8*)(lds + PG8_SA(b, h) + aoff + m * 2048 + k * 1024); } while (0)
#define PG8_LDB(dst, b, h) do { _Pragma("unroll") for (int n = 0; n < 2; ++n) _Pragma("unroll") for (int k = 0; k < 2; ++k) dst[n][k] = *(const PG8_LAS bf16x8*)(lds + PG8_SB(b, h) + boff + n * 2048 + k * 1024); } while (0)
#define PG8_MMA(ai, bj, At, Bt) do { __builtin_amdgcn_s_setprio(1); _Pragma("unroll") for (int m = 0; m < 4; ++m) _Pragma("unroll") for (int n = 0; n < 2; ++n) _Pragma("unroll") for (int k = 0; k < 2; ++k) \
        acc[ai][bj][m][n] = __builtin_amdgcn_mfma_f32_16x16x32_bf16(Bt[n][k], At[m][k], acc[ai][bj][m][n], 0, 0, 0); __builtin_amdgcn_s_setprio(0); } while (0)
#define PG8_WAIT_V(n) asm volatile("s_waitcnt vmcnt(" #n ")" ::: "memory")
#define PG8_WAIT_L(n) asm volatile("s_waitcnt lgkmcnt(" #n ")" ::: "memory")
#define PG8_BAR __builtin_amdgcn_s_barrier()
#define PG8_SCHED __builtin_amdgcn_sched_barrier(0)
    Unit cur, nxt; int ui = 0;
    if (!S.next(0, cur)) return;
    f32x4 acc[2][2][4][2];
#pragma unroll
    for (int a = 0; a < 2; ++a)
#pragma unroll
        for (int b = 0; b < 2; ++b)
#pragma unroll
            for (int m = 0; m < 4; ++m)
#pragma unroll
                for (int n = 0; n < 2; ++n) acc[a][b][m][n] = (f32x4){0.f, 0.f, 0.f, 0.f};
    bf16x8 At[4][2], B0[2][2], B1[2][2];
    const char* cA = (const char*)g.A + (size_t)cur.pm * tstep; const char* cB = (const char*)g.Bt + (size_t)cur.pn * tstep;
    S.a_ready(cur);
    if constexpr (SP2) {
        PG8_STAGE(PG8_SB(0, 0), cB, voffB); PG8_STAGE(PG8_SB(0, 1), cB + hstep, voffB); PG8_STAGE(PG8_SA(0, 0), cA, voffA); PG8_STAGE(PG8_SA(0, 1), cA + hstep, voffA);
        if (wr == 1) PG8_BAR;
        PG8_WAIT_V(2); PG8_BAR;
        PG8_STAGE(PG8_SB(1, 0), cB + kstep, voffB); PG8_STAGE(PG8_SA(1, 0), cA + kstep, voffA); PG8_STAGE(PG8_SB(1, 1), cB + hstep + kstep, voffB);
        PG8_WAIT_V(6); PG8_BAR;
    } else {
        PG8_STAGE(PG8_SB(0, 0), cB, voffB); PG8_STAGE(PG8_SA(0, 0), cA, voffA); PG8_STAGE(PG8_SB(0, 1), cB + hstep, voffB); PG8_STAGE(PG8_SA(0, 1), cA + hstep, voffA);
        if (wr == 1) PG8_BAR;
        PG8_WAIT_V(4); PG8_BAR;
        PG8_STAGE(PG8_SB(1, 0), cB + kstep, voffB); PG8_STAGE(PG8_SA(1, 0), cA + kstep, voffA); PG8_STAGE(PG8_SB(1, 1), cB + hstep + kstep, voffB);
        PG8_WAIT_V(6); PG8_BAR;
    }
    for (;;) {
        const bool has_next = S.next(ui + 1, nxt);
        const char* nA = has_next ? (const char*)g.A + (size_t)nxt.pm * tstep : cA; const char* nB = has_next ? (const char*)g.Bt + (size_t)nxt.pn * tstep : cB;
        for (int t = 0; t < nt; t += 2) {
            const bool last = (t == nt - 2);
            const char* a1 = cA + (size_t)(t + 1) * kstep;
            const char* a2 = last ? nA : cA + (size_t)(t + 2) * kstep; const char* b2 = last ? nB : cB + (size_t)(t + 2) * kstep;
            const char* a3 = a2 + kstep; const char* b3 = b2 + kstep;
            if (last && has_next) S.a_ready(nxt);
            if constexpr (SP2) {
            PG8_LDB(B0, 0, 0); PG8_LDB(B1, 0, 1); PG8_SCHED; PG8_LDA(At, 0, 0); PG8_STAGE(PG8_SA(1, 1), a1 + hstep, voffA);
            PG8_WAIT_V(8); PG8_WAIT_L(0); PG8_BAR; PG8_MMA(0, 0, At, B0); PG8_MMA(0, 1, At, B1); PG8_BAR; PG8_SCHED;
            PG8_LDA(At, 0, 1); PG8_STAGE(PG8_SB(0, 0), b2, voffB); PG8_STAGE(PG8_SB(0, 1), b2 + hstep, voffB); PG8_STAGE(PG8_SA(0, 0), a2, voffA);
            PG8_WAIT_V(8); PG8_WAIT_L(0); PG8_BAR; PG8_MMA(1, 0, At, B0); PG8_MMA(1, 1, At, B1); PG8_BAR; PG8_SCHED;
            PG8_LDB(B0, 1, 0); PG8_LDB(B1, 1, 1); PG8_SCHED; PG8_LDA(At, 1, 0); PG8_STAGE(PG8_SA(0, 1), a2 + hstep, voffA);
            PG8_WAIT_V(8); PG8_WAIT_L(0); PG8_BAR; PG8_MMA(0, 0, At, B0); PG8_MMA(0, 1, At, B1); PG8_BAR; PG8_SCHED;
            PG8_LDA(At, 1, 1); PG8_STAGE(PG8_SB(1, 0), b3, voffB); PG8_STAGE(PG8_SB(1, 1), b3 + hstep, voffB); PG8_STAGE(PG8_SA(1, 0), a3, voffA);
            PG8_WAIT_V(8); PG8_WAIT_L(0); PG8_BAR; PG8_MMA(1, 0, At, B0); PG8_MMA(1, 1, At, B1); PG8_BAR; PG8_SCHED;
            } else {
            PG8_LDB(B0, 0, 0); PG8_SCHED; PG8_LDA(At, 0, 0); PG8_STAGE(PG8_SA(1, 1), a1 + hstep, voffA);
            PG8_WAIT_L(8); PG8_BAR; PG8_WAIT_L(0); PG8_MMA(0, 0, At, B0); PG8_BAR; PG8_SCHED;
            PG8_LDB(B1, 0, 1); PG8_STAGE(PG8_SB(0, 0), b2, voffB);
            PG8_BAR; PG8_WAIT_L(0); PG8_MMA(0, 1, At, B1); PG8_BAR;
            PG8_LDA(At, 0, 1); PG8_STAGE(PG8_SA(0, 0), a2, voffA);
            PG8_BAR; PG8_WAIT_L(0); PG8_MMA(1, 0, At, B0); PG8_BAR; PG8_SCHED;
            PG8_STAGE(PG8_SB(0, 1), b2 + hstep, voffB);
            PG8_WAIT_V(6); PG8_BAR; PG8_MMA(1, 1, At, B1); PG8_BAR;
            PG8_LDB(B0, 1, 0); PG8_SCHED; PG8_LDA(At, 1, 0); PG8_STAGE(PG8_SA(0, 1), a2 + hstep, voffA);
            PG8_WAIT_L(8); PG8_BAR; PG8_WAIT_L(0); PG8_MMA(0, 0, At, B0); PG8_BAR; PG8_SCHED;
            PG8_LDB(B1, 1, 1); PG8_STAGE(PG8_SB(1, 0), b3, voffB);
            PG8_BAR; PG8_WAIT_L(0); PG8_MMA(0, 1, At, B1); PG8_BAR;
            PG8_LDA(At, 1, 1); PG8_STAGE(PG8_SA(1, 0), a3, voffA);
            PG8_BAR; PG8_WAIT_L(0); PG8_MMA(1, 0, At, B0); PG8_BAR; PG8_SCHED;
            PG8_STAGE(PG8_SB(1, 1), b3 + hstep, voffB);
            PG8_WAIT_V(6); PG8_BAR; PG8_MMA(1, 1, At, B1); PG8_BAR;
            }
        }
        if constexpr (ALIGN_EPI) { if (wr == 0) PG8_BAR; }
        if constexpr (!Epi::AFTER_DRAIN) { E(acc, cur, wr, wc, fr, fq); S.done(cur); }
        if (!has_next) break;
#pragma unroll
        for (int a = 0; a < 2; ++a)
#pragma unroll
            for (int b = 0; b < 2; ++b)
#pragma unroll
                for (int m = 0; m < 4; ++m)
#pragma unroll
                    for (int n = 0; n < 2; ++n) acc[a][b][m][n] = (f32x4){0.f, 0.f, 0.f, 0.f};
        cur = nxt; cA = nA; cB = nB; ++ui;
        if constexpr (ALIGN_EPI) { if (wr == 1) PG8_BAR; }
    }
    PG8_WAIT_V(0);
    if constexpr (!ALIGN_EPI) { if (wr == 0) PG8_BAR; }
    PG8_BAR;
    if constexpr (Epi::AFTER_DRAIN) { E.fused(acc, cur, wr, wc, fr, fq, lds, wid, lane); S.done(cur); }
#undef PG8_SA
#undef PG8_SB
#undef PG8_STAGE
#undef PG8_LDA
#undef PG8_LDB
#undef PG8_MMA
#undef PG8_WAIT_V
#undef PG8_WAIT_L
#undef PG8_BAR
#undef PG8_SCHED
}
}
constexpr int T = 8192, D = 2048, NIN = 6528, NINP = 6656, RW = 1024, NH = 16, HD = 64, CH = 64, NCH = T / CH;
constexpr int C_R = 0, C_K = 1024, C_V = 2048, C_WD = 3072, C_AD = 3136, C_G = 3200, C_AQ = 4224, C_AK = 5248, C_AV = 5376, C_AG = 5504;
constexpr float RMS_EPS = 1e-5f, LNX_EPS = 64e-5f;
constexpr int NWAVES = 8, NTHR = 512;
constexpr size_t MiB = 1u << 20;
constexpr size_t WS_WTIN = 1 * MiB;
constexpr size_t WS_XN = 27 * MiB;
constexpr size_t WS_WTOUT = 59 * MiB;
constexpr size_t WS_UPT = 67 * MiB;
constexpr size_t WS_SSP = 68 * MiB;
constexpr size_t WS_PROJ = 70 * MiB;
constexpr size_t WS_SCR = 174 * MiB;
constexpr size_t WS_MIX = 223 * MiB;
constexpr size_t WS_P32 = 223 * MiB;
constexpr int LDS_BYTES = 163840;

#define GAS __attribute__((address_space(1)))
#define LAS __attribute__((address_space(3)))
typedef unsigned short bf16;
typedef unsigned v4u __attribute__((ext_vector_type(4)));
typedef unsigned v2u __attribute__((ext_vector_type(2)));
typedef float f32x4 __attribute__((ext_vector_type(4)));
typedef float f32x16 __attribute__((ext_vector_type(16)));
typedef short bf16x8 __attribute__((ext_vector_type(8)));
typedef __bf16 bf16x2_t __attribute__((ext_vector_type(2)));
__device__ __forceinline__ unsigned pk2(float a, float b) { bf16x2_t v; v[0] = (__bf16)a; v[1] = (__bf16)b; return __builtin_bit_cast(unsigned, v); }
__device__ __forceinline__ float bflo(unsigned u) { return __uint_as_float(u << 16); }
__device__ __forceinline__ float bfhi(unsigned u) { return __uint_as_float(u & 0xffff0000u); }
__device__ __forceinline__ void unpack8(const v4u& p, float (&f)[8]) { f[0] = bflo(p.x); f[1] = bfhi(p.x); f[2] = bflo(p.y); f[3] = bfhi(p.y); f[4] = bflo(p.z); f[5] = bfhi(p.z); f[6] = bflo(p.w); f[7] = bfhi(p.w); }
__device__ __forceinline__ v4u pack8(const float (&f)[8]) { v4u o; o.x = pk2(f[0], f[1]); o.y = pk2(f[2], f[3]); o.z = pk2(f[4], f[5]); o.w = pk2(f[6], f[7]); return o; }
__device__ __forceinline__ float wave_sum(float v) {
#pragma unroll
    for (int o = 1; o < 64; o <<= 1) v += __shfl_xor(v, o);
    return v;
}
__device__ __forceinline__ float sum8(float v) { v += __shfl_xor(v, 1); v += __shfl_xor(v, 2); v += __shfl_xor(v, 4); return v; }
__device__ __forceinline__ float sigmoidf_(float x) { return 1.f / (1.f + __expf(-x)); }
__device__ __forceinline__ float siluf_(float x) { return x / (1.f + __expf(-x)); }

__device__ __forceinline__ void bar_lds() { asm volatile("s_waitcnt lgkmcnt(0)" ::: "memory"); __builtin_amdgcn_s_barrier(); asm volatile("" ::: "memory"); }
struct Args { const float* in[16]; float* out; unsigned char* ws; int ph_lo, ph_hi; };

struct TItem { const float* W; bf16* WT; int K, N, k0, n0; };
__device__ __forceinline__ bool p0_item(const Args& a, int it, TItem& o) {
    constexpr int I_IN = (D / 64) * (NIN / 32), I_OUT = (D / 64) * (D / 32), I_UP = RW / 32;
    bf16* wtin = (bf16*)(a.ws + WS_WTIN); bf16* wtout = (bf16*)(a.ws + WS_WTOUT); bf16* upt = (bf16*)(a.ws + WS_UPT); bf16* aupt = upt + 65536;
    int r = it;
    if (r < 0) { r += I_OUT; if (r < 0) return false; o.W = a.in[14]; o.WT = wtout; o.K = D; o.N = D; }
    else if (r < I_IN) { o.W = a.in[2]; o.WT = wtin; o.K = D; o.N = NIN; }
    else if ((r -= I_IN) < I_UP) { o.W = a.in[5]; o.WT = upt; o.K = 64; o.N = RW; }
    else if ((r -= I_UP) < I_UP) { o.W = a.in[7]; o.WT = aupt; o.K = 64; o.N = RW; }
    else return false;
    const int nblk = o.N / 32; o.k0 = 64 * (r / nblk); o.n0 = 32 * (r % nblk); return true;
}
__device__ __forceinline__ void p0_ld(const TItem& t, int lane, f32x4 (&v)[8]) {
#pragma unroll
    for (int i = 0; i < 8; ++i) v[i] = *(const f32x4*)(t.W + (size_t)(t.k0 + 8 * i + (lane >> 3)) * t.N + t.n0 + 4 * (lane & 7));
}
__device__ __forceinline__ void p0_st(const TItem& t, int lane, const f32x4 (&v)[8], LAS float* scr) {
#pragma unroll
    for (int i = 0; i < 8; ++i) { LAS float* d = scr + (8 * i + (lane >> 3)) * 33 + 4 * (lane & 7); d[0] = v[i].x; d[1] = v[i].y; d[2] = v[i].z; d[3] = v[i].w; }
    asm volatile("s_waitcnt lgkmcnt(0)" ::: "memory");
    const int c = lane & 7;
#pragma unroll
    for (int j = 0; j < 4; ++j) { const int n = (lane >> 3) + 8 * j; const LAS float* s = scr + (8 * c) * 33 + n;
        v4u o; o.x = pk2(s[0 * 33], s[1 * 33]); o.y = pk2(s[2 * 33], s[3 * 33]); o.z = pk2(s[4 * 33], s[5 * 33]); o.w = pk2(s[6 * 33], s[7 * 33]);
        *(v4u*)(t.WT + (size_t)(t.n0 + n) * t.K + t.k0 + 8 * c) = o; }
    asm volatile("s_waitcnt lgkmcnt(0)" ::: "memory");
}
__device__ __forceinline__ void wout_transposes(const Args& a, LAS unsigned char* lds, int gw, int NGW, int wave, int lane) {
    LAS float* scr = (LAS float*)(lds + wave * 16384);
    constexpr int I_OUT = (D / 64) * (D / 32);
    for (int it = gw - I_OUT; it < 0; it += NGW) { TItem t0; f32x4 v0[8]; if (!p0_item(a, it, t0)) break; p0_ld(t0, lane, v0); p0_st(t0, lane, v0, scr); }
}
__device__ __forceinline__ void p0_prologue(const Args& a, LAS unsigned char* lds, int vcu, int G, int wave, int lane) {
    LAS float* scr = (LAS float*)(lds + wave * 16384);
    const int gw = vcu * NWAVES + wave, NGW = G * NWAVES;
    bf16* wtin = (bf16*)(a.ws + WS_WTIN);
#ifdef PROBE_P0X
    for (int rep_ = 0; rep_ < 2; ++rep_)
#endif
    for (int it = gw; ; it += 2 * NGW) {
        TItem t0, t1; f32x4 v0[8], v1[8];
        const bool h0 = p0_item(a, it, t0), h1 = p0_item(a, it + NGW, t1);
        if (!h0) break;
        p0_ld(t0, lane, v0); if (h1) p0_ld(t1, lane, v1);
        p0_st(t0, lane, v0, scr); if (h1) p0_st(t1, lane, v1, scr);
    }
    wout_transposes(a, lds, gw, NGW, wave, lane);
    { v4u z = {0u, 0u, 0u, 0u}; v4u* p = (v4u*)(wtin + (size_t)NIN * D); const int n16 = (NINP - NIN) * D * 2 / 16;
      for (int i = gw * 64 + lane; i < n16; i += NGW * 64) p[i] = z; }
    const float* gain = a.in[1];
#ifdef PROBE_P0R
    for (int rep_ = 0; rep_ < 2; ++rep_)
#endif
    for (int m = gw; m < T; m += 2 * NGW) {
        const int m2 = m + NGW;
        const f32x4* xr = (const f32x4*)(a.in[0] + (size_t)m * D) + lane; const f32x4* xr2 = (const f32x4*)(a.in[0] + (size_t)(m2 < T ? m2 : m) * D) + lane;
        f32x4 v[8], u[8]; float s = 0.f, s2 = 0.f;
#pragma unroll
        for (int j = 0; j < 8; ++j) { v[j] = xr[64 * j]; u[j] = xr2[64 * j]; }
#pragma unroll
        for (int j = 0; j < 8; ++j) { s += (v[j].x * v[j].x + v[j].y * v[j].y) + (v[j].z * v[j].z + v[j].w * v[j].w); s2 += (u[j].x * u[j].x + u[j].y * u[j].y) + (u[j].z * u[j].z + u[j].w * u[j].w); }
        const float rstd = 1.f / sqrtf(wave_sum(s) * (1.f / D) + RMS_EPS), rstd2 = 1.f / sqrtf(wave_sum(s2) * (1.f / D) + RMS_EPS);
        v2u* o8 = (v2u*)((bf16*)(a.ws + WS_XN) + (size_t)m * D) + lane; v2u* o82 = (v2u*)((bf16*)(a.ws + WS_XN) + (size_t)m2 * D) + lane;
#pragma unroll
        for (int j = 0; j < 8; ++j) { const f32x4 g = *((const f32x4*)gain + lane + 64 * j); v2u o; o.x = pk2(v[j].x * rstd * g.x, v[j].y * rstd * g.y); o.y = pk2(v[j].z * rstd * g.z, v[j].w * rstd * g.w); o8[64 * j] = o;
            if (m2 < T) { o.x = pk2(u[j].x * rstd2 * g.x, u[j].y * rstd2 * g.y); o.y = pk2(u[j].z * rstd2 * g.z, u[j].w * rstd2 * g.w); o82[64 * j] = o; } }
    }
}
__device__ __forceinline__ void final_norm(const Args& a, int vcu, int G, int wave, int lane) {
    const int gw = vcu * NWAVES + wave, NGW = G * NWAVES; const float* ssp = (const float*)(a.ws + WS_SSP); const float* gain = a.in[15];
    for (int m = gw; m < T; m += NGW) {
        float s = (lane < 32) ? ssp[(size_t)m * 32 + lane] : 0.f; s = wave_sum(s);
        const float rstd = 1.f / sqrtf(s * (1.f / D) + RMS_EPS);
        f32x4* xr = (f32x4*)(a.out + (size_t)m * D) + lane;
#pragma unroll
        for (int j = 0; j < 8; ++j) { f32x4 v = xr[64 * j]; const f32x4 g = *((const f32x4*)gain + lane + 64 * j); v.x *= rstd * g.x; v.y *= rstd * g.y; v.z *= rstd * g.z; v.w *= rstd * g.w; xr[64 * j] = v; }
    }
}
#define XB_TMO      128
#define XB_XCNT(j)  (256  + 64 * (j))
#define XB_XSUB(j)  (1280 + 64 * (j))
#define XB_XGEN(j)  (2304 + 64 * (j))
#define XB_TOP      3328
#define XB_TOPGEN   3392
#define XCD_BAR_WORDS 3456
#define XB_SPIN_CAP (1u << 18)

__device__ __forceinline__ unsigned xb_ld(unsigned* p)              { return __hip_atomic_load(p, __ATOMIC_RELAXED, __HIP_MEMORY_SCOPE_AGENT); }
__device__ __forceinline__ unsigned xb_add(unsigned* p, unsigned v) { return __hip_atomic_fetch_add(p, v, __ATOMIC_RELAXED, __HIP_MEMORY_SCOPE_AGENT); }
__device__ __forceinline__ unsigned xb_xcc_id() { return (unsigned)__builtin_amdgcn_s_getreg((3 << 11) | 20) & 0xFu; }
#define XB_SPIN(cond, bar) do { unsigned _sp = 0; while (cond) { __builtin_amdgcn_s_sleep(1); \
    if ((++_sp & 255u) == 0u) { if (xb_ld(&(bar)[XB_TMO])) break; if (_sp > XB_SPIN_CAP) { atomicAdd(&(bar)[XB_TMO], 1u); break; } } } } while (0)

struct XcdBarrier {
    unsigned* bar; unsigned x;
    volatile LAS unsigned* st;
};

__device__ __forceinline__ XcdBarrier xcd_barrier_post(unsigned* bar, volatile LAS unsigned* st) {
    XcdBarrier b; b.bar = bar; b.x = xb_xcc_id(); b.st = st;
    if (threadIdx.x == 0) (void)xb_add(&bar[XB_XCNT(b.x)], 1u);
    return b;
}
__device__ __forceinline__ void xcd_barrier_complete(unsigned* bar, unsigned x, unsigned& nloc, unsigned& nx) {
    const unsigned G = gridDim.x * gridDim.y * gridDim.z;
    unsigned sum, cnt, mine, sp = 0u;
    for (;;) {
        sum = 0u; cnt = 0u; mine = 0u;
#pragma unroll
        for (unsigned j = 0; j < 16; ++j) { const unsigned c = xb_ld(&bar[XB_XCNT(j)]); sum += c; cnt += (c > 0u) ? 1u : 0u; mine = (j == x) ? c : mine; }
        if (sum == G) break;
        __builtin_amdgcn_s_sleep(1);
        if ((++sp & 255u) == 0u) { if (xb_ld(&bar[XB_TMO])) break; if (sp > XB_SPIN_CAP) { atomicAdd(&bar[XB_TMO], 1u); break; } }
    }
    nloc = mine > 0u ? mine : 1u; nx = cnt > 0u ? cnt : 1u;
}

__device__ __forceinline__ void xcd_barrier(const XcdBarrier& b) {
    asm volatile("s_waitcnt vmcnt(0)" ::: "memory");
    __syncthreads();
    if (threadIdx.x == 0) {
        unsigned* bar = b.bar;
        __builtin_amdgcn_s_waitcnt(0);
        unsigned nloc = b.st[0], nx = b.st[1];
        if (nloc == 0u) { xcd_barrier_complete(bar, b.x, nloc, nx); b.st[0] = nloc; b.st[1] = nx; }
        const unsigned old = xb_add(&bar[XB_XSUB(b.x)], 1u);
        const unsigned gen = old / nloc;
        if (old + 1u == (gen + 1u) * nloc) {
            __builtin_amdgcn_fence(__ATOMIC_RELEASE, "agent");
            asm volatile("s_waitcnt vmcnt(0)" ::: "memory");
            const unsigned og = xb_add(&bar[XB_TOP], 1u);
            const unsigned tg = og / nx;
            if (og + 1u == (tg + 1u) * nx) xb_add(&bar[XB_TOPGEN], 1u);
            else XB_SPIN(xb_ld(&bar[XB_TOPGEN]) == tg, bar);
            __builtin_amdgcn_fence(__ATOMIC_ACQUIRE, "agent");
            xb_add(&bar[XB_XGEN(b.x)], 1u);
            asm volatile("s_waitcnt vmcnt(0)" ::: "memory");
        } else {
            XB_SPIN(xb_ld(&bar[XB_XGEN(b.x)]) == gen, bar);
            __builtin_amdgcn_fence(__ATOMIC_ACQUIRE, "agent");
            asm volatile("s_waitcnt vmcnt(0)" ::: "memory");
        }
    }
    __syncthreads();
}

#define MFMA32(a_, b_, c_) __builtin_amdgcn_mfma_f32_32x32x16_bf16((a_), (b_), (c_), 0, 0, 0)
#define MFMA16(a_, b_, c_) __builtin_amdgcn_mfma_f32_16x16x32_bf16((a_), (b_), (c_), 0, 0, 0)
__device__ __forceinline__ v4u ldg16(const bf16* p) { return *(const v4u*)p; }
__device__ __forceinline__ void load_shift8(const bf16* proj, int row, int col, const float* mu, float (&o)[8]) {
    const v4u p = ldg16(proj + (size_t)row * NINP + col); v4u q = {0u, 0u, 0u, 0u};
    if (row > 0) q = ldg16(proj + (size_t)(row - 1) * NINP + col);
    float pf[8], qf[8]; unpack8(p, pf); unpack8(q, qf);
    const f32x4 m0 = *(const f32x4*)(mu + col), m1 = *(const f32x4*)(mu + col + 4);
    const float mf[8] = {m0.x, m0.y, m0.z, m0.w, m1.x, m1.y, m1.z, m1.w};
#pragma unroll
    for (int j = 0; j < 8; ++j) o[j] = pf[j] + (qf[j] - pf[j]) * mf[j];
}
__device__ __forceinline__ void ld8f(const float* p, float (&o)[8]) { const f32x4 a = *(const f32x4*)p, b = *(const f32x4*)(p + 4); o[0] = a.x; o[1] = a.y; o[2] = a.z; o[3] = a.w; o[4] = b.x; o[5] = b.y; o[6] = b.z; o[7] = b.w; }

constexpr int VP = 168;
__device__ __forceinline__ void attn_unit(const Args& a, LAS unsigned char* lds, int unit, int tid, int wave, int lane) {
    const bf16* proj = (const bf16*)(a.ws + WS_PROJ); bf16* mix = (bf16*)(a.ws + WS_MIX);
    const int qb = unit >> 1, kvh = unit & 1, q0 = qb * 32, kbase = q0 - 128, hq = kvh * 8 + wave;
    LAS bf16* VT = (LAS bf16*)lds;
    const int r = lane & 31, h = lane >> 5;
    bf16x8 bq[4];
    { const bf16* qrow = proj + (size_t)(q0 + r) * NINP + C_AQ + hq * 64 + 8 * h;
#pragma unroll
      for (int s = 0; s < 4; ++s) bq[s] = *(const bf16x8*)(qrow + 16 * s); }
    const float slope = exp2f(-0.5f * (float)(hq + 1)), sink = a.in[13][hq];
    f32x16 sc[5]; float mx = sink;
    bf16x8 kf[5][4];
#pragma unroll
    for (int kt = 0; kt < 5; ++kt) { const int tkb = kbase + 32 * kt;
        if (tkb >= 0) { const bf16* krow = proj + (size_t)(tkb + r) * NINP + C_AK + kvh * 64 + 8 * h;
#pragma unroll
            for (int s = 0; s < 4; ++s) kf[kt][s] = *(const bf16x8*)(krow + 16 * s); } }
    v2u gpre[2][4];
#pragma unroll
    for (int dt = 0; dt < 2; ++dt)
#pragma unroll
        for (int g4 = 0; g4 < 4; ++g4) gpre[dt][g4] = *(const v2u*)(proj + (size_t)(q0 + r) * NINP + C_AG + hq * 64 + 32 * dt + 8 * g4 + 4 * h);
    bar_lds();
    for (int idx = tid; idx < 160 * 8; idx += NTHR) {
        const int key = idx >> 3, d8 = (idx & 7) * 8, tk = kbase + key;
        v4u p = {0u, 0u, 0u, 0u};
        if (tk >= 0) p = ldg16(proj + (size_t)tk * NINP + C_AV + kvh * 64 + d8);
        const unsigned w[4] = {p.x, p.y, p.z, p.w};
#pragma unroll
        for (int j = 0; j < 4; ++j) { VT[(d8 + 2 * j) * VP + key] = (bf16)(w[j] & 0xffffu); VT[(d8 + 2 * j + 1) * VP + key] = (bf16)(w[j] >> 16); }
    }
    bar_lds();
    const float L2E = 1.44269504f, SA = 0.125f * L2E, SB = slope * L2E, sinkl = sink * L2E;
    mx = sinkl;
#pragma unroll
    for (int kt = 0; kt < 5; ++kt) {
        const int tkb = kbase + 32 * kt;
        if (tkb >= 0) {
            f32x16 acc; for (int i = 0; i < 16; ++i) acc[i] = 0.f;
#pragma unroll
            for (int s = 0; s < 4; ++s) acc = MFMA32(kf[kt][s], bq[s], acc);
            const int dli = (q0 + r) - tkb - 4 * h; const float base = -SB * (float)dli;
#pragma unroll
            for (int i = 0; i < 16; ++i) {
                const int ci = (i & 3) + 8 * (i >> 2);
                float v = __builtin_fmaf(acc[i], SA, __builtin_fmaf(SB, (float)ci, base));
                if (kt == 0) v = (dli - ci < 128) ? v : -1e30f;
                if (kt == 4) v = (dli - ci >= 0) ? v : -1e30f;
                sc[kt][i] = v; mx = fmaxf(mx, v);
            }
        } else {
#pragma unroll
            for (int i = 0; i < 16; ++i) sc[kt][i] = -1e30f;
        }
    }
    mx = fmaxf(mx, __shfl_xor(mx, 32));
    float sum = 0.f;
#pragma unroll
    for (int kt = 0; kt < 5; ++kt)
#pragma unroll
        for (int i = 0; i < 16; ++i) { const float p = __builtin_amdgcn_exp2f(sc[kt][i] - mx); sc[kt][i] = p; sum += p; }
    sum += __shfl_xor(sum, 32); sum += __builtin_amdgcn_exp2f(sinkl - mx);
    f32x16 o[2]; for (int i = 0; i < 16; ++i) { o[0][i] = 0.f; o[1][i] = 0.f; }
#pragma unroll
    for (int kt = 0; kt < 5; ++kt) {
        if (kbase + 32 * kt >= 0) {
#pragma unroll
            for (int s = 0; s < 2; ++s) {
                v4u pw; pw.x = pk2(sc[kt][8 * s + 0], sc[kt][8 * s + 1]); pw.y = pk2(sc[kt][8 * s + 2], sc[kt][8 * s + 3]); pw.z = pk2(sc[kt][8 * s + 4], sc[kt][8 * s + 5]); pw.w = pk2(sc[kt][8 * s + 6], sc[kt][8 * s + 7]);
                const bf16x8 pb = __builtin_bit_cast(bf16x8, pw);
#pragma unroll
                for (int dt = 0; dt < 2; ++dt) {
                    const LAS bf16* vp = VT + (32 * dt + r) * VP + 32 * kt + 16 * s + 4 * h;
                    const v2u lo = *(const LAS v2u*)vp, hi = *(const LAS v2u*)(vp + 8);
                    v4u vw; vw.x = lo.x; vw.y = lo.y; vw.z = hi.x; vw.w = hi.y;
                    o[dt] = MFMA32(__builtin_bit_cast(bf16x8, vw), pb, o[dt]);
                }
            }
        }
    }
    const float inv = 1.f / sum;
#pragma unroll
    for (int dt = 0; dt < 2; ++dt)
#pragma unroll
        for (int g4 = 0; g4 < 4; ++g4) {
            const int d0 = 32 * dt + 8 * g4 + 4 * h;
            float g0, g1, g2, g3;
            { const v2u gp = gpre[dt][g4]; g0 = bflo(gp.x); g1 = bfhi(gp.x); g2 = bflo(gp.y); g3 = bfhi(gp.y); }
            v2u w; w.x = pk2(o[dt][4 * g4 + 0] * inv * siluf_(g0), o[dt][4 * g4 + 1] * inv * siluf_(g1));
            w.y = pk2(o[dt][4 * g4 + 2] * inv * siluf_(g2), o[dt][4 * g4 + 3] * inv * siluf_(g3));
            *(v2u*)(mix + (size_t)(q0 + r) * D + RW + hq * 64 + d0) = w;
        }
}

struct Prep { float r[8], kp[8], v[8], g[8], w[8], lw[8], kk[8], b[8], bonus; };
__device__ __forceinline__ void rwkv_prep(const Args& a, LAS unsigned char* lds, int h, int t0, int tid, int wave, int lane, Prep& P) {
    const bf16* proj = (const bf16*)(a.ws + WS_PROJ); const bf16* upt = (const bf16*)(a.ws + WS_UPT); const bf16* aupt = upt + 65536;
    LAS bf16* TW = (LAS bf16*)lds; LAS bf16* ADm = TW + 64 * 72; LAS float* Z = (LAS float*)(lds + 18432); LAS float* AP = Z + 64 * 68;
    const int t = tid >> 3, c8 = (tid & 7) * 8, ch = h * 64 + c8, row = t0 + t;
    const float* mu = a.in[3];
    { float x[8]; load_shift8(proj, row, C_WD + c8, mu, x);
#pragma unroll
      for (int j = 0; j < 8; ++j) x[j] = 1.f - 2.f * __builtin_amdgcn_rcpf(1.f + __expf(2.f * x[j]));
      *(LAS v4u*)(TW + t * 72 + c8) = pack8(x);
      load_shift8(proj, row, C_AD + c8, mu, x); *(LAS v4u*)(ADm + t * 72 + c8) = pack8(x); }
    bar_lds();
    { const int rt = wave & 3, cp = (wave >> 2) * 2, fr = lane & 15, fq = lane >> 4;
      bf16x8 aT[2], aA[2];
#pragma unroll
      for (int s = 0; s < 2; ++s) { aT[s] = *(const LAS bf16x8*)(TW + (16 * rt + fr) * 72 + 32 * s + 8 * fq); aA[s] = *(const LAS bf16x8*)(ADm + (16 * rt + fr) * 72 + 32 * s + 8 * fq); }
#pragma unroll
      for (int ci = 0; ci < 2; ++ci) { const int ct = cp + ci; f32x4 z = {0.f, 0.f, 0.f, 0.f}, ap = {0.f, 0.f, 0.f, 0.f};
#pragma unroll
          for (int s = 0; s < 2; ++s) { const size_t bo = (size_t)(h * 64 + 16 * ct + fr) * 64 + 32 * s + 8 * fq;
              z = MFMA16(aT[s], *(const bf16x8*)(upt + bo), z); ap = MFMA16(aA[s], *(const bf16x8*)(aupt + bo), ap); }
#pragma unroll
          for (int j = 0; j < 4; ++j) { Z[(16 * rt + 4 * fq + j) * 68 + 16 * ct + fr] = z[j]; AP[(16 * rt + 4 * fq + j) * 68 + 16 * ct + fr] = ap[j]; } } }
    bar_lds();
    float zz[8], aa[8], kr[8], c0[8], c1[8];
#pragma unroll
    for (int j = 0; j < 8; ++j) { zz[j] = Z[t * 68 + c8 + j]; aa[j] = AP[t * 68 + c8 + j]; }
    load_shift8(proj, row, C_R + ch, mu, P.r); load_shift8(proj, row, C_K + ch, mu, kr); load_shift8(proj, row, C_V + ch, mu, P.v); load_shift8(proj, row, C_G + ch, mu, P.g);
    ld8f(a.in[4] + ch, c0); ld8f(a.in[6] + ch, c1);
#pragma unroll
    for (int j = 0; j < 8; ++j) { const float z = c0[j] + zz[j]; const float sp = (z < -15.f) ? -z : __logf(1.f + __expf(-z)); const float wl = -sp - 0.5f; P.lw[j] = -__expf(wl); P.w[j] = __expf(P.lw[j]); aa[j] = sigmoidf_(c1[j] + aa[j]); }
    ld8f(a.in[8] + ch, c0); ld8f(a.in[9] + ch, c1);
    float ss = 0.f;
#pragma unroll
    for (int j = 0; j < 8; ++j) { P.kk[j] = kr[j] * c0[j]; ss += P.kk[j] * P.kk[j]; P.kp[j] = kr[j] * (1.f + (aa[j] - 1.f) * c1[j]); }
    ss = sum8(ss); const float rn = 1.f / fmaxf(sqrtf(ss), 1e-12f);
    ld8f(a.in[10] + ch, c0);
    float bs = 0.f;
#pragma unroll
    for (int j = 0; j < 8; ++j) { P.kk[j] *= rn; P.b[j] = P.kk[j] * aa[j]; bs += P.r[j] * P.kp[j] * c0[j]; }
    P.bonus = sum8(bs);
}
__device__ __forceinline__ void rwkv_out8(const Args& a, const float (&y)[8], const float (&v)[8], const float (&g)[8], float bonus, int row, int ch) {
    bf16* mix = (bf16*)(a.ws + WS_MIX);
    float s = 0.f;
#pragma unroll
    for (int j = 0; j < 8; ++j) s += y[j];
    const float mean = sum8(s) * (1.f / 64.f); float q = 0.f;
#pragma unroll
    for (int j = 0; j < 8; ++j) { const float d = y[j] - mean; q += d * d; }
    const float rstd = 1.f / sqrtf(sum8(q) * (1.f / 64.f) + LNX_EPS);
    float lg[8], lb[8], o[8]; ld8f(a.in[11] + ch, lg); ld8f(a.in[12] + ch, lb);
#pragma unroll
    for (int j = 0; j < 8; ++j) { const float yn = (y[j] - mean) * rstd * lg[j] + lb[j] + bonus * v[j]; o[j] = yn * siluf_(g[j]); }
    *(v4u*)(mix + (size_t)row * D + ch) = pack8(o);
}
constexpr size_t WS_MF = 174 * MiB, WS_QF = 190 * MiB, WS_SF = 206 * MiB, WS_BON = 222 * MiB;
constexpr size_t OUT_NF = 0, OUT_Y2 = 32 * MiB;
constexpr int MP = 72;
constexpr int L_AT = 0, L_ATT = 9216, L_BT = 18432, L_KT = 27648, L_RT = 36864, L_BHT = 46080, L_KHT = 55296, L_VT = 64512, L_LW = 73728, L_P = 73728, L_PT = 82944,
              L_AAK = 92160, L_ARB = 101376, L_ARK = 110592, L_TM = 119808, L_SEG = 119808, L_GC = 129024, L_WT = L_AT, L_X1T = L_BT, L_U2T = L_KT;
struct WTile { int ta, tb0, fr, fq; };
__device__ __forceinline__ bf16x8 ldfrag(const LAS bf16* M, int tile, int s, const WTile& w) { return *(const LAS bf16x8*)(M + (16 * tile + w.fr) * MP + 32 * s + 8 * w.fq); }
__device__ __forceinline__ void mm2(const LAS bf16* A, const LAS bf16* B, const WTile& w, f32x4 (&acc)[2]) {
#pragma unroll
    for (int s = 0; s < 2; ++s) { const bf16x8 af = ldfrag(A, w.ta, s, w);
#pragma unroll
        for (int ci = 0; ci < 2; ++ci) acc[ci] = MFMA16(af, ldfrag(B, w.tb0 + ci, s, w), acc[ci]); }
}
__device__ __forceinline__ void st_T(LAS bf16* X, int ta, int tb, const WTile& w, const f32x4& v) { v2u o; o.x = pk2(v[0], v[1]); o.y = pk2(v[2], v[3]); *(LAS v2u*)(X + (16 * tb + w.fr) * MP + 16 * ta + 4 * w.fq) = o; }
__device__ __forceinline__ void st_N(LAS bf16* X, int ta, int tb, const WTile& w, const f32x4& v) {
    const unsigned a = pk2(v[0], v[1]), b = pk2(v[2], v[3]); LAS bf16* p = X + (16 * ta + 4 * w.fq) * MP + 16 * tb + w.fr;
    p[0] = (bf16)(a & 0xffffu); p[MP] = (bf16)(a >> 16); p[2 * MP] = (bf16)(b & 0xffffu); p[3 * MP] = (bf16)(b >> 16);
}
#define ZERO2(x) do { x[0] = (f32x4){0.f, 0.f, 0.f, 0.f}; x[1] = (f32x4){0.f, 0.f, 0.f, 0.f}; } while (0)
template <int MODE> __device__ __forceinline__ void mask2(f32x4 (&acc)[2], const WTile& w) {
#pragma unroll
    for (int ci = 0; ci < 2; ++ci)
#pragma unroll
        for (int j = 0; j < 4; ++j) { const int row = 16 * w.ta + 4 * w.fq + j, col = 16 * (w.tb0 + ci) + w.fr;
            const bool keep = MODE == 0 ? (row < col) : (MODE == 1 ? (row <= col) : (col < row)); if (!keep) acc[ci][j] = 0.f; }
}
__device__ __forceinline__ void st_bf16x8_T2(LAS bf16* X, int c8, int t, int lane, const float (&v)[8]) {
    const v4u p = pack8(v); const unsigned w[4] = {p.x, p.y, p.z, p.w}; const bool odd = (lane >> 3) & 1;
#pragma unroll
    for (int j = 0; j < 4; ++j) {
        const unsigned q = (unsigned)__builtin_amdgcn_update_dpp(0, (int)w[j], 0x128  , 0xf, 0xf, false);
        const unsigned o = odd ? ((q >> 16) | (w[j] & 0xffff0000u)) : ((w[j] & 0xffffu) | (q << 16));
        *(LAS unsigned*)(X + (c8 + 2 * j + (odd ? 1 : 0)) * MP + (t & ~1)) = o;
    }
}
__device__ __forceinline__ void st_bf16x8_T(LAS bf16* X, int c8, int t, const float (&v)[8]) {
    const v4u p = pack8(v); const unsigned w[4] = {p.x, p.y, p.z, p.w};
#pragma unroll
    for (int j = 0; j < 4; ++j) { X[(c8 + 2 * j) * MP + t] = (bf16)(w[j] & 0xffffu); X[(c8 + 2 * j + 1) * MP + t] = (bf16)(w[j] >> 16); }
}

__device__ __forceinline__ void rwkv_chunk_prep(const Args& a, LAS unsigned char* lds, int unit, int tid, int wave, int lane) {
    const int c = unit >> 4, h = unit & 15, t0 = c * CH, t = tid >> 3, c8 = (tid & 7) * 8;
    LAS bf16* At = (LAS bf16*)(lds + L_AT); LAS bf16* AtT = (LAS bf16*)(lds + L_ATT); LAS bf16* Bt = (LAS bf16*)(lds + L_BT); LAS bf16* Kt = (LAS bf16*)(lds + L_KT);
    LAS bf16* Rt = (LAS bf16*)(lds + L_RT); LAS bf16* BhT = (LAS bf16*)(lds + L_BHT); LAS bf16* KhT = (LAS bf16*)(lds + L_KHT); LAS bf16* VT = (LAS bf16*)(lds + L_VT);
    LAS float* LW = (LAS float*)(lds + L_LW); LAS bf16* Pm = (LAS bf16*)(lds + L_P); LAS bf16* PT = (LAS bf16*)(lds + L_PT);
    LAS bf16* AAK = (LAS bf16*)(lds + L_AAK); LAS bf16* ARB = (LAS bf16*)(lds + L_ARB); LAS bf16* ARK = (LAS bf16*)(lds + L_ARK); LAS bf16* TM = (LAS bf16*)(lds + L_TM);
    LAS float* SEG = (LAS float*)(lds + L_SEG); LAS float* GC = (LAS float*)(lds + L_GC);
    LAS bf16* WT = (LAS bf16*)(lds + L_WT); LAS bf16* X1T = (LAS bf16*)(lds + L_X1T); LAS bf16* U2T = (LAS bf16*)(lds + L_U2T);
    bar_lds();
    Prep P; rwkv_prep(a, lds, h, t0, tid, wave, lane, P);
#ifdef PROBE_PREP2
    bar_lds(); rwkv_prep(a, lds, h, t0, tid, wave, lane, P);
#endif
    if ((tid & 7) == 0) ((float*)(a.ws + WS_BON))[(size_t)(t0 + t) * 16 + h] = P.bonus;
#pragma unroll
    for (int j = 0; j < 8; ++j) LW[t * 68 + c8 + j] = P.lw[j];
    bar_lds();
    { const int cc = tid & 63, sg = tid >> 6; float run = 0.f;
#pragma unroll
      for (int i = 0; i < 8; ++i) { run += LW[(8 * sg + i) * 68 + cc]; LW[(8 * sg + i) * 68 + cc] = run; }
      SEG[sg * 64 + cc] = run; }
    bar_lds();
    {
        float Lt[8], LC[8];
#pragma unroll
        for (int j = 0; j < 8; ++j) { float off = 0.f, tot = 0.f;
#pragma unroll
            for (int s = 0; s < 8; ++s) { const float sv = SEG[s * 64 + c8 + j]; tot += sv; if (s < (t >> 3)) off += sv; }
            Lt[j] = LW[t * 68 + c8 + j] + off; LC[j] = tot; }
        if (t == 0) {
#pragma unroll
            for (int j = 0; j < 8; ++j) GC[c8 + j] = __expf(LC[j]); }
        float x[8], y[8];
#pragma unroll
        for (int j = 0; j < 8; ++j) x[j] = -P.kk[j] * __expf(Lt[j] - P.lw[j]);
        *(LAS v4u*)(At + t * MP + c8) = pack8(x); st_bf16x8_T(AtT, c8, t, x);
#pragma unroll
        for (int j = 0; j < 8; ++j) { const float e = __expf(-Lt[j]); x[j] = P.b[j] * e; y[j] = P.kp[j] * e; }
        *(LAS v4u*)(Bt + t * MP + c8) = pack8(x); *(LAS v4u*)(Kt + t * MP + c8) = pack8(y);
#pragma unroll
        for (int j = 0; j < 8; ++j) x[j] = P.r[j] * __expf(Lt[j]);
        *(LAS v4u*)(Rt + t * MP + c8) = pack8(x);
#pragma unroll
        for (int j = 0; j < 8; ++j) { const float e = __expf(LC[j] - Lt[j]); x[j] = P.b[j] * e; y[j] = P.kp[j] * e; }
        st_bf16x8_T(BhT, c8, t, x); st_bf16x8_T(KhT, c8, t, y); st_bf16x8_T(VT, c8, t, P.v);
    }
    bar_lds();
    WTile w; w.ta = wave & 3; w.tb0 = (wave >> 2) * 2; w.fr = lane & 15; w.fq = lane >> 4;
    f32x4 acc[2], Tacc[2];
    ZERO2(Tacc); mm2(At, Bt, w, Tacc); mask2<2>(Tacc, w);
    ZERO2(acc); mm2(Kt, At, w, acc); mask2<0>(acc, w);
    f32x4 rb[2], rk[2]; ZERO2(rb); mm2(Bt, Rt, w, rb); mask2<1>(rb, w); ZERO2(rk); mm2(Kt, Rt, w, rk); mask2<1>(rk, w);
    bar_lds();
#pragma unroll
    for (int ci = 0; ci < 2; ++ci) { st_N(Pm, w.ta, w.tb0 + ci, w, Tacc[ci]); st_T(PT, w.ta, w.tb0 + ci, w, Tacc[ci]);
        st_T(AAK, w.ta, w.tb0 + ci, w, acc[ci]); st_T(ARB, w.ta, w.tb0 + ci, w, rb[ci]); st_T(ARK, w.ta, w.tb0 + ci, w, rk[ci]);
#pragma unroll
        for (int j = 0; j < 4; ++j) if (16 * w.ta + 4 * w.fq + j == 16 * (w.tb0 + ci) + w.fr) Tacc[ci][j] += 1.f;
        st_N(TM, w.ta, w.tb0 + ci, w, Tacc[ci]); }
    bar_lds();
#pragma unroll 1
#ifdef PROBE_NEU2
    for (int n = 0; n < 10; ++n) {
#else
    for (int n = 0; n < 5; ++n) {
#endif
        ZERO2(acc); mm2(Pm, PT, w, acc);
        bar_lds();
#pragma unroll
        for (int ci = 0; ci < 2; ++ci) { st_N(Pm, w.ta, w.tb0 + ci, w, acc[ci]); st_T(PT, w.ta, w.tb0 + ci, w, acc[ci]); }
        bar_lds();
        mm2(TM, PT, w, Tacc);
        bar_lds();
#pragma unroll
        for (int ci = 0; ci < 2; ++ci) st_N(TM, w.ta, w.tb0 + ci, w, Tacc[ci]);
        bar_lds();
    }
    ZERO2(acc); mm2(TM, AtT, w, acc); ZERO2(rb); mm2(AAK, VT, w, rb);
#pragma unroll
    for (int ci = 0; ci < 2; ++ci) { st_T(WT, w.ta, w.tb0 + ci, w, acc[ci]); st_T(X1T, w.ta, w.tb0 + ci, w, rb[ci]); }
    bar_lds();
    const size_t ub = (size_t)unit * 4096;
    { ZERO2(acc); mm2(TM, X1T, w, acc);
#pragma unroll
      for (int ci = 0; ci < 2; ++ci) st_T(U2T, w.ta, w.tb0 + ci, w, acc[ci]);
      bf16* MF = (bf16*)(a.ws + WS_MF) + ub; bf16* QF = (bf16*)(a.ws + WS_QF) + ub;
      ZERO2(acc); mm2(WT, BhT, w, acc);
      ZERO2(rb); mm2(WT, ARB, w, rb);
#pragma unroll
      for (int ci = 0; ci < 2; ++ci) { const int tb = w.tb0 + ci; const int col = 16 * tb + w.fr; const float gc = GC[col];
          f32x4 m = acc[ci];
#pragma unroll
          for (int j = 0; j < 4; ++j) if (16 * w.ta + 4 * w.fq + j == col) m[j] += gc;
          const size_t fo = (size_t)((tb * 2 + (w.ta >> 1)) * 64 + lane) * 8 + 4 * (w.ta & 1);
          v2u o; o.x = pk2(m[0], m[1]); o.y = pk2(m[2], m[3]); *(v2u*)(MF + fo) = o;
          const v2u rr = *(const LAS v2u*)(Rt + col * MP + 16 * w.ta + 4 * w.fq);
          f32x4 q = rb[ci]; q[0] += bflo(rr.x); q[1] += bfhi(rr.x); q[2] += bflo(rr.y); q[3] += bfhi(rr.y);
          o.x = pk2(q[0], q[1]); o.y = pk2(q[2], q[3]); *(v2u*)(QF + fo) = o; } }
    bar_lds();
    { float* NF = (float*)((unsigned char*)a.out + OUT_NF) + ub; float* Y2 = (float*)((unsigned char*)a.out + OUT_Y2) + ub;
      ZERO2(acc); mm2(BhT, U2T, w, acc); mm2(KhT, VT, w, acc);
      ZERO2(rb); mm2(U2T, ARB, w, rb); mm2(VT, ARK, w, rb);
#pragma unroll
      for (int ci = 0; ci < 2; ++ci) { const int tb = w.tb0 + ci;
          *(f32x4*)(NF + (size_t)((tb * 4 + w.ta) * 64 + lane) * 4) = acc[ci];
          *(f32x4*)(Y2 + (size_t)(16 * tb + w.fr) * 64 + 16 * w.ta + 4 * w.fq) = rb[ci]; } }
}

constexpr int KR = 4, NR = NCH / KR, SLOT = 10240, RBUF = KR * SLOT, NPIECE = RBUF / 16, LPT = 6, PPC = SLOT / 16;
__device__ __forceinline__ const v4u* sp_src(const Args& a, int h, int cg, int r, int p) {
    const int cc = p / PPC, q = p % PPC, c = r * KR + cc; const size_t ub = (size_t)(c * 16 + h) * 4096;
    return q < 512 ? (const v4u*)((const bf16*)(a.ws + WS_MF) + ub) + q : (const v4u*)((const bf16*)((const unsigned char*)a.out + OUT_NF) + ub + cg * 1024) + (q - 512);
}
__device__ __forceinline__ void state_pass(const Args& a, LAS unsigned char* lds, int b, int tid, int wave, int lane) {
    const int h = b & 15, cg = b >> 4, lt = tid - 64;
    v4u ra[LPT], rb[LPT];
    if (wave != 0) {
#pragma unroll
        for (int i = 0; i < LPT; ++i) { const int p = lt + 448 * i; if (p < NPIECE) ra[i] = *sp_src(a, h, cg, 0, p); }
#pragma unroll
        for (int i = 0; i < LPT; ++i) { const int p = lt + 448 * i; if (p < NPIECE) *(LAS v4u*)(lds + p * 16) = ra[i]; }
#pragma unroll
        for (int i = 0; i < LPT; ++i) { const int p = lt + 448 * i; if (p < NPIECE) ra[i] = *sp_src(a, h, cg, 1, p); }
    }
    f32x4 st[4];
#pragma unroll
    for (int i = 0; i < 4; ++i) st[i] = (f32x4){0.f, 0.f, 0.f, 0.f};
    bar_lds();
    bf16* SF = (bf16*)(a.ws + WS_SF);
#define SP_ROUND(r_, RA, RB) do { \
        if (wave != 0) { \
            if ((r_) + 2 < NR) { _Pragma("unroll") for (int i = 0; i < LPT; ++i) { const int p = lt + 448 * i; if (p < NPIECE) RB[i] = *sp_src(a, h, cg, (r_) + 2, p); } } \
            if ((r_) + 1 < NR) { _Pragma("unroll") for (int i = 0; i < LPT; ++i) { const int p = lt + 448 * i; if (p < NPIECE) *(LAS v4u*)(lds + (((r_) + 1) & 1) * RBUF + p * 16) = RA[i]; } } \
        } else { \
            _Pragma("unroll") for (int cc = 0; cc < KR; ++cc) { \
                const LAS unsigned char* sl = lds + ((r_) & 1) * RBUF + cc * SLOT; const int c = (r_) * KR + cc; \
                v4u b0, b1; b0.x = pk2(st[0][0], st[0][1]); b0.y = pk2(st[0][2], st[0][3]); b0.z = pk2(st[1][0], st[1][1]); b0.w = pk2(st[1][2], st[1][3]); \
                b1.x = pk2(st[2][0], st[2][1]); b1.y = pk2(st[2][2], st[2][3]); b1.z = pk2(st[3][0], st[3][1]); b1.w = pk2(st[3][2], st[3][3]); \
                v4u* sfo = (v4u*)(SF + (size_t)(c * 16 + h) * 4096) + (cg * 2) * 64 + lane; sfo[0] = b0; sfo[64] = b1; \
                const bf16x8 f0 = __builtin_bit_cast(bf16x8, b0), f1 = __builtin_bit_cast(bf16x8, b1); \
                _Pragma("unroll") for (int rt = 0; rt < 4; ++rt) { \
                    const v2u nb_ = *(const LAS v2u*)(sl + 8192 + (rt * 64 + lane) * 8); f32x4 n = {bflo(nb_.x), bfhi(nb_.x), bflo(nb_.y), bfhi(nb_.y)}; \
                    n = MFMA16(*(const LAS bf16x8*)(sl + ((rt * 2 + 0) * 64 + lane) * 16), f0, n); \
                    n = MFMA16(*(const LAS bf16x8*)(sl + ((rt * 2 + 1) * 64 + lane) * 16), f1, n); st[rt] = n; } \
            } \
        } \
        bar_lds(); } while (0)
#pragma unroll 1
    for (int r = 0; r < NR; r += 2) { SP_ROUND(r, ra, rb); SP_ROUND(r + 1, rb, ra); }
#undef SP_ROUND
}

__device__ __forceinline__ void rwkv_out_unit(const Args& a, LAS unsigned char* lds, int unit, int tid, int wave, int lane) {
    const int c = unit >> 4, h = unit & 15, t0 = c * CH, t = tid >> 3, c8 = (tid & 7) * 8, ch = h * 64 + c8;
    const size_t ub = (size_t)unit * 4096;
    const bf16* QF = (const bf16*)(a.ws + WS_QF) + ub; const bf16* SF = (const bf16*)(a.ws + WS_SF) + ub; const bf16* Y2 = (const bf16*)((const unsigned char*)a.out + OUT_Y2) + ub;
    LAS float* SY = (LAS float*)lds;
    const int ta = wave & 3, tb0 = (wave >> 2) * 2, fr = lane & 15, fq = lane >> 4;
    bf16x8 af[2], bfr[2][2];
#pragma unroll
    for (int s = 0; s < 2; ++s) { af[s] = *(const bf16x8*)(QF + (size_t)((ta * 2 + s) * 64 + lane) * 8);
#pragma unroll
        for (int ci = 0; ci < 2; ++ci) bfr[s][ci] = *(const bf16x8*)(SF + (size_t)(((tb0 + ci) * 2 + s) * 64 + lane) * 8); }
    float y2[8], v[8], g[8];
    unpack8(ldg16(Y2 + t * 64 + c8), y2);
    const bf16* proj = (const bf16*)(a.ws + WS_PROJ);
    load_shift8(proj, t0 + t, C_V + ch, a.in[3], v); load_shift8(proj, t0 + t, C_G + ch, a.in[3], g);
    const float bonus = ((const float*)(a.ws + WS_BON))[(size_t)(t0 + t) * 16 + h];
    f32x4 acc[2]; ZERO2(acc);
#pragma unroll
    for (int s = 0; s < 2; ++s)
#pragma unroll
        for (int ci = 0; ci < 2; ++ci) acc[ci] = MFMA16(af[s], bfr[s][ci], acc[ci]);
    bar_lds();
#pragma unroll
    for (int ci = 0; ci < 2; ++ci)
#pragma unroll
        for (int j = 0; j < 4; ++j) SY[(16 * ta + 4 * fq + j) * 68 + 16 * (tb0 + ci) + fr] = acc[ci][j];
    bar_lds();
    float y[8];
#pragma unroll
    for (int j = 0; j < 8; ++j) y[j] = SY[t * 68 + c8 + j] + y2[j];
    rwkv_out8(a, y, v, g, bonus, t0 + t, ch);
}
constexpr int L2_SEG = 129280, L2_XST = 131328, L2_TW = 131584, L2_ADM = 140800, L2_X1T = 150016;
struct PF { v4u p[4], q[4]; };
__device__ __forceinline__ void pf_issue(PF& f, const bf16* proj, int row, int ch) {
    const int cols[4] = {C_R, C_K, C_V, C_G};
#pragma unroll
    for (int i = 0; i < 4; ++i) { f.p[i] = ldg16(proj + (size_t)row * NINP + cols[i] + ch); f.q[i] = (v4u){0u, 0u, 0u, 0u}; if (row > 0) f.q[i] = ldg16(proj + (size_t)(row - 1) * NINP + cols[i] + ch); }
}
__device__ __forceinline__ void pf_shift(const v4u& p, const v4u& q, const float (&mf)[8], float (&o)[8]) {
    float pf[8], qf[8]; unpack8(p, pf); unpack8(q, qf);
#pragma unroll
    for (int j = 0; j < 8; ++j) o[j] = pf[j] + (qf[j] - pf[j]) * mf[j];
}
template <bool DOP, bool DOT, bool CHK = false> __device__ __forceinline__ void neu_stage(const LAS bf16* Pin, const LAS bf16* PTin, LAS bf16* Pout, LAS bf16* PTout, const LAS bf16* TMin, LAS bf16* TMout, const WTile& w, f32x4 (&Tacc)[2], LAS unsigned* flag = nullptr) {
    f32x4 acc[2];
    if (DOP) { ZERO2(acc); mm2(Pin, PTin, w, acc); }
    if (DOP && CHK) {
        float m = 0.f;
#pragma unroll
        for (int ci = 0; ci < 2; ++ci)
#pragma unroll
            for (int j = 0; j < 4; ++j) m = fmaxf(m, fabsf(acc[ci][j]));
        if (m > 1e-4f) atomicMax((unsigned*)flag, __float_as_uint(m));
    }
    if (DOT) mm2(TMin, PTin, w, Tacc);
#pragma unroll
    for (int ci = 0; ci < 2; ++ci) {
        if (DOP) { st_N(Pout, w.ta, w.tb0 + ci, w, acc[ci]); st_T(PTout, w.ta, w.tb0 + ci, w, acc[ci]); }
        if (DOT) st_N(TMout, w.ta, w.tb0 + ci, w, Tacc[ci]);
    }
    bar_lds();
}
__device__ __forceinline__ void rwkv_chunk_group(const Args& a, LAS unsigned char* lds, int item, int tid, int wave, int lane) {
    const int c = item >> 1, hg = item & 1, t0 = c * CH, t = tid >> 3, c8 = (tid & 7) * 8, row = t0 + t;
    const bf16* proj = (const bf16*)(a.ws + WS_PROJ); const bf16* upt = (const bf16*)(a.ws + WS_UPT); const bf16* aupt = upt + 65536; const float* mu = a.in[3];
    LAS bf16* TW = (LAS bf16*)(lds + L2_TW); LAS bf16* ADm = (LAS bf16*)(lds + L2_ADM);
    WTile w; w.ta = wave & 3; w.tb0 = (wave >> 2) * 2; w.fr = lane & 15; w.fq = lane >> 4;
    bar_lds();
    { float x[8]; load_shift8(proj, row, C_WD + c8, mu, x);
#pragma unroll
      for (int j = 0; j < 8; ++j) x[j] = 1.f - 2.f * __builtin_amdgcn_rcpf(1.f + __expf(2.f * x[j]));
      *(LAS v4u*)(TW + t * 72 + c8) = pack8(x);
      load_shift8(proj, row, C_AD + c8, mu, x); *(LAS v4u*)(ADm + t * 72 + c8) = pack8(x); }
    PF pf; pf_issue(pf, proj, row, hg * 512 + c8);
#pragma unroll 1
    for (int hh = 0; hh < 8; ++hh) {
        const int h = hg * 8 + hh, ch = h * 64 + c8, unit = c * 16 + h;
        LAS unsigned char* L = lds; asm volatile("" : "+v"(L));
        LAS bf16* At = (LAS bf16*)(L + L_AT); LAS bf16* AtT = (LAS bf16*)(L + L_ATT); LAS bf16* Bt = (LAS bf16*)(L + L_BT); LAS bf16* Kt = (LAS bf16*)(L + L_KT);
        LAS bf16* Rt = (LAS bf16*)(L + L_RT); LAS bf16* BhT = (LAS bf16*)(L + L_BHT); LAS bf16* KhT = (LAS bf16*)(L + L_KHT); LAS bf16* VT = (LAS bf16*)(L + L_VT);
        LAS bf16* P0 = (LAS bf16*)(L + L_P); LAS bf16* PT0 = (LAS bf16*)(L + L_PT); LAS bf16* TM0 = (LAS bf16*)(L + L_TM);
        LAS bf16* P1 = At; LAS bf16* PT1 = Bt; LAS bf16* TM1 = Kt;
        LAS bf16* AAK = (LAS bf16*)(L + L_AAK); LAS bf16* ARB = (LAS bf16*)(L + L_ARB); LAS bf16* ARK = (LAS bf16*)(L + L_ARK);
        LAS float* SEG = (LAS float*)(L + L2_SEG); LAS float* GC = (LAS float*)(L + L_GC);
        LAS bf16* X1T = (LAS bf16*)(L + L2_X1T);
        LAS float* Z = (LAS float*)(L + 18432); LAS float* AP = Z + 64 * 68;
        LAS bf16* WT = At; LAS bf16* U2T = Bt; LAS unsigned* NFLAG = (LAS unsigned*)(L + 159232);
        bf16x8 bU[2][2], bA[2][2];
#pragma unroll
        for (int ci = 0; ci < 2; ++ci)
#pragma unroll
            for (int s = 0; s < 2; ++s) { const size_t bo = (size_t)(h * 64 + 16 * (w.tb0 + ci) + w.fr) * 64 + 32 * s + 8 * w.fq; bU[ci][s] = *(const bf16x8*)(upt + bo); bA[ci][s] = *(const bf16x8*)(aupt + bo); }
        float pw0[8], pa0[8], pkk[8], pka[8], prk[8], mur[8], muk[8], muv[8];
        ld8f(a.in[4] + ch, pw0); ld8f(a.in[6] + ch, pa0); ld8f(a.in[8] + ch, pkk); ld8f(a.in[9] + ch, pka); ld8f(a.in[10] + ch, prk);
        ld8f(mu + C_R + ch, mur); ld8f(mu + C_K + ch, muk); ld8f(mu + C_V + ch, muv);
        bar_lds();
#ifdef PROBE_G
        if (blockIdx.x == 0 && tid == 0 && hh == 3) ((unsigned long long*)(a.ws + 65536))[0] = __builtin_amdgcn_s_memrealtime();
#endif

        { const int rt = w.ta, cp = w.tb0, fr = w.fr, fq = w.fq;
          bf16x8 aT[2], aA[2];
#pragma unroll
          for (int s = 0; s < 2; ++s) { aT[s] = *(const LAS bf16x8*)(TW + (16 * rt + fr) * 72 + 32 * s + 8 * fq); aA[s] = *(const LAS bf16x8*)(ADm + (16 * rt + fr) * 72 + 32 * s + 8 * fq); }
#pragma unroll
          for (int ci = 0; ci < 2; ++ci) { const int ct = cp + ci; f32x4 z = {0.f, 0.f, 0.f, 0.f}, ap = {0.f, 0.f, 0.f, 0.f};
#pragma unroll
              for (int s = 0; s < 2; ++s) { z = MFMA16(aT[s], bU[ci][s], z); ap = MFMA16(aA[s], bA[ci][s], ap); }
#pragma unroll
              for (int j = 0; j < 4; ++j) { Z[(16 * rt + 4 * fq + j) * 68 + 16 * ct + fr] = z[j]; AP[(16 * rt + 4 * fq + j) * 68 + 16 * ct + fr] = ap[j]; } } }
        bar_lds();
#ifdef PROBE_G
        if (blockIdx.x == 0 && tid == 0 && hh == 3) ((unsigned long long*)(a.ws + 65536))[1] = __builtin_amdgcn_s_memrealtime();
#endif
        float r[8], kp[8], vv[8], lw[8], kk[8], bb[8];
        { float zz[8], aa[8], kr[8];
#pragma unroll
          for (int j = 0; j < 8; ++j) { zz[j] = Z[t * 68 + c8 + j]; aa[j] = AP[t * 68 + c8 + j]; }
          pf_shift(pf.p[0], pf.q[0], mur, r); pf_shift(pf.p[1], pf.q[1], muk, kr); pf_shift(pf.p[2], pf.q[2], muv, vv);
#pragma unroll
          for (int j = 0; j < 8; ++j) { const float z = pw0[j] + zz[j]; lw[j] = -0.60653066f * __builtin_amdgcn_rcpf(1.f + __expf(-z)); aa[j] = sigmoidf_(pa0[j] + aa[j]); }
          float ss = 0.f;
#pragma unroll
          for (int j = 0; j < 8; ++j) { kk[j] = kr[j] * pkk[j]; ss += kk[j] * kk[j]; kp[j] = kr[j] * (1.f + (aa[j] - 1.f) * pka[j]); }
          ss = sum8(ss); const float rn = 1.f / fmaxf(sqrtf(ss), 1e-12f);
          float bs = 0.f;
#pragma unroll
          for (int j = 0; j < 8; ++j) { kk[j] *= rn; bb[j] = kk[j] * aa[j]; bs += r[j] * kp[j] * prk[j]; }
          bs = sum8(bs);
          if ((tid & 7) == 0) ((float*)(a.ws + WS_BON))[(size_t)row * 16 + h] = bs; }
        if (hh < 7) pf_issue(pf, proj, row, ch + 64);
        float Lt[8];
#pragma unroll
        for (int j = 0; j < 8; ++j) { float x = lw[j];
#pragma unroll
            for (int d = 8; d < 64; d <<= 1) { const float y = __shfl_up(x, d); if (lane >= d) x += y; }
            Lt[j] = x; }
        if ((lane >> 3) == 7) {
#pragma unroll
            for (int j = 0; j < 8; ++j) SEG[wave * 64 + c8 + j] = Lt[j]; }
        bar_lds();
        {
            float gc[8], x[8], y[8];
            { float off[8], tot[8];
#pragma unroll
              for (int j = 0; j < 8; ++j) { off[j] = 0.f; tot[j] = 0.f; }
#pragma unroll
              for (int s = 0; s < 8; ++s) { const f32x4 s0 = *(const LAS f32x4*)(SEG + s * 64 + c8), s1 = *(const LAS f32x4*)(SEG + s * 64 + c8 + 4);
                  const float sv[8] = {s0.x, s0.y, s0.z, s0.w, s1.x, s1.y, s1.z, s1.w};
#pragma unroll
                  for (int j = 0; j < 8; ++j) { tot[j] += sv[j]; if (s < wave) off[j] += sv[j]; } }
#pragma unroll
              for (int j = 0; j < 8; ++j) { Lt[j] += off[j]; gc[j] = __expf(tot[j]); } }
            if (t == 0) {
#pragma unroll
                for (int j = 0; j < 8; ++j) GC[c8 + j] = gc[j]; }
            float e1[8], ie1[8];
#pragma unroll
            for (int j = 0; j < 8; ++j) { e1[j] = __expf(Lt[j]); ie1[j] = __builtin_amdgcn_rcpf(e1[j]); }
#pragma unroll
            for (int j = 0; j < 8; ++j) x[j] = -kk[j] * __expf(Lt[j] - lw[j]);
            *(LAS v4u*)(At + t * MP + c8) = pack8(x); st_bf16x8_T2(AtT, c8, t, lane, x);
#pragma unroll
            for (int j = 0; j < 8; ++j) { x[j] = bb[j] * ie1[j]; y[j] = kp[j] * ie1[j]; }
            *(LAS v4u*)(Bt + t * MP + c8) = pack8(x); *(LAS v4u*)(Kt + t * MP + c8) = pack8(y);
#pragma unroll
            for (int j = 0; j < 8; ++j) x[j] = r[j] * e1[j];
            *(LAS v4u*)(Rt + t * MP + c8) = pack8(x);
#pragma unroll
            for (int j = 0; j < 8; ++j) { const float e = gc[j] * ie1[j]; x[j] = bb[j] * e; y[j] = kp[j] * e; }
            st_bf16x8_T2(BhT, c8, t, lane, x); st_bf16x8_T2(KhT, c8, t, lane, y); st_bf16x8_T2(VT, c8, t, lane, vv);
        }
        bar_lds();
#ifdef PROBE_G
        if (blockIdx.x == 0 && tid == 0 && hh == 3) ((unsigned long long*)(a.ws + 65536))[2] = __builtin_amdgcn_s_memrealtime();
#endif
        f32x4 acc[2], Tacc[2], rb[2], rk[2];
        ZERO2(Tacc); mm2(At, Bt, w, Tacc); mask2<2>(Tacc, w);
        ZERO2(acc); mm2(Kt, At, w, acc); mask2<0>(acc, w);
        ZERO2(rb); mm2(Bt, Rt, w, rb); mask2<1>(rb, w); ZERO2(rk); mm2(Kt, Rt, w, rk); mask2<1>(rk, w);
        bar_lds();
#pragma unroll
        for (int ci = 0; ci < 2; ++ci) { st_N(P1, w.ta, w.tb0 + ci, w, Tacc[ci]); st_T(PT1, w.ta, w.tb0 + ci, w, Tacc[ci]);
            st_T(AAK, w.ta, w.tb0 + ci, w, acc[ci]); st_T(ARB, w.ta, w.tb0 + ci, w, rb[ci]); st_T(ARK, w.ta, w.tb0 + ci, w, rk[ci]);
#pragma unroll
            for (int j = 0; j < 4; ++j) if (16 * w.ta + 4 * w.fq + j == 16 * (w.tb0 + ci) + w.fr) Tacc[ci][j] += 1.f;
            st_N(TM1, w.ta, w.tb0 + ci, w, Tacc[ci]); }
        if (tid == 0) *NFLAG = 0u;
        bar_lds();
#ifdef PROBE_G
        if (blockIdx.x == 0 && tid == 0 && hh == 3) ((unsigned long long*)(a.ws + 65536))[3] = __builtin_amdgcn_s_memrealtime();
#endif
        { ZERO2(acc); mm2(AAK, VT, w, acc);
#pragma unroll
          for (int ci = 0; ci < 2; ++ci) st_T(X1T, w.ta, w.tb0 + ci, w, acc[ci]); }
        neu_stage<true, false>(P1, PT1, P0, PT0, nullptr, nullptr, w, Tacc);
        int nrep = 1; asm volatile("" : "+s"(nrep));
#pragma unroll 1
        for (int n = 0; n < nrep; ++n) {
            neu_stage<true, true>(P0, PT0, P1, PT1, TM1, TM0, w, Tacc);
            neu_stage<true, true, true>(P1, PT1, P0, PT0, TM0, TM1, w, Tacc, NFLAG);
        }
        if (*NFLAG != 0u) {
            neu_stage<true, true>(P0, PT0, P1, PT1, TM1, TM0, w, Tacc);
            neu_stage<true, true>(P1, PT1, P0, PT0, TM0, TM1, w, Tacc);
        }
        neu_stage<false, true>(P0, PT0, nullptr, nullptr, TM1, TM0, w, Tacc);

#ifdef PROBE_G
        if (blockIdx.x == 0 && tid == 0 && hh == 3) ((unsigned long long*)(a.ws + 65536))[4] = __builtin_amdgcn_s_memrealtime();
#endif
        ZERO2(acc); mm2(TM0, AtT, w, acc); ZERO2(rb); mm2(TM0, X1T, w, rb);
#pragma unroll
        for (int ci = 0; ci < 2; ++ci) { st_T(WT, w.ta, w.tb0 + ci, w, acc[ci]); st_T(U2T, w.ta, w.tb0 + ci, w, rb[ci]); }
        bar_lds();
        const size_t ub = (size_t)unit * 4096;
        { bf16* MF = (bf16*)(a.ws + WS_MF) + ub; bf16* QF = (bf16*)(a.ws + WS_QF) + ub;
          ZERO2(acc); mm2(WT, BhT, w, acc); ZERO2(rb); mm2(WT, ARB, w, rb);
#pragma unroll
          for (int ci = 0; ci < 2; ++ci) { const int tb = w.tb0 + ci; const int col = 16 * tb + w.fr; const float gcv = GC[col];
              f32x4 m = acc[ci];
#pragma unroll
              for (int j = 0; j < 4; ++j) if (16 * w.ta + 4 * w.fq + j == col) m[j] += gcv;
              const size_t fo = (size_t)((tb * 2 + (w.ta >> 1)) * 64 + lane) * 8 + 4 * (w.ta & 1);
              v2u o; o.x = pk2(m[0], m[1]); o.y = pk2(m[2], m[3]); *(v2u*)(MF + fo) = o;
              const v2u rr = *(const LAS v2u*)(Rt + col * MP + 16 * w.ta + 4 * w.fq);
              f32x4 q = rb[ci]; q[0] += bflo(rr.x); q[1] += bfhi(rr.x); q[2] += bflo(rr.y); q[3] += bfhi(rr.y);
              o.x = pk2(q[0], q[1]); o.y = pk2(q[2], q[3]); *(v2u*)(QF + fo) = o; }
          bf16* NF = (bf16*)((unsigned char*)a.out + OUT_NF) + ub; bf16* Y2 = (bf16*)((unsigned char*)a.out + OUT_Y2) + ub;
          ZERO2(acc); mm2(BhT, U2T, w, acc); mm2(KhT, VT, w, acc);
          ZERO2(rb); mm2(U2T, ARB, w, rb); mm2(VT, ARK, w, rb);
#pragma unroll
          for (int ci = 0; ci < 2; ++ci) { const int tb = w.tb0 + ci;
              v2u o; o.x = pk2(acc[ci][0], acc[ci][1]); o.y = pk2(acc[ci][2], acc[ci][3]); *(v2u*)(NF + (size_t)((tb * 4 + w.ta) * 64 + lane) * 4) = o;
              o.x = pk2(rb[ci][0], rb[ci][1]); o.y = pk2(rb[ci][2], rb[ci][3]); *(v2u*)(Y2 + (size_t)(16 * tb + w.fr) * 64 + 16 * w.ta + 4 * w.fq) = o; } }

#ifdef PROBE_G
        if (blockIdx.x == 0 && tid == 0 && hh == 3) ((unsigned long long*)(a.ws + 65536))[5] = __builtin_amdgcn_s_memrealtime();
#endif
    }
}
#ifndef HOSTDUP
#define HOSTDUP -1
#endif
#ifndef ONE_LAUNCH
#define ONE_LAUNCH 1
#endif
#if HOSTDUP != -1 || defined(MULTI)
#undef ONE_LAUNCH
#define ONE_LAUNCH 0
#endif
constexpr int NPHASE = 7;
__global__ void __launch_bounds__(NTHR, 2) mega(Args a) {
    extern __shared__ __attribute__((aligned(16))) unsigned char lds_[];
    LAS unsigned char* lds = (LAS unsigned char*)lds_;
    const int tid = threadIdx.x, lane = tid & 63, wave = __builtin_amdgcn_readfirstlane(tid >> 6);
    const int G = gridDim.x, bx = blockIdx.x, vcu = (G % 8 == 0) ? (bx % 8) * (G / 8) + bx / 8 : bx;
    cg::grid_group grid = cg::this_grid();
    volatile LAS unsigned* xst = (volatile LAS unsigned*)(lds + L2_XST);
    if (tid < 2) xst[tid] = 0u;
    __syncthreads();
    XcdBarrier xbar; xbar.bar = (unsigned*)a.ws; xbar.x = 0; xbar.st = xst;
    if (a.ph_hi - a.ph_lo > 1) xbar = xcd_barrier_post((unsigned*)a.ws, xst);
#ifndef PROBE_Q
#define PROBE_Q 1
#endif
#ifdef PROBE_TS
    unsigned long long ts_[10];
#define STAMP(i) do { ts_[i] = __builtin_amdgcn_s_memrealtime(); } while (0)
#else
#define STAMP(i) do {} while (0)
#endif
    STAMP(0);
#define IN(k) (a.ph_lo <= (k) && (k) < a.ph_hi)
#define SEAM(k) do { if (IN(k) && IN((k) + 1)) xcd_barrier(xbar); } while (0)
    if (a.ph_lo < 0) grid.sync();
    if (IN(0)) { p0_prologue(a, lds, vcu, G, wave, lane); }
    SEAM(0); STAMP(1);
    if (IN(1)) {
        constexpr int N1 = 6144;
        pg8::Gemm g{(const pg8::bf16_t*)(a.ws + WS_XN), (const pg8::bf16_t*)(a.ws + WS_WTIN), T, (G == 256 ? N1 : NINP), D}; pg8::StaticOrder S; S.init(T, (G == 256 ? N1 : NINP), G, bx);
        pg8::EpiBf16<0> E{(pg8::bf16_t*)(a.ws + WS_PROJ), NINP, nullptr, 0, 0, 1.f};
        pg8::gemm_phase<pg8::EpiBf16<0>, pg8::StaticOrder, true, true>(lds, g, S, E);
    }
    SEAM(1); STAMP(2);
    if (IN(2)) {
        for (int it = bx; it < NCH * 2; it += G) rwkv_chunk_group(a, lds, it, tid, wave, lane);
    }
    SEAM(2); STAMP(3);
    if (IN(3)) {
        if (bx < 64) state_pass(a, lds, bx, tid, wave, lane);
        else if (G == 256 && bx < 128) {
            pg8::Gemm g{(const pg8::bf16_t*)(a.ws + WS_XN), (const pg8::bf16_t*)(a.ws + WS_WTIN), T, NINP, D}; pg8::OneTile S{(bx - 64) >> 1, 24 + ((bx - 64) & 1)};
            pg8::EpiBf16<0> E{(pg8::bf16_t*)(a.ws + WS_PROJ), NINP, nullptr, 0, 0, 1.f};
            pg8::gemm_phase<pg8::EpiBf16<0>, pg8::OneTile, true, true>(lds, g, S, E);
        } else if (G == 256) { for (int it = bx - 128; it < 256; it += 128) attn_unit(a, lds, 2 * it, tid, wave, lane); }
    }
    SEAM(3); STAMP(4);
    if (IN(4)) {
        if (G == 256) { for (int it = bx; it < 256; it += G) attn_unit(a, lds, 2 * it + 1, tid, wave, lane); }
        else { for (int it = bx; it < 512; it += G) attn_unit(a, lds, it, tid, wave, lane); }
        STAMP(8);
        for (int u = bx; u < NCH * NH; u += G) rwkv_out_unit(a, lds, u, tid, wave, lane);
    }
    SEAM(4); STAMP(5);
    if (IN(5)) {
        pg8::Gemm g{(const pg8::bf16_t*)(a.ws + WS_MIX), (const pg8::bf16_t*)(a.ws + WS_WTOUT), T, D, D}; pg8::StaticOrder S; S.init(T, D, G, bx);
        if (G == 256 && a.ph_hi - a.ph_lo > 1) {
            pg8::EpiResidNorm E{a.in[0], a.out, (float*)(a.ws + WS_SSP), (unsigned*)a.ws + 4096, a.in[15], D, RMS_EPS};
            pg8::gemm_phase<pg8::EpiResidNorm, pg8::StaticOrder, false, true>(lds, g, S, E);
        } else {
            pg8::EpiResid E{a.in[0], a.out, (float*)(a.ws + WS_SSP), D};
            pg8::gemm_phase<pg8::EpiResid, pg8::StaticOrder, true, true>(lds, g, S, E);
        }
    }
    if (!(G == 256 && a.ph_hi - a.ph_lo > 1)) { SEAM(5); } STAMP(6);
    if (IN(6) && !(G == 256 && a.ph_hi - a.ph_lo > 1)) final_norm(a, vcu, G, wave, lane);
#ifdef PROBE_G
    __syncthreads();
    if (bx == 0 && tid == 0) { const unsigned long long* g_ = (const unsigned long long*)(a.ws + 65536); a.out[0] = (float)(g_[PROBE_G + 1] - g_[PROBE_G]) * 0.1f; }
#endif
#ifdef PROBE_TS
    STAMP(7); __syncthreads();
    if (bx == 0 && tid == 0) { const int k_ = PROBE_TS; const unsigned long long d_ = (k_ == 9) ? ts_[7] - ts_[0] : (k_ == 8) ? ts_[8] - ts_[4] : ts_[k_ + 1] - ts_[k_]; a.out[0] = (float)(((int)((float)d_ * 0.01f) / PROBE_Q) * PROBE_Q + PROBE_Q / 2); }
#endif
#undef IN
#undef SEAM
}

extern "C" void kernel_launch(void* const* d_in, const int* in_sizes, int n_in, void* d_out, int out_size, void* d_ws, size_t ws_size, hipStream_t stream) {
    static int grid = 0;
    if (grid == 0) {
        int dev = 0, cus = 0;
        if (hipGetDevice(&dev) != hipSuccess || hipDeviceGetAttribute(&cus, hipDeviceAttributeMultiprocessorCount, dev) != hipSuccess) { fprintf(stderr, "kernel_launch: device query failed\n"); grid = -1; return; }
        if (hipFuncSetAttribute((const void*)mega, hipFuncAttributeMaxDynamicSharedMemorySize, LDS_BYTES) != hipSuccess) { fprintf(stderr, "kernel_launch: hipFuncSetAttribute failed\n"); grid = -1; return; }
        (void)hipGetLastError();
        grid = cus;
    }
    if (grid < 0) return;
    Args a{};
    for (int i = 0; i < 16; ++i) a.in[i] = (const float*)d_in[i];
    a.out = (float*)d_out; a.ws = (unsigned char*)d_ws;
#if ONE_LAUNCH
    (void)hipMemsetAsync(d_ws, 0, 32768, stream);
    a.ph_lo = 0; a.ph_hi = NPHASE;
    void* args[] = {&a};
#ifdef PROBE_PLAIN
    hipLaunchKernelGGL(mega, dim3(grid), dim3(NTHR), LDS_BYTES, stream, a); hipError_t e = hipSuccess; (void)args;
#else
    hipError_t e = hipLaunchCooperativeKernel((const void*)mega, dim3(grid), dim3(NTHR), args, LDS_BYTES, stream);
#endif
    if (e != hipSuccess) fprintf(stderr, "cooperative launch failed: %s (grid %d)\n", hipGetErrorString(e), grid);
#else
    for (int p = 0; p < NPHASE; ++p) for (int rep = 0; rep < (p == HOSTDUP ? 2 : 1); ++rep) { a.ph_lo = p; a.ph_hi = p + 1; hipLaunchKernelGGL(mega, dim3(grid), dim3(NTHR), LDS_BYTES, stream, a); }
#endif
}
```

```cpp
#define ONE 1
#include <hip/hip_runtime.h>
#include <hip/hip_cooperative_groups.h>
#include <cstdio>
#include <cstdint>
namespace cg = cooperative_groups;
namespace pg8 {
#define PG8_LAS __attribute__((address_space(3)))
typedef unsigned short bf16_t;
typedef short bf16x8 __attribute__((ext_vector_type(8)));
typedef float f32x4 __attribute__((ext_vector_type(4)));
typedef unsigned u32x4 __attribute__((ext_vector_type(4)));
constexpr int BM = 256, BK = 64, HALF = 128, HTB = HALF * BK * 2  , STAGE_BYTES = 8 * HTB, NXCD = 8, WGM = 8;

__host__ __device__ __forceinline__ int lds_byte(int r, int c) { const int st = (r >> 4) * 2 + (c >> 5), rr = r & 15, cc = c & 31, ob = rr * 64 + cc * 2; return st * 1024 + (ob ^ (((ob >> 9) & 1) << 5)); }
__host__ __device__ __forceinline__ void stage_rc(int b, int& R, int& C) { const int st = b / 1024, sb = b % 1024, swz = sb ^ (((sb >> 9) & 1) << 5); R = (st >> 1) * 16 + swz / 64; C = (st & 1) * 32 + (swz % 64) / 2; }
__host__ __device__ __forceinline__ int perm32(int rho) { const int n = rho >> 4, i = rho & 15; return 8 * (i >> 2) + 4 * n + (i & 3); }

struct Unit { int pm, pn; };
struct Gemm { const bf16_t* A; const bf16_t* Bt; int M, N, K; };

struct StaticOrder {
    int nM, nN, nwg, G, c;
    __host__ __device__ void init(int M, int N, int G_, int c_) { nM = M / BM; nN = N / BM; nwg = nM * nN; G = G_; c = c_; }
    __host__ __device__ bool next(int i, Unit& u) const {
        const long L = (long)i * G + c; if (L >= nwg) return false;
        int wgid = (int)L; { const int q = nwg / NXCD, r = nwg % NXCD, xcd = wgid % NXCD, off = wgid / NXCD; wgid = (xcd < r ? xcd * (q + 1) : r * (q + 1) + (xcd - r) * q) + off; }
        const int nig = WGM * nN, gid = wgid / nig, fm = gid * WGM, gsz = (nM - fm) < WGM ? (nM - fm) : WGM;
        u.pm = fm + ((wgid % nig) % gsz); u.pn = (wgid % nig) / gsz; return true;
    }
    __device__ __forceinline__ void a_ready(const Unit&) const {}
    __device__ __forceinline__ void done(const Unit&) const {}
};

__device__ __forceinline__ unsigned cvt_pk_bf16(float lo, float hi) { unsigned r; asm volatile("v_cvt_pk_bf16_f32 %0, %1, %2" : "=v"(r) : "v"(lo), "v"(hi)); return r; }
typedef float f32x2 __attribute__((ext_vector_type(2)));
__device__ __forceinline__ f32x2 gelu_pk(f32x2 v) {
    const f32x2 av = __builtin_elementwise_abs(v), d = av * 0.2316418882f + 1.0f;
    f32x2 t; t.x = __builtin_amdgcn_rcpf(d.x); t.y = __builtin_amdgcn_rcpf(d.y);
    f32x2 q = t * 0.5307027145f + (-0.7265760135f); q = q * t + 0.7107068705f; q = q * t + (-0.142248368f); q = q * t + 0.127414796f; q = q * t;
    const f32x2 s = (v * v) * (-0.72134752044f);
    f32x2 e; e.x = __builtin_amdgcn_exp2f(s.x); e.y = __builtin_amdgcn_exp2f(s.y);
    const f32x2 m = v * (q * e), r = v - m;
    f32x2 o; o.x = v.x < 0.f ? m.x : r.x; o.y = v.y < 0.f ? m.y : r.y; return o;
}

template <int ACT  > struct EpiBf16 {
    static constexpr bool PERM = true, AFTER_DRAIN = false; static_assert(ACT == 0 || ACT == 1, "EpiBf16: ACT is 0 (none) or 1 (gelu_pk)");
    bf16_t* O; int ldc; const float* bias; int split_cols; size_t split_stride; float scale0;
    __device__ __forceinline__ void operator()(const f32x4 (&acc)[2][2][4][2], const Unit& u, int wr, int wc, int fr, int fq) const {
        const int row0 = u.pm * BM + wr * 64 + fr; int colt = u.pn * BM; bf16_t* base = O;
        float sc = 1.f; if (split_cols) { const int t = colt / split_cols; base += (size_t)t * split_stride; colt -= t * split_cols; if (t == 0) sc = scale0; }
        const int col0 = colt + wc * 32 + 8 * fq, bcol0 = u.pn * BM + wc * 32 + 8 * fq;
        f32x4 bv[2][2];
#pragma unroll
        for (int bj = 0; bj < 2; ++bj)
#pragma unroll
            for (int n = 0; n < 2; ++n) bv[bj][n] = bias ? *(const f32x4*)(bias + bcol0 + bj * HALF + 4 * n) : (f32x4){0.f, 0.f, 0.f, 0.f};
#pragma unroll
        for (int ai = 0; ai < 2; ++ai)
#pragma unroll
            for (int m = 0; m < 4; ++m) { bf16_t* rowp = base + (size_t)(row0 + ai * HALF + m * 16) * ldc + col0;
#pragma unroll
                for (int bj = 0; bj < 2; ++bj) { f32x4 v0 = acc[ai][bj][m][0] + bv[bj][0], v1 = acc[ai][bj][m][1] + bv[bj][1];
                    if (ACT == 1) { f32x2 a = gelu_pk((f32x2){v0[0], v0[1]}), b = gelu_pk((f32x2){v0[2], v0[3]}), c = gelu_pk((f32x2){v1[0], v1[1]}), d = gelu_pk((f32x2){v1[2], v1[3]});
                        v0 = (f32x4){a.x, a.y, b.x, b.y}; v1 = (f32x4){c.x, c.y, d.x, d.y}; }
                    v0 = v0 * sc; v1 = v1 * sc; u32x4 w; w.x = cvt_pk_bf16(v0[0], v0[1]); w.y = cvt_pk_bf16(v0[2], v0[3]); w.z = cvt_pk_bf16(v1[0], v1[1]); w.w = cvt_pk_bf16(v1[2], v1[3]);
                    *(u32x4*)(rowp + bj * HALF) = w; } }
    }
};
struct EpiResid {
    static constexpr bool PERM = false, AFTER_DRAIN = false;
    const float* x; float* out; float* sspart; int ldc;
    __device__ __forceinline__ void operator()(const f32x4 (&acc)[2][2][4][2], const Unit& u, int wr, int wc, int fr, int fq) const {
        const int row0 = u.pm * BM + wr * 64 + fr, col0 = u.pn * BM + wc * 32 + 4 * fq;
#pragma unroll
        for (int ai = 0; ai < 2; ++ai)
#pragma unroll
            for (int m = 0; m < 4; ++m) {
                const int row = row0 + ai * HALF + m * 16; float ss = 0.f;
#pragma unroll
                for (int bj = 0; bj < 2; ++bj)
#pragma unroll
                    for (int n = 0; n < 2; ++n) {
                        const size_t off = (size_t)row * ldc + col0 + bj * HALF + n * 16;
                        const f32x4 xv = *(const f32x4*)(x + off); const f32x4 v = acc[ai][bj][m][n] + xv;
                        *(f32x4*)(out + off) = v; ss += (v[0] * v[0] + v[1] * v[1]) + (v[2] * v[2] + v[3] * v[3]);
                    }
                ss += __shfl_xor(ss, 16); ss += __shfl_xor(ss, 32);
                if (fq == 0) sspart[(size_t)row * 32 + u.pn * 4 + wc] = ss;
            }
    }
};

struct OneTile {
    int pm, pn;
    __host__ __device__ bool next(int i, Unit& u) const { if (i != 0) return false; u.pm = pm; u.pn = pn; return true; }
    __device__ __forceinline__ void a_ready(const Unit&) const {}
    __device__ __forceinline__ void done(const Unit&) const {}
};
struct EpiResidNorm {
    static constexpr bool PERM = false, AFTER_DRAIN = true;
    const float* x; float* out; float* ssp; unsigned* cnt; const float* gain; int ldc; float eps;
    __device__ __forceinline__ void fused(f32x4 (&acc)[2][2][4][2], const Unit& u, int wr, int wc, int fr, int fq, PG8_LAS unsigned char* lds, int wid, int lane) const {
        const int row0 = u.pm * BM + wr * 64 + fr, col0 = u.pn * BM + wc * 32 + 4 * fq;
#pragma unroll
        for (int ai = 0; ai < 2; ++ai) {
            f32x4 xv[4][2][2];
#pragma unroll
            for (int m = 0; m < 4; ++m)
#pragma unroll
                for (int bj = 0; bj < 2; ++bj)
#pragma unroll
                    for (int n = 0; n < 2; ++n) xv[m][bj][n] = *(const f32x4*)(x + (size_t)(row0 + ai * HALF + m * 16) * ldc + col0 + bj * HALF + n * 16);
#pragma unroll
            for (int m = 0; m < 4; ++m) {
                const int row = row0 + ai * HALF + m * 16; float ss = 0.f;
#pragma unroll
                for (int bj = 0; bj < 2; ++bj)
#pragma unroll
                    for (int n = 0; n < 2; ++n) {
                        const f32x4 v = acc[ai][bj][m][n] + xv[m][bj][n];
                        acc[ai][bj][m][n] = v; ss += (v[0] * v[0] + v[1] * v[1]) + (v[2] * v[2] + v[3] * v[3]);
                    }
                ss += __shfl_xor(ss, 16); ss += __shfl_xor(ss, 32);
                if (fq == 0) __hip_atomic_store(ssp + (size_t)row * 32 + u.pn * 4 + wc, ss, __ATOMIC_RELAXED, __HIP_MEMORY_SCOPE_AGENT);
            }
        }
        asm volatile("s_waitcnt vmcnt(0)" ::: "memory");
        __syncthreads();
        unsigned* c = cnt + 64 * u.pm;
        if (threadIdx.x == 0) {
            __hip_atomic_fetch_add(c, 1u, __ATOMIC_RELEASE, __HIP_MEMORY_SCOPE_AGENT);
            unsigned spins = 0;
            while (__hip_atomic_load(c, __ATOMIC_RELAXED, __HIP_MEMORY_SCOPE_AGENT) < 8u) { __builtin_amdgcn_s_sleep(2); if (++spins > (1u << 22)) break; }
            __builtin_amdgcn_fence(__ATOMIC_ACQUIRE, "agent");
        }
        __syncthreads();
        PG8_LAS float* S = (PG8_LAS float*)lds;
        if (threadIdx.x < 256) {
            const float* p = ssp + (size_t)(u.pm * BM + threadIdx.x) * 32; float s = 0.f;
#pragma unroll
            for (int i = 0; i < 32; ++i) s += __hip_atomic_load(p + i, __ATOMIC_RELAXED, __HIP_MEMORY_SCOPE_AGENT);
            S[threadIdx.x] = 1.0f / sqrtf(s * (1.0f / 2048.0f) + eps);
        }
        __syncthreads();
#pragma unroll
        for (int bj = 0; bj < 2; ++bj)
#pragma unroll
            for (int n = 0; n < 2; ++n) {
                const f32x4 g = *(const f32x4*)(gain + col0 + bj * HALF + n * 16);
#pragma unroll
                for (int ai = 0; ai < 2; ++ai)
#pragma unroll
                    for (int m = 0; m < 4; ++m) {
                        const int lr = wr * 64 + fr + ai * HALF + m * 16; const float rs = S[lr];
                        f32x4 v = acc[ai][bj][m][n]; v[0] *= rs * g[0]; v[1] *= rs * g[1]; v[2] *= rs * g[2]; v[3] *= rs * g[3];
                        *(f32x4*)(out + (size_t)(u.pm * BM + lr) * ldc + col0 + bj * HALF + n * 16) = v;
                    }
            }
    }
};

template <class Epi, class Sched, bool ALIGN_EPI = false, bool SP2 = false>
__device__ __forceinline__ void gemm_phase(PG8_LAS unsigned char* lds, const Gemm g, const Sched& S, const Epi& E) {
    const int tid = threadIdx.x, wid = __builtin_amdgcn_readfirstlane(tid >> 6), lane = tid & 63, wr = wid >> 2, wc = wid & 3, fr = lane & 15, fq = lane >> 4;
    const int K = g.K, nt = K / BK;
    unsigned voffA[2], voffB[2];
#pragma unroll
    for (int i = 0; i < 2; ++i) { int R, C; stage_rc(tid * 16 + i * 8192, R, C); const int Rb = Epi::PERM ? ((R & ~31) + perm32(R & 31)) : R;
        voffA[i] = (unsigned)(R * K + C) * 2u; voffB[i] = (unsigned)(Rb * K + C) * 2u; }
    const size_t kstep = (size_t)(BK * 2);
    const size_t hstep = (size_t)HALF * K * 2;
    const size_t tstep = 2 * hstep;
    const unsigned ldsw = (unsigned)wid * 1024u;
    const int aoff = lds_byte(wr * 64 + fr, fq * 8), boff = lds_byte(wc * 32 + fr, fq * 8);
#define PG8_SA(b, h) (((b) * 2 + (h)) * HTB)
#define PG8_SB(b, h) ((4 + (b) * 2 + (h)) * HTB)
#define PG8_STAGE(bufoff, gbase, voff) do { _Pragma("unroll") for (int _i = 0; _i < 2; ++_i) \
        __builtin_amdgcn_global_load_lds((const unsigned*)((const char*)(gbase) + (voff)[_i]), (PG8_LAS unsigned*)(lds + (bufoff) + ldsw + _i * 8192), 16, 0, 0); } while (0)
#define PG8_LDA(dst, b, h) do { _Pragma("unroll") for (int m = 0; m < 4; ++m) _Pragma("unroll") for (int k = 0; k < 2; ++k) dst[m][k] = *(const PG8_LAS bf16x8*)(lds + PG8_SA(b, h) + aoff + m * 2048 + k * 1024); } while (0)
#define PG8_LDB(dst, b, h) do { _Pragma("unroll") for (int n = 0; n < 2; ++n) _Pragma("unroll") for (int k = 0; k < 2; ++k) dst[n][k] = *(const PG8_LAS bf16x8*)(lds + PG8_SB(b, h) + boff + n * 2048 + k * 1024); } while (0)
#define PG8_MMA(ai, bj, At, Bt) do { __builtin_amdgcn_s_setprio(1); _Pragma("unroll") for (int m = 0; m < 4; ++m) _Pragma("unroll") for (int n = 0; n < 2; ++n) _Pragma("unroll") for (int k = 0; k < 2; ++k) \
        acc[ai][bj][m][n] = __builtin_amdgcn_mfma_f32_16x16x32_bf16(Bt[n][k], At[m][k], acc[ai][bj][m][n], 0, 0, 0); __builtin_amdgcn_s_setprio(0); } while (0)
#define PG8_WAIT_V(n) asm volatile("s_waitcnt vmcnt(" #n ")" ::: "memory")
#define PG8_WAIT_L(n) asm volatile("s_waitcnt lgkmcnt(" #n ")" ::: "memory")
#define PG8_BAR __builtin_amdgcn_s_barrier()
#define PG8_SCHED __builtin_amdgcn_sched_barrier(0)
    Unit cur, nxt; int ui = 0;
    if (!S.next(0, cur)) return;
    f32x4 acc[2][2][4][2];
#pragma unroll
    for (int a = 0; a < 2; ++a)
#pragma unroll
        for (int b = 0; b < 2; ++b)
#pragma unroll
            for (int m = 0; m < 4; ++m)
#pragma unroll
                for (int n = 0; n < 2; ++n) acc[a][b][m][n] = (f32x4){0.f, 0.f, 0.f, 0.f};
    bf16x8 At[4][2], B0[2][2], B1[2][2];
    const char* cA = (const char*)g.A + (size_t)cur.pm * tstep; const char* cB = (const char*)g.Bt + (size_t)cur.pn * tstep;
    S.a_ready(cur);
    if constexpr (SP2) {
        PG8_STAGE(PG8_SB(0, 0), cB, voffB); PG8_STAGE(PG8_SB(0, 1), cB + hstep, voffB); PG8_STAGE(PG8_SA(0, 0), cA, voffA); PG8_STAGE(PG8_SA(0, 1), cA + hstep, voffA);
        if (wr == 1) PG8_BAR;
        PG8_WAIT_V(2); PG8_BAR;
        PG8_STAGE(PG8_SB(1, 0), cB + kstep, voffB); PG8_STAGE(PG8_SA(1, 0), cA + kstep, voffA); PG8_STAGE(PG8_SB(1, 1), cB + hstep + kstep, voffB);
        PG8_WAIT_V(6); PG8_BAR;
    } else {
        PG8_STAGE(PG8_SB(0, 0), cB, voffB); PG8_STAGE(PG8_SA(0, 0), cA, voffA); PG8_STAGE(PG8_SB(0, 1), cB + hstep, voffB); PG8_STAGE(PG8_SA(0, 1), cA + hstep, voffA);
        if (wr == 1) PG8_BAR;
        PG8_WAIT_V(4); PG8_BAR;
        PG8_STAGE(PG8_SB(1, 0), cB + kstep, voffB); PG8_STAGE(PG8_SA(1, 0), cA + kstep, voffA); PG8_STAGE(PG8_SB(1, 1), cB + hstep + kstep, voffB);
        PG8_WAIT_V(6); PG8_BAR;
    }
    for (;;) {
        const bool has_next = S.next(ui + 1, nxt);
        const char* nA = has_next ? (const char*)g.A + (size_t)nxt.pm * tstep : cA; const char* nB = has_next ? (const char*)g.Bt + (size_t)nxt.pn * tstep : cB;
        for (int t = 0; t < nt; t += 2) {
            const bool last = (t == nt - 2);
            const char* a1 = cA + (size_t)(t + 1) * kstep;
            const char* a2 = last ? nA : cA + (size_t)(t + 2) * kstep; const char* b2 = last ? nB : cB + (size_t)(t + 2) * kstep;
            const char* a3 = a2 + kstep; const char* b3 = b2 + kstep;
            if (last && has_next) S.a_ready(nxt);
            if constexpr (SP2) {
            PG8_LDB(B0, 0, 0); PG8_LDB(B1, 0, 1); PG8_SCHED; PG8_LDA(At, 0, 0); PG8_STAGE(PG8_SA(1, 1), a1 + hstep, voffA);
            PG8_WAIT_V(8); PG8_WAIT_L(0); PG8_BAR; PG8_MMA(0, 0, At, B0); PG8_MMA(0, 1, At, B1); PG8_BAR; PG8_SCHED;
            PG8_LDA(At, 0, 1); PG8_STAGE(PG8_SB(0, 0), b2, voffB); PG8_STAGE(PG8_SB(0, 1), b2 + hstep, voffB); PG8_STAGE(PG8_SA(0, 0), a2, voffA);
            PG8_WAIT_V(8); PG8_WAIT_L(0); PG8_BAR; PG8_MMA(1, 0, At, B0); PG8_MMA(1, 1, At, B1); PG8_BAR; PG8_SCHED;
            PG8_LDB(B0, 1, 0); PG8_LDB(B1, 1, 1); PG8_SCHED; PG8_LDA(At, 1, 0); PG8_STAGE(PG8_SA(0, 1), a2 + hstep, voffA);
            PG8_WAIT_V(8); PG8_WAIT_L(0); PG8_BAR; PG8_MMA(0, 0, At, B0); PG8_MMA(0, 1, At, B1); PG8_BAR; PG8_SCHED;
            PG8_LDA(At, 1, 1); PG8_STAGE(PG8_SB(1, 0), b3, voffB); PG8_STAGE(PG8_SB(1, 1), b3 + hstep, voffB); PG8_STAGE(PG8_SA(1, 0), a3, voffA);
            PG8_WAIT_V(8); PG8_WAIT_L(0); PG8_BAR; PG8_MMA(1, 0, At, B0); PG8_MMA(1, 1, At, B1); PG8_BAR; PG8_SCHED;
            } else {
            PG8_LDB(B0, 0, 0); PG8_SCHED; PG8_LDA(At, 0, 0); PG8_STAGE(PG8_SA(1, 1), a1 + hstep, voffA);
            PG8_WAIT_L(8); PG8_BAR; PG8_WAIT_L(0); PG8_MMA(0, 0, At, B0); PG8_BAR; PG8_SCHED;
            PG8_LDB(B1, 0, 1); PG8_STAGE(PG8_SB(0, 0), b2, voffB);
            PG8_BAR; PG8_WAIT_L(0); PG8_MMA(0, 1, At, B1); PG8_BAR;
            PG8_LDA(At, 0, 1); PG8_STAGE(PG8_SA(0, 0), a2, voffA);
            PG8_BAR; PG8_WAIT_L(0); PG8_MMA(1, 0, At, B0); PG8_BAR; PG8_SCHED;
            PG8_STAGE(PG8_SB(0, 1), b2 + hstep, voffB);
            PG8_WAIT_V(6); PG8_BAR; PG8_MMA(1, 1, At, B1); PG8_BAR;
            PG8_LDB(B0, 1, 0); PG8_SCHED; PG8_LDA(At, 1, 0); PG8_STAGE(PG8_SA(0, 1), a2 + hstep, voffA);
            PG8_WAIT_L(8); PG8_BAR; PG8_WAIT_L(0); PG8_MMA(0, 0, At, B0); PG8_BAR; PG8_SCHED;
            PG8_LDB(B1, 1, 1); PG8_STAGE(PG8_SB(1, 0), b3, voffB);
            PG8_BAR; PG8_WAIT_L(0); PG8_MMA(0, 1, At, B1); PG8_BAR;
            PG8_LDA(At, 1, 1); PG8_STAGE(PG8_SA(1, 0), a3, voffA);
            PG8_BAR; PG8_WAIT_L(0); PG8_MMA(1, 0, At, B0); PG8_BAR; PG8_SCHED;
            PG8_STAGE(PG8_SB(1, 1), b3 + hstep, voffB);
            PG8_WAIT_V(6); PG8_BAR; PG8_MMA(1, 1, At, B1); PG8_BAR;
            }
        }
        if constexpr (ALIGN_EPI) { if (wr == 0) PG8_BAR; }
        if constexpr (!Epi::AFTER_DRAIN) { E(acc, cur, wr, wc, fr, fq); S.done(cur); }
        if (!has_next) break;
#pragma unroll
        for (int a = 0; a < 2; ++a)
#pragma unroll
            for (int b = 0; b < 2; ++b)
#pragma unroll
                for (int m = 0; m < 4; ++m)
#pragma unroll
                    for (int n = 0; n < 2; ++n) acc[a][b][m][n] = (f32x4){0.f, 0.f, 0.f, 0.f};
        cur = nxt; cA = nA; cB = nB; ++ui;
        if constexpr (ALIGN_EPI) { if (wr == 1) PG8_BAR; }
    }
    PG8_WAIT_V(0);
    if constexpr (!ALIGN_EPI) { if (wr == 0) PG8_BAR; }
    PG8_BAR;
    if constexpr (Epi::AFTER_DRAIN) { E.fused(acc, cur, wr, wc, fr, fq, lds, wid, lane); S.done(cur); }
#undef PG8_SA
#undef PG8_SB
#undef PG8_STAGE
#undef PG8_LDA
#undef PG8_LDB
#undef PG8_MMA
#undef PG8_WAIT_V
#undef PG8_WAIT_L
#undef PG8_BAR
#undef PG8_SCHED
}
}
constexpr int T = 8192, D = 2048, NIN = 6528, NINP = 6656, RW = 1024, NH = 16, HD = 64, CH = 64, NCH = T / CH;
constexpr int C_R = 0, C_K = 1024, C_V = 2048, C_WD = 3072, C_AD = 3136, C_G = 3200, C_AQ = 4224, C_AK = 5248, C_AV = 5376, C_AG = 5504;
constexpr float RMS_EPS = 1e-5f, LNX_EPS = 64e-5f;
constexpr int NWAVES = 8, NTHR = 512;
constexpr size_t MiB = 1u << 20;
constexpr size_t WS_WTIN = 1 * MiB;
constexpr size_t WS_XN = 27 * MiB;
constexpr size_t WS_WTOUT = 59 * MiB;
constexpr size_t WS_UPT = 67 * MiB;
constexpr size_t WS_SSP = 68 * MiB;
constexpr size_t WS_PROJ = 70 * MiB;
constexpr size_t WS_SCR = 174 * MiB;
constexpr size_t WS_MIX = 223 * MiB;
constexpr size_t WS_P32 = 223 * MiB;
constexpr int LDS_BYTES = 163840;

#define GAS __attribute__((address_space(1)))
#define LAS __attribute__((address_space(3)))
typedef unsigned short bf16;
typedef unsigned v4u __attribute__((ext_vector_type(4)));
typedef unsigned v2u __attribute__((ext_vector_type(2)));
typedef float f32x4 __attribute__((ext_vector_type(4)));
typedef float f32x16 __attribute__((ext_vector_type(16)));
typedef short bf16x8 __attribute__((ext_vector_type(8)));
typedef __bf16 bf16x2_t __attribute__((ext_vector_type(2)));
__device__ __forceinline__ unsigned pk2(float a, float b) { bf16x2_t v; v[0] = (__bf16)a; v[1] = (__bf16)b; return __builtin_bit_cast(unsigned, v); }
__device__ __forceinline__ float bflo(unsigned u) { return __uint_as_float(u << 16); }
__device__ __forceinline__ float bfhi(unsigned u) { return __uint_as_float(u & 0xffff0000u); }
__device__ __forceinline__ void unpack8(const v4u& p, float (&f)[8]) { f[0] = bflo(p.x); f[1] = bfhi(p.x); f[2] = bflo(p.y); f[3] = bfhi(p.y); f[4] = bflo(p.z); f[5] = bfhi(p.z); f[6] = bflo(p.w); f[7] = bfhi(p.w); }
__device__ __forceinline__ v4u pack8(const float (&f)[8]) { v4u o; o.x = pk2(f[0], f[1]); o.y = pk2(f[2], f[3]); o.z = pk2(f[4], f[5]); o.w = pk2(f[6], f[7]); return o; }
__device__ __forceinline__ float wave_sum(float v) {
#pragma unroll
    for (int o = 1; o < 64; o <<= 1) v += __shfl_xor(v, o);
    return v;
}
__device__ __forceinline__ float sum8(float v) { v += __shfl_xor(v, 1); v += __shfl_xor(v, 2); v += __shfl_xor(v, 4); return v; }
__device__ __forceinline__ float sigmoidf_(float x) { return 1.f / (1.f + __expf(-x)); }
__device__ __forceinline__ float siluf_(float x) { return x / (1.f + __expf(-x)); }

__device__ __forceinline__ void bar_lds() { asm volatile("s_waitcnt lgkmcnt(0)" ::: "memory"); __builtin_amdgcn_s_barrier(); asm volatile("" ::: "memory"); }
struct Args { const float* in[16]; float* out; unsigned char* ws; int ph_lo, ph_hi; };

struct TItem { const float* W; bf16* WT; int K, N, k0, n0; };
__device__ __forceinline__ bool p0_item(const Args& a, int it, TItem& o) {
    constexpr int I_IN = (D / 64) * (NIN / 32), I_OUT = (D / 64) * (D / 32), I_UP = RW / 32;
    bf16* wtin = (bf16*)(a.ws + WS_WTIN); bf16* wtout = (bf16*)(a.ws + WS_WTOUT); bf16* upt = (bf16*)(a.ws + WS_UPT); bf16* aupt = upt + 65536;
    int r = it;
    if (r < 0) { r += I_OUT; if (r < 0) return false; o.W = a.in[14]; o.WT = wtout; o.K = D; o.N = D; }
    else if (r < I_IN) { o.W = a.in[2]; o.WT = wtin; o.K = D; o.N = NIN; }
    else if ((r -= I_IN) < I_UP) { o.W = a.in[5]; o.WT = upt; o.K = 64; o.N = RW; }
    else if ((r -= I_UP) < I_UP) { o.W = a.in[7]; o.WT = aupt; o.K = 64; o.N = RW; }
    else return false;
    const int nblk = o.N / 32; o.k0 = 64 * (r / nblk); o.n0 = 32 * (r % nblk); return true;
}
__device__ __forceinline__ void p0_ld(const TItem& t, int lane, f32x4 (&v)[8]) {
#pragma unroll
    for (int i = 0; i < 8; ++i) v[i] = *(const f32x4*)(t.W + (size_t)(t.k0 + 8 * i + (lane >> 3)) * t.N + t.n0 + 4 * (lane & 7));
}
__device__ __forceinline__ void p0_st(const TItem& t, int lane, const f32x4 (&v)[8], LAS float* scr) {
#pragma unroll
    for (int i = 0; i < 8; ++i) { LAS float* d = scr + (8 * i + (lane >> 3)) * 33 + 4 * (lane & 7); d[0] = v[i].x; d[1] = v[i].y; d[2] = v[i].z; d[3] = v[i].w; }
    asm volatile("s_waitcnt lgkmcnt(0)" ::: "memory");
    const int c = lane & 7;
#pragma unroll
    for (int j = 0; j < 4; ++j) { const int n = (lane >> 3) + 8 * j; const LAS float* s = scr + (8 * c) * 33 + n;
        v4u o; o.x = pk2(s[0 * 33], s[1 * 33]); o.y = pk2(s[2 * 33], s[3 * 33]); o.z = pk2(s[4 * 33], s[5 * 33]); o.w = pk2(s[6 * 33], s[7 * 33]);
        *(v4u*)(t.WT + (size_t)(t.n0 + n) * t.K + t.k0 + 8 * c) = o; }
    asm volatile("s_waitcnt lgkmcnt(0)" ::: "memory");
}
__device__ __forceinline__ void wout_transposes(const Args& a, LAS unsigned char* lds, int gw, int NGW, int wave, int lane) {
    LAS float* scr = (LAS float*)(lds + wave * 16384);
    constexpr int I_OUT = (D / 64) * (D / 32);
    for (int it = gw - I_OUT; it < 0; it += NGW) { TItem t0; f32x4 v0[8]; if (!p0_item(a, it, t0)) break; p0_ld(t0, lane, v0); p0_st(t0, lane, v0, scr); }
}
__device__ __forceinline__ void p0_prologue(const Args& a, LAS unsigned char* lds, int vcu, int G, int wave, int lane) {
    LAS float* scr = (LAS float*)(lds + wave * 16384);
    const int gw = vcu * NWAVES + wave, NGW = G * NWAVES;
    bf16* wtin = (bf16*)(a.ws + WS_WTIN);
#ifdef PROBE_P0X
    for (int rep_ = 0; rep_ < 2; ++rep_)
#endif
    for (int it = gw; ; it += 2 * NGW) {
        TItem t0, t1; f32x4 v0[8], v1[8];
        const bool h0 = p0_item(a, it, t0), h1 = p0_item(a, it + NGW, t1);
        if (!h0) break;
        p0_ld(t0, lane, v0); if (h1) p0_ld(t1, lane, v1);
        p0_st(t0, lane, v0, scr); if (h1) p0_st(t1, lane, v1, scr);
    }
    wout_transposes(a, lds, gw, NGW, wave, lane);
    { v4u z = {0u, 0u, 0u, 0u}; v4u* p = (v4u*)(wtin + (size_t)NIN * D); const int n16 = (NINP - NIN) * D * 2 / 16;
      for (int i = gw * 64 + lane; i < n16; i += NGW * 64) p[i] = z; }
    const float* gain = a.in[1];
#ifdef PROBE_P0R
    for (int rep_ = 0; rep_ < 2; ++rep_)
#endif
    for (int m = gw; m < T; m += 2 * NGW) {
        const int m2 = m + NGW;
        const f32x4* xr = (const f32x4*)(a.in[0] + (size_t)m * D) + lane; const f32x4* xr2 = (const f32x4*)(a.in[0] + (size_t)(m2 < T ? m2 : m) * D) + lane;
        f32x4 v[8], u[8]; float s = 0.f, s2 = 0.f;
#pragma unroll
        for (int j = 0; j < 8; ++j) { v[j] = xr[64 * j]; u[j] = xr2[64 * j]; }
#pragma unroll
        for (int j = 0; j < 8; ++j) { s += (v[j].x * v[j].x + v[j].y * v[j].y) + (v[j].z * v[j].z + v[j].w * v[j].w); s2 += (u[j].x * u[j].x + u[j].y * u[j].y) + (u[j].z * u[j].z + u[j].w * u[j].w); }
        const float rstd = 1.f / sqrtf(wave_sum(s) * (1.f / D) + RMS_EPS), rstd2 = 1.f / sqrtf(wave_sum(s2) * (1.f / D) + RMS_EPS);
        v2u* o8 = (v2u*)((bf16*)(a.ws + WS_XN) + (size_t)m * D) + lane; v2u* o82 = (v2u*)((bf16*)(a.ws + WS_XN) + (size_t)m2 * D) + lane;
#pragma unroll
        for (int j = 0; j < 8; ++j) { const f32x4 g = *((const f32x4*)gain + lane + 64 * j); v2u o; o.x = pk2(v[j].x * rstd * g.x, v[j].y * rstd * g.y); o.y = pk2(v[j].z * rstd * g.z, v[j].w * rstd * g.w); o8[64 * j] = o;
            if (m2 < T) { o.x = pk2(u[j].x * rstd2 * g.x, u[j].y * rstd2 * g.y); o.y = pk2(u[j].z * rstd2 * g.z, u[j].w * rstd2 * g.w); o82[64 * j] = o; } }
    }
}
__device__ __forceinline__ void final_norm(const Args& a, int vcu, int G, int wave, int lane) {
    const int gw = vcu * NWAVES + wave, NGW = G * NWAVES; const float* ssp = (const float*)(a.ws + WS_SSP); const float* gain = a.in[15];
    for (int m = gw; m < T; m += NGW) {
        float s = (lane < 32) ? ssp[(size_t)m * 32 + lane] : 0.f; s = wave_sum(s);
        const float rstd = 1.f / sqrtf(s * (1.f / D) + RMS_EPS);
        f32x4* xr = (f32x4*)(a.out + (size_t)m * D) + lane;
#pragma unroll
        for (int j = 0; j < 8; ++j) { f32x4 v = xr[64 * j]; const f32x4 g = *((const f32x4*)gain + lane + 64 * j); v.x *= rstd * g.x; v.y *= rstd * g.y; v.z *= rstd * g.z; v.w *= rstd * g.w; xr[64 * j] = v; }
    }
}
#define XB_TMO      128
#define XB_XCNT(j)  (256  + 64 * (j))
#define XB_XSUB(j)  (1280 + 64 * (j))
#define XB_XGEN(j)  (2304 + 64 * (j))
#define XB_TOP      3328
#define XB_TOPGEN   3392
#define XCD_BAR_WORDS 3456
#define XB_SPIN_CAP (1u << 18)

__device__ __forceinline__ unsigned xb_ld(unsigned* p)              { return __hip_atomic_load(p, __ATOMIC_RELAXED, __HIP_MEMORY_SCOPE_AGENT); }
__device__ __forceinline__ unsigned xb_add(unsigned* p, unsigned v) { return __hip_atomic_fetch_add(p, v, __ATOMIC_RELAXED, __HIP_MEMORY_SCOPE_AGENT); }
__device__ __forceinline__ unsigned xb_xcc_id() { return (unsigned)__builtin_amdgcn_s_getreg((3 << 11) | 20) & 0xFu; }
#define XB_SPIN(cond, bar) do { unsigned _sp = 0; while (cond) { __builtin_amdgcn_s_sleep(1); \
    if ((++_sp & 255u) == 0u) { if (xb_ld(&(bar)[XB_TMO])) break; if (_sp > XB_SPIN_CAP) { atomicAdd(&(bar)[XB_TMO], 1u); break; } } } } while (0)

struct XcdBarrier {
    unsigned* bar; unsigned x;
    volatile LAS unsigned* st;
};

__device__ __forceinline__ XcdBarrier xcd_barrier_post(unsigned* bar, volatile LAS unsigned* st) {
    XcdBarrier b; b.bar = bar; b.x = xb_xcc_id(); b.st = st;
    if (threadIdx.x == 0) (void)xb_add(&bar[XB_XCNT(b.x)], 1u);
    return b;
}
__device__ __forceinline__ void xcd_barrier_complete(unsigned* bar, unsigned x, unsigned& nloc, unsigned& nx) {
    const unsigned G = gridDim.x * gridDim.y * gridDim.z;
    unsigned sum, cnt, mine, sp = 0u;
    for (;;) {
        sum = 0u; cnt = 0u; mine = 0u;
#pragma unroll
        for (unsigned j = 0; j < 16; ++j) { const unsigned c = xb_ld(&bar[XB_XCNT(j)]); sum += c; cnt += (c > 0u) ? 1u : 0u; mine = (j == x) ? c : mine; }
        if (sum == G) break;
        __builtin_amdgcn_s_sleep(1);
        if ((++sp & 255u) == 0u) { if (xb_ld(&bar[XB_TMO])) break; if (sp > XB_SPIN_CAP) { atomicAdd(&bar[XB_TMO], 1u); break; } }
    }
    nloc = mine > 0u ? mine : 1u; nx = cnt > 0u ? cnt : 1u;
}

__device__ __forceinline__ void xcd_barrier(const XcdBarrier& b) {
    asm volatile("s_waitcnt vmcnt(0)" ::: "memory");
    __syncthreads();
    if (threadIdx.x == 0) {
        unsigned* bar = b.bar;
        __builtin_amdgcn_s_waitcnt(0);
        unsigned nloc = b.st[0], nx = b.st[1];
        if (nloc == 0u) { xcd_barrier_complete(bar, b.x, nloc, nx); b.st[0] = nloc; b.st[1] = nx; }
        const unsigned old = xb_add(&bar[XB_XSUB(b.x)], 1u);
        const unsigned gen = old / nloc;
        if (old + 1u == (gen + 1u) * nloc) {
            __builtin_amdgcn_fence(__ATOMIC_RELEASE, "agent");
            asm volatile("s_waitcnt vmcnt(0)" ::: "memory");
            const unsigned og = xb_add(&bar[XB_TOP], 1u);
            const unsigned tg = og / nx;
            if (og + 1u == (tg + 1u) * nx) xb_add(&bar[XB_TOPGEN], 1u);
            else XB_SPIN(xb_ld(&bar[XB_TOPGEN]) == tg, bar);
            __builtin_amdgcn_fence(__ATOMIC_ACQUIRE, "agent");
            xb_add(&bar[XB_XGEN(b.x)], 1u);
            asm volatile("s_waitcnt vmcnt(0)" ::: "memory");
        } else {
            XB_SPIN(xb_ld(&bar[XB_XGEN(b.x)]) == gen, bar);
            __builtin_amdgcn_fence(__ATOMIC_ACQUIRE, "agent");
            asm volatile("s_waitcnt vmcnt(0)" ::: "memory");
        }
    }
    __syncthreads();
}

#define MFMA32(a_, b_, c_) __builtin_amdgcn_mfma_f32_32x32x16_bf16((a_), (b_), (c_), 0, 0, 0)
#define MFMA16(a_, b_, c_) __builtin_amdgcn_mfma_f32_16x16x32_bf16((a_), (b_), (c_), 0, 0, 0)
__device__ __forceinline__ v4u ldg16(const bf16* p) { return *(const v4u*)p; }
__device__ __forceinline__ void load_shift8(const bf16* proj, int row, int col, const float* mu, float (&o)[8]) {
    const v4u p = ldg16(proj + (size_t)row * NINP + col); v4u q = {0u, 0u, 0u, 0u};
    if (row > 0) q = ldg16(proj + (size_t)(row - 1) * NINP + col);
    float pf[8], qf[8]; unpack8(p, pf); unpack8(q, qf);
    const f32x4 m0 = *(const f32x4*)(mu + col), m1 = *(const f32x4*)(mu + col + 4);
    const float mf[8] = {m0.x, m0.y, m0.z, m0.w, m1.x, m1.y, m1.z, m1.w};
#pragma unroll
    for (int j = 0; j < 8; ++j) o[j] = pf[j] + (qf[j] - pf[j]) * mf[j];
}
__device__ __forceinline__ void ld8f(const float* p, float (&o)[8]) { const f32x4 a = *(const f32x4*)p, b = *(const f32x4*)(p + 4); o[0] = a.x; o[1] = a.y; o[2] = a.z; o[3] = a.w; o[4] = b.x; o[5] = b.y; o[6] = b.z; o[7] = b.w; }

constexpr int VP = 168;
__device__ __forceinline__ void attn_unit(const Args& a, LAS unsigned char* lds, int unit, int tid, int wave, int lane) {
    const bf16* proj = (const bf16*)(a.ws + WS_PROJ); bf16* mix = (bf16*)(a.ws + WS_MIX);
    const int qb = unit >> 1, kvh = unit & 1, q0 = qb * 32, kbase = q0 - 128, hq = kvh * 8 + wave;
    LAS bf16* VT = (LAS bf16*)lds;
    const int r = lane & 31, h = lane >> 5;
    bf16x8 bq[4];
    { const bf16* qrow = proj + (size_t)(q0 + r) * NINP + C_AQ + hq * 64 + 8 * h;
#pragma unroll
      for (int s = 0; s < 4; ++s) bq[s] = *(const bf16x8*)(qrow + 16 * s); }
    const float slope = exp2f(-0.5f * (float)(hq + 1)), sink = a.in[13][hq];
    f32x16 sc[5]; float mx = sink;
    bf16x8 kf[5][4];
#pragma unroll
    for (int kt = 0; kt < 5; ++kt) { const int tkb = kbase + 32 * kt;
        if (tkb >= 0) { const bf16* krow = proj + (size_t)(tkb + r) * NINP + C_AK + kvh * 64 + 8 * h;
#pragma unroll
            for (int s = 0; s < 4; ++s) kf[kt][s] = *(const bf16x8*)(krow + 16 * s); } }
    v2u gpre[2][4];
#pragma unroll
    for (int dt = 0; dt < 2; ++dt)
#pragma unroll
        for (int g4 = 0; g4 < 4; ++g4) gpre[dt][g4] = *(const v2u*)(proj + (size_t)(q0 + r) * NINP + C_AG + hq * 64 + 32 * dt + 8 * g4 + 4 * h);
    bar_lds();
    for (int idx = tid; idx < 160 * 8; idx += NTHR) {
        const int key = idx >> 3, d8 = (idx & 7) * 8, tk = kbase + key;
        v4u p = {0u, 0u, 0u, 0u};
        if (tk >= 0) p = ldg16(proj + (size_t)tk * NINP + C_AV + kvh * 64 + d8);
        const unsigned w[4] = {p.x, p.y, p.z, p.w};
#pragma unroll
        for (int j = 0; j < 4; ++j) { VT[(d8 + 2 * j) * VP + key] = (bf16)(w[j] & 0xffffu); VT[(d8 + 2 * j + 1) * VP + key] = (bf16)(w[j] >> 16); }
    }
    bar_lds();
    const float L2E = 1.44269504f, SA = 0.125f * L2E, SB = slope * L2E, sinkl = sink * L2E;
    mx = sinkl;
#pragma unroll
    for (int kt = 0; kt < 5; ++kt) {
        const int tkb = kbase + 32 * kt;
        if (tkb >= 0) {
            f32x16 acc; for (int i = 0; i < 16; ++i) acc[i] = 0.f;
#pragma unroll
            for (int s = 0; s < 4; ++s) acc = MFMA32(kf[kt][s], bq[s], acc);
            const int dli = (q0 + r) - tkb - 4 * h; const float base = -SB * (float)dli;
#pragma unroll
            for (int i = 0; i < 16; ++i) {
                const int ci = (i & 3) + 8 * (i >> 2);
                float v = __builtin_fmaf(acc[i], SA, __builtin_fmaf(SB, (float)ci, base));
                if (kt == 0) v = (dli - ci < 128) ? v : -1e30f;
                if (kt == 4) v = (dli - ci >= 0) ? v : -1e30f;
                sc[kt][i] = v; mx = fmaxf(mx, v);
            }
        } else {
#pragma unroll
            for (int i = 0; i < 16; ++i) sc[kt][i] = -1e30f;
        }
    }
    mx = fmaxf(mx, __shfl_xor(mx, 32));
    float sum = 0.f;
#pragma unroll
    for (int kt = 0; kt < 5; ++kt)
#pragma unroll
        for (int i = 0; i < 16; ++i) { const float p = __builtin_amdgcn_exp2f(sc[kt][i] - mx); sc[kt][i] = p; sum += p; }
    sum += __shfl_xor(sum, 32); sum += __builtin_amdgcn_exp2f(sinkl - mx);
    f32x16 o[2]; for (int i = 0; i < 16; ++i) { o[0][i] = 0.f; o[1][i] = 0.f; }
#pragma unroll
    for (int kt = 0; kt < 5; ++kt) {
        if (kbase + 32 * kt >= 0) {
#pragma unroll
            for (int s = 0; s < 2; ++s) {
                v4u pw; pw.x = pk2(sc[kt][8 * s + 0], sc[kt][8 * s + 1]); pw.y = pk2(sc[kt][8 * s + 2], sc[kt][8 * s + 3]); pw.z = pk2(sc[kt][8 * s + 4], sc[kt][8 * s + 5]); pw.w = pk2(sc[kt][8 * s + 6], sc[kt][8 * s + 7]);
                const bf16x8 pb = __builtin_bit_cast(bf16x8, pw);
#pragma unroll
                for (int dt = 0; dt < 2; ++dt) {
                    const LAS bf16* vp = VT + (32 * dt + r) * VP + 32 * kt + 16 * s + 4 * h;
                    const v2u lo = *(const LAS v2u*)vp, hi = *(const LAS v2u*)(vp + 8);
                    v4u vw; vw.x = lo.x; vw.y = lo.y; vw.z = hi.x; vw.w = hi.y;
                    o[dt] = MFMA32(__builtin_bit_cast(bf16x8, vw), pb, o[dt]);
                }
            }
        }
    }
    const float inv = 1.f / sum;
#pragma unroll
    for (int dt = 0; dt < 2; ++dt)
#pragma unroll
        for (int g4 = 0; g4 < 4; ++g4) {
            const int d0 = 32 * dt + 8 * g4 + 4 * h;
            float g0, g1, g2, g3;
            { const v2u gp = gpre[dt][g4]; g0 = bflo(gp.x); g1 = bfhi(gp.x); g2 = bflo(gp.y); g3 = bfhi(gp.y); }
            v2u w; w.x = pk2(o[dt][4 * g4 + 0] * inv * siluf_(g0), o[dt][4 * g4 + 1] * inv * siluf_(g1));
            w.y = pk2(o[dt][4 * g4 + 2] * inv * siluf_(g2), o[dt][4 * g4 + 3] * inv * siluf_(g3));
            *(v2u*)(mix + (size_t)(q0 + r) * D + RW + hq * 64 + d0) = w;
        }
}

struct Prep { float r[8], kp[8], v[8], g[8], w[8], lw[8], kk[8], b[8], bonus; };
__device__ __forceinline__ void rwkv_prep(const Args& a, LAS unsigned char* lds, int h, int t0, int tid, int wave, int lane, Prep& P) {
    const bf16* proj = (const bf16*)(a.ws + WS_PROJ); const bf16* upt = (const bf16*)(a.ws + WS_UPT); const bf16* aupt = upt + 65536;
    LAS bf16* TW = (LAS bf16*)lds; LAS bf16* ADm = TW + 64 * 72; LAS float* Z = (LAS float*)(lds + 18432); LAS float* AP = Z + 64 * 68;
    const int t = tid >> 3, c8 = (tid & 7) * 8, ch = h * 64 + c8, row = t0 + t;
    const float* mu = a.in[3];
    { float x[8]; load_shift8(proj, row, C_WD + c8, mu, x);
#pragma unroll
      for (int j = 0; j < 8; ++j) x[j] = 1.f - 2.f * __builtin_amdgcn_rcpf(1.f + __expf(2.f * x[j]));
      *(LAS v4u*)(TW + t * 72 + c8) = pack8(x);
      load_shift8(proj, row, C_AD + c8, mu, x); *(LAS v4u*)(ADm + t * 72 + c8) = pack8(x); }
    bar_lds();
    { const int rt = wave & 3, cp = (wave >> 2) * 2, fr = lane & 15, fq = lane >> 4;
      bf16x8 aT[2], aA[2];
#pragma unroll
      for (int s = 0; s < 2; ++s) { aT[s] = *(const LAS bf16x8*)(TW + (16 * rt + fr) * 72 + 32 * s + 8 * fq); aA[s] = *(const LAS bf16x8*)(ADm + (16 * rt + fr) * 72 + 32 * s + 8 * fq); }
#pragma unroll
      for (int ci = 0; ci < 2; ++ci) { const int ct = cp + ci; f32x4 z = {0.f, 0.f, 0.f, 0.f}, ap = {0.f, 0.f, 0.f, 0.f};
#pragma unroll
          for (int s = 0; s < 2; ++s) { const size_t bo = (size_t)(h * 64 + 16 * ct + fr) * 64 + 32 * s + 8 * fq;
              z = MFMA16(aT[s], *(const bf16x8*)(upt + bo), z); ap = MFMA16(aA[s], *(const bf16x8*)(aupt + bo), ap); }
#pragma unroll
          for (int j = 0; j < 4; ++j) { Z[(16 * rt + 4 * fq + j) * 68 + 16 * ct + fr] = z[j]; AP[(16 * rt + 4 * fq + j) * 68 + 16 * ct + fr] = ap[j]; } } }
    bar_lds();
    float zz[8], aa[8], kr[8], c0[8], c1[8];
#pragma unroll
    for (int j = 0; j < 8; ++j) { zz[j] = Z[t * 68 + c8 + j]; aa[j] = AP[t * 68 + c8 + j]; }
    load_shift8(proj, row, C_R + ch, mu, P.r); load_shift8(proj, row, C_K + ch, mu, kr); load_shift8(proj, row, C_V + ch, mu, P.v); load_shift8(proj, row, C_G + ch, mu, P.g);
    ld8f(a.in[4] + ch, c0); ld8f(a.in[6] + ch, c1);
#pragma unroll
    for (int j = 0; j < 8; ++j) { const float z = c0[j] + zz[j]; const float sp = (z < -15.f) ? -z : __logf(1.f + __expf(-z)); const float wl = -sp - 0.5f; P.lw[j] = -__expf(wl); P.w[j] = __expf(P.lw[j]); aa[j] = sigmoidf_(c1[j] + aa[j]); }
    ld8f(a.in[8] + ch, c0); ld8f(a.in[9] + ch, c1);
    float ss = 0.f;
#pragma unroll
    for (int j = 0; j < 8; ++j) { P.kk[j] = kr[j] * c0[j]; ss += P.kk[j] * P.kk[j]; P.kp[j] = kr[j] * (1.f + (aa[j] - 1.f) * c1[j]); }
    ss = sum8(ss); const float rn = 1.f / fmaxf(sqrtf(ss), 1e-12f);
    ld8f(a.in[10] + ch, c0);
    float bs = 0.f;
#pragma unroll
    for (int j = 0; j < 8; ++j) { P.kk[j] *= rn; P.b[j] = P.kk[j] * aa[j]; bs += P.r[j] * P.kp[j] * c0[j]; }
    P.bonus = sum8(bs);
}
__device__ __forceinline__ void rwkv_out8(const Args& a, const float (&y)[8], const float (&v)[8], const float (&g)[8], float bonus, int row, int ch) {
    bf16* mix = (bf16*)(a.ws + WS_MIX);
    float s = 0.f;
#pragma unroll
    for (int j = 0; j < 8; ++j) s += y[j];
    const float mean = sum8(s) * (1.f / 64.f); float q = 0.f;
#pragma unroll
    for (int j = 0; j < 8; ++j) { const float d = y[j] - mean; q += d * d; }
    const float rstd = 1.f / sqrtf(sum8(q) * (1.f / 64.f) + LNX_EPS);
    float lg[8], lb[8], o[8]; ld8f(a.in[11] + ch, lg); ld8f(a.in[12] + ch, lb);
#pragma unroll
    for (int j = 0; j < 8; ++j) { const float yn = (y[j] - mean) * rstd * lg[j] + lb[j] + bonus * v[j]; o[j] = yn * siluf_(g[j]); }
    *(v4u*)(mix + (size_t)row * D + ch) = pack8(o);
}
constexpr size_t WS_MF = 174 * MiB, WS_QF = 190 * MiB, WS_SF = 206 * MiB, WS_BON = 222 * MiB;
constexpr size_t OUT_NF = 0, OUT_Y2 = 32 * MiB;
constexpr int MP = 72;
constexpr int L_AT = 0, L_ATT = 9216, L_BT = 18432, L_KT = 27648, L_RT = 36864, L_BHT = 46080, L_KHT = 55296, L_VT = 64512, L_LW = 73728, L_P = 73728, L_PT = 82944,
              L_AAK = 92160, L_ARB = 101376, L_ARK = 110592, L_TM = 119808, L_SEG = 119808, L_GC = 129024, L_WT = L_AT, L_X1T = L_BT, L_U2T = L_KT;
struct WTile { int ta, tb0, fr, fq; };
__device__ __forceinline__ bf16x8 ldfrag(const LAS bf16* M, int tile, int s, const WTile& w) { return *(const LAS bf16x8*)(M + (16 * tile + w.fr) * MP + 32 * s + 8 * w.fq); }
__device__ __forceinline__ void mm2(const LAS bf16* A, const LAS bf16* B, const WTile& w, f32x4 (&acc)[2]) {
#pragma unroll
    for (int s = 0; s < 2; ++s) { const bf16x8 af = ldfrag(A, w.ta, s, w);
#pragma unroll
        for (int ci = 0; ci < 2; ++ci) acc[ci] = MFMA16(af, ldfrag(B, w.tb0 + ci, s, w), acc[ci]); }
}
__device__ __forceinline__ void st_T(LAS bf16* X, int ta, int tb, const WTile& w, const f32x4& v) { v2u o; o.x = pk2(v[0], v[1]); o.y = pk2(v[2], v[3]); *(LAS v2u*)(X + (16 * tb + w.fr) * MP + 16 * ta + 4 * w.fq) = o; }
__device__ __forceinline__ void st_N(LAS bf16* X, int ta, int tb, const WTile& w, const f32x4& v) {
    const unsigned a = pk2(v[0], v[1]), b = pk2(v[2], v[3]); LAS bf16* p = X + (16 * ta + 4 * w.fq) * MP + 16 * tb + w.fr;
    p[0] = (bf16)(a & 0xffffu); p[MP] = (bf16)(a >> 16); p[2 * MP] = (bf16)(b & 0xffffu); p[3 * MP] = (bf16)(b >> 16);
}
#define ZERO2(x) do { x[0] = (f32x4){0.f, 0.f, 0.f, 0.f}; x[1] = (f32x4){0.f, 0.f, 0.f, 0.f}; } while (0)
template <int MODE> __device__ __forceinline__ void mask2(f32x4 (&acc)[2], const WTile& w) {
#pragma unroll
    for (int ci = 0; ci < 2; ++ci)
#pragma unroll
        for (int j = 0; j < 4; ++j) { const int row = 16 * w.ta + 4 * w.fq + j, col = 16 * (w.tb0 + ci) + w.fr;
            const bool keep = MODE == 0 ? (row < col) : (MODE == 1 ? (row <= col) : (col < row)); if (!keep) acc[ci][j] = 0.f; }
}
__device__ __forceinline__ void st_bf16x8_T2(LAS bf16* X, int c8, int t, int lane, const float (&v)[8]) {
    const v4u p = pack8(v); const unsigned w[4] = {p.x, p.y, p.z, p.w}; const bool odd = (lane >> 3) & 1;
#pragma unroll
    for (int j = 0; j < 4; ++j) {
        const unsigned q = (unsigned)__builtin_amdgcn_update_dpp(0, (int)w[j], 0x128  , 0xf, 0xf, false);
        const unsigned o = odd ? ((q >> 16) | (w[j] & 0xffff0000u)) : ((w[j] & 0xffffu) | (q << 16));
        *(LAS unsigned*)(X + (c8 + 2 * j + (odd ? 1 : 0)) * MP + (t & ~1)) = o;
    }
}
__device__ __forceinline__ void st_bf16x8_T(LAS bf16* X, int c8, int t, const float (&v)[8]) {
    const v4u p = pack8(v); const unsigned w[4] = {p.x, p.y, p.z, p.w};
#pragma unroll
    for (int j = 0; j < 4; ++j) { X[(c8 + 2 * j) * MP + t] = (bf16)(w[j] & 0xffffu); X[(c8 + 2 * j + 1) * MP + t] = (bf16)(w[j] >> 16); }
}

__device__ __forceinline__ void rwkv_chunk_prep(const Args& a, LAS unsigned char* lds, int unit, int tid, int wave, int lane) {
    const int c = unit >> 4, h = unit & 15, t0 = c * CH, t = tid >> 3, c8 = (tid & 7) * 8;
    LAS bf16* At = (LAS bf16*)(lds + L_AT); LAS bf16* AtT = (LAS bf16*)(lds + L_ATT); LAS bf16* Bt = (LAS bf16*)(lds + L_BT); LAS bf16* Kt = (LAS bf16*)(lds + L_KT);
    LAS bf16* Rt = (LAS bf16*)(lds + L_RT); LAS bf16* BhT = (LAS bf16*)(lds + L_BHT); LAS bf16* KhT = (LAS bf16*)(lds + L_KHT); LAS bf16* VT = (LAS bf16*)(lds + L_VT);
    LAS float* LW = (LAS float*)(lds + L_LW); LAS bf16* Pm = (LAS bf16*)(lds + L_P); LAS bf16* PT = (LAS bf16*)(lds + L_PT);
    LAS bf16* AAK = (LAS bf16*)(lds + L_AAK); LAS bf16* ARB = (LAS bf16*)(lds + L_ARB); LAS bf16* ARK = (LAS bf16*)(lds + L_ARK); LAS bf16* TM = (LAS bf16*)(lds + L_TM);
    LAS float* SEG = (LAS float*)(lds + L_SEG); LAS float* GC = (LAS float*)(lds + L_GC);
    LAS bf16* WT = (LAS bf16*)(lds + L_WT); LAS bf16* X1T = (LAS bf16*)(lds + L_X1T); LAS bf16* U2T = (LAS bf16*)(lds + L_U2T);
    bar_lds();
    Prep P; rwkv_prep(a, lds, h, t0, tid, wave, lane, P);
#ifdef PROBE_PREP2
    bar_lds(); rwkv_prep(a, lds, h, t0, tid, wave, lane, P);
#endif
    if ((tid & 7) == 0) ((float*)(a.ws + WS_BON))[(size_t)(t0 + t) * 16 + h] = P.bonus;
#pragma unroll
    for (int j = 0; j < 8; ++j) LW[t * 68 + c8 + j] = P.lw[j];
    bar_lds();
    { const int cc = tid & 63, sg = tid >> 6; float run = 0.f;
#pragma unroll
      for (int i = 0; i < 8; ++i) { run += LW[(8 * sg + i) * 68 + cc]; LW[(8 * sg + i) * 68 + cc] = run; }
      SEG[sg * 64 + cc] = run; }
    bar_lds();
    {
        float Lt[8], LC[8];
#pragma unroll
        for (int j = 0; j < 8; ++j) { float off = 0.f, tot = 0.f;
#pragma unroll
            for (int s = 0; s < 8; ++s) { const float sv = SEG[s * 64 + c8 + j]; tot += sv; if (s < (t >> 3)) off += sv; }
            Lt[j] = LW[t * 68 + c8 + j] + off; LC[j] = tot; }
        if (t == 0) {
#pragma unroll
            for (int j = 0; j < 8; ++j) GC[c8 + j] = __expf(LC[j]); }
        float x[8], y[8];
#pragma unroll
        for (int j = 0; j < 8; ++j) x[j] = -P.kk[j] * __expf(Lt[j] - P.lw[j]);
        *(LAS v4u*)(At + t * MP + c8) = pack8(x); st_bf16x8_T(AtT, c8, t, x);
#pragma unroll
        for (int j = 0; j < 8; ++j) { const float e = __expf(-Lt[j]); x[j] = P.b[j] * e; y[j] = P.kp[j] * e; }
        *(LAS v4u*)(Bt + t * MP + c8) = pack8(x); *(LAS v4u*)(Kt + t * MP + c8) = pack8(y);
#pragma unroll
        for (int j = 0; j < 8; ++j) x[j] = P.r[j] * __expf(Lt[j]);
        *(LAS v4u*)(Rt + t * MP + c8) = pack8(x);
#pragma unroll
        for (int j = 0; j < 8; ++j) { const float e = __expf(LC[j] - Lt[j]); x[j] = P.b[j] * e; y[j] = P.kp[j] * e; }
        st_bf16x8_T(BhT, c8, t, x); st_bf16x8_T(KhT, c8, t, y); st_bf16x8_T(VT, c8, t, P.v);
    }
    bar_lds();
    WTile w; w.ta = wave & 3; w.tb0 = (wave >> 2) * 2; w.fr = lane & 15; w.fq = lane >> 4;
    f32x4 acc[2], Tacc[2];
    ZERO2(Tacc); mm2(At, Bt, w, Tacc); mask2<2>(Tacc, w);
    ZERO2(acc); mm2(Kt, At, w, acc); mask2<0>(acc, w);
    f32x4 rb[2], rk[2]; ZERO2(rb); mm2(Bt, Rt, w, rb); mask2<1>(rb, w); ZERO2(rk); mm2(Kt, Rt, w, rk); mask2<1>(rk, w);
    bar_lds();
#pragma unroll
    for (int ci = 0; ci < 2; ++ci) { st_N(Pm, w.ta, w.tb0 + ci, w, Tacc[ci]); st_T(PT, w.ta, w.tb0 + ci, w, Tacc[ci]);
        st_T(AAK, w.ta, w.tb0 + ci, w, acc[ci]); st_T(ARB, w.ta, w.tb0 + ci, w, rb[ci]); st_T(ARK, w.ta, w.tb0 + ci, w, rk[ci]);
#pragma unroll
        for (int j = 0; j < 4; ++j) if (16 * w.ta + 4 * w.fq + j == 16 * (w.tb0 + ci) + w.fr) Tacc[ci][j] += 1.f;
        st_N(TM, w.ta, w.tb0 + ci, w, Tacc[ci]); }
    bar_lds();
#pragma unroll 1
#ifdef PROBE_NEU2
    for (int n = 0; n < 10; ++n) {
#else
    for (int n = 0; n < 5; ++n) {
#endif
        ZERO2(acc); mm2(Pm, PT, w, acc);
        bar_lds();
#pragma unroll
        for (int ci = 0; ci < 2; ++ci) { st_N(Pm, w.ta, w.tb0 + ci, w, acc[ci]); st_T(PT, w.ta, w.tb0 + ci, w, acc[ci]); }
        bar_lds();
        mm2(TM, PT, w, Tacc);
        bar_lds();
#pragma unroll
        for (int ci = 0; ci < 2; ++ci) st_N(TM, w.ta, w.tb0 + ci, w, Tacc[ci]);
        bar_lds();
    }
    ZERO2(acc); mm2(TM, AtT, w, acc); ZERO2(rb); mm2(AAK, VT, w, rb);
#pragma unroll
    for (int ci = 0; ci < 2; ++ci) { st_T(WT, w.ta, w.tb0 + ci, w, acc[ci]); st_T(X1T, w.ta, w.tb0 + ci, w, rb[ci]); }
    bar_lds();
    const size_t ub = (size_t)unit * 4096;
    { ZERO2(acc); mm2(TM, X1T, w, acc);
#pragma unroll
      for (int ci = 0; ci < 2; ++ci) st_T(U2T, w.ta, w.tb0 + ci, w, acc[ci]);
      bf16* MF = (bf16*)(a.ws + WS_MF) + ub; bf16* QF = (bf16*)(a.ws + WS_QF) + ub;
      ZERO2(acc); mm2(WT, BhT, w, acc);
      ZERO2(rb); mm2(WT, ARB, w, rb);
#pragma unroll
      for (int ci = 0; ci < 2; ++ci) { const int tb = w.tb0 + ci; const int col = 16 * tb + w.fr; const float gc = GC[col];
          f32x4 m = acc[ci];
#pragma unroll
          for (int j = 0; j < 4; ++j) if (16 * w.ta + 4 * w.fq + j == col) m[j] += gc;
          const size_t fo = (size_t)((tb * 2 + (w.ta >> 1)) * 64 + lane) * 8 + 4 * (w.ta & 1);
          v2u o; o.x = pk2(m[0], m[1]); o.y = pk2(m[2], m[3]); *(v2u*)(MF + fo) = o;
          const v2u rr = *(const LAS v2u*)(Rt + col * MP + 16 * w.ta + 4 * w.fq);
          f32x4 q = rb[ci]; q[0] += bflo(rr.x); q[1] += bfhi(rr.x); q[2] += bflo(rr.y); q[3] += bfhi(rr.y);
          o.x = pk2(q[0], q[1]); o.y = pk2(q[2], q[3]); *(v2u*)(QF + fo) = o; } }
    bar_lds();
    { float* NF = (float*)((unsigned char*)a.out + OUT_NF) + ub; float* Y2 = (float*)((unsigned char*)a.out + OUT_Y2) + ub;
      ZERO2(acc); mm2(BhT, U2T, w, acc); mm2(KhT, VT, w, acc);
      ZERO2(rb); mm2(U2T, ARB, w, rb); mm2(VT, ARK, w, rb);
#pragma unroll
      for (int ci = 0; ci < 2; ++ci) { const int tb = w.tb0 + ci;
          *(f32x4*)(NF + (size_t)((tb * 4 + w.ta) * 64 + lane) * 4) = acc[ci];
          *(f32x4*)(Y2 + (size_t)(16 * tb + w.fr) * 64 + 16 * w.ta + 4 * w.fq) = rb[ci]; } }
}

#ifndef HSPLIT_V
#define HSPLIT_V 64
#endif
constexpr int HSPLIT = HSPLIT_V;
constexpr int KR = 4, NR = NCH / KR, SLOT = 10240, RBUF = KR * SLOT, NPIECE = RBUF / 16, LPT = 6, PPC = SLOT / 16;
__device__ __forceinline__ const v4u* sp_src(const Args& a, int h, int cg, int r, int p) {
    const int cc = p / PPC, q = p % PPC, c = r * KR + cc; const size_t ub = (size_t)(c * 16 + h) * 4096;
    return q < 512 ? (const v4u*)((const bf16*)(a.ws + WS_MF) + ub) + q : (const v4u*)((const bf16*)((const unsigned char*)a.out + OUT_NF) + ub + cg * 1024) + (q - 512);
}
__device__ __forceinline__ void state_pass(const Args& a, LAS unsigned char* lds, int b, int tid, int wave, int lane) {
    unsigned* half_flag = (unsigned*)a.ws + 7168;
    const int h = b & 15, cg = b >> 4, lt = tid - 64;
    v4u ra[LPT], rb[LPT];
    if (wave != 0) {
#pragma unroll
        for (int i = 0; i < LPT; ++i) { const int p = lt + 448 * i; if (p < NPIECE) ra[i] = *sp_src(a, h, cg, 0, p); }
#pragma unroll
        for (int i = 0; i < LPT; ++i) { const int p = lt + 448 * i; if (p < NPIECE) *(LAS v4u*)(lds + p * 16) = ra[i]; }
#pragma unroll
        for (int i = 0; i < LPT; ++i) { const int p = lt + 448 * i; if (p < NPIECE) ra[i] = *sp_src(a, h, cg, 1, p); }
    }
    f32x4 st[4];
#pragma unroll
    for (int i = 0; i < 4; ++i) st[i] = (f32x4){0.f, 0.f, 0.f, 0.f};
    bar_lds();
    bf16* SF = (bf16*)(a.ws + WS_SF);
#define SP_ROUND(r_, RA, RB) do { \
        if (wave != 0) { \
            if ((r_) + 2 < NR) { _Pragma("unroll") for (int i = 0; i < LPT; ++i) { const int p = lt + 448 * i; if (p < NPIECE) RB[i] = *sp_src(a, h, cg, (r_) + 2, p); } } \
            if ((r_) + 1 < NR) { _Pragma("unroll") for (int i = 0; i < LPT; ++i) { const int p = lt + 448 * i; if (p < NPIECE) *(LAS v4u*)(lds + (((r_) + 1) & 1) * RBUF + p * 16) = RA[i]; } } \
        } else { \
            if ((r_) == HSPLIT / KR && lane == 0) { __threadfence(); __hip_atomic_fetch_add(half_flag, 1u, __ATOMIC_RELEASE, __HIP_MEMORY_SCOPE_AGENT); }     \
            _Pragma("unroll") for (int cc = 0; cc < KR; ++cc) { \
                const LAS unsigned char* sl = lds + ((r_) & 1) * RBUF + cc * SLOT; const int c = (r_) * KR + cc; \
                v4u b0, b1; b0.x = pk2(st[0][0], st[0][1]); b0.y = pk2(st[0][2], st[0][3]); b0.z = pk2(st[1][0], st[1][1]); b0.w = pk2(st[1][2], st[1][3]); \
                b1.x = pk2(st[2][0], st[2][1]); b1.y = pk2(st[2][2], st[2][3]); b1.z = pk2(st[3][0], st[3][1]); b1.w = pk2(st[3][2], st[3][3]); \
                v4u* sfo = (v4u*)(SF + (size_t)(c * 16 + h) * 4096) + (cg * 2) * 64 + lane; sfo[0] = b0; sfo[64] = b1; \
                const bf16x8 f0 = __builtin_bit_cast(bf16x8, b0), f1 = __builtin_bit_cast(bf16x8, b1); \
                _Pragma("unroll") for (int rt = 0; rt < 4; ++rt) { \
                    const v2u nb_ = *(const LAS v2u*)(sl + 8192 + (rt * 64 + lane) * 8); f32x4 n = {bflo(nb_.x), bfhi(nb_.x), bflo(nb_.y), bfhi(nb_.y)}; \
                    n = MFMA16(*(const LAS bf16x8*)(sl + ((rt * 2 + 0) * 64 + lane) * 16), f0, n); \
                    n = MFMA16(*(const LAS bf16x8*)(sl + ((rt * 2 + 1) * 64 + lane) * 16), f1, n); st[rt] = n; } \
            } \
        } \
        bar_lds(); } while (0)
#pragma unroll 1
    for (int r = 0; r < NR; r += 2) { SP_ROUND(r, ra, rb); SP_ROUND(r + 1, rb, ra); }
#undef SP_ROUND
}

__device__ __forceinline__ void rwkv_out_unit(const Args& a, LAS unsigned char* lds, int unit, int tid, int wave, int lane) {
    const int c = unit >> 4, h = unit & 15, t0 = c * CH, t = tid >> 3, c8 = (tid & 7) * 8, ch = h * 64 + c8;
    const size_t ub = (size_t)unit * 4096;
    const bf16* QF = (const bf16*)(a.ws + WS_QF) + ub; const bf16* SF = (const bf16*)(a.ws + WS_SF) + ub; const bf16* Y2 = (const bf16*)((const unsigned char*)a.out + OUT_Y2) + ub;
    LAS float* SY = (LAS float*)lds;
    const int ta = wave & 3, tb0 = (wave >> 2) * 2, fr = lane & 15, fq = lane >> 4;
    bf16x8 af[2], bfr[2][2];
#pragma unroll
    for (int s = 0; s < 2; ++s) { af[s] = *(const bf16x8*)(QF + (size_t)((ta * 2 + s) * 64 + lane) * 8);
#pragma unroll
        for (int ci = 0; ci < 2; ++ci) bfr[s][ci] = *(const bf16x8*)(SF + (size_t)(((tb0 + ci) * 2 + s) * 64 + lane) * 8); }
    float y2[8], v[8], g[8];
    unpack8(ldg16(Y2 + t * 64 + c8), y2);
    const bf16* proj = (const bf16*)(a.ws + WS_PROJ);
    load_shift8(proj, t0 + t, C_V + ch, a.in[3], v); load_shift8(proj, t0 + t, C_G + ch, a.in[3], g);
    const float bonus = ((const float*)(a.ws + WS_BON))[(size_t)(t0 + t) * 16 + h];
    f32x4 acc[2]; ZERO2(acc);
#pragma unroll
    for (int s = 0; s < 2; ++s)
#pragma unroll
        for (int ci = 0; ci < 2; ++ci) acc[ci] = MFMA16(af[s], bfr[s][ci], acc[ci]);
    bar_lds();
#pragma unroll
    for (int ci = 0; ci < 2; ++ci)
#pragma unroll
        for (int j = 0; j < 4; ++j) SY[(16 * ta + 4 * fq + j) * 68 + 16 * (tb0 + ci) + fr] = acc[ci][j];
    bar_lds();
    float y[8];
#pragma unroll
    for (int j = 0; j < 8; ++j) y[j] = SY[t * 68 + c8 + j] + y2[j];
    rwkv_out8(a, y, v, g, bonus, t0 + t, ch);
}
constexpr int L2_SEG = 129280, L2_XST = 131328, L2_TW = 131584, L2_ADM = 140800, L2_X1T = 150016;
struct PF { v4u p[4], q[4]; };
__device__ __forceinline__ void pf_issue(PF& f, const bf16* proj, int row, int ch) {
    const int cols[4] = {C_R, C_K, C_V, C_G};
#pragma unroll
    for (int i = 0; i < 4; ++i) { f.p[i] = ldg16(proj + (size_t)row * NINP + cols[i] + ch); f.q[i] = (v4u){0u, 0u, 0u, 0u}; if (row > 0) f.q[i] = ldg16(proj + (size_t)(row - 1) * NINP + cols[i] + ch); }
}
__device__ __forceinline__ void pf_shift(const v4u& p, const v4u& q, const float (&mf)[8], float (&o)[8]) {
    float pf[8], qf[8]; unpack8(p, pf); unpack8(q, qf);
#pragma unroll
    for (int j = 0; j < 8; ++j) o[j] = pf[j] + (qf[j] - pf[j]) * mf[j];
}
template <bool DOP, bool DOT, bool CHK = false> __device__ __forceinline__ void neu_stage(const LAS bf16* Pin, const LAS bf16* PTin, LAS bf16* Pout, LAS bf16* PTout, const LAS bf16* TMin, LAS bf16* TMout, const WTile& w, f32x4 (&Tacc)[2], LAS unsigned* flag = nullptr) {
    f32x4 acc[2];
    if (DOP) { ZERO2(acc); mm2(Pin, PTin, w, acc); }
    if (DOP && CHK) {
        float m = 0.f;
#pragma unroll
        for (int ci = 0; ci < 2; ++ci)
#pragma unroll
            for (int j = 0; j < 4; ++j) m = fmaxf(m, fabsf(acc[ci][j]));
        if (m > 1e-4f) atomicMax((unsigned*)flag, __float_as_uint(m));
    }
    if (DOT) mm2(TMin, PTin, w, Tacc);
#pragma unroll
    for (int ci = 0; ci < 2; ++ci) {
        if (DOP) { st_N(Pout, w.ta, w.tb0 + ci, w, acc[ci]); st_T(PTout, w.ta, w.tb0 + ci, w, acc[ci]); }
        if (DOT) st_N(TMout, w.ta, w.tb0 + ci, w, Tacc[ci]);
    }
    bar_lds();
}
__device__ __forceinline__ void rwkv_chunk_group(const Args& a, LAS unsigned char* lds, int item, int tid, int wave, int lane) {
    const int c = item >> 1, hg = item & 1, t0 = c * CH, t = tid >> 3, c8 = (tid & 7) * 8, row = t0 + t;
    const bf16* proj = (const bf16*)(a.ws + WS_PROJ); const bf16* upt = (const bf16*)(a.ws + WS_UPT); const bf16* aupt = upt + 65536; const float* mu = a.in[3];
    LAS bf16* TW = (LAS bf16*)(lds + L2_TW); LAS bf16* ADm = (LAS bf16*)(lds + L2_ADM);
    WTile w; w.ta = wave & 3; w.tb0 = (wave >> 2) * 2; w.fr = lane & 15; w.fq = lane >> 4;
    bar_lds();
    { float x[8]; load_shift8(proj, row, C_WD + c8, mu, x);
#pragma unroll
      for (int j = 0; j < 8; ++j) x[j] = 1.f - 2.f * __builtin_amdgcn_rcpf(1.f + __expf(2.f * x[j]));
      *(LAS v4u*)(TW + t * 72 + c8) = pack8(x);
      load_shift8(proj, row, C_AD + c8, mu, x); *(LAS v4u*)(ADm + t * 72 + c8) = pack8(x); }
    PF pf; pf_issue(pf, proj, row, hg * 512 + c8);
#pragma unroll 1
    for (int hh = 0; hh < 8; ++hh) {
        const int h = hg * 8 + hh, ch = h * 64 + c8, unit = c * 16 + h;
        LAS unsigned char* L = lds; asm volatile("" : "+v"(L));
        LAS bf16* At = (LAS bf16*)(L + L_AT); LAS bf16* AtT = (LAS bf16*)(L + L_ATT); LAS bf16* Bt = (LAS bf16*)(L + L_BT); LAS bf16* Kt = (LAS bf16*)(L + L_KT);
        LAS bf16* Rt = (LAS bf16*)(L + L_RT); LAS bf16* BhT = (LAS bf16*)(L + L_BHT); LAS bf16* KhT = (LAS bf16*)(L + L_KHT); LAS bf16* VT = (LAS bf16*)(L + L_VT);
        LAS bf16* P0 = (LAS bf16*)(L + L_P); LAS bf16* PT0 = (LAS bf16*)(L + L_PT); LAS bf16* TM0 = (LAS bf16*)(L + L_TM);
        LAS bf16* P1 = At; LAS bf16* PT1 = Bt; LAS bf16* TM1 = Kt;
        LAS bf16* AAK = (LAS bf16*)(L + L_AAK); LAS bf16* ARB = (LAS bf16*)(L + L_ARB); LAS bf16* ARK = (LAS bf16*)(L + L_ARK);
        LAS float* SEG = (LAS float*)(L + L2_SEG); LAS float* GC = (LAS float*)(L + L_GC);
        LAS bf16* X1T = (LAS bf16*)(L + L2_X1T);
        LAS float* Z = (LAS float*)(L + 18432); LAS float* AP = Z + 64 * 68;
        LAS bf16* WT = At; LAS bf16* U2T = Bt; LAS unsigned* NFLAG = (LAS unsigned*)(L + 159232);
        bf16x8 bU[2][2], bA[2][2];
#pragma unroll
        for (int ci = 0; ci < 2; ++ci)
#pragma unroll
            for (int s = 0; s < 2; ++s) { const size_t bo = (size_t)(h * 64 + 16 * (w.tb0 + ci) + w.fr) * 64 + 32 * s + 8 * w.fq; bU[ci][s] = *(const bf16x8*)(upt + bo); bA[ci][s] = *(const bf16x8*)(aupt + bo); }
        float pw0[8], pa0[8], pkk[8], pka[8], prk[8], mur[8], muk[8], muv[8];
        ld8f(a.in[4] + ch, pw0); ld8f(a.in[6] + ch, pa0); ld8f(a.in[8] + ch, pkk); ld8f(a.in[9] + ch, pka); ld8f(a.in[10] + ch, prk);
        ld8f(mu + C_R + ch, mur); ld8f(mu + C_K + ch, muk); ld8f(mu + C_V + ch, muv);
        bar_lds();
#ifdef PROBE_G
        if (blockIdx.x == 0 && tid == 0 && hh == 3) ((unsigned long long*)(a.ws + 65536))[0] = __builtin_amdgcn_s_memrealtime();
#endif

        { const int rt = w.ta, cp = w.tb0, fr = w.fr, fq = w.fq;
          bf16x8 aT[2], aA[2];
#pragma unroll
          for (int s = 0; s < 2; ++s) { aT[s] = *(const LAS bf16x8*)(TW + (16 * rt + fr) * 72 + 32 * s + 8 * fq); aA[s] = *(const LAS bf16x8*)(ADm + (16 * rt + fr) * 72 + 32 * s + 8 * fq); }
#pragma unroll
          for (int ci = 0; ci < 2; ++ci) { const int ct = cp + ci; f32x4 z = {0.f, 0.f, 0.f, 0.f}, ap = {0.f, 0.f, 0.f, 0.f};
#pragma unroll
              for (int s = 0; s < 2; ++s) { z = MFMA16(aT[s], bU[ci][s], z); ap = MFMA16(aA[s], bA[ci][s], ap); }
#pragma unroll
              for (int j = 0; j < 4; ++j) { Z[(16 * rt + 4 * fq + j) * 68 + 16 * ct + fr] = z[j]; AP[(16 * rt + 4 * fq + j) * 68 + 16 * ct + fr] = ap[j]; } } }
        bar_lds();
#ifdef PROBE_G
        if (blockIdx.x == 0 && tid == 0 && hh == 3) ((unsigned long long*)(a.ws + 65536))[1] = __builtin_amdgcn_s_memrealtime();
#endif
        float r[8], kp[8], vv[8], lw[8], kk[8], bb[8];
        { float zz[8], aa[8], kr[8];
#pragma unroll
          for (int j = 0; j < 8; ++j) { zz[j] = Z[t * 68 + c8 + j]; aa[j] = AP[t * 68 + c8 + j]; }
          pf_shift(pf.p[0], pf.q[0], mur, r); pf_shift(pf.p[1], pf.q[1], muk, kr); pf_shift(pf.p[2], pf.q[2], muv, vv);
#pragma unroll
          for (int j = 0; j < 8; ++j) { const float z = pw0[j] + zz[j]; lw[j] = -0.60653066f * __builtin_amdgcn_rcpf(1.f + __expf(-z)); aa[j] = sigmoidf_(pa0[j] + aa[j]); }
          float ss = 0.f;
#pragma unroll
          for (int j = 0; j < 8; ++j) { kk[j] = kr[j] * pkk[j]; ss += kk[j] * kk[j]; kp[j] = kr[j] * (1.f + (aa[j] - 1.f) * pka[j]); }
          ss = sum8(ss); const float rn = 1.f / fmaxf(sqrtf(ss), 1e-12f);
          float bs = 0.f;
#pragma unroll
          for (int j = 0; j < 8; ++j) { kk[j] *= rn; bb[j] = kk[j] * aa[j]; bs += r[j] * kp[j] * prk[j]; }
          bs = sum8(bs);
          if ((tid & 7) == 0) ((float*)(a.ws + WS_BON))[(size_t)row * 16 + h] = bs; }
        if (hh < 7) pf_issue(pf, proj, row, ch + 64);
        float Lt[8];
#pragma unroll
        for (int j = 0; j < 8; ++j) { float x = lw[j];
#pragma unroll
            for (int d = 8; d < 64; d <<= 1) { const float y = __shfl_up(x, d); if (lane >= d) x += y; }
            Lt[j] = x; }
        if ((lane >> 3) == 7) {
#pragma unroll
            for (int j = 0; j < 8; ++j) SEG[wave * 64 + c8 + j] = Lt[j]; }
        bar_lds();
        {
            float gc[8], x[8], y[8];
            { float off[8], tot[8];
#pragma unroll
              for (int j = 0; j < 8; ++j) { off[j] = 0.f; tot[j] = 0.f; }
#pragma unroll
              for (int s = 0; s < 8; ++s) { const f32x4 s0 = *(const LAS f32x4*)(SEG + s * 64 + c8), s1 = *(const LAS f32x4*)(SEG + s * 64 + c8 + 4);
                  const float sv[8] = {s0.x, s0.y, s0.z, s0.w, s1.x, s1.y, s1.z, s1.w};
#pragma unroll
                  for (int j = 0; j < 8; ++j) { tot[j] += sv[j]; if (s < wave) off[j] += sv[j]; } }
#pragma unroll
              for (int j = 0; j < 8; ++j) { Lt[j] += off[j]; gc[j] = __expf(tot[j]); } }
            if (t == 0) {
#pragma unroll
                for (int j = 0; j < 8; ++j) GC[c8 + j] = gc[j]; }
            float e1[8], ie1[8];
#pragma unroll
            for (int j = 0; j < 8; ++j) { e1[j] = __expf(Lt[j]); ie1[j] = __builtin_amdgcn_rcpf(e1[j]); }
#pragma unroll
            for (int j = 0; j < 8; ++j) x[j] = -kk[j] * __expf(Lt[j] - lw[j]);
            *(LAS v4u*)(At + t * MP + c8) = pack8(x); st_bf16x8_T2(AtT, c8, t, lane, x);
#pragma unroll
            for (int j = 0; j < 8; ++j) { x[j] = bb[j] * ie1[j]; y[j] = kp[j] * ie1[j]; }
            *(LAS v4u*)(Bt + t * MP + c8) = pack8(x); *(LAS v4u*)(Kt + t * MP + c8) = pack8(y);
#pragma unroll
            for (int j = 0; j < 8; ++j) x[j] = r[j] * e1[j];
            *(LAS v4u*)(Rt + t * MP + c8) = pack8(x);
#pragma unroll
            for (int j = 0; j < 8; ++j) { const float e = gc[j] * ie1[j]; x[j] = bb[j] * e; y[j] = kp[j] * e; }
            st_bf16x8_T2(BhT, c8, t, lane, x); st_bf16x8_T2(KhT, c8, t, lane, y); st_bf16x8_T2(VT, c8, t, lane, vv);
        }
        bar_lds();
#ifdef PROBE_G
        if (blockIdx.x == 0 && tid == 0 && hh == 3) ((unsigned long long*)(a.ws + 65536))[2] = __builtin_amdgcn_s_memrealtime();
#endif
        f32x4 acc[2], Tacc[2], rb[2], rk[2];
        ZERO2(Tacc); mm2(At, Bt, w, Tacc); mask2<2>(Tacc, w);
        ZERO2(acc); mm2(Kt, At, w, acc); mask2<0>(acc, w);
        ZERO2(rb); mm2(Bt, Rt, w, rb); mask2<1>(rb, w); ZERO2(rk); mm2(Kt, Rt, w, rk); mask2<1>(rk, w);
        bar_lds();
#pragma unroll
        for (int ci = 0; ci < 2; ++ci) { st_N(P1, w.ta, w.tb0 + ci, w, Tacc[ci]); st_T(PT1, w.ta, w.tb0 + ci, w, Tacc[ci]);
            st_T(AAK, w.ta, w.tb0 + ci, w, acc[ci]); st_T(ARB, w.ta, w.tb0 + ci, w, rb[ci]); st_T(ARK, w.ta, w.tb0 + ci, w, rk[ci]);
#pragma unroll
            for (int j = 0; j < 4; ++j) if (16 * w.ta + 4 * w.fq + j == 16 * (w.tb0 + ci) + w.fr) Tacc[ci][j] += 1.f;
            st_N(TM1, w.ta, w.tb0 + ci, w, Tacc[ci]); }
        if (tid == 0) *NFLAG = 0u;
        bar_lds();
#ifdef PROBE_G
        if (blockIdx.x == 0 && tid == 0 && hh == 3) ((unsigned long long*)(a.ws + 65536))[3] = __builtin_amdgcn_s_memrealtime();
#endif
        { ZERO2(acc); mm2(AAK, VT, w, acc);
#pragma unroll
          for (int ci = 0; ci < 2; ++ci) st_T(X1T, w.ta, w.tb0 + ci, w, acc[ci]); }
        neu_stage<true, false>(P1, PT1, P0, PT0, nullptr, nullptr, w, Tacc);
        int nrep = 1; asm volatile("" : "+s"(nrep));
#pragma unroll 1
        for (int n = 0; n < nrep; ++n) {
            neu_stage<true, true>(P0, PT0, P1, PT1, TM1, TM0, w, Tacc);
            neu_stage<true, true, true>(P1, PT1, P0, PT0, TM0, TM1, w, Tacc, NFLAG);
        }
        if (*NFLAG != 0u) {
            neu_stage<true, true>(P0, PT0, P1, PT1, TM1, TM0, w, Tacc);
            neu_stage<true, true>(P1, PT1, P0, PT0, TM0, TM1, w, Tacc);
        }
        neu_stage<false, true>(P0, PT0, nullptr, nullptr, TM1, TM0, w, Tacc);

#ifdef PROBE_G
        if (blockIdx.x == 0 && tid == 0 && hh == 3) ((unsigned long long*)(a.ws + 65536))[4] = __builtin_amdgcn_s_memrealtime();
#endif
        ZERO2(acc); mm2(TM0, AtT, w, acc); ZERO2(rb); mm2(TM0, X1T, w, rb);
#pragma unroll
        for (int ci = 0; ci < 2; ++ci) { st_T(WT, w.ta, w.tb0 + ci, w, acc[ci]); st_T(U2T, w.ta, w.tb0 + ci, w, rb[ci]); }
        bar_lds();
        const size_t ub = (size_t)unit * 4096;
        { bf16* MF = (bf16*)(a.ws + WS_MF) + ub; bf16* QF = (bf16*)(a.ws + WS_QF) + ub;
          ZERO2(acc); mm2(WT, BhT, w, acc); ZERO2(rb); mm2(WT, ARB, w, rb);
#pragma unroll
          for (int ci = 0; ci < 2; ++ci) { const int tb = w.tb0 + ci; const int col = 16 * tb + w.fr; const float gcv = GC[col];
              f32x4 m = acc[ci];
#pragma unroll
              for (int j = 0; j < 4; ++j) if (16 * w.ta + 4 * w.fq + j == col) m[j] += gcv;
              const size_t fo = (size_t)((tb * 2 + (w.ta >> 1)) * 64 + lane) * 8 + 4 * (w.ta & 1);
              v2u o; o.x = pk2(m[0], m[1]); o.y = pk2(m[2], m[3]); *(v2u*)(MF + fo) = o;
              const v2u rr = *(const LAS v2u*)(Rt + col * MP + 16 * w.ta + 4 * w.fq);
              f32x4 q = rb[ci]; q[0] += bflo(rr.x); q[1] += bfhi(rr.x); q[2] += bflo(rr.y); q[3] += bfhi(rr.y);
              o.x = pk2(q[0], q[1]); o.y = pk2(q[2], q[3]); *(v2u*)(QF + fo) = o; }
          bf16* NF = (bf16*)((unsigned char*)a.out + OUT_NF) + ub; bf16* Y2 = (bf16*)((unsigned char*)a.out + OUT_Y2) + ub;
          ZERO2(acc); mm2(BhT, U2T, w, acc); mm2(KhT, VT, w, acc);
          ZERO2(rb); mm2(U2T, ARB, w, rb); mm2(VT, ARK, w, rb);
#pragma unroll
          for (int ci = 0; ci < 2; ++ci) { const int tb = w.tb0 + ci;
              v2u o; o.x = pk2(acc[ci][0], acc[ci][1]); o.y = pk2(acc[ci][2], acc[ci][3]); *(v2u*)(NF + (size_t)((tb * 4 + w.ta) * 64 + lane) * 4) = o;
              o.x = pk2(rb[ci][0], rb[ci][1]); o.y = pk2(rb[ci][2], rb[ci][3]); *(v2u*)(Y2 + (size_t)(16 * tb + w.fr) * 64 + 16 * w.ta + 4 * w.fq) = o; } }

#ifdef PROBE_G
        if (blockIdx.x == 0 && tid == 0 && hh == 3) ((unsigned long long*)(a.ws + 65536))[5] = __builtin_amdgcn_s_memrealtime();
#endif
    }
}
#ifndef HOSTDUP
#define HOSTDUP -1
#endif
#ifndef ONE_LAUNCH
#define ONE_LAUNCH 1
#endif
#if HOSTDUP != -1 || defined(MULTI)
#undef ONE_LAUNCH
#define ONE_LAUNCH 0
#endif
constexpr int NPHASE = 7;
__global__ void __launch_bounds__(NTHR, 2) mega(Args a) {
    extern __shared__ __attribute__((aligned(16))) unsigned char lds_[];
    LAS unsigned char* lds = (LAS unsigned char*)lds_;
    const int tid = threadIdx.x, lane = tid & 63, wave = __builtin_amdgcn_readfirstlane(tid >> 6);
    const int G = gridDim.x, bx = blockIdx.x, vcu = (G % 8 == 0) ? (bx % 8) * (G / 8) + bx / 8 : bx;
    cg::grid_group grid = cg::this_grid();
    volatile LAS unsigned* xst = (volatile LAS unsigned*)(lds + L2_XST);
    if (tid < 2) xst[tid] = 0u;
    __syncthreads();
    XcdBarrier xbar; xbar.bar = (unsigned*)a.ws; xbar.x = 0; xbar.st = xst;
    if (a.ph_hi - a.ph_lo > 1) xbar = xcd_barrier_post((unsigned*)a.ws, xst);
#ifndef PROBE_Q
#define PROBE_Q 1
#endif
#ifdef PROBE_TS
    unsigned long long ts_[10];
#define STAMP(i) do { ts_[i] = __builtin_amdgcn_s_memrealtime(); } while (0)
#else
#define STAMP(i) do {} while (0)
#endif
    STAMP(0);
#define IN(k) (a.ph_lo <= (k) && (k) < a.ph_hi)
#define SEAM(k) do { if (IN(k) && IN((k) + 1)) xcd_barrier(xbar); } while (0)
    if (a.ph_lo < 0) grid.sync();
    if (IN(0)) { p0_prologue(a, lds, vcu, G, wave, lane); }
    SEAM(0); STAMP(1);
    if (IN(1)) {
        constexpr int N1 = 6144;
        pg8::Gemm g{(const pg8::bf16_t*)(a.ws + WS_XN), (const pg8::bf16_t*)(a.ws + WS_WTIN), T, (G == 256 ? N1 : NINP), D}; pg8::StaticOrder S; S.init(T, (G == 256 ? N1 : NINP), G, bx);
        pg8::EpiBf16<0> E{(pg8::bf16_t*)(a.ws + WS_PROJ), NINP, nullptr, 0, 0, 1.f};
        pg8::gemm_phase<pg8::EpiBf16<0>, pg8::StaticOrder, true, true>(lds, g, S, E);
    }
    SEAM(1); STAMP(2);
    if (IN(2)) {
        for (int it = bx; it < NCH * 2; it += G) rwkv_chunk_group(a, lds, it, tid, wave, lane);
    }
    SEAM(2); STAMP(3);
    if (IN(3)) {
        if (bx < 64) state_pass(a, lds, bx, tid, wave, lane);
        else if (G == 256 && bx < 128) {
            pg8::Gemm g{(const pg8::bf16_t*)(a.ws + WS_XN), (const pg8::bf16_t*)(a.ws + WS_WTIN), T, NINP, D}; pg8::OneTile S{(bx - 64) >> 1, 24 + ((bx - 64) & 1)};
            pg8::EpiBf16<0> E{(pg8::bf16_t*)(a.ws + WS_PROJ), NINP, nullptr, 0, 0, 1.f};
            pg8::gemm_phase<pg8::EpiBf16<0>, pg8::OneTile, true, true>(lds, g, S, E);
        } else if (G == 256) {
            for (int it = bx - 128; it < 256; it += 128) attn_unit(a, lds, 2 * it, tid, wave, lane);
            __syncthreads();
            if (tid == 0) { unsigned* hf = (unsigned*)a.ws + 7168; unsigned spins = 0;
                while (__hip_atomic_load(hf, __ATOMIC_RELAXED, __HIP_MEMORY_SCOPE_AGENT) < 64u) { __builtin_amdgcn_s_sleep(4); if (++spins > (1u << 22)) break; }
                __builtin_amdgcn_fence(__ATOMIC_ACQUIRE, "agent"); }
            __syncthreads();
            for (int u = bx - 128; u < HSPLIT * NH; u += 128) rwkv_out_unit(a, lds, u, tid, wave, lane);
        }
    }
    SEAM(3); STAMP(4);
    if (IN(4)) {
        if (G == 256) { for (int it = bx; it < 256; it += G) attn_unit(a, lds, 2 * it + 1, tid, wave, lane); }
        else { for (int it = bx; it < 512; it += G) attn_unit(a, lds, it, tid, wave, lane); }
        STAMP(8);
        for (int u = (G == 256 ? HSPLIT * NH : 0) + bx; u < NCH * NH; u += G) rwkv_out_unit(a, lds, u, tid, wave, lane);
    }
    SEAM(4); STAMP(5);
    if (IN(5)) {
        pg8::Gemm g{(const pg8::bf16_t*)(a.ws + WS_MIX), (const pg8::bf16_t*)(a.ws + WS_WTOUT), T, D, D}; pg8::StaticOrder S; S.init(T, D, G, bx);
        if (G == 256 && a.ph_hi - a.ph_lo > 1) {
            pg8::EpiResidNorm E{a.in[0], a.out, (float*)(a.ws + WS_SSP), (unsigned*)a.ws + 4096, a.in[15], D, RMS_EPS};
            pg8::gemm_phase<pg8::EpiResidNorm, pg8::StaticOrder, false, true>(lds, g, S, E);
        } else {
            pg8::EpiResid E{a.in[0], a.out, (float*)(a.ws + WS_SSP), D};
            pg8::gemm_phase<pg8::EpiResid, pg8::StaticOrder, true, true>(lds, g, S, E);
        }
    }
    if (!(G == 256 && a.ph_hi - a.ph_lo > 1)) { SEAM(5); } STAMP(6);
    if (IN(6) && !(G == 256 && a.ph_hi - a.ph_lo > 1)) final_norm(a, vcu, G, wave, lane);
#ifdef PROBE_G
    __syncthreads();
    if (bx == 0 && tid == 0) { const unsigned long long* g_ = (const unsigned long long*)(a.ws + 65536); a.out[0] = (float)(g_[PROBE_G + 1] - g_[PROBE_G]) * 0.1f; }
#endif
#ifdef PROBE_TS
    STAMP(7); __syncthreads();
    if (bx == 0 && tid == 0) { const int k_ = PROBE_TS; const unsigned long long d_ = (k_ == 9) ? ts_[7] - ts_[0] : (k_ == 8) ? ts_[8] - ts_[4] : ts_[k_ + 1] - ts_[k_]; a.out[0] = (float)(((int)((float)d_ * 0.01f) / PROBE_Q) * PROBE_Q + PROBE_Q / 2); }
#endif
#undef IN
#undef SEAM
}

extern "C" void kernel_launch(void* const* d_in, const int* in_sizes, int n_in, void* d_out, int out_size, void* d_ws, size_t ws_size, hipStream_t stream) {
    static int grid = 0;
    if (grid == 0) {
        int dev = 0, cus = 0;
        if (hipGetDevice(&dev) != hipSuccess || hipDeviceGetAttribute(&cus, hipDeviceAttributeMultiprocessorCount, dev) != hipSuccess) { fprintf(stderr, "kernel_launch: device query failed\n"); grid = -1; return; }
        if (hipFuncSetAttribute((const void*)mega, hipFuncAttributeMaxDynamicSharedMemorySize, LDS_BYTES) != hipSuccess) { fprintf(stderr, "kernel_launch: hipFuncSetAttribute failed\n"); grid = -1; return; }
        (void)hipGetLastError();
        grid = cus;
    }
    if (grid < 0) return;
    Args a{};
    for (int i = 0; i < 16; ++i) a.in[i] = (const float*)d_in[i];
    a.out = (float*)d_out; a.ws = (unsigned char*)d_ws;
#if ONE_LAUNCH
    (void)hipMemsetAsync(d_ws, 0, 32768, stream);
    a.ph_lo = 0; a.ph_hi = NPHASE;
    void* args[] = {&a};
#ifdef PROBE_PLAIN
    hipLaunchKernelGGL(mega, dim3(grid), dim3(NTHR), LDS_BYTES, stream, a); hipError_t e = hipSuccess; (void)args;
#else
    hipError_t e = hipLaunchCooperativeKernel((const void*)mega, dim3(grid), dim3(NTHR), args, LDS_BYTES, stream);
#endif
    if (e != hipSuccess) fprintf(stderr, "cooperative launch failed: %s (grid %d)\n", hipGetErrorString(e), grid);
#else
    for (int p = 0; p < NPHASE; ++p) for (int rep = 0; rep < (p == HOSTDUP ? 2 : 1); ++rep) { a.ph_lo = p; a.ph_hi = p + 1; hipLaunchKernelGGL(mega, dim3(grid), dim3(NTHR), LDS_BYTES, stream, a); }
#endif
}
```

```cpp
#define ONE 1
#include <hip/hip_runtime.h>
#include <hip/hip_cooperative_groups.h>
#include <cstdio>
#include <cstdint>
namespace cg = cooperative_groups;
namespace pg8 {
#define PG8_LAS __attribute__((address_space(3)))
typedef unsigned short bf16_t;
typedef short bf16x8 __attribute__((ext_vector_type(8)));
typedef float f32x4 __attribute__((ext_vector_type(4)));
typedef unsigned u32x4 __attribute__((ext_vector_type(4)));
constexpr int BM = 256, BK = 64, HALF = 128, HTB = HALF * BK * 2  , STAGE_BYTES = 8 * HTB, NXCD = 8, WGM = 8;

__host__ __device__ __forceinline__ int lds_byte(int r, int c) { const int st = (r >> 4) * 2 + (c >> 5), rr = r & 15, cc = c & 31, ob = rr * 64 + cc * 2; return st * 1024 + (ob ^ (((ob >> 9) & 1) << 5)); }
__host__ __device__ __forceinline__ void stage_rc(int b, int& R, int& C) { const int st = b / 1024, sb = b % 1024, swz = sb ^ (((sb >> 9) & 1) << 5); R = (st >> 1) * 16 + swz / 64; C = (st & 1) * 32 + (swz % 64) / 2; }
__host__ __device__ __forceinline__ int perm32(int rho) { const int n = rho >> 4, i = rho & 15; return 8 * (i >> 2) + 4 * n + (i & 3); }

struct Unit { int pm, pn; };
struct Gemm { const bf16_t* A; const bf16_t* Bt; int M, N, K; };

struct StaticOrder {
    int nM, nN, nwg, G, c;
    __host__ __device__ void init(int M, int N, int G_, int c_) { nM = M / BM; nN = N / BM; nwg = nM * nN; G = G_; c = c_; }
    __host__ __device__ bool next(int i, Unit& u) const {
        const long L = (long)i * G + c; if (L >= nwg) return false;
        int wgid = (int)L; { const int q = nwg / NXCD, r = nwg % NXCD, xcd = wgid % NXCD, off = wgid / NXCD; wgid = (xcd < r ? xcd * (q + 1) : r * (q + 1) + (xcd - r) * q) + off; }
        const int nig = WGM * nN, gid = wgid / nig, fm = gid * WGM, gsz = (nM - fm) < WGM ? (nM - fm) : WGM;
        u.pm = fm + ((wgid % nig) % gsz); u.pn = (wgid % nig) / gsz; return true;
    }
    __device__ __forceinline__ void a_ready(const Unit&) const {}
    __device__ __forceinline__ void done(const Unit&) const {}
};

__device__ __forceinline__ unsigned cvt_pk_bf16(float lo, float hi) { unsigned r; asm volatile("v_cvt_pk_bf16_f32 %0, %1, %2" : "=v"(r) : "v"(lo), "v"(hi)); return r; }
typedef float f32x2 __attribute__((ext_vector_type(2)));
__device__ __forceinline__ f32x2 gelu_pk(f32x2 v) {
    const f32x2 av = __builtin_elementwise_abs(v), d = av * 0.2316418882f + 1.0f;
    f32x2 t; t.x = __builtin_amdgcn_rcpf(d.x); t.y = __builtin_amdgcn_rcpf(d.y);
    f32x2 q = t * 0.5307027145f + (-0.7265760135f); q = q * t + 0.7107068705f; q = q * t + (-0.142248368f); q = q * t + 0.127414796f; q = q * t;
    const f32x2 s = (v * v) * (-0.72134752044f);
    f32x2 e; e.x = __builtin_amdgcn_exp2f(s.x); e.y = __builtin_amdgcn_exp2f(s.y);
    const f32x2 m = v * (q * e), r = v - m;
    f32x2 o; o.x = v.x < 0.f ? m.x : r.x; o.y = v.y < 0.f ? m.y : r.y; return o;
}

template <int ACT  > struct EpiBf16 {
    static constexpr bool PERM = true, AFTER_DRAIN = false; static_assert(ACT == 0 || ACT == 1, "EpiBf16: ACT is 0 (none) or 1 (gelu_pk)");
    bf16_t* O; int ldc; const float* bias; int split_cols; size_t split_stride; float scale0;
    __device__ __forceinline__ void operator()(const f32x4 (&acc)[2][2][4][2], const Unit& u, int wr, int wc, int fr, int fq) const {
        const int row0 = u.pm * BM + wr * 64 + fr; int colt = u.pn * BM; bf16_t* base = O;
        float sc = 1.f; if (split_cols) { const int t = colt / split_cols; base += (size_t)t * split_stride; colt -= t * split_cols; if (t == 0) sc = scale0; }
        const int col0 = colt + wc * 32 + 8 * fq, bcol0 = u.pn * BM + wc * 32 + 8 * fq;
        f32x4 bv[2][2];
#pragma unroll
        for (int bj = 0; bj < 2; ++bj)
#pragma unroll
            for (int n = 0; n < 2; ++n) bv[bj][n] = bias ? *(const f32x4*)(bias + bcol0 + bj * HALF + 4 * n) : (f32x4){0.f, 0.f, 0.f, 0.f};
#pragma unroll
        for (int ai = 0; ai < 2; ++ai)
#pragma unroll
            for (int m = 0; m < 4; ++m) { bf16_t* rowp = base + (size_t)(row0 + ai * HALF + m * 16) * ldc + col0;
#pragma unroll
                for (int bj = 0; bj < 2; ++bj) { f32x4 v0 = acc[ai][bj][m][0] + bv[bj][0], v1 = acc[ai][bj][m][1] + bv[bj][1];
                    if (ACT == 1) { f32x2 a = gelu_pk((f32x2){v0[0], v0[1]}), b = gelu_pk((f32x2){v0[2], v0[3]}), c = gelu_pk((f32x2){v1[0], v1[1]}), d = gelu_pk((f32x2){v1[2], v1[3]});
                        v0 = (f32x4){a.x, a.y, b.x, b.y}; v1 = (f32x4){c.x, c.y, d.x, d.y}; }
                    v0 = v0 * sc; v1 = v1 * sc; u32x4 w; w.x = cvt_pk_bf16(v0[0], v0[1]); w.y = cvt_pk_bf16(v0[2], v0[3]); w.z = cvt_pk_bf16(v1[0], v1[1]); w.w = cvt_pk_bf16(v1[2], v1[3]);
                    *(u32x4*)(rowp + bj * HALF) = w; } }
    }
};
struct EpiResid {
    static constexpr bool PERM = false, AFTER_DRAIN = false;
    const float* x; float* out; float* sspart; int ldc;
    __device__ __forceinline__ void operator()(const f32x4 (&acc)[2][2][4][2], const Unit& u, int wr, int wc, int fr, int fq) const {
        const int row0 = u.pm * BM + wr * 64 + fr, col0 = u.pn * BM + wc * 32 + 4 * fq;
#pragma unroll
        for (int ai = 0; ai < 2; ++ai)
#pragma unroll
            for (int m = 0; m < 4; ++m) {
                const int row = row0 + ai * HALF + m * 16; float ss = 0.f;
#pragma unroll
                for (int bj = 0; bj < 2; ++bj)
#pragma unroll
                    for (int n = 0; n < 2; ++n) {
                        const size_t off = (size_t)row * ldc + col0 + bj * HALF + n * 16;
                        const f32x4 xv = *(const f32x4*)(x + off); const f32x4 v = acc[ai][bj][m][n] + xv;
                        *(f32x4*)(out + off) = v; ss += (v[0] * v[0] + v[1] * v[1]) + (v[2] * v[2] + v[3] * v[3]);
                    }
                ss += __shfl_xor(ss, 16); ss += __shfl_xor(ss, 32);
                if (fq == 0) sspart[(size_t)row * 32 + u.pn * 4 + wc] = ss;
            }
    }
};

struct OneTile {
    int pm, pn;
    __host__ __device__ bool next(int i, Unit& u) const { if (i != 0) return false; u.pm = pm; u.pn = pn; return true; }
    __device__ __forceinline__ void a_ready(const Unit&) const {}
    __device__ __forceinline__ void done(const Unit&) const {}
};
struct EpiResidNorm {
    static constexpr bool PERM = false, AFTER_DRAIN = true;
    const float* x; float* out; float* ssp; unsigned* cnt; const float* gain; int ldc; float eps;
    __device__ __forceinline__ void fused(f32x4 (&acc)[2][2][4][2], const Unit& u, int wr, int wc, int fr, int fq, PG8_LAS unsigned char* lds, int wid, int lane) const {
        const int row0 = u.pm * BM + wr * 64 + fr, col0 = u.pn * BM + wc * 32 + 4 * fq;
#pragma unroll
        for (int ai = 0; ai < 2; ++ai) {
            f32x4 xv[4][2][2];
#pragma unroll
            for (int m = 0; m < 4; ++m)
#pragma unroll
                for (int bj = 0; bj < 2; ++bj)
#pragma unroll
                    for (int n = 0; n < 2; ++n) xv[m][bj][n] = *(const f32x4*)(x + (size_t)(row0 + ai * HALF + m * 16) * ldc + col0 + bj * HALF + n * 16);
#pragma unroll
            for (int m = 0; m < 4; ++m) {
                const int row = row0 + ai * HALF + m * 16; float ss = 0.f;
#pragma unroll
                for (int bj = 0; bj < 2; ++bj)
#pragma unroll
                    for (int n = 0; n < 2; ++n) {
                        const f32x4 v = acc[ai][bj][m][n] + xv[m][bj][n];
                        acc[ai][bj][m][n] = v; ss += (v[0] * v[0] + v[1] * v[1]) + (v[2] * v[2] + v[3] * v[3]);
                    }
                ss += __shfl_xor(ss, 16); ss += __shfl_xor(ss, 32);
                if (fq == 0) __hip_atomic_store(ssp + (size_t)row * 32 + u.pn * 4 + wc, ss, __ATOMIC_RELAXED, __HIP_MEMORY_SCOPE_AGENT);
            }
        }
        asm volatile("s_waitcnt vmcnt(0)" ::: "memory");
        __syncthreads();
        unsigned* c = cnt + 64 * u.pm;
        if (threadIdx.x == 0) {
            __hip_atomic_fetch_add(c, 1u, __ATOMIC_RELEASE, __HIP_MEMORY_SCOPE_AGENT);
            unsigned spins = 0;
            while (__hip_atomic_load(c, __ATOMIC_RELAXED, __HIP_MEMORY_SCOPE_AGENT) < 8u) { __builtin_amdgcn_s_sleep(2); if (++spins > (1u << 22)) break; }
            __builtin_amdgcn_fence(__ATOMIC_ACQUIRE, "agent");
        }
        __syncthreads();
        PG8_LAS float* S = (PG8_LAS float*)lds;
        if (threadIdx.x < 256) {
            const float* p = ssp + (size_t)(u.pm * BM + threadIdx.x) * 32; float s = 0.f;
#pragma unroll
            for (int i = 0; i < 32; ++i) s += __hip_atomic_load(p + i, __ATOMIC_RELAXED, __HIP_MEMORY_SCOPE_AGENT);
            S[threadIdx.x] = 1.0f / sqrtf(s * (1.0f / 2048.0f) + eps);
        }
        __syncthreads();
#pragma unroll
        for (int bj = 0; bj < 2; ++bj)
#pragma unroll
            for (int n = 0; n < 2; ++n) {
                const f32x4 g = *(const f32x4*)(gain + col0 + bj * HALF + n * 16);
#pragma unroll
                for (int ai = 0; ai < 2; ++ai)
#pragma unroll
                    for (int m = 0; m < 4; ++m) {
                        const int lr = wr * 64 + fr + ai * HALF + m * 16; const float rs = S[lr];
                        f32x4 v = acc[ai][bj][m][n]; v[0] *= rs * g[0]; v[1] *= rs * g[1]; v[2] *= rs * g[2]; v[3] *= rs * g[3];
                        *(f32x4*)(out + (size_t)(u.pm * BM + lr) * ldc + col0 + bj * HALF + n * 16) = v;
                    }
            }
    }
};

template <class Epi, class Sched, bool ALIGN_EPI = false, bool SP2 = false>
__device__ __forceinline__ void gemm_phase(PG8_LAS unsigned char* lds, const Gemm g, const Sched& S, const Epi& E) {
    const int tid = threadIdx.x, wid = __builtin_amdgcn_readfirstlane(tid >> 6), lane = tid & 63, wr = wid >> 2, wc = wid & 3, fr = lane & 15, fq = lane >> 4;
    const int K = g.K, nt = K / BK;
    unsigned voffA[2], voffB[2];
#pragma unroll
    for (int i = 0; i < 2; ++i) { int R, C; stage_rc(tid * 16 + i * 8192, R, C); const int Rb = Epi::PERM ? ((R & ~31) + perm32(R & 31)) : R;
        voffA[i] = (unsigned)(R * K + C) * 2u; voffB[i] = (unsigned)(Rb * K + C) * 2u; }
    const size_t kstep = (size_t)(BK * 2);
    const size_t hstep = (size_t)HALF * K * 2;
    const size_t tstep = 2 * hstep;
    const unsigned ldsw = (unsigned)wid * 1024u;
    const int aoff = lds_byte(wr * 64 + fr, fq * 8), boff = lds_byte(wc * 32 + fr, fq * 8);
#define PG8_SA(b, h) (((b) * 2 + (h)) * HTB)
#define PG8_SB(b, h) ((4 + (b) * 2 + (h)) * HTB)
#define PG8_STAGE(bufoff, gbase, voff) do { _Pragma("unroll") for (int _i = 0; _i < 2; ++_i) \
        __builtin_amdgcn_global_load_lds((const unsigned*)((const char*)(gbase) + (voff)[_i]), (PG8_LAS unsigned*)(lds + (bufoff) + ldsw + _i * 8192), 16, 0, 0); } while (0)
#define PG8_LDA(dst, b, h) do { _Pragma("unroll") for (int m = 0; m < 4; ++m) _Pragma("unroll") for (int k = 0; k < 2; ++k) dst[m][k] = *(const PG8_LAS bf16x8*)(lds + PG8_SA(b, h) + aoff + m * 2048 + k * 1024); } while (0)
#define PG8_LDB(dst, b, h) do { _Pragma("unroll") for (int n = 0; n < 2; ++n) _Pragma("unroll") for (int k = 0; k < 2; ++k) dst[n][k] = *(const PG8_LAS bf16x8*)(lds + PG8_SB(b, h) + boff + n * 2048 + k * 1024); } while (0)
#define PG8_MMA(ai, bj, At, Bt) do { __builtin_amdgcn_s_setprio(1); _Pragma("unroll") for (int m = 0; m < 4; ++m) _Pragma("unroll") for (int n = 0; n < 2; ++n) _Pragma("unroll") for (int k = 0; k < 2; ++k) \
        acc[ai][bj][m][n] = __builtin_amdgcn_mfma_f32_16x16x32_bf16(Bt[n][k], At[m][k], acc[ai][bj][m][n], 0, 0, 0); __builtin_amdgcn_s_setprio(0); } while (0)
#define PG8_WAIT_V(n) asm volatile("s_waitcnt vmcnt(" #n ")" ::: "memory")
#define PG8_WAIT_L(n) asm volatile("s_waitcnt lgkmcnt(" #n ")" ::: "memory")
#define PG8_BAR __builtin_amdgcn_s_barrier()
#define PG8_SCHED __builtin_amdgcn_sched_barrier(0)
    Unit cur, nxt; int ui = 0;
    if (!S.next(0, cur)) return;
    f32x4 acc[2][2][4][2];
#pragma unroll
    for (int a = 0; a < 2; ++a)
#pragma unroll
        for (int b = 0; b < 2; ++b)
#pragma unroll
            for (int m = 0; m < 4; ++m)
#pragma unroll
                for (int n = 0; n < 2; ++n) acc[a][b][m][n] = (f32x4){0.f, 0.f, 0.f, 0.f};
    bf16x8 At[4][2], B0[2][2], B1[2][2];
    const char* cA = (const char*)g.A + (size_t)cur.pm * tstep; const char* cB = (const char*)g.Bt + (size_t)cur.pn * tstep;
    S.a_ready(cur);
    if constexpr (SP2) {
        PG8_STAGE(PG8_SB(0, 0), cB, voffB); PG8_STAGE(PG8_SB(0, 1), cB + hstep, voffB); PG8_STAGE(PG8_SA(0, 0), cA, voffA); PG8_STAGE(PG8_SA(0, 1), cA + hstep, voffA);
        if (wr == 1) PG8_BAR;
        PG8_WAIT_V(2); PG8_BAR;
        PG8_STAGE(PG8_SB(1, 0), cB + kstep, voffB); PG8_STAGE(PG8_SA(1, 0), cA + kstep, voffA); PG8_STAGE(PG8_SB(1, 1), cB + hstep + kstep, voffB);
        PG8_WAIT_V(6); PG8_BAR;
    } else {
        PG8_STAGE(PG8_SB(0, 0), cB, voffB); PG8_STAGE(PG8_SA(0, 0), cA, voffA); PG8_STAGE(PG8_SB(0, 1), cB + hstep, voffB); PG8_STAGE(PG8_SA(0, 1), cA + hstep, voffA);
        if (wr == 1) PG8_BAR;
        PG8_WAIT_V(4); PG8_BAR;
        PG8_STAGE(PG8_SB(1, 0), cB + kstep, voffB); PG8_STAGE(PG8_SA(1, 0), cA + kstep, voffA); PG8_STAGE(PG8_SB(1, 1), cB + hstep + kstep, voffB);
        PG8_WAIT_V(6); PG8_BAR;
    }
    for (;;) {
        const bool has_next = S.next(ui + 1, nxt);
        const char* nA = has_next ? (const char*)g.A + (size_t)nxt.pm * tstep : cA; const char* nB = has_next ? (const char*)g.Bt + (size_t)nxt.pn * tstep : cB;
        for (int t = 0; t < nt; t += 2) {
            const bool last = (t == nt - 2);
            const char* a1 = cA + (size_t)(t + 1) * kstep;
            const char* a2 = last ? nA : cA + (size_t)(t + 2) * kstep; const char* b2 = last ? nB : cB + (size_t)(t + 2) * kstep;
            const char* a3 = a2 + kstep; const char* b3 = b2 + kstep;
            if (last && has_next) S.a_ready(nxt);
            if constexpr (SP2) {
            PG8_LDB(B0, 0, 0); PG8_LDB(B1, 0, 1); PG8_SCHED; PG8_LDA(At, 0, 0); PG8_STAGE(PG8_SA(1, 1), a1 + hstep, voffA);
            PG8_WAIT_V(8); PG8_WAIT_L(0); PG8_BAR; PG8_MMA(0, 0, At, B0); PG8_MMA(0, 1, At, B1); PG8_BAR; PG8_SCHED;
            PG8_LDA(At, 0, 1); PG8_STAGE(PG8_SB(0, 0), b2, voffB); PG8_STAGE(PG8_SB(0, 1), b2 + hstep, voffB); PG8_STAGE(PG8_SA(0, 0), a2, voffA);
            PG8_WAIT_V(8); PG8_WAIT_L(0); PG8_BAR; PG8_MMA(1, 0, At, B0); PG8_MMA(1, 1, At, B1); PG8_BAR; PG8_SCHED;
            PG8_LDB(B0, 1, 0); PG8_LDB(B1, 1, 1); PG8_SCHED; PG8_LDA(At, 1, 0); PG8_STAGE(PG8_SA(0, 1), a2 + hstep, voffA);
            PG8_WAIT_V(8); PG8_WAIT_L(0); PG8_BAR; PG8_MMA(0, 0, At, B0); PG8_MMA(0, 1, At, B1); PG8_BAR; PG8_SCHED;
            PG8_LDA(At, 1, 1); PG8_STAGE(PG8_SB(1, 0), b3, voffB); PG8_STAGE(PG8_SB(1, 1), b3 + hstep, voffB); PG8_STAGE(PG8_SA(1, 0), a3, voffA);
            PG8_WAIT_V(8); PG8_WAIT_L(0); PG8_BAR; PG8_MMA(1, 0, At, B0); PG8_MMA(1, 1, At, B1); PG8_BAR; PG8_SCHED;
            } else {
            PG8_LDB(B0, 0, 0); PG8_SCHED; PG8_LDA(At, 0, 0); PG8_STAGE(PG8_SA(1, 1), a1 + hstep, voffA);
            PG8_WAIT_L(8); PG8_BAR; PG8_WAIT_L(0); PG8_MMA(0, 0, At, B0); PG8_BAR; PG8_SCHED;
            PG8_LDB(B1, 0, 1); PG8_STAGE(PG8_SB(0, 0), b2, voffB);
            PG8_BAR; PG8_WAIT_L(0); PG8_MMA(0, 1, At, B1); PG8_BAR;
            PG8_LDA(At, 0, 1); PG8_STAGE(PG8_SA(0, 0), a2, voffA);
            PG8_BAR; PG8_WAIT_L(0); PG8_MMA(1, 0, At, B0); PG8_BAR; PG8_SCHED;
            PG8_STAGE(PG8_SB(0, 1), b2 + hstep, voffB);
            PG8_WAIT_V(6); PG8_BAR; PG8_MMA(1, 1, At, B1); PG8_BAR;
            PG8_LDB(B0, 1, 0); PG8_SCHED; PG8_LDA(At, 1, 0); PG8_STAGE(PG8_SA(0, 1), a2 + hstep, voffA);
            PG8_WAIT_L(8); PG8_BAR; PG8_WAIT_L(0); PG8_MMA(0, 0, At, B0); PG8_BAR; PG8_SCHED;
            PG8_LDB(B1, 1, 1); PG8_STAGE(PG8_SB(1, 0), b3, voffB);
            PG8_BAR; PG8_WAIT_L(0); PG8_MMA(0, 1, At, B1); PG8_BAR;
            PG8_LDA(At, 1, 1); PG8_STAGE(PG8_SA(1, 0), a3, voffA);
            PG8_BAR; PG8_WAIT_L(0); PG8_MMA(1, 0, At, B0); PG8_BAR; PG8_SCHED;
            PG8_STAGE(PG8_SB(1, 1), b3 + hstep, voffB);
            PG8_WAIT_V(6); PG8_BAR; PG8_MMA(1, 1, At, B1); PG8_BAR;
            }
        }
        if constexpr (ALIGN_EPI) { if (wr == 0) PG8_BAR; }
        if constexpr (!Epi::AFTER_DRAIN) { E(acc, cur, wr, wc, fr, fq); S.done(cur); }
        if (!has_next) break;
#pragma unroll
        for (int a = 0; a < 2; ++a)
#pragma unroll
            for (int b = 0; b < 2; ++b)
#pragma unroll
                for (int m = 0; m < 4; ++m)
#pragma unroll
                    for (int n = 0; n < 2; ++n) acc[a][b][m][n] = (f32x4){0.f, 0.f, 0.f, 0.f};
        cur = nxt; cA = nA; cB = nB; ++ui;
        if constexpr (ALIGN_EPI) { if (wr == 1) PG8_BAR; }
    }
    PG8_WAIT_V(0);
    if constexpr (!ALIGN_EPI) { if (wr == 0) PG8_BAR; }
    PG8_BAR;
    if constexpr (Epi::AFTER_DRAIN) { E.fused(acc, cur, wr, wc, fr, fq, lds, wid, lane); S.done(cur); }
#undef PG8_SA
#undef PG8_SB
#undef PG8_STAGE
#undef PG8_LDA
#undef PG8_LDB
#undef PG8_MMA
#undef PG8_WAIT_V
#undef PG8_WAIT_L
#undef PG8_BAR
#undef PG8_SCHED
}
}
constexpr int T = 8192, D = 2048, NIN = 6528, NINP = 6656, RW = 1024, NH = 16, HD = 64, CH = 64, NCH = T / CH;
constexpr int C_R = 0, C_K = 1024, C_V = 2048, C_WD = 3072, C_AD = 3136, C_G = 3200, C_AQ = 4224, C_AK = 5248, C_AV = 5376, C_AG = 5504;
constexpr float RMS_EPS = 1e-5f, LNX_EPS = 64e-5f;
constexpr int NWAVES = 8, NTHR = 512;
constexpr size_t MiB = 1u << 20;
constexpr size_t WS_WTIN = 1 * MiB;
constexpr size_t WS_XN = 27 * MiB;
constexpr size_t WS_WTOUT = 59 * MiB;
constexpr size_t WS_UPT = 67 * MiB;
constexpr size_t WS_SSP = 68 * MiB;
constexpr size_t WS_PROJ = 70 * MiB;
constexpr size_t WS_SCR = 174 * MiB;
constexpr size_t WS_MIX = 223 * MiB;
constexpr size_t WS_P32 = 223 * MiB;
constexpr int LDS_BYTES = 163840;

#define GAS __attribute__((address_space(1)))
#define LAS __attribute__((address_space(3)))
typedef unsigned short bf16;
typedef unsigned v4u __attribute__((ext_vector_type(4)));
typedef unsigned v2u __attribute__((ext_vector_type(2)));
typedef float f32x4 __attribute__((ext_vector_type(4)));
typedef float f32x16 __attribute__((ext_vector_type(16)));
typedef short bf16x8 __attribute__((ext_vector_type(8)));
typedef __bf16 bf16x2_t __attribute__((ext_vector_type(2)));
__device__ __forceinline__ unsigned pk2(float a, float b) { bf16x2_t v; v[0] = (__bf16)a; v[1] = (__bf16)b; return __builtin_bit_cast(unsigned, v); }
__device__ __forceinline__ float bflo(unsigned u) { return __uint_as_float(u << 16); }
__device__ __forceinline__ float bfhi(unsigned u) { return __uint_as_float(u & 0xffff0000u); }
__device__ __forceinline__ void unpack8(const v4u& p, float (&f)[8]) { f[0] = bflo(p.x); f[1] = bfhi(p.x); f[2] = bflo(p.y); f[3] = bfhi(p.y); f[4] = bflo(p.z); f[5] = bfhi(p.z); f[6] = bflo(p.w); f[7] = bfhi(p.w); }
__device__ __forceinline__ v4u pack8(const float (&f)[8]) { v4u o; o.x = pk2(f[0], f[1]); o.y = pk2(f[2], f[3]); o.z = pk2(f[4], f[5]); o.w = pk2(f[6], f[7]); return o; }
__device__ __forceinline__ float wave_sum(float v) {
#pragma unroll
    for (int o = 1; o < 64; o <<= 1) v += __shfl_xor(v, o);
    return v;
}
__device__ __forceinline__ float sum8(float v) { v += __shfl_xor(v, 1); v += __shfl_xor(v, 2); v += __shfl_xor(v, 4); return v; }
__device__ __forceinline__ float sigmoidf_(float x) { return 1.f / (1.f + __expf(-x)); }
__device__ __forceinline__ float siluf_(float x) { return x / (1.f + __expf(-x)); }

__device__ __forceinline__ void bar_lds() { asm volatile("s_waitcnt lgkmcnt(0)" ::: "memory"); __builtin_amdgcn_s_barrier(); asm volatile("" ::: "memory"); }
struct Args { const float* in[16]; float* out; unsigned char* ws; int ph_lo, ph_hi; };

struct TItem { const float* W; bf16* WT; int K, N, k0, n0; };
__device__ __forceinline__ bool p0_item(const Args& a, int it, TItem& o) {
    constexpr int I_IN = (D / 64) * (NIN / 32), I_OUT = (D / 64) * (D / 32), I_UP = RW / 32;
    bf16* wtin = (bf16*)(a.ws + WS_WTIN); bf16* wtout = (bf16*)(a.ws + WS_WTOUT); bf16* upt = (bf16*)(a.ws + WS_UPT); bf16* aupt = upt + 65536;
    int r = it;
    if (r < 0) { r += I_OUT; if (r < 0) return false; o.W = a.in[14]; o.WT = wtout; o.K = D; o.N = D; }
    else if (r < I_IN) { o.W = a.in[2]; o.WT = wtin; o.K = D; o.N = NIN; }
    else if ((r -= I_IN) < I_UP) { o.W = a.in[5]; o.WT = upt; o.K = 64; o.N = RW; }
    else if ((r -= I_UP) < I_UP) { o.W = a.in[7]; o.WT = aupt; o.K = 64; o.N = RW; }
    else return false;
    const int nblk = o.N / 32; o.k0 = 64 * (r / nblk); o.n0 = 32 * (r % nblk); return true;
}
__device__ __forceinline__ void p0_ld(const TItem& t, int lane, f32x4 (&v)[8]) {
#pragma unroll
    for (int i = 0; i < 8; ++i) v[i] = *(const f32x4*)(t.W + (size_t)(t.k0 + 8 * i + (lane >> 3)) * t.N + t.n0 + 4 * (lane & 7));
}
__device__ __forceinline__ void p0_st(const TItem& t, int lane, const f32x4 (&v)[8], LAS float* scr) {
#pragma unroll
    for (int i = 0; i < 8; ++i) { LAS float* d = scr + (8 * i + (lane >> 3)) * 33 + 4 * (lane & 7); d[0] = v[i].x; d[1] = v[i].y; d[2] = v[i].z; d[3] = v[i].w; }
    asm volatile("s_waitcnt lgkmcnt(0)" ::: "memory");
    const int c = lane & 7;
#pragma unroll
    for (int j = 0; j < 4; ++j) { const int n = (lane >> 3) + 8 * j; const LAS float* s = scr + (8 * c) * 33 + n;
        v4u o; o.x = pk2(s[0 * 33], s[1 * 33]); o.y = pk2(s[2 * 33], s[3 * 33]); o.z = pk2(s[4 * 33], s[5 * 33]); o.w = pk2(s[6 * 33], s[7 * 33]);
        *(v4u*)(t.WT + (size_t)(t.n0 + n) * t.K + t.k0 + 8 * c) = o; }
    asm volatile("s_waitcnt lgkmcnt(0)" ::: "memory");
}
__device__ __forceinline__ void wout_transposes(const Args& a, LAS unsigned char* lds, int gw, int NGW, int wave, int lane) {
    LAS float* scr = (LAS float*)(lds + wave * 16384);
    constexpr int I_OUT = (D / 64) * (D / 32);
    for (int it = gw - I_OUT; it < 0; it += NGW) { TItem t0; f32x4 v0[8]; if (!p0_item(a, it, t0)) break; p0_ld(t0, lane, v0); p0_st(t0, lane, v0, scr); }
}
__device__ __forceinline__ void p0_prologue(const Args& a, LAS unsigned char* lds, int vcu, int G, int wave, int lane) {
    LAS float* scr = (LAS float*)(lds + wave * 16384);
    const int gw = vcu * NWAVES + wave, NGW = G * NWAVES;
    bf16* wtin = (bf16*)(a.ws + WS_WTIN);
#ifdef PROBE_P0X
    for (int rep_ = 0; rep_ < 2; ++rep_)
#endif
    for (int it = gw; ; it += 2 * NGW) {
        TItem t0, t1; f32x4 v0[8], v1[8];
        const bool h0 = p0_item(a, it, t0), h1 = p0_item(a, it + NGW, t1);
        if (!h0) break;
        p0_ld(t0, lane, v0); if (h1) p0_ld(t1, lane, v1);
        p0_st(t0, lane, v0, scr); if (h1) p0_st(t1, lane, v1, scr);
    }
    wout_transposes(a, lds, gw, NGW, wave, lane);
    { v4u z = {0u, 0u, 0u, 0u}; v4u* p = (v4u*)(wtin + (size_t)NIN * D); const int n16 = (NINP - NIN) * D * 2 / 16;
      for (int i = gw * 64 + lane; i < n16; i += NGW * 64) p[i] = z; }
    const float* gain = a.in[1];
#ifdef PROBE_P0R
    for (int rep_ = 0; rep_ < 2; ++rep_)
#endif
    for (int m = gw; m < T; m += 2 * NGW) {
        const int m2 = m + NGW;
        const f32x4* xr = (const f32x4*)(a.in[0] + (size_t)m * D) + lane; const f32x4* xr2 = (const f32x4*)(a.in[0] + (size_t)(m2 < T ? m2 : m) * D) + lane;
        f32x4 v[8], u[8]; float s = 0.f, s2 = 0.f;
#pragma unroll
        for (int j = 0; j < 8; ++j) { v[j] = xr[64 * j]; u[j] = xr2[64 * j]; }
#pragma unroll
        for (int j = 0; j < 8; ++j) { s += (v[j].x * v[j].x + v[j].y * v[j].y) + (v[j].z * v[j].z + v[j].w * v[j].w); s2 += (u[j].x * u[j].x + u[j].y * u[j].y) + (u[j].z * u[j].z + u[j].w * u[j].w); }
        const float rstd = 1.f / sqrtf(wave_sum(s) * (1.f / D) + RMS_EPS), rstd2 = 1.f / sqrtf(wave_sum(s2) * (1.f / D) + RMS_EPS);
        v2u* o8 = (v2u*)((bf16*)(a.ws + WS_XN) + (size_t)m * D) + lane; v2u* o82 = (v2u*)((bf16*)(a.ws + WS_XN) + (size_t)m2 * D) + lane;
#pragma unroll
        for (int j = 0; j < 8; ++j) { const f32x4 g = *((const f32x4*)gain + lane + 64 * j); v2u o; o.x = pk2(v[j].x * rstd * g.x, v[j].y * rstd * g.y); o.y = pk2(v[j].z * rstd * g.z, v[j].w * rstd * g.w); o8[64 * j] = o;
            if (m2 < T) { o.x = pk2(u[j].x * rstd2 * g.x, u[j].y * rstd2 * g.y); o.y = pk2(u[j].z * rstd2 * g.z, u[j].w * rstd2 * g.w); o82[64 * j] = o; } }
    }
}
__device__ __forceinline__ void final_norm(const Args& a, int vcu, int G, int wave, int lane) {
    const int gw = vcu * NWAVES + wave, NGW = G * NWAVES; const float* ssp = (const float*)(a.ws + WS_SSP); const float* gain = a.in[15];
    for (int m = gw; m < T; m += NGW) {
        float s = (lane < 32) ? ssp[(size_t)m * 32 + lane] : 0.f; s = wave_sum(s);
        const float rstd = 1.f / sqrtf(s * (1.f / D) + RMS_EPS);
        f32x4* xr = (f32x4*)(a.out + (size_t)m * D) + lane;
#pragma unroll
        for (int j = 0; j < 8; ++j) { f32x4 v = xr[64 * j]; const f32x4 g = *((const f32x4*)gain + lane + 64 * j); v.x *= rstd * g.x; v.y *= rstd * g.y; v.z *= rstd * g.z; v.w *= rstd * g.w; xr[64 * j] = v; }
    }
}
#define XB_TMO      128
#define XB_XCNT(j)  (256  + 64 * (j))
#define XB_XSUB(j)  (1280 + 64 * (j))
#define XB_XGEN(j)  (2304 + 64 * (j))
#define XB_TOP      3328
#define XB_TOPGEN   3392
#define XCD_BAR_WORDS 3456
#define XB_SPIN_CAP (1u << 18)

__device__ __forceinline__ unsigned xb_ld(unsigned* p)              { return __hip_atomic_load(p, __ATOMIC_RELAXED, __HIP_MEMORY_SCOPE_AGENT); }
__device__ __forceinline__ unsigned xb_add(unsigned* p, unsigned v) { return __hip_atomic_fetch_add(p, v, __ATOMIC_RELAXED, __HIP_MEMORY_SCOPE_AGENT); }
__device__ __forceinline__ unsigned xb_xcc_id() { return (unsigned)__builtin_amdgcn_s_getreg((3 << 11) | 20) & 0xFu; }
#define XB_SPIN(cond, bar) do { unsigned _sp = 0; while (cond) { __builtin_amdgcn_s_sleep(1); \
    if ((++_sp & 255u) == 0u) { if (xb_ld(&(bar)[XB_TMO])) break; if (_sp > XB_SPIN_CAP) { atomicAdd(&(bar)[XB_TMO], 1u); break; } } } } while (0)

struct XcdBarrier {
    unsigned* bar; unsigned x;
    volatile LAS unsigned* st;
};

__device__ __forceinline__ XcdBarrier xcd_barrier_post(unsigned* bar, volatile LAS unsigned* st) {
    XcdBarrier b; b.bar = bar; b.x = xb_xcc_id(); b.st = st;
    if (threadIdx.x == 0) (void)xb_add(&bar[XB_XCNT(b.x)], 1u);
    return b;
}
__device__ __forceinline__ void xcd_barrier_complete(unsigned* bar, unsigned x, unsigned& nloc, unsigned& nx) {
    const unsigned G = gridDim.x * gridDim.y * gridDim.z;
    unsigned sum, cnt, mine, sp = 0u;
    for (;;) {
        sum = 0u; cnt = 0u; mine = 0u;
#pragma unroll
        for (unsigned j = 0; j < 16; ++j) { const unsigned c = xb_ld(&bar[XB_XCNT(j)]); sum += c; cnt += (c > 0u) ? 1u : 0u; mine = (j == x) ? c : mine; }
        if (sum == G) break;
        __builtin_amdgcn_s_sleep(1);
        if ((++sp & 255u) == 0u) { if (xb_ld(&bar[XB_TMO])) break; if (sp > XB_SPIN_CAP) { atomicAdd(&bar[XB_TMO], 1u); break; } }
    }
    nloc = mine > 0u ? mine : 1u; nx = cnt > 0u ? cnt : 1u;
}

__device__ __forceinline__ void xcd_barrier(const XcdBarrier& b) {
    asm volatile("s_waitcnt vmcnt(0)" ::: "memory");
    __syncthreads();
    if (threadIdx.x == 0) {
        unsigned* bar = b.bar;
        __builtin_amdgcn_s_waitcnt(0);
        unsigned nloc = b.st[0], nx = b.st[1];
        if (nloc == 0u) { xcd_barrier_complete(bar, b.x, nloc, nx); b.st[0] = nloc; b.st[1] = nx; }
        const unsigned old = xb_add(&bar[XB_XSUB(b.x)], 1u);
        const unsigned gen = old / nloc;
        if (old + 1u == (gen + 1u) * nloc) {
            __builtin_amdgcn_fence(__ATOMIC_RELEASE, "agent");
            asm volatile("s_waitcnt vmcnt(0)" ::: "memory");
            const unsigned og = xb_add(&bar[XB_TOP], 1u);
            const unsigned tg = og / nx;
            if (og + 1u == (tg + 1u) * nx) xb_add(&bar[XB_TOPGEN], 1u);
            else XB_SPIN(xb_ld(&bar[XB_TOPGEN]) == tg, bar);
            __builtin_amdgcn_fence(__ATOMIC_ACQUIRE, "agent");
            xb_add(&bar[XB_XGEN(b.x)], 1u);
            asm volatile("s_waitcnt vmcnt(0)" ::: "memory");
        } else {
            XB_SPIN(xb_ld(&bar[XB_XGEN(b.x)]) == gen, bar);
            __builtin_amdgcn_fence(__ATOMIC_ACQUIRE, "agent");
            asm volatile("s_waitcnt vmcnt(0)" ::: "memory");
        }
    }
    __syncthreads();
}

#define MFMA32(a_, b_, c_) __builtin_amdgcn_mfma_f32_32x32x16_bf16((a_), (b_), (c_), 0, 0, 0)
#define MFMA16(a_, b_, c_) __builtin_amdgcn_mfma_f32_16x16x32_bf16((a_), (b_), (c_), 0, 0, 0)
__device__ __forceinline__ v4u ldg16(const bf16* p) { return *(const v4u*)p; }
__device__ __forceinline__ void load_shift8(const bf16* proj, int row, int col, const float* mu, float (&o)[8]) {
    const v4u p = ldg16(proj + (size_t)row * NINP + col); v4u q = {0u, 0u, 0u, 0u};
    if (row > 0) q = ldg16(proj + (size_t)(row - 1) * NINP + col);
    float pf[8], qf[8]; unpack8(p, pf); unpack8(q, qf);
    const f32x4 m0 = *(const f32x4*)(mu + col), m1 = *(const f32x4*)(mu + col + 4);
    const float mf[8] = {m0.x, m0.y, m0.z, m0.w, m1.x, m1.y, m1.z, m1.w};
#pragma unroll
    for (int j = 0; j < 8; ++j) o[j] = pf[j] + (qf[j] - pf[j]) * mf[j];
}
__device__ __forceinline__ void ld8f(const float* p, float (&o)[8]) { const f32x4 a = *(const f32x4*)p, b = *(const f32x4*)(p + 4); o[0] = a.x; o[1] = a.y; o[2] = a.z; o[3] = a.w; o[4] = b.x; o[5] = b.y; o[6] = b.z; o[7] = b.w; }

constexpr int VP = 168;
__device__ __forceinline__ void attn_unit(const Args& a, LAS unsigned char* lds, int unit, int tid, int wave, int lane) {
    const bf16* proj = (const bf16*)(a.ws + WS_PROJ); bf16* mix = (bf16*)(a.ws + WS_MIX);
    const int qb = unit >> 1, kvh = unit & 1, q0 = qb * 32, kbase = q0 - 128, hq = kvh * 8 + wave;
    LAS bf16* VT = (LAS bf16*)lds;
    const int r = lane & 31, h = lane >> 5;
    bf16x8 bq[4];
    { const bf16* qrow = proj + (size_t)(q0 + r) * NINP + C_AQ + hq * 64 + 8 * h;
#pragma unroll
      for (int s = 0; s < 4; ++s) bq[s] = *(const bf16x8*)(qrow + 16 * s); }
    const float slope = exp2f(-0.5f * (float)(hq + 1)), sink = a.in[13][hq];
    f32x16 sc[5]; float mx = sink;
    bf16x8 kf[5][4];
#pragma unroll
    for (int kt = 0; kt < 5; ++kt) { const int tkb = kbase + 32 * kt;
        if (tkb >= 0) { const bf16* krow = proj + (size_t)(tkb + r) * NINP + C_AK + kvh * 64 + 8 * h;
#pragma unroll
            for (int s = 0; s < 4; ++s) kf[kt][s] = *(const bf16x8*)(krow + 16 * s); } }
    v2u gpre[2][4];
#pragma unroll
    for (int dt = 0; dt < 2; ++dt)
#pragma unroll
        for (int g4 = 0; g4 < 4; ++g4) gpre[dt][g4] = *(const v2u*)(proj + (size_t)(q0 + r) * NINP + C_AG + hq * 64 + 32 * dt + 8 * g4 + 4 * h);
    bar_lds();
    for (int idx = tid; idx < 160 * 8; idx += NTHR) {
        const int key = idx >> 3, d8 = (idx & 7) * 8, tk = kbase + key;
        v4u p = {0u, 0u, 0u, 0u};
        if (tk >= 0) p = ldg16(proj + (size_t)tk * NINP + C_AV + kvh * 64 + d8);
        const unsigned w[4] = {p.x, p.y, p.z, p.w};
#pragma unroll
        for (int j = 0; j < 4; ++j) { VT[(d8 + 2 * j) * VP + key] = (bf16)(w[j] & 0xffffu); VT[(d8 + 2 * j + 1) * VP + key] = (bf16)(w[j] >> 16); }
    }
    bar_lds();
    const float L2E = 1.44269504f, SA = 0.125f * L2E, SB = slope * L2E, sinkl = sink * L2E;
    mx = sinkl;
#pragma unroll
    for (int kt = 0; kt < 5; ++kt) {
        const int tkb = kbase + 32 * kt;
        if (tkb >= 0) {
            f32x16 acc; for (int i = 0; i < 16; ++i) acc[i] = 0.f;
#pragma unroll
            for (int s = 0; s < 4; ++s) acc = MFMA32(kf[kt][s], bq[s], acc);
            const int dli = (q0 + r) - tkb - 4 * h; const float base = -SB * (float)dli;
#pragma unroll
            for (int i = 0; i < 16; ++i) {
                const int ci = (i & 3) + 8 * (i >> 2);
                float v = __builtin_fmaf(acc[i], SA, __builtin_fmaf(SB, (float)ci, base));
                if (kt == 0) v = (dli - ci < 128) ? v : -1e30f;
                if (kt == 4) v = (dli - ci >= 0) ? v : -1e30f;
                sc[kt][i] = v; mx = fmaxf(mx, v);
            }
        } else {
#pragma unroll
            for (int i = 0; i < 16; ++i) sc[kt][i] = -1e30f;
        }
    }
    mx = fmaxf(mx, __shfl_xor(mx, 32));
    float sum = 0.f;
#pragma unroll
    for (int kt = 0; kt < 5; ++kt)
#pragma unroll
        for (int i = 0; i < 16; ++i) { const float p = __builtin_amdgcn_exp2f(sc[kt][i] - mx); sc[kt][i] = p; sum += p; }
    sum += __shfl_xor(sum, 32); sum += __builtin_amdgcn_exp2f(sinkl - mx);
    f32x16 o[2]; for (int i = 0; i < 16; ++i) { o[0][i] = 0.f; o[1][i] = 0.f; }
#pragma unroll
    for (int kt = 0; kt < 5; ++kt) {
        if (kbase + 32 * kt >= 0) {
#pragma unroll
            for (int s = 0; s < 2; ++s) {
                v4u pw; pw.x = pk2(sc[kt][8 * s + 0], sc[kt][8 * s + 1]); pw.y = pk2(sc[kt][8 * s + 2], sc[kt][8 * s + 3]); pw.z = pk2(sc[kt][8 * s + 4], sc[kt][8 * s + 5]); pw.w = pk2(sc[kt][8 * s + 6], sc[kt][8 * s + 7]);
                const bf16x8 pb = __builtin_bit_cast(bf16x8, pw);
#pragma unroll
                for (int dt = 0; dt < 2; ++dt) {
                    const LAS bf16* vp = VT + (32 * dt + r) * VP + 32 * kt + 16 * s + 4 * h;
                    const v2u lo = *(const LAS v2u*)vp, hi = *(const LAS v2u*)(vp + 8);
                    v4u vw; vw.x = lo.x; vw.y = lo.y; vw.z = hi.x; vw.w = hi.y;
                    o[dt] = MFMA32(__builtin_bit_cast(bf16x8, vw), pb, o[dt]);
                }
            }
        }
    }
    const float inv = 1.f / sum;
#pragma unroll
    for (int dt = 0; dt < 2; ++dt)
#pragma unroll
        for (int g4 = 0; g4 < 4; ++g4) {
            const int d0 = 32 * dt + 8 * g4 + 4 * h;
            float g0, g1, g2, g3;
            { const v2u gp = gpre[dt][g4]; g0 = bflo(gp.x); g1 = bfhi(gp.x); g2 = bflo(gp.y); g3 = bfhi(gp.y); }
            v2u w; w.x = pk2(o[dt][4 * g4 + 0] * inv * siluf_(g0), o[dt][4 * g4 + 1] * inv * siluf_(g1));
            w.y = pk2(o[dt][4 * g4 + 2] * inv * siluf_(g2), o[dt][4 * g4 + 3] * inv * siluf_(g3));
            *(v2u*)(mix + (size_t)(q0 + r) * D + RW + hq * 64 + d0) = w;
        }
}

struct Prep { float r[8], kp[8], v[8], g[8], w[8], lw[8], kk[8], b[8], bonus; };
__device__ __forceinline__ void rwkv_prep(const Args& a, LAS unsigned char* lds, int h, int t0, int tid, int wave, int lane, Prep& P) {
    const bf16* proj = (const bf16*)(a.ws + WS_PROJ); const bf16* upt = (const bf16*)(a.ws + WS_UPT); const bf16* aupt = upt + 65536;
    LAS bf16* TW = (LAS bf16*)lds; LAS bf16* ADm = TW + 64 * 72; LAS float* Z = (LAS float*)(lds + 18432); LAS float* AP = Z + 64 * 68;
    const int t = tid >> 3, c8 = (tid & 7) * 8, ch = h * 64 + c8, row = t0 + t;
    const float* mu = a.in[3];
    { float x[8]; load_shift8(proj, row, C_WD + c8, mu, x);
#pragma unroll
      for (int j = 0; j < 8; ++j) x[j] = 1.f - 2.f * __builtin_amdgcn_rcpf(1.f + __expf(2.f * x[j]));
      *(LAS v4u*)(TW + t * 72 + c8) = pack8(x);
      load_shift8(proj, row, C_AD + c8, mu, x); *(LAS v4u*)(ADm + t * 72 + c8) = pack8(x); }
    bar_lds();
    { const int rt = wave & 3, cp = (wave >> 2) * 2, fr = lane & 15, fq = lane >> 4;
      bf16x8 aT[2], aA[2];
#pragma unroll
      for (int s = 0; s < 2; ++s) { aT[s] = *(const LAS bf16x8*)(TW + (16 * rt + fr) * 72 + 32 * s + 8 * fq); aA[s] = *(const LAS bf16x8*)(ADm + (16 * rt + fr) * 72 + 32 * s + 8 * fq); }
#pragma unroll
      for (int ci = 0; ci < 2; ++ci) { const int ct = cp + ci; f32x4 z = {0.f, 0.f, 0.f, 0.f}, ap = {0.f, 0.f, 0.f, 0.f};
#pragma unroll
          for (int s = 0; s < 2; ++s) { const size_t bo = (size_t)(h * 64 + 16 * ct + fr) * 64 + 32 * s + 8 * fq;
              z = MFMA16(aT[s], *(const bf16x8*)(upt + bo), z); ap = MFMA16(aA[s], *(const bf16x8*)(aupt + bo), ap); }
#pragma unroll
          for (int j = 0; j < 4; ++j) { Z[(16 * rt + 4 * fq + j) * 68 + 16 * ct + fr] = z[j]; AP[(16 * rt + 4 * fq + j) * 68 + 16 * ct + fr] = ap[j]; } } }
    bar_lds();
    float zz[8], aa[8], kr[8], c0[8], c1[8];
#pragma unroll
    for (int j = 0; j < 8; ++j) { zz[j] = Z[t * 68 + c8 + j]; aa[j] = AP[t * 68 + c8 + j]; }
    load_shift8(proj, row, C_R + ch, mu, P.r); load_shift8(proj, row, C_K + ch, mu, kr); load_shift8(proj, row, C_V + ch, mu, P.v); load_shift8(proj, row, C_G + ch, mu, P.g);
    ld8f(a.in[4] + ch, c0); ld8f(a.in[6] + ch, c1);
#pragma unroll
    for (int j = 0; j < 8; ++j) { const float z = c0[j] + zz[j]; const float sp = (z < -15.f) ? -z : __logf(1.f + __expf(-z)); const float wl = -sp - 0.5f; P.lw[j] = -__expf(wl); P.w[j] = __expf(P.lw[j]); aa[j] = sigmoidf_(c1[j] + aa[j]); }
    ld8f(a.in[8] + ch, c0); ld8f(a.in[9] + ch, c1);
    float ss = 0.f;
#pragma unroll
    for (int j = 0; j < 8; ++j) { P.kk[j] = kr[j] * c0[j]; ss += P.kk[j] * P.kk[j]; P.kp[j] = kr[j] * (1.f + (aa[j] - 1.f) * c1[j]); }
    ss = sum8(ss); const float rn = 1.f / fmaxf(sqrtf(ss), 1e-12f);
    ld8f(a.in[10] + ch, c0);
    float bs = 0.f;
#pragma unroll
    for (int j = 0; j < 8; ++j) { P.kk[j] *= rn; P.b[j] = P.kk[j] * aa[j]; bs += P.r[j] * P.kp[j] * c0[j]; }
    P.bonus = sum8(bs);
}
__device__ __forceinline__ void rwkv_out8(const Args& a, const float (&y)[8], const float (&v)[8], const float (&g)[8], float bonus, int row, int ch) {
    bf16* mix = (bf16*)(a.ws + WS_MIX);
    float s = 0.f;
#pragma unroll
    for (int j = 0; j < 8; ++j) s += y[j];
    const float mean = sum8(s) * (1.f / 64.f); float q = 0.f;
#pragma unroll
    for (int j = 0; j < 8; ++j) { const float d = y[j] - mean; q += d * d; }
    const float rstd = 1.f / sqrtf(sum8(q) * (1.f / 64.f) + LNX_EPS);
    float lg[8], lb[8], o[8]; ld8f(a.in[11] + ch, lg); ld8f(a.in[12] + ch, lb);
#pragma unroll
    for (int j = 0; j < 8; ++j) { const float yn = (y[j] - mean) * rstd * lg[j] + lb[j] + bonus * v[j]; o[j] = yn * siluf_(g[j]); }
    *(v4u*)(mix + (size_t)row * D + ch) = pack8(o);
}
constexpr size_t WS_MF = 174 * MiB, WS_QF = 190 * MiB, WS_SF = 206 * MiB, WS_BON = 222 * MiB;
constexpr size_t OUT_NF = 0, OUT_Y2 = 32 * MiB;
constexpr int MP = 72;
constexpr int L_AT = 0, L_ATT = 9216, L_BT = 18432, L_KT = 27648, L_RT = 36864, L_BHT = 46080, L_KHT = 55296, L_VT = 64512, L_LW = 73728, L_P = 73728, L_PT = 82944,
              L_AAK = 92160, L_ARB = 101376, L_ARK = 110592, L_TM = 119808, L_SEG = 119808, L_GC = 129024, L_WT = L_AT, L_X1T = L_BT, L_U2T = L_KT;
struct WTile { int ta, tb0, fr, fq; };
__device__ __forceinline__ bf16x8 ldfrag(const LAS bf16* M, int tile, int s, const WTile& w) { return *(const LAS bf16x8*)(M + (16 * tile + w.fr) * MP + 32 * s + 8 * w.fq); }
__device__ __forceinline__ void mm2(const LAS bf16* A, const LAS bf16* B, const WTile& w, f32x4 (&acc)[2]) {
#pragma unroll
    for (int s = 0; s < 2; ++s) { const bf16x8 af = ldfrag(A, w.ta, s, w);
#pragma unroll
        for (int ci = 0; ci < 2; ++ci) acc[ci] = MFMA16(af, ldfrag(B, w.tb0 + ci, s, w), acc[ci]); }
}
__device__ __forceinline__ void st_T(LAS bf16* X, int ta, int tb, const WTile& w, const f32x4& v) { v2u o; o.x = pk2(v[0], v[1]); o.y = pk2(v[2], v[3]); *(LAS v2u*)(X + (16 * tb + w.fr) * MP + 16 * ta + 4 * w.fq) = o; }
__device__ __forceinline__ void st_N(LAS bf16* X, int ta, int tb, const WTile& w, const f32x4& v) {
    const unsigned a = pk2(v[0], v[1]), b = pk2(v[2], v[3]); LAS bf16* p = X + (16 * ta + 4 * w.fq) * MP + 16 * tb + w.fr;
    p[0] = (bf16)(a & 0xffffu); p[MP] = (bf16)(a >> 16); p[2 * MP] = (bf16)(b & 0xffffu); p[3 * MP] = (bf16)(b >> 16);
}
#define ZERO2(x) do { x[0] = (f32x4){0.f, 0.f, 0.f, 0.f}; x[1] = (f32x4){0.f, 0.f, 0.f, 0.f}; } while (0)
template <int MODE> __device__ __forceinline__ void mask2(f32x4 (&acc)[2], const WTile& w) {
#pragma unroll
    for (int ci = 0; ci < 2; ++ci)
#pragma unroll
        for (int j = 0; j < 4; ++j) { const int row = 16 * w.ta + 4 * w.fq + j, col = 16 * (w.tb0 + ci) + w.fr;
            const bool keep = MODE == 0 ? (row < col) : (MODE == 1 ? (row <= col) : (col < row)); if (!keep) acc[ci][j] = 0.f; }
}
__device__ __forceinline__ void st_bf16x8_T2(LAS bf16* X, int c8, int t, int lane, const float (&v)[8]) {
    const v4u p = pack8(v); const unsigned w[4] = {p.x, p.y, p.z, p.w}; const bool odd = (lane >> 3) & 1;
#pragma unroll
    for (int j = 0; j < 4; ++j) {
        const unsigned q = (unsigned)__builtin_amdgcn_update_dpp(0, (int)w[j], 0x128  , 0xf, 0xf, false);
        const unsigned o = odd ? ((q >> 16) | (w[j] & 0xffff0000u)) : ((w[j] & 0xffffu) | (q << 16));
        *(LAS unsigned*)(X + (c8 + 2 * j + (odd ? 1 : 0)) * MP + (t & ~1)) = o;
    }
}
__device__ __forceinline__ void st_bf16x8_T(LAS bf16* X, int c8, int t, const float (&v)[8]) {
    const v4u p = pack8(v); const unsigned w[4] = {p.x, p.y, p.z, p.w};
#pragma unroll
    for (int j = 0; j < 4; ++j) { X[(c8 + 2 * j) * MP + t] = (bf16)(w[j] & 0xffffu); X[(c8 + 2 * j + 1) * MP + t] = (bf16)(w[j] >> 16); }
}

__device__ __forceinline__ void rwkv_chunk_prep(const Args& a, LAS unsigned char* lds, int unit, int tid, int wave, int lane) {
    const int c = unit >> 4, h = unit & 15, t0 = c * CH, t = tid >> 3, c8 = (tid & 7) * 8;
    LAS bf16* At = (LAS bf16*)(lds + L_AT); LAS bf16* AtT = (LAS bf16*)(lds + L_ATT); LAS bf16* Bt = (LAS bf16*)(lds + L_BT); LAS bf16* Kt = (LAS bf16*)(lds + L_KT);
    LAS bf16* Rt = (LAS bf16*)(lds + L_RT); LAS bf16* BhT = (LAS bf16*)(lds + L_BHT); LAS bf16* KhT = (LAS bf16*)(lds + L_KHT); LAS bf16* VT = (LAS bf16*)(lds + L_VT);
    LAS float* LW = (LAS float*)(lds + L_LW); LAS bf16* Pm = (LAS bf16*)(lds + L_P); LAS bf16* PT = (LAS bf16*)(lds + L_PT);
    LAS bf16* AAK = (LAS bf16*)(lds + L_AAK); LAS bf16* ARB = (LAS bf16*)(lds + L_ARB); LAS bf16* ARK = (LAS bf16*)(lds + L_ARK); LAS bf16* TM = (LAS bf16*)(lds + L_TM);
    LAS float* SEG = (LAS float*)(lds + L_SEG); LAS float* GC = (LAS float*)(lds + L_GC);
    LAS bf16* WT = (LAS bf16*)(lds + L_WT); LAS bf16* X1T = (LAS bf16*)(lds + L_X1T); LAS bf16* U2T = (LAS bf16*)(lds + L_U2T);
    bar_lds();
    Prep P; rwkv_prep(a, lds, h, t0, tid, wave, lane, P);
#ifdef PROBE_PREP2
    bar_lds(); rwkv_prep(a, lds, h, t0, tid, wave, lane, P);
#endif
    if ((tid & 7) == 0) ((float*)(a.ws + WS_BON))[(size_t)(t0 + t) * 16 + h] = P.bonus;
#pragma unroll
    for (int j = 0; j < 8; ++j) LW[t * 68 + c8 + j] = P.lw[j];
    bar_lds();
    { const int cc = tid & 63, sg = tid >> 6; float run = 0.f;
#pragma unroll
      for (int i = 0; i < 8; ++i) { run += LW[(8 * sg + i) * 68 + cc]; LW[(8 * sg + i) * 68 + cc] = run; }
      SEG[sg * 64 + cc] = run; }
    bar_lds();
    {
        float Lt[8], LC[8];
#pragma unroll
        for (int j = 0; j < 8; ++j) { float off = 0.f, tot = 0.f;
#pragma unroll
            for (int s = 0; s < 8; ++s) { const float sv = SEG[s * 64 + c8 + j]; tot += sv; if (s < (t >> 3)) off += sv; }
            Lt[j] = LW[t * 68 + c8 + j] + off; LC[j] = tot; }
        if (t == 0) {
#pragma unroll
            for (int j = 0; j < 8; ++j) GC[c8 + j] = __expf(LC[j]); }
        float x[8], y[8];
#pragma unroll
        for (int j = 0; j < 8; ++j) x[j] = -P.kk[j] * __expf(Lt[j] - P.lw[j]);
        *(LAS v4u*)(At + t * MP + c8) = pack8(x); st_bf16x8_T(AtT, c8, t, x);
#pragma unroll
        for (int j = 0; j < 8; ++j) { const float e = __expf(-Lt[j]); x[j] = P.b[j] * e; y[j] = P.kp[j] * e; }
        *(LAS v4u*)(Bt + t * MP + c8) = pack8(x); *(LAS v4u*)(Kt + t * MP + c8) = pack8(y);
#pragma unroll
        for (int j = 0; j < 8; ++j) x[j] = P.r[j] * __expf(Lt[j]);
        *(LAS v4u*)(Rt + t * MP + c8) = pack8(x);
#pragma unroll
        for (int j = 0; j < 8; ++j) { const float e = __expf(LC[j] - Lt[j]); x[j] = P.b[j] * e; y[j] = P.kp[j] * e; }
        st_bf16x8_T(BhT, c8, t, x); st_bf16x8_T(KhT, c8, t, y); st_bf16x8_T(VT, c8, t, P.v);
    }
    bar_lds();
    WTile w; w.ta = wave & 3; w.tb0 = (wave >> 2) * 2; w.fr = lane & 15; w.fq = lane >> 4;
    f32x4 acc[2], Tacc[2];
    ZERO2(Tacc); mm2(At, Bt, w, Tacc); mask2<2>(Tacc, w);
    ZERO2(acc); mm2(Kt, At, w, acc); mask2<0>(acc, w);
    f32x4 rb[2], rk[2]; ZERO2(rb); mm2(Bt, Rt, w, rb); mask2<1>(rb, w); ZERO2(rk); mm2(Kt, Rt, w, rk); mask2<1>(rk, w);
    bar_lds();
#pragma unroll
    for (int ci = 0; ci < 2; ++ci) { st_N(Pm, w.ta, w.tb0 + ci, w, Tacc[ci]); st_T(PT, w.ta, w.tb0 + ci, w, Tacc[ci]);
        st_T(AAK, w.ta, w.tb0 + ci, w, acc[ci]); st_T(ARB, w.ta, w.tb0 + ci, w, rb[ci]); st_T(ARK, w.ta, w.tb0 + ci, w, rk[ci]);
#pragma unroll
        for (int j = 0; j < 4; ++j) if (16 * w.ta + 4 * w.fq + j == 16 * (w.tb0 + ci) + w.fr) Tacc[ci][j] += 1.f;
        st_N(TM, w.ta, w.tb0 + ci, w, Tacc[ci]); }
    bar_lds();
#pragma unroll 1
#ifdef PROBE_NEU2
    for (int n = 0; n < 10; ++n) {
#else
    for (int n = 0; n < 5; ++n) {
#endif
        ZERO2(acc); mm2(Pm, PT, w, acc);
        bar_lds();
#pragma unroll
        for (int ci = 0; ci < 2; ++ci) { st_N(Pm, w.ta, w.tb0 + ci, w, acc[ci]); st_T(PT, w.ta, w.tb0 + ci, w, acc[ci]); }
        bar_lds();
        mm2(TM, PT, w, Tacc);
        bar_lds();
#pragma unroll
        for (int ci = 0; ci < 2; ++ci) st_N(TM, w.ta, w.tb0 + ci, w, Tacc[ci]);
        bar_lds();
    }
    ZERO2(acc); mm2(TM, AtT, w, acc); ZERO2(rb); mm2(AAK, VT, w, rb);
#pragma unroll
    for (int ci = 0; ci < 2; ++ci) { st_T(WT, w.ta, w.tb0 + ci, w, acc[ci]); st_T(X1T, w.ta, w.tb0 + ci, w, rb[ci]); }
    bar_lds();
    const size_t ub = (size_t)unit * 4096;
    { ZERO2(acc); mm2(TM, X1T, w, acc);
#pragma unroll
      for (int ci = 0; ci < 2; ++ci) st_T(U2T, w.ta, w.tb0 + ci, w, acc[ci]);
      bf16* MF = (bf16*)(a.ws + WS_MF) + ub; bf16* QF = (bf16*)(a.ws + WS_QF) + ub;
      ZERO2(acc); mm2(WT, BhT, w, acc);
      ZERO2(rb); mm2(WT, ARB, w, rb);
#pragma unroll
      for (int ci = 0; ci < 2; ++ci) { const int tb = w.tb0 + ci; const int col = 16 * tb + w.fr; const float gc = GC[col];
          f32x4 m = acc[ci];
#pragma unroll
          for (int j = 0; j < 4; ++j) if (16 * w.ta + 4 * w.fq + j == col) m[j] += gc;
          const size_t fo = (size_t)((tb * 2 + (w.ta >> 1)) * 64 + lane) * 8 + 4 * (w.ta & 1);
          v2u o; o.x = pk2(m[0], m[1]); o.y = pk2(m[2], m[3]); *(v2u*)(MF + fo) = o;
          const v2u rr = *(const LAS v2u*)(Rt + col * MP + 16 * w.ta + 4 * w.fq);
          f32x4 q = rb[ci]; q[0] += bflo(rr.x); q[1] += bfhi(rr.x); q[2] += bflo(rr.y); q[3] += bfhi(rr.y);
          o.x = pk2(q[0], q[1]); o.y = pk2(q[2], q[3]); *(v2u*)(QF + fo) = o; } }
    bar_lds();
    { float* NF = (float*)((unsigned char*)a.out + OUT_NF) + ub; float* Y2 = (float*)((unsigned char*)a.out + OUT_Y2) + ub;
      ZERO2(acc); mm2(BhT, U2T, w, acc); mm2(KhT, VT, w, acc);
      ZERO2(rb); mm2(U2T, ARB, w, rb); mm2(VT, ARK, w, rb);
#pragma unroll
      for (int ci = 0; ci < 2; ++ci) { const int tb = w.tb0 + ci;
          *(f32x4*)(NF + (size_t)((tb * 4 + w.ta) * 64 + lane) * 4) = acc[ci];
          *(f32x4*)(Y2 + (size_t)(16 * tb + w.fr) * 64 + 16 * w.ta + 4 * w.fq) = rb[ci]; } }
}

#ifndef HSPLIT_V
#define HSPLIT_V 64
#endif
constexpr int HSPLIT = HSPLIT_V;
constexpr int KR = 4, NR = NCH / KR, SLOT = 10240, RBUF = KR * SLOT, NPIECE = RBUF / 16, LPT = 6, PPC = SLOT / 16;
__device__ __forceinline__ const v4u* sp_src(const Args& a, int h, int cg, int r, int p) {
    const int cc = p / PPC, q = p % PPC, c = r * KR + cc; const size_t ub = (size_t)(c * 16 + h) * 4096;
    return q < 512 ? (const v4u*)((const bf16*)(a.ws + WS_MF) + ub) + q : (const v4u*)((const bf16*)((const unsigned char*)a.out + OUT_NF) + ub + cg * 1024) + (q - 512);
}
__device__ __forceinline__ void state_pass(const Args& a, LAS unsigned char* lds, int b, int tid, int wave, int lane) {
    unsigned* half_flag = (unsigned*)a.ws + 7168;
    const int h = b & 15, cg = b >> 4, lt = tid - 64;
    v4u ra[LPT], rb[LPT];
    if (wave != 0) {
#pragma unroll
        for (int i = 0; i < LPT; ++i) { const int p = lt + 448 * i; if (p < NPIECE) ra[i] = *sp_src(a, h, cg, 0, p); }
#pragma unroll
        for (int i = 0; i < LPT; ++i) { const int p = lt + 448 * i; if (p < NPIECE) *(LAS v4u*)(lds + p * 16) = ra[i]; }
#pragma unroll
        for (int i = 0; i < LPT; ++i) { const int p = lt + 448 * i; if (p < NPIECE) ra[i] = *sp_src(a, h, cg, 1, p); }
    }
    f32x4 st[4];
#pragma unroll
    for (int i = 0; i < 4; ++i) st[i] = (f32x4){0.f, 0.f, 0.f, 0.f};
    bar_lds();
    bf16* SF = (bf16*)(a.ws + WS_SF);
#define SP_ROUND(r_, RA, RB) do { \
        if (wave != 0) { \
            if ((r_) + 2 < NR) { _Pragma("unroll") for (int i = 0; i < LPT; ++i) { const int p = lt + 448 * i; if (p < NPIECE) RB[i] = *sp_src(a, h, cg, (r_) + 2, p); } } \
            if ((r_) + 1 < NR) { _Pragma("unroll") for (int i = 0; i < LPT; ++i) { const int p = lt + 448 * i; if (p < NPIECE) *(LAS v4u*)(lds + (((r_) + 1) & 1) * RBUF + p * 16) = RA[i]; } } \
        } else { \
            if ((r_) == HSPLIT / KR && lane == 0) { __threadfence(); __hip_atomic_fetch_add(half_flag, 1u, __ATOMIC_RELEASE, __HIP_MEMORY_SCOPE_AGENT); }     \
            _Pragma("unroll") for (int cc = 0; cc < KR; ++cc) { \
                const LAS unsigned char* sl = lds + ((r_) & 1) * RBUF + cc * SLOT; const int c = (r_) * KR + cc; \
                v4u b0, b1; b0.x = pk2(st[0][0], st[0][1]); b0.y = pk2(st[0][2], st[0][3]); b0.z = pk2(st[1][0], st[1][1]); b0.w = pk2(st[1][2], st[1][3]); \
                b1.x = pk2(st[2][0], st[2][1]); b1.y = pk2(st[2][2], st[2][3]); b1.z = pk2(st[3][0], st[3][1]); b1.w = pk2(st[3][2], st[3][3]); \
                v4u* sfo = (v4u*)(SF + (size_t)(c * 16 + h) * 4096) + (cg * 2) * 64 + lane; sfo[0] = b0; sfo[64] = b1; \
                const bf16x8 f0 = __builtin_bit_cast(bf16x8, b0), f1 = __builtin_bit_cast(bf16x8, b1); \
                _Pragma("unroll") for (int rt = 0; rt < 4; ++rt) { \
                    const v2u nb_ = *(const LAS v2u*)(sl + 8192 + (rt * 64 + lane) * 8); f32x4 n = {bflo(nb_.x), bfhi(nb_.x), bflo(nb_.y), bfhi(nb_.y)}; \
                    n = MFMA16(*(const LAS bf16x8*)(sl + ((rt * 2 + 0) * 64 + lane) * 16), f0, n); \
                    n = MFMA16(*(const LAS bf16x8*)(sl + ((rt * 2 + 1) * 64 + lane) * 16), f1, n); st[rt] = n; } \
            } \
        } \
        bar_lds(); } while (0)
#pragma unroll 1
    for (int r = 0; r < NR; r += 2) { SP_ROUND(r, ra, rb); SP_ROUND(r + 1, rb, ra); }
#undef SP_ROUND
}

__device__ __forceinline__ void rwkv_out_unit(const Args& a, LAS unsigned char* lds, int unit, int tid, int wave, int lane) {
    const int c = unit >> 4, h = unit & 15, t0 = c * CH, t = tid >> 3, c8 = (tid & 7) * 8, ch = h * 64 + c8;
    const size_t ub = (size_t)unit * 4096;
    const bf16* QF = (const bf16*)(a.ws + WS_QF) + ub; const bf16* SF = (const bf16*)(a.ws + WS_SF) + ub; const bf16* Y2 = (const bf16*)((const unsigned char*)a.out + OUT_Y2) + ub;
    LAS float* SY = (LAS float*)lds;
    const int ta = wave & 3, tb0 = (wave >> 2) * 2, fr = lane & 15, fq = lane >> 4;
    bf16x8 af[2], bfr[2][2];
#pragma unroll
    for (int s = 0; s < 2; ++s) { af[s] = *(const bf16x8*)(QF + (size_t)((ta * 2 + s) * 64 + lane) * 8);
#pragma unroll
        for (int ci = 0; ci < 2; ++ci) bfr[s][ci] = *(const bf16x8*)(SF + (size_t)(((tb0 + ci) * 2 + s) * 64 + lane) * 8); }
    float y2[8], v[8], g[8];
    unpack8(ldg16(Y2 + t * 64 + c8), y2);
    const bf16* proj = (const bf16*)(a.ws + WS_PROJ);
    load_shift8(proj, t0 + t, C_V + ch, a.in[3], v); load_shift8(proj, t0 + t, C_G + ch, a.in[3], g);
    const float bonus = ((const float*)(a.ws + WS_BON))[(size_t)(t0 + t) * 16 + h];
    f32x4 acc[2]; ZERO2(acc);
#pragma unroll
    for (int s = 0; s < 2; ++s)
#pragma unroll
        for (int ci = 0; ci < 2; ++ci) acc[ci] = MFMA16(af[s], bfr[s][ci], acc[ci]);
    bar_lds();
#pragma unroll
    for (int ci = 0; ci < 2; ++ci)
#pragma unroll
        for (int j = 0; j < 4; ++j) SY[(16 * ta + 4 * fq + j) * 68 + 16 * (tb0 + ci) + fr] = acc[ci][j];
    bar_lds();
    float y[8];
#pragma unroll
    for (int j = 0; j < 8; ++j) y[j] = SY[t * 68 + c8 + j] + y2[j];
    rwkv_out8(a, y, v, g, bonus, t0 + t, ch);
}
constexpr int L2_SEG = 129280, L2_XST = 131328, L2_TW = 131584, L2_ADM = 140800, L2_X1T = 150016;
struct PF { v4u p[4], q[4]; };
__device__ __forceinline__ void pf_issue(PF& f, const bf16* proj, int row, int ch) {
    const int cols[4] = {C_R, C_K, C_V, C_G};
#pragma unroll
    for (int i = 0; i < 4; ++i) { f.p[i] = ldg16(proj + (size_t)row * NINP + cols[i] + ch); f.q[i] = (v4u){0u, 0u, 0u, 0u}; if (row > 0) f.q[i] = ldg16(proj + (size_t)(row - 1) * NINP + cols[i] + ch); }
}
__device__ __forceinline__ void pf_shift(const v4u& p, const v4u& q, const float (&mf)[8], float (&o)[8]) {
    float pf[8], qf[8]; unpack8(p, pf); unpack8(q, qf);
#pragma unroll
    for (int j = 0; j < 8; ++j) o[j] = pf[j] + (qf[j] - pf[j]) * mf[j];
}
template <bool DOP, bool DOT, bool CHK = false> __device__ __forceinline__ void neu_stage(const LAS bf16* Pin, const LAS bf16* PTin, LAS bf16* Pout, LAS bf16* PTout, const LAS bf16* TMin, LAS bf16* TMout, const WTile& w, f32x4 (&Tacc)[2], LAS unsigned* flag = nullptr) {
    f32x4 acc[2];
    if (DOP) { ZERO2(acc); mm2(Pin, PTin, w, acc); }
    if (DOP && CHK) {
        float m = 0.f;
#pragma unroll
        for (int ci = 0; ci < 2; ++ci)
#pragma unroll
            for (int j = 0; j < 4; ++j) m = fmaxf(m, fabsf(acc[ci][j]));
        if (m > 5e-4f) atomicMax((unsigned*)flag, __float_as_uint(m));
    }
    if (DOT) mm2(TMin, PTin, w, Tacc);
#pragma unroll
    for (int ci = 0; ci < 2; ++ci) {
        if (DOP) { st_N(Pout, w.ta, w.tb0 + ci, w, acc[ci]); st_T(PTout, w.ta, w.tb0 + ci, w, acc[ci]); }
        if (DOT) st_N(TMout, w.ta, w.tb0 + ci, w, Tacc[ci]);
    }
    bar_lds();
}
__device__ __forceinline__ void rwkv_chunk_group(const Args& a, LAS unsigned char* lds, int item, int tid, int wave, int lane) {
    const int c = item >> 1, hg = item & 1, t0 = c * CH, t = tid >> 3, c8 = (tid & 7) * 8, row = t0 + t;
    const bf16* proj = (const bf16*)(a.ws + WS_PROJ); const bf16* upt = (const bf16*)(a.ws + WS_UPT); const bf16* aupt = upt + 65536; const float* mu = a.in[3];
    LAS bf16* TW = (LAS bf16*)(lds + L2_TW); LAS bf16* ADm = (LAS bf16*)(lds + L2_ADM);
    WTile w; w.ta = wave & 3; w.tb0 = (wave >> 2) * 2; w.fr = lane & 15; w.fq = lane >> 4;
    bar_lds();
    { float x[8]; load_shift8(proj, row, C_WD + c8, mu, x);
#pragma unroll
      for (int j = 0; j < 8; ++j) x[j] = 1.f - 2.f * __builtin_amdgcn_rcpf(1.f + __expf(2.f * x[j]));
      *(LAS v4u*)(TW + t * 72 + c8) = pack8(x);
      load_shift8(proj, row, C_AD + c8, mu, x); *(LAS v4u*)(ADm + t * 72 + c8) = pack8(x); }
    PF pf; pf_issue(pf, proj, row, hg * 512 + c8);
#pragma unroll 1
    for (int hh = 0; hh < 8; ++hh) {
        const int h = hg * 8 + hh, ch = h * 64 + c8, unit = c * 16 + h;
        LAS unsigned char* L = lds; asm volatile("" : "+v"(L));
        LAS bf16* At = (LAS bf16*)(L + L_AT); LAS bf16* AtT = (LAS bf16*)(L + L_ATT); LAS bf16* Bt = (LAS bf16*)(L + L_BT); LAS bf16* Kt = (LAS bf16*)(L + L_KT);
        LAS bf16* Rt = (LAS bf16*)(L + L_RT); LAS bf16* BhT = (LAS bf16*)(L + L_BHT); LAS bf16* KhT = (LAS bf16*)(L + L_KHT); LAS bf16* VT = (LAS bf16*)(L + L_VT);
        LAS bf16* P0 = (LAS bf16*)(L + L_P); LAS bf16* PT0 = (LAS bf16*)(L + L_PT); LAS bf16* TM0 = (LAS bf16*)(L + L_TM);
        LAS bf16* P1 = At; LAS bf16* PT1 = Bt; LAS bf16* TM1 = Kt;
        LAS bf16* AAK = (LAS bf16*)(L + L_AAK); LAS bf16* ARB = (LAS bf16*)(L + L_ARB); LAS bf16* ARK = (LAS bf16*)(L + L_ARK);
        LAS float* SEG = (LAS float*)(L + L2_SEG); LAS float* GC = (LAS float*)(L + L_GC);
        LAS bf16* X1T = (LAS bf16*)(L + L2_X1T);
        LAS float* Z = (LAS float*)(L + 18432); LAS float* AP = Z + 64 * 68;
        LAS bf16* WT = At; LAS bf16* U2T = Bt; LAS unsigned* NFLAG = (LAS unsigned*)(L + 159232);
        bf16x8 bU[2][2], bA[2][2];
#pragma unroll
        for (int ci = 0; ci < 2; ++ci)
#pragma unroll
            for (int s = 0; s < 2; ++s) { const size_t bo = (size_t)(h * 64 + 16 * (w.tb0 + ci) + w.fr) * 64 + 32 * s + 8 * w.fq; bU[ci][s] = *(const bf16x8*)(upt + bo); bA[ci][s] = *(const bf16x8*)(aupt + bo); }
        float pw0[8], pa0[8], pkk[8], pka[8], prk[8], mur[8], muk[8], muv[8];
        ld8f(a.in[4] + ch, pw0); ld8f(a.in[6] + ch, pa0); ld8f(a.in[8] + ch, pkk); ld8f(a.in[9] + ch, pka); ld8f(a.in[10] + ch, prk);
        ld8f(mu + C_R + ch, mur); ld8f(mu + C_K + ch, muk); ld8f(mu + C_V + ch, muv);
        bar_lds();
#ifdef PROBE_G
        if (blockIdx.x == 0 && tid == 0 && hh == 3) ((unsigned long long*)(a.ws + 65536))[0] = __builtin_amdgcn_s_memrealtime();
#endif

        { const int rt = w.ta, cp = w.tb0, fr = w.fr, fq = w.fq;
          bf16x8 aT[2], aA[2];
#pragma unroll
          for (int s = 0; s < 2; ++s) { aT[s] = *(const LAS bf16x8*)(TW + (16 * rt + fr) * 72 + 32 * s + 8 * fq); aA[s] = *(const LAS bf16x8*)(ADm + (16 * rt + fr) * 72 + 32 * s + 8 * fq); }
#pragma unroll
          for (int ci = 0; ci < 2; ++ci) { const int ct = cp + ci; f32x4 z = {0.f, 0.f, 0.f, 0.f}, ap = {0.f, 0.f, 0.f, 0.f};
#pragma unroll
              for (int s = 0; s < 2; ++s) { z = MFMA16(aT[s], bU[ci][s], z); ap = MFMA16(aA[s], bA[ci][s], ap); }
#pragma unroll
              for (int j = 0; j < 4; ++j) { Z[(16 * rt + 4 * fq + j) * 68 + 16 * ct + fr] = z[j]; AP[(16 * rt + 4 * fq + j) * 68 + 16 * ct + fr] = ap[j]; } } }
        bar_lds();
#ifdef PROBE_G
        if (blockIdx.x == 0 && tid == 0 && hh == 3) ((unsigned long long*)(a.ws + 65536))[1] = __builtin_amdgcn_s_memrealtime();
#endif
        float r[8], kp[8], vv[8], lw[8], kk[8], bb[8];
        { float zz[8], aa[8], kr[8];
#pragma unroll
          for (int j = 0; j < 8; ++j) { zz[j] = Z[t * 68 + c8 + j]; aa[j] = AP[t * 68 + c8 + j]; }
          pf_shift(pf.p[0], pf.q[0], mur, r); pf_shift(pf.p[1], pf.q[1], muk, kr); pf_shift(pf.p[2], pf.q[2], muv, vv);
#pragma unroll
          for (int j = 0; j < 8; ++j) { const float z = pw0[j] + zz[j]; lw[j] = -0.60653066f * __builtin_amdgcn_rcpf(1.f + __expf(-z)); aa[j] = sigmoidf_(pa0[j] + aa[j]); }
          float ss = 0.f;
#pragma unroll
          for (int j = 0; j < 8; ++j) { kk[j] = kr[j] * pkk[j]; ss += kk[j] * kk[j]; kp[j] = kr[j] * (1.f + (aa[j] - 1.f) * pka[j]); }
          ss = sum8(ss); const float rn = 1.f / fmaxf(sqrtf(ss), 1e-12f);
          float bs = 0.f;
#pragma unroll
          for (int j = 0; j < 8; ++j) { kk[j] *= rn; bb[j] = kk[j] * aa[j]; bs += r[j] * kp[j] * prk[j]; }
          bs = sum8(bs);
          if ((tid & 7) == 0) ((float*)(a.ws + WS_BON))[(size_t)row * 16 + h] = bs; }
        if (hh < 7) pf_issue(pf, proj, row, ch + 64);
        float Lt[8];
#pragma unroll
        for (int j = 0; j < 8; ++j) { float x = lw[j];
#pragma unroll
            for (int d = 8; d < 64; d <<= 1) { const float y = __shfl_up(x, d); if (lane >= d) x += y; }
            Lt[j] = x; }
        if ((lane >> 3) == 7) {
#pragma unroll
            for (int j = 0; j < 8; ++j) SEG[wave * 64 + c8 + j] = Lt[j]; }
        bar_lds();
        {
            float gc[8], x[8], y[8];
            { float off[8], tot[8];
#pragma unroll
              for (int j = 0; j < 8; ++j) { off[j] = 0.f; tot[j] = 0.f; }
#pragma unroll
              for (int s = 0; s < 8; ++s) { const f32x4 s0 = *(const LAS f32x4*)(SEG + s * 64 + c8), s1 = *(const LAS f32x4*)(SEG + s * 64 + c8 + 4);
                  const float sv[8] = {s0.x, s0.y, s0.z, s0.w, s1.x, s1.y, s1.z, s1.w};
#pragma unroll
                  for (int j = 0; j < 8; ++j) { tot[j] += sv[j]; if (s < wave) off[j] += sv[j]; } }
#pragma unroll
              for (int j = 0; j < 8; ++j) { Lt[j] += off[j]; gc[j] = __expf(tot[j]); } }
            if (t == 0) {
#pragma unroll
                for (int j = 0; j < 8; ++j) GC[c8 + j] = gc[j]; }
            float e1[8], ie1[8];
#pragma unroll
            for (int j = 0; j < 8; ++j) { e1[j] = __expf(Lt[j]); ie1[j] = __builtin_amdgcn_rcpf(e1[j]); }
#pragma unroll
            for (int j = 0; j < 8; ++j) x[j] = -kk[j] * __expf(Lt[j] - lw[j]);
            *(LAS v4u*)(At + t * MP + c8) = pack8(x); st_bf16x8_T2(AtT, c8, t, lane, x);
#pragma unroll
            for (int j = 0; j < 8; ++j) { x[j] = bb[j] * ie1[j]; y[j] = kp[j] * ie1[j]; }
            *(LAS v4u*)(Bt + t * MP + c8) = pack8(x); *(LAS v4u*)(Kt + t * MP + c8) = pack8(y);
#pragma unroll
            for (int j = 0; j < 8; ++j) x[j] = r[j] * e1[j];
            *(LAS v4u*)(Rt + t * MP + c8) = pack8(x);
#pragma unroll
            for (int j = 0; j < 8; ++j) { const float e = gc[j] * ie1[j]; x[j] = bb[j] * e; y[j] = kp[j] * e; }
            st_bf16x8_T2(BhT, c8, t, lane, x); st_bf16x8_T2(KhT, c8, t, lane, y); st_bf16x8_T2(VT, c8, t, lane, vv);
        }
        bar_lds();
#ifdef PROBE_G
        if (blockIdx.x == 0 && tid == 0 && hh == 3) ((unsigned long long*)(a.ws + 65536))[2] = __builtin_amdgcn_s_memrealtime();
#endif
        f32x4 acc[2], Tacc[2], rb[2], rk[2];
        ZERO2(Tacc); mm2(At, Bt, w, Tacc); mask2<2>(Tacc, w);
        ZERO2(acc); mm2(Kt, At, w, acc); mask2<0>(acc, w);
        ZERO2(rb); mm2(Bt, Rt, w, rb); mask2<1>(rb, w); ZERO2(rk); mm2(Kt, Rt, w, rk); mask2<1>(rk, w);
        bar_lds();
#pragma unroll
        for (int ci = 0; ci < 2; ++ci) { st_N(P1, w.ta, w.tb0 + ci, w, Tacc[ci]); st_T(PT1, w.ta, w.tb0 + ci, w, Tacc[ci]);
            st_T(AAK, w.ta, w.tb0 + ci, w, acc[ci]); st_T(ARB, w.ta, w.tb0 + ci, w, rb[ci]); st_T(ARK, w.ta, w.tb0 + ci, w, rk[ci]);
#pragma unroll
            for (int j = 0; j < 4; ++j) if (16 * w.ta + 4 * w.fq + j == 16 * (w.tb0 + ci) + w.fr) Tacc[ci][j] += 1.f;
            st_N(TM1, w.ta, w.tb0 + ci, w, Tacc[ci]); }
        if (tid == 0) *NFLAG = 0u;
        bar_lds();
#ifdef PROBE_G
        if (blockIdx.x == 0 && tid == 0 && hh == 3) ((unsigned long long*)(a.ws + 65536))[3] = __builtin_amdgcn_s_memrealtime();
#endif
        { ZERO2(acc); mm2(AAK, VT, w, acc);
#pragma unroll
          for (int ci = 0; ci < 2; ++ci) st_T(X1T, w.ta, w.tb0 + ci, w, acc[ci]); }
        neu_stage<true, false>(P1, PT1, P0, PT0, nullptr, nullptr, w, Tacc);
        int nrep = 1; asm volatile("" : "+s"(nrep));
#pragma unroll 1
        for (int n = 0; n < nrep; ++n) {
            neu_stage<true, true>(P0, PT0, P1, PT1, TM1, TM0, w, Tacc);
            neu_stage<true, true, true>(P1, PT1, P0, PT0, TM0, TM1, w, Tacc, NFLAG);
        }
        if (*NFLAG != 0u) {
            neu_stage<true, true>(P0, PT0, P1, PT1, TM1, TM0, w, Tacc);
            neu_stage<true, true>(P1, PT1, P0, PT0, TM0, TM1, w, Tacc);
        }
        neu_stage<false, true>(P0, PT0, nullptr, nullptr, TM1, TM0, w, Tacc);

#ifdef PROBE_G
        if (blockIdx.x == 0 && tid == 0 && hh == 3) ((unsigned long long*)(a.ws + 65536))[4] = __builtin_amdgcn_s_memrealtime();
#endif
        ZERO2(acc); mm2(TM0, AtT, w, acc); ZERO2(rb); mm2(TM0, X1T, w, rb);
#pragma unroll
        for (int ci = 0; ci < 2; ++ci) { st_T(WT, w.ta, w.tb0 + ci, w, acc[ci]); st_T(U2T, w.ta, w.tb0 + ci, w, rb[ci]); }
        bar_lds();
        const size_t ub = (size_t)unit * 4096;
        { bf16* MF = (bf16*)(a.ws + WS_MF) + ub; bf16* QF = (bf16*)(a.ws + WS_QF) + ub;
          ZERO2(acc); mm2(WT, BhT, w, acc); ZERO2(rb); mm2(WT, ARB, w, rb);
#pragma unroll
          for (int ci = 0; ci < 2; ++ci) { const int tb = w.tb0 + ci; const int col = 16 * tb + w.fr; const float gcv = GC[col];
              f32x4 m = acc[ci];
#pragma unroll
              for (int j = 0; j < 4; ++j) if (16 * w.ta + 4 * w.fq + j == col) m[j] += gcv;
              const size_t fo = (size_t)((tb * 2 + (w.ta >> 1)) * 64 + lane) * 8 + 4 * (w.ta & 1);
              v2u o; o.x = pk2(m[0], m[1]); o.y = pk2(m[2], m[3]); *(v2u*)(MF + fo) = o;
              const v2u rr = *(const LAS v2u*)(Rt + col * MP + 16 * w.ta + 4 * w.fq);
              f32x4 q = rb[ci]; q[0] += bflo(rr.x); q[1] += bfhi(rr.x); q[2] += bflo(rr.y); q[3] += bfhi(rr.y);
              o.x = pk2(q[0], q[1]); o.y = pk2(q[2], q[3]); *(v2u*)(QF + fo) = o; }
          bf16* NF = (bf16*)((unsigned char*)a.out + OUT_NF) + ub; bf16* Y2 = (bf16*)((unsigned char*)a.out + OUT_Y2) + ub;
          ZERO2(acc); mm2(BhT, U2T, w, acc); mm2(KhT, VT, w, acc);
          ZERO2(rb); mm2(U2T, ARB, w, rb); mm2(VT, ARK, w, rb);
#pragma unroll
          for (int ci = 0; ci < 2; ++ci) { const int tb = w.tb0 + ci;
              v2u o; o.x = pk2(acc[ci][0], acc[ci][1]); o.y = pk2(acc[ci][2], acc[ci][3]); *(v2u*)(NF + (size_t)((tb * 4 + w.ta) * 64 + lane) * 4) = o;
              o.x = pk2(rb[ci][0], rb[ci][1]); o.y = pk2(rb[ci][2], rb[ci][3]); *(v2u*)(Y2 + (size_t)(16 * tb + w.fr) * 64 + 16 * w.ta + 4 * w.fq) = o; } }

#ifdef PROBE_G
        if (blockIdx.x == 0 && tid == 0 && hh == 3) ((unsigned long long*)(a.ws + 65536))[5] = __builtin_amdgcn_s_memrealtime();
#endif
    }
}
#ifndef HOSTDUP
#define HOSTDUP -1
#endif
#ifndef ONE_LAUNCH
#define ONE_LAUNCH 1
#endif
#if HOSTDUP != -1 || defined(MULTI)
#undef ONE_LAUNCH
#define ONE_LAUNCH 0
#endif
constexpr int NPHASE = 7;
__global__ void __launch_bounds__(NTHR, 2) mega(Args a) {
    extern __shared__ __attribute__((aligned(16))) unsigned char lds_[];
    LAS unsigned char* lds = (LAS unsigned char*)lds_;
    const int tid = threadIdx.x, lane = tid & 63, wave = __builtin_amdgcn_readfirstlane(tid >> 6);
    const int G = gridDim.x, bx = blockIdx.x, vcu = (G % 8 == 0) ? (bx % 8) * (G / 8) + bx / 8 : bx;
    cg::grid_group grid = cg::this_grid();
    volatile LAS unsigned* xst = (volatile LAS unsigned*)(lds + L2_XST);
    if (tid < 2) xst[tid] = 0u;
    __syncthreads();
    XcdBarrier xbar; xbar.bar = (unsigned*)a.ws; xbar.x = 0; xbar.st = xst;
    if (a.ph_hi - a.ph_lo > 1) xbar = xcd_barrier_post((unsigned*)a.ws, xst);
#ifndef PROBE_Q
#define PROBE_Q 1
#endif
#ifdef PROBE_TS
    unsigned long long ts_[10];
#define STAMP(i) do { ts_[i] = __builtin_amdgcn_s_memrealtime(); } while (0)
#else
#define STAMP(i) do {} while (0)
#endif
    STAMP(0);
#define IN(k) (a.ph_lo <= (k) && (k) < a.ph_hi)
#define SEAM(k) do { if (IN(k) && IN((k) + 1)) xcd_barrier(xbar); } while (0)
    if (a.ph_lo < 0) grid.sync();
    if (IN(0)) { p0_prologue(a, lds, vcu, G, wave, lane); }
    SEAM(0); STAMP(1);
    if (IN(1)) {
        constexpr int N1 = 6144;
        pg8::Gemm g{(const pg8::bf16_t*)(a.ws + WS_XN), (const pg8::bf16_t*)(a.ws + WS_WTIN), T, (G == 256 ? N1 : NINP), D}; pg8::StaticOrder S; S.init(T, (G == 256 ? N1 : NINP), G, bx);
        pg8::EpiBf16<0> E{(pg8::bf16_t*)(a.ws + WS_PROJ), NINP, nullptr, 0, 0, 1.f};
        pg8::gemm_phase<pg8::EpiBf16<0>, pg8::StaticOrder, true, true>(lds, g, S, E);
    }
    SEAM(1); STAMP(2);
    if (IN(2)) {
        for (int it = bx; it < NCH * 2; it += G) rwkv_chunk_group(a, lds, it, tid, wave, lane);
    }
    SEAM(2); STAMP(3);
    if (IN(3)) {
        if (bx < 64) state_pass(a, lds, bx, tid, wave, lane);
        else if (G == 256 && bx < 128) {
            pg8::Gemm g{(const pg8::bf16_t*)(a.ws + WS_XN), (const pg8::bf16_t*)(a.ws + WS_WTIN), T, NINP, D}; pg8::OneTile S{(bx - 64) >> 1, 24 + ((bx - 64) & 1)};
            pg8::EpiBf16<0> E{(pg8::bf16_t*)(a.ws + WS_PROJ), NINP, nullptr, 0, 0, 1.f};
            pg8::gemm_phase<pg8::EpiBf16<0>, pg8::OneTile, true, true>(lds, g, S, E);
        } else if (G == 256) {
            for (int it = bx - 128; it < 256; it += 128) attn_unit(a, lds, 2 * it, tid, wave, lane);
            __syncthreads();
            if (tid == 0) { unsigned* hf = (unsigned*)a.ws + 7168; unsigned spins = 0;
                while (__hip_atomic_load(hf, __ATOMIC_RELAXED, __HIP_MEMORY_SCOPE_AGENT) < 64u) { __builtin_amdgcn_s_sleep(4); if (++spins > (1u << 22)) break; }
                __builtin_amdgcn_fence(__ATOMIC_ACQUIRE, "agent"); }
            __syncthreads();
            for (int u = bx - 128; u < HSPLIT * NH; u += 128) rwkv_out_unit(a, lds, u, tid, wave, lane);
        }
    }
    SEAM(3); STAMP(4);
    if (IN(4)) {
        if (G == 256) { for (int it = bx; it < 256; it += G) attn_unit(a, lds, 2 * it + 1, tid, wave, lane); }
        else { for (int it = bx; it < 512; it += G) attn_unit(a, lds, it, tid, wave, lane); }
        STAMP(8);
        for (int u = (G == 256 ? HSPLIT * NH : 0) + bx; u < NCH * NH; u += G) rwkv_out_unit(a, lds, u, tid, wave, lane);
    }
    SEAM(4); STAMP(5);
    if (IN(5)) {
        pg8::Gemm g{(const pg8::bf16_t*)(a.ws + WS_MIX), (const pg8::bf16_t*)(a.ws + WS_WTOUT), T, D, D}; pg8::StaticOrder S; S.init(T, D, G, bx);
        if (G == 256 && a.ph_hi - a.ph_lo > 1) {
            pg8::EpiResidNorm E{a.in[0], a.out, (float*)(a.ws + WS_SSP), (unsigned*)a.ws + 4096, a.in[15], D, RMS_EPS};
            pg8::gemm_phase<pg8::EpiResidNorm, pg8::StaticOrder, false, true>(lds, g, S, E);
        } else {
            pg8::EpiResid E{a.in[0], a.out, (float*)(a.ws + WS_SSP), D};
            pg8::gemm_phase<pg8::EpiResid, pg8::StaticOrder, true, true>(lds, g, S, E);
        }
    }
    if (!(G == 256 && a.ph_hi - a.ph_lo > 1)) { SEAM(5); } STAMP(6);
    if (IN(6) && !(G == 256 && a.ph_hi - a.ph_lo > 1)) final_norm(a, vcu, G, wave, lane);
#ifdef PROBE_G
    __syncthreads();
    if (bx == 0 && tid == 0) { const unsigned long long* g_ = (const unsigned long long*)(a.ws + 65536); a.out[0] = (float)(g_[PROBE_G + 1] - g_[PROBE_G]) * 0.1f; }
#endif
#ifdef PROBE_TS
    STAMP(7); __syncthreads();
    if (bx == 0 && tid == 0) { const int k_ = PROBE_TS; const unsigned long long d_ = (k_ == 9) ? ts_[7] - ts_[0] : (k_ == 8) ? ts_[8] - ts_[4] : ts_[k_ + 1] - ts_[k_]; a.out[0] = (float)(((int)((float)d_ * 0.01f) / PROBE_Q) * PROBE_Q + PROBE_Q / 2); }
#endif
#undef IN
#undef SEAM
}

extern "C" void kernel_launch(void* const* d_in, const int* in_sizes, int n_in, void* d_out, int out_size, void* d_ws, size_t ws_size, hipStream_t stream) {
    static int grid = 0;
    if (grid == 0) {
        int dev = 0, cus = 0;
        if (hipGetDevice(&dev) != hipSuccess || hipDeviceGetAttribute(&cus, hipDeviceAttributeMultiprocessorCount, dev) != hipSuccess) { fprintf(stderr, "kernel_launch: device query failed\n"); grid = -1; return; }
        if (hipFuncSetAttribute((const void*)mega, hipFuncAttributeMaxDynamicSharedMemorySize, LDS_BYTES) != hipSuccess) { fprintf(stderr, "kernel_launch: hipFuncSetAttribute failed\n"); grid = -1; return; }
        (void)hipGetLastError();
        grid = cus;
    }
    if (grid < 0) return;
    Args a{};
    for (int i = 0; i < 16; ++i) a.in[i] = (const float*)d_in[i];
    a.out = (float*)d_out; a.ws = (unsigned char*)d_ws;
#if ONE_LAUNCH
    (void)hipMemsetAsync(d_ws, 0, 32768, stream);
    a.ph_lo = 0; a.ph_hi = NPHASE;
    void* args[] = {&a};
#ifdef PROBE_PLAIN
    hipLaunchKernelGGL(mega, dim3(grid), dim3(NTHR), LDS_BYTES, stream, a); hipError_t e = hipSuccess; (void)args;
#else
    hipError_t e = hipLaunchCooperativeKernel((const void*)mega, dim3(grid), dim3(NTHR), args, LDS_BYTES, stream);
#endif
    if (e != hipSuccess) fprintf(stderr, "cooperative launch failed: %s (grid %d)\n", hipGetErrorString(e), grid);
#else
    for (int p = 0; p < NPHASE; ++p) for (int rep = 0; rep < (p == HOSTDUP ? 2 : 1); ++rep) { a.ph_lo = p; a.ph_hi = p + 1; hipLaunchKernelGGL(mega, dim3(grid), dim3(NTHR), LDS_BYTES, stream, a); }
#endif
}
```

```cpp
#include <hip/hip_runtime.h>
#include <hip/hip_cooperative_groups.h>
#include <cstdio>
#include <cstdint>
namespace cg = cooperative_groups;
namespace pg8 {
#define PG8_LAS __attribute__((address_space(3)))
typedef unsigned short bf16_t;
typedef short bf16x8 __attribute__((ext_vector_type(8)));
typedef float f32x4 __attribute__((ext_vector_type(4)));
typedef unsigned u32x4 __attribute__((ext_vector_type(4)));
constexpr int BM = 256, BK = 64, HALF = 128, HTB = HALF * BK * 2  , STAGE_BYTES = 8 * HTB, NXCD = 8, WGM = 8;

__host__ __device__ __forceinline__ int lds_byte(int r, int c) { const int st = (r >> 4) * 2 + (c >> 5), rr = r & 15, cc = c & 31, ob = rr * 64 + cc * 2; return st * 1024 + (ob ^ (((ob >> 9) & 1) << 5)); }
__host__ __device__ __forceinline__ void stage_rc(int b, int& R, int& C) { const int st = b / 1024, sb = b % 1024, swz = sb ^ (((sb >> 9) & 1) << 5); R = (st >> 1) * 16 + swz / 64; C = (st & 1) * 32 + (swz % 64) / 2; }
__host__ __device__ __forceinline__ int perm32(int rho) { const int n = rho >> 4, i = rho & 15; return 8 * (i >> 2) + 4 * n + (i & 3); }

struct Unit { int pm, pn; };
struct Gemm { const bf16_t* A; const bf16_t* Bt; int M, N, K; };

struct StaticOrder {
    int nM, nN, nwg, G, c;
    __host__ __device__ void init(int M, int N, int G_, int c_) { nM = M / BM; nN = N / BM; nwg = nM * nN; G = G_; c = c_; }
    __host__ __device__ bool next(int i, Unit& u) const {
        const long L = (long)i * G + c; if (L >= nwg) return false;
        int wgid = (int)L; { const int q = nwg / NXCD, r = nwg % NXCD, xcd = wgid % NXCD, off = wgid / NXCD; wgid = (xcd < r ? xcd * (q + 1) : r * (q + 1) + (xcd - r) * q) + off; }
        const int nig = WGM * nN, gid = wgid / nig, fm = gid * WGM, gsz = (nM - fm) < WGM ? (nM - fm) : WGM;
        u.pm = fm + ((wgid % nig) % gsz); u.pn = (wgid % nig) / gsz; return true;
    }
    __device__ __forceinline__ void a_ready(const Unit&) const {}
    __device__ __forceinline__ void done(const Unit&) const {}
};

__device__ __forceinline__ unsigned cvt_pk_bf16(float lo, float hi) { unsigned r; asm volatile("v_cvt_pk_bf16_f32 %0, %1, %2" : "=v"(r) : "v"(lo), "v"(hi)); return r; }
typedef float f32x2 __attribute__((ext_vector_type(2)));
__device__ __forceinline__ f32x2 gelu_pk(f32x2 v) {
    const f32x2 av = __builtin_elementwise_abs(v), d = av * 0.2316418882f + 1.0f;
    f32x2 t; t.x = __builtin_amdgcn_rcpf(d.x); t.y = __builtin_amdgcn_rcpf(d.y);
    f32x2 q = t * 0.5307027145f + (-0.7265760135f); q = q * t + 0.7107068705f; q = q * t + (-0.142248368f); q = q * t + 0.127414796f; q = q * t;
    const f32x2 s = (v * v) * (-0.72134752044f);
    f32x2 e; e.x = __builtin_amdgcn_exp2f(s.x); e.y = __builtin_amdgcn_exp2f(s.y);
    const f32x2 m = v * (q * e), r = v - m;
    f32x2 o; o.x = v.x < 0.f ? m.x : r.x; o.y = v.y < 0.f ? m.y : r.y; return o;
}

template <int ACT  > struct EpiBf16 {
    static constexpr bool PERM = true, AFTER_DRAIN = false; static_assert(ACT == 0 || ACT == 1, "EpiBf16: ACT is 0 (none) or 1 (gelu_pk)");
    bf16_t* O; int ldc; const float* bias; int split_cols; size_t split_stride; float scale0;
    __device__ __forceinline__ void operator()(const f32x4 (&acc)[2][2][4][2], const Unit& u, int wr, int wc, int fr, int fq) const {
        const int row0 = u.pm * BM + wr * 64 + fr; int colt = u.pn * BM; bf16_t* base = O;
        float sc = 1.f; if (split_cols) { const int t = colt / split_cols; base += (size_t)t * split_stride; colt -= t * split_cols; if (t == 0) sc = scale0; }
        const int col0 = colt + wc * 32 + 8 * fq, bcol0 = u.pn * BM + wc * 32 + 8 * fq;
        f32x4 bv[2][2];
#pragma unroll
        for (int bj = 0; bj < 2; ++bj)
#pragma unroll
            for (int n = 0; n < 2; ++n) bv[bj][n] = bias ? *(const f32x4*)(bias + bcol0 + bj * HALF + 4 * n) : (f32x4){0.f, 0.f, 0.f, 0.f};
#pragma unroll
        for (int ai = 0; ai < 2; ++ai)
#pragma unroll
            for (int m = 0; m < 4; ++m) { bf16_t* rowp = base + (size_t)(row0 + ai * HALF + m * 16) * ldc + col0;
#pragma unroll
                for (int bj = 0; bj < 2; ++bj) { f32x4 v0 = acc[ai][bj][m][0] + bv[bj][0], v1 = acc[ai][bj][m][1] + bv[bj][1];
                    if (ACT == 1) { f32x2 a = gelu_pk((f32x2){v0[0], v0[1]}), b = gelu_pk((f32x2){v0[2], v0[3]}), c = gelu_pk((f32x2){v1[0], v1[1]}), d = gelu_pk((f32x2){v1[2], v1[3]});
                        v0 = (f32x4){a.x, a.y, b.x, b.y}; v1 = (f32x4){c.x, c.y, d.x, d.y}; }
                    v0 = v0 * sc; v1 = v1 * sc; u32x4 w; w.x = cvt_pk_bf16(v0[0], v0[1]); w.y = cvt_pk_bf16(v0[2], v0[3]); w.z = cvt_pk_bf16(v1[0], v1[1]); w.w = cvt_pk_bf16(v1[2], v1[3]);
                    *(u32x4*)(rowp + bj * HALF) = w; } }
    }
};
struct EpiResid {
    static constexpr bool PERM = false, AFTER_DRAIN = false;
    const float* x; float* out; float* sspart; int ldc;
    __device__ __forceinline__ void operator()(const f32x4 (&acc)[2][2][4][2], const Unit& u, int wr, int wc, int fr, int fq) const {
        const int row0 = u.pm * BM + wr * 64 + fr, col0 = u.pn * BM + wc * 32 + 4 * fq;
#pragma unroll
        for (int ai = 0; ai < 2; ++ai)
#pragma unroll
            for (int m = 0; m < 4; ++m) {
                const int row = row0 + ai * HALF + m * 16; float ss = 0.f;
#pragma unroll
                for (int bj = 0; bj < 2; ++bj)
#pragma unroll
                    for (int n = 0; n < 2; ++n) {
                        const size_t off = (size_t)row * ldc + col0 + bj * HALF + n * 16;
                        const f32x4 xv = *(const f32x4*)(x + off); const f32x4 v = acc[ai][bj][m][n] + xv;
                        *(f32x4*)(out + off) = v; ss += (v[0] * v[0] + v[1] * v[1]) + (v[2] * v[2] + v[3] * v[3]);
                    }
                ss += __shfl_xor(ss, 16); ss += __shfl_xor(ss, 32);
                if (fq == 0) sspart[(size_t)row * 32 + u.pn * 4 + wc] = ss;
            }
    }
};

struct OneTile {
    int pm, pn;
    __host__ __device__ bool next(int i, Unit& u) const { if (i != 0) return false; u.pm = pm; u.pn = pn; return true; }
    __device__ __forceinline__ void a_ready(const Unit&) const {}
    __device__ __forceinline__ void done(const Unit&) const {}
};
struct EpiResidNorm {
    static constexpr bool PERM = false, AFTER_DRAIN = true;
    const float* x; float* out; float* ssp; unsigned* cnt; const float* gain; int ldc; float eps;
    __device__ __forceinline__ void fused(f32x4 (&acc)[2][2][4][2], const Unit& u, int wr, int wc, int fr, int fq, PG8_LAS unsigned char* lds, int wid, int lane) const {
        const int row0 = u.pm * BM + wr * 64 + fr, col0 = u.pn * BM + wc * 32 + 4 * fq;
#pragma unroll
        for (int ai = 0; ai < 2; ++ai) {
            f32x4 xv[4][2][2];
#pragma unroll
            for (int m = 0; m < 4; ++m)
#pragma unroll
                for (int bj = 0; bj < 2; ++bj)
#pragma unroll
                    for (int n = 0; n < 2; ++n) xv[m][bj][n] = *(const f32x4*)(x + (size_t)(row0 + ai * HALF + m * 16) * ldc + col0 + bj * HALF + n * 16);
#pragma unroll
            for (int m = 0; m < 4; ++m) {
                const int row = row0 + ai * HALF + m * 16; float ss = 0.f;
#pragma unroll
                for (int bj = 0; bj < 2; ++bj)
#pragma unroll
                    for (int n = 0; n < 2; ++n) {
                        const f32x4 v = acc[ai][bj][m][n] + xv[m][bj][n];
                        acc[ai][bj][m][n] = v; ss += (v[0] * v[0] + v[1] * v[1]) + (v[2] * v[2] + v[3] * v[3]);
                    }
                ss += __shfl_xor(ss, 16); ss += __shfl_xor(ss, 32);
                if (fq == 0) __hip_atomic_store(ssp + (size_t)row * 32 + u.pn * 4 + wc, ss, __ATOMIC_RELAXED, __HIP_MEMORY_SCOPE_AGENT);
            }
        }
        asm volatile("s_waitcnt vmcnt(0)" ::: "memory");
        __syncthreads();
        unsigned* c = cnt + 64 * u.pm;
        if (threadIdx.x == 0) {
            __hip_atomic_fetch_add(c, 1u, __ATOMIC_RELEASE, __HIP_MEMORY_SCOPE_AGENT);
            unsigned spins = 0;
            while (__hip_atomic_load(c, __ATOMIC_RELAXED, __HIP_MEMORY_SCOPE_AGENT) < 8u) { __builtin_amdgcn_s_sleep(2); if (++spins > (1u << 22)) break; }
            __builtin_amdgcn_fence(__ATOMIC_ACQUIRE, "agent");
        }
        __syncthreads();
        PG8_LAS float* S = (PG8_LAS float*)lds;
        if (threadIdx.x < 256) {
            const float* p = ssp + (size_t)(u.pm * BM + threadIdx.x) * 32; float s = 0.f;
#pragma unroll
            for (int i = 0; i < 32; ++i) s += __hip_atomic_load(p + i, __ATOMIC_RELAXED, __HIP_MEMORY_SCOPE_AGENT);
            S[threadIdx.x] = 1.0f / sqrtf(s * (1.0f / 2048.0f) + eps);
        }
        __syncthreads();
#pragma unroll
        for (int bj = 0; bj < 2; ++bj)
#pragma unroll
            for (int n = 0; n < 2; ++n) {
                const f32x4 g = *(const f32x4*)(gain + col0 + bj * HALF + n * 16);
#pragma unroll
                for (int ai = 0; ai < 2; ++ai)
#pragma unroll
                    for (int m = 0; m < 4; ++m) {
                        const int lr = wr * 64 + fr + ai * HALF + m * 16; const float rs = S[lr];
                        f32x4 v = acc[ai][bj][m][n]; v[0] *= rs * g[0]; v[1] *= rs * g[1]; v[2] *= rs * g[2]; v[3] *= rs * g[3];
                        *(f32x4*)(out + (size_t)(u.pm * BM + lr) * ldc + col0 + bj * HALF + n * 16) = v;
                    }
            }
    }
};

template <class Epi, class Sched, bool ALIGN_EPI = false, bool SP2 = false>
__device__ __forceinline__ void gemm_phase(PG8_LAS unsigned char* lds, const Gemm g, const Sched& S, const Epi& E) {
    const int tid = threadIdx.x, wid = __builtin_amdgcn_readfirstlane(tid >> 6), lane = tid & 63, wr = wid >> 2, wc = wid & 3, fr = lane & 15, fq = lane >> 4;
    const int K = g.K, nt = K / BK;
    unsigned voffA[2], voffB[2];
#pragma unroll
    for (int i = 0; i < 2; ++i) { int R, C; stage_rc(tid * 16 + i * 8192, R, C); const int Rb = Epi::PERM ? ((R & ~31) + perm32(R & 31)) : R;
        voffA[i] = (unsigned)(R * K + C) * 2u; voffB[i] = (unsigned)(Rb * K + C) * 2u; }
    const size_t kstep = (size_t)(BK * 2);
    const size_t hstep = (size_t)HALF * K * 2;
    const size_t tstep = 2 * hstep;
    const unsigned ldsw = (unsigned)wid * 1024u;
    const int aoff = lds_byte(wr * 64 + fr, fq * 8), boff = lds_byte(wc * 32 + fr, fq * 8);
#define PG8_SA(b, h) (((b) * 2 + (h)) * HTB)
#define PG8_SB(b, h) ((4 + (b) * 2 + (h)) * HTB)
#define PG8_STAGE(bufoff, gbase, voff) do { _Pragma("unroll") for (int _i = 0; _i < 2; ++_i) \
        __builtin_amdgcn_global_load_lds((const unsigned*)((const char*)(gbase) + (voff)[_i]), (PG8_LAS unsigned*)(lds + (bufoff) + ldsw + _i * 8192), 16, 0, 0); } while (0)
#define PG8_LDA(dst, b, h) do { _Pragma("unroll") for (int m = 0; m < 4; ++m) _Pragma("unroll") for (int k = 0; k < 2; ++k) dst[m][k] = *(const PG8_LAS bf16x8*)(lds + PG8_SA(b, h) + aoff + m * 2048 + k * 1024); } while (0)
#define PG8_LDB(dst, b, h) do { _Pragma("unroll") for (int n = 0; n < 2; ++n) _Pragma("unroll") for (int k = 0; k < 2; ++k) dst[n][k] = *(const PG8_LAS bf16x8*)(lds + PG8_SB(b, h) + boff + n * 2048 + k * 1024); } while (0)
#define PG8_MMA(ai, bj, At, Bt) do { __builtin_amdgcn_s_setprio(1); _Pragma("unroll") for (int m = 0; m < 4; ++m) _Pragma("unroll") for (int n = 0; n < 2; ++n) _Pragma("unroll") for (int k = 0; k < 2; ++k) \
        acc[ai][bj][m][n] = __builtin_amdgcn_mfma_f32_16x16x32_bf16(Bt[n][k], At[m][k], acc[ai][bj][m][n], 0, 0, 0); __builtin_amdgcn_s_setprio(0); } while (0)
#define PG8_WAIT_V(n) asm volatile("s_waitcnt vmcnt(" #n ")" ::: "memory")
#define PG8_WAIT_L(n) asm volatile("s_waitcnt lgkmcnt(" #n ")" ::: "memory")
#define PG8_BAR __builtin_amdgcn_s_barrier()
#define PG8_SCHED __builtin_amdgcn_sched_barrier(0)
    Unit cur, nxt; int ui = 0;
    if (!S.next(0, cur)) return;
    f32x4 acc[2][2][4][2];
#pragma unroll
    for (int a = 0; a < 2; ++a)
#pragma unroll
        for (int b = 0; b < 2; ++b)
#pragma unroll
            for (int m = 0; m < 4; ++m)
#pragma unroll
                for (int n = 0; n < 2; ++n) acc[a][b][m][n] = (f32x4){0.f, 0.f, 0.f, 0.f};
    bf16x8 At[4][2], B0[2][2], B1[2][2];
    const char* cA = (const char*)g.A + (size_t)cur.pm * tstep; const char* cB = (const char*)g.Bt + (size_t)cur.pn * tstep;
    S.a_ready(cur);
    if constexpr (SP2) {
        PG8_STAGE(PG8_SB(0, 0), cB, voffB); PG8_STAGE(PG8_SB(0, 1), cB + hstep, voffB); PG8_STAGE(PG8_SA(0, 0), cA, voffA); PG8_STAGE(PG8_SA(0, 1), cA + hstep, voffA);
        if (wr == 1) PG8_BAR;
        PG8_WAIT_V(2); PG8_BAR;
        PG8_STAGE(PG8_SB(1, 0), cB + kstep, voffB); PG8_STAGE(PG8_SA(1, 0), cA + kstep, voffA); PG8_STAGE(PG8_SB(1, 1), cB + hstep + kstep, voffB);
        PG8_WAIT_V(6); PG8_BAR;
    } else {
        PG8_STAGE(PG8_SB(0, 0), cB, voffB); PG8_STAGE(PG8_SA(0, 0), cA, voffA); PG8_STAGE(PG8_SB(0, 1), cB + hstep, voffB); PG8_STAGE(PG8_SA(0, 1), cA + hstep, voffA);
        if (wr == 1) PG8_BAR;
        PG8_WAIT_V(4); PG8_BAR;
        PG8_STAGE(PG8_SB(1, 0), cB + kstep, voffB); PG8_STAGE(PG8_SA(1, 0), cA + kstep, voffA); PG8_STAGE(PG8_SB(1, 1), cB + hstep + kstep, voffB);
        PG8_WAIT_V(6); PG8_BAR;
    }
    for (;;) {
        const bool has_next = S.next(ui + 1, nxt);
        const char* nA = has_next ? (const char*)g.A + (size_t)nxt.pm * tstep : cA; const char* nB = has_next ? (const char*)g.Bt + (size_t)nxt.pn * tstep : cB;
        for (int t = 0; t < nt; t += 2) {
            const bool last = (t == nt - 2);
            const char* a1 = cA + (size_t)(t + 1) * kstep;
            const char* a2 = last ? nA : cA + (size_t)(t + 2) * kstep; const char* b2 = last ? nB : cB + (size_t)(t + 2) * kstep;
            const char* a3 = a2 + kstep; const char* b3 = b2 + kstep;
            if (last && has_next) S.a_ready(nxt);
            if constexpr (SP2) {
            PG8_LDB(B0, 0, 0); PG8_LDB(B1, 0, 1); PG8_SCHED; PG8_LDA(At, 0, 0); PG8_STAGE(PG8_SA(1, 1), a1 + hstep, voffA);
            PG8_WAIT_V(8); PG8_WAIT_L(0); PG8_BAR; PG8_MMA(0, 0, At, B0); PG8_MMA(0, 1, At, B1); PG8_BAR; PG8_SCHED;
            PG8_LDA(At, 0, 1); PG8_STAGE(PG8_SB(0, 0), b2, voffB); PG8_STAGE(PG8_SB(0, 1), b2 + hstep, voffB); PG8_STAGE(PG8_SA(0, 0), a2, voffA);
            PG8_WAIT_V(8); PG8_WAIT_L(0); PG8_BAR; PG8_MMA(1, 0, At, B0); PG8_MMA(1, 1, At, B1); PG8_BAR; PG8_SCHED;
            PG8_LDB(B0, 1, 0); PG8_LDB(B1, 1, 1); PG8_SCHED; PG8_LDA(At, 1, 0); PG8_STAGE(PG8_SA(0, 1), a2 + hstep, voffA);
            PG8_WAIT_V(8); PG8_WAIT_L(0); PG8_BAR; PG8_MMA(0, 0, At, B0); PG8_MMA(0, 1, At, B1); PG8_BAR; PG8_SCHED;
            PG8_LDA(At, 1, 1); PG8_STAGE(PG8_SB(1, 0), b3, voffB); PG8_STAGE(PG8_SB(1, 1), b3 + hstep, voffB); PG8_STAGE(PG8_SA(1, 0), a3, voffA);
            PG8_WAIT_V(8); PG8_WAIT_L(0); PG8_BAR; PG8_MMA(1, 0, At, B0); PG8_MMA(1, 1, At, B1); PG8_BAR; PG8_SCHED;
            } else {
            PG8_LDB(B0, 0, 0); PG8_SCHED; PG8_LDA(At, 0, 0); PG8_STAGE(PG8_SA(1, 1), a1 + hstep, voffA);
            PG8_WAIT_L(8); PG8_BAR; PG8_WAIT_L(0); PG8_MMA(0, 0, At, B0); PG8_BAR; PG8_SCHED;
            PG8_LDB(B1, 0, 1); PG8_STAGE(PG8_SB(0, 0), b2, voffB);
            PG8_BAR; PG8_WAIT_L(0); PG8_MMA(0, 1, At, B1); PG8_BAR;
            PG8_LDA(At, 0, 1); PG8_STAGE(PG8_SA(0, 0), a2, voffA);
            PG8_BAR; PG8_WAIT_L(0); PG8_MMA(1, 0, At, B0); PG8_BAR; PG8_SCHED;
            PG8_STAGE(PG8_SB(0, 1), b2 + hstep, voffB);
            PG8_WAIT_V(6); PG8_BAR; PG8_MMA(1, 1, At, B1); PG8_BAR;
            PG8_LDB(B0, 1, 0); PG8_SCHED; PG8_LDA(At, 1, 0); PG8_STAGE(PG8_SA(0, 1), a2 + hstep, voffA);
            PG8_WAIT_L(8); PG8_BAR; PG8_WAIT_L(0); PG8_MMA(0, 0, At, B0); PG8_BAR; PG8_SCHED;
            PG8_LDB(B1, 1, 1); PG8_STAGE(PG8_SB(1, 0), b3, voffB);
            PG8_BAR; PG8_WAIT_L(0); PG8_MMA(0, 1, At, B1); PG8_BAR;
            PG8_LDA(At, 1, 1); PG8_STAGE(PG8_SA(1, 0), a3, voffA);
            PG8_BAR; PG8_WAIT_L(0); PG8_MMA(1, 0, At, B0); PG8_BAR; PG8_SCHED;
            PG8_STAGE(PG8_SB(1, 1), b3 + hstep, voffB);
            PG8_WAIT_V(6); PG8_BAR; PG8_MMA(1, 1, At, B1); PG8_BAR;
            }
        }
        if constexpr (ALIGN_EPI) { if (wr == 0) PG8_BAR; }
        if constexpr (!Epi::AFTER_DRAIN) { E(acc, cur, wr, wc, fr, fq); S.done(cur); }
        if (!has_next) break;
#pragma unroll
        for (int a = 0; a < 2; ++a)
#pragma unroll
            for (int b = 0; b < 2; ++b)
#pragma unroll
                for (int m = 0; m < 4; ++m)
#pragma unroll
                    for (int n = 0; n < 2; ++n) acc[a][b][m][n] = (f32x4){0.f, 0.f, 0.f, 0.f};
        cur = nxt; cA = nA; cB = nB; ++ui;
        if constexpr (ALIGN_EPI) { if (wr == 1) PG8_BAR; }
    }
    PG8_WAIT_V(0);
    if constexpr (!ALIGN_EPI) { if (wr == 0) PG8_BAR; }
    PG8_BAR;
    if constexpr (Epi::AFTER_DRAIN) { E.fused(acc, cur, wr, wc, fr, fq, lds, wid, lane); S.done(cur); }
#undef PG8_SA
#undef PG8_SB
#undef PG8_STAGE
#undef PG8_LDA
#undef PG8_LDB
#undef PG8_MMA
#undef PG8_WAIT_V
#undef PG8_WAIT_L
#undef PG8_BAR
#undef PG8_SCHED
}
}
constexpr int T = 8192, D = 2048, NIN = 6528, NINP = 6656, RW = 1024, NH = 16, HD = 64, CH = 64, NCH = T / CH;
constexpr int C_R = 0, C_K = 1024, C_V = 2048, C_WD = 3072, C_AD = 3136, C_G = 3200, C_AQ = 4224, C_AK = 5248, C_AV = 5376, C_AG = 5504;
constexpr float RMS_EPS = 1e-5f, LNX_EPS = 64e-5f;
constexpr int NWAVES = 8, NTHR = 512;
constexpr size_t MiB = 1u << 20;
constexpr size_t WS_WTIN = 1 * MiB;
constexpr size_t WS_XN = 27 * MiB;
constexpr size_t WS_WTOUT = 59 * MiB;
constexpr size_t WS_UPT = 67 * MiB;
constexpr size_t WS_SSP = 68 * MiB;
constexpr size_t WS_PROJ = 70 * MiB;
constexpr size_t WS_SCR = 174 * MiB;
constexpr size_t WS_MIX = 223 * MiB;
constexpr size_t WS_P32 = 223 * MiB;
constexpr int LDS_BYTES = 163840;

#define GAS __attribute__((address_space(1)))
#define LAS __attribute__((address_space(3)))
typedef unsigned short bf16;
typedef unsigned v4u __attribute__((ext_vector_type(4)));
typedef unsigned v2u __attribute__((ext_vector_type(2)));
typedef float f32x4 __attribute__((ext_vector_type(4)));
typedef float f32x16 __attribute__((ext_vector_type(16)));
typedef short bf16x8 __attribute__((ext_vector_type(8)));
typedef __bf16 bf16x2_t __attribute__((ext_vector_type(2)));
__device__ __forceinline__ unsigned pk2(float a, float b) { bf16x2_t v; v[0] = (__bf16)a; v[1] = (__bf16)b; return __builtin_bit_cast(unsigned, v); }
__device__ __forceinline__ float bflo(unsigned u) { return __uint_as_float(u << 16); }
__device__ __forceinline__ float bfhi(unsigned u) { return __uint_as_float(u & 0xffff0000u); }
__device__ __forceinline__ void unpack8(const v4u& p, float (&f)[8]) { f[0] = bflo(p.x); f[1] = bfhi(p.x); f[2] = bflo(p.y); f[3] = bfhi(p.y); f[4] = bflo(p.z); f[5] = bfhi(p.z); f[6] = bflo(p.w); f[7] = bfhi(p.w); }
__device__ __forceinline__ v4u pack8(const float (&f)[8]) { v4u o; o.x = pk2(f[0], f[1]); o.y = pk2(f[2], f[3]); o.z = pk2(f[4], f[5]); o.w = pk2(f[6], f[7]); return o; }
__device__ __forceinline__ float wave_sum(float v) {
#pragma unroll
    for (int o = 1; o < 64; o <<= 1) v += __shfl_xor(v, o);
    return v;
}
__device__ __forceinline__ float sum8(float v) { v += __shfl_xor(v, 1); v += __shfl_xor(v, 2); v += __shfl_xor(v, 4); return v; }
__device__ __forceinline__ float sigmoidf_(float x) { return 1.f / (1.f + __expf(-x)); }
__device__ __forceinline__ float siluf_(float x) { return x / (1.f + __expf(-x)); }

__device__ __forceinline__ void bar_lds() { asm volatile("s_waitcnt lgkmcnt(0)" ::: "memory"); __builtin_amdgcn_s_barrier(); asm volatile("" ::: "memory"); }
struct Args { const float* in[16]; float* out; unsigned char* ws; int ph_lo, ph_hi; };

struct TItem { const float* W; bf16* WT; int K, N, k0, n0; };
__device__ __forceinline__ bool p0_item(const Args& a, int it, TItem& o) {
    constexpr int I_IN = (D / 64) * (NIN / 32), I_OUT = (D / 64) * (D / 32), I_UP = RW / 32;
    bf16* wtin = (bf16*)(a.ws + WS_WTIN); bf16* wtout = (bf16*)(a.ws + WS_WTOUT); bf16* upt = (bf16*)(a.ws + WS_UPT); bf16* aupt = upt + 65536;
    int r = it;
    if (r < 0) { r += I_OUT; if (r < 0) return false; o.W = a.in[14]; o.WT = wtout; o.K = D; o.N = D; }
    else if (r < I_IN) { o.W = a.in[2]; o.WT = wtin; o.K = D; o.N = NIN; }
    else if ((r -= I_IN) < I_UP) { o.W = a.in[5]; o.WT = upt; o.K = 64; o.N = RW; }
    else if ((r -= I_UP) < I_UP) { o.W = a.in[7]; o.WT = aupt; o.K = 64; o.N = RW; }
    else return false;
    const int nblk = o.N / 32; o.k0 = 64 * (r / nblk); o.n0 = 32 * (r % nblk); return true;
}
__device__ __forceinline__ void p0_ld(const TItem& t, int lane, f32x4 (&v)[8]) {
#pragma unroll
    for (int i = 0; i < 8; ++i) v[i] = *(const f32x4*)(t.W + (size_t)(t.k0 + 8 * i + (lane >> 3)) * t.N + t.n0 + 4 * (lane & 7));
}
__device__ __forceinline__ void p0_st(const TItem& t, int lane, const f32x4 (&v)[8], LAS float* scr) {
#pragma unroll
    for (int i = 0; i < 8; ++i) { LAS float* d = scr + (8 * i + (lane >> 3)) * 33 + 4 * (lane & 7); d[0] = v[i].x; d[1] = v[i].y; d[2] = v[i].z; d[3] = v[i].w; }
    asm volatile("s_waitcnt lgkmcnt(0)" ::: "memory");
    const int c = lane & 7;
#pragma unroll
    for (int j = 0; j < 4; ++j) { const int n = (lane >> 3) + 8 * j; const LAS float* s = scr + (8 * c) * 33 + n;
        v4u o; o.x = pk2(s[0 * 33], s[1 * 33]); o.y = pk2(s[2 * 33], s[3 * 33]); o.z = pk2(s[4 * 33], s[5 * 33]); o.w = pk2(s[6 * 33], s[7 * 33]);
        *(v4u*)(t.WT + (size_t)(t.n0 + n) * t.K + t.k0 + 8 * c) = o; }
    asm volatile("s_waitcnt lgkmcnt(0)" ::: "memory");
}
__device__ __forceinline__ void wout_transposes(const Args& a, LAS unsigned char* lds, int gw, int NGW, int wave, int lane) {
    LAS float* scr = (LAS float*)(lds + wave * 16384);
    constexpr int I_OUT = (D / 64) * (D / 32);
    for (int it = gw - I_OUT; it < 0; it += NGW) { TItem t0; f32x4 v0[8]; if (!p0_item(a, it, t0)) break; p0_ld(t0, lane, v0); p0_st(t0, lane, v0, scr); }
}
__device__ __forceinline__ void p0_prologue(const Args& a, LAS unsigned char* lds, int vcu, int G, int wave, int lane) {
    LAS float* scr = (LAS float*)(lds + wave * 16384);
    const int gw = vcu * NWAVES + wave, NGW = G * NWAVES;
    bf16* wtin = (bf16*)(a.ws + WS_WTIN);
#ifdef PROBE_P0X
    for (int rep_ = 0; rep_ < 2; ++rep_)
#endif
    for (int it = gw; ; it += 2 * NGW) {
        TItem t0, t1; f32x4 v0[8], v1[8];
        const bool h0 = p0_item(a, it, t0), h1 = p0_item(a, it + NGW, t1);
        if (!h0) break;
        p0_ld(t0, lane, v0); if (h1) p0_ld(t1, lane, v1);
        p0_st(t0, lane, v0, scr); if (h1) p0_st(t1, lane, v1, scr);
    }
    wout_transposes(a, lds, gw, NGW, wave, lane);
    { v4u z = {0u, 0u, 0u, 0u}; v4u* p = (v4u*)(wtin + (size_t)NIN * D); const int n16 = (NINP - NIN) * D * 2 / 16;
      for (int i = gw * 64 + lane; i < n16; i += NGW * 64) p[i] = z; }
    const float* gain = a.in[1];
#ifdef PROBE_P0R
    for (int rep_ = 0; rep_ < 2; ++rep_)
#endif
    for (int m = gw; m < T; m += 2 * NGW) {
        const int m2 = m + NGW;
        const f32x4* xr = (const f32x4*)(a.in[0] + (size_t)m * D) + lane; const f32x4* xr2 = (const f32x4*)(a.in[0] + (size_t)(m2 < T ? m2 : m) * D) + lane;
        f32x4 v[8], u[8]; float s = 0.f, s2 = 0.f;
#pragma unroll
        for (int j = 0; j < 8; ++j) { v[j] = xr[64 * j]; u[j] = xr2[64 * j]; }
#pragma unroll
        for (int j = 0; j < 8; ++j) { s += (v[j].x * v[j].x + v[j].y * v[j].y) + (v[j].z * v[j].z + v[j].w * v[j].w); s2 += (u[j].x * u[j].x + u[j].y * u[j].y) + (u[j].z * u[j].z + u[j].w * u[j].w); }
        const float rstd = 1.f / sqrtf(wave_sum(s) * (1.f / D) + RMS_EPS), rstd2 = 1.f / sqrtf(wave_sum(s2) * (1.f / D) + RMS_EPS);
        v2u* o8 = (v2u*)((bf16*)(a.ws + WS_XN) + (size_t)m * D) + lane; v2u* o82 = (v2u*)((bf16*)(a.ws + WS_XN) + (size_t)m2 * D) + lane;
#pragma unroll
        for (int j = 0; j < 8; ++j) { const f32x4 g = *((const f32x4*)gain + lane + 64 * j); v2u o; o.x = pk2(v[j].x * rstd * g.x, v[j].y * rstd * g.y); o.y = pk2(v[j].z * rstd * g.z, v[j].w * rstd * g.w); o8[64 * j] = o;
            if (m2 < T) { o.x = pk2(u[j].x * rstd2 * g.x, u[j].y * rstd2 * g.y); o.y = pk2(u[j].z * rstd2 * g.z, u[j].w * rstd2 * g.w); o82[64 * j] = o; } }
    }
}
__device__ __forceinline__ void final_norm(const Args& a, int vcu, int G, int wave, int lane) {
    const int gw = vcu * NWAVES + wave, NGW = G * NWAVES; const float* ssp = (const float*)(a.ws + WS_SSP); const float* gain = a.in[15];
    for (int m = gw; m < T; m += NGW) {
        float s = (lane < 32) ? ssp[(size_t)m * 32 + lane] : 0.f; s = wave_sum(s);
        const float rstd = 1.f / sqrtf(s * (1.f / D) + RMS_EPS);
        f32x4* xr = (f32x4*)(a.out + (size_t)m * D) + lane;
#pragma unroll
        for (int j = 0; j < 8; ++j) { f32x4 v = xr[64 * j]; const f32x4 g = *((const f32x4*)gain + lane + 64 * j); v.x *= rstd * g.x; v.y *= rstd * g.y; v.z *= rstd * g.z; v.w *= rstd * g.w; xr[64 * j] = v; }
    }
}
#define XB_TMO      128
#define XB_XCNT(j)  (256  + 64 * (j))
#define XB_XSUB(j)  (1280 + 64 * (j))
#define XB_XGEN(j)  (2304 + 64 * (j))
#define XB_TOP      3328
#define XB_TOPGEN   3392
#define XCD_BAR_WORDS 3456
#define XB_SPIN_CAP (1u << 18)

__device__ __forceinline__ unsigned xb_ld(unsigned* p)              { return __hip_atomic_load(p, __ATOMIC_RELAXED, __HIP_MEMORY_SCOPE_AGENT); }
__device__ __forceinline__ unsigned xb_add(unsigned* p, unsigned v) { return __hip_atomic_fetch_add(p, v, __ATOMIC_RELAXED, __HIP_MEMORY_SCOPE_AGENT); }
__device__ __forceinline__ unsigned xb_xcc_id() { return (unsigned)__builtin_amdgcn_s_getreg((3 << 11) | 20) & 0xFu; }
#define XB_SPIN(cond, bar) do { unsigned _sp = 0; while (cond) { __builtin_amdgcn_s_sleep(1); \
    if ((++_sp & 255u) == 0u) { if (xb_ld(&(bar)[XB_TMO])) break; if (_sp > XB_SPIN_CAP) { atomicAdd(&(bar)[XB_TMO], 1u); break; } } } } while (0)

struct XcdBarrier {
    unsigned* bar; unsigned x;
    volatile LAS unsigned* st;
};

__device__ __forceinline__ XcdBarrier xcd_barrier_post(unsigned* bar, volatile LAS unsigned* st) {
    XcdBarrier b; b.bar = bar; b.x = xb_xcc_id(); b.st = st;
    if (threadIdx.x == 0) (void)xb_add(&bar[XB_XCNT(b.x)], 1u);
    return b;
}
__device__ __forceinline__ void xcd_barrier_complete(unsigned* bar, unsigned x, unsigned& nloc, unsigned& nx) {
    const unsigned G = gridDim.x * gridDim.y * gridDim.z;
    unsigned sum, cnt, mine, sp = 0u;
    for (;;) {
        sum = 0u; cnt = 0u; mine = 0u;
#pragma unroll
        for (unsigned j = 0; j < 16; ++j) { const unsigned c = xb_ld(&bar[XB_XCNT(j)]); sum += c; cnt += (c > 0u) ? 1u : 0u; mine = (j == x) ? c : mine; }
        if (sum == G) break;
        __builtin_amdgcn_s_sleep(1);
        if ((++sp & 255u) == 0u) { if (xb_ld(&bar[XB_TMO])) break; if (sp > XB_SPIN_CAP) { atomicAdd(&bar[XB_TMO], 1u); break; } }
    }
    nloc = mine > 0u ? mine : 1u; nx = cnt > 0u ? cnt : 1u;
}

__device__ __forceinline__ void xcd_barrier(const XcdBarrier& b) {
    asm volatile("s_waitcnt vmcnt(0)" ::: "memory");
    __syncthreads();
    if (threadIdx.x == 0) {
        unsigned* bar = b.bar;
        __builtin_amdgcn_s_waitcnt(0);
        unsigned nloc = b.st[0], nx = b.st[1];
        if (nloc == 0u) { xcd_barrier_complete(bar, b.x, nloc, nx); b.st[0] = nloc; b.st[1] = nx; }
        const unsigned old = xb_add(&bar[XB_XSUB(b.x)], 1u);
        const unsigned gen = old / nloc;
        if (old + 1u == (gen + 1u) * nloc) {
            __builtin_amdgcn_fence(__ATOMIC_RELEASE, "agent");
            asm volatile("s_waitcnt vmcnt(0)" ::: "memory");
            const unsigned og = xb_add(&bar[XB_TOP], 1u);
            const unsigned tg = og / nx;
            if (og + 1u == (tg + 1u) * nx) xb_add(&bar[XB_TOPGEN], 1u);
            else XB_SPIN(xb_ld(&bar[XB_TOPGEN]) == tg, bar);
            __builtin_amdgcn_fence(__ATOMIC_ACQUIRE, "agent");
            xb_add(&bar[XB_XGEN(b.x)], 1u);
            asm volatile("s_waitcnt vmcnt(0)" ::: "memory");
        } else {
            XB_SPIN(xb_ld(&bar[XB_XGEN(b.x)]) == gen, bar);
            __builtin_amdgcn_fence(__ATOMIC_ACQUIRE, "agent");
            asm volatile("s_waitcnt vmcnt(0)" ::: "memory");
        }
    }
    __syncthreads();
}

#define MFMA32(a_, b_, c_) __builtin_amdgcn_mfma_f32_32x32x16_bf16((a_), (b_), (c_), 0, 0, 0)
#define MFMA16(a_, b_, c_) __builtin_amdgcn_mfma_f32_16x16x32_bf16((a_), (b_), (c_), 0, 0, 0)
__device__ __forceinline__ v4u ldg16(const bf16* p) { return *(const v4u*)p; }
__device__ __forceinline__ void load_shift8(const bf16* proj, int row, int col, const float* mu, float (&o)[8]) {
    const v4u p = ldg16(proj + (size_t)row * NINP + col); v4u q = {0u, 0u, 0u, 0u};
    if (row > 0) q = ldg16(proj + (size_t)(row - 1) * NINP + col);
    float pf[8], qf[8]; unpack8(p, pf); unpack8(q, qf);
    const f32x4 m0 = *(const f32x4*)(mu + col), m1 = *(const f32x4*)(mu + col + 4);
    const float mf[8] = {m0.x, m0.y, m0.z, m0.w, m1.x, m1.y, m1.z, m1.w};
#pragma unroll
    for (int j = 0; j < 8; ++j) o[j] = pf[j] + (qf[j] - pf[j]) * mf[j];
}
__device__ __forceinline__ void ld8f(const float* p, float (&o)[8]) { const f32x4 a = *(const f32x4*)p, b = *(const f32x4*)(p + 4); o[0] = a.x; o[1] = a.y; o[2] = a.z; o[3] = a.w; o[4] = b.x; o[5] = b.y; o[6] = b.z; o[7] = b.w; }

constexpr int VP = 168;
__device__ __forceinline__ void attn_unit(const Args& a, LAS unsigned char* lds, int unit, int tid, int wave, int lane) {
    const bf16* proj = (const bf16*)(a.ws + WS_PROJ); bf16* mix = (bf16*)(a.ws + WS_MIX);
    const int qb = unit >> 1, kvh = unit & 1, q0 = qb * 32, kbase = q0 - 128, hq = kvh * 8 + wave;
    LAS bf16* VT = (LAS bf16*)lds;
    const int r = lane & 31, h = lane >> 5;
    bf16x8 bq[4];
    { const bf16* qrow = proj + (size_t)(q0 + r) * NINP + C_AQ + hq * 64 + 8 * h;
#pragma unroll
      for (int s = 0; s < 4; ++s) bq[s] = *(const bf16x8*)(qrow + 16 * s); }
    const float slope = exp2f(-0.5f * (float)(hq + 1)), sink = a.in[13][hq];
    f32x16 sc[5]; float mx = sink;
    bf16x8 kf[5][4];
#pragma unroll
    for (int kt = 0; kt < 5; ++kt) { const int tkb = kbase + 32 * kt;
        if (tkb >= 0) { const bf16* krow = proj + (size_t)(tkb + r) * NINP + C_AK + kvh * 64 + 8 * h;
#pragma unroll
            for (int s = 0; s < 4; ++s) kf[kt][s] = *(const bf16x8*)(krow + 16 * s); } }
    v2u gpre[2][4];
#pragma unroll
    for (int dt = 0; dt < 2; ++dt)
#pragma unroll
        for (int g4 = 0; g4 < 4; ++g4) gpre[dt][g4] = *(const v2u*)(proj + (size_t)(q0 + r) * NINP + C_AG + hq * 64 + 32 * dt + 8 * g4 + 4 * h);
    bar_lds();
    for (int idx = tid; idx < 160 * 8; idx += NTHR) {
        const int key = idx >> 3, d8 = (idx & 7) * 8, tk = kbase + key;
        v4u p = {0u, 0u, 0u, 0u};
        if (tk >= 0) p = ldg16(proj + (size_t)tk * NINP + C_AV + kvh * 64 + d8);
        const unsigned w[4] = {p.x, p.y, p.z, p.w};
#pragma unroll
        for (int j = 0; j < 4; ++j) { VT[(d8 + 2 * j) * VP + key] = (bf16)(w[j] & 0xffffu); VT[(d8 + 2 * j + 1) * VP + key] = (bf16)(w[j] >> 16); }
    }
    bar_lds();
    const float L2E = 1.44269504f, SA = 0.125f * L2E, SB = slope * L2E, sinkl = sink * L2E;
    mx = sinkl;
#pragma unroll
    for (int kt = 0; kt < 5; ++kt) {
        const int tkb = kbase + 32 * kt;
        if (tkb >= 0) {
            f32x16 acc; for (int i = 0; i < 16; ++i) acc[i] = 0.f;
#pragma unroll
            for (int s = 0; s < 4; ++s) acc = MFMA32(kf[kt][s], bq[s], acc);
            const int dli = (q0 + r) - tkb - 4 * h; const float base = -SB * (float)dli;
#pragma unroll
            for (int i = 0; i < 16; ++i) {
                const int ci = (i & 3) + 8 * (i >> 2);
                float v = __builtin_fmaf(acc[i], SA, __builtin_fmaf(SB, (float)ci, base));
                if (kt == 0) v = (dli - ci < 128) ? v : -1e30f;
                if (kt == 4) v = (dli - ci >= 0) ? v : -1e30f;
                sc[kt][i] = v; mx = fmaxf(mx, v);
            }
        } else {
#pragma unroll
            for (int i = 0; i < 16; ++i) sc[kt][i] = -1e30f;
        }
    }
    mx = fmaxf(mx, __shfl_xor(mx, 32));
    float sum = 0.f;
#pragma unroll
    for (int kt = 0; kt < 5; ++kt)
#pragma unroll
        for (int i = 0; i < 16; ++i) { const float p = __builtin_amdgcn_exp2f(sc[kt][i] - mx); sc[kt][i] = p; sum += p; }
    sum += __shfl_xor(sum, 32); sum += __builtin_amdgcn_exp2f(sinkl - mx);
    f32x16 o[2]; for (int i = 0; i < 16; ++i) { o[0][i] = 0.f; o[1][i] = 0.f; }
#pragma unroll
    for (int kt = 0; kt < 5; ++kt) {
        if (kbase + 32 * kt >= 0) {
#pragma unroll
            for (int s = 0; s < 2; ++s) {
                v4u pw; pw.x = pk2(sc[kt][8 * s + 0], sc[kt][8 * s + 1]); pw.y = pk2(sc[kt][8 * s + 2], sc[kt][8 * s + 3]); pw.z = pk2(sc[kt][8 * s + 4], sc[kt][8 * s + 5]); pw.w = pk2(sc[kt][8 * s + 6], sc[kt][8 * s + 7]);
                const bf16x8 pb = __builtin_bit_cast(bf16x8, pw);
#pragma unroll
                for (int dt = 0; dt < 2; ++dt) {
                    const LAS bf16* vp = VT + (32 * dt + r) * VP + 32 * kt + 16 * s + 4 * h;
                    const v2u lo = *(const LAS v2u*)vp, hi = *(const LAS v2u*)(vp + 8);
                    v4u vw; vw.x = lo.x; vw.y = lo.y; vw.z = hi.x; vw.w = hi.y;
                    o[dt] = MFMA32(__builtin_bit_cast(bf16x8, vw), pb, o[dt]);
                }
            }
        }
    }
    const float inv = 1.f / sum;
#pragma unroll
    for (int dt = 0; dt < 2; ++dt)
#pragma unroll
        for (int g4 = 0; g4 < 4; ++g4) {
            const int d0 = 32 * dt + 8 * g4 + 4 * h;
            float g0, g1, g2, g3;
            { const v2u gp = gpre[dt][g4]; g0 = bflo(gp.x); g1 = bfhi(gp.x); g2 = bflo(gp.y); g3 = bfhi(gp.y); }
            v2u w; w.x = pk2(o[dt][4 * g4 + 0] * inv * siluf_(g0), o[dt][4 * g4 + 1] * inv * siluf_(g1));
            w.y = pk2(o[dt][4 * g4 + 2] * inv * siluf_(g2), o[dt][4 * g4 + 3] * inv * siluf_(g3));
            *(v2u*)(mix + (size_t)(q0 + r) * D + RW + hq * 64 + d0) = w;
        }
}

struct Prep { float r[8], kp[8], v[8], g[8], w[8], lw[8], kk[8], b[8], bonus; };
__device__ __forceinline__ void rwkv_prep(const Args& a, LAS unsigned char* lds, int h, int t0, int tid, int wave, int lane, Prep& P) {
    const bf16* proj = (const bf16*)(a.ws + WS_PROJ); const bf16* upt = (const bf16*)(a.ws + WS_UPT); const bf16* aupt = upt + 65536;
    LAS bf16* TW = (LAS bf16*)lds; LAS bf16* ADm = TW + 64 * 72; LAS float* Z = (LAS float*)(lds + 18432); LAS float* AP = Z + 64 * 68;
    const int t = tid >> 3, c8 = (tid & 7) * 8, ch = h * 64 + c8, row = t0 + t;
    const float* mu = a.in[3];
    { float x[8]; load_shift8(proj, row, C_WD + c8, mu, x);
#pragma unroll
      for (int j = 0; j < 8; ++j) x[j] = 1.f - 2.f * __builtin_amdgcn_rcpf(1.f + __expf(2.f * x[j]));
      *(LAS v4u*)(TW + t * 72 + c8) = pack8(x);
      load_shift8(proj, row, C_AD + c8, mu, x); *(LAS v4u*)(ADm + t * 72 + c8) = pack8(x); }
    bar_lds();
    { const int rt = wave & 3, cp = (wave >> 2) * 2, fr = lane & 15, fq = lane >> 4;
      bf16x8 aT[2], aA[2];
#pragma unroll
      for (int s = 0; s < 2; ++s) { aT[s] = *(const LAS bf16x8*)(TW + (16 * rt + fr) * 72 + 32 * s + 8 * fq); aA[s] = *(const LAS bf16x8*)(ADm + (16 * rt + fr) * 72 + 32 * s + 8 * fq); }
#pragma unroll
      for (int ci = 0; ci < 2; ++ci) { const int ct = cp + ci; f32x4 z = {0.f, 0.f, 0.f, 0.f}, ap = {0.f, 0.f, 0.f, 0.f};
#pragma unroll
          for (int s = 0; s < 2; ++s) { const size_t bo = (size_t)(h * 64 + 16 * ct + fr) * 64 + 32 * s + 8 * fq;
              z = MFMA16(aT[s], *(const bf16x8*)(upt + bo), z); ap = MFMA16(aA[s], *(const bf16x8*)(aupt + bo), ap); }
#pragma unroll
          for (int j = 0; j < 4; ++j) { Z[(16 * rt + 4 * fq + j) * 68 + 16 * ct + fr] = z[j]; AP[(16 * rt + 4 * fq + j) * 68 + 16 * ct + fr] = ap[j]; } } }
    bar_lds();
    float zz[8], aa[8], kr[8], c0[8], c1[8];
#pragma unroll
    for (int j = 0; j < 8; ++j) { zz[j] = Z[t * 68 + c8 + j]; aa[j] = AP[t * 68 + c8 + j]; }
    load_shift8(proj, row, C_R + ch, mu, P.r); load_shift8(proj, row, C_K + ch, mu, kr); load_shift8(proj, row, C_V + ch, mu, P.v); load_shift8(proj, row, C_G + ch, mu, P.g);
    ld8f(a.in[4] + ch, c0); ld8f(a.in[6] + ch, c1);
#pragma unroll
    for (int j = 0; j < 8; ++j) { const float z = c0[j] + zz[j]; const float sp = (z < -15.f) ? -z : __logf(1.f + __expf(-z)); const float wl = -sp - 0.5f; P.lw[j] = -__expf(wl); P.w[j] = __expf(P.lw[j]); aa[j] = sigmoidf_(c1[j] + aa[j]); }
    ld8f(a.in[8] + ch, c0); ld8f(a.in[9] + ch, c1);
    float ss = 0.f;
#pragma unroll
    for (int j = 0; j < 8; ++j) { P.kk[j] = kr[j] * c0[j]; ss += P.kk[j] * P.kk[j]; P.kp[j] = kr[j] * (1.f + (aa[j] - 1.f) * c1[j]); }
    ss = sum8(ss); const float rn = 1.f / fmaxf(sqrtf(ss), 1e-12f);
    ld8f(a.in[10] + ch, c0);
    float bs = 0.f;
#pragma unroll
    for (int j = 0; j < 8; ++j) { P.kk[j] *= rn; P.b[j] = P.kk[j] * aa[j]; bs += P.r[j] * P.kp[j] * c0[j]; }
    P.bonus = sum8(bs);
}
__device__ __forceinline__ void rwkv_out8(const Args& a, const float (&y)[8], const float (&v)[8], const float (&g)[8], float bonus, int row, int ch) {
    bf16* mix = (bf16*)(a.ws + WS_MIX);
    float s = 0.f;
#pragma unroll
    for (int j = 0; j < 8; ++j) s += y[j];
    const float mean = sum8(s) * (1.f / 64.f); float q = 0.f;
#pragma unroll
    for (int j = 0; j < 8; ++j) { const float d = y[j] - mean; q += d * d; }
    const float rstd = 1.f / sqrtf(sum8(q) * (1.f / 64.f) + LNX_EPS);
    float lg[8], lb[8], o[8]; ld8f(a.in[11] + ch, lg); ld8f(a.in[12] + ch, lb);
#pragma unroll
    for (int j = 0; j < 8; ++j) { const float yn = (y[j] - mean) * rstd * lg[j] + lb[j] + bonus * v[j]; o[j] = yn * siluf_(g[j]); }
    *(v4u*)(mix + (size_t)row * D + ch) = pack8(o);
}
constexpr size_t WS_MF = 174 * MiB, WS_QF = 190 * MiB, WS_SF = 206 * MiB, WS_BON = 222 * MiB;
constexpr size_t OUT_NF = 0, OUT_Y2 = 32 * MiB;
constexpr int MP = 72;
constexpr int L_AT = 0, L_ATT = 9216, L_BT = 18432, L_KT = 27648, L_RT = 36864, L_BHT = 46080, L_KHT = 55296, L_VT = 64512, L_LW = 73728, L_P = 73728, L_PT = 82944,
              L_AAK = 92160, L_ARB = 101376, L_ARK = 110592, L_TM = 119808, L_SEG = 119808, L_GC = 129024, L_WT = L_AT, L_X1T = L_BT, L_U2T = L_KT;
struct WTile { int ta, tb0, fr, fq; };
__device__ __forceinline__ bf16x8 ldfrag(const LAS bf16* M, int tile, int s, const WTile& w) { return *(const LAS bf16x8*)(M + (16 * tile + w.fr) * MP + 32 * s + 8 * w.fq); }
__device__ __forceinline__ void mm2(const LAS bf16* A, const LAS bf16* B, const WTile& w, f32x4 (&acc)[2]) {
#pragma unroll
    for (int s = 0; s < 2; ++s) { const bf16x8 af = ldfrag(A, w.ta, s, w);
#pragma unroll
        for (int ci = 0; ci < 2; ++ci) acc[ci] = MFMA16(af, ldfrag(B, w.tb0 + ci, s, w), acc[ci]); }
}
__device__ __forceinline__ void st_T(LAS bf16* X, int ta, int tb, const WTile& w, const f32x4& v) { v2u o; o.x = pk2(v[0], v[1]); o.y = pk2(v[2], v[3]); *(LAS v2u*)(X + (16 * tb + w.fr) * MP + 16 * ta + 4 * w.fq) = o; }
__device__ __forceinline__ void st_N(LAS bf16* X, int ta, int tb, const WTile& w, const f32x4& v) {
    const unsigned a = pk2(v[0], v[1]), b = pk2(v[2], v[3]); LAS bf16* p = X + (16 * ta + 4 * w.fq) * MP + 16 * tb + w.fr;
    p[0] = (bf16)(a & 0xffffu); p[MP] = (bf16)(a >> 16); p[2 * MP] = (bf16)(b & 0xffffu); p[3 * MP] = (bf16)(b >> 16);
}
#define ZERO2(x) do { x[0] = (f32x4){0.f, 0.f, 0.f, 0.f}; x[1] = (f32x4){0.f, 0.f, 0.f, 0.f}; } while (0)
template <int MODE> __device__ __forceinline__ void mask2(f32x4 (&acc)[2], const WTile& w) {
#pragma unroll
    for (int ci = 0; ci < 2; ++ci)
#pragma unroll
        for (int j = 0; j < 4; ++j) { const int row = 16 * w.ta + 4 * w.fq + j, col = 16 * (w.tb0 + ci) + w.fr;
            const bool keep = MODE == 0 ? (row < col) : (MODE == 1 ? (row <= col) : (col < row)); if (!keep) acc[ci][j] = 0.f; }
}
__device__ __forceinline__ void st_bf16x8_T2(LAS bf16* X, int c8, int t, int lane, const float (&v)[8]) {
    const v4u p = pack8(v); const unsigned w[4] = {p.x, p.y, p.z, p.w}; const bool odd = (lane >> 3) & 1;
#pragma unroll
    for (int j = 0; j < 4; ++j) {
        const unsigned q = (unsigned)__builtin_amdgcn_update_dpp(0, (int)w[j], 0x128  , 0xf, 0xf, false);
        const unsigned o = odd ? ((q >> 16) | (w[j] & 0xffff0000u)) : ((w[j] & 0xffffu) | (q << 16));
        *(LAS unsigned*)(X + (c8 + 2 * j + (odd ? 1 : 0)) * MP + (t & ~1)) = o;
    }
}
__device__ __forceinline__ void st_bf16x8_T(LAS bf16* X, int c8, int t, const float (&v)[8]) {
    const v4u p = pack8(v); const unsigned w[4] = {p.x, p.y, p.z, p.w};
#pragma unroll
    for (int j = 0; j < 4; ++j) { X[(c8 + 2 * j) * MP + t] = (bf16)(w[j] & 0xffffu); X[(c8 + 2 * j + 1) * MP + t] = (bf16)(w[j] >> 16); }
}

__device__ __forceinline__ void rwkv_chunk_prep(const Args& a, LAS unsigned char* lds, int unit, int tid, int wave, int lane) {
    const int c = unit >> 4, h = unit & 15, t0 = c * CH, t = tid >> 3, c8 = (tid & 7) * 8;
    LAS bf16* At = (LAS bf16*)(lds + L_AT); LAS bf16* AtT = (LAS bf16*)(lds + L_ATT); LAS bf16* Bt = (LAS bf16*)(lds + L_BT); LAS bf16* Kt = (LAS bf16*)(lds + L_KT);
    LAS bf16* Rt = (LAS bf16*)(lds + L_RT); LAS bf16* BhT = (LAS bf16*)(lds + L_BHT); LAS bf16* KhT = (LAS bf16*)(lds + L_KHT); LAS bf16* VT = (LAS bf16*)(lds + L_VT);
    LAS float* LW = (LAS float*)(lds + L_LW); LAS bf16* Pm = (LAS bf16*)(lds + L_P); LAS bf16* PT = (LAS bf16*)(lds + L_PT);
    LAS bf16* AAK = (LAS bf16*)(lds + L_AAK); LAS bf16* ARB = (LAS bf16*)(lds + L_ARB); LAS bf16* ARK = (LAS bf16*)(lds + L_ARK); LAS bf16* TM = (LAS bf16*)(lds + L_TM);
    LAS float* SEG = (LAS float*)(lds + L_SEG); LAS float* GC = (LAS float*)(lds + L_GC);
    LAS bf16* WT = (LAS bf16*)(lds + L_WT); LAS bf16* X1T = (LAS bf16*)(lds + L_X1T); LAS bf16* U2T = (LAS bf16*)(lds + L_U2T);
    bar_lds();
    Prep P; rwkv_prep(a, lds, h, t0, tid, wave, lane, P);
#ifdef PROBE_PREP2
    bar_lds(); rwkv_prep(a, lds, h, t0, tid, wave, lane, P);
#endif
    if ((tid & 7) == 0) ((float*)(a.ws + WS_BON))[(size_t)(t0 + t) * 16 + h] = P.bonus;
#pragma unroll
    for (int j = 0; j < 8; ++j) LW[t * 68 + c8 + j] = P.lw[j];
    bar_lds();
    { const int cc = tid & 63, sg = tid >> 6; float run = 0.f;
#pragma unroll
      for (int i = 0; i < 8; ++i) { run += LW[(8 * sg + i) * 68 + cc]; LW[(8 * sg + i) * 68 + cc] = run; }
      SEG[sg * 64 + cc] = run; }
    bar_lds();
    {
        float Lt[8], LC[8];
#pragma unroll
        for (int j = 0; j < 8; ++j) { float off = 0.f, tot = 0.f;
#pragma unroll
            for (int s = 0; s < 8; ++s) { const float sv = SEG[s * 64 + c8 + j]; tot += sv; if (s < (t >> 3)) off += sv; }
            Lt[j] = LW[t * 68 + c8 + j] + off; LC[j] = tot; }
        if (t == 0) {
#pragma unroll
            for (int j = 0; j < 8; ++j) GC[c8 + j] = __expf(LC[j]); }
        float x[8], y[8];
#pragma unroll
        for (int j = 0; j < 8; ++j) x[j] = -P.kk[j] * __expf(Lt[j] - P.lw[j]);
        *(LAS v4u*)(At + t * MP + c8) = pack8(x); st_bf16x8_T(AtT, c8, t, x);
#pragma unroll
        for (int j = 0; j < 8; ++j) { const float e = __expf(-Lt[j]); x[j] = P.b[j] * e; y[j] = P.kp[j] * e; }
        *(LAS v4u*)(Bt + t * MP + c8) = pack8(x); *(LAS v4u*)(Kt + t * MP + c8) = pack8(y);
#pragma unroll
        for (int j = 0; j < 8; ++j) x[j] = P.r[j] * __expf(Lt[j]);
        *(LAS v4u*)(Rt + t * MP + c8) = pack8(x);
#pragma unroll
        for (int j = 0; j < 8; ++j) { const float e = __expf(LC[j] - Lt[j]); x[j] = P.b[j] * e; y[j] = P.kp[j] * e; }
        st_bf16x8_T(BhT, c8, t, x); st_bf16x8_T(KhT, c8, t, y); st_bf16x8_T(VT, c8, t, P.v);
    }
    bar_lds();
    WTile w; w.ta = wave & 3; w.tb0 = (wave >> 2) * 2; w.fr = lane & 15; w.fq = lane >> 4;
    f32x4 acc[2], Tacc[2];
    ZERO2(Tacc); mm2(At, Bt, w, Tacc); mask2<2>(Tacc, w);
    ZERO2(acc); mm2(Kt, At, w, acc); mask2<0>(acc, w);
    f32x4 rb[2], rk[2]; ZERO2(rb); mm2(Bt, Rt, w, rb); mask2<1>(rb, w); ZERO2(rk); mm2(Kt, Rt, w, rk); mask2<1>(rk, w);
    bar_lds();
#pragma unroll
    for (int ci = 0; ci < 2; ++ci) { st_N(Pm, w.ta, w.tb0 + ci, w, Tacc[ci]); st_T(PT, w.ta, w.tb0 + ci, w, Tacc[ci]);
        st_T(AAK, w.ta, w.tb0 + ci, w, acc[ci]); st_T(ARB, w.ta, w.tb0 + ci, w, rb[ci]); st_T(ARK, w.ta, w.tb0 + ci, w, rk[ci]);
#pragma unroll
        for (int j = 0; j < 4; ++j) if (16 * w.ta + 4 * w.fq + j == 16 * (w.tb0 + ci) + w.fr) Tacc[ci][j] += 1.f;
        st_N(TM, w.ta, w.tb0 + ci, w, Tacc[ci]); }
    bar_lds();
#pragma unroll 1
#ifdef PROBE_NEU2
    for (int n = 0; n < 10; ++n) {
#else
    for (int n = 0; n < 5; ++n) {
#endif
        ZERO2(acc); mm2(Pm, PT, w, acc);
        bar_lds();
#pragma unroll
        for (int ci = 0; ci < 2; ++ci) { st_N(Pm, w.ta, w.tb0 + ci, w, acc[ci]); st_T(PT, w.ta, w.tb0 + ci, w, acc[ci]); }
        bar_lds();
        mm2(TM, PT, w, Tacc);
        bar_lds();
#pragma unroll
        for (int ci = 0; ci < 2; ++ci) st_N(TM, w.ta, w.tb0 + ci, w, Tacc[ci]);
        bar_lds();
    }
    ZERO2(acc); mm2(TM, AtT, w, acc); ZERO2(rb); mm2(AAK, VT, w, rb);
#pragma unroll
    for (int ci = 0; ci < 2; ++ci) { st_T(WT, w.ta, w.tb0 + ci, w, acc[ci]); st_T(X1T, w.ta, w.tb0 + ci, w, rb[ci]); }
    bar_lds();
    const size_t ub = (size_t)unit * 4096;
    { ZERO2(acc); mm2(TM, X1T, w, acc);
#pragma unroll
      for (int ci = 0; ci < 2; ++ci) st_T(U2T, w.ta, w.tb0 + ci, w, acc[ci]);
      bf16* MF = (bf16*)(a.ws + WS_MF) + ub; bf16* QF = (bf16*)(a.ws + WS_QF) + ub;
      ZERO2(acc); mm2(WT, BhT, w, acc);
      ZERO2(rb); mm2(WT, ARB, w, rb);
#pragma unroll
      for (int ci = 0; ci < 2; ++ci) { const int tb = w.tb0 + ci; const int col = 16 * tb + w.fr; const float gc = GC[col];
          f32x4 m = acc[ci];
#pragma unroll
          for (int j = 0; j < 4; ++j) if (16 * w.ta + 4 * w.fq + j == col) m[j] += gc;
          const size_t fo = (size_t)((tb * 2 + (w.ta >> 1)) * 64 + lane) * 8 + 4 * (w.ta & 1);
          v2u o; o.x = pk2(m[0], m[1]); o.y = pk2(m[2], m[3]); *(v2u*)(MF + fo) = o;
          const v2u rr = *(const LAS v2u*)(Rt + col * MP + 16 * w.ta + 4 * w.fq);
          f32x4 q = rb[ci]; q[0] += bflo(rr.x); q[1] += bfhi(rr.x); q[2] += bflo(rr.y); q[3] += bfhi(rr.y);
          o.x = pk2(q[0], q[1]); o.y = pk2(q[2], q[3]); *(v2u*)(QF + fo) = o; } }
    bar_lds();
    { float* NF = (float*)((unsigned char*)a.out + OUT_NF) + ub; float* Y2 = (float*)((unsigned char*)a.out + OUT_Y2) + ub;
      ZERO2(acc); mm2(BhT, U2T, w, acc); mm2(KhT, VT, w, acc);
      ZERO2(rb); mm2(U2T, ARB, w, rb); mm2(VT, ARK, w, rb);
#pragma unroll
      for (int ci = 0; ci < 2; ++ci) { const int tb = w.tb0 + ci;
          *(f32x4*)(NF + (size_t)((tb * 4 + w.ta) * 64 + lane) * 4) = acc[ci];
          *(f32x4*)(Y2 + (size_t)(16 * tb + w.fr) * 64 + 16 * w.ta + 4 * w.fq) = rb[ci]; } }
}

#ifndef HSPLIT_V
#define HSPLIT_V 64
#endif
constexpr int HSPLIT = HSPLIT_V;
constexpr int KR = 4, NR = NCH / KR, SLOT = 10240, RBUF = KR * SLOT, NPIECE = RBUF / 16, LPT = 6, PPC = SLOT / 16;
__device__ __forceinline__ const v4u* sp_src(const Args& a, int h, int cg, int r, int p) {
    const int cc = p / PPC, q = p % PPC, c = r * KR + cc; const size_t ub = (size_t)(c * 16 + h) * 4096;
    return q < 512 ? (const v4u*)((const bf16*)(a.ws + WS_MF) + ub) + q : (const v4u*)((const bf16*)((const unsigned char*)a.out + OUT_NF) + ub + cg * 1024) + (q - 512);
}
__device__ __forceinline__ void state_pass(const Args& a, LAS unsigned char* lds, int b, int tid, int wave, int lane) {
    unsigned* half_flag = (unsigned*)a.ws + 7168;
    const int h = b & 15, cg = b >> 4, lt = tid - 64;
    v4u ra[LPT], rb[LPT];
    if (wave != 0) {
#pragma unroll
        for (int i = 0; i < LPT; ++i) { const int p = lt + 448 * i; if (p < NPIECE) ra[i] = *sp_src(a, h, cg, 0, p); }
#pragma unroll
        for (int i = 0; i < LPT; ++i) { const int p = lt + 448 * i; if (p < NPIECE) *(LAS v4u*)(lds + p * 16) = ra[i]; }
#pragma unroll
        for (int i = 0; i < LPT; ++i) { const int p = lt + 448 * i; if (p < NPIECE) ra[i] = *sp_src(a, h, cg, 1, p); }
    }
    f32x4 st[4];
#pragma unroll
    for (int i = 0; i < 4; ++i) st[i] = (f32x4){0.f, 0.f, 0.f, 0.f};
    bar_lds();
    bf16* SF = (bf16*)(a.ws + WS_SF);
#define SP_ROUND(r_, RA, RB) do { \
        if (wave != 0) { \
            if ((r_) + 2 < NR) { _Pragma("unroll") for (int i = 0; i < LPT; ++i) { const int p = lt + 448 * i; if (p < NPIECE) RB[i] = *sp_src(a, h, cg, (r_) + 2, p); } } \
            if ((r_) + 1 < NR) { _Pragma("unroll") for (int i = 0; i < LPT; ++i) { const int p = lt + 448 * i; if (p < NPIECE) *(LAS v4u*)(lds + (((r_) + 1) & 1) * RBUF + p * 16) = RA[i]; } } \
        } else { \
            if ((r_) == HSPLIT / KR && lane == 0) { __threadfence(); __hip_atomic_fetch_add(half_flag, 1u, __ATOMIC_RELEASE, __HIP_MEMORY_SCOPE_AGENT); }     \
            _Pragma("unroll") for (int cc = 0; cc < KR; ++cc) { \
                const LAS unsigned char* sl = lds + ((r_) & 1) * RBUF + cc * SLOT; const int c = (r_) * KR + cc; \
                v4u b0, b1; b0.x = pk2(st[0][0], st[0][1]); b0.y = pk2(st[0][2], st[0][3]); b0.z = pk2(st[1][0], st[1][1]); b0.w = pk2(st[1][2], st[1][3]); \
                b1.x = pk2(st[2][0], st[2][1]); b1.y = pk2(st[2][2], st[2][3]); b1.z = pk2(st[3][0], st[3][1]); b1.w = pk2(st[3][2], st[3][3]); \
                v4u* sfo = (v4u*)(SF + (size_t)(c * 16 + h) * 4096) + (cg * 2) * 64 + lane; sfo[0] = b0; sfo[64] = b1; \
                const bf16x8 f0 = __builtin_bit_cast(bf16x8, b0), f1 = __builtin_bit_cast(bf16x8, b1); \
                _Pragma("unroll") for (int rt = 0; rt < 4; ++rt) { \
                    const v2u nb_ = *(const LAS v2u*)(sl + 8192 + (rt * 64 + lane) * 8); f32x4 n = {bflo(nb_.x), bfhi(nb_.x), bflo(nb_.y), bfhi(nb_.y)}; \
                    n = MFMA16(*(const LAS bf16x8*)(sl + ((rt * 2 + 0) * 64 + lane) * 16), f0, n); \
                    n = MFMA16(*(const LAS bf16x8*)(sl + ((rt * 2 + 1) * 64 + lane) * 16), f1, n); st[rt] = n; } \
            } \
        } \
        bar_lds(); } while (0)
#pragma unroll 1
    for (int r = 0; r < NR; r += 2) { SP_ROUND(r, ra, rb); SP_ROUND(r + 1, rb, ra); }
#undef SP_ROUND
}

__device__ __forceinline__ void rwkv_out_unit(const Args& a, LAS unsigned char* lds, int unit, int tid, int wave, int lane) {
    const int c = unit >> 4, h = unit & 15, t0 = c * CH, t = tid >> 3, c8 = (tid & 7) * 8, ch = h * 64 + c8;
    const size_t ub = (size_t)unit * 4096;
    const bf16* QF = (const bf16*)(a.ws + WS_QF) + ub; const bf16* SF = (const bf16*)(a.ws + WS_SF) + ub; const bf16* Y2 = (const bf16*)((const unsigned char*)a.out + OUT_Y2) + ub;
    LAS float* SY = (LAS float*)lds;
    const int ta = wave & 3, tb0 = (wave >> 2) * 2, fr = lane & 15, fq = lane >> 4;
    bf16x8 af[2], bfr[2][2];
#pragma unroll
    for (int s = 0; s < 2; ++s) { af[s] = *(const bf16x8*)(QF + (size_t)((ta * 2 + s) * 64 + lane) * 8);
#pragma unroll
        for (int ci = 0; ci < 2; ++ci) bfr[s][ci] = *(const bf16x8*)(SF + (size_t)(((tb0 + ci) * 2 + s) * 64 + lane) * 8); }
    float y2[8], v[8], g[8];
    unpack8(ldg16(Y2 + t * 64 + c8), y2);
    const bf16* proj = (const bf16*)(a.ws + WS_PROJ);
    load_shift8(proj, t0 + t, C_V + ch, a.in[3], v); load_shift8(proj, t0 + t, C_G + ch, a.in[3], g);
    const float bonus = ((const float*)(a.ws + WS_BON))[(size_t)(t0 + t) * 16 + h];
    f32x4 acc[2]; ZERO2(acc);
#pragma unroll
    for (int s = 0; s < 2; ++s)
#pragma unroll
        for (int ci = 0; ci < 2; ++ci) acc[ci] = MFMA16(af[s], bfr[s][ci], acc[ci]);
    bar_lds();
#pragma unroll
    for (int ci = 0; ci < 2; ++ci)
#pragma unroll
        for (int j = 0; j < 4; ++j) SY[(16 * ta + 4 * fq + j) * 68 + 16 * (tb0 + ci) + fr] = acc[ci][j];
    bar_lds();
    float y[8];
#pragma unroll
    for (int j = 0; j < 8; ++j) y[j] = SY[t * 68 + c8 + j] + y2[j];
    rwkv_out8(a, y, v, g, bonus, t0 + t, ch);
}
constexpr int L2_SEG = 129280, L2_XST = 131328, L2_TW = 131584, L2_ADM = 140800, L2_X1T = 150016;
struct PF { v4u p[4], q[4]; };
__device__ __forceinline__ void pf_issue(PF& f, const bf16* proj, int row, int ch) {
    const int cols[4] = {C_R, C_K, C_V, C_G};
#pragma unroll
    for (int i = 0; i < 4; ++i) { f.p[i] = ldg16(proj + (size_t)row * NINP + cols[i] + ch); f.q[i] = (v4u){0u, 0u, 0u, 0u}; if (row > 0) f.q[i] = ldg16(proj + (size_t)(row - 1) * NINP + cols[i] + ch); }
}
__device__ __forceinline__ void pf_shift(const v4u& p, const v4u& q, const float (&mf)[8], float (&o)[8]) {
    float pf[8], qf[8]; unpack8(p, pf); unpack8(q, qf);
#pragma unroll
    for (int j = 0; j < 8; ++j) o[j] = pf[j] + (qf[j] - pf[j]) * mf[j];
}
template <bool DOP, bool DOT, bool CHK = false> __device__ __forceinline__ void neu_stage(const LAS bf16* Pin, const LAS bf16* PTin, LAS bf16* Pout, LAS bf16* PTout, const LAS bf16* TMin, LAS bf16* TMout, const WTile& w, f32x4 (&Tacc)[2], LAS unsigned* flag = nullptr) {
    f32x4 acc[2];
    if (DOP) { ZERO2(acc); mm2(Pin, PTin, w, acc); }
    if (DOP && CHK) {
        float m = 0.f;
#pragma unroll
        for (int ci = 0; ci < 2; ++ci)
#pragma unroll
            for (int j = 0; j < 4; ++j) m = fmaxf(m, fabsf(acc[ci][j]));
        if (m > 5e-4f) atomicMax((unsigned*)flag, __float_as_uint(m));
    }
    if (DOT) mm2(TMin, PTin, w, Tacc);
#pragma unroll
    for (int ci = 0; ci < 2; ++ci) {
        if (DOP) { st_N(Pout, w.ta, w.tb0 + ci, w, acc[ci]); st_T(PTout, w.ta, w.tb0 + ci, w, acc[ci]); }
        if (DOT) st_N(TMout, w.ta, w.tb0 + ci, w, Tacc[ci]);
    }
    bar_lds();
}
__device__ __forceinline__ void rwkv_chunk_group(const Args& a, LAS unsigned char* lds, int item, int tid, int wave, int lane) {
    const int c = item >> 1, hg = item & 1, t0 = c * CH, t = tid >> 3, c8 = (tid & 7) * 8, row = t0 + t;
    const bf16* proj = (const bf16*)(a.ws + WS_PROJ); const bf16* upt = (const bf16*)(a.ws + WS_UPT); const bf16* aupt = upt + 65536; const float* mu = a.in[3];
    LAS bf16* TW = (LAS bf16*)(lds + L2_TW); LAS bf16* ADm = (LAS bf16*)(lds + L2_ADM);
    WTile w; w.ta = wave & 3; w.tb0 = (wave >> 2) * 2; w.fr = lane & 15; w.fq = lane >> 4;
    bar_lds();
    { float x[8]; load_shift8(proj, row, C_WD + c8, mu, x);
#pragma unroll
      for (int j = 0; j < 8; ++j) x[j] = 1.f - 2.f * __builtin_amdgcn_rcpf(1.f + __expf(2.f * x[j]));
      *(LAS v4u*)(TW + t * 72 + c8) = pack8(x);
      load_shift8(proj, row, C_AD + c8, mu, x); *(LAS v4u*)(ADm + t * 72 + c8) = pack8(x); }
    PF pf; pf_issue(pf, proj, row, hg * 512 + c8);
#pragma unroll 1
    for (int hh = 0; hh < 8; ++hh) {
        const int h = hg * 8 + hh, ch = h * 64 + c8, unit = c * 16 + h;
        LAS unsigned char* L = lds; asm volatile("" : "+v"(L));
        LAS bf16* At = (LAS bf16*)(L + L_AT); LAS bf16* AtT = (LAS bf16*)(L + L_ATT); LAS bf16* Bt = (LAS bf16*)(L + L_BT); LAS bf16* Kt = (LAS bf16*)(L + L_KT);
        LAS bf16* Rt = (LAS bf16*)(L + L_RT); LAS bf16* BhT = (LAS bf16*)(L + L_BHT); LAS bf16* KhT = (LAS bf16*)(L + L_KHT); LAS bf16* VT = (LAS bf16*)(L + L_VT);
        LAS bf16* P0 = (LAS bf16*)(L + L_P); LAS bf16* PT0 = (LAS bf16*)(L + L_PT); LAS bf16* TM0 = (LAS bf16*)(L + L_TM);
        LAS bf16* P1 = At; LAS bf16* PT1 = Bt; LAS bf16* TM1 = Kt;
        LAS bf16* AAK = (LAS bf16*)(L + L_AAK); LAS bf16* ARB = (LAS bf16*)(L + L_ARB); LAS bf16* ARK = (LAS bf16*)(L + L_ARK);
        LAS float* SEG = (LAS float*)(L + L2_SEG); LAS float* GC = (LAS float*)(L + L_GC);
        LAS bf16* X1T = (LAS bf16*)(L + L2_X1T);
        LAS float* Z = (LAS float*)(L + 18432); LAS float* AP = Z + 64 * 68;
        LAS bf16* WT = At; LAS bf16* U2T = Bt; LAS unsigned* NFLAG = (LAS unsigned*)(L + 159232);
        bf16x8 bU[2][2], bA[2][2];
#pragma unroll
        for (int ci = 0; ci < 2; ++ci)
#pragma unroll
            for (int s = 0; s < 2; ++s) { const size_t bo = (size_t)(h * 64 + 16 * (w.tb0 + ci) + w.fr) * 64 + 32 * s + 8 * w.fq; bU[ci][s] = *(const bf16x8*)(upt + bo); bA[ci][s] = *(const bf16x8*)(aupt + bo); }
        float pw0[8], pa0[8], pkk[8], pka[8], prk[8], mur[8], muk[8], muv[8];
        ld8f(a.in[4] + ch, pw0); ld8f(a.in[6] + ch, pa0); ld8f(a.in[8] + ch, pkk); ld8f(a.in[9] + ch, pka); ld8f(a.in[10] + ch, prk);
        ld8f(mu + C_R + ch, mur); ld8f(mu + C_K + ch, muk); ld8f(mu + C_V + ch, muv);
        bar_lds();
#ifdef PROBE_G
        if (blockIdx.x == 0 && tid == 0 && hh == 3) ((unsigned long long*)(a.ws + 65536))[0] = __builtin_amdgcn_s_memrealtime();
#endif

        { const int rt = w.ta, cp = w.tb0, fr = w.fr, fq = w.fq;
          bf16x8 aT[2], aA[2];
#pragma unroll
          for (int s = 0; s < 2; ++s) { aT[s] = *(const LAS bf16x8*)(TW + (16 * rt + fr) * 72 + 32 * s + 8 * fq); aA[s] = *(const LAS bf16x8*)(ADm + (16 * rt + fr) * 72 + 32 * s + 8 * fq); }
#pragma unroll
          for (int ci = 0; ci < 2; ++ci) { const int ct = cp + ci; f32x4 z = {0.f, 0.f, 0.f, 0.f}, ap = {0.f, 0.f, 0.f, 0.f};
#pragma unroll
              for (int s = 0; s < 2; ++s) { z = MFMA16(aT[s], bU[ci][s], z); ap = MFMA16(aA[s], bA[ci][s], ap); }
#pragma unroll
              for (int j = 0; j < 4; ++j) { Z[(16 * rt + 4 * fq + j) * 68 + 16 * ct + fr] = z[j]; AP[(16 * rt + 4 * fq + j) * 68 + 16 * ct + fr] = ap[j]; } } }
        bar_lds();
#ifdef PROBE_G
        if (blockIdx.x == 0 && tid == 0 && hh == 3) ((unsigned long long*)(a.ws + 65536))[1] = __builtin_amdgcn_s_memrealtime();
#endif
        float r[8], kp[8], vv[8], lw[8], kk[8], bb[8];
        { float zz[8], aa[8], kr[8];
#pragma unroll
          for (int j = 0; j < 8; ++j) { zz[j] = Z[t * 68 + c8 + j]; aa[j] = AP[t * 68 + c8 + j]; }
          pf_shift(pf.p[0], pf.q[0], mur, r); pf_shift(pf.p[1], pf.q[1], muk, kr); pf_shift(pf.p[2], pf.q[2], muv, vv);
#pragma unroll
          for (int j = 0; j < 8; ++j) { const float z = pw0[j] + zz[j]; lw[j] = -0.60653066f * __builtin_amdgcn_rcpf(1.f + __expf(-z)); aa[j] = sigmoidf_(pa0[j] + aa[j]); }
          float ss = 0.f;
#pragma unroll
          for (int j = 0; j < 8; ++j) { kk[j] = kr[j] * pkk[j]; ss += kk[j] * kk[j]; kp[j] = kr[j] * (1.f + (aa[j] - 1.f) * pka[j]); }
          ss = sum8(ss); const float rn = 1.f / fmaxf(sqrtf(ss), 1e-12f);
          float bs = 0.f;
#pragma unroll
          for (int j = 0; j < 8; ++j) { kk[j] *= rn; bb[j] = kk[j] * aa[j]; bs += r[j] * kp[j] * prk[j]; }
          bs = sum8(bs);
          if ((tid & 7) == 0) ((float*)(a.ws + WS_BON))[(size_t)row * 16 + h] = bs; }
        if (hh < 7) pf_issue(pf, proj, row, ch + 64);
        float Lt[8];
#pragma unroll
        for (int j = 0; j < 8; ++j) { float x = lw[j];
#pragma unroll
            for (int d = 8; d < 64; d <<= 1) { const float y = __shfl_up(x, d); if (lane >= d) x += y; }
            Lt[j] = x; }
        if ((lane >> 3) == 7) {
#pragma unroll
            for (int j = 0; j < 8; ++j) SEG[wave * 64 + c8 + j] = Lt[j]; }
        bar_lds();
        {
            float gc[8], x[8], y[8];
            { float off[8], tot[8];
#pragma unroll
              for (int j = 0; j < 8; ++j) { off[j] = 0.f; tot[j] = 0.f; }
#pragma unroll
              for (int s = 0; s < 8; ++s) { const f32x4 s0 = *(const LAS f32x4*)(SEG + s * 64 + c8), s1 = *(const LAS f32x4*)(SEG + s * 64 + c8 + 4);
                  const float sv[8] = {s0.x, s0.y, s0.z, s0.w, s1.x, s1.y, s1.z, s1.w};
#pragma unroll
                  for (int j = 0; j < 8; ++j) { tot[j] += sv[j]; if (s < wave) off[j] += sv[j]; } }
#pragma unroll
              for (int j = 0; j < 8; ++j) { Lt[j] += off[j]; gc[j] = __expf(tot[j]); } }
            if (t == 0) {
#pragma unroll
                for (int j = 0; j < 8; ++j) GC[c8 + j] = gc[j]; }
            float e1[8], ie1[8];
#pragma unroll
            for (int j = 0; j < 8; ++j) { e1[j] = __expf(Lt[j]); ie1[j] = __builtin_amdgcn_rcpf(e1[j]); }
#pragma unroll
            for (int j = 0; j < 8; ++j) x[j] = -kk[j] * __expf(Lt[j] - lw[j]);
            *(LAS v4u*)(At + t * MP + c8) = pack8(x); st_bf16x8_T2(AtT, c8, t, lane, x);
#pragma unroll
            for (int j = 0; j < 8; ++j) { x[j] = bb[j] * ie1[j]; y[j] = kp[j] * ie1[j]; }
            *(LAS v4u*)(Bt + t * MP + c8) = pack8(x); *(LAS v4u*)(Kt + t * MP + c8) = pack8(y);
#pragma unroll
            for (int j = 0; j < 8; ++j) x[j] = r[j] * e1[j];
            *(LAS v4u*)(Rt + t * MP + c8) = pack8(x);
#pragma unroll
            for (int j = 0; j < 8; ++j) { const float e = gc[j] * ie1[j]; x[j] = bb[j] * e; y[j] = kp[j] * e; }
            st_bf16x8_T2(BhT, c8, t, lane, x); st_bf16x8_T2(KhT, c8, t, lane, y); st_bf16x8_T2(VT, c8, t, lane, vv);
        }
        bar_lds();
#ifdef PROBE_G
        if (blockIdx.x == 0 && tid == 0 && hh == 3) ((unsigned long long*)(a.ws + 65536))[2] = __builtin_amdgcn_s_memrealtime();
#endif
        f32x4 acc[2], Tacc[2], rb[2], rk[2];
        ZERO2(Tacc); mm2(At, Bt, w, Tacc); mask2<2>(Tacc, w);
        ZERO2(acc); mm2(Kt, At, w, acc); mask2<0>(acc, w);
        ZERO2(rb); mm2(Bt, Rt, w, rb); mask2<1>(rb, w); ZERO2(rk); mm2(Kt, Rt, w, rk); mask2<1>(rk, w);
        bar_lds();
#pragma unroll
        for (int ci = 0; ci < 2; ++ci) { st_N(P1, w.ta, w.tb0 + ci, w, Tacc[ci]); st_T(PT1, w.ta, w.tb0 + ci, w, Tacc[ci]);
            st_T(AAK, w.ta, w.tb0 + ci, w, acc[ci]); st_T(ARB, w.ta, w.tb0 + ci, w, rb[ci]); st_T(ARK, w.ta, w.tb0 + ci, w, rk[ci]);
#pragma unroll
            for (int j = 0; j < 4; ++j) if (16 * w.ta + 4 * w.fq + j == 16 * (w.tb0 + ci) + w.fr) Tacc[ci][j] += 1.f;
            st_N(TM1, w.ta, w.tb0 + ci, w, Tacc[ci]); }
        if (tid == 0) *NFLAG = 0u;
        bar_lds();
#ifdef PROBE_G
        if (blockIdx.x == 0 && tid == 0 && hh == 3) ((unsigned long long*)(a.ws + 65536))[3] = __builtin_amdgcn_s_memrealtime();
#endif
        { ZERO2(acc); mm2(AAK, VT, w, acc);
#pragma unroll
          for (int ci = 0; ci < 2; ++ci) st_T(X1T, w.ta, w.tb0 + ci, w, acc[ci]); }
        neu_stage<true, false>(P1, PT1, P0, PT0, nullptr, nullptr, w, Tacc);
        int nrep = 1; asm volatile("" : "+s"(nrep));
#pragma unroll 1
        for (int n = 0; n < nrep; ++n) {
            neu_stage<true, true>(P0, PT0, P1, PT1, TM1, TM0, w, Tacc);
            neu_stage<true, true, true>(P1, PT1, P0, PT0, TM0, TM1, w, Tacc, NFLAG);
        }
        if (*NFLAG != 0u) {
            neu_stage<true, true>(P0, PT0, P1, PT1, TM1, TM0, w, Tacc);
            neu_stage<true, true>(P1, PT1, P0, PT0, TM0, TM1, w, Tacc);
        }
        neu_stage<false, true>(P0, PT0, nullptr, nullptr, TM1, TM0, w, Tacc);

#ifdef PROBE_G
        if (blockIdx.x == 0 && tid == 0 && hh == 3) ((unsigned long long*)(a.ws + 65536))[4] = __builtin_amdgcn_s_memrealtime();
#endif
        ZERO2(acc); mm2(TM0, AtT, w, acc); ZERO2(rb); mm2(TM0, X1T, w, rb);
#pragma unroll
        for (int ci = 0; ci < 2; ++ci) { st_T(WT, w.ta, w.tb0 + ci, w, acc[ci]); st_T(U2T, w.ta, w.tb0 + ci, w, rb[ci]); }
        bar_lds();
        const size_t ub = (size_t)unit * 4096;
        { bf16* MF = (bf16*)(a.ws + WS_MF) + ub; bf16* QF = (bf16*)(a.ws + WS_QF) + ub;
          ZERO2(acc); mm2(WT, BhT, w, acc); ZERO2(rb); mm2(WT, ARB, w, rb);
#pragma unroll
          for (int ci = 0; ci < 2; ++ci) { const int tb = w.tb0 + ci; const int col = 16 * tb + w.fr; const float gcv = GC[col];
              f32x4 m = acc[ci];
#pragma unroll
              for (int j = 0; j < 4; ++j) if (16 * w.ta + 4 * w.fq + j == col) m[j] += gcv;
              const size_t fo = (size_t)((tb * 2 + (w.ta >> 1)) * 64 + lane) * 8 + 4 * (w.ta & 1);
              v2u o; o.x = pk2(m[0], m[1]); o.y = pk2(m[2], m[3]); *(v2u*)(MF + fo) = o;
              const v2u rr = *(const LAS v2u*)(Rt + col * MP + 16 * w.ta + 4 * w.fq);
              f32x4 q = rb[ci]; q[0] += bflo(rr.x); q[1] += bfhi(rr.x); q[2] += bflo(rr.y); q[3] += bfhi(rr.y);
              o.x = pk2(q[0], q[1]); o.y = pk2(q[2], q[3]); *(v2u*)(QF + fo) = o; }
          bf16* NF = (bf16*)((unsigned char*)a.out + OUT_NF) + ub; bf16* Y2 = (bf16*)((unsigned char*)a.out + OUT_Y2) + ub;
          ZERO2(acc); mm2(BhT, U2T, w, acc); mm2(KhT, VT, w, acc);
          ZERO2(rb); mm2(U2T, ARB, w, rb); mm2(VT, ARK, w, rb);
#pragma unroll
          for (int ci = 0; ci < 2; ++ci) { const int tb = w.tb0 + ci;
              v2u o; o.x = pk2(acc[ci][0], acc[ci][1]); o.y = pk2(acc[ci][2], acc[ci][3]); *(v2u*)(NF + (size_t)((tb * 4 + w.ta) * 64 + lane) * 4) = o;
              o.x = pk2(rb[ci][0], rb[ci][1]); o.y = pk2(rb[ci][2], rb[ci][3]); *(v2u*)(Y2 + (size_t)(16 * tb + w.fr) * 64 + 16 * w.ta + 4 * w.fq) = o; } }

#ifdef PROBE_G
        if (blockIdx.x == 0 && tid == 0 && hh == 3) ((unsigned long long*)(a.ws + 65536))[5] = __builtin_amdgcn_s_memrealtime();
#endif
    }
}
#ifndef HOSTDUP
#define HOSTDUP -1
#endif
#ifndef ONE_LAUNCH
#define ONE_LAUNCH 1
#endif
#if HOSTDUP != -1 || defined(MULTI)
#undef ONE_LAUNCH
#define ONE_LAUNCH 0
#endif
constexpr int NPHASE = 7;
__global__ void __launch_bounds__(NTHR, 2) mega(Args a) {
    extern __shared__ __attribute__((aligned(16))) unsigned char lds_[];
    LAS unsigned char* lds = (LAS unsigned char*)lds_;
    const int tid = threadIdx.x, lane = tid & 63, wave = __builtin_amdgcn_readfirstlane(tid >> 6);
    const int G = gridDim.x, bx = blockIdx.x, vcu = (G % 8 == 0) ? (bx % 8) * (G / 8) + bx / 8 : bx;
    cg::grid_group grid = cg::this_grid();
    volatile LAS unsigned* xst = (volatile LAS unsigned*)(lds + L2_XST);
    if (tid < 2) xst[tid] = 0u;
    __syncthreads();
    XcdBarrier xbar; xbar.bar = (unsigned*)a.ws; xbar.x = 0; xbar.st = xst;
    if (a.ph_hi - a.ph_lo > 1) xbar = xcd_barrier_post((unsigned*)a.ws, xst);
#ifndef PROBE_Q
#define PROBE_Q 1
#endif
#ifdef PROBE_TS
    unsigned long long ts_[10];
#define STAMP(i) do { ts_[i] = __builtin_amdgcn_s_memrealtime(); } while (0)
#else
#define STAMP(i) do {} while (0)
#endif
    STAMP(0);
#define IN(k) (a.ph_lo <= (k) && (k) < a.ph_hi)
#define SEAM(k) do { if (IN(k) && IN((k) + 1)) xcd_barrier(xbar); } while (0)
    if (a.ph_lo < 0) grid.sync();
    if (IN(0)) { p0_prologue(a, lds, vcu, G, wave, lane); }
    SEAM(0); STAMP(1);
    if (IN(1)) {
        constexpr int N1 = 6144;
        pg8::Gemm g{(const pg8::bf16_t*)(a.ws + WS_XN), (const pg8::bf16_t*)(a.ws + WS_WTIN), T, (G == 256 ? N1 : NINP), D}; pg8::StaticOrder S; S.init(T, (G == 256 ? N1 : NINP), G, bx);
        pg8::EpiBf16<0> E{(pg8::bf16_t*)(a.ws + WS_PROJ), NINP, nullptr, 0, 0, 1.f};
        pg8::gemm_phase<pg8::EpiBf16<0>, pg8::StaticOrder, true, true>(lds, g, S, E);
    }
    SEAM(1); STAMP(2);
    if (IN(2)) {
        for (int it = bx; it < NCH * 2; it += G) rwkv_chunk_group(a, lds, it, tid, wave, lane);
    }
    SEAM(2); STAMP(3);
    if (IN(3)) {
        if (bx < 64) state_pass(a, lds, bx, tid, wave, lane);
        else if (G == 256 && bx < 128) {
            pg8::Gemm g{(const pg8::bf16_t*)(a.ws + WS_XN), (const pg8::bf16_t*)(a.ws + WS_WTIN), T, NINP, D}; pg8::OneTile S{(bx - 64) >> 1, 24 + ((bx - 64) & 1)};
            pg8::EpiBf16<0> E{(pg8::bf16_t*)(a.ws + WS_PROJ), NINP, nullptr, 0, 0, 1.f};
            pg8::gemm_phase<pg8::EpiBf16<0>, pg8::OneTile, true, true>(lds, g, S, E);
        } else if (G == 256) {
            for (int it = bx - 128; it < 256; it += 128) attn_unit(a, lds, 2 * it, tid, wave, lane);
            __syncthreads();
            if (tid == 0) { unsigned* hf = (unsigned*)a.ws + 7168; unsigned spins = 0;
                while (__hip_atomic_load(hf, __ATOMIC_RELAXED, __HIP_MEMORY_SCOPE_AGENT) < 64u) { __builtin_amdgcn_s_sleep(4); if (++spins > (1u << 22)) break; }
                __builtin_amdgcn_fence(__ATOMIC_ACQUIRE, "agent"); }
            __syncthreads();
            for (int u = bx - 128; u < HSPLIT * NH; u += 128) rwkv_out_unit(a, lds, u, tid, wave, lane);
        }
    }
    SEAM(3); STAMP(4);
    if (IN(4)) {
        if (G == 256) { for (int it = bx; it < 256; it += G) attn_unit(a, lds, 2 * it + 1, tid, wave, lane); }
        else { for (int it = bx; it < 512; it += G) attn_unit(a, lds, it, tid, wave, lane); }
        STAMP(8);
        for (int u = (G == 256 ? HSPLIT * NH : 0) + bx; u < NCH * NH; u += G) rwkv_out_unit(a, lds, u, tid, wave, lane);
    }
    SEAM(4); STAMP(5);
    if (IN(5)) {
        pg8::Gemm g{(const pg8::bf16_t*)(a.ws + WS_MIX), (const pg8::bf16_t*)(a.ws + WS_WTOUT), T, D, D}; pg8::StaticOrder S; S.init(T, D, G, bx);
        if (G == 256 && a.ph_hi - a.ph_lo > 1) {
            pg8::EpiResidNorm E{a.in[0], a.out, (float*)(a.ws + WS_SSP), (unsigned*)a.ws + 4096, a.in[15], D, RMS_EPS};
            pg8::gemm_phase<pg8::EpiResidNorm, pg8::StaticOrder, false, true>(lds, g, S, E);
        } else {
            pg8::EpiResid E{a.in[0], a.out, (float*)(a.ws + WS_SSP), D};
            pg8::gemm_phase<pg8::EpiResid, pg8::StaticOrder, true, true>(lds, g, S, E);
        }
    }
    if (!(G == 256 && a.ph_hi - a.ph_lo > 1)) { SEAM(5); } STAMP(6);
    if (IN(6) && !(G == 256 && a.ph_hi - a.ph_lo > 1)) final_norm(a, vcu, G, wave, lane);
#ifdef PROBE_G
    __syncthreads();
    if (bx == 0 && tid == 0) { const unsigned long long* g_ = (const unsigned long long*)(a.ws + 65536); a.out[0] = (float)(g_[PROBE_G + 1] - g_[PROBE_G]) * 0.1f; }
#endif
#ifdef PROBE_TS
    STAMP(7); __syncthreads();
    if (bx == 0 && tid == 0) { const int k_ = PROBE_TS; const unsigned long long d_ = (k_ == 9) ? ts_[7] - ts_[0] : (k_ == 8) ? ts_[8] - ts_[4] : ts_[k_ + 1] - ts_[k_]; a.out[0] = (float)(((int)((float)d_ * 0.01f) / PROBE_Q) * PROBE_Q + PROBE_Q / 2); }
#endif
#undef IN
#undef SEAM
}

extern "C" void kernel_launch(void* const* d_in, const int* in_sizes, int n_in, void* d_out, int out_size, void* d_ws, size_t ws_size, hipStream_t stream) {
    static int grid = 0;
    if (grid == 0) {
        int dev = 0, cus = 0;
        if (hipGetDevice(&dev) != hipSuccess || hipDeviceGetAttribute(&cus, hipDeviceAttributeMultiprocessorCount, dev) != hipSuccess) { fprintf(stderr, "kernel_launch: device query failed\n"); grid = -1; return; }
        if (hipFuncSetAttribute((const void*)mega, hipFuncAttributeMaxDynamicSharedMemorySize, LDS_BYTES) != hipSuccess) { fprintf(stderr, "kernel_launch: hipFuncSetAttribute failed\n"); grid = -1; return; }
        (void)hipGetLastError();
        grid = cus;
    }
    if (grid < 0) return;
    Args a{};
    for (int i = 0; i < 16; ++i) a.in[i] = (const float*)d_in[i];
    a.out = (float*)d_out; a.ws = (unsigned char*)d_ws;
#if ONE_LAUNCH
    (void)hipMemsetAsync(d_ws, 0, 32768, stream);
    a.ph_lo = 0; a.ph_hi = NPHASE;
    void* args[] = {&a};
#ifdef PROBE_PLAIN
    hipLaunchKernelGGL(mega, dim3(grid), dim3(NTHR), LDS_BYTES, stream, a); hipError_t e = hipSuccess; (void)args;
#else
    hipError_t e = hipLaunchCooperativeKernel((const void*)mega, dim3(grid), dim3(NTHR), args, LDS_BYTES, stream);
#endif
    if (e != hipSuccess) fprintf(stderr, "cooperative launch failed: %s (grid %d)\n", hipGetErrorString(e), grid);
#else
    for (int p = 0; p < NPHASE; ++p) for (int rep = 0; rep < (p == HOSTDUP ? 2 : 1); ++rep) { a.ph_lo = p; a.ph_hi = p + 1; hipLaunchKernelGGL(mega, dim3(grid), dim3(NTHR), LDS_BYTES, stream, a); }
#endif
}
```

```cpp
#include <hip/hip_runtime.h>
#include <hip/hip_cooperative_groups.h>
#include <cstdio>
#include <cstdint>
namespace cg = cooperative_groups;
namespace pg8 {
#define PG8_LAS __attribute__((address_space(3)))
typedef unsigned short bf16_t;
typedef short bf16x8 __attribute__((ext_vector_type(8)));
typedef float f32x4 __attribute__((ext_vector_type(4)));
typedef unsigned u32x4 __attribute__((ext_vector_type(4)));
constexpr int BM = 256, BK = 64, HALF = 128, HTB = HALF * BK * 2  , STAGE_BYTES = 8 * HTB, NXCD = 8, WGM = 8;

__host__ __device__ __forceinline__ int lds_byte(int r, int c) { const int st = (r >> 4) * 2 + (c >> 5), rr = r & 15, cc = c & 31, ob = rr * 64 + cc * 2; return st * 1024 + (ob ^ (((ob >> 9) & 1) << 5)); }
__host__ __device__ __forceinline__ void stage_rc(int b, int& R, int& C) { const int st = b / 1024, sb = b % 1024, swz = sb ^ (((sb >> 9) & 1) << 5); R = (st >> 1) * 16 + swz / 64; C = (st & 1) * 32 + (swz % 64) / 2; }
__host__ __device__ __forceinline__ int perm32(int rho) { const int n = rho >> 4, i = rho & 15; return 8 * (i >> 2) + 4 * n + (i & 3); }

struct Unit { int pm, pn; };
struct Gemm { const bf16_t* A; const bf16_t* Bt; int M, N, K; };

struct StaticOrder {
    int nM, nN, nwg, G, c;
    __host__ __device__ void init(int M, int N, int G_, int c_) { nM = M / BM; nN = N / BM; nwg = nM * nN; G = G_; c = c_; }
    __host__ __device__ bool next(int i, Unit& u) const {
        const long L = (long)i * G + c; if (L >= nwg) return false;
        int wgid = (int)L; { const int q = nwg / NXCD, r = nwg % NXCD, xcd = wgid % NXCD, off = wgid / NXCD; wgid = (xcd < r ? xcd * (q + 1) : r * (q + 1) + (xcd - r) * q) + off; }
        const int nig = WGM * nN, gid = wgid / nig, fm = gid * WGM, gsz = (nM - fm) < WGM ? (nM - fm) : WGM;
        u.pm = fm + ((wgid % nig) % gsz); u.pn = (wgid % nig) / gsz; return true;
    }
    __device__ __forceinline__ void a_ready(const Unit&) const {}
    __device__ __forceinline__ void done(const Unit&) const {}
};

__device__ __forceinline__ unsigned cvt_pk_bf16(float lo, float hi) { unsigned r; asm volatile("v_cvt_pk_bf16_f32 %0, %1, %2" : "=v"(r) : "v"(lo), "v"(hi)); return r; }
typedef float f32x2 __attribute__((ext_vector_type(2)));
__device__ __forceinline__ f32x2 gelu_pk(f32x2 v) {
    const f32x2 av = __builtin_elementwise_abs(v), d = av * 0.2316418882f + 1.0f;
    f32x2 t; t.x = __builtin_amdgcn_rcpf(d.x); t.y = __builtin_amdgcn_rcpf(d.y);
    f32x2 q = t * 0.5307027145f + (-0.7265760135f); q = q * t + 0.7107068705f; q = q * t + (-0.142248368f); q = q * t + 0.127414796f; q = q * t;
    const f32x2 s = (v * v) * (-0.72134752044f);
    f32x2 e; e.x = __builtin_amdgcn_exp2f(s.x); e.y = __builtin_amdgcn_exp2f(s.y);
    const f32x2 m = v * (q * e), r = v - m;
    f32x2 o; o.x = v.x < 0.f ? m.x : r.x; o.y = v.y < 0.f ? m.y : r.y; return o;
}

template <int ACT  > struct EpiBf16 {
    static constexpr bool PERM = true, AFTER_DRAIN = false; static_assert(ACT == 0 || ACT == 1, "EpiBf16: ACT is 0 (none) or 1 (gelu_pk)");
    bf16_t* O; int ldc; const float* bias; int split_cols; size_t split_stride; float scale0;
    __device__ __forceinline__ void operator()(const f32x4 (&acc)[2][2][4][2], const Unit& u, int wr, int wc, int fr, int fq) const {
        const int row0 = u.pm * BM + wr * 64 + fr; int colt = u.pn * BM; bf16_t* base = O;
        float sc = 1.f; if (split_cols) { const int t = colt / split_cols; base += (size_t)t * split_stride; colt -= t * split_cols; if (t == 0) sc = scale0; }
        const int col0 = colt + wc * 32 + 8 * fq, bcol0 = u.pn * BM + wc * 32 + 8 * fq;
        f32x4 bv[2][2];
#pragma unroll
        for (int bj = 0; bj < 2; ++bj)
#pragma unroll
            for (int n = 0; n < 2; ++n) bv[bj][n] = bias ? *(const f32x4*)(bias + bcol0 + bj * HALF + 4 * n) : (f32x4){0.f, 0.f, 0.f, 0.f};
#pragma unroll
        for (int ai = 0; ai < 2; ++ai)
#pragma unroll
            for (int m = 0; m < 4; ++m) { bf16_t* rowp = base + (size_t)(row0 + ai * HALF + m * 16) * ldc + col0;
#pragma unroll
                for (int bj = 0; bj < 2; ++bj) { f32x4 v0 = acc[ai][bj][m][0] + bv[bj][0], v1 = acc[ai][bj][m][1] + bv[bj][1];
                    if (ACT == 1) { f32x2 a = gelu_pk((f32x2){v0[0], v0[1]}), b = gelu_pk((f32x2){v0[2], v0[3]}), c = gelu_pk((f32x2){v1[0], v1[1]}), d = gelu_pk((f32x2){v1[2], v1[3]});
                        v0 = (f32x4){a.x, a.y, b.x, b.y}; v1 = (f32x4){c.x, c.y, d.x, d.y}; }
                    v0 = v0 * sc; v1 = v1 * sc; u32x4 w; w.x = cvt_pk_bf16(v0[0], v0[1]); w.y = cvt_pk_bf16(v0[2], v0[3]); w.z = cvt_pk_bf16(v1[0], v1[1]); w.w = cvt_pk_bf16(v1[2], v1[3]);
                    *(u32x4*)(rowp + bj * HALF) = w; } }
    }
};
struct EpiResid {
    static constexpr bool PERM = false, AFTER_DRAIN = false;
    const float* x; float* out; float* sspart; int ldc;
    __device__ __forceinline__ void operator()(const f32x4 (&acc)[2][2][4][2], const Unit& u, int wr, int wc, int fr, int fq) const {
        const int row0 = u.pm * BM + wr * 64 + fr, col0 = u.pn * BM + wc * 32 + 4 * fq;
#pragma unroll
        for (int ai = 0; ai < 2; ++ai)
#pragma unroll
            for (int m = 0; m < 4; ++m) {
                const int row = row0 + ai * HALF + m * 16; float ss = 0.f;
#pragma unroll
                for (int bj = 0; bj < 2; ++bj)
#pragma unroll
                    for (int n = 0; n < 2; ++n) {
                        const size_t off = (size_t)row * ldc + col0 + bj * HALF + n * 16;
                        const f32x4 xv = *(const f32x4*)(x + off); const f32x4 v = acc[ai][bj][m][n] + xv;
                        *(f32x4*)(out + off) = v; ss += (v[0] * v[0] + v[1] * v[1]) + (v[2] * v[2] + v[3] * v[3]);
                    }
                ss += __shfl_xor(ss, 16); ss += __shfl_xor(ss, 32);
                if (fq == 0) sspart[(size_t)row * 32 + u.pn * 4 + wc] = ss;
            }
    }
};

struct OneTile {
    int pm, pn;
    __host__ __device__ bool next(int i, Unit& u) const { if (i != 0) return false; u.pm = pm; u.pn = pn; return true; }
    __device__ __forceinline__ void a_ready(const Unit&) const {}
    __device__ __forceinline__ void done(const Unit&) const {}
};
struct EpiResidNorm {
    static constexpr bool PERM = false, AFTER_DRAIN = true;
    const float* x; float* out; float* ssp; unsigned* cnt; const float* gain; int ldc; float eps;
    __device__ __forceinline__ void fused(f32x4 (&acc)[2][2][4][2], const Unit& u, int wr, int wc, int fr, int fq, PG8_LAS unsigned char* lds, int wid, int lane) const {
        const int row0 = u.pm * BM + wr * 64 + fr, col0 = u.pn * BM + wc * 32 + 4 * fq;
#pragma unroll
        for (int ai = 0; ai < 2; ++ai) {
            f32x4 xv[4][2][2];
#pragma unroll
            for (int m = 0; m < 4; ++m)
#pragma unroll
                for (int bj = 0; bj < 2; ++bj)
#pragma unroll
                    for (int n = 0; n < 2; ++n) xv[m][bj][n] = __builtin_nontemporal_load((const f32x4*)(x + (size_t)(row0 + ai * HALF + m * 16) * ldc + col0 + bj * HALF + n * 16));
#pragma unroll
            for (int m = 0; m < 4; ++m) {
                const int row = row0 + ai * HALF + m * 16; float ss = 0.f;
#pragma unroll
                for (int bj = 0; bj < 2; ++bj)
#pragma unroll
                    for (int n = 0; n < 2; ++n) {
                        const f32x4 v = acc[ai][bj][m][n] + xv[m][bj][n];
                        acc[ai][bj][m][n] = v; ss += (v[0] * v[0] + v[1] * v[1]) + (v[2] * v[2] + v[3] * v[3]);
                    }
                ss += __shfl_xor(ss, 16); ss += __shfl_xor(ss, 32);
                if (fq == 0) __hip_atomic_store(ssp + (size_t)row * 32 + u.pn * 4 + wc, ss, __ATOMIC_RELAXED, __HIP_MEMORY_SCOPE_AGENT);
            }
        }
        asm volatile("s_waitcnt vmcnt(0)" ::: "memory");
        __syncthreads();
        unsigned* c = cnt + 64 * u.pm;
        if (threadIdx.x == 0) {
            __hip_atomic_fetch_add(c, 1u, __ATOMIC_RELEASE, __HIP_MEMORY_SCOPE_AGENT);
            unsigned spins = 0;
            while (__hip_atomic_load(c, __ATOMIC_RELAXED, __HIP_MEMORY_SCOPE_AGENT) < 8u) { __builtin_amdgcn_s_sleep(2); if (++spins > (1u << 22)) break; }
            __builtin_amdgcn_fence(__ATOMIC_ACQUIRE, "agent");
        }
        __syncthreads();
        PG8_LAS float* S = (PG8_LAS float*)lds;
        if (threadIdx.x < 256) {
            const float* p = ssp + (size_t)(u.pm * BM + threadIdx.x) * 32; float s = 0.f;
#pragma unroll
            for (int i = 0; i < 32; ++i) s += __hip_atomic_load(p + i, __ATOMIC_RELAXED, __HIP_MEMORY_SCOPE_AGENT);
            S[threadIdx.x] = 1.0f / sqrtf(s * (1.0f / 2048.0f) + eps);
        }
        __syncthreads();
#pragma unroll
        for (int bj = 0; bj < 2; ++bj)
#pragma unroll
            for (int n = 0; n < 2; ++n) {
                const f32x4 g = *(const f32x4*)(gain + col0 + bj * HALF + n * 16);
#pragma unroll
                for (int ai = 0; ai < 2; ++ai)
#pragma unroll
                    for (int m = 0; m < 4; ++m) {
                        const int lr = wr * 64 + fr + ai * HALF + m * 16; const float rs = S[lr];
                        f32x4 v = acc[ai][bj][m][n]; v[0] *= rs * g[0]; v[1] *= rs * g[1]; v[2] *= rs * g[2]; v[3] *= rs * g[3];
                        __builtin_nontemporal_store(v, (f32x4*)(out + (size_t)(u.pm * BM + lr) * ldc + col0 + bj * HALF + n * 16));
                    }
            }
    }
};

template <class Epi, class Sched, bool ALIGN_EPI = false, bool SP2 = false>
__device__ __forceinline__ void gemm_phase(PG8_LAS unsigned char* lds, const Gemm g, const Sched& S, const Epi& E) {
    const int tid = threadIdx.x, wid = __builtin_amdgcn_readfirstlane(tid >> 6), lane = tid & 63, wr = wid >> 2, wc = wid & 3, fr = lane & 15, fq = lane >> 4;
    const int K = g.K, nt = K / BK;
    unsigned voffA[2], voffB[2];
#pragma unroll
    for (int i = 0; i < 2; ++i) { int R, C; stage_rc(tid * 16 + i * 8192, R, C); const int Rb = Epi::PERM ? ((R & ~31) + perm32(R & 31)) : R;
        voffA[i] = (unsigned)(R * K + C) * 2u; voffB[i] = (unsigned)(Rb * K + C) * 2u; }
    const size_t kstep = (size_t)(BK * 2);
    const size_t hstep = (size_t)HALF * K * 2;
    const size_t tstep = 2 * hstep;
    const unsigned ldsw = (unsigned)wid * 1024u;
    const int aoff = lds_byte(wr * 64 + fr, fq * 8), boff = lds_byte(wc * 32 + fr, fq * 8);
#define PG8_SA(b, h) (((b) * 2 + (h)) * HTB)
#define PG8_SB(b, h) ((4 + (b) * 2 + (h)) * HTB)
#define PG8_STAGE(bufoff, gbase, voff) do { _Pragma("unroll") for (int _i = 0; _i < 2; ++_i) \
        __builtin_amdgcn_global_load_lds((const unsigned*)((const char*)(gbase) + (voff)[_i]), (PG8_LAS unsigned*)(lds + (bufoff) + ldsw + _i * 8192), 16, 0, 0); } while (0)
#define PG8_LDA(dst, b, h) do { _Pragma("unroll") for (int m = 0; m < 4; ++m) _Pragma("unroll") for (int k = 0; k < 2; ++k) dst[m][k] = *(const PG8_LAS bf16x8*)(lds + PG8_SA(b, h) + aoff + m * 2048 + k * 1024); } while (0)
#define PG8_LDB(dst, b, h) do { _Pragma("unroll") for (int n = 0; n < 2; ++n) _Pragma("unroll") for (int k = 0; k < 2; ++k) dst[n][k] = *(const PG8_LAS bf16x8*)(lds + PG8_SB(b, h) + boff + n * 2048 + k * 1024); } while (0)
#define PG8_MMA(ai, bj, At, Bt) do { __builtin_amdgcn_s_setprio(1); _Pragma("unroll") for (int m = 0; m < 4; ++m) _Pragma("unroll") for (int n = 0; n < 2; ++n) _Pragma("unroll") for (int k = 0; k < 2; ++k) \
        acc[ai][bj][m][n] = __builtin_amdgcn_mfma_f32_16x16x32_bf16(Bt[n][k], At[m][k], acc[ai][bj][m][n], 0, 0, 0); __builtin_amdgcn_s_setprio(0); } while (0)
#define PG8_WAIT_V(n) asm volatile("s_waitcnt vmcnt(" #n ")" ::: "memory")
#define PG8_WAIT_L(n) asm volatile("s_waitcnt lgkmcnt(" #n ")" ::: "memory")
#define PG8_BAR __builtin_amdgcn_s_barrier()
#define PG8_SCHED __builtin_amdgcn_sched_barrier(0)
    Unit cur, nxt; int ui = 0;
    if (!S.next(0, cur)) return;
    f32x4 acc[2][2][4][2];
#pragma unroll
    for (int a = 0; a < 2; ++a)
#pragma unroll
        for (int b = 0; b < 2; ++b)
#pragma unroll
            for (int m = 0; m < 4; ++m)
#pragma unroll
                for (int n = 0; n < 2; ++n) acc[a][b][m][n] = (f32x4){0.f, 0.f, 0.f, 0.f};
    bf16x8 At[4][2], B0[2][2], B1[2][2];
    const char* cA = (const char*)g.A + (size_t)cur.pm * tstep; const char* cB = (const char*)g.Bt + (size_t)cur.pn * tstep;
    S.a_ready(cur);
    if constexpr (SP2) {
        PG8_STAGE(PG8_SB(0, 0), cB, voffB); PG8_STAGE(PG8_SB(0, 1), cB + hstep, voffB); PG8_STAGE(PG8_SA(0, 0), cA, voffA); PG8_STAGE(PG8_SA(0, 1), cA + hstep, voffA);
        if (wr == 1) PG8_BAR;
        PG8_WAIT_V(2); PG8_BAR;
        PG8_STAGE(PG8_SB(1, 0), cB + kstep, voffB); PG8_STAGE(PG8_SA(1, 0), cA + kstep, voffA); PG8_STAGE(PG8_SB(1, 1), cB + hstep + kstep, voffB);
        PG8_WAIT_V(6); PG8_BAR;
    } else {
        PG8_STAGE(PG8_SB(0, 0), cB, voffB); PG8_STAGE(PG8_SA(0, 0), cA, voffA); PG8_STAGE(PG8_SB(0, 1), cB + hstep, voffB); PG8_STAGE(PG8_SA(0, 1), cA + hstep, voffA);
        if (wr == 1) PG8_BAR;
        PG8_WAIT_V(4); PG8_BAR;
        PG8_STAGE(PG8_SB(1, 0), cB + kstep, voffB); PG8_STAGE(PG8_SA(1, 0), cA + kstep, voffA); PG8_STAGE(PG8_SB(1, 1), cB + hstep + kstep, voffB);
        PG8_WAIT_V(6); PG8_BAR;
    }
    for (;;) {
        const bool has_next = S.next(ui + 1, nxt);
        const char* nA = has_next ? (const char*)g.A + (size_t)nxt.pm * tstep : cA; const char* nB = has_next ? (const char*)g.Bt + (size_t)nxt.pn * tstep : cB;
        for (int t = 0; t < nt; t += 2) {
            const bool last = (t == nt - 2);
            const char* a1 = cA + (size_t)(t + 1) * kstep;
            const char* a2 = last ? nA : cA + (size_t)(t + 2) * kstep; const char* b2 = last ? nB : cB + (size_t)(t + 2) * kstep;
            const char* a3 = a2 + kstep; const char* b3 = b2 + kstep;
            if (last && has_next) S.a_ready(nxt);
            if constexpr (SP2) {
            PG8_LDB(B0, 0, 0); PG8_LDB(B1, 0, 1); PG8_SCHED; PG8_LDA(At, 0, 0); PG8_STAGE(PG8_SA(1, 1), a1 + hstep, voffA);
            PG8_WAIT_V(8); PG8_WAIT_L(0); PG8_BAR; PG8_MMA(0, 0, At, B0); PG8_MMA(0, 1, At, B1); PG8_BAR; PG8_SCHED;
            PG8_LDA(At, 0, 1); PG8_STAGE(PG8_SB(0, 0), b2, voffB); PG8_STAGE(PG8_SB(0, 1), b2 + hstep, voffB); PG8_STAGE(PG8_SA(0, 0), a2, voffA);
            PG8_WAIT_V(8); PG8_WAIT_L(0); PG8_BAR; PG8_MMA(1, 0, At, B0); PG8_MMA(1, 1, At, B1); PG8_BAR; PG8_SCHED;
            PG8_LDB(B0, 1, 0); PG8_LDB(B1, 1, 1); PG8_SCHED; PG8_LDA(At, 1, 0); PG8_STAGE(PG8_SA(0, 1), a2 + hstep, voffA);
            PG8_WAIT_V(8); PG8_WAIT_L(0); PG8_BAR; PG8_MMA(0, 0, At, B0); PG8_MMA(0, 1, At, B1); PG8_BAR; PG8_SCHED;
            PG8_LDA(At, 1, 1); PG8_STAGE(PG8_SB(1, 0), b3, voffB); PG8_STAGE(PG8_SB(1, 1), b3 + hstep, voffB); PG8_STAGE(PG8_SA(1, 0), a3, voffA);
            PG8_WAIT_V(8); PG8_WAIT_L(0); PG8_BAR; PG8_MMA(1, 0, At, B0); PG8_MMA(1, 1, At, B1); PG8_BAR; PG8_SCHED;
            } else {
            PG8_LDB(B0, 0, 0); PG8_SCHED; PG8_LDA(At, 0, 0); PG8_STAGE(PG8_SA(1, 1), a1 + hstep, voffA);
            PG8_WAIT_L(8); PG8_BAR; PG8_WAIT_L(0); PG8_MMA(0, 0, At, B0); PG8_BAR; PG8_SCHED;
            PG8_LDB(B1, 0, 1); PG8_STAGE(PG8_SB(0, 0), b2, voffB);
            PG8_BAR; PG8_WAIT_L(0); PG8_MMA(0, 1, At, B1); PG8_BAR;
            PG8_LDA(At, 0, 1); PG8_STAGE(PG8_SA(0, 0), a2, voffA);
            PG8_BAR; PG8_WAIT_L(0); PG8_MMA(1, 0, At, B0); PG8_BAR; PG8_SCHED;
            PG8_STAGE(PG8_SB(0, 1), b2 + hstep, voffB);
            PG8_WAIT_V(6); PG8_BAR; PG8_MMA(1, 1, At, B1); PG8_BAR;
            PG8_LDB(B0, 1, 0); PG8_SCHED; PG8_LDA(At, 1, 0); PG8_STAGE(PG8_SA(0, 1), a2 + hstep, voffA);
            PG8_WAIT_L(8); PG8_BAR; PG8_WAIT_L(0); PG8_MMA(0, 0, At, B0); PG8_BAR; PG8_SCHED;
            PG8_LDB(B1, 1, 1); PG8_STAGE(PG8_SB(1, 0), b3, voffB);
            PG8_BAR; PG8_WAIT_L(0); PG8_MMA(0, 1, At, B1); PG8_BAR;
            PG8_LDA(At, 1, 1); PG8_STAGE(PG8_SA(1, 0), a3, voffA);
            PG8_BAR; PG8_WAIT_L(0); PG8_MMA(1, 0, At, B0); PG8_BAR; PG8_SCHED;
            PG8_STAGE(PG8_SB(1, 1), b3 + hstep, voffB);
            PG8_WAIT_V(6); PG8_BAR; PG8_MMA(1, 1, At, B1); PG8_BAR;
            }
        }
        if constexpr (ALIGN_EPI) { if (wr == 0) PG8_BAR; }
        if constexpr (!Epi::AFTER_DRAIN) { E(acc, cur, wr, wc, fr, fq); S.done(cur); }
        if (!has_next) break;
#pragma unroll
        for (int a = 0; a < 2; ++a)
#pragma unroll
            for (int b = 0; b < 2; ++b)
#pragma unroll
                for (int m = 0; m < 4; ++m)
#pragma unroll
                    for (int n = 0; n < 2; ++n) acc[a][b][m][n] = (f32x4){0.f, 0.f, 0.f, 0.f};
        cur = nxt; cA = nA; cB = nB; ++ui;
        if constexpr (ALIGN_EPI) { if (wr == 1) PG8_BAR; }
    }
    PG8_WAIT_V(0);
    if constexpr (!ALIGN_EPI) { if (wr == 0) PG8_BAR; }
    PG8_BAR;
    if constexpr (Epi::AFTER_DRAIN) { E.fused(acc, cur, wr, wc, fr, fq, lds, wid, lane); S.done(cur); }
#undef PG8_SA
#undef PG8_SB
#undef PG8_STAGE
#undef PG8_LDA
#undef PG8_LDB
#undef PG8_MMA
#undef PG8_WAIT_V
#undef PG8_WAIT_L
#undef PG8_BAR
#undef PG8_SCHED
}
}
constexpr int T = 8192, D = 2048, NIN = 6528, NINP = 6656, RW = 1024, NH = 16, HD = 64, CH = 64, NCH = T / CH;
constexpr int C_R = 0, C_K = 1024, C_V = 2048, C_WD = 3072, C_AD = 3136, C_G = 3200, C_AQ = 4224, C_AK = 5248, C_AV = 5376, C_AG = 5504;
constexpr float RMS_EPS = 1e-5f, LNX_EPS = 64e-5f;
constexpr int NWAVES = 8, NTHR = 512;
constexpr size_t MiB = 1u << 20;
constexpr size_t WS_WTIN = 1 * MiB;
constexpr size_t WS_XN = 27 * MiB;
constexpr size_t WS_WTOUT = 59 * MiB;
constexpr size_t WS_UPT = 67 * MiB;
constexpr size_t WS_SSP = 68 * MiB;
constexpr size_t WS_PROJ = 70 * MiB;
constexpr size_t WS_SCR = 174 * MiB;
constexpr size_t WS_MIX = 223 * MiB;
constexpr size_t WS_P32 = 223 * MiB;
constexpr int LDS_BYTES = 163840;

#define GAS __attribute__((address_space(1)))
#define LAS __attribute__((address_space(3)))
typedef unsigned short bf16;
typedef unsigned v4u __attribute__((ext_vector_type(4)));
typedef unsigned v2u __attribute__((ext_vector_type(2)));
typedef float f32x4 __attribute__((ext_vector_type(4)));
typedef float f32x16 __attribute__((ext_vector_type(16)));
typedef short bf16x8 __attribute__((ext_vector_type(8)));
typedef __bf16 bf16x2_t __attribute__((ext_vector_type(2)));
__device__ __forceinline__ unsigned pk2(float a, float b) { bf16x2_t v; v[0] = (__bf16)a; v[1] = (__bf16)b; return __builtin_bit_cast(unsigned, v); }
__device__ __forceinline__ float bflo(unsigned u) { return __uint_as_float(u << 16); }
__device__ __forceinline__ float bfhi(unsigned u) { return __uint_as_float(u & 0xffff0000u); }
__device__ __forceinline__ void unpack8(const v4u& p, float (&f)[8]) { f[0] = bflo(p.x); f[1] = bfhi(p.x); f[2] = bflo(p.y); f[3] = bfhi(p.y); f[4] = bflo(p.z); f[5] = bfhi(p.z); f[6] = bflo(p.w); f[7] = bfhi(p.w); }
__device__ __forceinline__ v4u pack8(const float (&f)[8]) { v4u o; o.x = pk2(f[0], f[1]); o.y = pk2(f[2], f[3]); o.z = pk2(f[4], f[5]); o.w = pk2(f[6], f[7]); return o; }
__device__ __forceinline__ float wave_sum(float v) {
#pragma unroll
    for (int o = 1; o < 64; o <<= 1) v += __shfl_xor(v, o);
    return v;
}
__device__ __forceinline__ float sum8(float v) { v += __shfl_xor(v, 1); v += __shfl_xor(v, 2); v += __shfl_xor(v, 4); return v; }
__device__ __forceinline__ float sigmoidf_(float x) { return 1.f / (1.f + __expf(-x)); }
__device__ __forceinline__ float siluf_(float x) { return x / (1.f + __expf(-x)); }

__device__ __forceinline__ void bar_lds() { asm volatile("s_waitcnt lgkmcnt(0)" ::: "memory"); __builtin_amdgcn_s_barrier(); asm volatile("" ::: "memory"); }
struct Args { const float* in[16]; float* out; unsigned char* ws; int ph_lo, ph_hi; };

struct TItem { const float* W; bf16* WT; int K, N, k0, n0; };
__device__ __forceinline__ bool p0_item(const Args& a, int it, TItem& o) {
    constexpr int I_IN = (D / 64) * (NIN / 32), I_OUT = (D / 64) * (D / 32), I_UP = RW / 32;
    bf16* wtin = (bf16*)(a.ws + WS_WTIN); bf16* wtout = (bf16*)(a.ws + WS_WTOUT); bf16* upt = (bf16*)(a.ws + WS_UPT); bf16* aupt = upt + 65536;
    int r = it;
    if (r < 0) { r += I_OUT; if (r < 0) return false; o.W = a.in[14]; o.WT = wtout; o.K = D; o.N = D; }
    else if (r < I_IN) { o.W = a.in[2]; o.WT = wtin; o.K = D; o.N = NIN; }
    else if ((r -= I_IN) < I_UP) { o.W = a.in[5]; o.WT = upt; o.K = 64; o.N = RW; }
    else if ((r -= I_UP) < I_UP) { o.W = a.in[7]; o.WT = aupt; o.K = 64; o.N = RW; }
    else return false;
    const int nblk = o.N / 32; o.k0 = 64 * (r / nblk); o.n0 = 32 * (r % nblk); return true;
}
__device__ __forceinline__ void p0_ld(const TItem& t, int lane, f32x4 (&v)[8]) {
#pragma unroll
    for (int i = 0; i < 8; ++i) v[i] = __builtin_nontemporal_load((const f32x4*)(t.W + (size_t)(t.k0 + 8 * i + (lane >> 3)) * t.N + t.n0 + 4 * (lane & 7)));
}
__device__ __forceinline__ void p0_st(const TItem& t, int lane, const f32x4 (&v)[8], LAS float* scr) {
#pragma unroll
    for (int i = 0; i < 8; ++i) { LAS float* d = scr + (8 * i + (lane >> 3)) * 33 + 4 * (lane & 7); d[0] = v[i].x; d[1] = v[i].y; d[2] = v[i].z; d[3] = v[i].w; }
    asm volatile("s_waitcnt lgkmcnt(0)" ::: "memory");
    const int c = lane & 7;
#pragma unroll
    for (int j = 0; j < 4; ++j) { const int n = (lane >> 3) + 8 * j; const LAS float* s = scr + (8 * c) * 33 + n;
        v4u o; o.x = pk2(s[0 * 33], s[1 * 33]); o.y = pk2(s[2 * 33], s[3 * 33]); o.z = pk2(s[4 * 33], s[5 * 33]); o.w = pk2(s[6 * 33], s[7 * 33]);
        *(v4u*)(t.WT + (size_t)(t.n0 + n) * t.K + t.k0 + 8 * c) = o; }
    asm volatile("s_waitcnt lgkmcnt(0)" ::: "memory");
}
__device__ __forceinline__ void wout_transposes(const Args& a, LAS unsigned char* lds, int gw, int NGW, int wave, int lane) {
    LAS float* scr = (LAS float*)(lds + wave * 16384);
    constexpr int I_OUT = (D / 64) * (D / 32);
    for (int it = gw - I_OUT; it < 0; it += NGW) { TItem t0; f32x4 v0[8]; if (!p0_item(a, it, t0)) break; p0_ld(t0, lane, v0); p0_st(t0, lane, v0, scr); }
}
__device__ __forceinline__ void p0_prologue(const Args& a, LAS unsigned char* lds, int vcu, int G, int wave, int lane) {
    LAS float* scr = (LAS float*)(lds + wave * 16384);
    const int gw = vcu * NWAVES + wave, NGW = G * NWAVES;
    bf16* wtin = (bf16*)(a.ws + WS_WTIN);
#ifdef PROBE_P0X
    for (int rep_ = 0; rep_ < 2; ++rep_)
#endif
    for (int it = gw; ; it += 2 * NGW) {
        TItem t0, t1; f32x4 v0[8], v1[8];
        const bool h0 = p0_item(a, it, t0), h1 = p0_item(a, it + NGW, t1);
        if (!h0) break;
        p0_ld(t0, lane, v0); if (h1) p0_ld(t1, lane, v1);
        p0_st(t0, lane, v0, scr); if (h1) p0_st(t1, lane, v1, scr);
    }
    wout_transposes(a, lds, gw, NGW, wave, lane);
    { v4u z = {0u, 0u, 0u, 0u}; v4u* p = (v4u*)(wtin + (size_t)NIN * D); const int n16 = (NINP - NIN) * D * 2 / 16;
      for (int i = gw * 64 + lane; i < n16; i += NGW * 64) p[i] = z; }
    const float* gain = a.in[1];
#ifdef PROBE_P0R
    for (int rep_ = 0; rep_ < 2; ++rep_)
#endif
    for (int m = gw; m < T; m += 2 * NGW) {
        const int m2 = m + NGW;
        const f32x4* xr = (const f32x4*)(a.in[0] + (size_t)m * D) + lane; const f32x4* xr2 = (const f32x4*)(a.in[0] + (size_t)(m2 < T ? m2 : m) * D) + lane;
        f32x4 v[8], u[8]; float s = 0.f, s2 = 0.f;
#pragma unroll
        for (int j = 0; j < 8; ++j) { v[j] = __builtin_nontemporal_load(xr + 64 * j); u[j] = __builtin_nontemporal_load(xr2 + 64 * j); }
#pragma unroll
        for (int j = 0; j < 8; ++j) { s += (v[j].x * v[j].x + v[j].y * v[j].y) + (v[j].z * v[j].z + v[j].w * v[j].w); s2 += (u[j].x * u[j].x + u[j].y * u[j].y) + (u[j].z * u[j].z + u[j].w * u[j].w); }
        const float rstd = 1.f / sqrtf(wave_sum(s) * (1.f / D) + RMS_EPS), rstd2 = 1.f / sqrtf(wave_sum(s2) * (1.f / D) + RMS_EPS);
        v2u* o8 = (v2u*)((bf16*)(a.ws + WS_XN) + (size_t)m * D) + lane; v2u* o82 = (v2u*)((bf16*)(a.ws + WS_XN) + (size_t)m2 * D) + lane;
#pragma unroll
        for (int j = 0; j < 8; ++j) { const f32x4 g = *((const f32x4*)gain + lane + 64 * j); v2u o; o.x = pk2(v[j].x * rstd * g.x, v[j].y * rstd * g.y); o.y = pk2(v[j].z * rstd * g.z, v[j].w * rstd * g.w); o8[64 * j] = o;
            if (m2 < T) { o.x = pk2(u[j].x * rstd2 * g.x, u[j].y * rstd2 * g.y); o.y = pk2(u[j].z * rstd2 * g.z, u[j].w * rstd2 * g.w); o82[64 * j] = o; } }
    }
}
__device__ __forceinline__ void final_norm(const Args& a, int vcu, int G, int wave, int lane) {
    const int gw = vcu * NWAVES + wave, NGW = G * NWAVES; const float* ssp = (const float*)(a.ws + WS_SSP); const float* gain = a.in[15];
    for (int m = gw; m < T; m += NGW) {
        float s = (lane < 32) ? ssp[(size_t)m * 32 + lane] : 0.f; s = wave_sum(s);
        const float rstd = 1.f / sqrtf(s * (1.f / D) + RMS_EPS);
        f32x4* xr = (f32x4*)(a.out + (size_t)m * D) + lane;
#pragma unroll
        for (int j = 0; j < 8; ++j) { f32x4 v = xr[64 * j]; const f32x4 g = *((const f32x4*)gain + lane + 64 * j); v.x *= rstd * g.x; v.y *= rstd * g.y; v.z *= rstd * g.z; v.w *= rstd * g.w; xr[64 * j] = v; }
    }
}
#define XB_TMO      128
#define XB_XCNT(j)  (256  + 64 * (j))
#define XB_XSUB(j)  (1280 + 64 * (j))
#define XB_XGEN(j)  (2304 + 64 * (j))
#define XB_TOP      3328
#define XB_TOPGEN   3392
#define XCD_BAR_WORDS 3456
#define XB_SPIN_CAP (1u << 18)

__device__ __forceinline__ unsigned xb_ld(unsigned* p)              { return __hip_atomic_load(p, __ATOMIC_RELAXED, __HIP_MEMORY_SCOPE_AGENT); }
__device__ __forceinline__ unsigned xb_add(unsigned* p, unsigned v) { return __hip_atomic_fetch_add(p, v, __ATOMIC_RELAXED, __HIP_MEMORY_SCOPE_AGENT); }
__device__ __forceinline__ unsigned xb_xcc_id() { return (unsigned)__builtin_amdgcn_s_getreg((3 << 11) | 20) & 0xFu; }
#define XB_SPIN(cond, bar) do { unsigned _sp = 0; while (cond) { __builtin_amdgcn_s_sleep(1); \
    if ((++_sp & 255u) == 0u) { if (xb_ld(&(bar)[XB_TMO])) break; if (_sp > XB_SPIN_CAP) { atomicAdd(&(bar)[XB_TMO], 1u); break; } } } } while (0)

struct XcdBarrier {
    unsigned* bar; unsigned x;
    volatile LAS unsigned* st;
};

__device__ __forceinline__ XcdBarrier xcd_barrier_post(unsigned* bar, volatile LAS unsigned* st) {
    XcdBarrier b; b.bar = bar; b.x = xb_xcc_id(); b.st = st;
    if (threadIdx.x == 0) (void)xb_add(&bar[XB_XCNT(b.x)], 1u);
    return b;
}
__device__ __forceinline__ void xcd_barrier_complete(unsigned* bar, unsigned x, unsigned& nloc, unsigned& nx) {
    const unsigned G = gridDim.x * gridDim.y * gridDim.z;
    unsigned sum, cnt, mine, sp = 0u;
    for (;;) {
        sum = 0u; cnt = 0u; mine = 0u;
#pragma unroll
        for (unsigned j = 0; j < 16; ++j) { const unsigned c = xb_ld(&bar[XB_XCNT(j)]); sum += c; cnt += (c > 0u) ? 1u : 0u; mine = (j == x) ? c : mine; }
        if (sum == G) break;
        __builtin_amdgcn_s_sleep(1);
        if ((++sp & 255u) == 0u) { if (xb_ld(&bar[XB_TMO])) break; if (sp > XB_SPIN_CAP) { atomicAdd(&bar[XB_TMO], 1u); break; } }
    }
    nloc = mine > 0u ? mine : 1u; nx = cnt > 0u ? cnt : 1u;
}

__device__ __forceinline__ void xcd_barrier(const XcdBarrier& b) {
    asm volatile("s_waitcnt vmcnt(0)" ::: "memory");
    __syncthreads();
    if (threadIdx.x == 0) {
        unsigned* bar = b.bar;
        __builtin_amdgcn_s_waitcnt(0);
        unsigned nloc = b.st[0], nx = b.st[1];
        if (nloc == 0u) { xcd_barrier_complete(bar, b.x, nloc, nx); b.st[0] = nloc; b.st[1] = nx; }
        const unsigned old = xb_add(&bar[XB_XSUB(b.x)], 1u);
        const unsigned gen = old / nloc;
        if (old + 1u == (gen + 1u) * nloc) {
            __builtin_amdgcn_fence(__ATOMIC_RELEASE, "agent");
            asm volatile("s_waitcnt vmcnt(0)" ::: "memory");
            const unsigned og = xb_add(&bar[XB_TOP], 1u);
            const unsigned tg = og / nx;
            if (og + 1u == (tg + 1u) * nx) xb_add(&bar[XB_TOPGEN], 1u);
            else XB_SPIN(xb_ld(&bar[XB_TOPGEN]) == tg, bar);
            __builtin_amdgcn_fence(__ATOMIC_ACQUIRE, "agent");
            xb_add(&bar[XB_XGEN(b.x)], 1u);
            asm volatile("s_waitcnt vmcnt(0)" ::: "memory");
        } else {
            XB_SPIN(xb_ld(&bar[XB_XGEN(b.x)]) == gen, bar);
            __builtin_amdgcn_fence(__ATOMIC_ACQUIRE, "agent");
            asm volatile("s_waitcnt vmcnt(0)" ::: "memory");
        }
    }
    __syncthreads();
}

#define MFMA32(a_, b_, c_) __builtin_amdgcn_mfma_f32_32x32x16_bf16((a_), (b_), (c_), 0, 0, 0)
#define MFMA16(a_, b_, c_) __builtin_amdgcn_mfma_f32_16x16x32_bf16((a_), (b_), (c_), 0, 0, 0)
__device__ __forceinline__ v4u ldg16(const bf16* p) { return *(const v4u*)p; }
__device__ __forceinline__ void load_shift8(const bf16* proj, int row, int col, const float* mu, float (&o)[8]) {
    const v4u p = ldg16(proj + (size_t)row * NINP + col); v4u q = {0u, 0u, 0u, 0u};
    if (row > 0) q = ldg16(proj + (size_t)(row - 1) * NINP + col);
    float pf[8], qf[8]; unpack8(p, pf); unpack8(q, qf);
    const f32x4 m0 = *(const f32x4*)(mu + col), m1 = *(const f32x4*)(mu + col + 4);
    const float mf[8] = {m0.x, m0.y, m0.z, m0.w, m1.x, m1.y, m1.z, m1.w};
#pragma unroll
    for (int j = 0; j < 8; ++j) o[j] = pf[j] + (qf[j] - pf[j]) * mf[j];
}
__device__ __forceinline__ void ld8f(const float* p, float (&o)[8]) { const f32x4 a = *(const f32x4*)p, b = *(const f32x4*)(p + 4); o[0] = a.x; o[1] = a.y; o[2] = a.z; o[3] = a.w; o[4] = b.x; o[5] = b.y; o[6] = b.z; o[7] = b.w; }

constexpr int VP = 168;
__device__ __forceinline__ void attn_unit(const Args& a, LAS unsigned char* lds, int unit, int tid, int wave, int lane) {
    const bf16* proj = (const bf16*)(a.ws + WS_PROJ); bf16* mix = (bf16*)(a.ws + WS_MIX);
    const int qb = unit >> 1, kvh = unit & 1, q0 = qb * 32, kbase = q0 - 128, hq = kvh * 8 + wave;
    LAS bf16* VT = (LAS bf16*)lds;
    const int r = lane & 31, h = lane >> 5;
    bf16x8 bq[4];
    { const bf16* qrow = proj + (size_t)(q0 + r) * NINP + C_AQ + hq * 64 + 8 * h;
#pragma unroll
      for (int s = 0; s < 4; ++s) bq[s] = *(const bf16x8*)(qrow + 16 * s); }
    const float slope = exp2f(-0.5f * (float)(hq + 1)), sink = a.in[13][hq];
    f32x16 sc[5]; float mx = sink;
    bf16x8 kf[5][4];
#pragma unroll
    for (int kt = 0; kt < 5; ++kt) { const int tkb = kbase + 32 * kt;
        if (tkb >= 0) { const bf16* krow = proj + (size_t)(tkb + r) * NINP + C_AK + kvh * 64 + 8 * h;
#pragma unroll
            for (int s = 0; s < 4; ++s) kf[kt][s] = *(const bf16x8*)(krow + 16 * s); } }
    v2u gpre[2][4];
#pragma unroll
    for (int dt = 0; dt < 2; ++dt)
#pragma unroll
        for (int g4 = 0; g4 < 4; ++g4) gpre[dt][g4] = *(const v2u*)(proj + (size_t)(q0 + r) * NINP + C_AG + hq * 64 + 32 * dt + 8 * g4 + 4 * h);
    bar_lds();
    for (int idx = tid; idx < 160 * 8; idx += NTHR) {
        const int key = idx >> 3, d8 = (idx & 7) * 8, tk = kbase + key;
        v4u p = {0u, 0u, 0u, 0u};
        if (tk >= 0) p = ldg16(proj + (size_t)tk * NINP + C_AV + kvh * 64 + d8);
        const unsigned w[4] = {p.x, p.y, p.z, p.w};
#pragma unroll
        for (int j = 0; j < 4; ++j) { VT[(d8 + 2 * j) * VP + key] = (bf16)(w[j] & 0xffffu); VT[(d8 + 2 * j + 1) * VP + key] = (bf16)(w[j] >> 16); }
    }
    bar_lds();
    const float L2E = 1.44269504f, SA = 0.125f * L2E, SB = slope * L2E, sinkl = sink * L2E;
    mx = sinkl;
#pragma unroll
    for (int kt = 0; kt < 5; ++kt) {
        const int tkb = kbase + 32 * kt;
        if (tkb >= 0) {
            f32x16 acc; for (int i = 0; i < 16; ++i) acc[i] = 0.f;
#pragma unroll
            for (int s = 0; s < 4; ++s) acc = MFMA32(kf[kt][s], bq[s], acc);
            const int dli = (q0 + r) - tkb - 4 * h; const float base = -SB * (float)dli;
#pragma unroll
            for (int i = 0; i < 16; ++i) {
                const int ci = (i & 3) + 8 * (i >> 2);
                float v = __builtin_fmaf(acc[i], SA, __builtin_fmaf(SB, (float)ci, base));
                if (kt == 0) v = (dli - ci < 128) ? v : -1e30f;
                if (kt == 4) v = (dli - ci >= 0) ? v : -1e30f;
                sc[kt][i] = v; mx = fmaxf(mx, v);
            }
        } else {
#pragma unroll
            for (int i = 0; i < 16; ++i) sc[kt][i] = -1e30f;
        }
    }
    mx = fmaxf(mx, __shfl_xor(mx, 32));
    float sum = 0.f;
#pragma unroll
    for (int kt = 0; kt < 5; ++kt)
#pragma unroll
        for (int i = 0; i < 16; ++i) { const float p = __builtin_amdgcn_exp2f(sc[kt][i] - mx); sc[kt][i] = p; sum += p; }
    sum += __shfl_xor(sum, 32); sum += __builtin_amdgcn_exp2f(sinkl - mx);
    f32x16 o[2]; for (int i = 0; i < 16; ++i) { o[0][i] = 0.f; o[1][i] = 0.f; }
#pragma unroll
    for (int kt = 0; kt < 5; ++kt) {
        if (kbase + 32 * kt >= 0) {
#pragma unroll
            for (int s = 0; s < 2; ++s) {
                v4u pw; pw.x = pk2(sc[kt][8 * s + 0], sc[kt][8 * s + 1]); pw.y = pk2(sc[kt][8 * s + 2], sc[kt][8 * s + 3]); pw.z = pk2(sc[kt][8 * s + 4], sc[kt][8 * s + 5]); pw.w = pk2(sc[kt][8 * s + 6], sc[kt][8 * s + 7]);
                const bf16x8 pb = __builtin_bit_cast(bf16x8, pw);
#pragma unroll
                for (int dt = 0; dt < 2; ++dt) {
                    const LAS bf16* vp = VT + (32 * dt + r) * VP + 32 * kt + 16 * s + 4 * h;
                    const v2u lo = *(const LAS v2u*)vp, hi = *(const LAS v2u*)(vp + 8);
                    v4u vw; vw.x = lo.x; vw.y = lo.y; vw.z = hi.x; vw.w = hi.y;
                    o[dt] = MFMA32(__builtin_bit_cast(bf16x8, vw), pb, o[dt]);
                }
            }
        }
    }
    const float inv = 1.f / sum;
#pragma unroll
    for (int dt = 0; dt < 2; ++dt)
#pragma unroll
        for (int g4 = 0; g4 < 4; ++g4) {
            const int d0 = 32 * dt + 8 * g4 + 4 * h;
            float g0, g1, g2, g3;
            { const v2u gp = gpre[dt][g4]; g0 = bflo(gp.x); g1 = bfhi(gp.x); g2 = bflo(gp.y); g3 = bfhi(gp.y); }
            v2u w; w.x = pk2(o[dt][4 * g4 + 0] * inv * siluf_(g0), o[dt][4 * g4 + 1] * inv * siluf_(g1));
            w.y = pk2(o[dt][4 * g4 + 2] * inv * siluf_(g2), o[dt][4 * g4 + 3] * inv * siluf_(g3));
            *(v2u*)(mix + (size_t)(q0 + r) * D + RW + hq * 64 + d0) = w;
        }
}

struct Prep { float r[8], kp[8], v[8], g[8], w[8], lw[8], kk[8], b[8], bonus; };
__device__ __forceinline__ void rwkv_prep(const Args& a, LAS unsigned char* lds, int h, int t0, int tid, int wave, int lane, Prep& P) {
    const bf16* proj = (const bf16*)(a.ws + WS_PROJ); const bf16* upt = (const bf16*)(a.ws + WS_UPT); const bf16* aupt = upt + 65536;
    LAS bf16* TW = (LAS bf16*)lds; LAS bf16* ADm = TW + 64 * 72; LAS float* Z = (LAS float*)(lds + 18432); LAS float* AP = Z + 64 * 68;
    const int t = tid >> 3, c8 = (tid & 7) * 8, ch = h * 64 + c8, row = t0 + t;
    const float* mu = a.in[3];
    { float x[8]; load_shift8(proj, row, C_WD + c8, mu, x);
#pragma unroll
      for (int j = 0; j < 8; ++j) x[j] = 1.f - 2.f * __builtin_amdgcn_rcpf(1.f + __expf(2.f * x[j]));
      *(LAS v4u*)(TW + t * 72 + c8) = pack8(x);
      load_shift8(proj, row, C_AD + c8, mu, x); *(LAS v4u*)(ADm + t * 72 + c8) = pack8(x); }
    bar_lds();
    { const int rt = wave & 3, cp = (wave >> 2) * 2, fr = lane & 15, fq = lane >> 4;
      bf16x8 aT[2], aA[2];
#pragma unroll
      for (int s = 0; s < 2; ++s) { aT[s] = *(const LAS bf16x8*)(TW + (16 * rt + fr) * 72 + 32 * s + 8 * fq); aA[s] = *(const LAS bf16x8*)(ADm + (16 * rt + fr) * 72 + 32 * s + 8 * fq); }
#pragma unroll
      for (int ci = 0; ci < 2; ++ci) { const int ct = cp + ci; f32x4 z = {0.f, 0.f, 0.f, 0.f}, ap = {0.f, 0.f, 0.f, 0.f};
#pragma unroll
          for (int s = 0; s < 2; ++s) { const size_t bo = (size_t)(h * 64 + 16 * ct + fr) * 64 + 32 * s + 8 * fq;
              z = MFMA16(aT[s], *(const bf16x8*)(upt + bo), z); ap = MFMA16(aA[s], *(const bf16x8*)(aupt + bo), ap); }
#pragma unroll
          for (int j = 0; j < 4; ++j) { Z[(16 * rt + 4 * fq + j) * 68 + 16 * ct + fr] = z[j]; AP[(16 * rt + 4 * fq + j) * 68 + 16 * ct + fr] = ap[j]; } } }
    bar_lds();
    float zz[8], aa[8], kr[8], c0[8], c1[8];
#pragma unroll
    for (int j = 0; j < 8; ++j) { zz[j] = Z[t * 68 + c8 + j]; aa[j] = AP[t * 68 + c8 + j]; }
    load_shift8(proj, row, C_R + ch, mu, P.r); load_shift8(proj, row, C_K + ch, mu, kr); load_shift8(proj, row, C_V + ch, mu, P.v); load_shift8(proj, row, C_G + ch, mu, P.g);
    ld8f(a.in[4] + ch, c0); ld8f(a.in[6] + ch, c1);
#pragma unroll
    for (int j = 0; j < 8; ++j) { const float z = c0[j] + zz[j]; const float sp = (z < -15.f) ? -z : __logf(1.f + __expf(-z)); const float wl = -sp - 0.5f; P.lw[j] = -__expf(wl); P.w[j] = __expf(P.lw[j]); aa[j] = sigmoidf_(c1[j] + aa[j]); }
    ld8f(a.in[8] + ch, c0); ld8f(a.in[9] + ch, c1);
    float ss = 0.f;
#pragma unroll
    for (int j = 0; j < 8; ++j) { P.kk[j] = kr[j] * c0[j]; ss += P.kk[j] * P.kk[j]; P.kp[j] = kr[j] * (1.f + (aa[j] - 1.f) * c1[j]); }
    ss = sum8(ss); const float rn = 1.f / fmaxf(sqrtf(ss), 1e-12f);
    ld8f(a.in[10] + ch, c0);
    float bs = 0.f;
#pragma unroll
    for (int j = 0; j < 8; ++j) { P.kk[j] *= rn; P.b[j] = P.kk[j] * aa[j]; bs += P.r[j] * P.kp[j] * c0[j]; }
    P.bonus = sum8(bs);
}
__device__ __forceinline__ void rwkv_out8(const Args& a, const float (&y)[8], const float (&v)[8], const float (&g)[8], float bonus, int row, int ch) {
    bf16* mix = (bf16*)(a.ws + WS_MIX);
    float s = 0.f;
#pragma unroll
    for (int j = 0; j < 8; ++j) s += y[j];
    const float mean = sum8(s) * (1.f / 64.f); float q = 0.f;
#pragma unroll
    for (int j = 0; j < 8; ++j) { const float d = y[j] - mean; q += d * d; }
    const float rstd = 1.f / sqrtf(sum8(q) * (1.f / 64.f) + LNX_EPS);
    float lg[8], lb[8], o[8]; ld8f(a.in[11] + ch, lg); ld8f(a.in[12] + ch, lb);
#pragma unroll
    for (int j = 0; j < 8; ++j) { const float yn = (y[j] - mean) * rstd * lg[j] + lb[j] + bonus * v[j]; o[j] = yn * siluf_(g[j]); }
    *(v4u*)(mix + (size_t)row * D + ch) = pack8(o);
}
constexpr size_t WS_MF = 174 * MiB, WS_QF = 190 * MiB, WS_SF = 206 * MiB, WS_BON = 222 * MiB;
constexpr size_t OUT_NF = 0, OUT_Y2 = 32 * MiB;
constexpr int MP = 72;
constexpr int L_AT = 0, L_ATT = 9216, L_BT = 18432, L_KT = 27648, L_RT = 36864, L_BHT = 46080, L_KHT = 55296, L_VT = 64512, L_LW = 73728, L_P = 73728, L_PT = 82944,
              L_AAK = 92160, L_ARB = 101376, L_ARK = 110592, L_TM = 119808, L_SEG = 119808, L_GC = 129024, L_WT = L_AT, L_X1T = L_BT, L_U2T = L_KT;
struct WTile { int ta, tb0, fr, fq; };
__device__ __forceinline__ bf16x8 ldfrag(const LAS bf16* M, int tile, int s, const WTile& w) { return *(const LAS bf16x8*)(M + (16 * tile + w.fr) * MP + 32 * s + 8 * w.fq); }
__device__ __forceinline__ void mm2(const LAS bf16* A, const LAS bf16* B, const WTile& w, f32x4 (&acc)[2]) {
#pragma unroll
    for (int s = 0; s < 2; ++s) { const bf16x8 af = ldfrag(A, w.ta, s, w);
#pragma unroll
        for (int ci = 0; ci < 2; ++ci) acc[ci] = MFMA16(af, ldfrag(B, w.tb0 + ci, s, w), acc[ci]); }
}
__device__ __forceinline__ void st_T(LAS bf16* X, int ta, int tb, const WTile& w, const f32x4& v) { v2u o; o.x = pk2(v[0], v[1]); o.y = pk2(v[2], v[3]); *(LAS v2u*)(X + (16 * tb + w.fr) * MP + 16 * ta + 4 * w.fq) = o; }
__device__ __forceinline__ void st_N(LAS bf16* X, int ta, int tb, const WTile& w, const f32x4& v) {
    const unsigned a = pk2(v[0], v[1]), b = pk2(v[2], v[3]); LAS bf16* p = X + (16 * ta + 4 * w.fq) * MP + 16 * tb + w.fr;
    p[0] = (bf16)(a & 0xffffu); p[MP] = (bf16)(a >> 16); p[2 * MP] = (bf16)(b & 0xffffu); p[3 * MP] = (bf16)(b >> 16);
}
#define ZERO2(x) do { x[0] = (f32x4){0.f, 0.f, 0.f, 0.f}; x[1] = (f32x4){0.f, 0.f, 0.f, 0.f}; } while (0)
template <int MODE> __device__ __forceinline__ void mask2(f32x4 (&acc)[2], const WTile& w) {
#pragma unroll
    for (int ci = 0; ci < 2; ++ci)
#pragma unroll
        for (int j = 0; j < 4; ++j) { const int row = 16 * w.ta + 4 * w.fq + j, col = 16 * (w.tb0 + ci) + w.fr;
            const bool keep = MODE == 0 ? (row < col) : (MODE == 1 ? (row <= col) : (col < row)); if (!keep) acc[ci][j] = 0.f; }
}
__device__ __forceinline__ void st_bf16x8_T2(LAS bf16* X, int c8, int t, int lane, const float (&v)[8]) {
    const v4u p = pack8(v); const unsigned w[4] = {p.x, p.y, p.z, p.w}; const bool odd = (lane >> 3) & 1;
#pragma unroll
    for (int j = 0; j < 4; ++j) {
        const unsigned q = (unsigned)__builtin_amdgcn_update_dpp(0, (int)w[j], 0x128  , 0xf, 0xf, false);
        const unsigned o = odd ? ((q >> 16) | (w[j] & 0xffff0000u)) : ((w[j] & 0xffffu) | (q << 16));
        *(LAS unsigned*)(X + (c8 + 2 * j + (odd ? 1 : 0)) * MP + (t & ~1)) = o;
    }
}
__device__ __forceinline__ void st_bf16x8_T(LAS bf16* X, int c8, int t, const float (&v)[8]) {
    const v4u p = pack8(v); const unsigned w[4] = {p.x, p.y, p.z, p.w};
#pragma unroll
    for (int j = 0; j < 4; ++j) { X[(c8 + 2 * j) * MP + t] = (bf16)(w[j] & 0xffffu); X[(c8 + 2 * j + 1) * MP + t] = (bf16)(w[j] >> 16); }
}

__device__ __forceinline__ void rwkv_chunk_prep(const Args& a, LAS unsigned char* lds, int unit, int tid, int wave, int lane) {
    const int c = unit >> 4, h = unit & 15, t0 = c * CH, t = tid >> 3, c8 = (tid & 7) * 8;
    LAS bf16* At = (LAS bf16*)(lds + L_AT); LAS bf16* AtT = (LAS bf16*)(lds + L_ATT); LAS bf16* Bt = (LAS bf16*)(lds + L_BT); LAS bf16* Kt = (LAS bf16*)(lds + L_KT);
    LAS bf16* Rt = (LAS bf16*)(lds + L_RT); LAS bf16* BhT = (LAS bf16*)(lds + L_BHT); LAS bf16* KhT = (LAS bf16*)(lds + L_KHT); LAS bf16* VT = (LAS bf16*)(lds + L_VT);
    LAS float* LW = (LAS float*)(lds + L_LW); LAS bf16* Pm = (LAS bf16*)(lds + L_P); LAS bf16* PT = (LAS bf16*)(lds + L_PT);
    LAS bf16* AAK = (LAS bf16*)(lds + L_AAK); LAS bf16* ARB = (LAS bf16*)(lds + L_ARB); LAS bf16* ARK = (LAS bf16*)(lds + L_ARK); LAS bf16* TM = (LAS bf16*)(lds + L_TM);
    LAS float* SEG = (LAS float*)(lds + L_SEG); LAS float* GC = (LAS float*)(lds + L_GC);
    LAS bf16* WT = (LAS bf16*)(lds + L_WT); LAS bf16* X1T = (LAS bf16*)(lds + L_X1T); LAS bf16* U2T = (LAS bf16*)(lds + L_U2T);
    bar_lds();
    Prep P; rwkv_prep(a, lds, h, t0, tid, wave, lane, P);
#ifdef PROBE_PREP2
    bar_lds(); rwkv_prep(a, lds, h, t0, tid, wave, lane, P);
#endif
    if ((tid & 7) == 0) ((float*)(a.ws + WS_BON))[(size_t)(t0 + t) * 16 + h] = P.bonus;
#pragma unroll
    for (int j = 0; j < 8; ++j) LW[t * 68 + c8 + j] = P.lw[j];
    bar_lds();
    { const int cc = tid & 63, sg = tid >> 6; float run = 0.f;
#pragma unroll
      for (int i = 0; i < 8; ++i) { run += LW[(8 * sg + i) * 68 + cc]; LW[(8 * sg + i) * 68 + cc] = run; }
      SEG[sg * 64 + cc] = run; }
    bar_lds();
    {
        float Lt[8], LC[8];
#pragma unroll
        for (int j = 0; j < 8; ++j) { float off = 0.f, tot = 0.f;
#pragma unroll
            for (int s = 0; s < 8; ++s) { const float sv = SEG[s * 64 + c8 + j]; tot += sv; if (s < (t >> 3)) off += sv; }
            Lt[j] = LW[t * 68 + c8 + j] + off; LC[j] = tot; }
        if (t == 0) {
#pragma unroll
            for (int j = 0; j < 8; ++j) GC[c8 + j] = __expf(LC[j]); }
        float x[8], y[8];
#pragma unroll
        for (int j = 0; j < 8; ++j) x[j] = -P.kk[j] * __expf(Lt[j] - P.lw[j]);
        *(LAS v4u*)(At + t * MP + c8) = pack8(x); st_bf16x8_T(AtT, c8, t, x);
#pragma unroll
        for (int j = 0; j < 8; ++j) { const float e = __expf(-Lt[j]); x[j] = P.b[j] * e; y[j] = P.kp[j] * e; }
        *(LAS v4u*)(Bt + t * MP + c8) = pack8(x); *(LAS v4u*)(Kt + t * MP + c8) = pack8(y);
#pragma unroll
        for (int j = 0; j < 8; ++j) x[j] = P.r[j] * __expf(Lt[j]);
        *(LAS v4u*)(Rt + t * MP + c8) = pack8(x);
#pragma unroll
        for (int j = 0; j < 8; ++j) { const float e = __expf(LC[j] - Lt[j]); x[j] = P.b[j] * e; y[j] = P.kp[j] * e; }
        st_bf16x8_T(BhT, c8, t, x); st_bf16x8_T(KhT, c8, t, y); st_bf16x8_T(VT, c8, t, P.v);
    }
    bar_lds();
    WTile w; w.ta = wave & 3; w.tb0 = (wave >> 2) * 2; w.fr = lane & 15; w.fq = lane >> 4;
    f32x4 acc[2], Tacc[2];
    ZERO2(Tacc); mm2(At, Bt, w, Tacc); mask2<2>(Tacc, w);
    ZERO2(acc); mm2(Kt, At, w, acc); mask2<0>(acc, w);
    f32x4 rb[2], rk[2]; ZERO2(rb); mm2(Bt, Rt, w, rb); mask2<1>(rb, w); ZERO2(rk); mm2(Kt, Rt, w, rk); mask2<1>(rk, w);
    bar_lds();
#pragma unroll
    for (int ci = 0; ci < 2; ++ci) { st_N(Pm, w.ta, w.tb0 + ci, w, Tacc[ci]); st_T(PT, w.ta, w.tb0 + ci, w, Tacc[ci]);
        st_T(AAK, w.ta, w.tb0 + ci, w, acc[ci]); st_T(ARB, w.ta, w.tb0 + ci, w, rb[ci]); st_T(ARK, w.ta, w.tb0 + ci, w, rk[ci]);
#pragma unroll
        for (int j = 0; j < 4; ++j) if (16 * w.ta + 4 * w.fq + j == 16 * (w.tb0 + ci) + w.fr) Tacc[ci][j] += 1.f;
        st_N(TM, w.ta, w.tb0 + ci, w, Tacc[ci]); }
    bar_lds();
#pragma unroll 1
#ifdef PROBE_NEU2
    for (int n = 0; n < 10; ++n) {
#else
    for (int n = 0; n < 5; ++n) {
#endif
        ZERO2(acc); mm2(Pm, PT, w, acc);
        bar_lds();
#pragma unroll
        for (int ci = 0; ci < 2; ++ci) { st_N(Pm, w.ta, w.tb0 + ci, w, acc[ci]); st_T(PT, w.ta, w.tb0 + ci, w, acc[ci]); }
        bar_lds();
        mm2(TM, PT, w, Tacc);
        bar_lds();
#pragma unroll
        for (int ci = 0; ci < 2; ++ci) st_N(TM, w.ta, w.tb0 + ci, w, Tacc[ci]);
        bar_lds();
    }
    ZERO2(acc); mm2(TM, AtT, w, acc); ZERO2(rb); mm2(AAK, VT, w, rb);
#pragma unroll
    for (int ci = 0; ci < 2; ++ci) { st_T(WT, w.ta, w.tb0 + ci, w, acc[ci]); st_T(X1T, w.ta, w.tb0 + ci, w, rb[ci]); }
    bar_lds();
    const size_t ub = (size_t)unit * 4096;
    { ZERO2(acc); mm2(TM, X1T, w, acc);
#pragma unroll
      for (int ci = 0; ci < 2; ++ci) st_T(U2T, w.ta, w.tb0 + ci, w, acc[ci]);
      bf16* MF = (bf16*)(a.ws + WS_MF) + ub; bf16* QF = (bf16*)(a.ws + WS_QF) + ub;
      ZERO2(acc); mm2(WT, BhT, w, acc);
      ZERO2(rb); mm2(WT, ARB, w, rb);
#pragma unroll
      for (int ci = 0; ci < 2; ++ci) { const int tb = w.tb0 + ci; const int col = 16 * tb + w.fr; const float gc = GC[col];
          f32x4 m = acc[ci];
#pragma unroll
          for (int j = 0; j < 4; ++j) if (16 * w.ta + 4 * w.fq + j == col) m[j] += gc;
          const size_t fo = (size_t)((tb * 2 + (w.ta >> 1)) * 64 + lane) * 8 + 4 * (w.ta & 1);
          v2u o; o.x = pk2(m[0], m[1]); o.y = pk2(m[2], m[3]); *(v2u*)(MF + fo) = o;
          const v2u rr = *(const LAS v2u*)(Rt + col * MP + 16 * w.ta + 4 * w.fq);
          f32x4 q = rb[ci]; q[0] += bflo(rr.x); q[1] += bfhi(rr.x); q[2] += bflo(rr.y); q[3] += bfhi(rr.y);
          o.x = pk2(q[0], q[1]); o.y = pk2(q[2], q[3]); *(v2u*)(QF + fo) = o; } }
    bar_lds();
    { float* NF = (float*)((unsigned char*)a.out + OUT_NF) + ub; float* Y2 = (float*)((unsigned char*)a.out + OUT_Y2) + ub;
      ZERO2(acc); mm2(BhT, U2T, w, acc); mm2(KhT, VT, w, acc);
      ZERO2(rb); mm2(U2T, ARB, w, rb); mm2(VT, ARK, w, rb);
#pragma unroll
      for (int ci = 0; ci < 2; ++ci) { const int tb = w.tb0 + ci;
          *(f32x4*)(NF + (size_t)((tb * 4 + w.ta) * 64 + lane) * 4) = acc[ci];
          *(f32x4*)(Y2 + (size_t)(16 * tb + w.fr) * 64 + 16 * w.ta + 4 * w.fq) = rb[ci]; } }
}

#ifndef HSPLIT_V
#define HSPLIT_V 64
#endif
constexpr int HSPLIT = HSPLIT_V;
constexpr int KR = 4, NR = NCH / KR, SLOT = 10240, RBUF = KR * SLOT, NPIECE = RBUF / 16, LPT = 6, PPC = SLOT / 16;
__device__ __forceinline__ const v4u* sp_src(const Args& a, int h, int cg, int r, int p) {
    const int cc = p / PPC, q = p % PPC, c = r * KR + cc; const size_t ub = (size_t)(c * 16 + h) * 4096;
    return q < 512 ? (const v4u*)((const bf16*)(a.ws + WS_MF) + ub) + q : (const v4u*)((const bf16*)((const unsigned char*)a.out + OUT_NF) + ub + cg * 1024) + (q - 512);
}
__device__ __forceinline__ void state_pass(const Args& a, LAS unsigned char* lds, int b, int tid, int wave, int lane) {
    unsigned* half_flag = (unsigned*)a.ws + 7168;
    const int h = b & 15, cg = b >> 4, lt = tid - 64;
    v4u ra[LPT], rb[LPT];
    if (wave != 0) {
#pragma unroll
        for (int i = 0; i < LPT; ++i) { const int p = lt + 448 * i; if (p < NPIECE) ra[i] = *sp_src(a, h, cg, 0, p); }
#pragma unroll
        for (int i = 0; i < LPT; ++i) { const int p = lt + 448 * i; if (p < NPIECE) *(LAS v4u*)(lds + p * 16) = ra[i]; }
#pragma unroll
        for (int i = 0; i < LPT; ++i) { const int p = lt + 448 * i; if (p < NPIECE) ra[i] = *sp_src(a, h, cg, 1, p); }
    }
    f32x4 st[4];
#pragma unroll
    for (int i = 0; i < 4; ++i) st[i] = (f32x4){0.f, 0.f, 0.f, 0.f};
    bar_lds();
    bf16* SF = (bf16*)(a.ws + WS_SF);
#define SP_ROUND(r_, RA, RB) do { \
        if (wave != 0) { \
            if ((r_) + 2 < NR) { _Pragma("unroll") for (int i = 0; i < LPT; ++i) { const int p = lt + 448 * i; if (p < NPIECE) RB[i] = *sp_src(a, h, cg, (r_) + 2, p); } } \
            if ((r_) + 1 < NR) { _Pragma("unroll") for (int i = 0; i < LPT; ++i) { const int p = lt + 448 * i; if (p < NPIECE) *(LAS v4u*)(lds + (((r_) + 1) & 1) * RBUF + p * 16) = RA[i]; } } \
        } else { \
            if ((r_) == HSPLIT / KR && lane == 0) { __threadfence(); __hip_atomic_fetch_add(half_flag, 1u, __ATOMIC_RELEASE, __HIP_MEMORY_SCOPE_AGENT); }     \
            _Pragma("unroll") for (int cc = 0; cc < KR; ++cc) { \
                const LAS unsigned char* sl = lds + ((r_) & 1) * RBUF + cc * SLOT; const int c = (r_) * KR + cc; \
                v4u b0, b1; b0.x = pk2(st[0][0], st[0][1]); b0.y = pk2(st[0][2], st[0][3]); b0.z = pk2(st[1][0], st[1][1]); b0.w = pk2(st[1][2], st[1][3]); \
                b1.x = pk2(st[2][0], st[2][1]); b1.y = pk2(st[2][2], st[2][3]); b1.z = pk2(st[3][0], st[3][1]); b1.w = pk2(st[3][2], st[3][3]); \
                v4u* sfo = (v4u*)(SF + (size_t)(c * 16 + h) * 4096) + (cg * 2) * 64 + lane; sfo[0] = b0; sfo[64] = b1; \
                const bf16x8 f0 = __builtin_bit_cast(bf16x8, b0), f1 = __builtin_bit_cast(bf16x8, b1); \
                _Pragma("unroll") for (int rt = 0; rt < 4; ++rt) { \
                    const v2u nb_ = *(const LAS v2u*)(sl + 8192 + (rt * 64 + lane) * 8); f32x4 n = {bflo(nb_.x), bfhi(nb_.x), bflo(nb_.y), bfhi(nb_.y)}; \
                    n = MFMA16(*(const LAS bf16x8*)(sl + ((rt * 2 + 0) * 64 + lane) * 16), f0, n); \
                    n = MFMA16(*(const LAS bf16x8*)(sl + ((rt * 2 + 1) * 64 + lane) * 16), f1, n); st[rt] = n; } \
            } \
        } \
        bar_lds(); } while (0)
#pragma unroll 1
    for (int r = 0; r < NR; r += 2) { SP_ROUND(r, ra, rb); SP_ROUND(r + 1, rb, ra); }
#undef SP_ROUND
}

__device__ __forceinline__ void rwkv_out_unit(const Args& a, LAS unsigned char* lds, int unit, int tid, int wave, int lane) {
    const int c = unit >> 4, h = unit & 15, t0 = c * CH, t = tid >> 3, c8 = (tid & 7) * 8, ch = h * 64 + c8;
    const size_t ub = (size_t)unit * 4096;
    const bf16* QF = (const bf16*)(a.ws + WS_QF) + ub; const bf16* SF = (const bf16*)(a.ws + WS_SF) + ub; const bf16* Y2 = (const bf16*)((const unsigned char*)a.out + OUT_Y2) + ub;
    LAS float* SY = (LAS float*)lds;
    const int ta = wave & 3, tb0 = (wave >> 2) * 2, fr = lane & 15, fq = lane >> 4;
    bf16x8 af[2], bfr[2][2];
#pragma unroll
    for (int s = 0; s < 2; ++s) { af[s] = *(const bf16x8*)(QF + (size_t)((ta * 2 + s) * 64 + lane) * 8);
#pragma unroll
        for (int ci = 0; ci < 2; ++ci) bfr[s][ci] = *(const bf16x8*)(SF + (size_t)(((tb0 + ci) * 2 + s) * 64 + lane) * 8); }
    float y2[8], v[8], g[8];
    unpack8(ldg16(Y2 + t * 64 + c8), y2);
    const bf16* proj = (const bf16*)(a.ws + WS_PROJ);
    load_shift8(proj, t0 + t, C_V + ch, a.in[3], v); load_shift8(proj, t0 + t, C_G + ch, a.in[3], g);
    const float bonus = ((const float*)(a.ws + WS_BON))[(size_t)(t0 + t) * 16 + h];
    f32x4 acc[2]; ZERO2(acc);
#pragma unroll
    for (int s = 0; s < 2; ++s)
#pragma unroll
        for (int ci = 0; ci < 2; ++ci) acc[ci] = MFMA16(af[s], bfr[s][ci], acc[ci]);
    bar_lds();
#pragma unroll
    for (int ci = 0; ci < 2; ++ci)
#pragma unroll
        for (int j = 0; j < 4; ++j) SY[(16 * ta + 4 * fq + j) * 68 + 16 * (tb0 + ci) + fr] = acc[ci][j];
    bar_lds();
    float y[8];
#pragma unroll
    for (int j = 0; j < 8; ++j) y[j] = SY[t * 68 + c8 + j] + y2[j];
    rwkv_out8(a, y, v, g, bonus, t0 + t, ch);
}
constexpr int L2_SEG = 129280, L2_XST = 131328, L2_TW = 131584, L2_ADM = 140800, L2_X1T = 150016;
struct PF { v4u p[4], q[4]; };
__device__ __forceinline__ void pf_issue(PF& f, const bf16* proj, int row, int ch) {
    const int cols[4] = {C_R, C_K, C_V, C_G};
#pragma unroll
    for (int i = 0; i < 4; ++i) { f.p[i] = ldg16(proj + (size_t)row * NINP + cols[i] + ch); f.q[i] = (v4u){0u, 0u, 0u, 0u}; if (row > 0) f.q[i] = ldg16(proj + (size_t)(row - 1) * NINP + cols[i] + ch); }
}
__device__ __forceinline__ void pf_shift(const v4u& p, const v4u& q, const float (&mf)[8], float (&o)[8]) {
    float pf[8], qf[8]; unpack8(p, pf); unpack8(q, qf);
#pragma unroll
    for (int j = 0; j < 8; ++j) o[j] = pf[j] + (qf[j] - pf[j]) * mf[j];
}
template <bool DOP, bool DOT, bool CHK = false> __device__ __forceinline__ void neu_stage(const LAS bf16* Pin, const LAS bf16* PTin, LAS bf16* Pout, LAS bf16* PTout, const LAS bf16* TMin, LAS bf16* TMout, const WTile& w, f32x4 (&Tacc)[2], LAS unsigned* flag = nullptr) {
    f32x4 acc[2];
    if (DOP) { ZERO2(acc); mm2(Pin, PTin, w, acc); }
    if (DOP && CHK) {
        float m = 0.f;
#pragma unroll
        for (int ci = 0; ci < 2; ++ci)
#pragma unroll
            for (int j = 0; j < 4; ++j) m = fmaxf(m, fabsf(acc[ci][j]));
        if (m > 5e-4f) atomicMax((unsigned*)flag, __float_as_uint(m));
    }
    if (DOT) mm2(TMin, PTin, w, Tacc);
#pragma unroll
    for (int ci = 0; ci < 2; ++ci) {
        if (DOP) { st_N(Pout, w.ta, w.tb0 + ci, w, acc[ci]); st_T(PTout, w.ta, w.tb0 + ci, w, acc[ci]); }
        if (DOT) st_N(TMout, w.ta, w.tb0 + ci, w, Tacc[ci]);
    }
    bar_lds();
}
__device__ __forceinline__ void rwkv_chunk_group(const Args& a, LAS unsigned char* lds, int item, int tid, int wave, int lane) {
    const int c = item >> 1, hg = item & 1, t0 = c * CH, t = tid >> 3, c8 = (tid & 7) * 8, row = t0 + t;
    const bf16* proj = (const bf16*)(a.ws + WS_PROJ); const bf16* upt = (const bf16*)(a.ws + WS_UPT); const bf16* aupt = upt + 65536; const float* mu = a.in[3];
    LAS bf16* TW = (LAS bf16*)(lds + L2_TW); LAS bf16* ADm = (LAS bf16*)(lds + L2_ADM);
    WTile w; w.ta = wave & 3; w.tb0 = (wave >> 2) * 2; w.fr = lane & 15; w.fq = lane >> 4;
    bar_lds();
    { float x[8]; load_shift8(proj, row, C_WD + c8, mu, x);
#pragma unroll
      for (int j = 0; j < 8; ++j) x[j] = 1.f - 2.f * __builtin_amdgcn_rcpf(1.f + __expf(2.f * x[j]));
      *(LAS v4u*)(TW + t * 72 + c8) = pack8(x);
      load_shift8(proj, row, C_AD + c8, mu, x); *(LAS v4u*)(ADm + t * 72 + c8) = pack8(x); }
    PF pf; pf_issue(pf, proj, row, hg * 512 + c8);
#pragma unroll 1
    for (int hh = 0; hh < 8; ++hh) {
        const int h = hg * 8 + hh, ch = h * 64 + c8, unit = c * 16 + h;
        LAS unsigned char* L = lds; asm volatile("" : "+v"(L));
        LAS bf16* At = (LAS bf16*)(L + L_AT); LAS bf16* AtT = (LAS bf16*)(L + L_ATT); LAS bf16* Bt = (LAS bf16*)(L + L_BT); LAS bf16* Kt = (LAS bf16*)(L + L_KT);
        LAS bf16* Rt = (LAS bf16*)(L + L_RT); LAS bf16* BhT = (LAS bf16*)(L + L_BHT); LAS bf16* KhT = (LAS bf16*)(L + L_KHT); LAS bf16* VT = (LAS bf16*)(L + L_VT);
        LAS bf16* P0 = (LAS bf16*)(L + L_P); LAS bf16* PT0 = (LAS bf16*)(L + L_PT); LAS bf16* TM0 = (LAS bf16*)(L + L_TM);
        LAS bf16* P1 = At; LAS bf16* PT1 = Bt; LAS bf16* TM1 = Kt;
        LAS bf16* AAK = (LAS bf16*)(L + L_AAK); LAS bf16* ARB = (LAS bf16*)(L + L_ARB); LAS bf16* ARK = (LAS bf16*)(L + L_ARK);
        LAS float* SEG = (LAS float*)(L + L2_SEG); LAS float* GC = (LAS float*)(L + L_GC);
        LAS bf16* X1T = (LAS bf16*)(L + L2_X1T);
        LAS float* Z = (LAS float*)(L + 18432); LAS float* AP = Z + 64 * 68;
        LAS bf16* WT = At; LAS bf16* U2T = Bt; LAS unsigned* NFLAG = (LAS unsigned*)(L + 159232);
        bf16x8 bU[2][2], bA[2][2];
#pragma unroll
        for (int ci = 0; ci < 2; ++ci)
#pragma unroll
            for (int s = 0; s < 2; ++s) { const size_t bo = (size_t)(h * 64 + 16 * (w.tb0 + ci) + w.fr) * 64 + 32 * s + 8 * w.fq; bU[ci][s] = *(const bf16x8*)(upt + bo); bA[ci][s] = *(const bf16x8*)(aupt + bo); }
        float pw0[8], pa0[8], pkk[8], pka[8], prk[8], mur[8], muk[8], muv[8];
        ld8f(a.in[4] + ch, pw0); ld8f(a.in[6] + ch, pa0); ld8f(a.in[8] + ch, pkk); ld8f(a.in[9] + ch, pka); ld8f(a.in[10] + ch, prk);
        ld8f(mu + C_R + ch, mur); ld8f(mu + C_K + ch, muk); ld8f(mu + C_V + ch, muv);
        bar_lds();
#ifdef PROBE_G
        if (blockIdx.x == 0 && tid == 0 && hh == 3) ((unsigned long long*)(a.ws + 65536))[0] = __builtin_amdgcn_s_memrealtime();
#endif

        { const int rt = w.ta, cp = w.tb0, fr = w.fr, fq = w.fq;
          bf16x8 aT[2], aA[2];
#pragma unroll
          for (int s = 0; s < 2; ++s) { aT[s] = *(const LAS bf16x8*)(TW + (16 * rt + fr) * 72 + 32 * s + 8 * fq); aA[s] = *(const LAS bf16x8*)(ADm + (16 * rt + fr) * 72 + 32 * s + 8 * fq); }
#pragma unroll
          for (int ci = 0; ci < 2; ++ci) { const int ct = cp + ci; f32x4 z = {0.f, 0.f, 0.f, 0.f}, ap = {0.f, 0.f, 0.f, 0.f};
#pragma unroll
              for (int s = 0; s < 2; ++s) { z = MFMA16(aT[s], bU[ci][s], z); ap = MFMA16(aA[s], bA[ci][s], ap); }
#pragma unroll
              for (int j = 0; j < 4; ++j) { Z[(16 * rt + 4 * fq + j) * 68 + 16 * ct + fr] = z[j]; AP[(16 * rt + 4 * fq + j) * 68 + 16 * ct + fr] = ap[j]; } } }
        bar_lds();
#ifdef PROBE_G
        if (blockIdx.x == 0 && tid == 0 && hh == 3) ((unsigned long long*)(a.ws + 65536))[1] = __builtin_amdgcn_s_memrealtime();
#endif
        float r[8], kp[8], vv[8], lw[8], kk[8], bb[8];
        { float zz[8], aa[8], kr[8];
#pragma unroll
          for (int j = 0; j < 8; ++j) { zz[j] = Z[t * 68 + c8 + j]; aa[j] = AP[t * 68 + c8 + j]; }
          pf_shift(pf.p[0], pf.q[0], mur, r); pf_shift(pf.p[1], pf.q[1], muk, kr); pf_shift(pf.p[2], pf.q[2], muv, vv);
#pragma unroll
          for (int j = 0; j < 8; ++j) { const float z = pw0[j] + zz[j]; lw[j] = -0.60653066f * __builtin_amdgcn_rcpf(1.f + __expf(-z)); aa[j] = sigmoidf_(pa0[j] + aa[j]); }
          float ss = 0.f;
#pragma unroll
          for (int j = 0; j < 8; ++j) { kk[j] = kr[j] * pkk[j]; ss += kk[j] * kk[j]; kp[j] = kr[j] * (1.f + (aa[j] - 1.f) * pka[j]); }
          ss = sum8(ss); const float rn = 1.f / fmaxf(sqrtf(ss), 1e-12f);
          float bs = 0.f;
#pragma unroll
          for (int j = 0; j < 8; ++j) { kk[j] *= rn; bb[j] = kk[j] * aa[j]; bs += r[j] * kp[j] * prk[j]; }
          bs = sum8(bs);
          if ((tid & 7) == 0) ((float*)(a.ws + WS_BON))[(size_t)row * 16 + h] = bs; }
        if (hh < 7) pf_issue(pf, proj, row, ch + 64);
        float Lt[8];
#pragma unroll
        for (int j = 0; j < 8; ++j) { float x = lw[j];
#pragma unroll
            for (int d = 8; d < 64; d <<= 1) { const float y = __shfl_up(x, d); if (lane >= d) x += y; }
            Lt[j] = x; }
        if ((lane >> 3) == 7) {
#pragma unroll
            for (int j = 0; j < 8; ++j) SEG[wave * 64 + c8 + j] = Lt[j]; }
        bar_lds();
        {
            float gc[8], x[8], y[8];
            { float off[8], tot[8];
#pragma unroll
              for (int j = 0; j < 8; ++j) { off[j] = 0.f; tot[j] = 0.f; }
#pragma unroll
              for (int s = 0; s < 8; ++s) { const f32x4 s0 = *(const LAS f32x4*)(SEG + s * 64 + c8), s1 = *(const LAS f32x4*)(SEG + s * 64 + c8 + 4);
                  const float sv[8] = {s0.x, s0.y, s0.z, s0.w, s1.x, s1.y, s1.z, s1.w};
#pragma unroll
                  for (int j = 0; j < 8; ++j) { tot[j] += sv[j]; if (s < wave) off[j] += sv[j]; } }
#pragma unroll
              for (int j = 0; j < 8; ++j) { Lt[j] += off[j]; gc[j] = __expf(tot[j]); } }
            if (t == 0) {
#pragma unroll
                for (int j = 0; j < 8; ++j) GC[c8 + j] = gc[j]; }
            float e1[8], ie1[8];
#pragma unroll
            for (int j = 0; j < 8; ++j) { e1[j] = __expf(Lt[j]); ie1[j] = __builtin_amdgcn_rcpf(e1[j]); }
#pragma unroll
            for (int j = 0; j < 8; ++j) x[j] = -kk[j] * __expf(Lt[j] - lw[j]);
            *(LAS v4u*)(At + t * MP + c8) = pack8(x); st_bf16x8_T2(AtT, c8, t, lane, x);
#pragma unroll
            for (int j = 0; j < 8; ++j) { x[j] = bb[j] * ie1[j]; y[j] = kp[j] * ie1[j]; }
            *(LAS v4u*)(Bt + t * MP + c8) = pack8(x); *(LAS v4u*)(Kt + t * MP + c8) = pack8(y);
#pragma unroll
            for (int j = 0; j < 8; ++j) x[j] = r[j] * e1[j];
            *(LAS v4u*)(Rt + t * MP + c8) = pack8(x);
#pragma unroll
            for (int j = 0; j < 8; ++j) { const float e = gc[j] * ie1[j]; x[j] = bb[j] * e; y[j] = kp[j] * e; }
            st_bf16x8_T2(BhT, c8, t, lane, x); st_bf16x8_T2(KhT, c8, t, lane, y); st_bf16x8_T2(VT, c8, t, lane, vv);
        }
        bar_lds();
#ifdef PROBE_G
        if (blockIdx.x == 0 && tid == 0 && hh == 3) ((unsigned long long*)(a.ws + 65536))[2] = __builtin_amdgcn_s_memrealtime();
#endif
        f32x4 acc[2], Tacc[2], rb[2], rk[2];
        ZERO2(Tacc); mm2(At, Bt, w, Tacc); mask2<2>(Tacc, w);
        ZERO2(acc); mm2(Kt, At, w, acc); mask2<0>(acc, w);
        ZERO2(rb); mm2(Bt, Rt, w, rb); mask2<1>(rb, w); ZERO2(rk); mm2(Kt, Rt, w, rk); mask2<1>(rk, w);
        bar_lds();
#pragma unroll
        for (int ci = 0; ci < 2; ++ci) { st_N(P1, w.ta, w.tb0 + ci, w, Tacc[ci]); st_T(PT1, w.ta, w.tb0 + ci, w, Tacc[ci]);
            st_T(AAK, w.ta, w.tb0 + ci, w, acc[ci]); st_T(ARB, w.ta, w.tb0 + ci, w, rb[ci]); st_T(ARK, w.ta, w.tb0 + ci, w, rk[ci]);
#pragma unroll
            for (int j = 0; j < 4; ++j) if (16 * w.ta + 4 * w.fq + j == 16 * (w.tb0 + ci) + w.fr) Tacc[ci][j] += 1.f;
            st_N(TM1, w.ta, w.tb0 + ci, w, Tacc[ci]); }
        if (tid == 0) *NFLAG = 0u;
        bar_lds();
#ifdef PROBE_G
        if (blockIdx.x == 0 && tid == 0 && hh == 3) ((unsigned long long*)(a.ws + 65536))[3] = __builtin_amdgcn_s_memrealtime();
#endif
        { ZERO2(acc); mm2(AAK, VT, w, acc);
#pragma unroll
          for (int ci = 0; ci < 2; ++ci) st_T(X1T, w.ta, w.tb0 + ci, w, acc[ci]); }
        neu_stage<true, false>(P1, PT1, P0, PT0, nullptr, nullptr, w, Tacc);
        int nrep = 1; asm volatile("" : "+s"(nrep));
#pragma unroll 1
        for (int n = 0; n < nrep; ++n) {
            neu_stage<true, true>(P0, PT0, P1, PT1, TM1, TM0, w, Tacc);
            neu_stage<true, true, true>(P1, PT1, P0, PT0, TM0, TM1, w, Tacc, NFLAG);
        }
        if (*NFLAG != 0u) {
            neu_stage<true, true>(P0, PT0, P1, PT1, TM1, TM0, w, Tacc);
            neu_stage<true, true>(P1, PT1, P0, PT0, TM0, TM1, w, Tacc);
        }
        neu_stage<false, true>(P0, PT0, nullptr, nullptr, TM1, TM0, w, Tacc);

#ifdef PROBE_G
        if (blockIdx.x == 0 && tid == 0 && hh == 3) ((unsigned long long*)(a.ws + 65536))[4] = __builtin_amdgcn_s_memrealtime();
#endif
        ZERO2(acc); mm2(TM0, AtT, w, acc); ZERO2(rb); mm2(TM0, X1T, w, rb);
#pragma unroll
        for (int ci = 0; ci < 2; ++ci) { st_T(WT, w.ta, w.tb0 + ci, w, acc[ci]); st_T(U2T, w.ta, w.tb0 + ci, w, rb[ci]); }
        bar_lds();
        const size_t ub = (size_t)unit * 4096;
        { bf16* MF = (bf16*)(a.ws + WS_MF) + ub; bf16* QF = (bf16*)(a.ws + WS_QF) + ub;
          ZERO2(acc); mm2(WT, BhT, w, acc); ZERO2(rb); mm2(WT, ARB, w, rb);
#pragma unroll
          for (int ci = 0; ci < 2; ++ci) { const int tb = w.tb0 + ci; const int col = 16 * tb + w.fr; const float gcv = GC[col];
              f32x4 m = acc[ci];
#pragma unroll
              for (int j = 0; j < 4; ++j) if (16 * w.ta + 4 * w.fq + j == col) m[j] += gcv;
              const size_t fo = (size_t)((tb * 2 + (w.ta >> 1)) * 64 + lane) * 8 + 4 * (w.ta & 1);
              v2u o; o.x = pk2(m[0], m[1]); o.y = pk2(m[2], m[3]); *(v2u*)(MF + fo) = o;
              const v2u rr = *(const LAS v2u*)(Rt + col * MP + 16 * w.ta + 4 * w.fq);
              f32x4 q = rb[ci]; q[0] += bflo(rr.x); q[1] += bfhi(rr.x); q[2] += bflo(rr.y); q[3] += bfhi(rr.y);
              o.x = pk2(q[0], q[1]); o.y = pk2(q[2], q[3]); *(v2u*)(QF + fo) = o; }
          bf16* NF = (bf16*)((unsigned char*)a.out + OUT_NF) + ub; bf16* Y2 = (bf16*)((unsigned char*)a.out + OUT_Y2) + ub;
          ZERO2(acc); mm2(BhT, U2T, w, acc); mm2(KhT, VT, w, acc);
          ZERO2(rb); mm2(U2T, ARB, w, rb); mm2(VT, ARK, w, rb);
#pragma unroll
          for (int ci = 0; ci < 2; ++ci) { const int tb = w.tb0 + ci;
              v2u o; o.x = pk2(acc[ci][0], acc[ci][1]); o.y = pk2(acc[ci][2], acc[ci][3]); *(v2u*)(NF + (size_t)((tb * 4 + w.ta) * 64 + lane) * 4) = o;
              o.x = pk2(rb[ci][0], rb[ci][1]); o.y = pk2(rb[ci][2], rb[ci][3]); *(v2u*)(Y2 + (size_t)(16 * tb + w.fr) * 64 + 16 * w.ta + 4 * w.fq) = o; } }

#ifdef PROBE_G
        if (blockIdx.x == 0 && tid == 0 && hh == 3) ((unsigned long long*)(a.ws + 65536))[5] = __builtin_amdgcn_s_memrealtime();
#endif
    }
}
#ifndef HOSTDUP
#define HOSTDUP -1
#endif
#ifndef ONE_LAUNCH
#define ONE_LAUNCH 1
#endif
#if HOSTDUP != -1 || defined(MULTI)
#undef ONE_LAUNCH
#define ONE_LAUNCH 0
#endif
constexpr int NPHASE = 7;
__global__ void __launch_bounds__(NTHR, 2) mega(Args a) {
    extern __shared__ __attribute__((aligned(16))) unsigned char lds_[];
    LAS unsigned char* lds = (LAS unsigned char*)lds_;
    const int tid = threadIdx.x, lane = tid & 63, wave = __builtin_amdgcn_readfirstlane(tid >> 6);
    const int G = gridDim.x, bx = blockIdx.x, vcu = (G % 8 == 0) ? (bx % 8) * (G / 8) + bx / 8 : bx;
    cg::grid_group grid = cg::this_grid();
    volatile LAS unsigned* xst = (volatile LAS unsigned*)(lds + L2_XST);
    if (tid < 2) xst[tid] = 0u;
    __syncthreads();
    XcdBarrier xbar; xbar.bar = (unsigned*)a.ws; xbar.x = 0; xbar.st = xst;
    if (a.ph_hi - a.ph_lo > 1) xbar = xcd_barrier_post((unsigned*)a.ws, xst);
#ifndef PROBE_Q
#define PROBE_Q 1
#endif
#ifdef PROBE_TS
    unsigned long long ts_[10];
#define STAMP(i) do { ts_[i] = __builtin_amdgcn_s_memrealtime(); } while (0)
#else
#define STAMP(i) do {} while (0)
#endif
    STAMP(0);
#define IN(k) (a.ph_lo <= (k) && (k) < a.ph_hi)
#define SEAM(k) do { if (IN(k) && IN((k) + 1)) xcd_barrier(xbar); } while (0)
    if (a.ph_lo < 0) grid.sync();
    if (IN(0)) { p0_prologue(a, lds, vcu, G, wave, lane); }
    SEAM(0); STAMP(1);
    if (IN(1)) {
        constexpr int N1 = 6144;
        pg8::Gemm g{(const pg8::bf16_t*)(a.ws + WS_XN), (const pg8::bf16_t*)(a.ws + WS_WTIN), T, (G == 256 ? N1 : NINP), D}; pg8::StaticOrder S; S.init(T, (G == 256 ? N1 : NINP), G, bx);
        pg8::EpiBf16<0> E{(pg8::bf16_t*)(a.ws + WS_PROJ), NINP, nullptr, 0, 0, 1.f};
        pg8::gemm_phase<pg8::EpiBf16<0>, pg8::StaticOrder, true, true>(lds, g, S, E);
    }
    SEAM(1); STAMP(2);
    if (IN(2)) {
        for (int it = bx; it < NCH * 2; it += G) rwkv_chunk_group(a, lds, it, tid, wave, lane);
    }
    SEAM(2); STAMP(3);
    if (IN(3)) {
        if (bx < 64) state_pass(a, lds, bx, tid, wave, lane);
        else if (G == 256 && bx < 128) {
            pg8::Gemm g{(const pg8::bf16_t*)(a.ws + WS_XN), (const pg8::bf16_t*)(a.ws + WS_WTIN), T, NINP, D}; pg8::OneTile S{(bx - 64) >> 1, 24 + ((bx - 64) & 1)};
            pg8::EpiBf16<0> E{(pg8::bf16_t*)(a.ws + WS_PROJ), NINP, nullptr, 0, 0, 1.f};
            pg8::gemm_phase<pg8::EpiBf16<0>, pg8::OneTile, true, true>(lds, g, S, E);
        } else if (G == 256) {
            for (int it = bx - 128; it < 256; it += 128) attn_unit(a, lds, 2 * it, tid, wave, lane);
            __syncthreads();
            if (tid == 0) { unsigned* hf = (unsigned*)a.ws + 7168; unsigned spins = 0;
                while (__hip_atomic_load(hf, __ATOMIC_RELAXED, __HIP_MEMORY_SCOPE_AGENT) < 64u) { __builtin_amdgcn_s_sleep(4); if (++spins > (1u << 22)) break; }
                __builtin_amdgcn_fence(__ATOMIC_ACQUIRE, "agent"); }
            __syncthreads();
            for (int u = bx - 128; u < HSPLIT * NH; u += 128) rwkv_out_unit(a, lds, u, tid, wave, lane);
        }
    }
    SEAM(3); STAMP(4);
    if (IN(4)) {
        if (G == 256) { for (int it = bx; it < 256; it += G) attn_unit(a, lds, 2 * it + 1, tid, wave, lane); }
        else { for (int it = bx; it < 512; it += G) attn_unit(a, lds, it, tid, wave, lane); }
        STAMP(8);
        for (int u = (G == 256 ? HSPLIT * NH : 0) + bx; u < NCH * NH; u += G) rwkv_out_unit(a, lds, u, tid, wave, lane);
    }
    SEAM(4); STAMP(5);
    if (IN(5)) {
        pg8::Gemm g{(const pg8::bf16_t*)(a.ws + WS_MIX), (const pg8::bf16_t*)(a.ws + WS_WTOUT), T, D, D}; pg8::StaticOrder S; S.init(T, D, G, bx);
        if (G == 256 && a.ph_hi - a.ph_lo > 1) {
            pg8::EpiResidNorm E{a.in[0], a.out, (float*)(a.ws + WS_SSP), (unsigned*)a.ws + 4096, a.in[15], D, RMS_EPS};
            pg8::gemm_phase<pg8::EpiResidNorm, pg8::StaticOrder, false, true>(lds, g, S, E);
        } else {
            pg8::EpiResid E{a.in[0], a.out, (float*)(a.ws + WS_SSP), D};
            pg8::gemm_phase<pg8::EpiResid, pg8::StaticOrder, true, true>(lds, g, S, E);
        }
    }
    if (!(G == 256 && a.ph_hi - a.ph_lo > 1)) { SEAM(5); } STAMP(6);
    if (IN(6) && !(G == 256 && a.ph_hi - a.ph_lo > 1)) final_norm(a, vcu, G, wave, lane);
#ifdef PROBE_G
    __syncthreads();
    if (bx == 0 && tid == 0) { const unsigned long long* g_ = (const unsigned long long*)(a.ws + 65536); a.out[0] = (float)(g_[PROBE_G + 1] - g_[PROBE_G]) * 0.1f; }
#endif
#ifdef PROBE_TS
    STAMP(7); __syncthreads();
    if (bx == 0 && tid == 0) { const int k_ = PROBE_TS; const unsigned long long d_ = (k_ == 9) ? ts_[7] - ts_[0] : (k_ == 8) ? ts_[8] - ts_[4] : ts_[k_ + 1] - ts_[k_]; a.out[0] = (float)(((int)((float)d_ * 0.01f) / PROBE_Q) * PROBE_Q + PROBE_Q / 2); }
#endif
#undef IN
#undef SEAM
}

extern "C" void kernel_launch(void* const* d_in, const int* in_sizes, int n_in, void* d_out, int out_size, void* d_ws, size_t ws_size, hipStream_t stream) {
    static int grid = 0;
    if (grid == 0) {
        int dev = 0, cus = 0;
        if (hipGetDevice(&dev) != hipSuccess || hipDeviceGetAttribute(&cus, hipDeviceAttributeMultiprocessorCount, dev) != hipSuccess) { fprintf(stderr, "kernel_launch: device query failed\n"); grid = -1; return; }
        if (hipFuncSetAttribute((const void*)mega, hipFuncAttributeMaxDynamicSharedMemorySize, LDS_BYTES) != hipSuccess) { fprintf(stderr, "kernel_launch: hipFuncSetAttribute failed\n"); grid = -1; return; }
        (void)hipGetLastError();
        grid = cus;
    }
    if (grid < 0) return;
    Args a{};
    for (int i = 0; i < 16; ++i) a.in[i] = (const float*)d_in[i];
    a.out = (float*)d_out; a.ws = (unsigned char*)d_ws;
#if ONE_LAUNCH
    (void)hipMemsetAsync(d_ws, 0, 32768, stream);
    a.ph_lo = 0; a.ph_hi = NPHASE;
    void* args[] = {&a};
#ifdef PROBE_PLAIN
    hipLaunchKernelGGL(mega, dim3(grid), dim3(NTHR), LDS_BYTES, stream, a); hipError_t e = hipSuccess; (void)args;
#else
    hipError_t e = hipLaunchCooperativeKernel((const void*)mega, dim3(grid), dim3(NTHR), args, LDS_BYTES, stream);
#endif
    if (e != hipSuccess) fprintf(stderr, "cooperative launch failed: %s (grid %d)\n", hipGetErrorString(e), grid);
#else
    for (int p = 0; p < NPHASE; ++p) for (int rep = 0; rep < (p == HOSTDUP ? 2 : 1); ++rep) { a.ph_lo = p; a.ph_hi = p + 1; hipLaunchKernelGGL(mega, dim3(grid), dim3(NTHR), LDS_BYTES, stream, a); }
#endif
}
```
